# Optimizing an MI355X kernel written in HIP

```python
import math
import jax, jax.numpy as jnp
from jax import lax
import numpy as np

D_MODEL = 2048
BATCH = 8
SEQ = 2048
DEPTH = 1

MIX_WIDTH = D_MODEL
DA_WIDTH = MIX_WIDTH // 2
RW_WIDTH = MIX_WIDTH - DA_WIDTH
DA_HEADS = 8
DA_V_DIM = DA_WIDTH // DA_HEADS
DA_QK_DIM = DA_V_DIM // 2
RW_HEAD_SIZE = 64
RW_HEADS = RW_WIDTH // RW_HEAD_SIZE
RW_DECAY_LORA = 64
RW_A_LORA = 64
RW_GATE_LORA = 160
IN_COLS = 3 * DA_WIDTH + 3 * RW_WIDTH
Q_BLOCK = 128
N_GROUPS = 4
EXPERTS_PER_GROUP = 8
N_EXPERTS = N_GROUPS * EXPERTS_PER_GROUP
TOP_K_IN_GROUP = 2
D_EXPERT = 512
MOE_BLOCK = 128
NORM_EPS = 1e-6
LN_X_EPS = 64e-5

kernel_name = 'hybrid_diffattn_rwkv7_hmoe'


def rms_norm(x, g, eps=NORM_EPS):
    xf = x.astype(jnp.float32)
    y = xf * lax.rsqrt(jnp.mean(xf * xf, axis=-1, keepdims=True) + eps)
    return (y * g.astype(jnp.float32)).astype(x.dtype)


def token_shift(z):
    return jnp.pad(z, ((0, 0), (1, 0), (0, 0)))[:, :-1]


def alibi_slopes(n_heads):
    return jnp.asarray(2.0 ** (-8.0 * np.arange(1, n_heads + 1) / n_heads), dtype=jnp.float32)


def lambda_init(layer):
    return 0.8 - 0.6 * math.exp(-0.3 * layer)


def diff_attention(q, k, v, lam, sub_g, lam_init):
    b, s, h, _, dq = q.shape
    scale = dq ** -0.5
    slopes = alibi_slopes(h)
    outs = []
    for i in range(s // Q_BLOCK):
        q0, q1 = i * Q_BLOCK, (i + 1) * Q_BLOCK
        sc = jnp.einsum('bqhcd,bkhcd->bhcqk', q[:, q0:q1], k[:, :q1]).astype(jnp.float32) * scale
        dist = (jnp.arange(q0, q1)[:, None] - jnp.arange(q1)[None, :]).astype(jnp.float32)
        sc = jnp.where(dist >= 0, sc - slopes[:, None, None, None] * dist, -jnp.inf)
        p = jax.nn.softmax(sc, axis=-1)
        a = p[:, :, 0] - lam * p[:, :, 1]
        outs.append(jnp.einsum('bhqk,bkhd->bqhd', a.astype(v.dtype), v[:, :q1]))
    o = jnp.concatenate(outs, axis=1)
    o = rms_norm(o, sub_g) * (1.0 - lam_init)
    return o.reshape(b, s, h * o.shape[-1])


def rwkv7_time_mix(xn, r, k, v, mu_x, mu_rkv, w0, w1, w2, a0, a1, a2, g1, g2, k_k, k_a, r_k, ln_w, ln_b):
    b, s, c = r.shape
    h, n = RW_HEADS, RW_HEAD_SIZE
    f32 = jnp.float32
    xx = token_shift(xn) - xn
    x_w = xn + xx * mu_x[0]
    x_a = xn + xx * mu_x[1]
    x_g = xn + xx * mu_x[2]
    r = r + (token_shift(r) - r) * mu_rkv[0]
    k = k + (token_shift(k) - k) * mu_rkv[1]
    v = v + (token_shift(v) - v) * mu_rkv[2]
    w_log = -jax.nn.softplus(-(w0 + jnp.tanh(x_w @ w1) @ w2).astype(f32)) - 0.5
    decay = jnp.exp(-jnp.exp(w_log))
    a = jax.nn.sigmoid((a0 + (x_a @ a1) @ a2).astype(f32))
    g = jax.nn.sigmoid(x_g @ g1) @ g2
    r_h, k_h, v_h, a_h, w_h = (z.astype(f32).reshape(b, s, h, n) for z in (r, k, v, a, decay))
    kk = k_h * k_k.reshape(h, n).astype(f32)
    kk = kk / jnp.maximum(jnp.linalg.norm(kk, axis=-1, keepdims=True), 1e-12)
    k_h = k_h * (1.0 + (a_h - 1.0) * k_a.reshape(h, n).astype(f32))

    def step(state, inp):
        r_t, w_t, k_t, v_t, kk_t, b_t = inp
        sa = jnp.einsum('bhij,bhj->bhi', state, -kk_t)
        state = (state * w_t[:, :, None, :] + sa[..., None] * b_t[:, :, None, :]
                 + v_t[..., None] * k_t[:, :, None, :])
        return state, jnp.einsum('bhij,bhj->bhi', state, r_t)

    tm = lambda z: jnp.moveaxis(z, 1, 0)
    state0 = jnp.zeros((b, h, n, n), f32)
    _, y = lax.scan(step, state0, (tm(r_h), tm(w_h), tm(k_h), tm(v_h), tm(kk), tm(kk * a_h)))
    y = jnp.moveaxis(y, 0, 1)
    mean = jnp.mean(y, axis=-1, keepdims=True)
    var = jnp.mean(jnp.square(y - mean), axis=-1, keepdims=True)
    y = ((y - mean) * lax.rsqrt(var + LN_X_EPS) * ln_w.reshape(h, n).astype(f32)
         + ln_b.reshape(h, n).astype(f32))
    y = y + jnp.sum(r_h * k_h * r_k.astype(f32), axis=-1, keepdims=True) * v_h
    return (y.reshape(b, s, c) * g.astype(f32)).astype(xn.dtype)


def hier_moe(xn, w_group, b_group, w_expert, b_expert, w_gate, w_up, w_down):
    b, s, d = xn.shape
    t = b * s
    f32 = jnp.float32
    xt = xn.reshape(t, d)
    lg = (xt @ w_group).astype(f32) + b_group.astype(f32)
    grp = jnp.argmax(lg, axis=-1).astype(jnp.int32)
    p_grp = jnp.take_along_axis(jax.nn.softmax(lg, axis=-1), grp[:, None], axis=-1)
    le = (xt @ w_expert).astype(f32).reshape(t, N_GROUPS, EXPERTS_PER_GROUP) + b_expert.astype(f32)
    le = jnp.take_along_axis(le, grp[:, None, None], axis=1)[:, 0]
    top_p, top_i = lax.top_k(jax.nn.softmax(le, axis=-1), TOP_K_IN_GROUP)
    gates = p_grp * top_p / jnp.sum(top_p, axis=-1, keepdims=True)

    tk = t * TOP_K_IN_GROUP
    n_blocks = -(-tk // MOE_BLOCK) + N_EXPERTS
    n_rows = n_blocks * MOE_BLOCK
    flat_e = (grp[:, None] * EXPERTS_PER_GROUP + top_i).reshape(-1).astype(jnp.int32)
    flat_tok = (jnp.arange(tk, dtype=jnp.int32) // TOP_K_IN_GROUP)
    flat_gate = gates.reshape(-1)
    order = jnp.argsort(flat_e)
    se = flat_e[order]
    counts = jnp.zeros((N_EXPERTS,), jnp.int32).at[flat_e].add(1)
    starts = jnp.cumsum(counts) - counts
    pcounts = ((counts + MOE_BLOCK - 1) // MOE_BLOCK) * MOE_BLOCK
    pends = jnp.cumsum(pcounts)
    pstarts = pends - pcounts
    dest = pstarts[se] + (jnp.arange(tk, dtype=jnp.int32) - starts[se])
    row_tok = jnp.full((n_rows,), t, jnp.int32).at[dest].set(flat_tok[order])
    row_gate = jnp.zeros((n_rows,), f32).at[dest].set(flat_gate[order])
    block_e = jnp.minimum(jnp.searchsorted(pends, jnp.arange(n_blocks, dtype=jnp.int32) * MOE_BLOCK,
                                           side='right'), N_EXPERTS - 1).astype(jnp.int32)
    x_pad = jnp.concatenate([xt, jnp.zeros((1, d), xt.dtype)], axis=0)
    xb = x_pad[row_tok].reshape(n_blocks, MOE_BLOCK, d)

    def expert_block(args):
        xblk, e = args
        hdn = jax.nn.silu(xblk @ w_gate[e]) * (xblk @ w_up[e])
        return hdn @ w_down[e]

    yb = lax.map(expert_block, (xb, block_e)).reshape(n_rows, d)
    yb = yb * row_gate[:, None].astype(yb.dtype)
    out = jnp.zeros((t + 1, d), yb.dtype).at[row_tok].add(yb)[:t]
    return out.reshape(b, s, d)


def setup_inputs(seed: int = 0) -> dict:
    key = jax.random.key(seed)
    keys = iter(jax.random.split(key, 48))

    def nrm(shape, scale):
        return scale * jax.random.normal(next(keys), shape, jnp.float32)

    def uni(shape, lo, hi):
        return jax.random.uniform(next(keys), shape, jnp.float32, lo, hi)

    L, D = DEPTH, D_MODEL
    return {
        'x': nrm((BATCH, SEQ, D), 1.0),
        'g_mix': 1.0 + nrm((L, D), 0.02),
        'w_in': nrm((L, D, IN_COLS), D ** -0.5),
        'w_out': nrm((L, MIX_WIDTH, D), MIX_WIDTH ** -0.5),
        'da_lambda_q1': nrm((L, DA_QK_DIM), 0.1),
        'da_lambda_k1': nrm((L, DA_QK_DIM), 0.1),
        'da_lambda_q2': nrm((L, DA_QK_DIM), 0.1),
        'da_lambda_k2': nrm((L, DA_QK_DIM), 0.1),
        'da_subln_g': 1.0 + nrm((L, DA_V_DIM), 0.02),
        'rw_mu_x': uni((L, 3, D), 0.0, 1.0),
        'rw_mu_rkv': uni((L, 3, RW_WIDTH), 0.0, 1.0),
        'rw_w0': uni((L, RW_WIDTH), -2.5, 0.5),
        'rw_w1': nrm((L, D, RW_DECAY_LORA), D ** -0.5),
        'rw_w2': nrm((L, RW_DECAY_LORA, RW_WIDTH), 0.3 * RW_DECAY_LORA ** -0.5),
        'rw_a0': nrm((L, RW_WIDTH), 0.1),
        'rw_a1': nrm((L, D, RW_A_LORA), D ** -0.5),
        'rw_a2': nrm((L, RW_A_LORA, RW_WIDTH), 0.5 * RW_A_LORA ** -0.5),
        'rw_g1': nrm((L, D, RW_GATE_LORA), D ** -0.5),
        'rw_g2': nrm((L, RW_GATE_LORA, RW_WIDTH), RW_GATE_LORA ** -0.5),
        'rw_k_k': 0.85 + nrm((L, RW_WIDTH), 0.02),
        'rw_k_a': 1.0 + nrm((L, RW_WIDTH), 0.02),
        'rw_r_k': nrm((L, RW_HEADS, RW_HEAD_SIZE), 0.1),
        'rw_ln_w': 1.0 + nrm((L, RW_WIDTH), 0.02),
        'rw_ln_b': nrm((L, RW_WIDTH), 0.01),
        'g_ffn': 1.0 + nrm((L, D), 0.02),
        'moe_w_group': nrm((L, D, N_GROUPS), D ** -0.5),
        'moe_b_group': nrm((L, N_GROUPS), 0.01),
        'moe_w_expert': nrm((L, D, N_EXPERTS), D ** -0.5),
        'moe_b_expert': nrm((L, N_GROUPS, EXPERTS_PER_GROUP), 0.01),
        'moe_w_gate': nrm((L, N_EXPERTS, D, D_EXPERT), D ** -0.5),
        'moe_w_up': nrm((L, N_EXPERTS, D, D_EXPERT), D ** -0.5),
        'moe_w_down': nrm((L, N_EXPERTS, D_EXPERT, D), D_EXPERT ** -0.5),
        'g_final': 1.0 + nrm((D,), 0.02),
    }


def reference(x, g_mix, w_in, w_out, da_lambda_q1, da_lambda_k1, da_lambda_q2, da_lambda_k2, da_subln_g,
              rw_mu_x, rw_mu_rkv, rw_w0, rw_w1, rw_w2, rw_a0, rw_a1, rw_a2, rw_g1, rw_g2, rw_k_k, rw_k_a,
              rw_r_k, rw_ln_w, rw_ln_b, g_ffn, moe_w_group, moe_b_group, moe_w_expert, moe_b_expert,
              moe_w_gate, moe_w_up, moe_w_down, g_final):
    b, s, _ = x.shape
    f32 = jnp.float32
    split_at = [DA_WIDTH, 2 * DA_WIDTH, 3 * DA_WIDTH, 3 * DA_WIDTH + RW_WIDTH, 3 * DA_WIDTH + 2 * RW_WIDTH]
    h = x
    for l in range(DEPTH):
        xn = rms_norm(h, g_mix[l])
        proj = xn @ w_in[l]
        dq, dk, dv, rr, rk, rv = jnp.split(proj, split_at, axis=-1)
        lam_init = lambda_init(l)
        lam = (jnp.exp(jnp.sum(da_lambda_q1[l].astype(f32) * da_lambda_k1[l].astype(f32)))
               - jnp.exp(jnp.sum(da_lambda_q2[l].astype(f32) * da_lambda_k2[l].astype(f32))) + lam_init)
        o_da = diff_attention(dq.reshape(b, s, DA_HEADS, 2, DA_QK_DIM),
                              dk.reshape(b, s, DA_HEADS, 2, DA_QK_DIM),
                              dv.reshape(b, s, DA_HEADS, DA_V_DIM),
                              lam, da_subln_g[l], lam_init)
        o_rw = rwkv7_time_mix(xn, rr, rk, rv, rw_mu_x[l], rw_mu_rkv[l], rw_w0[l], rw_w1[l], rw_w2[l],
                              rw_a0[l], rw_a1[l], rw_a2[l], rw_g1[l], rw_g2[l], rw_k_k[l], rw_k_a[l],
                              rw_r_k[l], rw_ln_w[l], rw_ln_b[l])
        h = h + jnp.concatenate([o_da, o_rw], axis=-1) @ w_out[l]
        h = h + hier_moe(rms_norm(h, g_ffn[l]), moe_w_group[l], moe_b_group[l], moe_w_expert[l],
                         moe_b_expert[l], moe_w_gate[l], moe_w_up[l], moe_w_down[l])
    return rms_norm(h, g_final)
```

```cpp
#include <hip/hip_runtime.h>
#include <hip/hip_cooperative_groups.h>
#include <cstdio>
#include <cstdint>
namespace cg = cooperative_groups;

#ifndef N_LAUNCH_MODE
#define N_LAUNCH_MODE 0
#endif
#ifndef USE_REF_GEMM
#define USE_REF_GEMM 1
#endif

constexpr int BATCH = 8, SEQ = 2048, DM = 2048, T = BATCH * SEQ;
constexpr int DAW = 1024, RWW = 1024, NH_DA = 8, NH_RW = 16;
constexpr int NIN = 6912;
constexpr int PW = 768;
constexpr int NEXP = 32, DEXP = 512, CAP = T;
constexpr int MAXTILES = 160;
constexpr float C2Q = 0.125f * 1.4426950408889634f;
constexpr float LOG2E = 1.4426950408889634f;

constexpr size_t MiB = 1u << 20;
constexpr size_t WS_CTL = 0, CTL_BYTES = 1 * MiB;
constexpr size_t CTL_SS2 = 65536;
constexpr size_t CTL_CNT = 131072;
constexpr size_t WS_WOUT = 1 * MiB;
constexpr size_t WS_L2T = 9 * MiB;
constexpr size_t WS_RSTD1 = 11 * MiB;
constexpr size_t WS_RSTD2 = 11 * MiB + 65536;
constexpr size_t WS_TOKINFO = 11 * MiB + 131072;
constexpr size_t WS_WIN = 12 * MiB;
constexpr size_t WS_XB = 40 * MiB;
constexpr size_t WS_O = 40 * MiB;
constexpr size_t WS_INBUF = 104 * MiB;
constexpr size_t WS_PBUF = 296 * MiB;
constexpr size_t WS_A2 = 320 * MiB;
constexpr size_t WS_WL = 344 * MiB;
constexpr size_t WS_ABUF = 408 * MiB;
constexpr size_t WS_GBUF = 440 * MiB;
constexpr size_t WS_OPART = 472 * MiB;
constexpr size_t WS_HB = 104 * MiB;
constexpr size_t WS_WGU = 168 * MiB;
constexpr size_t WS_WD = 296 * MiB;
constexpr size_t WS_RT = 360 * MiB;
constexpr size_t WS_GATEB = 362 * MiB;
constexpr size_t WS_HID = 364 * MiB;
constexpr size_t WS_YB = 404 * MiB;
constexpr size_t WS_END = 564 * MiB;

constexpr int NTHREADS = 512, NWAVES = 8;
constexpr int LDS_BYTES = 147456;

typedef unsigned short bf16_t;
typedef short bf16x8 __attribute__((ext_vector_type(8)));
typedef float f32x4 __attribute__((ext_vector_type(4)));
typedef float f32x2 __attribute__((ext_vector_type(2)));
typedef unsigned u32x4 __attribute__((ext_vector_type(4)));
typedef unsigned u32x2 __attribute__((ext_vector_type(2)));

__device__ __forceinline__ unsigned f2bf(float f) { unsigned u = __builtin_bit_cast(unsigned, f); return (u + 0x7fffu + ((u >> 16) & 1u)) >> 16; }
__device__ __forceinline__ unsigned pk2(float lo, float hi) { return f2bf(lo) | (f2bf(hi) << 16); }
__device__ __forceinline__ float bf2f(unsigned h) { return __builtin_bit_cast(float, h << 16); }
__device__ __forceinline__ float bflo(unsigned w) { return __builtin_bit_cast(float, w << 16); }
__device__ __forceinline__ float bfhi(unsigned w) { return __builtin_bit_cast(float, w & 0xffff0000u); }
__device__ __forceinline__ float wave_sum(float v) {
#pragma unroll
    for (int o = 1; o < 64; o <<= 1) v += __shfl_xor(v, o);
    return v;
}
__device__ __forceinline__ float sigmoidf_(float x) { return 1.0f / (1.0f + __expf(-x)); }

struct Params {
    const float* in[33];
    float* out;
    unsigned char* ws;
    int ph_lo, ph_hi;
};

enum { PH_PRO = 0, PH_INPROJ, PH_L2PREP, PH_L2GEMM, PH_MIX, PH_COMB, PH_OUT, PH_ROUTE, PH_G1, PH_G2, PH_FINAL, PH_COUNT };

struct Unit { int pm, pn; long a_off, b_off; const int* gidx; int valid, e, tile; };
struct Gemm { const bf16_t* A; const bf16_t* Bt; int lda, ldb, K; };

struct DenseOrder {
    int nM, nN, nwg, G, c, lda, ldb, acol_shift, acol_w;
    __device__ void init(int M, int N, int G_, int c_, int lda_, int ldb_, int acol_shift_ = -1, int acol_w_ = 0) {
        nM = M / 256; nN = N / 256; nwg = nM * nN; G = G_; c = c_; lda = lda_; ldb = ldb_; acol_shift = acol_shift_; acol_w = acol_w_; }
    __device__ bool next(int i, Unit& u) const {
        const long L = (long)i * G + c; if (L >= nwg) return false;
        int wgid = (int)L; { const int q = nwg / 8, r = nwg % 8, xcd = wgid % 8, off = wgid / 8; wgid = (xcd < r ? xcd * (q + 1) : r * (q + 1) + (xcd - r) * q) + off; }
        const int nig = 8 * nN, gid = wgid / nig, fm = gid * 8, gsz = (nM - fm) < 8 ? (nM - fm) : 8;
        u.pm = fm + ((wgid % nig) % gsz); u.pn = (wgid % nig) / gsz;
        u.a_off = (long)u.pm * 256 * lda + (acol_shift >= 0 ? (long)(u.pn >> acol_shift) * acol_w : 0);
        u.b_off = (long)u.pn * 256 * ldb; u.gidx = nullptr; u.valid = 256; u.e = 0; u.tile = 0; return true;
    }
};
struct MoeOrder {
    const unsigned* cnt; const int* rt; int ncol, G, c, mode; long a_ld, b_estride, b_ld;
    __device__ bool next(int i, Unit& u) const {
        const long L = (long)i * G + c; const int g = (int)(L / ncol), pn = (int)(L % ncol);
        int ts = 0, e = 0, k = -1, ce = 0;
        for (e = 0; e < NEXP; ++e) { ce = (int)cnt[e]; const int nt = (ce + 255) >> 8; if (g < ts + nt) { k = g - ts; break; } ts += nt; }
        if (k < 0) return false;
        u.pm = g; u.pn = pn; u.e = e; u.tile = g; u.valid = (ce - 256 * k) < 256 ? (ce - 256 * k) : 256;
        if (mode == 0) { u.gidx = rt + (long)e * CAP + 256 * k; u.a_off = 0; }
        else { u.gidx = nullptr; u.a_off = (long)g * 256 * a_ld; }
        u.b_off = (long)e * b_estride + (long)pn * 256 * b_ld; return true;
    }
};

template <class Epi, class Sched>
__device__ __forceinline__ void gemm_phase_ref(unsigned char* lds, const Gemm g, const Sched& S, const Epi& E) {
    const int tid = threadIdx.x, wid = tid >> 6, lane = tid & 63, wr = wid >> 2, wc = wid & 3, fr = lane & 15, fq = lane >> 4;
    bf16_t* As = (bf16_t*)lds; bf16_t* Bs = As + 256 * 72;
    Unit u;
    for (int ui = 0; S.next(ui, u); ++ui) {
        f32x4 acc[2][2][4][2];
#pragma unroll
        for (int a = 0; a < 2; ++a)
#pragma unroll
            for (int b = 0; b < 2; ++b)
#pragma unroll
                for (int m = 0; m < 4; ++m)
#pragma unroll
                    for (int n = 0; n < 2; ++n) acc[a][b][m][n] = (f32x4){0.f, 0.f, 0.f, 0.f};
        long arow[4];
#pragma unroll
        for (int i = 0; i < 4; ++i) { const int row = (tid + 512 * i) >> 3; arow[i] = u.gidx ? (row < u.valid ? (long)u.gidx[row] : 0L) : (long)row; }
        for (int k0 = 0; k0 < g.K; k0 += 64) {
            __syncthreads();
#pragma unroll
            for (int i = 0; i < 4; ++i) { const int ch = tid + 512 * i, row = ch >> 3, c8 = ch & 7;
                const u32x4 va = *(const u32x4*)(g.A + u.a_off + arow[i] * g.lda + k0 + c8 * 8);
                const u32x4 vb = *(const u32x4*)(g.Bt + u.b_off + (long)row * g.ldb + k0 + c8 * 8);
                *(u32x4*)(As + row * 72 + c8 * 8) = va; *(u32x4*)(Bs + row * 72 + c8 * 8) = vb; }
            __syncthreads();
            for (int kk = 0; kk < 64; ++kk) {
                float a[2][4];
#pragma unroll
                for (int ai = 0; ai < 2; ++ai)
#pragma unroll
                    for (int m = 0; m < 4; ++m) a[ai][m] = bf2f(As[(ai * 128 + wr * 64 + m * 16 + fr) * 72 + kk]);
#pragma unroll
                for (int bj = 0; bj < 2; ++bj)
#pragma unroll
                    for (int n = 0; n < 2; ++n)
#pragma unroll
                        for (int e = 0; e < 4; ++e) {
                            const int cl = Epi::PERM ? (bj * 128 + wc * 32 + 8 * fq + 4 * n + e) : (bj * 128 + wc * 32 + 16 * n + 4 * fq + e);
                            const float b = bf2f(Bs[cl * 72 + kk]);
#pragma unroll
                            for (int ai = 0; ai < 2; ++ai)
#pragma unroll
                                for (int m = 0; m < 4; ++m) acc[ai][bj][m][n][e] += a[ai][m] * b;
                        }
            }
        }
        E(acc, u, wr, wc, fr, fq);
    }
    __syncthreads();
}

__device__ __forceinline__ u32x4 pack8(const f32x4 v0, const f32x4 v1) { u32x4 w; w.x = pk2(v0[0], v0[1]); w.y = pk2(v0[2], v0[3]); w.z = pk2(v1[0], v1[1]); w.w = pk2(v1[2], v1[3]); return w; }

struct EpiIn {
    static constexpr bool PERM = true;
    bf16_t* inbuf; bf16_t* pbuf; const float* rstd1;
    __device__ __forceinline__ void operator()(const f32x4 (&acc)[2][2][4][2], const Unit& u, int wr, int wc, int fr, int fq) const {
        bf16_t* base; int ldc, colt; float sc0 = 1.f;
        if (u.pn < 24) { base = inbuf + (size_t)(u.pn >> 2) * T * 1024; ldc = 1024; colt = (u.pn & 3) * 256; if (u.pn < 4) sc0 = C2Q; }
        else { base = pbuf; ldc = PW; colt = (u.pn - 24) * 256; }
        const int row0 = u.pm * 256 + wr * 64 + fr, col0 = colt + wc * 32 + 8 * fq;
#pragma unroll
        for (int ai = 0; ai < 2; ++ai)
#pragma unroll
            for (int m = 0; m < 4; ++m) { const int row = row0 + ai * 128 + m * 16; const float rs = rstd1[row] * sc0; bf16_t* rowp = base + (size_t)row * ldc + col0;
#pragma unroll
                for (int bj = 0; bj < 2; ++bj) *(u32x4*)(rowp + bj * 128) = pack8(acc[ai][bj][m][0] * rs, acc[ai][bj][m][1] * rs); }
    }
};
struct EpiL2 {
    static constexpr bool PERM = true;
    float* wl; bf16_t* abuf; bf16_t* gbuf; const float* w0; const float* a0;
    __device__ __forceinline__ void operator()(const f32x4 (&acc)[2][2][4][2], const Unit& u, int wr, int wc, int fr, int fq) const {
        const int grp = u.pn >> 2, colt = (u.pn & 3) * 256;
        const int row0 = u.pm * 256 + wr * 64 + fr, col0 = colt + wc * 32 + 8 * fq;
#pragma unroll
        for (int bj = 0; bj < 2; ++bj) {
            const int c = col0 + bj * 128;
            f32x4 b0 = (f32x4){0.f, 0.f, 0.f, 0.f}, b1 = b0;
            if (grp == 0) { b0 = *(const f32x4*)(w0 + c); b1 = *(const f32x4*)(w0 + c + 4); }
            else if (grp == 1) { b0 = *(const f32x4*)(a0 + c); b1 = *(const f32x4*)(a0 + c + 4); }
#pragma unroll
            for (int ai = 0; ai < 2; ++ai)
#pragma unroll
                for (int m = 0; m < 4; ++m) { const int row = row0 + ai * 128 + m * 16; f32x4 v0 = acc[ai][bj][m][0] + b0, v1 = acc[ai][bj][m][1] + b1;
                    if (grp == 0) {
#pragma unroll
                        for (int e = 0; e < 4; ++e) { v0[e] = -0.60653065971f * LOG2E * sigmoidf_(v0[e]); v1[e] = -0.60653065971f * LOG2E * sigmoidf_(v1[e]); }
                        float* p = wl + (size_t)row * 1024 + c; *(f32x4*)p = v0; *(f32x4*)(p + 4) = v1;
                    } else if (grp == 1) {
#pragma unroll
                        for (int e = 0; e < 4; ++e) { v0[e] = sigmoidf_(v0[e]); v1[e] = sigmoidf_(v1[e]); }
                        *(u32x4*)(abuf + (size_t)row * 1024 + c) = pack8(v0, v1);
                    } else { *(u32x4*)(gbuf + (size_t)row * 1024 + c) = pack8(v0, v1); }
                }
        }
    }
};
struct EpiOut {
    static constexpr bool PERM = true;
    const float* x; float* h; bf16_t* hb; float* ss2;
    __device__ __forceinline__ void operator()(const f32x4 (&acc)[2][2][4][2], const Unit& u, int wr, int wc, int fr, int fq) const {
        const int row0 = u.pm * 256 + wr * 64 + fr, col0 = u.pn * 256 + wc * 32 + 8 * fq;
#pragma unroll
        for (int ai = 0; ai < 2; ++ai)
#pragma unroll
            for (int m = 0; m < 4; ++m) { const int row = row0 + ai * 128 + m * 16; float ss = 0.f;
#pragma unroll
                for (int bj = 0; bj < 2; ++bj) { const size_t off = (size_t)row * DM + col0 + bj * 128;
                    const f32x4 x0 = *(const f32x4*)(x + off), x1 = *(const f32x4*)(x + off + 4);
                    const f32x4 v0 = acc[ai][bj][m][0] + x0, v1 = acc[ai][bj][m][1] + x1;
                    *(f32x4*)(h + off) = v0; *(f32x4*)(h + off + 4) = v1; *(u32x4*)(hb + off) = pack8(v0, v1);
                    ss += (v0[0] * v0[0] + v0[1] * v0[1]) + (v0[2] * v0[2] + v0[3] * v0[3]) + (v1[0] * v1[0] + v1[1] * v1[1]) + (v1[2] * v1[2] + v1[3] * v1[3]); }
                ss += __shfl_xor(ss, 16); ss += __shfl_xor(ss, 32);
                if (fq == 0) atomicAdd(ss2 + row, ss); }
    }
};
struct EpiGU {
    static constexpr bool PERM = true;
    bf16_t* hid; const float* rstd2;
    __device__ __forceinline__ void operator()(const f32x4 (&acc)[2][2][4][2], const Unit& u, int wr, int wc, int fr, int fq) const {
        const int col0 = u.pn * 128 + wc * 32 + 8 * fq;
#pragma unroll
        for (int ai = 0; ai < 2; ++ai)
#pragma unroll
            for (int m = 0; m < 4; ++m) { const int rl = ai * 128 + wr * 64 + m * 16 + fr; const int tok = (rl < u.valid) ? u.gidx[rl] : 0; const float rs = rstd2[tok];
                f32x4 o0, o1;
#pragma unroll
                for (int e = 0; e < 4; ++e) { const float g0 = acc[ai][0][m][0][e] * rs, u0 = acc[ai][1][m][0][e] * rs, g1 = acc[ai][0][m][1][e] * rs, u1 = acc[ai][1][m][1][e] * rs;
                    o0[e] = g0 * sigmoidf_(g0) * u0; o1[e] = g1 * sigmoidf_(g1) * u1; }
                *(u32x4*)(hid + ((size_t)u.tile * 256 + rl) * DEXP + col0) = pack8(o0, o1); }
    }
};
struct EpiDown {
    static constexpr bool PERM = true;
    bf16_t* yb; const float* gateb; const unsigned* cnt;
    __device__ __forceinline__ void operator()(const f32x4 (&acc)[2][2][4][2], const Unit& u, int wr, int wc, int fr, int fq) const {
        const int col0 = u.pn * 256 + wc * 32 + 8 * fq;
        int ts = 0; for (int e = 0; e < u.e; ++e) ts += ((int)cnt[e] + 255) >> 8;
        const int k = u.tile - ts;
#pragma unroll
        for (int ai = 0; ai < 2; ++ai)
#pragma unroll
            for (int m = 0; m < 4; ++m) { const int rl = ai * 128 + wr * 64 + m * 16 + fr; const float gt = (rl < u.valid) ? gateb[(size_t)u.e * CAP + 256 * k + rl] : 0.f;
#pragma unroll
                for (int bj = 0; bj < 2; ++bj) *(u32x4*)(yb + ((size_t)u.tile * 256 + rl) * DM + col0 + bj * 128) = pack8(acc[ai][bj][m][0] * gt, acc[ai][bj][m][1] * gt); }
    }
};

__device__ __forceinline__ void tr_item(const float* W, int ldw, int Kvalid, int k0, int n0, bf16_t* WT, int ldt, int trow0, float* scr, int lane,
                                        const float* gk, const float* mu, int mode) {
#pragma unroll 8
    for (int i = 0; i < 32; ++i) { const int kk = 2 * i + (lane >> 5), k = k0 + kk; float v = 0.f;
        if (k < Kvalid) { v = W[(size_t)k * ldw + n0 + (lane & 31)]; float s = gk ? gk[k] : 1.f; if (mode == 1) s *= (1.f - mu[k]); else if (mode == 2) s *= mu[k]; v *= s; }
        scr[kk * 33 + (lane & 31)] = v; }
    __builtin_amdgcn_s_waitcnt(0xC07F); asm volatile("" ::: "memory");
    const int c = lane & 7;
#pragma unroll
    for (int j = 0; j < 4; ++j) { const int n = (lane >> 3) + 8 * j; const float* s = scr + (8 * c) * 33 + n;
        u32x4 o; o.x = pk2(s[0 * 33], s[1 * 33]); o.y = pk2(s[2 * 33], s[3 * 33]); o.z = pk2(s[4 * 33], s[5 * 33]); o.w = pk2(s[6 * 33], s[7 * 33]);
        *(u32x4*)(WT + (size_t)(trow0 + n) * ldt + k0 + 8 * c) = o; }
    __builtin_amdgcn_s_waitcnt(0xC07F); asm volatile("" ::: "memory");
}

__device__ __forceinline__ void phase_prologue(const Params& p, unsigned char* lds) {
    const int tid = threadIdx.x, lane = tid & 63, wave = tid >> 6;
    const int gw = blockIdx.x * NWAVES + wave, NGW = gridDim.x * NWAVES;
    unsigned char* ws = p.ws;
    float* scr = (float*)(lds + wave * 16384);
    bf16_t* WinT = (bf16_t*)(ws + WS_WIN); bf16_t* WoutT = (bf16_t*)(ws + WS_WOUT); bf16_t* L2T = (bf16_t*)(ws + WS_L2T);
    const float* g_mix = p.in[1]; const float* mu_x = p.in[9];
    constexpr int I_WIN = 32 * 192;
    constexpr int I_L1 = 32 * 2 * 2 + 32 * 2 * 2 + 32 * 5 * 2;
    constexpr int I_WOUT = 32 * 64;
    constexpr int I_L2 = 3 * 4 * 32;
    constexpr int NITEMS = I_WIN + I_L1 + I_WOUT + I_L2;
    for (int it = gw; it < NITEMS; it += NGW) {
        int r = it;
        if (r < I_WIN) { const int kb = r / 192, nb = r % 192; tr_item(p.in[2], 6144, 2048, 64 * kb, 32 * nb, WinT, 2048, 32 * nb, scr, lane, g_mix, nullptr, 0); continue; } r -= I_WIN;
        if (r < I_L1) {
            int which, nb, mode, kb;
            if (r < 128) { which = 0; } else if (r < 256) { which = 1; r -= 128; } else { which = 2; r -= 256; }
            const int nnb = (which == 2) ? 5 : 2;
            kb = r / (nnb * 2); const int rr = r % (nnb * 2); nb = rr / 2; mode = 1 + (rr & 1);
            const float* W = which == 0 ? p.in[12] : which == 1 ? p.in[15] : p.in[17];
            const int ldw = which == 2 ? 160 : 64;
            const int rowbase = 6144 + (which == 0 ? 0 : which == 1 ? 128 : 256) + (mode == 2 ? ldw : 0);
            tr_item(W, ldw, 2048, 64 * kb, 32 * nb, WinT, 2048, rowbase + 32 * nb, scr, lane, g_mix, mu_x + which * 2048, mode); continue; } r -= I_L1;
        if (r < I_WOUT) { const int kb = r / 64, nb = r % 64; tr_item(p.in[3], 2048, 2048, 64 * kb, 32 * nb, WoutT, 2048, 32 * nb, scr, lane, nullptr, nullptr, 0); continue; } r -= I_WOUT;
        { const int which = r / 128, rr = r % 128, kb = rr / 32, nb = rr % 32;
          const float* W = which == 0 ? p.in[13] : which == 1 ? p.in[16] : p.in[18]; const int kv = which == 2 ? 160 : 64;
          tr_item(W, 1024, kv, 64 * kb, 32 * nb, L2T, 256, which * 1024 + 32 * nb, scr, lane, nullptr, nullptr, 0); }
    }
    for (int ch = blockIdx.x * NTHREADS + tid; ch < 192 * 256; ch += gridDim.x * NTHREADS) *(u32x4*)(WinT + (size_t)6720 * 2048 + (size_t)ch * 8) = (u32x4){0u, 0u, 0u, 0u};
    const float* x = p.in[0]; bf16_t* xb = (bf16_t*)(ws + WS_XB); float* rstd1 = (float*)(ws + WS_RSTD1);
    for (int m = gw; m < T; m += NGW) {
        const f32x4* xr = (const f32x4*)(x + (size_t)m * DM) + lane; f32x4 v[8]; float s = 0.f;
#pragma unroll
        for (int j = 0; j < 8; ++j) { v[j] = xr[64 * j]; s += (v[j][0] * v[j][0] + v[j][1] * v[j][1]) + (v[j][2] * v[j][2] + v[j][3] * v[j][3]); }
        s = wave_sum(s);
        u32x2* o = (u32x2*)(xb + (size_t)m * DM) + lane;
#pragma unroll
        for (int j = 0; j < 8; ++j) { u32x2 w; w.x = pk2(v[j][0], v[j][1]); w.y = pk2(v[j][2], v[j][3]); o[64 * j] = w; }
        if (lane == 0) rstd1[m] = 1.0f / sqrtf(s * (1.0f / DM) + 1e-6f);
    }
}

__device__ __forceinline__ void convert_experts(const Params& p, unsigned char* lds) {
    const int tid = threadIdx.x, lane = tid & 63, wave = tid >> 6;
    const int gw = blockIdx.x * NWAVES + wave, NGW = gridDim.x * NWAVES;
    float* scr = (float*)(lds + 65536 + wave * 8704);
    bf16_t* Wgu = (bf16_t*)(p.ws + WS_WGU); bf16_t* Wd = (bf16_t*)(p.ws + WS_WD); const float* gf = p.in[24];
    constexpr int I_G = 32 * 32 * 16;
    constexpr int I_D = 32 * 8 * 64;
    for (int it = gw; it < 2 * I_G + I_D; it += NGW) {
        int r = it;
        if (r < 2 * I_G) { const int up = r >= I_G; if (up) r -= I_G; const int e = r / 512, rr = r % 512, kb = rr / 16, nb = rr % 16; const int n0 = 32 * nb;
            tr_item((up ? p.in[30] : p.in[29]) + (size_t)e * 2048 * 512, 512, 2048, 64 * kb, n0, Wgu + (size_t)e * 1024 * 2048, 2048, 256 * (n0 >> 7) + (n0 & 127) + (up ? 128 : 0), scr, lane, gf, nullptr, 0); continue; }
        r -= 2 * I_G;
        { const int e = r / 512, rr = r % 512, kb = rr / 64, nb = rr % 64;
          tr_item(p.in[31] + (size_t)e * 512 * 2048, 2048, 512, 64 * kb, 32 * nb, Wd + (size_t)e * 2048 * 512, 512, 32 * nb, scr, lane, nullptr, nullptr, 0); }
    }
}

__device__ __forceinline__ void phase_l2prep(const Params& p) {
    const bf16_t* P = (const bf16_t*)(p.ws + WS_PBUF); bf16_t* A2 = (bf16_t*)(p.ws + WS_A2);
    const int nchunk = T * 96;
    for (int id = blockIdx.x * NTHREADS + threadIdx.x; id < nchunk; id += gridDim.x * NTHREADS) {
        const int t = id / 96, ch = id % 96, gi = ch >> 5, jc = (ch & 31) * 8;
        const int width = gi == 2 ? 160 : 64, pa = gi == 0 ? 0 : gi == 1 ? 128 : 256, pb = pa + width;
        u32x4 o = (u32x4){0u, 0u, 0u, 0u};
        if (jc < width) {
            const u32x4 va = *(const u32x4*)(P + (size_t)t * PW + pa + jc);
            u32x4 vb = (u32x4){0u, 0u, 0u, 0u};
            if ((t & (SEQ - 1)) != 0) vb = *(const u32x4*)(P + (size_t)(t - 1) * PW + pb + jc);
            float f[8];
#pragma unroll
            for (int i = 0; i < 4; ++i) { f[2 * i] = bflo(va[i]) + bflo(vb[i]); f[2 * i + 1] = bfhi(va[i]) + bfhi(vb[i]); }
#pragma unroll
            for (int i = 0; i < 8; ++i) { if (gi == 0) f[i] = 1.0f - 2.0f / (__expf(2.0f * f[i]) + 1.0f); else if (gi == 2) f[i] = sigmoidf_(f[i]); }
            o.x = pk2(f[0], f[1]); o.y = pk2(f[2], f[3]); o.z = pk2(f[4], f[5]); o.w = pk2(f[6], f[7]);
        }
        *(u32x4*)(A2 + (size_t)t * PW + ch * 8) = o;
    }
}

constexpr int TC = 32;
__device__ __forceinline__ void rwkv_chain(const Params& p, unsigned char* lds, int chain) {
    const int tid = threadIdx.x, lane = tid & 63, wave = tid >> 6;
    const int b = chain >> 4, h = chain & 15, c = h * 64 + lane;
    float* Rs = (float*)lds; float* Ws = Rs + TC * 64; float* Ks = Ws + TC * 64; float* Vs = Ks + TC * 64; float* KKs = Vs + TC * 64; float* Bs = KKs + TC * 64;
    float* Ys = Bs + TC * 64; float* Gs = Ys + TC * 64; float* BON = Gs + TC * 64;
    const bf16_t* rb = (const bf16_t*)(p.ws + WS_INBUF) + (size_t)3 * T * 1024; const bf16_t* kb = rb + (size_t)T * 1024; const bf16_t* vb = kb + (size_t)T * 1024;
    const float* wl = (const float*)(p.ws + WS_WL); const bf16_t* ab = (const bf16_t*)(p.ws + WS_ABUF); const bf16_t* gb = (const bf16_t*)(p.ws + WS_GBUF);
    bf16_t* O = (bf16_t*)(p.ws + WS_O);
    const float mu_r = p.in[10][c], mu_k = p.in[10][1024 + c], mu_v = p.in[10][2048 + c];
    const float k_k = p.in[19][c], k_a = p.in[20][c], r_k = p.in[21][c], ln_w = p.in[22][c], ln_b = p.in[23][c];
    const int r8 = lane >> 3, q = lane & 7, irow = 8 * wave + r8;
    float S[8];
#pragma unroll
    for (int e = 0; e < 8; ++e) S[e] = 0.f;
    for (int t0 = 0; t0 < SEQ; t0 += TC) {
#pragma unroll
        for (int s = 0; s < TC / NWAVES; ++s) {
            const int tl = wave * (TC / NWAVES) + s, t = t0 + tl; const size_t m = (size_t)b * SEQ + t, off = m * 1024 + c;
            const float rc = bf2f(rb[off]), kc = bf2f(kb[off]), vc = bf2f(vb[off]);
            float rp = 0.f, kp = 0.f, vp = 0.f;
            if (t > 0) { rp = bf2f(rb[off - 1024]); kp = bf2f(kb[off - 1024]); vp = bf2f(vb[off - 1024]); }
            const float rr = rc + (rp - rc) * mu_r, kx = kc + (kp - kc) * mu_k, vv = vc + (vp - vc) * mu_v;
            const float w = __builtin_amdgcn_exp2f(wl[off]), a = bf2f(ab[off]);
            const float kkv = kx * k_k; const float n2 = wave_sum(kkv * kkv); const float kkn = kkv / fmaxf(sqrtf(n2), 1e-12f);
            const float kmod = kx * (1.0f + (a - 1.0f) * k_a);
            const float bon = wave_sum(rr * kmod * r_k);
            Rs[tl * 64 + lane] = rr; Ws[tl * 64 + lane] = w; Ks[tl * 64 + lane] = kmod; Vs[tl * 64 + lane] = vv; KKs[tl * 64 + lane] = -kkn; Bs[tl * 64 + lane] = kkn * a;
            Gs[tl * 64 + lane] = bf2f(gb[off]); if (lane == 0) BON[tl] = bon;
        }
        __syncthreads();
        for (int tl = 0; tl < TC; ++tl) {
            const f32x4 kk0 = *(const f32x4*)(KKs + tl * 64 + 8 * q), kk1 = *(const f32x4*)(KKs + tl * 64 + 8 * q + 4);
            const f32x4 w0 = *(const f32x4*)(Ws + tl * 64 + 8 * q), w1 = *(const f32x4*)(Ws + tl * 64 + 8 * q + 4);
            const f32x4 b0 = *(const f32x4*)(Bs + tl * 64 + 8 * q), b1 = *(const f32x4*)(Bs + tl * 64 + 8 * q + 4);
            const f32x4 k0 = *(const f32x4*)(Ks + tl * 64 + 8 * q), k1 = *(const f32x4*)(Ks + tl * 64 + 8 * q + 4);
            const f32x4 r0 = *(const f32x4*)(Rs + tl * 64 + 8 * q), r1 = *(const f32x4*)(Rs + tl * 64 + 8 * q + 4);
            const float v = Vs[tl * 64 + irow];
            float sa = (S[0] * kk0[0] + S[1] * kk0[1]) + (S[2] * kk0[2] + S[3] * kk0[3]) + (S[4] * kk1[0] + S[5] * kk1[1]) + (S[6] * kk1[2] + S[7] * kk1[3]);
            sa += __shfl_xor(sa, 1); sa += __shfl_xor(sa, 2); sa += __shfl_xor(sa, 4);
#pragma unroll
            for (int e = 0; e < 4; ++e) { S[e] = S[e] * w0[e] + (sa * b0[e] + v * k0[e]); S[4 + e] = S[4 + e] * w1[e] + (sa * b1[e] + v * k1[e]); }
            float y = (S[0] * r0[0] + S[1] * r0[1]) + (S[2] * r0[2] + S[3] * r0[3]) + (S[4] * r1[0] + S[5] * r1[1]) + (S[6] * r1[2] + S[7] * r1[3]);
            y += __shfl_xor(y, 1); y += __shfl_xor(y, 2); y += __shfl_xor(y, 4);
            if (q == 0) Ys[tl * 64 + irow] = y;
        }
        __syncthreads();
#pragma unroll
        for (int s = 0; s < TC / NWAVES; ++s) {
            const int tl = wave * (TC / NWAVES) + s, t = t0 + tl; const size_t m = (size_t)b * SEQ + t;
            const float y = Ys[tl * 64 + lane]; const float mean = wave_sum(y) * (1.0f / 64.0f); const float d = y - mean; const float var = wave_sum(d * d) * (1.0f / 64.0f);
            float yn = d * (1.0f / sqrtf(var + 64e-5f)) * ln_w + ln_b;
            yn += BON[tl] * Vs[tl * 64 + lane];
            O[m * DM + 1024 + c] = (bf16_t)f2bf(yn * Gs[tl * 64 + lane]);
        }
        __syncthreads();
    }
}

__device__ __forceinline__ void attn_unit_ref(const Params& p, unsigned char* lds, int b, int h, int comp, int qb) {
    const int tid = threadIdx.x, row = tid & 255, dh = tid >> 8;
    float* Kt = (float*)lds; float* Vt = Kt + 64 * 64;
    const bf16_t* qbuf = (const bf16_t*)(p.ws + WS_INBUF); const bf16_t* kbuf = qbuf + (size_t)T * 1024; const bf16_t* vbuf = kbuf + (size_t)T * 1024;
    bf16_t* Op = (bf16_t*)(p.ws + WS_OPART) + (size_t)comp * T * 1024;
    const size_t rowbase = (size_t)b * SEQ; const int qpos = qb * 256 + row;
    float qv[64], o[64];
    { const bf16_t* qp = qbuf + (rowbase + qpos) * 1024 + h * 128 + comp * 64;
#pragma unroll
      for (int d = 0; d < 64; d += 8) { const u32x4 w = *(const u32x4*)(qp + d);
#pragma unroll
          for (int i = 0; i < 4; ++i) { qv[d + 2 * i] = bflo(w[i]); qv[d + 2 * i + 1] = bfhi(w[i]); } } }
#pragma unroll
    for (int d = 0; d < 64; ++d) o[d] = 0.f;
    float mrun = -1e30f, l = 0.f;
    const float slope2 = exp2f(-(float)(h + 1)) * LOG2E;
    const int ntile = (qb + 1) * 4;
    for (int kt = 0; kt < ntile; ++kt) {
        __syncthreads();
        for (int ch = tid; ch < 1536; ch += NTHREADS) { const int r = ch / 24, cc = ch % 24; const size_t grow = rowbase + kt * 64 + r;
            if (cc < 8) { const u32x4 w = *(const u32x4*)(kbuf + grow * 1024 + h * 128 + comp * 64 + cc * 8);
#pragma unroll
                for (int i = 0; i < 4; ++i) { Kt[r * 64 + cc * 8 + 2 * i] = bflo(w[i]); Kt[r * 64 + cc * 8 + 2 * i + 1] = bfhi(w[i]); } }
            else { const int c2 = cc - 8; const u32x4 w = *(const u32x4*)(vbuf + grow * 1024 + h * 128 + c2 * 8);
#pragma unroll
                for (int i = 0; i < 4; ++i) { Vt[r * 128 + c2 * 8 + 2 * i] = bflo(w[i]); Vt[r * 128 + c2 * 8 + 2 * i + 1] = bfhi(w[i]); } } }
        __syncthreads();
        for (int j = 0; j < 64; ++j) {
            const int kpos = kt * 64 + j; if (kpos > qpos) break;
            float s = 0.f;
#pragma unroll
            for (int d = 0; d < 64; d += 4) { const f32x4 kv = *(const f32x4*)(Kt + j * 64 + d); s += qv[d] * kv[0] + qv[d + 1] * kv[1] + qv[d + 2] * kv[2] + qv[d + 3] * kv[3]; }
            s += slope2 * (float)kpos;
            if (s > mrun) { const float f = exp2f(mrun - s); l *= f;
#pragma unroll
                for (int d = 0; d < 64; ++d) o[d] *= f;
                mrun = s; }
            const float pr = exp2f(s - mrun); l += pr;
#pragma unroll
            for (int d = 0; d < 64; d += 4) { const f32x4 vv = *(const f32x4*)(Vt + j * 128 + dh * 64 + d); o[d] += pr * vv[0]; o[d + 1] += pr * vv[1]; o[d + 2] += pr * vv[2]; o[d + 3] += pr * vv[3]; }
        }
    }
    const float il = 1.0f / l;
    bf16_t* op = Op + (rowbase + qpos) * 1024 + h * 128 + dh * 64;
#pragma unroll
    for (int d = 0; d < 64; d += 8) { u32x4 w; w.x = pk2(o[d] * il, o[d + 1] * il); w.y = pk2(o[d + 2] * il, o[d + 3] * il); w.z = pk2(o[d + 4] * il, o[d + 5] * il); w.w = pk2(o[d + 6] * il, o[d + 7] * il); *(u32x4*)(op + d) = w; }
    __syncthreads();
}

__device__ __forceinline__ void phase_combine(const Params& p) {
    const int tid = threadIdx.x, lane = tid & 63, wave = tid >> 6;
    const int gw = blockIdx.x * NWAVES + wave, NGW = gridDim.x * NWAVES;
    const float s1 = wave_sum(p.in[4][lane] * p.in[5][lane]), s2 = wave_sum(p.in[6][lane] * p.in[7][lane]);
    const float lam = __expf(s1) - __expf(s2) + 0.2f;
    const bf16_t* O0 = (const bf16_t*)(p.ws + WS_OPART); const bf16_t* O1 = O0 + (size_t)T * 1024; bf16_t* O = (bf16_t*)(p.ws + WS_O);
    const float* sg = p.in[8] + (lane & 7) * 16;
    for (int m = gw; m < T; m += NGW) {
        const u32x4 a0 = *(const u32x4*)(O0 + (size_t)m * 1024 + lane * 16), a1 = *(const u32x4*)(O0 + (size_t)m * 1024 + lane * 16 + 8);
        const u32x4 c0 = *(const u32x4*)(O1 + (size_t)m * 1024 + lane * 16), c1 = *(const u32x4*)(O1 + (size_t)m * 1024 + lane * 16 + 8);
        float d[16]; float ss = 0.f;
#pragma unroll
        for (int i = 0; i < 4; ++i) { d[2 * i] = bflo(a0[i]) - lam * bflo(c0[i]); d[2 * i + 1] = bfhi(a0[i]) - lam * bfhi(c0[i]); d[8 + 2 * i] = bflo(a1[i]) - lam * bflo(c1[i]); d[8 + 2 * i + 1] = bfhi(a1[i]) - lam * bfhi(c1[i]); }
#pragma unroll
        for (int i = 0; i < 16; ++i) ss += d[i] * d[i];
        ss += __shfl_xor(ss, 1); ss += __shfl_xor(ss, 2); ss += __shfl_xor(ss, 4);
        const float rs = 0.8f / sqrtf(ss * (1.0f / 128.0f) + 1e-6f);
        u32x4 w0, w1;
        w0.x = pk2(d[0] * rs * sg[0], d[1] * rs * sg[1]); w0.y = pk2(d[2] * rs * sg[2], d[3] * rs * sg[3]); w0.z = pk2(d[4] * rs * sg[4], d[5] * rs * sg[5]); w0.w = pk2(d[6] * rs * sg[6], d[7] * rs * sg[7]);
        w1.x = pk2(d[8] * rs * sg[8], d[9] * rs * sg[9]); w1.y = pk2(d[10] * rs * sg[10], d[11] * rs * sg[11]); w1.z = pk2(d[12] * rs * sg[12], d[13] * rs * sg[13]); w1.w = pk2(d[14] * rs * sg[14], d[15] * rs * sg[15]);
        *(u32x4*)(O + (size_t)m * DM + lane * 16) = w0; *(u32x4*)(O + (size_t)m * DM + lane * 16 + 8) = w1;
    }
}

__device__ __forceinline__ void phase_router(const Params& p, unsigned char* lds) {
    const int tid = threadIdx.x, lane = tid & 63, wave = tid >> 6;
    float* hs = (float*)lds;
    float* Wsm = hs + 64 * 260;
    float* lg = Wsm + 36 * 256;
    const float* h = p.out; const float* gf = p.in[24]; const float* wg = p.in[25]; const float* we = p.in[27];
    const float* ss2 = (const float*)(p.ws + WS_CTL + CTL_SS2); float* rstd2 = (float*)(p.ws + WS_RSTD2);
    unsigned* cnt = (unsigned*)(p.ws + WS_CTL + CTL_CNT); int* rt = (int*)(p.ws + WS_RT); float* gateb = (float*)(p.ws + WS_GATEB); int* tokinfo = (int*)(p.ws + WS_TOKINFO);
    for (int tb = blockIdx.x; tb < T / 64; tb += gridDim.x) {
        const int tok0 = tb * 64;
        float acc[5];
#pragma unroll
        for (int i = 0; i < 5; ++i) acc[i] = 0.f;
        for (int k0 = 0; k0 < DM; k0 += 256) {
            __syncthreads();
            for (int ch = tid; ch < 64 * 64; ch += NTHREADS) { const int r = ch >> 6, c4 = ch & 63; *(f32x4*)(hs + r * 260 + c4 * 4) = *(const f32x4*)(h + (size_t)(tok0 + r) * DM + k0 + c4 * 4); }
            for (int id = tid; id < 36 * 256; id += NTHREADS) { const int k = id / 36, cc = id % 36; const float w = cc < 4 ? wg[(size_t)(k0 + k) * 4 + cc] : we[(size_t)(k0 + k) * 32 + cc - 4]; Wsm[cc * 256 + k] = w * gf[k0 + k]; }
            __syncthreads();
            for (int k = 0; k < 256; k += 4) { const f32x4 hv = *(const f32x4*)(hs + lane * 260 + k);
#pragma unroll
                for (int i = 0; i < 5; ++i) { const int cc = wave + 8 * i; if (cc < 36) { const f32x4 wv = *(const f32x4*)(Wsm + cc * 256 + k); acc[i] += hv[0] * wv[0] + hv[1] * wv[1] + hv[2] * wv[2] + hv[3] * wv[3]; } } }
        }
#pragma unroll
        for (int i = 0; i < 5; ++i) { const int cc = wave + 8 * i; if (cc < 36) lg[lane * 40 + cc] = acc[i]; }
        __syncthreads();
        if (tid < 64) {
            const int t = tok0 + tid; const float rs = 1.0f / sqrtf(ss2[t] * (1.0f / DM) + 1e-6f); rstd2[t] = rs;
            float g4[4]; int grp = 0; float gmax = -3.0e38f;
#pragma unroll
            for (int i = 0; i < 4; ++i) { g4[i] = lg[tid * 40 + i] * rs + p.in[26][i]; if (g4[i] > gmax) { gmax = g4[i]; grp = i; } }
            float gs = 0.f;
#pragma unroll
            for (int i = 0; i < 4; ++i) gs += __expf(g4[i] - gmax);
            const float pg = 1.0f / gs;
            float e8[8]; int i0 = 0; float m0 = -3.0e38f;
#pragma unroll
            for (int i = 0; i < 8; ++i) { e8[i] = lg[tid * 40 + 4 + grp * 8 + i] * rs + p.in[28][grp * 8 + i]; if (e8[i] > m0) { m0 = e8[i]; i0 = i; } }
            int i1 = 0; float m1 = -3.0e38f;
#pragma unroll
            for (int i = 0; i < 8; ++i) if (i != i0 && e8[i] > m1) { m1 = e8[i]; i1 = i; }
            const float p1 = __expf(m1 - m0); const float g0 = pg / (1.0f + p1), g1 = pg * p1 / (1.0f + p1);
            const int e0 = grp * 8 + i0, e1 = grp * 8 + i1;
            const unsigned r0 = atomicAdd(cnt + e0, 1u), r1 = atomicAdd(cnt + e1, 1u);
            rt[(size_t)e0 * CAP + r0] = t; rt[(size_t)e1 * CAP + r1] = t; gateb[(size_t)e0 * CAP + r0] = g0; gateb[(size_t)e1 * CAP + r1] = g1;
            int4 ti; ti.x = e0 * CAP + (int)r0; ti.y = e1 * CAP + (int)r1; ti.z = 0; ti.w = 0; *(int4*)(tokinfo + (size_t)t * 4) = ti;
        }
        __syncthreads();
    }
}

__device__ __forceinline__ void phase_final(const Params& p, unsigned char* lds) {
    const int tid = threadIdx.x, lane = tid & 63, wave = tid >> 6;
    const int gw = blockIdx.x * NWAVES + wave, NGW = gridDim.x * NWAVES;
    int* pst = (int*)lds;
    const unsigned* cnt = (const unsigned*)(p.ws + WS_CTL + CTL_CNT);
    if (tid == 0) { int ts = 0; for (int e = 0; e < NEXP; ++e) { pst[e] = ts; ts += ((int)cnt[e] + 255) >> 8; } }
    __syncthreads();
    const int* tokinfo = (const int*)(p.ws + WS_TOKINFO); const bf16_t* yb = (const bf16_t*)(p.ws + WS_YB); const float* gfin = p.in[32]; float* out = p.out;
    for (int m = gw; m < T; m += NGW) {
        const int4 ti = *(const int4*)(tokinfo + (size_t)m * 4);
        const int e0 = ti.x / CAP, r0 = ti.x % CAP, e1 = ti.y / CAP, r1 = ti.y % CAP;
        const size_t s0 = (size_t)pst[e0] * 256 + r0, s1 = (size_t)pst[e1] * 256 + r1;
        f32x4* hr = (f32x4*)(out + (size_t)m * DM) + lane; const u32x2* y0 = (const u32x2*)(yb + s0 * DM) + lane; const u32x2* y1 = (const u32x2*)(yb + s1 * DM) + lane;
        f32x4 v[8]; float s = 0.f;
#pragma unroll
        for (int j = 0; j < 8; ++j) { v[j] = hr[64 * j]; const u32x2 a = y0[64 * j], b2 = y1[64 * j];
            v[j][0] += bflo(a.x) + bflo(b2.x); v[j][1] += bfhi(a.x) + bfhi(b2.x); v[j][2] += bflo(a.y) + bflo(b2.y); v[j][3] += bfhi(a.y) + bfhi(b2.y);
            s += (v[j][0] * v[j][0] + v[j][1] * v[j][1]) + (v[j][2] * v[j][2] + v[j][3] * v[j][3]); }
        s = wave_sum(s); const float rs = 1.0f / sqrtf(s * (1.0f / DM) + 1e-6f);
#pragma unroll
        for (int j = 0; j < 8; ++j) { const f32x4 gv = *((const f32x4*)gfin + lane + 64 * j); hr[64 * j] = v[j] * rs * gv; }
    }
}

#if USE_REF_GEMM
#define GEMM_PHASE gemm_phase_ref
#endif

__global__ void __launch_bounds__(NTHREADS, 2) fwd_kernel(Params p) {
    extern __shared__ __attribute__((aligned(16))) unsigned char lds[];
    unsigned char* ws = p.ws;
    const int lo = p.ph_lo, hi = p.ph_hi;
#define IN(k) (lo <= (k) && (k) < hi)
#if N_LAUNCH_MODE == 1
    cg::grid_group grid = cg::this_grid();
#define SEAM(k) do { if (IN(k) && IN((k) + 1)) grid.sync(); } while (0)
#else
#define SEAM(k) do { } while (0)
#endif
    if (IN(PH_PRO)) { phase_prologue(p, lds); } SEAM(PH_PRO);
    if (IN(PH_INPROJ)) {
        Gemm g{(const bf16_t*)(ws + WS_XB), (const bf16_t*)(ws + WS_WIN), DM, DM, DM};
        DenseOrder S; S.init(T, NIN, gridDim.x, blockIdx.x, DM, DM);
        EpiIn E{(bf16_t*)(ws + WS_INBUF), (bf16_t*)(ws + WS_PBUF), (const float*)(ws + WS_RSTD1)};
        GEMM_PHASE<EpiIn, DenseOrder>(lds, g, S, E);
    } SEAM(PH_INPROJ);
    if (IN(PH_L2PREP)) { phase_l2prep(p); } SEAM(PH_L2PREP);
    if (IN(PH_L2GEMM)) {
        Gemm g{(const bf16_t*)(ws + WS_A2), (const bf16_t*)(ws + WS_L2T), PW, 256, 256};
        DenseOrder S; S.init(T, 3072, gridDim.x, blockIdx.x, PW, 256, 2, 256);
        EpiL2 E{(float*)(ws + WS_WL), (bf16_t*)(ws + WS_ABUF), (bf16_t*)(ws + WS_GBUF), p.in[11], p.in[14]};
        GEMM_PHASE<EpiL2, DenseOrder>(lds, g, S, E);
    } SEAM(PH_L2GEMM);
    if (IN(PH_MIX)) {
        for (int chain = blockIdx.x; chain < BATCH * NH_RW; chain += gridDim.x) rwkv_chain(p, lds, chain);
        for (int u = blockIdx.x; u < 1024; u += gridDim.x) { const int qb = 7 - (u >> 7), r = u & 127; attn_unit_ref(p, lds, r >> 4, (r >> 1) & 7, r & 1, qb); }
    } SEAM(PH_MIX);
    if (IN(PH_COMB)) { phase_combine(p); } SEAM(PH_COMB);
    if (IN(PH_OUT)) {
        Gemm g{(const bf16_t*)(ws + WS_O), (const bf16_t*)(ws + WS_WOUT), DM, DM, DM};
        DenseOrder S; S.init(T, DM, gridDim.x, blockIdx.x, DM, DM);
        EpiOut E{p.in[0], p.out, (bf16_t*)(ws + WS_HB), (float*)(ws + WS_CTL + CTL_SS2)};
        GEMM_PHASE<EpiOut, DenseOrder>(lds, g, S, E);
    } SEAM(PH_OUT);
    if (IN(PH_ROUTE)) { phase_router(p, lds); convert_experts(p, lds); } SEAM(PH_ROUTE);
    if (IN(PH_G1)) {
        Gemm g{(const bf16_t*)(ws + WS_HB), (const bf16_t*)(ws + WS_WGU), DM, DM, DM};
        MoeOrder S{(const unsigned*)(ws + WS_CTL + CTL_CNT), (const int*)(ws + WS_RT), 4, (int)gridDim.x, (int)blockIdx.x, 0, DM, (long)1024 * 2048, DM};
        EpiGU E{(bf16_t*)(ws + WS_HID), (const float*)(ws + WS_RSTD2)};
        GEMM_PHASE<EpiGU, MoeOrder>(lds, g, S, E);
    } SEAM(PH_G1);
    if (IN(PH_G2)) {
        Gemm g{(const bf16_t*)(ws + WS_HID), (const bf16_t*)(ws + WS_WD), DEXP, DEXP, DEXP};
        MoeOrder S{(const unsigned*)(ws + WS_CTL + CTL_CNT), (const int*)(ws + WS_RT), 8, (int)gridDim.x, (int)blockIdx.x, 1, DEXP, (long)2048 * 512, DEXP};
        EpiDown E{(bf16_t*)(ws + WS_YB), (const float*)(ws + WS_GATEB), (const unsigned*)(ws + WS_CTL + CTL_CNT)};
        GEMM_PHASE<EpiDown, MoeOrder>(lds, g, S, E);
    } SEAM(PH_G2);
    if (IN(PH_FINAL)) { phase_final(p, lds); }
}

extern "C" void kernel_launch(void* const* d_in, const int* in_sizes, int n_in, void* d_out, int out_size, void* d_ws, size_t ws_size, hipStream_t stream) {
    static int grid = 0;
    if (grid == 0) {
        if (n_in != 33 || out_size != T * DM || ws_size < WS_END) { fprintf(stderr, "kernel_launch: unexpected problem (n_in %d out %d ws %zu)\n", n_in, out_size, ws_size); grid = -1; return; }
        int dev = 0, cus = 0;
        hipGetDevice(&dev); hipDeviceGetAttribute(&cus, hipDeviceAttributeMultiprocessorCount, dev);
        if (hipFuncSetAttribute((const void*)fwd_kernel, hipFuncAttributeMaxDynamicSharedMemorySize, LDS_BYTES) != hipSuccess) { fprintf(stderr, "kernel_launch: hipFuncSetAttribute failed\n"); grid = -1; return; }
        int per_cu = 0; hipOccupancyMaxActiveBlocksPerMultiprocessor(&per_cu, (const void*)fwd_kernel, NTHREADS, LDS_BYTES); (void)hipGetLastError();
        if (per_cu < 1) fprintf(stderr, "kernel_launch: occupancy query says %d blocks per CU\n", per_cu);
        grid = cus > 0 ? cus : 256;
    }
    if (grid < 0) return;
    hipMemsetAsync((char*)d_ws + WS_CTL, 0, CTL_BYTES, stream);
    Params p{};
    for (int i = 0; i < 33; ++i) p.in[i] = (const float*)d_in[i];
    p.out = (float*)d_out; p.ws = (unsigned char*)d_ws;
#if N_LAUNCH_MODE == 1
    p.ph_lo = 0; p.ph_hi = PH_COUNT;
    void* args[] = {&p};
    hipError_t e = hipLaunchCooperativeKernel((const void*)fwd_kernel, dim3(grid), dim3(NTHREADS), args, LDS_BYTES, stream);
    if (e != hipSuccess) fprintf(stderr, "cooperative launch failed: %s (grid %d)\n", hipGetErrorString(e), grid);
#else
    for (int ph = 0; ph < PH_COUNT; ++ph) { p.ph_lo = ph; p.ph_hi = ph + 1; hipLaunchKernelGGL(fwd_kernel, dim3(grid), dim3(NTHREADS), LDS_BYTES, stream, p); }
#endif
}
```

```cpp
#include <hip/hip_runtime.h>
#include <hip/hip_cooperative_groups.h>
#include <cstdio>
#include <cstdint>
namespace cg = cooperative_groups;

#ifndef N_LAUNCH_MODE
#define N_LAUNCH_MODE 1
#endif
#ifndef USE_REF_GEMM
#define USE_REF_GEMM 1
#endif

constexpr int BATCH = 8, SEQ = 2048, DM = 2048, T = BATCH * SEQ;
constexpr int DAW = 1024, RWW = 1024, NH_DA = 8, NH_RW = 16;
constexpr int NIN = 6912;
constexpr int PW = 768;
constexpr int NEXP = 32, DEXP = 512, CAP = T;
constexpr int MAXTILES = 160;
constexpr float C2Q = 0.125f * 1.4426950408889634f;
constexpr float LOG2E = 1.4426950408889634f;

constexpr size_t MiB = 1u << 20;
constexpr size_t WS_CTL = 0, CTL_BYTES = 1 * MiB;
constexpr size_t CTL_SS2 = 65536;
constexpr size_t CTL_CNT = 131072;
constexpr size_t WS_WOUT = 1 * MiB;
constexpr size_t WS_L2T = 9 * MiB;
constexpr size_t WS_RSTD1 = 11 * MiB;
constexpr size_t WS_RSTD2 = 11 * MiB + 65536;
constexpr size_t WS_TOKINFO = 11 * MiB + 131072;
constexpr size_t WS_WIN = 12 * MiB;
constexpr size_t WS_XB = 40 * MiB;
constexpr size_t WS_O = 40 * MiB;
constexpr size_t WS_INBUF = 104 * MiB;
constexpr size_t WS_PBUF = 296 * MiB;
constexpr size_t WS_A2 = 320 * MiB;
constexpr size_t WS_WL = 344 * MiB;
constexpr size_t WS_ABUF = 408 * MiB;
constexpr size_t WS_GBUF = 440 * MiB;
constexpr size_t WS_OPART = 472 * MiB;
constexpr size_t WS_HB = 104 * MiB;
constexpr size_t WS_WGU = 168 * MiB;
constexpr size_t WS_WD = 296 * MiB;
constexpr size_t WS_RT = 360 * MiB;
constexpr size_t WS_GATEB = 362 * MiB;
constexpr size_t WS_HID = 364 * MiB;
constexpr size_t WS_YB = 404 * MiB;
constexpr size_t WS_END = 564 * MiB;

constexpr int NTHREADS = 512, NWAVES = 8;
constexpr int LDS_BYTES = 147456;

typedef unsigned short bf16_t;
typedef short bf16x8 __attribute__((ext_vector_type(8)));
typedef float f32x4 __attribute__((ext_vector_type(4)));
typedef float f32x2 __attribute__((ext_vector_type(2)));
typedef unsigned u32x4 __attribute__((ext_vector_type(4)));
typedef unsigned u32x2 __attribute__((ext_vector_type(2)));

__device__ __forceinline__ unsigned f2bf(float f) { unsigned u = __builtin_bit_cast(unsigned, f); return (u + 0x7fffu + ((u >> 16) & 1u)) >> 16; }
__device__ __forceinline__ unsigned pk2(float lo, float hi) { return f2bf(lo) | (f2bf(hi) << 16); }
__device__ __forceinline__ float bf2f(unsigned h) { return __builtin_bit_cast(float, h << 16); }
__device__ __forceinline__ float bflo(unsigned w) { return __builtin_bit_cast(float, w << 16); }
__device__ __forceinline__ float bfhi(unsigned w) { return __builtin_bit_cast(float, w & 0xffff0000u); }
__device__ __forceinline__ float wave_sum(float v) {
#pragma unroll
    for (int o = 1; o < 64; o <<= 1) v += __shfl_xor(v, o);
    return v;
}
__device__ __forceinline__ float sigmoidf_(float x) { return 1.0f / (1.0f + __expf(-x)); }

struct Params {
    const float* in[33];
    float* out;
    unsigned char* ws;
    int ph_lo, ph_hi;
};

enum { PH_PRO = 0, PH_INPROJ, PH_L2PREP, PH_L2GEMM, PH_MIX, PH_COMB, PH_OUT, PH_ROUTE, PH_G1, PH_G2, PH_FINAL, PH_COUNT };

struct Unit { int pm, pn; long a_off, b_off; const int* gidx; int valid, e, tile; };
struct Gemm { const bf16_t* A; const bf16_t* Bt; int lda, ldb, K; };

struct DenseOrder {
    int nM, nN, nwg, G, c, lda, ldb, acol_shift, acol_w;
    __device__ void init(int M, int N, int G_, int c_, int lda_, int ldb_, int acol_shift_ = -1, int acol_w_ = 0) {
        nM = M / 256; nN = N / 256; nwg = nM * nN; G = G_; c = c_; lda = lda_; ldb = ldb_; acol_shift = acol_shift_; acol_w = acol_w_; }
    __device__ bool next(int i, Unit& u) const {
        const long L = (long)i * G + c; if (L >= nwg) return false;
        int wgid = (int)L; { const int q = nwg / 8, r = nwg % 8, xcd = wgid % 8, off = wgid / 8; wgid = (xcd < r ? xcd * (q + 1) : r * (q + 1) + (xcd - r) * q) + off; }
        const int nig = 8 * nN, gid = wgid / nig, fm = gid * 8, gsz = (nM - fm) < 8 ? (nM - fm) : 8;
        u.pm = fm + ((wgid % nig) % gsz); u.pn = (wgid % nig) / gsz;
        u.a_off = (long)u.pm * 256 * lda + (acol_shift >= 0 ? (long)(u.pn >> acol_shift) * acol_w : 0);
        u.b_off = (long)u.pn * 256 * ldb; u.gidx = nullptr; u.valid = 256; u.e = 0; u.tile = 0; return true;
    }
};
struct MoeOrder {
    const unsigned* cnt; const int* rt; int ncol, G, c, mode; long a_ld, b_estride, b_ld;
    __device__ bool next(int i, Unit& u) const {
        const long L = (long)i * G + c; const int g = (int)(L / ncol), pn = (int)(L % ncol);
        int ts = 0, e = 0, k = -1, ce = 0;
        for (e = 0; e < NEXP; ++e) { ce = (int)cnt[e]; const int nt = (ce + 255) >> 8; if (g < ts + nt) { k = g - ts; break; } ts += nt; }
        if (k < 0) return false;
        u.pm = g; u.pn = pn; u.e = e; u.tile = g; u.valid = (ce - 256 * k) < 256 ? (ce - 256 * k) : 256;
        if (mode == 0) { u.gidx = rt + (long)e * CAP + 256 * k; u.a_off = 0; }
        else { u.gidx = nullptr; u.a_off = (long)g * 256 * a_ld; }
        u.b_off = (long)e * b_estride + (long)pn * 256 * b_ld; return true;
    }
};

template <class Epi, class Sched>
__device__ __forceinline__ void gemm_phase_ref(unsigned char* lds, const Gemm g, const Sched& S, const Epi& E) {
    const int tid = threadIdx.x, wid = tid >> 6, lane = tid & 63, wr = wid >> 2, wc = wid & 3, fr = lane & 15, fq = lane >> 4;
    bf16_t* As = (bf16_t*)lds; bf16_t* Bs = As + 256 * 72;
    Unit u;
    for (int ui = 0; S.next(ui, u); ++ui) {
        f32x4 acc[2][2][4][2];
#pragma unroll
        for (int a = 0; a < 2; ++a)
#pragma unroll
            for (int b = 0; b < 2; ++b)
#pragma unroll
                for (int m = 0; m < 4; ++m)
#pragma unroll
                    for (int n = 0; n < 2; ++n) acc[a][b][m][n] = (f32x4){0.f, 0.f, 0.f, 0.f};
        long arow[4];
#pragma unroll
        for (int i = 0; i < 4; ++i) { const int row = (tid + 512 * i) >> 3; arow[i] = u.gidx ? (row < u.valid ? (long)u.gidx[row] : 0L) : (long)row; }
        for (int k0 = 0; k0 < g.K; k0 += 64) {
            __syncthreads();
#pragma unroll
            for (int i = 0; i < 4; ++i) { const int ch = tid + 512 * i, row = ch >> 3, c8 = ch & 7;
                const u32x4 va = *(const u32x4*)(g.A + u.a_off + arow[i] * g.lda + k0 + c8 * 8);
                const u32x4 vb = *(const u32x4*)(g.Bt + u.b_off + (long)row * g.ldb + k0 + c8 * 8);
                *(u32x4*)(As + row * 72 + c8 * 8) = va; *(u32x4*)(Bs + row * 72 + c8 * 8) = vb; }
            __syncthreads();
            for (int kk = 0; kk < 64; ++kk) {
                float a[2][4];
#pragma unroll
                for (int ai = 0; ai < 2; ++ai)
#pragma unroll
                    for (int m = 0; m < 4; ++m) a[ai][m] = bf2f(As[(ai * 128 + wr * 64 + m * 16 + fr) * 72 + kk]);
#pragma unroll
                for (int bj = 0; bj < 2; ++bj)
#pragma unroll
                    for (int n = 0; n < 2; ++n)
#pragma unroll
                        for (int e = 0; e < 4; ++e) {
                            const int cl = Epi::PERM ? (bj * 128 + wc * 32 + 8 * fq + 4 * n + e) : (bj * 128 + wc * 32 + 16 * n + 4 * fq + e);
                            const float b = bf2f(Bs[cl * 72 + kk]);
#pragma unroll
                            for (int ai = 0; ai < 2; ++ai)
#pragma unroll
                                for (int m = 0; m < 4; ++m) acc[ai][bj][m][n][e] += a[ai][m] * b;
                        }
            }
        }
        E(acc, u, wr, wc, fr, fq);
    }
    __syncthreads();
}

__device__ __forceinline__ u32x4 pack8(const f32x4 v0, const f32x4 v1) { u32x4 w; w.x = pk2(v0[0], v0[1]); w.y = pk2(v0[2], v0[3]); w.z = pk2(v1[0], v1[1]); w.w = pk2(v1[2], v1[3]); return w; }

struct EpiIn {
    static constexpr bool PERM = true;
    bf16_t* inbuf; bf16_t* pbuf; const float* rstd1;
    __device__ __forceinline__ void operator()(const f32x4 (&acc)[2][2][4][2], const Unit& u, int wr, int wc, int fr, int fq) const {
        bf16_t* base; int ldc, colt; float sc0 = 1.f;
        if (u.pn < 24) { base = inbuf + (size_t)(u.pn >> 2) * T * 1024; ldc = 1024; colt = (u.pn & 3) * 256; if (u.pn < 4) sc0 = C2Q; }
        else { base = pbuf; ldc = PW; colt = (u.pn - 24) * 256; }
        const int row0 = u.pm * 256 + wr * 64 + fr, col0 = colt + wc * 32 + 8 * fq;
#pragma unroll
        for (int ai = 0; ai < 2; ++ai)
#pragma unroll
            for (int m = 0; m < 4; ++m) { const int row = row0 + ai * 128 + m * 16; const float rs = rstd1[row] * sc0; bf16_t* rowp = base + (size_t)row * ldc + col0;
#pragma unroll
                for (int bj = 0; bj < 2; ++bj) *(u32x4*)(rowp + bj * 128) = pack8(acc[ai][bj][m][0] * rs, acc[ai][bj][m][1] * rs); }
    }
};
struct EpiL2 {
    static constexpr bool PERM = true;
    float* wl; bf16_t* abuf; bf16_t* gbuf; const float* w0; const float* a0;
    __device__ __forceinline__ void operator()(const f32x4 (&acc)[2][2][4][2], const Unit& u, int wr, int wc, int fr, int fq) const {
        const int grp = u.pn >> 2, colt = (u.pn & 3) * 256;
        const int row0 = u.pm * 256 + wr * 64 + fr, col0 = colt + wc * 32 + 8 * fq;
#pragma unroll
        for (int bj = 0; bj < 2; ++bj) {
            const int c = col0 + bj * 128;
            f32x4 b0 = (f32x4){0.f, 0.f, 0.f, 0.f}, b1 = b0;
            if (grp == 0) { b0 = *(const f32x4*)(w0 + c); b1 = *(const f32x4*)(w0 + c + 4); }
            else if (grp == 1) { b0 = *(const f32x4*)(a0 + c); b1 = *(const f32x4*)(a0 + c + 4); }
#pragma unroll
            for (int ai = 0; ai < 2; ++ai)
#pragma unroll
                for (int m = 0; m < 4; ++m) { const int row = row0 + ai * 128 + m * 16; f32x4 v0 = acc[ai][bj][m][0] + b0, v1 = acc[ai][bj][m][1] + b1;
                    if (grp == 0) {
#pragma unroll
                        for (int e = 0; e < 4; ++e) { v0[e] = -0.60653065971f * LOG2E * sigmoidf_(v0[e]); v1[e] = -0.60653065971f * LOG2E * sigmoidf_(v1[e]); }
                        float* p = wl + (size_t)row * 1024 + c; *(f32x4*)p = v0; *(f32x4*)(p + 4) = v1;
                    } else if (grp == 1) {
#pragma unroll
                        for (int e = 0; e < 4; ++e) { v0[e] = sigmoidf_(v0[e]); v1[e] = sigmoidf_(v1[e]); }
                        *(u32x4*)(abuf + (size_t)row * 1024 + c) = pack8(v0, v1);
                    } else { *(u32x4*)(gbuf + (size_t)row * 1024 + c) = pack8(v0, v1); }
                }
        }
    }
};
struct EpiOut {
    static constexpr bool PERM = true;
    const float* x; float* h; bf16_t* hb; float* ss2;
    __device__ __forceinline__ void operator()(const f32x4 (&acc)[2][2][4][2], const Unit& u, int wr, int wc, int fr, int fq) const {
        const int row0 = u.pm * 256 + wr * 64 + fr, col0 = u.pn * 256 + wc * 32 + 8 * fq;
#pragma unroll
        for (int ai = 0; ai < 2; ++ai)
#pragma unroll
            for (int m = 0; m < 4; ++m) { const int row = row0 + ai * 128 + m * 16; float ss = 0.f;
#pragma unroll
                for (int bj = 0; bj < 2; ++bj) { const size_t off = (size_t)row * DM + col0 + bj * 128;
                    const f32x4 x0 = *(const f32x4*)(x + off), x1 = *(const f32x4*)(x + off + 4);
                    const f32x4 v0 = acc[ai][bj][m][0] + x0, v1 = acc[ai][bj][m][1] + x1;
                    *(f32x4*)(h + off) = v0; *(f32x4*)(h + off + 4) = v1; *(u32x4*)(hb + off) = pack8(v0, v1);
                    ss += (v0[0] * v0[0] + v0[1] * v0[1]) + (v0[2] * v0[2] + v0[3] * v0[3]) + (v1[0] * v1[0] + v1[1] * v1[1]) + (v1[2] * v1[2] + v1[3] * v1[3]); }
                ss += __shfl_xor(ss, 16); ss += __shfl_xor(ss, 32);
                if (fq == 0) atomicAdd(ss2 + row, ss); }
    }
};
struct EpiGU {
    static constexpr bool PERM = true;
    bf16_t* hid; const float* rstd2;
    __device__ __forceinline__ void operator()(const f32x4 (&acc)[2][2][4][2], const Unit& u, int wr, int wc, int fr, int fq) const {
        const int col0 = u.pn * 128 + wc * 32 + 8 * fq;
#pragma unroll
        for (int ai = 0; ai < 2; ++ai)
#pragma unroll
            for (int m = 0; m < 4; ++m) { const int rl = ai * 128 + wr * 64 + m * 16 + fr; const int tok = (rl < u.valid) ? u.gidx[rl] : 0; const float rs = rstd2[tok];
                f32x4 o0, o1;
#pragma unroll
                for (int e = 0; e < 4; ++e) { const float g0 = acc[ai][0][m][0][e] * rs, u0 = acc[ai][1][m][0][e] * rs, g1 = acc[ai][0][m][1][e] * rs, u1 = acc[ai][1][m][1][e] * rs;
                    o0[e] = g0 * sigmoidf_(g0) * u0; o1[e] = g1 * sigmoidf_(g1) * u1; }
                *(u32x4*)(hid + ((size_t)u.tile * 256 + rl) * DEXP + col0) = pack8(o0, o1); }
    }
};
struct EpiDown {
    static constexpr bool PERM = true;
    bf16_t* yb; const float* gateb; const unsigned* cnt;
    __device__ __forceinline__ void operator()(const f32x4 (&acc)[2][2][4][2], const Unit& u, int wr, int wc, int fr, int fq) const {
        const int col0 = u.pn * 256 + wc * 32 + 8 * fq;
        int ts = 0; for (int e = 0; e < u.e; ++e) ts += ((int)cnt[e] + 255) >> 8;
        const int k = u.tile - ts;
#pragma unroll
        for (int ai = 0; ai < 2; ++ai)
#pragma unroll
            for (int m = 0; m < 4; ++m) { const int rl = ai * 128 + wr * 64 + m * 16 + fr; const float gt = (rl < u.valid) ? gateb[(size_t)u.e * CAP + 256 * k + rl] : 0.f;
#pragma unroll
                for (int bj = 0; bj < 2; ++bj) *(u32x4*)(yb + ((size_t)u.tile * 256 + rl) * DM + col0 + bj * 128) = pack8(acc[ai][bj][m][0] * gt, acc[ai][bj][m][1] * gt); }
    }
};

__device__ __forceinline__ void tr_item(const float* W, int ldw, int Kvalid, int k0, int n0, bf16_t* WT, int ldt, int trow0, float* scr, int lane,
                                        const float* gk, const float* mu, int mode) {
#pragma unroll 8
    for (int i = 0; i < 32; ++i) { const int kk = 2 * i + (lane >> 5), k = k0 + kk; float v = 0.f;
        if (k < Kvalid) { v = W[(size_t)k * ldw + n0 + (lane & 31)]; float s = gk ? gk[k] : 1.f; if (mode == 1) s *= (1.f - mu[k]); else if (mode == 2) s *= mu[k]; v *= s; }
        scr[kk * 33 + (lane & 31)] = v; }
    __builtin_amdgcn_s_waitcnt(0xC07F); asm volatile("" ::: "memory");
    const int c = lane & 7;
#pragma unroll
    for (int j = 0; j < 4; ++j) { const int n = (lane >> 3) + 8 * j; const float* s = scr + (8 * c) * 33 + n;
        u32x4 o; o.x = pk2(s[0 * 33], s[1 * 33]); o.y = pk2(s[2 * 33], s[3 * 33]); o.z = pk2(s[4 * 33], s[5 * 33]); o.w = pk2(s[6 * 33], s[7 * 33]);
        *(u32x4*)(WT + (size_t)(trow0 + n) * ldt + k0 + 8 * c) = o; }
    __builtin_amdgcn_s_waitcnt(0xC07F); asm volatile("" ::: "memory");
}

__device__ __forceinline__ void phase_prologue(const Params& p, unsigned char* lds) {
    const int tid = threadIdx.x, lane = tid & 63, wave = tid >> 6;
    const int gw = blockIdx.x * NWAVES + wave, NGW = gridDim.x * NWAVES;
    unsigned char* ws = p.ws;
    float* scr = (float*)(lds + wave * 16384);
    bf16_t* WinT = (bf16_t*)(ws + WS_WIN); bf16_t* WoutT = (bf16_t*)(ws + WS_WOUT); bf16_t* L2T = (bf16_t*)(ws + WS_L2T);
    const float* g_mix = p.in[1]; const float* mu_x = p.in[9];
    constexpr int I_WIN = 32 * 192;
    constexpr int I_L1 = 32 * 2 * 2 + 32 * 2 * 2 + 32 * 5 * 2;
    constexpr int I_WOUT = 32 * 64;
    constexpr int I_L2 = 3 * 4 * 32;
    constexpr int NITEMS = I_WIN + I_L1 + I_WOUT + I_L2;
    for (int it = gw; it < NITEMS; it += NGW) {
        int r = it;
        if (r < I_WIN) { const int kb = r / 192, nb = r % 192; tr_item(p.in[2], 6144, 2048, 64 * kb, 32 * nb, WinT, 2048, 32 * nb, scr, lane, g_mix, nullptr, 0); continue; } r -= I_WIN;
        if (r < I_L1) {
            int which, nb, mode, kb;
            if (r < 128) { which = 0; } else if (r < 256) { which = 1; r -= 128; } else { which = 2; r -= 256; }
            const int nnb = (which == 2) ? 5 : 2;
            kb = r / (nnb * 2); const int rr = r % (nnb * 2); nb = rr / 2; mode = 1 + (rr & 1);
            const float* W = which == 0 ? p.in[12] : which == 1 ? p.in[15] : p.in[17];
            const int ldw = which == 2 ? 160 : 64;
            const int rowbase = 6144 + (which == 0 ? 0 : which == 1 ? 128 : 256) + (mode == 2 ? ldw : 0);
            tr_item(W, ldw, 2048, 64 * kb, 32 * nb, WinT, 2048, rowbase + 32 * nb, scr, lane, g_mix, mu_x + which * 2048, mode); continue; } r -= I_L1;
        if (r < I_WOUT) { const int kb = r / 64, nb = r % 64; tr_item(p.in[3], 2048, 2048, 64 * kb, 32 * nb, WoutT, 2048, 32 * nb, scr, lane, nullptr, nullptr, 0); continue; } r -= I_WOUT;
        { const int which = r / 128, rr = r % 128, kb = rr / 32, nb = rr % 32;
          const float* W = which == 0 ? p.in[13] : which == 1 ? p.in[16] : p.in[18]; const int kv = which == 2 ? 160 : 64;
          tr_item(W, 1024, kv, 64 * kb, 32 * nb, L2T, 256, which * 1024 + 32 * nb, scr, lane, nullptr, nullptr, 0); }
    }
    for (int ch = blockIdx.x * NTHREADS + tid; ch < 192 * 256; ch += gridDim.x * NTHREADS) *(u32x4*)(WinT + (size_t)6720 * 2048 + (size_t)ch * 8) = (u32x4){0u, 0u, 0u, 0u};
    const float* x = p.in[0]; bf16_t* xb = (bf16_t*)(ws + WS_XB); float* rstd1 = (float*)(ws + WS_RSTD1);
    for (int m = gw; m < T; m += NGW) {
        const f32x4* xr = (const f32x4*)(x + (size_t)m * DM) + lane; f32x4 v[8]; float s = 0.f;
#pragma unroll
        for (int j = 0; j < 8; ++j) { v[j] = xr[64 * j]; s += (v[j][0] * v[j][0] + v[j][1] * v[j][1]) + (v[j][2] * v[j][2] + v[j][3] * v[j][3]); }
        s = wave_sum(s);
        u32x2* o = (u32x2*)(xb + (size_t)m * DM) + lane;
#pragma unroll
        for (int j = 0; j < 8; ++j) { u32x2 w; w.x = pk2(v[j][0], v[j][1]); w.y = pk2(v[j][2], v[j][3]); o[64 * j] = w; }
        if (lane == 0) rstd1[m] = 1.0f / sqrtf(s * (1.0f / DM) + 1e-6f);
    }
}

__device__ __forceinline__ void convert_experts(const Params& p, unsigned char* lds) {
    const int tid = threadIdx.x, lane = tid & 63, wave = tid >> 6;
    const int gw = blockIdx.x * NWAVES + wave, NGW = gridDim.x * NWAVES;
    float* scr = (float*)(lds + 65536 + wave * 8704);
    bf16_t* Wgu = (bf16_t*)(p.ws + WS_WGU); bf16_t* Wd = (bf16_t*)(p.ws + WS_WD); const float* gf = p.in[24];
    constexpr int I_G = 32 * 32 * 16;
    constexpr int I_D = 32 * 8 * 64;
    for (int it = gw; it < 2 * I_G + I_D; it += NGW) {
        int r = it;
        if (r < 2 * I_G) { const int up = r >= I_G; if (up) r -= I_G; const int e = r / 512, rr = r % 512, kb = rr / 16, nb = rr % 16; const int n0 = 32 * nb;
            tr_item((up ? p.in[30] : p.in[29]) + (size_t)e * 2048 * 512, 512, 2048, 64 * kb, n0, Wgu + (size_t)e * 1024 * 2048, 2048, 256 * (n0 >> 7) + (n0 & 127) + (up ? 128 : 0), scr, lane, gf, nullptr, 0); continue; }
        r -= 2 * I_G;
        { const int e = r / 512, rr = r % 512, kb = rr / 64, nb = rr % 64;
          tr_item(p.in[31] + (size_t)e * 512 * 2048, 2048, 512, 64 * kb, 32 * nb, Wd + (size_t)e * 2048 * 512, 512, 32 * nb, scr, lane, nullptr, nullptr, 0); }
    }
}

__device__ __forceinline__ void phase_l2prep(const Params& p) {
    const bf16_t* P = (const bf16_t*)(p.ws + WS_PBUF); bf16_t* A2 = (bf16_t*)(p.ws + WS_A2);
    const int nchunk = T * 96;
    for (int id = blockIdx.x * NTHREADS + threadIdx.x; id < nchunk; id += gridDim.x * NTHREADS) {
        const int t = id / 96, ch = id % 96, gi = ch >> 5, jc = (ch & 31) * 8;
        const int width = gi == 2 ? 160 : 64, pa = gi == 0 ? 0 : gi == 1 ? 128 : 256, pb = pa + width;
        u32x4 o = (u32x4){0u, 0u, 0u, 0u};
        if (jc < width) {
            const u32x4 va = *(const u32x4*)(P + (size_t)t * PW + pa + jc);
            u32x4 vb = (u32x4){0u, 0u, 0u, 0u};
            if ((t & (SEQ - 1)) != 0) vb = *(const u32x4*)(P + (size_t)(t - 1) * PW + pb + jc);
            float f[8];
#pragma unroll
            for (int i = 0; i < 4; ++i) { f[2 * i] = bflo(va[i]) + bflo(vb[i]); f[2 * i + 1] = bfhi(va[i]) + bfhi(vb[i]); }
#pragma unroll
            for (int i = 0; i < 8; ++i) { if (gi == 0) f[i] = 1.0f - 2.0f / (__expf(2.0f * f[i]) + 1.0f); else if (gi == 2) f[i] = sigmoidf_(f[i]); }
            o.x = pk2(f[0], f[1]); o.y = pk2(f[2], f[3]); o.z = pk2(f[4], f[5]); o.w = pk2(f[6], f[7]);
        }
        *(u32x4*)(A2 + (size_t)t * PW + ch * 8) = o;
    }
}

constexpr int TC = 32;
__device__ __forceinline__ void rwkv_chain(const Params& p, unsigned char* lds, int chain) {
    const int tid = threadIdx.x, lane = tid & 63, wave = tid >> 6;
    const int b = chain >> 4, h = chain & 15, c = h * 64 + lane;
    float* Rs = (float*)lds; float* Ws = Rs + TC * 64; float* Ks = Ws + TC * 64; float* Vs = Ks + TC * 64; float* KKs = Vs + TC * 64; float* Bs = KKs + TC * 64;
    float* Ys = Bs + TC * 64; float* Gs = Ys + TC * 64; float* BON = Gs + TC * 64;
    const bf16_t* rb = (const bf16_t*)(p.ws + WS_INBUF) + (size_t)3 * T * 1024; const bf16_t* kb = rb + (size_t)T * 1024; const bf16_t* vb = kb + (size_t)T * 1024;
    const float* wl = (const float*)(p.ws + WS_WL); const bf16_t* ab = (const bf16_t*)(p.ws + WS_ABUF); const bf16_t* gb = (const bf16_t*)(p.ws + WS_GBUF);
    bf16_t* O = (bf16_t*)(p.ws + WS_O);
    const float mu_r = p.in[10][c], mu_k = p.in[10][1024 + c], mu_v = p.in[10][2048 + c];
    const float k_k = p.in[19][c], k_a = p.in[20][c], r_k = p.in[21][c], ln_w = p.in[22][c], ln_b = p.in[23][c];
    const int r8 = lane >> 3, q = lane & 7, irow = 8 * wave + r8;
    float S[8];
#pragma unroll
    for (int e = 0; e < 8; ++e) S[e] = 0.f;
    for (int t0 = 0; t0 < SEQ; t0 += TC) {
#pragma unroll
        for (int s = 0; s < TC / NWAVES; ++s) {
            const int tl = wave * (TC / NWAVES) + s, t = t0 + tl; const size_t m = (size_t)b * SEQ + t, off = m * 1024 + c;
            const float rc = bf2f(rb[off]), kc = bf2f(kb[off]), vc = bf2f(vb[off]);
            float rp = 0.f, kp = 0.f, vp = 0.f;
            if (t > 0) { rp = bf2f(rb[off - 1024]); kp = bf2f(kb[off - 1024]); vp = bf2f(vb[off - 1024]); }
            const float rr = rc + (rp - rc) * mu_r, kx = kc + (kp - kc) * mu_k, vv = vc + (vp - vc) * mu_v;
            const float w = __builtin_amdgcn_exp2f(wl[off]), a = bf2f(ab[off]);
            const float kkv = kx * k_k; const float n2 = wave_sum(kkv * kkv); const float kkn = kkv / fmaxf(sqrtf(n2), 1e-12f);
            const float kmod = kx * (1.0f + (a - 1.0f) * k_a);
            const float bon = wave_sum(rr * kmod * r_k);
            Rs[tl * 64 + lane] = rr; Ws[tl * 64 + lane] = w; Ks[tl * 64 + lane] = kmod; Vs[tl * 64 + lane] = vv; KKs[tl * 64 + lane] = -kkn; Bs[tl * 64 + lane] = kkn * a;
            Gs[tl * 64 + lane] = bf2f(gb[off]); if (lane == 0) BON[tl] = bon;
        }
        __syncthreads();
        for (int tl = 0; tl < TC; ++tl) {
            const f32x4 kk0 = *(const f32x4*)(KKs + tl * 64 + 8 * q), kk1 = *(const f32x4*)(KKs + tl * 64 + 8 * q + 4);
            const f32x4 w0 = *(const f32x4*)(Ws + tl * 64 + 8 * q), w1 = *(const f32x4*)(Ws + tl * 64 + 8 * q + 4);
            const f32x4 b0 = *(const f32x4*)(Bs + tl * 64 + 8 * q), b1 = *(const f32x4*)(Bs + tl * 64 + 8 * q + 4);
            const f32x4 k0 = *(const f32x4*)(Ks + tl * 64 + 8 * q), k1 = *(const f32x4*)(Ks + tl * 64 + 8 * q + 4);
            const f32x4 r0 = *(const f32x4*)(Rs + tl * 64 + 8 * q), r1 = *(const f32x4*)(Rs + tl * 64 + 8 * q + 4);
            const float v = Vs[tl * 64 + irow];
            float sa = (S[0] * kk0[0] + S[1] * kk0[1]) + (S[2] * kk0[2] + S[3] * kk0[3]) + (S[4] * kk1[0] + S[5] * kk1[1]) + (S[6] * kk1[2] + S[7] * kk1[3]);
            sa += __shfl_xor(sa, 1); sa += __shfl_xor(sa, 2); sa += __shfl_xor(sa, 4);
#pragma unroll
            for (int e = 0; e < 4; ++e) { S[e] = S[e] * w0[e] + (sa * b0[e] + v * k0[e]); S[4 + e] = S[4 + e] * w1[e] + (sa * b1[e] + v * k1[e]); }
            float y = (S[0] * r0[0] + S[1] * r0[1]) + (S[2] * r0[2] + S[3] * r0[3]) + (S[4] * r1[0] + S[5] * r1[1]) + (S[6] * r1[2] + S[7] * r1[3]);
            y += __shfl_xor(y, 1); y += __shfl_xor(y, 2); y += __shfl_xor(y, 4);
            if (q == 0) Ys[tl * 64 + irow] = y;
        }
        __syncthreads();
#pragma unroll
        for (int s = 0; s < TC / NWAVES; ++s) {
            const int tl = wave * (TC / NWAVES) + s, t = t0 + tl; const size_t m = (size_t)b * SEQ + t;
            const float y = Ys[tl * 64 + lane]; const float mean = wave_sum(y) * (1.0f / 64.0f); const float d = y - mean; const float var = wave_sum(d * d) * (1.0f / 64.0f);
            float yn = d * (1.0f / sqrtf(var + 64e-5f)) * ln_w + ln_b;
            yn += BON[tl] * Vs[tl * 64 + lane];
            O[m * DM + 1024 + c] = (bf16_t)f2bf(yn * Gs[tl * 64 + lane]);
        }
        __syncthreads();
    }
}

__device__ __forceinline__ void attn_unit_ref(const Params& p, unsigned char* lds, int b, int h, int comp, int qb) {
    const int tid = threadIdx.x, row = tid & 255, dh = tid >> 8;
    float* Kt = (float*)lds; float* Vt = Kt + 64 * 64;
    const bf16_t* qbuf = (const bf16_t*)(p.ws + WS_INBUF); const bf16_t* kbuf = qbuf + (size_t)T * 1024; const bf16_t* vbuf = kbuf + (size_t)T * 1024;
    bf16_t* Op = (bf16_t*)(p.ws + WS_OPART) + (size_t)comp * T * 1024;
    const size_t rowbase = (size_t)b * SEQ; const int qpos = qb * 256 + row;
    float qv[64], o[64];
    { const bf16_t* qp = qbuf + (rowbase + qpos) * 1024 + h * 128 + comp * 64;
#pragma unroll
      for (int d = 0; d < 64; d += 8) { const u32x4 w = *(const u32x4*)(qp + d);
#pragma unroll
          for (int i = 0; i < 4; ++i) { qv[d + 2 * i] = bflo(w[i]); qv[d + 2 * i + 1] = bfhi(w[i]); } } }
#pragma unroll
    for (int d = 0; d < 64; ++d) o[d] = 0.f;
    float mrun = -1e30f, l = 0.f;
    const float slope2 = exp2f(-(float)(h + 1)) * LOG2E;
    const int ntile = (qb + 1) * 4;
    for (int kt = 0; kt < ntile; ++kt) {
        __syncthreads();
        for (int ch = tid; ch < 1536; ch += NTHREADS) { const int r = ch / 24, cc = ch % 24; const size_t grow = rowbase + kt * 64 + r;
            if (cc < 8) { const u32x4 w = *(const u32x4*)(kbuf + grow * 1024 + h * 128 + comp * 64 + cc * 8);
#pragma unroll
                for (int i = 0; i < 4; ++i) { Kt[r * 64 + cc * 8 + 2 * i] = bflo(w[i]); Kt[r * 64 + cc * 8 + 2 * i + 1] = bfhi(w[i]); } }
            else { const int c2 = cc - 8; const u32x4 w = *(const u32x4*)(vbuf + grow * 1024 + h * 128 + c2 * 8);
#pragma unroll
                for (int i = 0; i < 4; ++i) { Vt[r * 128 + c2 * 8 + 2 * i] = bflo(w[i]); Vt[r * 128 + c2 * 8 + 2 * i + 1] = bfhi(w[i]); } } }
        __syncthreads();
        for (int j = 0; j < 64; ++j) {
            const int kpos = kt * 64 + j; if (kpos > qpos) break;
            float s = 0.f;
#pragma unroll
            for (int d = 0; d < 64; d += 4) { const f32x4 kv = *(const f32x4*)(Kt + j * 64 + d); s += qv[d] * kv[0] + qv[d + 1] * kv[1] + qv[d + 2] * kv[2] + qv[d + 3] * kv[3]; }
            s += slope2 * (float)kpos;
            if (s > mrun) { const float f = exp2f(mrun - s); l *= f;
#pragma unroll
                for (int d = 0; d < 64; ++d) o[d] *= f;
                mrun = s; }
            const float pr = exp2f(s - mrun); l += pr;
#pragma unroll
            for (int d = 0; d < 64; d += 4) { const f32x4 vv = *(const f32x4*)(Vt + j * 128 + dh * 64 + d); o[d] += pr * vv[0]; o[d + 1] += pr * vv[1]; o[d + 2] += pr * vv[2]; o[d + 3] += pr * vv[3]; }
        }
    }
    const float il = 1.0f / l;
    bf16_t* op = Op + (rowbase + qpos) * 1024 + h * 128 + dh * 64;
#pragma unroll
    for (int d = 0; d < 64; d += 8) { u32x4 w; w.x = pk2(o[d] * il, o[d + 1] * il); w.y = pk2(o[d + 2] * il, o[d + 3] * il); w.z = pk2(o[d + 4] * il, o[d + 5] * il); w.w = pk2(o[d + 6] * il, o[d + 7] * il); *(u32x4*)(op + d) = w; }
    __syncthreads();
}

__device__ __forceinline__ void phase_combine(const Params& p) {
    const int tid = threadIdx.x, lane = tid & 63, wave = tid >> 6;
    const int gw = blockIdx.x * NWAVES + wave, NGW = gridDim.x * NWAVES;
    const float s1 = wave_sum(p.in[4][lane] * p.in[5][lane]), s2 = wave_sum(p.in[6][lane] * p.in[7][lane]);
    const float lam = __expf(s1) - __expf(s2) + 0.2f;
    const bf16_t* O0 = (const bf16_t*)(p.ws + WS_OPART); const bf16_t* O1 = O0 + (size_t)T * 1024; bf16_t* O = (bf16_t*)(p.ws + WS_O);
    const float* sg = p.in[8] + (lane & 7) * 16;
    for (int m = gw; m < T; m += NGW) {
        const u32x4 a0 = *(const u32x4*)(O0 + (size_t)m * 1024 + lane * 16), a1 = *(const u32x4*)(O0 + (size_t)m * 1024 + lane * 16 + 8);
        const u32x4 c0 = *(const u32x4*)(O1 + (size_t)m * 1024 + lane * 16), c1 = *(const u32x4*)(O1 + (size_t)m * 1024 + lane * 16 + 8);
        float d[16]; float ss = 0.f;
#pragma unroll
        for (int i = 0; i < 4; ++i) { d[2 * i] = bflo(a0[i]) - lam * bflo(c0[i]); d[2 * i + 1] = bfhi(a0[i]) - lam * bfhi(c0[i]); d[8 + 2 * i] = bflo(a1[i]) - lam * bflo(c1[i]); d[8 + 2 * i + 1] = bfhi(a1[i]) - lam * bfhi(c1[i]); }
#pragma unroll
        for (int i = 0; i < 16; ++i) ss += d[i] * d[i];
        ss += __shfl_xor(ss, 1); ss += __shfl_xor(ss, 2); ss += __shfl_xor(ss, 4);
        const float rs = 0.8f / sqrtf(ss * (1.0f / 128.0f) + 1e-6f);
        u32x4 w0, w1;
        w0.x = pk2(d[0] * rs * sg[0], d[1] * rs * sg[1]); w0.y = pk2(d[2] * rs * sg[2], d[3] * rs * sg[3]); w0.z = pk2(d[4] * rs * sg[4], d[5] * rs * sg[5]); w0.w = pk2(d[6] * rs * sg[6], d[7] * rs * sg[7]);
        w1.x = pk2(d[8] * rs * sg[8], d[9] * rs * sg[9]); w1.y = pk2(d[10] * rs * sg[10], d[11] * rs * sg[11]); w1.z = pk2(d[12] * rs * sg[12], d[13] * rs * sg[13]); w1.w = pk2(d[14] * rs * sg[14], d[15] * rs * sg[15]);
        *(u32x4*)(O + (size_t)m * DM + lane * 16) = w0; *(u32x4*)(O + (size_t)m * DM + lane * 16 + 8) = w1;
    }
}

__device__ __forceinline__ void phase_router(const Params& p, unsigned char* lds) {
    const int tid = threadIdx.x, lane = tid & 63, wave = tid >> 6;
    float* hs = (float*)lds;
    float* Wsm = hs + 64 * 260;
    float* lg = Wsm + 36 * 256;
    const float* h = p.out; const float* gf = p.in[24]; const float* wg = p.in[25]; const float* we = p.in[27];
    const float* ss2 = (const float*)(p.ws + WS_CTL + CTL_SS2); float* rstd2 = (float*)(p.ws + WS_RSTD2);
    unsigned* cnt = (unsigned*)(p.ws + WS_CTL + CTL_CNT); int* rt = (int*)(p.ws + WS_RT); float* gateb = (float*)(p.ws + WS_GATEB); int* tokinfo = (int*)(p.ws + WS_TOKINFO);
    for (int tb = blockIdx.x; tb < T / 64; tb += gridDim.x) {
        const int tok0 = tb * 64;
        float acc[5];
#pragma unroll
        for (int i = 0; i < 5; ++i) acc[i] = 0.f;
        for (int k0 = 0; k0 < DM; k0 += 256) {
            __syncthreads();
            for (int ch = tid; ch < 64 * 64; ch += NTHREADS) { const int r = ch >> 6, c4 = ch & 63; *(f32x4*)(hs + r * 260 + c4 * 4) = *(const f32x4*)(h + (size_t)(tok0 + r) * DM + k0 + c4 * 4); }
            for (int id = tid; id < 36 * 256; id += NTHREADS) { const int k = id / 36, cc = id % 36; const float w = cc < 4 ? wg[(size_t)(k0 + k) * 4 + cc] : we[(size_t)(k0 + k) * 32 + cc - 4]; Wsm[cc * 256 + k] = w * gf[k0 + k]; }
            __syncthreads();
            for (int k = 0; k < 256; k += 4) { const f32x4 hv = *(const f32x4*)(hs + lane * 260 + k);
#pragma unroll
                for (int i = 0; i < 5; ++i) { const int cc = wave + 8 * i; if (cc < 36) { const f32x4 wv = *(const f32x4*)(Wsm + cc * 256 + k); acc[i] += hv[0] * wv[0] + hv[1] * wv[1] + hv[2] * wv[2] + hv[3] * wv[3]; } } }
        }
#pragma unroll
        for (int i = 0; i < 5; ++i) { const int cc = wave + 8 * i; if (cc < 36) lg[lane * 40 + cc] = acc[i]; }
        __syncthreads();
        if (tid < 64) {
            const int t = tok0 + tid; const float rs = 1.0f / sqrtf(ss2[t] * (1.0f / DM) + 1e-6f); rstd2[t] = rs;
            float g4[4]; int grp = 0; float gmax = -3.0e38f;
#pragma unroll
            for (int i = 0; i < 4; ++i) { g4[i] = lg[tid * 40 + i] * rs + p.in[26][i]; if (g4[i] > gmax) { gmax = g4[i]; grp = i; } }
            float gs = 0.f;
#pragma unroll
            for (int i = 0; i < 4; ++i) gs += __expf(g4[i] - gmax);
            const float pg = 1.0f / gs;
            float e8[8]; int i0 = 0; float m0 = -3.0e38f;
#pragma unroll
            for (int i = 0; i < 8; ++i) { e8[i] = lg[tid * 40 + 4 + grp * 8 + i] * rs + p.in[28][grp * 8 + i]; if (e8[i] > m0) { m0 = e8[i]; i0 = i; } }
            int i1 = 0; float m1 = -3.0e38f;
#pragma unroll
            for (int i = 0; i < 8; ++i) if (i != i0 && e8[i] > m1) { m1 = e8[i]; i1 = i; }
            const float p1 = __expf(m1 - m0); const float g0 = pg / (1.0f + p1), g1 = pg * p1 / (1.0f + p1);
            const int e0 = grp * 8 + i0, e1 = grp * 8 + i1;
            const unsigned r0 = atomicAdd(cnt + e0, 1u), r1 = atomicAdd(cnt + e1, 1u);
            rt[(size_t)e0 * CAP + r0] = t; rt[(size_t)e1 * CAP + r1] = t; gateb[(size_t)e0 * CAP + r0] = g0; gateb[(size_t)e1 * CAP + r1] = g1;
            int4 ti; ti.x = e0 * CAP + (int)r0; ti.y = e1 * CAP + (int)r1; ti.z = 0; ti.w = 0; *(int4*)(tokinfo + (size_t)t * 4) = ti;
        }
        __syncthreads();
    }
}

__device__ __forceinline__ void phase_final(const Params& p, unsigned char* lds) {
    const int tid = threadIdx.x, lane = tid & 63, wave = tid >> 6;
    const int gw = blockIdx.x * NWAVES + wave, NGW = gridDim.x * NWAVES;
    int* pst = (int*)lds;
    const unsigned* cnt = (const unsigned*)(p.ws + WS_CTL + CTL_CNT);
    if (tid == 0) { int ts = 0; for (int e = 0; e < NEXP; ++e) { pst[e] = ts; ts += ((int)cnt[e] + 255) >> 8; } }
    __syncthreads();
    const int* tokinfo = (const int*)(p.ws + WS_TOKINFO); const bf16_t* yb = (const bf16_t*)(p.ws + WS_YB); const float* gfin = p.in[32]; float* out = p.out;
    for (int m = gw; m < T; m += NGW) {
        const int4 ti = *(const int4*)(tokinfo + (size_t)m * 4);
        const int e0 = ti.x / CAP, r0 = ti.x % CAP, e1 = ti.y / CAP, r1 = ti.y % CAP;
        const size_t s0 = (size_t)pst[e0] * 256 + r0, s1 = (size_t)pst[e1] * 256 + r1;
        f32x4* hr = (f32x4*)(out + (size_t)m * DM) + lane; const u32x2* y0 = (const u32x2*)(yb + s0 * DM) + lane; const u32x2* y1 = (const u32x2*)(yb + s1 * DM) + lane;
        f32x4 v[8]; float s = 0.f;
#pragma unroll
        for (int j = 0; j < 8; ++j) { v[j] = hr[64 * j]; const u32x2 a = y0[64 * j], b2 = y1[64 * j];
            v[j][0] += bflo(a.x) + bflo(b2.x); v[j][1] += bfhi(a.x) + bfhi(b2.x); v[j][2] += bflo(a.y) + bflo(b2.y); v[j][3] += bfhi(a.y) + bfhi(b2.y);
            s += (v[j][0] * v[j][0] + v[j][1] * v[j][1]) + (v[j][2] * v[j][2] + v[j][3] * v[j][3]); }
        s = wave_sum(s); const float rs = 1.0f / sqrtf(s * (1.0f / DM) + 1e-6f);
#pragma unroll
        for (int j = 0; j < 8; ++j) { const f32x4 gv = *((const f32x4*)gfin + lane + 64 * j); hr[64 * j] = v[j] * rs * gv; }
    }
}

#if USE_REF_GEMM
#define GEMM_PHASE gemm_phase_ref
#endif

__global__ void __launch_bounds__(NTHREADS, 2) fwd_kernel(Params p) {
    extern __shared__ __attribute__((aligned(16))) unsigned char lds[];
    unsigned char* ws = p.ws;
    const int lo = p.ph_lo, hi = p.ph_hi;
#define IN(k) (lo <= (k) && (k) < hi)
#if N_LAUNCH_MODE == 1
    cg::grid_group grid = cg::this_grid();
#define SEAM(k) do { if (IN(k) && IN((k) + 1)) grid.sync(); } while (0)
#else
#define SEAM(k) do { } while (0)
#endif
    if (IN(PH_PRO)) { phase_prologue(p, lds); } SEAM(PH_PRO);
    if (IN(PH_INPROJ)) {
        Gemm g{(const bf16_t*)(ws + WS_XB), (const bf16_t*)(ws + WS_WIN), DM, DM, DM};
        DenseOrder S; S.init(T, NIN, gridDim.x, blockIdx.x, DM, DM);
        EpiIn E{(bf16_t*)(ws + WS_INBUF), (bf16_t*)(ws + WS_PBUF), (const float*)(ws + WS_RSTD1)};
        GEMM_PHASE<EpiIn, DenseOrder>(lds, g, S, E);
    } SEAM(PH_INPROJ);
    if (IN(PH_L2PREP)) { phase_l2prep(p); } SEAM(PH_L2PREP);
    if (IN(PH_L2GEMM)) {
        Gemm g{(const bf16_t*)(ws + WS_A2), (const bf16_t*)(ws + WS_L2T), PW, 256, 256};
        DenseOrder S; S.init(T, 3072, gridDim.x, blockIdx.x, PW, 256, 2, 256);
        EpiL2 E{(float*)(ws + WS_WL), (bf16_t*)(ws + WS_ABUF), (bf16_t*)(ws + WS_GBUF), p.in[11], p.in[14]};
        GEMM_PHASE<EpiL2, DenseOrder>(lds, g, S, E);
    } SEAM(PH_L2GEMM);
    if (IN(PH_MIX)) {
        for (int chain = blockIdx.x; chain < BATCH * NH_RW; chain += gridDim.x) rwkv_chain(p, lds, chain);
        for (int u = blockIdx.x; u < 1024; u += gridDim.x) { const int qb = 7 - (u >> 7), r = u & 127; attn_unit_ref(p, lds, r >> 4, (r >> 1) & 7, r & 1, qb); }
    } SEAM(PH_MIX);
    if (IN(PH_COMB)) { phase_combine(p); } SEAM(PH_COMB);
    if (IN(PH_OUT)) {
        Gemm g{(const bf16_t*)(ws + WS_O), (const bf16_t*)(ws + WS_WOUT), DM, DM, DM};
        DenseOrder S; S.init(T, DM, gridDim.x, blockIdx.x, DM, DM);
        EpiOut E{p.in[0], p.out, (bf16_t*)(ws + WS_HB), (float*)(ws + WS_CTL + CTL_SS2)};
        GEMM_PHASE<EpiOut, DenseOrder>(lds, g, S, E);
    } SEAM(PH_OUT);
    if (IN(PH_ROUTE)) { phase_router(p, lds); convert_experts(p, lds); } SEAM(PH_ROUTE);
    if (IN(PH_G1)) {
        Gemm g{(const bf16_t*)(ws + WS_HB), (const bf16_t*)(ws + WS_WGU), DM, DM, DM};
        MoeOrder S{(const unsigned*)(ws + WS_CTL + CTL_CNT), (const int*)(ws + WS_RT), 4, (int)gridDim.x, (int)blockIdx.x, 0, DM, (long)1024 * 2048, DM};
        EpiGU E{(bf16_t*)(ws + WS_HID), (const float*)(ws + WS_RSTD2)};
        GEMM_PHASE<EpiGU, MoeOrder>(lds, g, S, E);
    } SEAM(PH_G1);
    if (IN(PH_G2)) {
        Gemm g{(const bf16_t*)(ws + WS_HID), (const bf16_t*)(ws + WS_WD), DEXP, DEXP, DEXP};
        MoeOrder S{(const unsigned*)(ws + WS_CTL + CTL_CNT), (const int*)(ws + WS_RT), 8, (int)gridDim.x, (int)blockIdx.x, 1, DEXP, (long)2048 * 512, DEXP};
        EpiDown E{(bf16_t*)(ws + WS_YB), (const float*)(ws + WS_GATEB), (const unsigned*)(ws + WS_CTL + CTL_CNT)};
        GEMM_PHASE<EpiDown, MoeOrder>(lds, g, S, E);
    } SEAM(PH_G2);
    if (IN(PH_FINAL)) { phase_final(p, lds); }
}

extern "C" void kernel_launch(void* const* d_in, const int* in_sizes, int n_in, void* d_out, int out_size, void* d_ws, size_t ws_size, hipStream_t stream) {
    static int grid = 0;
    if (grid == 0) {
        if (n_in != 33 || out_size != T * DM || ws_size < WS_END) { fprintf(stderr, "kernel_launch: unexpected problem (n_in %d out %d ws %zu)\n", n_in, out_size, ws_size); grid = -1; return; }
        int dev = 0, cus = 0;
        hipGetDevice(&dev); hipDeviceGetAttribute(&cus, hipDeviceAttributeMultiprocessorCount, dev);
        if (hipFuncSetAttribute((const void*)fwd_kernel, hipFuncAttributeMaxDynamicSharedMemorySize, LDS_BYTES) != hipSuccess) { fprintf(stderr, "kernel_launch: hipFuncSetAttribute failed\n"); grid = -1; return; }
        int per_cu = 0; hipOccupancyMaxActiveBlocksPerMultiprocessor(&per_cu, (const void*)fwd_kernel, NTHREADS, LDS_BYTES); (void)hipGetLastError();
        if (per_cu < 1) fprintf(stderr, "kernel_launch: occupancy query says %d blocks per CU\n", per_cu);
        grid = cus > 0 ? cus : 256;
    }
    if (grid < 0) return;
    hipMemsetAsync((char*)d_ws + WS_CTL, 0, CTL_BYTES, stream);
    Params p{};
    for (int i = 0; i < 33; ++i) p.in[i] = (const float*)d_in[i];
    p.out = (float*)d_out; p.ws = (unsigned char*)d_ws;
#if N_LAUNCH_MODE == 1
    p.ph_lo = 0; p.ph_hi = PH_COUNT;
    void* args[] = {&p};
    hipError_t e = hipLaunchCooperativeKernel((const void*)fwd_kernel, dim3(grid), dim3(NTHREADS), args, LDS_BYTES, stream);
    if (e != hipSuccess) fprintf(stderr, "cooperative launch failed: %s (grid %d)\n", hipGetErrorString(e), grid);
#else
    for (int ph = 0; ph < PH_COUNT; ++ph) { p.ph_lo = ph; p.ph_hi = ph + 1; hipLaunchKernelGGL(fwd_kernel, dim3(grid), dim3(NTHREADS), LDS_BYTES, stream, p); }
#endif
}
```

```cpp
#include <hip/hip_runtime.h>
#include <hip/hip_cooperative_groups.h>
#include <cstdio>
#include <cstdint>
namespace cg = cooperative_groups;

#ifndef N_LAUNCH_MODE
#define N_LAUNCH_MODE 1
#endif
#ifndef USE_REF_GEMM
#define USE_REF_GEMM 0
#endif

constexpr int BATCH = 8, SEQ = 2048, DM = 2048, T = BATCH * SEQ;
constexpr int DAW = 1024, RWW = 1024, NH_DA = 8, NH_RW = 16;
constexpr int NIN = 6912;
constexpr int PW = 768;
constexpr int NEXP = 32, DEXP = 512, CAP = T;
constexpr int MAXTILES = 160;
constexpr float C2Q = 0.125f * 1.4426950408889634f;
constexpr float LOG2E = 1.4426950408889634f;

constexpr size_t MiB = 1u << 20;
constexpr size_t WS_CTL = 0, CTL_BYTES = 1 * MiB;
constexpr size_t CTL_SS2 = 65536;
constexpr size_t CTL_CNT = 131072;
constexpr size_t WS_WOUT = 1 * MiB;
constexpr size_t WS_L2T = 9 * MiB;
constexpr size_t WS_RSTD1 = 11 * MiB;
constexpr size_t WS_RSTD2 = 11 * MiB + 65536;
constexpr size_t WS_TOKINFO = 11 * MiB + 131072;
constexpr size_t WS_WIN = 12 * MiB;
constexpr size_t WS_XB = 40 * MiB;
constexpr size_t WS_O = 40 * MiB;
constexpr size_t WS_INBUF = 104 * MiB;
constexpr size_t WS_PBUF = 296 * MiB;
constexpr size_t WS_A2 = 320 * MiB;
constexpr size_t WS_WL = 344 * MiB;
constexpr size_t WS_ABUF = 408 * MiB;
constexpr size_t WS_GBUF = 440 * MiB;
constexpr size_t WS_OPART = 472 * MiB;
constexpr size_t WS_HB = 104 * MiB;
constexpr size_t WS_WGU = 168 * MiB;
constexpr size_t WS_WD = 296 * MiB;
constexpr size_t WS_RT = 360 * MiB;
constexpr size_t WS_GATEB = 362 * MiB;
constexpr size_t WS_HID = 364 * MiB;
constexpr size_t WS_YB = 404 * MiB;
constexpr size_t WS_END = 564 * MiB;

constexpr int NTHREADS = 512, NWAVES = 8;
constexpr int LDS_BYTES = 147456;

typedef unsigned short bf16_t;
typedef short bf16x8 __attribute__((ext_vector_type(8)));
typedef float f32x4 __attribute__((ext_vector_type(4)));
typedef float f32x2 __attribute__((ext_vector_type(2)));
typedef unsigned u32x4 __attribute__((ext_vector_type(4)));
typedef unsigned u32x2 __attribute__((ext_vector_type(2)));

__device__ __forceinline__ unsigned f2bf(float f) { unsigned u = __builtin_bit_cast(unsigned, f); return (u + 0x7fffu + ((u >> 16) & 1u)) >> 16; }
__device__ __forceinline__ unsigned pk2(float lo, float hi) { return f2bf(lo) | (f2bf(hi) << 16); }
__device__ __forceinline__ float bf2f(unsigned h) { return __builtin_bit_cast(float, h << 16); }
__device__ __forceinline__ float bflo(unsigned w) { return __builtin_bit_cast(float, w << 16); }
__device__ __forceinline__ float bfhi(unsigned w) { return __builtin_bit_cast(float, w & 0xffff0000u); }
__device__ __forceinline__ float wave_sum(float v) {
#pragma unroll
    for (int o = 1; o < 64; o <<= 1) v += __shfl_xor(v, o);
    return v;
}
__device__ __forceinline__ int opaque_tid() { int t = threadIdx.x; asm volatile("" : "+v"(t)); return t; }
__device__ __forceinline__ float sigmoidf_(float x) { return 1.0f / (1.0f + __expf(-x)); }

struct Params {
    const float* in[33];
    float* out;
    unsigned char* ws;
    int ph_lo, ph_hi;
};

enum { PH_PRO = 0, PH_INPROJ, PH_L2PREP, PH_L2GEMM, PH_MIX, PH_COMB, PH_OUT, PH_ROUTE, PH_G1, PH_G2, PH_FINAL, PH_COUNT };

struct Unit { int pm, pn; long a_off, b_off; const int* gidx; int valid, e, tile, k; };
struct Gemm { const bf16_t* A; const bf16_t* Bt; int lda, ldb, K; };

struct DenseOrder {
    static constexpr bool GATHER = false;
    int nM, nN, nwg, G, c, lda, ldb, acol_shift, acol_w;
    __device__ void init(int M, int N, int G_, int c_, int lda_, int ldb_, int acol_shift_ = -1, int acol_w_ = 0) {
        nM = M / 256; nN = N / 256; nwg = nM * nN; G = G_; c = c_; lda = lda_; ldb = ldb_; acol_shift = acol_shift_; acol_w = acol_w_; }
    __device__ bool next(int i, Unit& u) const {
        const long L = (long)i * G + c; if (L >= nwg) return false;
        int wgid = (int)L; { const int q = nwg / 8, r = nwg % 8, xcd = wgid % 8, off = wgid / 8; wgid = (xcd < r ? xcd * (q + 1) : r * (q + 1) + (xcd - r) * q) + off; }
        const int nig = 8 * nN, gid = wgid / nig, fm = gid * 8, gsz = (nM - fm) < 8 ? (nM - fm) : 8;
        u.pm = fm + ((wgid % nig) % gsz); u.pn = (wgid % nig) / gsz;
        u.a_off = (long)u.pm * 256 * lda + (acol_shift >= 0 ? (long)(u.pn >> acol_shift) * acol_w : 0);
        u.b_off = (long)u.pn * 256 * ldb; u.gidx = nullptr; u.valid = 256; u.e = 0; u.tile = 0; u.k = 0; return true;
    }
};
template <bool GATHER_> struct MoeOrder {
    static constexpr bool GATHER = GATHER_;
    const unsigned* cnt; const int* rt; int ncol, G, c, mode; long a_ld, b_estride, b_ld;
    __device__ bool next(int i, Unit& u) const {
        const long L = (long)i * G + c; const int g = (int)(L / ncol), pn = (int)(L % ncol);
        int ts = 0, e = 0, k = -1, ce = 0;
        for (e = 0; e < NEXP; ++e) { ce = __builtin_amdgcn_readfirstlane((int)cnt[e]); const int nt = (ce + 255) >> 8; if (g < ts + nt) { k = g - ts; break; } ts += nt; }
        if (k < 0) return false;
        u.pm = g; u.pn = pn; u.e = e; u.tile = g; u.k = k; u.valid = (ce - 256 * k) < 256 ? (ce - 256 * k) : 256;
        if (mode == 0) { u.gidx = rt + (long)e * CAP + 256 * k; u.a_off = 0; }
        else { u.gidx = nullptr; u.a_off = (long)g * 256 * a_ld; }
        u.b_off = (long)e * b_estride + (long)pn * 256 * b_ld; return true;
    }
};

template <class Epi, class Sched>
__device__ __forceinline__ void gemm_phase_ref(unsigned char* lds, const Gemm g, const Sched& S, const Epi& E) {
    const int tid = threadIdx.x, wid = tid >> 6, lane = tid & 63, wr = wid >> 2, wc = wid & 3, fr = lane & 15, fq = lane >> 4;
    bf16_t* As = (bf16_t*)lds; bf16_t* Bs = As + 256 * 72;
    Unit u;
    for (int ui = 0; S.next(ui, u); ++ui) {
        f32x4 acc[2][2][4][2];
#pragma unroll
        for (int a = 0; a < 2; ++a)
#pragma unroll
            for (int b = 0; b < 2; ++b)
#pragma unroll
                for (int m = 0; m < 4; ++m)
#pragma unroll
                    for (int n = 0; n < 2; ++n) acc[a][b][m][n] = (f32x4){0.f, 0.f, 0.f, 0.f};
        long arow[4];
#pragma unroll
        for (int i = 0; i < 4; ++i) { const int row = (tid + 512 * i) >> 3; arow[i] = u.gidx ? (row < u.valid ? (long)u.gidx[row] : 0L) : (long)row; }
        for (int k0 = 0; k0 < g.K; k0 += 64) {
            __syncthreads();
#pragma unroll
            for (int i = 0; i < 4; ++i) { const int ch = tid + 512 * i, row = ch >> 3, c8 = ch & 7;
                const u32x4 va = *(const u32x4*)(g.A + u.a_off + arow[i] * g.lda + k0 + c8 * 8);
                const u32x4 vb = *(const u32x4*)(g.Bt + u.b_off + (long)row * g.ldb + k0 + c8 * 8);
                *(u32x4*)(As + row * 72 + c8 * 8) = va; *(u32x4*)(Bs + row * 72 + c8 * 8) = vb; }
            __syncthreads();
            for (int kk = 0; kk < 64; ++kk) {
                float a[2][4];
#pragma unroll
                for (int ai = 0; ai < 2; ++ai)
#pragma unroll
                    for (int m = 0; m < 4; ++m) a[ai][m] = bf2f(As[(ai * 128 + wr * 64 + m * 16 + fr) * 72 + kk]);
#pragma unroll
                for (int bj = 0; bj < 2; ++bj)
#pragma unroll
                    for (int n = 0; n < 2; ++n)
#pragma unroll
                        for (int e = 0; e < 4; ++e) {
                            const int cl = Epi::PERM ? (bj * 128 + wc * 32 + 8 * fq + 4 * n + e) : (bj * 128 + wc * 32 + 16 * n + 4 * fq + e);
                            const float b = bf2f(Bs[cl * 72 + kk]);
#pragma unroll
                            for (int ai = 0; ai < 2; ++ai)
#pragma unroll
                                for (int m = 0; m < 4; ++m) acc[ai][bj][m][n][e] += a[ai][m] * b;
                        }
            }
        }
        E(acc, u, wr, wc, fr, fq);
    }
    __syncthreads();
}


#define LAS __attribute__((address_space(3)))
namespace pg8 {
constexpr int BK = 64, HALF = 128, HTB = HALF * BK * 2, STAGE_BYTES = 8 * HTB;
__device__ __forceinline__ int lds_byte(int r, int c) { const int st = (r >> 4) * 2 + (c >> 5), rr = r & 15, cc = c & 31, ob = rr * 64 + cc * 2; return st * 1024 + (ob ^ (((ob >> 9) & 1) << 5)); }
__device__ __forceinline__ void stage_rc(int b, int& R, int& C) { const int st = b / 1024, sb = b % 1024, swz = sb ^ (((sb >> 9) & 1) << 5); R = (st >> 1) * 16 + swz / 64; C = (st & 1) * 32 + (swz % 64) / 2; }
__device__ __forceinline__ int perm32(int rho) { const int n = rho >> 4, i = rho & 15; return 8 * (i >> 2) + 4 * n + (i & 3); }
template <bool GATHER>
__device__ __forceinline__ void unit_voffA(const Unit& u, int lda, int tid, unsigned (&v0)[2], unsigned (&v1)[2]) {
#pragma unroll
    for (int i = 0; i < 2; ++i) { int R, C; stage_rc(tid * 16 + i * 8192, R, C); int r0 = R, r1 = R + HALF;
        if (GATHER) { const int a = (r0 < u.valid) ? u.gidx[r0] : 0, b = (r1 < u.valid) ? u.gidx[r1] : 0; r0 = a; r1 = b; }
        v0[i] = (unsigned)(r0 * lda + C) * 2u; v1[i] = (unsigned)(r1 * lda + C) * 2u; }
}
template <class Epi, class Sched, bool ALIGN_EPI = true>
__device__ __forceinline__ void gemm_phase(LAS unsigned char* lds, const Gemm g, const Sched& S, const Epi& E) {
    const int tid = threadIdx.x, wid = __builtin_amdgcn_readfirstlane(tid >> 6), lane = tid & 63, wr = wid >> 2, wc = wid & 3, fr = lane & 15, fq = lane >> 4;
    const int K = g.K, nt = K / BK;
    constexpr bool GATHER = Sched::GATHER;
    unsigned voffB[2];
#pragma unroll
    for (int i = 0; i < 2; ++i) { int R, C; stage_rc(tid * 16 + i * 8192, R, C); const int Rb = Epi::PERM ? ((R & ~31) + perm32(R & 31)) : R; voffB[i] = (unsigned)(Rb * g.ldb + C) * 2u; }
    const size_t hstepA = (size_t)HALF * g.lda * 2;
    const size_t kstep = (size_t)(BK * 2);
    const size_t hstepB = (size_t)HALF * g.ldb * 2;
    const unsigned ldsw = (unsigned)wid * 1024u;
    const int aoff = lds_byte(wr * 64 + fr, fq * 8), boff = lds_byte(wc * 32 + fr, fq * 8);
#define PG8_SA(b, h) (((b) * 2 + (h)) * HTB)
#define PG8_SB(b, h) ((4 + (b) * 2 + (h)) * HTB)
#define PG8_STAGE(bufoff, gbase, voff) do { _Pragma("unroll") for (int _i = 0; _i < 2; ++_i) \
        __builtin_amdgcn_global_load_lds((const unsigned*)((const char*)(gbase) + (voff)[_i]), (LAS unsigned*)(lds + (bufoff) + ldsw + _i * 8192), 16, 0, 0); } while (0)
#define PG8_LDA(dst, b, h) do { _Pragma("unroll") for (int m = 0; m < 4; ++m) _Pragma("unroll") for (int k = 0; k < 2; ++k) dst[m][k] = *(const LAS bf16x8*)(lds + PG8_SA(b, h) + aoff + m * 2048 + k * 1024); } while (0)
#define PG8_LDB(dst, b, h) do { _Pragma("unroll") for (int n = 0; n < 2; ++n) _Pragma("unroll") for (int k = 0; k < 2; ++k) dst[n][k] = *(const LAS bf16x8*)(lds + PG8_SB(b, h) + boff + n * 2048 + k * 1024); } while (0)
#define PG8_MMA(ai, bj, At, Bt) do { __builtin_amdgcn_s_setprio(1); _Pragma("unroll") for (int m = 0; m < 4; ++m) _Pragma("unroll") for (int n = 0; n < 2; ++n) _Pragma("unroll") for (int k = 0; k < 2; ++k) \
        acc[ai][bj][m][n] = __builtin_amdgcn_mfma_f32_16x16x32_bf16(Bt[n][k], At[m][k], acc[ai][bj][m][n], 0, 0, 0); __builtin_amdgcn_s_setprio(0); } while (0)
#define PG8_WAIT_V(n) asm volatile("s_waitcnt vmcnt(" #n ")" ::: "memory")
#define PG8_WAIT_L(n) asm volatile("s_waitcnt lgkmcnt(" #n ")" ::: "memory")
#define PG8_BAR __builtin_amdgcn_s_barrier()
#define PG8_SCHED __builtin_amdgcn_sched_barrier(0)
    Unit cur, nxt; int ui = 0;
    if (!S.next(0, cur)) return;
    f32x4 acc[2][2][4][2];
#pragma unroll
    for (int a = 0; a < 2; ++a)
#pragma unroll
        for (int b = 0; b < 2; ++b)
#pragma unroll
            for (int m = 0; m < 4; ++m)
#pragma unroll
                for (int n = 0; n < 2; ++n) acc[a][b][m][n] = (f32x4){0.f, 0.f, 0.f, 0.f};
    bf16x8 At[4][2], B0[2][2], B1[2][2];
    const char* cA = (const char*)(g.A + cur.a_off); const char* cB = (const char*)(g.Bt + cur.b_off);
    unsigned vA0[2], vA1[2], nA0[2], nA1[2];
    unit_voffA<GATHER>(cur, g.lda, tid, vA0, vA1);
#define PG8_STAGE_A(bufoff, gbase, h, sel) do { if constexpr (GATHER) { if (sel) { if ((h) == 0) PG8_STAGE(bufoff, gbase, nA0); else PG8_STAGE(bufoff, gbase, nA1); } else { if ((h) == 0) PG8_STAGE(bufoff, gbase, vA0); else PG8_STAGE(bufoff, gbase, vA1); } } \
        else { PG8_STAGE(bufoff, (gbase) + ((h) ? hstepA : (size_t)0), vA0); } } while (0)
    PG8_STAGE(PG8_SB(0, 0), cB, voffB); PG8_STAGE(PG8_SB(0, 1), cB + hstepB, voffB); PG8_STAGE_A(PG8_SA(0, 0), cA, 0, false); PG8_STAGE_A(PG8_SA(0, 1), cA, 1, false);
    if (wr == 1) PG8_BAR;
    PG8_WAIT_V(2); PG8_BAR;
    PG8_STAGE(PG8_SB(1, 0), cB + kstep, voffB); PG8_STAGE_A(PG8_SA(1, 0), cA + kstep, 0, false); PG8_STAGE(PG8_SB(1, 1), cB + hstepB + kstep, voffB);
    PG8_WAIT_V(6); PG8_BAR;
    for (;;) {
        const bool has_next = S.next(ui + 1, nxt);
        const char* nA = has_next ? (const char*)(g.A + nxt.a_off) : cA; const char* nB = has_next ? (const char*)(g.Bt + nxt.b_off) : cB;
        if constexpr (GATHER) { if (has_next) unit_voffA<true>(nxt, g.lda, tid, nA0, nA1); else { nA0[0] = vA0[0]; nA0[1] = vA0[1]; nA1[0] = vA1[0]; nA1[1] = vA1[1]; } }
        for (int t = 0; t < nt; t += 2) {
            const bool last = (t == nt - 2);
            const char* a1 = cA + (size_t)(t + 1) * kstep;
            const char* a2 = last ? nA : cA + (size_t)(t + 2) * kstep; const char* b2 = last ? nB : cB + (size_t)(t + 2) * kstep;
            const char* a3 = a2 + kstep; const char* b3 = b2 + kstep;
            PG8_LDB(B0, 0, 0); PG8_LDB(B1, 0, 1); PG8_SCHED; PG8_LDA(At, 0, 0); PG8_STAGE_A(PG8_SA(1, 1), a1, 1, false);
            PG8_WAIT_V(8); PG8_WAIT_L(0); PG8_BAR; PG8_MMA(0, 0, At, B0); PG8_MMA(0, 1, At, B1); PG8_BAR; PG8_SCHED;
            PG8_LDA(At, 0, 1); PG8_STAGE(PG8_SB(0, 0), b2, voffB); PG8_STAGE(PG8_SB(0, 1), b2 + hstepB, voffB); PG8_STAGE_A(PG8_SA(0, 0), a2, 0, last);
            PG8_WAIT_V(8); PG8_WAIT_L(0); PG8_BAR; PG8_MMA(1, 0, At, B0); PG8_MMA(1, 1, At, B1); PG8_BAR; PG8_SCHED;
            PG8_LDB(B0, 1, 0); PG8_LDB(B1, 1, 1); PG8_SCHED; PG8_LDA(At, 1, 0); PG8_STAGE_A(PG8_SA(0, 1), a2, 1, last);
            PG8_WAIT_V(8); PG8_WAIT_L(0); PG8_BAR; PG8_MMA(0, 0, At, B0); PG8_MMA(0, 1, At, B1); PG8_BAR; PG8_SCHED;
            PG8_LDA(At, 1, 1); PG8_STAGE(PG8_SB(1, 0), b3, voffB); PG8_STAGE(PG8_SB(1, 1), b3 + hstepB, voffB); PG8_STAGE_A(PG8_SA(1, 0), a3, 0, last);
            PG8_WAIT_V(8); PG8_WAIT_L(0); PG8_BAR; PG8_MMA(1, 0, At, B0); PG8_MMA(1, 1, At, B1); PG8_BAR; PG8_SCHED;
        }
        if constexpr (ALIGN_EPI) { if (wr == 0) PG8_BAR; }
        E(acc, cur, wr, wc, fr, fq);
        if (!has_next) break;
#pragma unroll
        for (int a = 0; a < 2; ++a)
#pragma unroll
            for (int b = 0; b < 2; ++b)
#pragma unroll
                for (int m = 0; m < 4; ++m)
#pragma unroll
                    for (int n = 0; n < 2; ++n) acc[a][b][m][n] = (f32x4){0.f, 0.f, 0.f, 0.f};
        cur = nxt; cA = nA; cB = nB; ++ui;
        if constexpr (GATHER) { vA0[0] = nA0[0]; vA0[1] = nA0[1]; vA1[0] = nA1[0]; vA1[1] = nA1[1]; }
        if constexpr (ALIGN_EPI) { if (wr == 1) PG8_BAR; }
    }
    PG8_WAIT_V(0);
    if constexpr (!ALIGN_EPI) { if (wr == 0) PG8_BAR; }
    PG8_BAR;
#undef PG8_SA
#undef PG8_SB
#undef PG8_STAGE
#undef PG8_STAGE_A
#undef PG8_LDA
#undef PG8_LDB
#undef PG8_MMA
#undef PG8_WAIT_V
#undef PG8_WAIT_L
#undef PG8_BAR
#undef PG8_SCHED
}
}
template <class Epi, class Sched>
__device__ __forceinline__ void gemm_phase_mfma(unsigned char* lds, const Gemm g, const Sched& S, const Epi& E) { pg8::gemm_phase<Epi, Sched, true>((LAS unsigned char*)lds, g, S, E); __syncthreads(); }

__device__ __forceinline__ u32x4 pack8(const f32x4 v0, const f32x4 v1) { u32x4 w; w.x = pk2(v0[0], v0[1]); w.y = pk2(v0[2], v0[3]); w.z = pk2(v1[0], v1[1]); w.w = pk2(v1[2], v1[3]); return w; }

struct EpiIn {
    static constexpr bool PERM = true;
    bf16_t* inbuf; bf16_t* pbuf; const float* rstd1;
    __device__ __forceinline__ void operator()(const f32x4 (&acc)[2][2][4][2], const Unit& u, int wr, int wc, int fr_, int fq_) const {
        int fr = fr_, fq = fq_; asm volatile("" : "+v"(fr), "+v"(fq));
        bf16_t* base; int ldc, colt; float sc0 = 1.f;
        if (u.pn < 24) { base = inbuf + (size_t)(u.pn >> 2) * T * 1024; ldc = 1024; colt = (u.pn & 3) * 256; if (u.pn < 4) sc0 = C2Q; }
        else { base = pbuf; ldc = PW; colt = (u.pn - 24) * 256; }
        const int row0 = u.pm * 256 + wr * 64 + fr, col0 = colt + wc * 32 + 8 * fq;
#pragma unroll
        for (int ai = 0; ai < 2; ++ai)
#pragma unroll
            for (int m = 0; m < 4; ++m) { const int row = row0 + ai * 128 + m * 16; const float rs = rstd1[row] * sc0; bf16_t* rowp = base + (size_t)row * ldc + col0;
#pragma unroll
                for (int bj = 0; bj < 2; ++bj) *(u32x4*)(rowp + bj * 128) = pack8(acc[ai][bj][m][0] * rs, acc[ai][bj][m][1] * rs); }
    }
};
struct EpiL2 {
    static constexpr bool PERM = true;
    float* wl; bf16_t* abuf; bf16_t* gbuf; const float* w0; const float* a0;
    __device__ __forceinline__ void operator()(const f32x4 (&acc)[2][2][4][2], const Unit& u, int wr, int wc, int fr_, int fq_) const {
        int fr = fr_, fq = fq_; asm volatile("" : "+v"(fr), "+v"(fq));
        const int grp = u.pn >> 2, colt = (u.pn & 3) * 256;
        const int row0 = u.pm * 256 + wr * 64 + fr, col0 = colt + wc * 32 + 8 * fq;
        if (grp == 0) {
#pragma unroll
            for (int bj = 0; bj < 2; ++bj) { const int c = col0 + bj * 128; const f32x4 b0 = *(const f32x4*)(w0 + c), b1 = *(const f32x4*)(w0 + c + 4);
#pragma unroll
                for (int ai = 0; ai < 2; ++ai)
#pragma unroll
                    for (int m = 0; m < 4; ++m) { const int row = row0 + ai * 128 + m * 16; f32x4 v0 = acc[ai][bj][m][0] + b0, v1 = acc[ai][bj][m][1] + b1;
#pragma unroll
                        for (int e = 0; e < 4; ++e) { v0[e] = -0.60653065971f * LOG2E * sigmoidf_(v0[e]); v1[e] = -0.60653065971f * LOG2E * sigmoidf_(v1[e]); }
                        float* p = wl + (size_t)row * 1024 + c; *(f32x4*)p = v0; *(f32x4*)(p + 4) = v1; asm volatile("" ::: "memory"); __builtin_amdgcn_sched_barrier(0); } }
        } else if (grp == 1) {
#pragma unroll
            for (int bj = 0; bj < 2; ++bj) { const int c = col0 + bj * 128; const f32x4 b0 = *(const f32x4*)(a0 + c), b1 = *(const f32x4*)(a0 + c + 4);
#pragma unroll
                for (int ai = 0; ai < 2; ++ai)
#pragma unroll
                    for (int m = 0; m < 4; ++m) { const int row = row0 + ai * 128 + m * 16; f32x4 v0 = acc[ai][bj][m][0] + b0, v1 = acc[ai][bj][m][1] + b1;
#pragma unroll
                        for (int e = 0; e < 4; ++e) { v0[e] = sigmoidf_(v0[e]); v1[e] = sigmoidf_(v1[e]); }
                        *(u32x4*)(abuf + (size_t)row * 1024 + c) = pack8(v0, v1); asm volatile("" ::: "memory"); __builtin_amdgcn_sched_barrier(0); } }
        } else {
#pragma unroll
            for (int bj = 0; bj < 2; ++bj) { const int c = col0 + bj * 128;
#pragma unroll
                for (int ai = 0; ai < 2; ++ai)
#pragma unroll
                    for (int m = 0; m < 4; ++m) { const int row = row0 + ai * 128 + m * 16; *(u32x4*)(gbuf + (size_t)row * 1024 + c) = pack8(acc[ai][bj][m][0], acc[ai][bj][m][1]); } }
        }
    }
};
struct EpiOut {
    static constexpr bool PERM = true;
    const float* x; float* h; bf16_t* hb; float* ss2;
    __device__ __forceinline__ void operator()(const f32x4 (&acc)[2][2][4][2], const Unit& u, int wr, int wc, int fr_, int fq_) const {
        int fr = fr_, fq = fq_; asm volatile("" : "+v"(fr), "+v"(fq));
        const int row0 = u.pm * 256 + wr * 64 + fr, col0 = u.pn * 256 + wc * 32 + 8 * fq;
#pragma unroll
        for (int ai = 0; ai < 2; ++ai)
#pragma unroll
            for (int m = 0; m < 4; ++m) { const int row = row0 + ai * 128 + m * 16; float ss = 0.f;
#pragma unroll
                for (int bj = 0; bj < 2; ++bj) { const size_t off = (size_t)row * DM + col0 + bj * 128;
                    const f32x4 x0 = *(const f32x4*)(x + off), x1 = *(const f32x4*)(x + off + 4);
                    const f32x4 v0 = acc[ai][bj][m][0] + x0, v1 = acc[ai][bj][m][1] + x1;
                    *(f32x4*)(h + off) = v0; *(f32x4*)(h + off + 4) = v1; *(u32x4*)(hb + off) = pack8(v0, v1);
                    ss += (v0[0] * v0[0] + v0[1] * v0[1]) + (v0[2] * v0[2] + v0[3] * v0[3]) + (v1[0] * v1[0] + v1[1] * v1[1]) + (v1[2] * v1[2] + v1[3] * v1[3]); }
                ss += __shfl_xor(ss, 16); ss += __shfl_xor(ss, 32);
                if (fq == 0) atomicAdd(ss2 + row, ss); }
    }
};
struct EpiGU {
    static constexpr bool PERM = true;
    bf16_t* hid; const float* rstd2;
    __device__ __forceinline__ void operator()(const f32x4 (&acc)[2][2][4][2], const Unit& u, int wr, int wc, int fr_, int fq_) const {
        int fr = fr_, fq = fq_; asm volatile("" : "+v"(fr), "+v"(fq));
        const int col0 = u.pn * 128 + wc * 32 + 8 * fq;
#pragma unroll
        for (int ai = 0; ai < 2; ++ai)
#pragma unroll
            for (int m = 0; m < 4; ++m) { const int rl = ai * 128 + wr * 64 + m * 16 + fr; const int tok = (rl < u.valid) ? u.gidx[rl] : 0; const float rs = rstd2[tok];
                f32x4 o0, o1;
#pragma unroll
                for (int e = 0; e < 4; ++e) { const float g0 = acc[ai][0][m][0][e] * rs, u0 = acc[ai][1][m][0][e] * rs, g1 = acc[ai][0][m][1][e] * rs, u1 = acc[ai][1][m][1][e] * rs;
                    o0[e] = g0 * sigmoidf_(g0) * u0; o1[e] = g1 * sigmoidf_(g1) * u1; }
                *(u32x4*)(hid + ((size_t)u.tile * 256 + rl) * DEXP + col0) = pack8(o0, o1); asm volatile("" ::: "memory"); __builtin_amdgcn_sched_barrier(0); }
    }
};
struct EpiDown {
    static constexpr bool PERM = true;
    bf16_t* yb; const float* gateb; const unsigned* cnt;
    __device__ __forceinline__ void operator()(const f32x4 (&acc)[2][2][4][2], const Unit& u, int wr, int wc, int fr_, int fq_) const {
        int fr = fr_, fq = fq_; asm volatile("" : "+v"(fr), "+v"(fq));
        const int col0 = u.pn * 256 + wc * 32 + 8 * fq;
        const int k = u.k;
#pragma unroll
        for (int ai = 0; ai < 2; ++ai)
#pragma unroll
            for (int m = 0; m < 4; ++m) { const int rl = ai * 128 + wr * 64 + m * 16 + fr; const float gt = (rl < u.valid) ? gateb[(size_t)u.e * CAP + 256 * k + rl] : 0.f;
#pragma unroll
                for (int bj = 0; bj < 2; ++bj) *(u32x4*)(yb + ((size_t)u.tile * 256 + rl) * DM + col0 + bj * 128) = pack8(acc[ai][bj][m][0] * gt, acc[ai][bj][m][1] * gt); }
    }
};

__device__ __forceinline__ void tr_item(const float* W, int ldw, int Kvalid, int k0, int n0, bf16_t* WT, int ldt, int trow0, float* scr, int lane,
                                        const float* gk, const float* mu, int mode) {
#pragma unroll 8
    for (int i = 0; i < 32; ++i) { const int kk = 2 * i + (lane >> 5), k = k0 + kk; float v = 0.f;
        if (k < Kvalid) { v = W[(size_t)k * ldw + n0 + (lane & 31)]; float s = gk ? gk[k] : 1.f; if (mode == 1) s *= (1.f - mu[k]); else if (mode == 2) s *= mu[k]; v *= s; }
        scr[kk * 33 + (lane & 31)] = v; }
    __builtin_amdgcn_s_waitcnt(0xC07F); asm volatile("" ::: "memory");
    const int c = lane & 7;
#pragma unroll
    for (int j = 0; j < 4; ++j) { const int n = (lane >> 3) + 8 * j; const float* s = scr + (8 * c) * 33 + n;
        u32x4 o; o.x = pk2(s[0 * 33], s[1 * 33]); o.y = pk2(s[2 * 33], s[3 * 33]); o.z = pk2(s[4 * 33], s[5 * 33]); o.w = pk2(s[6 * 33], s[7 * 33]);
        *(u32x4*)(WT + (size_t)(trow0 + n) * ldt + k0 + 8 * c) = o; }
    __builtin_amdgcn_s_waitcnt(0xC07F); asm volatile("" ::: "memory");
}

__device__ __forceinline__ void phase_prologue(const Params& p, unsigned char* lds) {
    const int tid = opaque_tid(), lane = tid & 63, wave = tid >> 6;
    const int gw = blockIdx.x * NWAVES + wave, NGW = gridDim.x * NWAVES;
    unsigned char* ws = p.ws;
    float* scr = (float*)(lds + wave * 16384);
    bf16_t* WinT = (bf16_t*)(ws + WS_WIN); bf16_t* WoutT = (bf16_t*)(ws + WS_WOUT); bf16_t* L2T = (bf16_t*)(ws + WS_L2T);
    const float* g_mix = p.in[1]; const float* mu_x = p.in[9];
    constexpr int I_WIN = 32 * 192;
    constexpr int I_L1 = 32 * 2 * 2 + 32 * 2 * 2 + 32 * 5 * 2;
    constexpr int I_WOUT = 32 * 64;
    constexpr int I_L2 = 3 * 4 * 32;
    constexpr int NITEMS = I_WIN + I_L1 + I_WOUT + I_L2;
    for (int it = gw; it < NITEMS; it += NGW) {
        int r = it;
        if (r < I_WIN) { const int kb = r / 192, nb = r % 192; tr_item(p.in[2], 6144, 2048, 64 * kb, 32 * nb, WinT, 2048, 32 * nb, scr, lane, g_mix, nullptr, 0); continue; } r -= I_WIN;
        if (r < I_L1) {
            int which, nb, mode, kb;
            if (r < 128) { which = 0; } else if (r < 256) { which = 1; r -= 128; } else { which = 2; r -= 256; }
            const int nnb = (which == 2) ? 5 : 2;
            kb = r / (nnb * 2); const int rr = r % (nnb * 2); nb = rr / 2; mode = 1 + (rr & 1);
            const float* W = which == 0 ? p.in[12] : which == 1 ? p.in[15] : p.in[17];
            const int ldw = which == 2 ? 160 : 64;
            const int rowbase = 6144 + (which == 0 ? 0 : which == 1 ? 128 : 256) + (mode == 2 ? ldw : 0);
            tr_item(W, ldw, 2048, 64 * kb, 32 * nb, WinT, 2048, rowbase + 32 * nb, scr, lane, g_mix, mu_x + which * 2048, mode); continue; } r -= I_L1;
        if (r < I_WOUT) { const int kb = r / 64, nb = r % 64; tr_item(p.in[3], 2048, 2048, 64 * kb, 32 * nb, WoutT, 2048, 32 * nb, scr, lane, nullptr, nullptr, 0); continue; } r -= I_WOUT;
        { const int which = r / 128, rr = r % 128, kb = rr / 32, nb = rr % 32;
          const float* W = which == 0 ? p.in[13] : which == 1 ? p.in[16] : p.in[18]; const int kv = which == 2 ? 160 : 64;
          tr_item(W, 1024, kv, 64 * kb, 32 * nb, L2T, 256, which * 1024 + 32 * nb, scr, lane, nullptr, nullptr, 0); }
    }
    for (int ch = blockIdx.x * NTHREADS + tid; ch < 192 * 256; ch += gridDim.x * NTHREADS) *(u32x4*)(WinT + (size_t)6720 * 2048 + (size_t)ch * 8) = (u32x4){0u, 0u, 0u, 0u};
    const float* x = p.in[0]; bf16_t* xb = (bf16_t*)(ws + WS_XB); float* rstd1 = (float*)(ws + WS_RSTD1);
    for (int m = gw; m < T; m += NGW) {
        const f32x4* xr = (const f32x4*)(x + (size_t)m * DM) + lane; f32x4 v[8]; float s = 0.f;
#pragma unroll
        for (int j = 0; j < 8; ++j) { v[j] = xr[64 * j]; s += (v[j][0] * v[j][0] + v[j][1] * v[j][1]) + (v[j][2] * v[j][2] + v[j][3] * v[j][3]); }
        s = wave_sum(s);
        u32x2* o = (u32x2*)(xb + (size_t)m * DM) + lane;
#pragma unroll
        for (int j = 0; j < 8; ++j) { u32x2 w; w.x = pk2(v[j][0], v[j][1]); w.y = pk2(v[j][2], v[j][3]); o[64 * j] = w; }
        if (lane == 0) rstd1[m] = 1.0f / sqrtf(s * (1.0f / DM) + 1e-6f);
    }
}

__device__ __forceinline__ void convert_experts(const Params& p, unsigned char* lds) {
    const int tid = opaque_tid(), lane = tid & 63, wave = tid >> 6;
    const int gw = blockIdx.x * NWAVES + wave, NGW = gridDim.x * NWAVES;
    float* scr = (float*)(lds + 65536 + wave * 8704);
    bf16_t* Wgu = (bf16_t*)(p.ws + WS_WGU); bf16_t* Wd = (bf16_t*)(p.ws + WS_WD); const float* gf = p.in[24];
    constexpr int I_G = 32 * 32 * 16;
    constexpr int I_D = 32 * 8 * 64;
    for (int it = gw; it < 2 * I_G + I_D; it += NGW) {
        int r = it;
        if (r < 2 * I_G) { const int up = r >= I_G; if (up) r -= I_G; const int e = r / 512, rr = r % 512, kb = rr / 16, nb = rr % 16; const int n0 = 32 * nb;
            tr_item((up ? p.in[30] : p.in[29]) + (size_t)e * 2048 * 512, 512, 2048, 64 * kb, n0, Wgu + (size_t)e * 1024 * 2048, 2048, 256 * (n0 >> 7) + (n0 & 127) + (up ? 128 : 0), scr, lane, gf, nullptr, 0); continue; }
        r -= 2 * I_G;
        { const int e = r / 512, rr = r % 512, kb = rr / 64, nb = rr % 64;
          tr_item(p.in[31] + (size_t)e * 512 * 2048, 2048, 512, 64 * kb, 32 * nb, Wd + (size_t)e * 2048 * 512, 512, 32 * nb, scr, lane, nullptr, nullptr, 0); }
    }
}

__device__ __forceinline__ void phase_l2prep(const Params& p) {
    const bf16_t* P = (const bf16_t*)(p.ws + WS_PBUF); bf16_t* A2 = (bf16_t*)(p.ws + WS_A2);
    const int nchunk = T * 96;
    const int tid = opaque_tid();
    for (int id = blockIdx.x * NTHREADS + tid; id < nchunk; id += gridDim.x * NTHREADS) {
        const int t = id / 96, ch = id % 96, gi = ch >> 5, jc = (ch & 31) * 8;
        const int width = gi == 2 ? 160 : 64, pa = gi == 0 ? 0 : gi == 1 ? 128 : 256, pb = pa + width;
        u32x4 o = (u32x4){0u, 0u, 0u, 0u};
        if (jc < width) {
            const u32x4 va = *(const u32x4*)(P + (size_t)t * PW + pa + jc);
            u32x4 vb = (u32x4){0u, 0u, 0u, 0u};
            if ((t & (SEQ - 1)) != 0) vb = *(const u32x4*)(P + (size_t)(t - 1) * PW + pb + jc);
            float f[8];
#pragma unroll
            for (int i = 0; i < 4; ++i) { f[2 * i] = bflo(va[i]) + bflo(vb[i]); f[2 * i + 1] = bfhi(va[i]) + bfhi(vb[i]); }
#pragma unroll
            for (int i = 0; i < 8; ++i) { if (gi == 0) f[i] = 1.0f - 2.0f / (__expf(2.0f * f[i]) + 1.0f); else if (gi == 2) f[i] = sigmoidf_(f[i]); }
            o.x = pk2(f[0], f[1]); o.y = pk2(f[2], f[3]); o.z = pk2(f[4], f[5]); o.w = pk2(f[6], f[7]);
        }
        *(u32x4*)(A2 + (size_t)t * PW + ch * 8) = o;
    }
}

constexpr int TC = 32;
__device__ __forceinline__ void rwkv_chain(const Params& p, unsigned char* lds, int chain) {
    const int tid = opaque_tid(), lane = tid & 63, wave = tid >> 6;
    const int b = chain >> 4, h = chain & 15, c = h * 64 + lane;
    float* Rs = (float*)lds; float* Ws = Rs + TC * 64; float* Ks = Ws + TC * 64; float* Vs = Ks + TC * 64; float* KKs = Vs + TC * 64; float* Bs = KKs + TC * 64;
    float* Ys = Bs + TC * 64; float* Gs = Ys + TC * 64; float* BON = Gs + TC * 64;
    const bf16_t* rb = (const bf16_t*)(p.ws + WS_INBUF) + (size_t)3 * T * 1024; const bf16_t* kb = rb + (size_t)T * 1024; const bf16_t* vb = kb + (size_t)T * 1024;
    const float* wl = (const float*)(p.ws + WS_WL); const bf16_t* ab = (const bf16_t*)(p.ws + WS_ABUF); const bf16_t* gb = (const bf16_t*)(p.ws + WS_GBUF);
    bf16_t* O = (bf16_t*)(p.ws + WS_O);
    const float mu_r = p.in[10][c], mu_k = p.in[10][1024 + c], mu_v = p.in[10][2048 + c];
    const float k_k = p.in[19][c], k_a = p.in[20][c], r_k = p.in[21][c], ln_w = p.in[22][c], ln_b = p.in[23][c];
    const int r8 = lane >> 3, q = lane & 7, irow = 8 * wave + r8;
    float S[8];
#pragma unroll
    for (int e = 0; e < 8; ++e) S[e] = 0.f;
    for (int t0 = 0; t0 < SEQ; t0 += TC) {
#pragma unroll
        for (int s = 0; s < TC / NWAVES; ++s) {
            const int tl = wave * (TC / NWAVES) + s, t = t0 + tl; const size_t m = (size_t)b * SEQ + t, off = m * 1024 + c;
            const float rc = bf2f(rb[off]), kc = bf2f(kb[off]), vc = bf2f(vb[off]);
            float rp = 0.f, kp = 0.f, vp = 0.f;
            if (t > 0) { rp = bf2f(rb[off - 1024]); kp = bf2f(kb[off - 1024]); vp = bf2f(vb[off - 1024]); }
            const float rr = rc + (rp - rc) * mu_r, kx = kc + (kp - kc) * mu_k, vv = vc + (vp - vc) * mu_v;
            const float w = __builtin_amdgcn_exp2f(wl[off]), a = bf2f(ab[off]);
            const float kkv = kx * k_k; const float n2 = wave_sum(kkv * kkv); const float kkn = kkv / fmaxf(sqrtf(n2), 1e-12f);
            const float kmod = kx * (1.0f + (a - 1.0f) * k_a);
            const float bon = wave_sum(rr * kmod * r_k);
            Rs[tl * 64 + lane] = rr; Ws[tl * 64 + lane] = w; Ks[tl * 64 + lane] = kmod; Vs[tl * 64 + lane] = vv; KKs[tl * 64 + lane] = -kkn; Bs[tl * 64 + lane] = kkn * a;
            Gs[tl * 64 + lane] = bf2f(gb[off]); if (lane == 0) BON[tl] = bon;
        }
        __syncthreads();
        for (int tl = 0; tl < TC; ++tl) {
            const f32x4 kk0 = *(const f32x4*)(KKs + tl * 64 + 8 * q), kk1 = *(const f32x4*)(KKs + tl * 64 + 8 * q + 4);
            const f32x4 w0 = *(const f32x4*)(Ws + tl * 64 + 8 * q), w1 = *(const f32x4*)(Ws + tl * 64 + 8 * q + 4);
            const f32x4 b0 = *(const f32x4*)(Bs + tl * 64 + 8 * q), b1 = *(const f32x4*)(Bs + tl * 64 + 8 * q + 4);
            const f32x4 k0 = *(const f32x4*)(Ks + tl * 64 + 8 * q), k1 = *(const f32x4*)(Ks + tl * 64 + 8 * q + 4);
            const f32x4 r0 = *(const f32x4*)(Rs + tl * 64 + 8 * q), r1 = *(const f32x4*)(Rs + tl * 64 + 8 * q + 4);
            const float v = Vs[tl * 64 + irow];
            float sa = (S[0] * kk0[0] + S[1] * kk0[1]) + (S[2] * kk0[2] + S[3] * kk0[3]) + (S[4] * kk1[0] + S[5] * kk1[1]) + (S[6] * kk1[2] + S[7] * kk1[3]);
            sa += __shfl_xor(sa, 1); sa += __shfl_xor(sa, 2); sa += __shfl_xor(sa, 4);
#pragma unroll
            for (int e = 0; e < 4; ++e) { S[e] = S[e] * w0[e] + (sa * b0[e] + v * k0[e]); S[4 + e] = S[4 + e] * w1[e] + (sa * b1[e] + v * k1[e]); }
            float y = (S[0] * r0[0] + S[1] * r0[1]) + (S[2] * r0[2] + S[3] * r0[3]) + (S[4] * r1[0] + S[5] * r1[1]) + (S[6] * r1[2] + S[7] * r1[3]);
            y += __shfl_xor(y, 1); y += __shfl_xor(y, 2); y += __shfl_xor(y, 4);
            if (q == 0) Ys[tl * 64 + irow] = y;
        }
        __syncthreads();
#pragma unroll
        for (int s = 0; s < TC / NWAVES; ++s) {
            const int tl = wave * (TC / NWAVES) + s, t = t0 + tl; const size_t m = (size_t)b * SEQ + t;
            const float y = Ys[tl * 64 + lane]; const float mean = wave_sum(y) * (1.0f / 64.0f); const float d = y - mean; const float var = wave_sum(d * d) * (1.0f / 64.0f);
            float yn = d * (1.0f / sqrtf(var + 64e-5f)) * ln_w + ln_b;
            yn += BON[tl] * Vs[tl * 64 + lane];
            O[m * DM + 1024 + c] = (bf16_t)f2bf(yn * Gs[tl * 64 + lane]);
        }
        __syncthreads();
    }
}

__device__ __forceinline__ void attn_unit_ref(const Params& p, unsigned char* lds, int b, int h, int comp, int qb) {
    const int tid = opaque_tid(), row = tid & 255, dh = tid >> 8;
    float* Kt = (float*)lds; float* Vt = Kt + 64 * 64;
    const bf16_t* qbuf = (const bf16_t*)(p.ws + WS_INBUF); const bf16_t* kbuf = qbuf + (size_t)T * 1024; const bf16_t* vbuf = kbuf + (size_t)T * 1024;
    bf16_t* Op = (bf16_t*)(p.ws + WS_OPART) + (size_t)comp * T * 1024;
    const size_t rowbase = (size_t)b * SEQ; const int qpos = qb * 256 + row;
    float qv[64], o[64];
    { const bf16_t* qp = qbuf + (rowbase + qpos) * 1024 + h * 128 + comp * 64;
#pragma unroll
      for (int d = 0; d < 64; d += 8) { const u32x4 w = *(const u32x4*)(qp + d);
#pragma unroll
          for (int i = 0; i < 4; ++i) { qv[d + 2 * i] = bflo(w[i]); qv[d + 2 * i + 1] = bfhi(w[i]); } } }
#pragma unroll
    for (int d = 0; d < 64; ++d) o[d] = 0.f;
    float mrun = -1e30f, l = 0.f;
    const float slope2 = exp2f(-(float)(h + 1)) * LOG2E;
    const int ntile = (qb + 1) * 4;
    for (int kt = 0; kt < ntile; ++kt) {
        __syncthreads();
        for (int ch = tid; ch < 1536; ch += NTHREADS) { const int r = ch / 24, cc = ch % 24; const size_t grow = rowbase + kt * 64 + r;
            if (cc < 8) { const u32x4 w = *(const u32x4*)(kbuf + grow * 1024 + h * 128 + comp * 64 + cc * 8);
#pragma unroll
                for (int i = 0; i < 4; ++i) { Kt[r * 64 + cc * 8 + 2 * i] = bflo(w[i]); Kt[r * 64 + cc * 8 + 2 * i + 1] = bfhi(w[i]); } }
            else { const int c2 = cc - 8; const u32x4 w = *(const u32x4*)(vbuf + grow * 1024 + h * 128 + c2 * 8);
#pragma unroll
                for (int i = 0; i < 4; ++i) { Vt[r * 128 + c2 * 8 + 2 * i] = bflo(w[i]); Vt[r * 128 + c2 * 8 + 2 * i + 1] = bfhi(w[i]); } } }
        __syncthreads();
        for (int j = 0; j < 64; ++j) {
            const int kpos = kt * 64 + j; if (kpos > qpos) break;
            float s = 0.f;
#pragma unroll
            for (int d = 0; d < 64; d += 4) { const f32x4 kv = *(const f32x4*)(Kt + j * 64 + d); s += qv[d] * kv[0] + qv[d + 1] * kv[1] + qv[d + 2] * kv[2] + qv[d + 3] * kv[3]; }
            s += slope2 * (float)kpos;
            if (s > mrun) { const float f = exp2f(mrun - s); l *= f;
#pragma unroll
                for (int d = 0; d < 64; ++d) o[d] *= f;
                mrun = s; }
            const float pr = exp2f(s - mrun); l += pr;
#pragma unroll
            for (int d = 0; d < 64; d += 4) { const f32x4 vv = *(const f32x4*)(Vt + j * 128 + dh * 64 + d); o[d] += pr * vv[0]; o[d + 1] += pr * vv[1]; o[d + 2] += pr * vv[2]; o[d + 3] += pr * vv[3]; }
        }
    }
    const float il = 1.0f / l;
    bf16_t* op = Op + (rowbase + qpos) * 1024 + h * 128 + dh * 64;
#pragma unroll
    for (int d = 0; d < 64; d += 8) { u32x4 w; w.x = pk2(o[d] * il, o[d + 1] * il); w.y = pk2(o[d + 2] * il, o[d + 3] * il); w.z = pk2(o[d + 4] * il, o[d + 5] * il); w.w = pk2(o[d + 6] * il, o[d + 7] * il); *(u32x4*)(op + d) = w; }
    __syncthreads();
}

__device__ __forceinline__ void phase_combine(const Params& p) {
    const int tid = opaque_tid(), lane = tid & 63, wave = tid >> 6;
    const int gw = blockIdx.x * NWAVES + wave, NGW = gridDim.x * NWAVES;
    const float s1 = wave_sum(p.in[4][lane] * p.in[5][lane]), s2 = wave_sum(p.in[6][lane] * p.in[7][lane]);
    const float lam = __expf(s1) - __expf(s2) + 0.2f;
    const bf16_t* O0 = (const bf16_t*)(p.ws + WS_OPART); const bf16_t* O1 = O0 + (size_t)T * 1024; bf16_t* O = (bf16_t*)(p.ws + WS_O);
    const float* sg = p.in[8] + (lane & 7) * 16;
    for (int m = gw; m < T; m += NGW) {
        const u32x4 a0 = *(const u32x4*)(O0 + (size_t)m * 1024 + lane * 16), a1 = *(const u32x4*)(O0 + (size_t)m * 1024 + lane * 16 + 8);
        const u32x4 c0 = *(const u32x4*)(O1 + (size_t)m * 1024 + lane * 16), c1 = *(const u32x4*)(O1 + (size_t)m * 1024 + lane * 16 + 8);
        float d[16]; float ss = 0.f;
#pragma unroll
        for (int i = 0; i < 4; ++i) { d[2 * i] = bflo(a0[i]) - lam * bflo(c0[i]); d[2 * i + 1] = bfhi(a0[i]) - lam * bfhi(c0[i]); d[8 + 2 * i] = bflo(a1[i]) - lam * bflo(c1[i]); d[8 + 2 * i + 1] = bfhi(a1[i]) - lam * bfhi(c1[i]); }
#pragma unroll
        for (int i = 0; i < 16; ++i) ss += d[i] * d[i];
        ss += __shfl_xor(ss, 1); ss += __shfl_xor(ss, 2); ss += __shfl_xor(ss, 4);
        const float rs = 0.8f / sqrtf(ss * (1.0f / 128.0f) + 1e-6f);
        u32x4 w0, w1;
        w0.x = pk2(d[0] * rs * sg[0], d[1] * rs * sg[1]); w0.y = pk2(d[2] * rs * sg[2], d[3] * rs * sg[3]); w0.z = pk2(d[4] * rs * sg[4], d[5] * rs * sg[5]); w0.w = pk2(d[6] * rs * sg[6], d[7] * rs * sg[7]);
        w1.x = pk2(d[8] * rs * sg[8], d[9] * rs * sg[9]); w1.y = pk2(d[10] * rs * sg[10], d[11] * rs * sg[11]); w1.z = pk2(d[12] * rs * sg[12], d[13] * rs * sg[13]); w1.w = pk2(d[14] * rs * sg[14], d[15] * rs * sg[15]);
        *(u32x4*)(O + (size_t)m * DM + lane * 16) = w0; *(u32x4*)(O + (size_t)m * DM + lane * 16 + 8) = w1;
    }
}

__device__ __forceinline__ void phase_router(const Params& p, unsigned char* lds) {
    const int tid = opaque_tid(), lane = tid & 63, wave = tid >> 6;
    float* hs = (float*)lds;
    float* Wsm = hs + 64 * 260;
    float* lg = Wsm + 36 * 256;
    const float* h = p.out; const float* gf = p.in[24]; const float* wg = p.in[25]; const float* we = p.in[27];
    const float* ss2 = (const float*)(p.ws + WS_CTL + CTL_SS2); float* rstd2 = (float*)(p.ws + WS_RSTD2);
    unsigned* cnt = (unsigned*)(p.ws + WS_CTL + CTL_CNT); int* rt = (int*)(p.ws + WS_RT); float* gateb = (float*)(p.ws + WS_GATEB); int* tokinfo = (int*)(p.ws + WS_TOKINFO);
    for (int tb = blockIdx.x; tb < T / 64; tb += gridDim.x) {
        const int tok0 = tb * 64;
        float acc[5];
#pragma unroll
        for (int i = 0; i < 5; ++i) acc[i] = 0.f;
        for (int k0 = 0; k0 < DM; k0 += 256) {
            __syncthreads();
            for (int ch = tid; ch < 64 * 64; ch += NTHREADS) { const int r = ch >> 6, c4 = ch & 63; *(f32x4*)(hs + r * 260 + c4 * 4) = *(const f32x4*)(h + (size_t)(tok0 + r) * DM + k0 + c4 * 4); }
            for (int id = tid; id < 36 * 256; id += NTHREADS) { const int k = id / 36, cc = id % 36; const float w = cc < 4 ? wg[(size_t)(k0 + k) * 4 + cc] : we[(size_t)(k0 + k) * 32 + cc - 4]; Wsm[cc * 256 + k] = w * gf[k0 + k]; }
            __syncthreads();
            for (int k = 0; k < 256; k += 4) { const f32x4 hv = *(const f32x4*)(hs + lane * 260 + k);
#pragma unroll
                for (int i = 0; i < 5; ++i) { const int cc = wave + 8 * i; if (cc < 36) { const f32x4 wv = *(const f32x4*)(Wsm + cc * 256 + k); acc[i] += hv[0] * wv[0] + hv[1] * wv[1] + hv[2] * wv[2] + hv[3] * wv[3]; } } }
        }
#pragma unroll
        for (int i = 0; i < 5; ++i) { const int cc = wave + 8 * i; if (cc < 36) lg[lane * 40 + cc] = acc[i]; }
        __syncthreads();
        if (tid < 64) {
            const int t = tok0 + tid; const float rs = 1.0f / sqrtf(ss2[t] * (1.0f / DM) + 1e-6f); rstd2[t] = rs;
            float g4[4]; int grp = 0; float gmax = -3.0e38f;
#pragma unroll
            for (int i = 0; i < 4; ++i) { g4[i] = lg[tid * 40 + i] * rs + p.in[26][i]; if (g4[i] > gmax) { gmax = g4[i]; grp = i; } }
            float gs = 0.f;
#pragma unroll
            for (int i = 0; i < 4; ++i) gs += __expf(g4[i] - gmax);
            const float pg = 1.0f / gs;
            float e8[8]; int i0 = 0; float m0 = -3.0e38f;
#pragma unroll
            for (int i = 0; i < 8; ++i) { e8[i] = lg[tid * 40 + 4 + grp * 8 + i] * rs + p.in[28][grp * 8 + i]; if (e8[i] > m0) { m0 = e8[i]; i0 = i; } }
            int i1 = 0; float m1 = -3.0e38f;
#pragma unroll
            for (int i = 0; i < 8; ++i) if (i != i0 && e8[i] > m1) { m1 = e8[i]; i1 = i; }
            const float p1 = __expf(m1 - m0); const float g0 = pg / (1.0f + p1), g1 = pg * p1 / (1.0f + p1);
            const int e0 = grp * 8 + i0, e1 = grp * 8 + i1;
            const unsigned r0 = atomicAdd(cnt + e0, 1u), r1 = atomicAdd(cnt + e1, 1u);
            rt[(size_t)e0 * CAP + r0] = t; rt[(size_t)e1 * CAP + r1] = t; gateb[(size_t)e0 * CAP + r0] = g0; gateb[(size_t)e1 * CAP + r1] = g1;
            int4 ti; ti.x = e0 * CAP + (int)r0; ti.y = e1 * CAP + (int)r1; ti.z = 0; ti.w = 0; *(int4*)(tokinfo + (size_t)t * 4) = ti;
        }
        __syncthreads();
    }
}

__device__ __forceinline__ void phase_final(const Params& p, unsigned char* lds) {
    const int tid = opaque_tid(), lane = tid & 63, wave = tid >> 6;
    const int gw = blockIdx.x * NWAVES + wave, NGW = gridDim.x * NWAVES;
    int* pst = (int*)lds;
    const unsigned* cnt = (const unsigned*)(p.ws + WS_CTL + CTL_CNT);
    if (tid == 0) { int ts = 0; for (int e = 0; e < NEXP; ++e) { pst[e] = ts; ts += ((int)cnt[e] + 255) >> 8; } }
    __syncthreads();
    const int* tokinfo = (const int*)(p.ws + WS_TOKINFO); const bf16_t* yb = (const bf16_t*)(p.ws + WS_YB); const float* gfin = p.in[32]; float* out = p.out;
    for (int m = gw; m < T; m += NGW) {
        const int4 ti = *(const int4*)(tokinfo + (size_t)m * 4);
        const int e0 = ti.x / CAP, r0 = ti.x % CAP, e1 = ti.y / CAP, r1 = ti.y % CAP;
        const size_t s0 = (size_t)pst[e0] * 256 + r0, s1 = (size_t)pst[e1] * 256 + r1;
        f32x4* hr = (f32x4*)(out + (size_t)m * DM) + lane; const u32x2* y0 = (const u32x2*)(yb + s0 * DM) + lane; const u32x2* y1 = (const u32x2*)(yb + s1 * DM) + lane;
        f32x4 v[8]; float s = 0.f;
#pragma unroll
        for (int j = 0; j < 8; ++j) { v[j] = hr[64 * j]; const u32x2 a = y0[64 * j], b2 = y1[64 * j];
            v[j][0] += bflo(a.x) + bflo(b2.x); v[j][1] += bfhi(a.x) + bfhi(b2.x); v[j][2] += bflo(a.y) + bflo(b2.y); v[j][3] += bfhi(a.y) + bfhi(b2.y);
            s += (v[j][0] * v[j][0] + v[j][1] * v[j][1]) + (v[j][2] * v[j][2] + v[j][3] * v[j][3]); }
        s = wave_sum(s); const float rs = 1.0f / sqrtf(s * (1.0f / DM) + 1e-6f);
#pragma unroll
        for (int j = 0; j < 8; ++j) { const f32x4 gv = *((const f32x4*)gfin + lane + 64 * j); hr[64 * j] = v[j] * rs * gv; }
    }
}

#if USE_REF_GEMM
#define GEMM_PHASE gemm_phase_ref
#else
#define GEMM_PHASE gemm_phase_mfma
#endif

__global__ void __launch_bounds__(NTHREADS, 2) fwd_kernel(Params p) {
    extern __shared__ __attribute__((aligned(16))) unsigned char lds[];
    unsigned char* ws = p.ws;
    const int lo = p.ph_lo, hi = p.ph_hi;
#define IN(k) (lo <= (k) && (k) < hi)
#if N_LAUNCH_MODE == 1
    cg::grid_group grid = cg::this_grid();
#define SEAM(k) do { if (IN(k) && IN((k) + 1)) grid.sync(); } while (0)
#else
#define SEAM(k) do { } while (0)
#endif
    if (IN(PH_PRO)) { phase_prologue(p, lds); } SEAM(PH_PRO);
    if (IN(PH_INPROJ)) {
        Gemm g{(const bf16_t*)(ws + WS_XB), (const bf16_t*)(ws + WS_WIN), DM, DM, DM};
        DenseOrder S; S.init(T, NIN, gridDim.x, blockIdx.x, DM, DM);
        EpiIn E{(bf16_t*)(ws + WS_INBUF), (bf16_t*)(ws + WS_PBUF), (const float*)(ws + WS_RSTD1)};
        GEMM_PHASE<EpiIn, DenseOrder>(lds, g, S, E);
    } SEAM(PH_INPROJ);
    if (IN(PH_L2PREP)) { phase_l2prep(p); } SEAM(PH_L2PREP);
    if (IN(PH_L2GEMM)) {
        Gemm g{(const bf16_t*)(ws + WS_A2), (const bf16_t*)(ws + WS_L2T), PW, 256, 256};
        DenseOrder S; S.init(T, 3072, gridDim.x, blockIdx.x, PW, 256, 2, 256);
        EpiL2 E{(float*)(ws + WS_WL), (bf16_t*)(ws + WS_ABUF), (bf16_t*)(ws + WS_GBUF), p.in[11], p.in[14]};
        GEMM_PHASE<EpiL2, DenseOrder>(lds, g, S, E);
    } SEAM(PH_L2GEMM);
    if (IN(PH_MIX)) {
        for (int chain = blockIdx.x; chain < BATCH * NH_RW; chain += gridDim.x) rwkv_chain(p, lds, chain);
        for (int u = blockIdx.x; u < 1024; u += gridDim.x) { const int qb = 7 - (u >> 7), r = u & 127; attn_unit_ref(p, lds, r >> 4, (r >> 1) & 7, r & 1, qb); }
    } SEAM(PH_MIX);
    if (IN(PH_COMB)) { phase_combine(p); } SEAM(PH_COMB);
    if (IN(PH_OUT)) {
        Gemm g{(const bf16_t*)(ws + WS_O), (const bf16_t*)(ws + WS_WOUT), DM, DM, DM};
        DenseOrder S; S.init(T, DM, gridDim.x, blockIdx.x, DM, DM);
        EpiOut E{p.in[0], p.out, (bf16_t*)(ws + WS_HB), (float*)(ws + WS_CTL + CTL_SS2)};
        GEMM_PHASE<EpiOut, DenseOrder>(lds, g, S, E);
    } SEAM(PH_OUT);
    if (IN(PH_ROUTE)) { phase_router(p, lds); convert_experts(p, lds); } SEAM(PH_ROUTE);
    if (IN(PH_G1)) {
        Gemm g{(const bf16_t*)(ws + WS_HB), (const bf16_t*)(ws + WS_WGU), DM, DM, DM};
        MoeOrder<true> S{(const unsigned*)(ws + WS_CTL + CTL_CNT), (const int*)(ws + WS_RT), 4, (int)gridDim.x, (int)blockIdx.x, 0, DM, (long)1024 * 2048, DM};
        EpiGU E{(bf16_t*)(ws + WS_HID), (const float*)(ws + WS_RSTD2)};
        GEMM_PHASE<EpiGU, MoeOrder<true>>(lds, g, S, E);
    } SEAM(PH_G1);
    if (IN(PH_G2)) {
        Gemm g{(const bf16_t*)(ws + WS_HID), (const bf16_t*)(ws + WS_WD), DEXP, DEXP, DEXP};
        MoeOrder<false> S{(const unsigned*)(ws + WS_CTL + CTL_CNT), (const int*)(ws + WS_RT), 8, (int)gridDim.x, (int)blockIdx.x, 1, DEXP, (long)2048 * 512, DEXP};
        EpiDown E{(bf16_t*)(ws + WS_YB), (const float*)(ws + WS_GATEB), (const unsigned*)(ws + WS_CTL + CTL_CNT)};
        GEMM_PHASE<EpiDown, MoeOrder<false>>(lds, g, S, E);
    } SEAM(PH_G2);
    if (IN(PH_FINAL)) { phase_final(p, lds); }
}

extern "C" void kernel_launch(void* const* d_in, const int* in_sizes, int n_in, void* d_out, int out_size, void* d_ws, size_t ws_size, hipStream_t stream) {
    static int grid = 0;
    if (grid == 0) {
        if (n_in != 33 || out_size != T * DM || ws_size < WS_END) { fprintf(stderr, "kernel_launch: unexpected problem (n_in %d out %d ws %zu)\n", n_in, out_size, ws_size); grid = -1; return; }
        int dev = 0, cus = 0;
        hipGetDevice(&dev); hipDeviceGetAttribute(&cus, hipDeviceAttributeMultiprocessorCount, dev);
        if (hipFuncSetAttribute((const void*)fwd_kernel, hipFuncAttributeMaxDynamicSharedMemorySize, LDS_BYTES) != hipSuccess) { fprintf(stderr, "kernel_launch: hipFuncSetAttribute failed\n"); grid = -1; return; }
        int per_cu = 0; hipOccupancyMaxActiveBlocksPerMultiprocessor(&per_cu, (const void*)fwd_kernel, NTHREADS, LDS_BYTES); (void)hipGetLastError();
        if (per_cu < 1) fprintf(stderr, "kernel_launch: occupancy query says %d blocks per CU\n", per_cu);
        grid = cus > 0 ? cus : 256;
    }
    if (grid < 0) return;
    hipMemsetAsync((char*)d_ws + WS_CTL, 0, CTL_BYTES, stream);
    Params p{};
    for (int i = 0; i < 33; ++i) p.in[i] = (const float*)d_in[i];
    p.out = (float*)d_out; p.ws = (unsigned char*)d_ws;
#if N_LAUNCH_MODE == 1
    p.ph_lo = 0; p.ph_hi = PH_COUNT;
    void* args[] = {&p};
    hipError_t e = hipLaunchCooperativeKernel((const void*)fwd_kernel, dim3(grid), dim3(NTHREADS), args, LDS_BYTES, stream);
    if (e != hipSuccess) fprintf(stderr, "cooperative launch failed: %s (grid %d)\n", hipGetErrorString(e), grid);
#else
    for (int ph = 0; ph < PH_COUNT; ++ph) { p.ph_lo = ph; p.ph_hi = ph + 1; hipLaunchKernelGGL(fwd_kernel, dim3(grid), dim3(NTHREADS), LDS_BYTES, stream, p); }
#endif
}
```

```cpp
#include <hip/hip_runtime.h>
#include <hip/hip_cooperative_groups.h>
#include <cstdio>
#include <cstdint>
namespace cg = cooperative_groups;

#ifndef N_LAUNCH_MODE
#define N_LAUNCH_MODE 1
#endif
#ifndef USE_REF_ATTN
#define USE_REF_ATTN 0
#endif
#ifndef USE_REF_GEMM
#define USE_REF_GEMM 0
#endif

constexpr int BATCH = 8, SEQ = 2048, DM = 2048, T = BATCH * SEQ;
constexpr int DAW = 1024, RWW = 1024, NH_DA = 8, NH_RW = 16;
constexpr int NIN = 6912;
constexpr int PW = 768;
constexpr int NEXP = 32, DEXP = 512, CAP = T;
constexpr int MAXTILES = 160;
constexpr float C2Q = 0.125f * 1.4426950408889634f;
constexpr float LOG2E = 1.4426950408889634f;

constexpr size_t MiB = 1u << 20;
constexpr size_t WS_CTL = 0, CTL_BYTES = 1 * MiB;
constexpr size_t CTL_SS2 = 65536;
constexpr size_t CTL_CNT = 131072;
constexpr size_t WS_WOUT = 1 * MiB;
constexpr size_t WS_L2T = 9 * MiB;
constexpr size_t WS_RSTD1 = 11 * MiB;
constexpr size_t WS_RSTD2 = 11 * MiB + 65536;
constexpr size_t WS_TOKINFO = 11 * MiB + 131072;
constexpr size_t WS_WIN = 12 * MiB;
constexpr size_t WS_XB = 40 * MiB;
constexpr size_t WS_O = 40 * MiB;
constexpr size_t WS_INBUF = 104 * MiB;
constexpr size_t WS_PBUF = 296 * MiB;
constexpr size_t WS_A2 = 320 * MiB;
constexpr size_t WS_WL = 344 * MiB;
constexpr size_t WS_ABUF = 408 * MiB;
constexpr size_t WS_GBUF = 440 * MiB;
constexpr size_t WS_OPART = 472 * MiB;
constexpr size_t WS_HB = 104 * MiB;
constexpr size_t WS_WGU = 168 * MiB;
constexpr size_t WS_WD = 296 * MiB;
constexpr size_t WS_RT = 360 * MiB;
constexpr size_t WS_GATEB = 362 * MiB;
constexpr size_t WS_HID = 364 * MiB;
constexpr size_t WS_YB = 404 * MiB;
constexpr size_t WS_END = 564 * MiB;

constexpr int NTHREADS = 512, NWAVES = 8;
constexpr int LDS_BYTES = 147456;

typedef unsigned short bf16_t;
typedef short bf16x8 __attribute__((ext_vector_type(8)));
typedef float f32x4 __attribute__((ext_vector_type(4)));
typedef float f32x2 __attribute__((ext_vector_type(2)));
typedef unsigned u32x4 __attribute__((ext_vector_type(4)));
typedef unsigned u32x2 __attribute__((ext_vector_type(2)));

__device__ __forceinline__ unsigned f2bf(float f) { unsigned u = __builtin_bit_cast(unsigned, f); return (u + 0x7fffu + ((u >> 16) & 1u)) >> 16; }
__device__ __forceinline__ unsigned pk2(float lo, float hi) { return f2bf(lo) | (f2bf(hi) << 16); }
__device__ __forceinline__ float bf2f(unsigned h) { return __builtin_bit_cast(float, h << 16); }
__device__ __forceinline__ float bflo(unsigned w) { return __builtin_bit_cast(float, w << 16); }
__device__ __forceinline__ float bfhi(unsigned w) { return __builtin_bit_cast(float, w & 0xffff0000u); }
__device__ __forceinline__ float wave_sum(float v) {
#pragma unroll
    for (int o = 1; o < 64; o <<= 1) v += __shfl_xor(v, o);
    return v;
}
__device__ __forceinline__ int opaque_tid() { int t = threadIdx.x; asm volatile("" : "+v"(t)); return t; }
__device__ __forceinline__ float sigmoidf_(float x) { return 1.0f / (1.0f + __expf(-x)); }

struct Params {
    const float* in[33];
    float* out;
    unsigned char* ws;
    int ph_lo, ph_hi;
};

enum { PH_PRO = 0, PH_INPROJ, PH_L2PREP, PH_L2GEMM, PH_MIX, PH_COMB, PH_OUT, PH_ROUTE, PH_G1, PH_G2, PH_FINAL, PH_COUNT };

struct Unit { int pm, pn; long a_off, b_off; const int* gidx; int valid, e, tile, k; };
struct Gemm { const bf16_t* A; const bf16_t* Bt; int lda, ldb, K; };

struct DenseOrder {
    static constexpr bool GATHER = false;
    int nM, nN, nwg, G, c, lda, ldb, acol_shift, acol_w;
    __device__ void init(int M, int N, int G_, int c_, int lda_, int ldb_, int acol_shift_ = -1, int acol_w_ = 0) {
        nM = M / 256; nN = N / 256; nwg = nM * nN; G = G_; c = c_; lda = lda_; ldb = ldb_; acol_shift = acol_shift_; acol_w = acol_w_; }
    __device__ bool next(int i, Unit& u) const {
        const long L = (long)i * G + c; if (L >= nwg) return false;
        int wgid = (int)L; { const int q = nwg / 8, r = nwg % 8, xcd = wgid % 8, off = wgid / 8; wgid = (xcd < r ? xcd * (q + 1) : r * (q + 1) + (xcd - r) * q) + off; }
        const int nig = 8 * nN, gid = wgid / nig, fm = gid * 8, gsz = (nM - fm) < 8 ? (nM - fm) : 8;
        u.pm = fm + ((wgid % nig) % gsz); u.pn = (wgid % nig) / gsz;
        u.a_off = (long)u.pm * 256 * lda + (acol_shift >= 0 ? (long)(u.pn >> acol_shift) * acol_w : 0);
        u.b_off = (long)u.pn * 256 * ldb; u.gidx = nullptr; u.valid = 256; u.e = 0; u.tile = 0; u.k = 0; return true;
    }
};
template <bool GATHER_> struct MoeOrder {
    static constexpr bool GATHER = GATHER_;
    const unsigned* cnt; const int* rt; int ncol, G, c, mode; long a_ld, b_estride, b_ld;
    __device__ bool next(int i, Unit& u) const {
        const long L = (long)i * G + c; const int g = (int)(L / ncol), pn = (int)(L % ncol);
        int ts = 0, e = 0, k = -1, ce = 0;
        for (e = 0; e < NEXP; ++e) { ce = __builtin_amdgcn_readfirstlane((int)cnt[e]); const int nt = (ce + 255) >> 8; if (g < ts + nt) { k = g - ts; break; } ts += nt; }
        if (k < 0) return false;
        u.pm = g; u.pn = pn; u.e = e; u.tile = g; u.k = k; u.valid = (ce - 256 * k) < 256 ? (ce - 256 * k) : 256;
        if (mode == 0) { u.gidx = rt + (long)e * CAP + 256 * k; u.a_off = 0; }
        else { u.gidx = nullptr; u.a_off = (long)g * 256 * a_ld; }
        u.b_off = (long)e * b_estride + (long)pn * 256 * b_ld; return true;
    }
};

template <class Epi, class Sched>
__device__ __forceinline__ void gemm_phase_ref(unsigned char* lds, const Gemm g, const Sched& S, const Epi& E) {
    const int tid = threadIdx.x, wid = tid >> 6, lane = tid & 63, wr = wid >> 2, wc = wid & 3, fr = lane & 15, fq = lane >> 4;
    bf16_t* As = (bf16_t*)lds; bf16_t* Bs = As + 256 * 72;
    Unit u;
    for (int ui = 0; S.next(ui, u); ++ui) {
        f32x4 acc[2][2][4][2];
#pragma unroll
        for (int a = 0; a < 2; ++a)
#pragma unroll
            for (int b = 0; b < 2; ++b)
#pragma unroll
                for (int m = 0; m < 4; ++m)
#pragma unroll
                    for (int n = 0; n < 2; ++n) acc[a][b][m][n] = (f32x4){0.f, 0.f, 0.f, 0.f};
        long arow[4];
#pragma unroll
        for (int i = 0; i < 4; ++i) { const int row = (tid + 512 * i) >> 3; arow[i] = u.gidx ? (row < u.valid ? (long)u.gidx[row] : 0L) : (long)row; }
        for (int k0 = 0; k0 < g.K; k0 += 64) {
            __syncthreads();
#pragma unroll
            for (int i = 0; i < 4; ++i) { const int ch = tid + 512 * i, row = ch >> 3, c8 = ch & 7;
                const u32x4 va = *(const u32x4*)(g.A + u.a_off + arow[i] * g.lda + k0 + c8 * 8);
                const u32x4 vb = *(const u32x4*)(g.Bt + u.b_off + (long)row * g.ldb + k0 + c8 * 8);
                *(u32x4*)(As + row * 72 + c8 * 8) = va; *(u32x4*)(Bs + row * 72 + c8 * 8) = vb; }
            __syncthreads();
            for (int kk = 0; kk < 64; ++kk) {
                float a[2][4];
#pragma unroll
                for (int ai = 0; ai < 2; ++ai)
#pragma unroll
                    for (int m = 0; m < 4; ++m) a[ai][m] = bf2f(As[(ai * 128 + wr * 64 + m * 16 + fr) * 72 + kk]);
#pragma unroll
                for (int bj = 0; bj < 2; ++bj)
#pragma unroll
                    for (int n = 0; n < 2; ++n)
#pragma unroll
                        for (int e = 0; e < 4; ++e) {
                            const int cl = Epi::PERM ? (bj * 128 + wc * 32 + 8 * fq + 4 * n + e) : (bj * 128 + wc * 32 + 16 * n + 4 * fq + e);
                            const float b = bf2f(Bs[cl * 72 + kk]);
#pragma unroll
                            for (int ai = 0; ai < 2; ++ai)
#pragma unroll
                                for (int m = 0; m < 4; ++m) acc[ai][bj][m][n][e] += a[ai][m] * b;
                        }
            }
        }
        E(acc, u, wr, wc, fr, fq);
    }
    __syncthreads();
}


#define LAS __attribute__((address_space(3)))
namespace pg8 {
constexpr int BK = 64, HALF = 128, HTB = HALF * BK * 2, STAGE_BYTES = 8 * HTB;
__device__ __forceinline__ int lds_byte(int r, int c) { const int st = (r >> 4) * 2 + (c >> 5), rr = r & 15, cc = c & 31, ob = rr * 64 + cc * 2; return st * 1024 + (ob ^ (((ob >> 9) & 1) << 5)); }
__device__ __forceinline__ void stage_rc(int b, int& R, int& C) { const int st = b / 1024, sb = b % 1024, swz = sb ^ (((sb >> 9) & 1) << 5); R = (st >> 1) * 16 + swz / 64; C = (st & 1) * 32 + (swz % 64) / 2; }
__device__ __forceinline__ int perm32(int rho) { const int n = rho >> 4, i = rho & 15; return 8 * (i >> 2) + 4 * n + (i & 3); }
template <bool GATHER>
__device__ __forceinline__ void unit_voffA(const Unit& u, int lda, int tid, unsigned (&v0)[2], unsigned (&v1)[2]) {
#pragma unroll
    for (int i = 0; i < 2; ++i) { int R, C; stage_rc(tid * 16 + i * 8192, R, C); int r0 = R, r1 = R + HALF;
        if (GATHER) { const int a = (r0 < u.valid) ? u.gidx[r0] : 0, b = (r1 < u.valid) ? u.gidx[r1] : 0; r0 = a; r1 = b; }
        v0[i] = (unsigned)(r0 * lda + C) * 2u; v1[i] = (unsigned)(r1 * lda + C) * 2u; }
}
template <class Epi, class Sched, bool ALIGN_EPI = true>
__device__ __forceinline__ void gemm_phase(LAS unsigned char* lds, const Gemm g, const Sched& S, const Epi& E) {
    const int tid = threadIdx.x, wid = __builtin_amdgcn_readfirstlane(tid >> 6), lane = tid & 63, wr = wid >> 2, wc = wid & 3, fr = lane & 15, fq = lane >> 4;
    const int K = g.K, nt = K / BK;
    constexpr bool GATHER = Sched::GATHER;
    unsigned voffB[2];
#pragma unroll
    for (int i = 0; i < 2; ++i) { int R, C; stage_rc(tid * 16 + i * 8192, R, C); const int Rb = Epi::PERM ? ((R & ~31) + perm32(R & 31)) : R; voffB[i] = (unsigned)(Rb * g.ldb + C) * 2u; }
    const size_t hstepA = (size_t)HALF * g.lda * 2;
    const size_t kstep = (size_t)(BK * 2);
    const size_t hstepB = (size_t)HALF * g.ldb * 2;
    const unsigned ldsw = (unsigned)wid * 1024u;
    const int aoff = lds_byte(wr * 64 + fr, fq * 8), boff = lds_byte(wc * 32 + fr, fq * 8);
#define PG8_SA(b, h) (((b) * 2 + (h)) * HTB)
#define PG8_SB(b, h) ((4 + (b) * 2 + (h)) * HTB)
#define PG8_STAGE(bufoff, gbase, voff) do { _Pragma("unroll") for (int _i = 0; _i < 2; ++_i) \
        __builtin_amdgcn_global_load_lds((const unsigned*)((const char*)(gbase) + (voff)[_i]), (LAS unsigned*)(lds + (bufoff) + ldsw + _i * 8192), 16, 0, 0); } while (0)
#define PG8_LDA(dst, b, h) do { _Pragma("unroll") for (int m = 0; m < 4; ++m) _Pragma("unroll") for (int k = 0; k < 2; ++k) dst[m][k] = *(const LAS bf16x8*)(lds + PG8_SA(b, h) + aoff + m * 2048 + k * 1024); } while (0)
#define PG8_LDB(dst, b, h) do { _Pragma("unroll") for (int n = 0; n < 2; ++n) _Pragma("unroll") for (int k = 0; k < 2; ++k) dst[n][k] = *(const LAS bf16x8*)(lds + PG8_SB(b, h) + boff + n * 2048 + k * 1024); } while (0)
#define PG8_MMA(ai, bj, At, Bt) do { __builtin_amdgcn_s_setprio(1); _Pragma("unroll") for (int m = 0; m < 4; ++m) _Pragma("unroll") for (int n = 0; n < 2; ++n) _Pragma("unroll") for (int k = 0; k < 2; ++k) \
        acc[ai][bj][m][n] = __builtin_amdgcn_mfma_f32_16x16x32_bf16(Bt[n][k], At[m][k], acc[ai][bj][m][n], 0, 0, 0); __builtin_amdgcn_s_setprio(0); } while (0)
#define PG8_WAIT_V(n) asm volatile("s_waitcnt vmcnt(" #n ")" ::: "memory")
#define PG8_WAIT_L(n) asm volatile("s_waitcnt lgkmcnt(" #n ")" ::: "memory")
#define PG8_BAR __builtin_amdgcn_s_barrier()
#define PG8_SCHED __builtin_amdgcn_sched_barrier(0)
    Unit cur, nxt; int ui = 0;
    if (!S.next(0, cur)) return;
    f32x4 acc[2][2][4][2];
#pragma unroll
    for (int a = 0; a < 2; ++a)
#pragma unroll
        for (int b = 0; b < 2; ++b)
#pragma unroll
            for (int m = 0; m < 4; ++m)
#pragma unroll
                for (int n = 0; n < 2; ++n) acc[a][b][m][n] = (f32x4){0.f, 0.f, 0.f, 0.f};
    bf16x8 At[4][2], B0[2][2], B1[2][2];
    const char* cA = (const char*)(g.A + cur.a_off); const char* cB = (const char*)(g.Bt + cur.b_off);
    unsigned vA0[2], vA1[2], nA0[2], nA1[2];
    unit_voffA<GATHER>(cur, g.lda, tid, vA0, vA1);
#define PG8_STAGE_A(bufoff, gbase, h, sel) do { if constexpr (GATHER) { if (sel) { if ((h) == 0) PG8_STAGE(bufoff, gbase, nA0); else PG8_STAGE(bufoff, gbase, nA1); } else { if ((h) == 0) PG8_STAGE(bufoff, gbase, vA0); else PG8_STAGE(bufoff, gbase, vA1); } } \
        else { PG8_STAGE(bufoff, (gbase) + ((h) ? hstepA : (size_t)0), vA0); } } while (0)
    PG8_STAGE(PG8_SB(0, 0), cB, voffB); PG8_STAGE(PG8_SB(0, 1), cB + hstepB, voffB); PG8_STAGE_A(PG8_SA(0, 0), cA, 0, false); PG8_STAGE_A(PG8_SA(0, 1), cA, 1, false);
    if (wr == 1) PG8_BAR;
    PG8_WAIT_V(2); PG8_BAR;
    PG8_STAGE(PG8_SB(1, 0), cB + kstep, voffB); PG8_STAGE_A(PG8_SA(1, 0), cA + kstep, 0, false); PG8_STAGE(PG8_SB(1, 1), cB + hstepB + kstep, voffB);
    PG8_WAIT_V(6); PG8_BAR;
    for (;;) {
        const bool has_next = S.next(ui + 1, nxt);
        const char* nA = has_next ? (const char*)(g.A + nxt.a_off) : cA; const char* nB = has_next ? (const char*)(g.Bt + nxt.b_off) : cB;
        if constexpr (GATHER) { if (has_next) unit_voffA<true>(nxt, g.lda, tid, nA0, nA1); else { nA0[0] = vA0[0]; nA0[1] = vA0[1]; nA1[0] = vA1[0]; nA1[1] = vA1[1]; } }
        for (int t = 0; t < nt; t += 2) {
            const bool last = (t == nt - 2);
            const char* a1 = cA + (size_t)(t + 1) * kstep;
            const char* a2 = last ? nA : cA + (size_t)(t + 2) * kstep; const char* b2 = last ? nB : cB + (size_t)(t + 2) * kstep;
            const char* a3 = a2 + kstep; const char* b3 = b2 + kstep;
            PG8_LDB(B0, 0, 0); PG8_LDB(B1, 0, 1); PG8_SCHED; PG8_LDA(At, 0, 0); PG8_STAGE_A(PG8_SA(1, 1), a1, 1, false);
            PG8_WAIT_V(8); PG8_WAIT_L(0); PG8_BAR; PG8_MMA(0, 0, At, B0); PG8_MMA(0, 1, At, B1); PG8_BAR; PG8_SCHED;
            PG8_LDA(At, 0, 1); PG8_STAGE(PG8_SB(0, 0), b2, voffB); PG8_STAGE(PG8_SB(0, 1), b2 + hstepB, voffB); PG8_STAGE_A(PG8_SA(0, 0), a2, 0, last);
            PG8_WAIT_V(8); PG8_WAIT_L(0); PG8_BAR; PG8_MMA(1, 0, At, B0); PG8_MMA(1, 1, At, B1); PG8_BAR; PG8_SCHED;
            PG8_LDB(B0, 1, 0); PG8_LDB(B1, 1, 1); PG8_SCHED; PG8_LDA(At, 1, 0); PG8_STAGE_A(PG8_SA(0, 1), a2, 1, last);
            PG8_WAIT_V(8); PG8_WAIT_L(0); PG8_BAR; PG8_MMA(0, 0, At, B0); PG8_MMA(0, 1, At, B1); PG8_BAR; PG8_SCHED;
            PG8_LDA(At, 1, 1); PG8_STAGE(PG8_SB(1, 0), b3, voffB); PG8_STAGE(PG8_SB(1, 1), b3 + hstepB, voffB); PG8_STAGE_A(PG8_SA(1, 0), a3, 0, last);
            PG8_WAIT_V(8); PG8_WAIT_L(0); PG8_BAR; PG8_MMA(1, 0, At, B0); PG8_MMA(1, 1, At, B1); PG8_BAR; PG8_SCHED;
        }
        if constexpr (ALIGN_EPI) { if (wr == 0) PG8_BAR; }
        E(acc, cur, wr, wc, fr, fq);
        if (!has_next) break;
#pragma unroll
        for (int a = 0; a < 2; ++a)
#pragma unroll
            for (int b = 0; b < 2; ++b)
#pragma unroll
                for (int m = 0; m < 4; ++m)
#pragma unroll
                    for (int n = 0; n < 2; ++n) acc[a][b][m][n] = (f32x4){0.f, 0.f, 0.f, 0.f};
        cur = nxt; cA = nA; cB = nB; ++ui;
        if constexpr (GATHER) { vA0[0] = nA0[0]; vA0[1] = nA0[1]; vA1[0] = nA1[0]; vA1[1] = nA1[1]; }
        if constexpr (ALIGN_EPI) { if (wr == 1) PG8_BAR; }
    }
    PG8_WAIT_V(0);
    if constexpr (!ALIGN_EPI) { if (wr == 0) PG8_BAR; }
    PG8_BAR;
#undef PG8_SA
#undef PG8_SB
#undef PG8_STAGE
#undef PG8_STAGE_A
#undef PG8_LDA
#undef PG8_LDB
#undef PG8_MMA
#undef PG8_WAIT_V
#undef PG8_WAIT_L
#undef PG8_BAR
#undef PG8_SCHED
}
}
template <class Epi, class Sched>
__device__ __forceinline__ void gemm_phase_mfma(unsigned char* lds, const Gemm g, const Sched& S, const Epi& E) { pg8::gemm_phase<Epi, Sched, true>((LAS unsigned char*)lds, g, S, E); __syncthreads(); }

__device__ __forceinline__ u32x4 pack8(const f32x4 v0, const f32x4 v1) { u32x4 w; w.x = pk2(v0[0], v0[1]); w.y = pk2(v0[2], v0[3]); w.z = pk2(v1[0], v1[1]); w.w = pk2(v1[2], v1[3]); return w; }

struct EpiIn {
    static constexpr bool PERM = true;
    bf16_t* inbuf; bf16_t* pbuf; const float* rstd1;
    __device__ __forceinline__ void operator()(const f32x4 (&acc)[2][2][4][2], const Unit& u, int wr, int wc, int fr_, int fq_) const {
        int fr = fr_, fq = fq_; asm volatile("" : "+v"(fr), "+v"(fq));
        bf16_t* base; int ldc, colt; float sc0 = 1.f;
        if (u.pn < 24) { base = inbuf + (size_t)(u.pn >> 2) * T * 1024; ldc = 1024; colt = (u.pn & 3) * 256; if (u.pn < 4) sc0 = C2Q; }
        else { base = pbuf; ldc = PW; colt = (u.pn - 24) * 256; }
        const int row0 = u.pm * 256 + wr * 64 + fr, col0 = colt + wc * 32 + 8 * fq;
#pragma unroll
        for (int ai = 0; ai < 2; ++ai)
#pragma unroll
            for (int m = 0; m < 4; ++m) { const int row = row0 + ai * 128 + m * 16; const float rs = rstd1[row] * sc0; bf16_t* rowp = base + (size_t)row * ldc + col0;
#pragma unroll
                for (int bj = 0; bj < 2; ++bj) *(u32x4*)(rowp + bj * 128) = pack8(acc[ai][bj][m][0] * rs, acc[ai][bj][m][1] * rs); }
    }
};
struct EpiL2 {
    static constexpr bool PERM = true;
    float* wl; bf16_t* abuf; bf16_t* gbuf; const float* w0; const float* a0;
    __device__ __forceinline__ void operator()(const f32x4 (&acc)[2][2][4][2], const Unit& u, int wr, int wc, int fr_, int fq_) const {
        int fr = fr_, fq = fq_; asm volatile("" : "+v"(fr), "+v"(fq));
        const int grp = u.pn >> 2, colt = (u.pn & 3) * 256;
        const int row0 = u.pm * 256 + wr * 64 + fr, col0 = colt + wc * 32 + 8 * fq;
        if (grp == 0) {
#pragma unroll
            for (int bj = 0; bj < 2; ++bj) { const int c = col0 + bj * 128; const f32x4 b0 = *(const f32x4*)(w0 + c), b1 = *(const f32x4*)(w0 + c + 4);
#pragma unroll
                for (int ai = 0; ai < 2; ++ai)
#pragma unroll
                    for (int m = 0; m < 4; ++m) { const int row = row0 + ai * 128 + m * 16; f32x4 v0 = acc[ai][bj][m][0] + b0, v1 = acc[ai][bj][m][1] + b1;
#pragma unroll
                        for (int e = 0; e < 4; ++e) { v0[e] = -0.60653065971f * LOG2E * sigmoidf_(v0[e]); v1[e] = -0.60653065971f * LOG2E * sigmoidf_(v1[e]); }
                        float* p = wl + (size_t)row * 1024 + c; *(f32x4*)p = v0; *(f32x4*)(p + 4) = v1; asm volatile("" ::: "memory"); __builtin_amdgcn_sched_barrier(0); } }
        } else if (grp == 1) {
#pragma unroll
            for (int bj = 0; bj < 2; ++bj) { const int c = col0 + bj * 128; const f32x4 b0 = *(const f32x4*)(a0 + c), b1 = *(const f32x4*)(a0 + c + 4);
#pragma unroll
                for (int ai = 0; ai < 2; ++ai)
#pragma unroll
                    for (int m = 0; m < 4; ++m) { const int row = row0 + ai * 128 + m * 16; f32x4 v0 = acc[ai][bj][m][0] + b0, v1 = acc[ai][bj][m][1] + b1;
#pragma unroll
                        for (int e = 0; e < 4; ++e) { v0[e] = sigmoidf_(v0[e]); v1[e] = sigmoidf_(v1[e]); }
                        *(u32x4*)(abuf + (size_t)row * 1024 + c) = pack8(v0, v1); asm volatile("" ::: "memory"); __builtin_amdgcn_sched_barrier(0); } }
        } else {
#pragma unroll
            for (int bj = 0; bj < 2; ++bj) { const int c = col0 + bj * 128;
#pragma unroll
                for (int ai = 0; ai < 2; ++ai)
#pragma unroll
                    for (int m = 0; m < 4; ++m) { const int row = row0 + ai * 128 + m * 16; *(u32x4*)(gbuf + (size_t)row * 1024 + c) = pack8(acc[ai][bj][m][0], acc[ai][bj][m][1]); } }
        }
    }
};
struct EpiOut {
    static constexpr bool PERM = true;
    const float* x; float* h; bf16_t* hb; float* ss2;
    __device__ __forceinline__ void operator()(const f32x4 (&acc)[2][2][4][2], const Unit& u, int wr, int wc, int fr_, int fq_) const {
        int fr = fr_, fq = fq_; asm volatile("" : "+v"(fr), "+v"(fq));
        const int row0 = u.pm * 256 + wr * 64 + fr, col0 = u.pn * 256 + wc * 32 + 8 * fq;
#pragma unroll
        for (int ai = 0; ai < 2; ++ai)
#pragma unroll
            for (int m = 0; m < 4; ++m) { const int row = row0 + ai * 128 + m * 16; float ss = 0.f;
#pragma unroll
                for (int bj = 0; bj < 2; ++bj) { const size_t off = (size_t)row * DM + col0 + bj * 128;
                    const f32x4 x0 = *(const f32x4*)(x + off), x1 = *(const f32x4*)(x + off + 4);
                    const f32x4 v0 = acc[ai][bj][m][0] + x0, v1 = acc[ai][bj][m][1] + x1;
                    *(f32x4*)(h + off) = v0; *(f32x4*)(h + off + 4) = v1; *(u32x4*)(hb + off) = pack8(v0, v1);
                    ss += (v0[0] * v0[0] + v0[1] * v0[1]) + (v0[2] * v0[2] + v0[3] * v0[3]) + (v1[0] * v1[0] + v1[1] * v1[1]) + (v1[2] * v1[2] + v1[3] * v1[3]); }
                ss += __shfl_xor(ss, 16); ss += __shfl_xor(ss, 32);
                if (fq == 0) atomicAdd(ss2 + row, ss); }
    }
};
struct EpiGU {
    static constexpr bool PERM = true;
    bf16_t* hid; const float* rstd2;
    __device__ __forceinline__ void operator()(const f32x4 (&acc)[2][2][4][2], const Unit& u, int wr, int wc, int fr_, int fq_) const {
        int fr = fr_, fq = fq_; asm volatile("" : "+v"(fr), "+v"(fq));
        const int col0 = u.pn * 128 + wc * 32 + 8 * fq;
#pragma unroll
        for (int ai = 0; ai < 2; ++ai)
#pragma unroll
            for (int m = 0; m < 4; ++m) { const int rl = ai * 128 + wr * 64 + m * 16 + fr; const int tok = (rl < u.valid) ? u.gidx[rl] : 0; const float rs = rstd2[tok];
                f32x4 o0, o1;
#pragma unroll
                for (int e = 0; e < 4; ++e) { const float g0 = acc[ai][0][m][0][e] * rs, u0 = acc[ai][1][m][0][e] * rs, g1 = acc[ai][0][m][1][e] * rs, u1 = acc[ai][1][m][1][e] * rs;
                    o0[e] = g0 * sigmoidf_(g0) * u0; o1[e] = g1 * sigmoidf_(g1) * u1; }
                *(u32x4*)(hid + ((size_t)u.tile * 256 + rl) * DEXP + col0) = pack8(o0, o1); asm volatile("" ::: "memory"); __builtin_amdgcn_sched_barrier(0); }
    }
};
struct EpiDown {
    static constexpr bool PERM = true;
    bf16_t* yb; const float* gateb; const unsigned* cnt;
    __device__ __forceinline__ void operator()(const f32x4 (&acc)[2][2][4][2], const Unit& u, int wr, int wc, int fr_, int fq_) const {
        int fr = fr_, fq = fq_; asm volatile("" : "+v"(fr), "+v"(fq));
        const int col0 = u.pn * 256 + wc * 32 + 8 * fq;
        const int k = u.k;
#pragma unroll
        for (int ai = 0; ai < 2; ++ai)
#pragma unroll
            for (int m = 0; m < 4; ++m) { const int rl = ai * 128 + wr * 64 + m * 16 + fr; const float gt = (rl < u.valid) ? gateb[(size_t)u.e * CAP + 256 * k + rl] : 0.f;
#pragma unroll
                for (int bj = 0; bj < 2; ++bj) *(u32x4*)(yb + ((size_t)u.tile * 256 + rl) * DM + col0 + bj * 128) = pack8(acc[ai][bj][m][0] * gt, acc[ai][bj][m][1] * gt); }
    }
};

__device__ __forceinline__ void tr_item(const float* W, int ldw, int Kvalid, int k0, int n0, bf16_t* WT, int ldt, int trow0, float* scr, int lane,
                                        const float* gk, const float* mu, int mode) {
#pragma unroll 8
    for (int i = 0; i < 32; ++i) { const int kk = 2 * i + (lane >> 5), k = k0 + kk; float v = 0.f;
        if (k < Kvalid) { v = W[(size_t)k * ldw + n0 + (lane & 31)]; float s = gk ? gk[k] : 1.f; if (mode == 1) s *= (1.f - mu[k]); else if (mode == 2) s *= mu[k]; v *= s; }
        scr[kk * 33 + (lane & 31)] = v; }
    __builtin_amdgcn_s_waitcnt(0xC07F); asm volatile("" ::: "memory");
    const int c = lane & 7;
#pragma unroll
    for (int j = 0; j < 4; ++j) { const int n = (lane >> 3) + 8 * j; const float* s = scr + (8 * c) * 33 + n;
        u32x4 o; o.x = pk2(s[0 * 33], s[1 * 33]); o.y = pk2(s[2 * 33], s[3 * 33]); o.z = pk2(s[4 * 33], s[5 * 33]); o.w = pk2(s[6 * 33], s[7 * 33]);
        *(u32x4*)(WT + (size_t)(trow0 + n) * ldt + k0 + 8 * c) = o; }
    __builtin_amdgcn_s_waitcnt(0xC07F); asm volatile("" ::: "memory");
}

__device__ __forceinline__ void phase_prologue(const Params& p, unsigned char* lds) {
    const int tid = opaque_tid(), lane = tid & 63, wave = tid >> 6;
    const int gw = blockIdx.x * NWAVES + wave, NGW = gridDim.x * NWAVES;
    unsigned char* ws = p.ws;
    float* scr = (float*)(lds + wave * 16384);
    bf16_t* WinT = (bf16_t*)(ws + WS_WIN); bf16_t* WoutT = (bf16_t*)(ws + WS_WOUT); bf16_t* L2T = (bf16_t*)(ws + WS_L2T);
    const float* g_mix = p.in[1]; const float* mu_x = p.in[9];
    constexpr int I_WIN = 32 * 192;
    constexpr int I_L1 = 32 * 2 * 2 + 32 * 2 * 2 + 32 * 5 * 2;
    constexpr int I_WOUT = 32 * 64;
    constexpr int I_L2 = 3 * 4 * 32;
    constexpr int NITEMS = I_WIN + I_L1 + I_WOUT + I_L2;
    for (int it = gw; it < NITEMS; it += NGW) {
        int r = it;
        if (r < I_WIN) { const int kb = r / 192, nb = r % 192; tr_item(p.in[2], 6144, 2048, 64 * kb, 32 * nb, WinT, 2048, 32 * nb, scr, lane, g_mix, nullptr, 0); continue; } r -= I_WIN;
        if (r < I_L1) {
            int which, nb, mode, kb;
            if (r < 128) { which = 0; } else if (r < 256) { which = 1; r -= 128; } else { which = 2; r -= 256; }
            const int nnb = (which == 2) ? 5 : 2;
            kb = r / (nnb * 2); const int rr = r % (nnb * 2); nb = rr / 2; mode = 1 + (rr & 1);
            const float* W = which == 0 ? p.in[12] : which == 1 ? p.in[15] : p.in[17];
            const int ldw = which == 2 ? 160 : 64;
            const int rowbase = 6144 + (which == 0 ? 0 : which == 1 ? 128 : 256) + (mode == 2 ? ldw : 0);
            tr_item(W, ldw, 2048, 64 * kb, 32 * nb, WinT, 2048, rowbase + 32 * nb, scr, lane, g_mix, mu_x + which * 2048, mode); continue; } r -= I_L1;
        if (r < I_WOUT) { const int kb = r / 64, nb = r % 64; tr_item(p.in[3], 2048, 2048, 64 * kb, 32 * nb, WoutT, 2048, 32 * nb, scr, lane, nullptr, nullptr, 0); continue; } r -= I_WOUT;
        { const int which = r / 128, rr = r % 128, kb = rr / 32, nb = rr % 32;
          const float* W = which == 0 ? p.in[13] : which == 1 ? p.in[16] : p.in[18]; const int kv = which == 2 ? 160 : 64;
          tr_item(W, 1024, kv, 64 * kb, 32 * nb, L2T, 256, which * 1024 + 32 * nb, scr, lane, nullptr, nullptr, 0); }
    }
    for (int ch = blockIdx.x * NTHREADS + tid; ch < 192 * 256; ch += gridDim.x * NTHREADS) *(u32x4*)(WinT + (size_t)6720 * 2048 + (size_t)ch * 8) = (u32x4){0u, 0u, 0u, 0u};
    const float* x = p.in[0]; bf16_t* xb = (bf16_t*)(ws + WS_XB); float* rstd1 = (float*)(ws + WS_RSTD1);
    for (int m = gw; m < T; m += NGW) {
        const f32x4* xr = (const f32x4*)(x + (size_t)m * DM) + lane; f32x4 v[8]; float s = 0.f;
#pragma unroll
        for (int j = 0; j < 8; ++j) { v[j] = xr[64 * j]; s += (v[j][0] * v[j][0] + v[j][1] * v[j][1]) + (v[j][2] * v[j][2] + v[j][3] * v[j][3]); }
        s = wave_sum(s);
        u32x2* o = (u32x2*)(xb + (size_t)m * DM) + lane;
#pragma unroll
        for (int j = 0; j < 8; ++j) { u32x2 w; w.x = pk2(v[j][0], v[j][1]); w.y = pk2(v[j][2], v[j][3]); o[64 * j] = w; }
        if (lane == 0) rstd1[m] = 1.0f / sqrtf(s * (1.0f / DM) + 1e-6f);
    }
}

__device__ __forceinline__ void convert_experts(const Params& p, unsigned char* lds) {
    const int tid = opaque_tid(), lane = tid & 63, wave = tid >> 6;
    const int gw = blockIdx.x * NWAVES + wave, NGW = gridDim.x * NWAVES;
    float* scr = (float*)(lds + 65536 + wave * 8704);
    bf16_t* Wgu = (bf16_t*)(p.ws + WS_WGU); bf16_t* Wd = (bf16_t*)(p.ws + WS_WD); const float* gf = p.in[24];
    constexpr int I_G = 32 * 32 * 16;
    constexpr int I_D = 32 * 8 * 64;
    for (int it = gw; it < 2 * I_G + I_D; it += NGW) {
        int r = it;
        if (r < 2 * I_G) { const int up = r >= I_G; if (up) r -= I_G; const int e = r / 512, rr = r % 512, kb = rr / 16, nb = rr % 16; const int n0 = 32 * nb;
            tr_item((up ? p.in[30] : p.in[29]) + (size_t)e * 2048 * 512, 512, 2048, 64 * kb, n0, Wgu + (size_t)e * 1024 * 2048, 2048, 256 * (n0 >> 7) + (n0 & 127) + (up ? 128 : 0), scr, lane, gf, nullptr, 0); continue; }
        r -= 2 * I_G;
        { const int e = r / 512, rr = r % 512, kb = rr / 64, nb = rr % 64;
          tr_item(p.in[31] + (size_t)e * 512 * 2048, 2048, 512, 64 * kb, 32 * nb, Wd + (size_t)e * 2048 * 512, 512, 32 * nb, scr, lane, nullptr, nullptr, 0); }
    }
}

__device__ __forceinline__ void phase_l2prep(const Params& p) {
    const bf16_t* P = (const bf16_t*)(p.ws + WS_PBUF); bf16_t* A2 = (bf16_t*)(p.ws + WS_A2);
    const int nchunk = T * 96;
    const int tid = opaque_tid();
    for (int id = blockIdx.x * NTHREADS + tid; id < nchunk; id += gridDim.x * NTHREADS) {
        const int t = id / 96, ch = id % 96, gi = ch >> 5, jc = (ch & 31) * 8;
        const int width = gi == 2 ? 160 : 64, pa = gi == 0 ? 0 : gi == 1 ? 128 : 256, pb = pa + width;
        u32x4 o = (u32x4){0u, 0u, 0u, 0u};
        if (jc < width) {
            const u32x4 va = *(const u32x4*)(P + (size_t)t * PW + pa + jc);
            u32x4 vb = (u32x4){0u, 0u, 0u, 0u};
            if ((t & (SEQ - 1)) != 0) vb = *(const u32x4*)(P + (size_t)(t - 1) * PW + pb + jc);
            float f[8];
#pragma unroll
            for (int i = 0; i < 4; ++i) { f[2 * i] = bflo(va[i]) + bflo(vb[i]); f[2 * i + 1] = bfhi(va[i]) + bfhi(vb[i]); }
#pragma unroll
            for (int i = 0; i < 8; ++i) { if (gi == 0) f[i] = 1.0f - 2.0f / (__expf(2.0f * f[i]) + 1.0f); else if (gi == 2) f[i] = sigmoidf_(f[i]); }
            o.x = pk2(f[0], f[1]); o.y = pk2(f[2], f[3]); o.z = pk2(f[4], f[5]); o.w = pk2(f[6], f[7]);
        }
        *(u32x4*)(A2 + (size_t)t * PW + ch * 8) = o;
    }
}

constexpr int TC = 32;
__device__ __forceinline__ void rwkv_chain(const Params& p, unsigned char* lds, int chain) {
    const int tid = opaque_tid(), lane = tid & 63, wave = tid >> 6;
    const int b = chain >> 4, h = chain & 15, c = h * 64 + lane;
    float* Rs = (float*)lds; float* Ws = Rs + TC * 64; float* Ks = Ws + TC * 64; float* Vs = Ks + TC * 64; float* KKs = Vs + TC * 64; float* Bs = KKs + TC * 64;
    float* Ys = Bs + TC * 64; float* Gs = Ys + TC * 64; float* BON = Gs + TC * 64;
    const bf16_t* rb = (const bf16_t*)(p.ws + WS_INBUF) + (size_t)3 * T * 1024; const bf16_t* kb = rb + (size_t)T * 1024; const bf16_t* vb = kb + (size_t)T * 1024;
    const float* wl = (const float*)(p.ws + WS_WL); const bf16_t* ab = (const bf16_t*)(p.ws + WS_ABUF); const bf16_t* gb = (const bf16_t*)(p.ws + WS_GBUF);
    bf16_t* O = (bf16_t*)(p.ws + WS_O);
    const float mu_r = p.in[10][c], mu_k = p.in[10][1024 + c], mu_v = p.in[10][2048 + c];
    const float k_k = p.in[19][c], k_a = p.in[20][c], r_k = p.in[21][c], ln_w = p.in[22][c], ln_b = p.in[23][c];
    const int r8 = lane >> 3, q = lane & 7, irow = 8 * wave + r8;
    float S[8];
#pragma unroll
    for (int e = 0; e < 8; ++e) S[e] = 0.f;
    for (int t0 = 0; t0 < SEQ; t0 += TC) {
#pragma unroll
        for (int s = 0; s < TC / NWAVES; ++s) {
            const int tl = wave * (TC / NWAVES) + s, t = t0 + tl; const size_t m = (size_t)b * SEQ + t, off = m * 1024 + c;
            const float rc = bf2f(rb[off]), kc = bf2f(kb[off]), vc = bf2f(vb[off]);
            float rp = 0.f, kp = 0.f, vp = 0.f;
            if (t > 0) { rp = bf2f(rb[off - 1024]); kp = bf2f(kb[off - 1024]); vp = bf2f(vb[off - 1024]); }
            const float rr = rc + (rp - rc) * mu_r, kx = kc + (kp - kc) * mu_k, vv = vc + (vp - vc) * mu_v;
            const float w = __builtin_amdgcn_exp2f(wl[off]), a = bf2f(ab[off]);
            const float kkv = kx * k_k; const float n2 = wave_sum(kkv * kkv); const float kkn = kkv / fmaxf(sqrtf(n2), 1e-12f);
            const float kmod = kx * (1.0f + (a - 1.0f) * k_a);
            const float bon = wave_sum(rr * kmod * r_k);
            Rs[tl * 64 + lane] = rr; Ws[tl * 64 + lane] = w; Ks[tl * 64 + lane] = kmod; Vs[tl * 64 + lane] = vv; KKs[tl * 64 + lane] = -kkn; Bs[tl * 64 + lane] = kkn * a;
            Gs[tl * 64 + lane] = bf2f(gb[off]); if (lane == 0) BON[tl] = bon;
        }
        __syncthreads();
        for (int tl = 0; tl < TC; ++tl) {
            const f32x4 kk0 = *(const f32x4*)(KKs + tl * 64 + 8 * q), kk1 = *(const f32x4*)(KKs + tl * 64 + 8 * q + 4);
            const f32x4 w0 = *(const f32x4*)(Ws + tl * 64 + 8 * q), w1 = *(const f32x4*)(Ws + tl * 64 + 8 * q + 4);
            const f32x4 b0 = *(const f32x4*)(Bs + tl * 64 + 8 * q), b1 = *(const f32x4*)(Bs + tl * 64 + 8 * q + 4);
            const f32x4 k0 = *(const f32x4*)(Ks + tl * 64 + 8 * q), k1 = *(const f32x4*)(Ks + tl * 64 + 8 * q + 4);
            const f32x4 r0 = *(const f32x4*)(Rs + tl * 64 + 8 * q), r1 = *(const f32x4*)(Rs + tl * 64 + 8 * q + 4);
            const float v = Vs[tl * 64 + irow];
            float sa = (S[0] * kk0[0] + S[1] * kk0[1]) + (S[2] * kk0[2] + S[3] * kk0[3]) + (S[4] * kk1[0] + S[5] * kk1[1]) + (S[6] * kk1[2] + S[7] * kk1[3]);
            sa += __shfl_xor(sa, 1); sa += __shfl_xor(sa, 2); sa += __shfl_xor(sa, 4);
#pragma unroll
            for (int e = 0; e < 4; ++e) { S[e] = S[e] * w0[e] + (sa * b0[e] + v * k0[e]); S[4 + e] = S[4 + e] * w1[e] + (sa * b1[e] + v * k1[e]); }
            float y = (S[0] * r0[0] + S[1] * r0[1]) + (S[2] * r0[2] + S[3] * r0[3]) + (S[4] * r1[0] + S[5] * r1[1]) + (S[6] * r1[2] + S[7] * r1[3]);
            y += __shfl_xor(y, 1); y += __shfl_xor(y, 2); y += __shfl_xor(y, 4);
            if (q == 0) Ys[tl * 64 + irow] = y;
        }
        __syncthreads();
#pragma unroll
        for (int s = 0; s < TC / NWAVES; ++s) {
            const int tl = wave * (TC / NWAVES) + s, t = t0 + tl; const size_t m = (size_t)b * SEQ + t;
            const float y = Ys[tl * 64 + lane]; const float mean = wave_sum(y) * (1.0f / 64.0f); const float d = y - mean; const float var = wave_sum(d * d) * (1.0f / 64.0f);
            float yn = d * (1.0f / sqrtf(var + 64e-5f)) * ln_w + ln_b;
            yn += BON[tl] * Vs[tl * 64 + lane];
            O[m * DM + 1024 + c] = (bf16_t)f2bf(yn * Gs[tl * 64 + lane]);
        }
        __syncthreads();
    }
}

#include <hip/hip_bf16.h>
#include <cmath>
namespace attn_body {
using bf16=__hip_bfloat16;
using bf16x8=__attribute__((ext_vector_type(8)))short;
using s16x4=__attribute__((ext_vector_type(4)))short;
using f32x16=__attribute__((ext_vector_type(16)))float;
using u32x4=__attribute__((ext_vector_type(4)))unsigned;
constexpr int SEQ=2048,D=64,DM=1024;
constexpr int NW=8,QBLK=32,QB=QBLK*NW,KVBLK=64,NQB=SEQ/QB;
__device__ __forceinline__ int crow(int r,int hi){return (r&3)+8*(r>>2)+4*hi;}
#define SBAR() __builtin_amdgcn_sched_barrier(0)
__device__ __forceinline__ void cmask(f32x16&p0,f32x16&p1,int jb,int qrel,int hi){
  const float NEG=-INFINITY; int kb=64*jb+4*hi;
  #pragma unroll
  for(int r=0;r<16;++r){int kv=kb+(r&3)+8*(r>>2); if(kv>qrel)p0[r]=NEG; if(kv+32>qrel)p1[r]=NEG;}
}

constexpr int NSLOT=3, SLOTB=8192;
constexpr int LDS_K=0, LDS_V=NSLOT*SLOTB, LDS_WS=2*NSLOT*SLOTB, LDS_OST=LDS_WS+NW*64*4, LDS_BYTES=LDS_OST+NW*4096;
constexpr float C2=0.125f*1.4426950408889634f;
__device__ __forceinline__ void glds16(const void*gsrc,unsigned lds_dst){unsigned keep;
  asm volatile("s_mov_b32 %0, m0\n\ts_mov_b32 m0, %2\n\ts_nop 0\n\tglobal_load_lds_dwordx4 %1, off\n\ts_mov_b32 m0, %0":"=&s"(keep):"v"(gsrc),"s"(lds_dst):"memory");}
__device__ __forceinline__ float max3f(float a,float b,float c){float r;asm("v_max3_f32 %0, %1, %2, %3":"=v"(r):"v"(a),"v"(b),"v"(c));return r;}
__device__ __forceinline__ float max2f(float a,float b){float r;asm("v_max_f32_e32 %0, %1, %2":"=v"(r):"v"(a),"v"(b));return r;}
__device__ __forceinline__ float fadd_s(float a,float b){float r;asm("v_add_f32_e32 %0, %1, %2":"=v"(r):"v"(a),"v"(b));return r;}
__device__ __forceinline__ float fsub_s(float a,float b){float r;asm("v_sub_f32_e32 %0, %1, %2":"=v"(r):"v"(a),"v"(b));return r;}
typedef float f32x2_t __attribute__((ext_vector_type(2))); typedef __bf16 bf16x2_t __attribute__((ext_vector_type(2)));
__device__ __forceinline__ unsigned cvtpk_s(float lo,float hi){f32x2_t v={lo,hi};bf16x2_t b=__builtin_convertvector(v,bf16x2_t);return __builtin_bit_cast(unsigned,b);}
#define WAIT_BAR(N) asm volatile("s_waitcnt vmcnt(" #N ") lgkmcnt(0)\n\ts_barrier":::"memory")

__device__ __forceinline__ void qkt(f32x16&p0,f32x16&p1,const char*Kslot,const bf16x8*qr,const f32x16&negm,int r32,int hi){
  const char*kb=Kslot+hi*1024+r32*16;
  #pragma unroll
  for(int d0=0;d0<4;++d0){
    const bf16x8 b0=*reinterpret_cast<const bf16x8*>(kb+d0*2048);
    const bf16x8 b1=*reinterpret_cast<const bf16x8*>(kb+d0*2048+512);
    if(d0==0){p0=__builtin_amdgcn_mfma_f32_32x32x16_bf16(b0,qr[0],negm,0,0,0);p1=__builtin_amdgcn_mfma_f32_32x32x16_bf16(b1,qr[0],negm,0,0,0);}
    else{p0=__builtin_amdgcn_mfma_f32_32x32x16_bf16(b0,qr[d0],p0,0,0,0);p1=__builtin_amdgcn_mfma_f32_32x32x16_bf16(b1,qr[d0],p1,0,0,0);}}
}
typedef __attribute__((address_space(3))) const char* lds_cptr;
typedef short v4i16_t __attribute__((ext_vector_type(4)));
__device__ __forceinline__ void kload8(bf16x8*kf,lds_cptr kp){
  kf[0]=*(const __attribute__((address_space(3))) bf16x8*)(kp);      kf[1]=*(const __attribute__((address_space(3))) bf16x8*)(kp+512);
  kf[2]=*(const __attribute__((address_space(3))) bf16x8*)(kp+2048); kf[3]=*(const __attribute__((address_space(3))) bf16x8*)(kp+2560);
  kf[4]=*(const __attribute__((address_space(3))) bf16x8*)(kp+4096); kf[5]=*(const __attribute__((address_space(3))) bf16x8*)(kp+4608);
  kf[6]=*(const __attribute__((address_space(3))) bf16x8*)(kp+6144); kf[7]=*(const __attribute__((address_space(3))) bf16x8*)(kp+6656);
}
__device__ __forceinline__ void kload2(bf16x8*kf,lds_cptr kp,int j){ kf[2*j]=*(const __attribute__((address_space(3))) bf16x8*)(kp+j*2048); kf[2*j+1]=*(const __attribute__((address_space(3))) bf16x8*)(kp+j*2048+512); }
__device__ __forceinline__ s16x4 vtr(lds_cptr p){ return __builtin_bit_cast(s16x4,__builtin_amdgcn_ds_read_tr16_b64_v4i16((__attribute__((address_space(3))) v4i16_t*)p)); }
__device__ __forceinline__ float rowmax(const f32x16&p0,const f32x16&p1){
  float a=max3f(p0[0],p0[1],p1[0]),b=max3f(p0[2],p0[3],p1[1]);a=max3f(a,p1[2],p1[3]);
  #pragma unroll
  for(int r=4;r<16;r+=4){a=max3f(a,p0[r],p0[r+1]);b=max3f(b,p0[r+2],p0[r+3]);a=max3f(a,p1[r],p1[r+1]);b=max3f(b,p1[r+2],p1[r+3]);}
  const float m=max2f(a,b);
  auto rr=__builtin_amdgcn_permlane32_swap(__float_as_uint(m),__float_as_uint(m),false,false);
  return max2f(__uint_as_float(rr[0]),__uint_as_float(rr[1]));
}
__device__ __forceinline__ void pv(f32x16*o,int vb,bf16x8 pa0,bf16x8 pa1,bf16x8 pa2,bf16x8 pa3){
  #pragma unroll
  for(int d0=0;d0<2;++d0){s16x4 lo[4],hi[4];
    #pragma unroll
    for(int ks=0;ks<4;++ks){
      asm volatile("ds_read_b64_tr_b16 %0,%1 offset:%c2":"=&v"(lo[ks]):"v"(vb),"i"(d0*4096+ks*1024):"memory");
      asm volatile("ds_read_b64_tr_b16 %0,%1 offset:%c2":"=&v"(hi[ks]):"v"(vb),"i"(d0*4096+ks*1024+512):"memory");}
    asm volatile("s_waitcnt lgkmcnt(0)":::"memory");SBAR();
    #define PK(k) (bf16x8){lo[k][0],lo[k][1],lo[k][2],lo[k][3],hi[k][0],hi[k][1],hi[k][2],hi[k][3]}
    o[d0]=__builtin_amdgcn_mfma_f32_32x32x16_bf16(pa0,PK(0),o[d0],0,0,0);
    o[d0]=__builtin_amdgcn_mfma_f32_32x32x16_bf16(pa1,PK(1),o[d0],0,0,0);
    o[d0]=__builtin_amdgcn_mfma_f32_32x32x16_bf16(pa2,PK(2),o[d0],0,0,0);
    o[d0]=__builtin_amdgcn_mfma_f32_32x32x16_bf16(pa3,PK(3),o[d0],0,0,0);
    #undef PK
  }
}

#ifndef ATTN_STORE16
#define ATTN_STORE16(p,v) (*(u32x4*)(p)=(v))
#endif
template<int THRL> __device__ __forceinline__ void attn_unit(int b,int qkcol,int vcol,int qb,float slope2,const bf16*Q,const bf16*__restrict__ K,const bf16*__restrict__ V,bf16*O,char*shm){
  const int tid=opaque_tid(),lane=tid&63,r32=lane&31,hi=lane>>5; const int wid=__builtin_amdgcn_readfirstlane(tid>>6);
  const long rowbase=(long)b*SEQ; const int q0=qb*QB;
  const bf16*Qw=Q+(rowbase+q0+wid*QBLK)*DM+qkcol;
  const bf16*Kh=K+rowbase*DM+qkcol,*Vh=V+rowbase*DM+vcol;
  const unsigned lds0=(unsigned)(uintptr_t)shm;
  float*wsf=(float*)(shm+LDS_WS)+wid*64;
  const bf16*ksrc=Kh+(long)lane*DM+wid*8;
  const bf16*vsrc=Vh+(long)(16*(wid&3)+(lane>>2))*DM+(wid>>2)*32+(lane&3)*8;
  const unsigned kdst=lds0+LDS_K+wid*1024, vdst=lds0+LDS_V+wid*1024;
  #define DMA_K(t,slot) glds16(ksrc+(long)(t)*KVBLK*DM,(unsigned)__builtin_amdgcn_readfirstlane(kdst+(slot)))
  #define DMA_V(t,slot) glds16(vsrc+(long)(t)*KVBLK*DM,(unsigned)__builtin_amdgcn_readfirstlane(vdst+(slot)))
  const int vb0=(int)(lds0+LDS_V)+((lane>>4)&1)*32+(lane&3)*8+(4*hi+((lane&15)>>2))*64;
  const char*Kbase=shm+LDS_K; bf16x8 kf[8];
  const lds_cptr shm3=(lds_cptr)shm; const lds_cptr kp0=shm3+LDS_K+hi*1024+r32*16; const lds_cptr vp0=shm3+LDS_V+((lane>>4)&1)*32+(lane&3)*8+(4*hi+((lane&15)>>2))*64;
  const int NT=(q0+QB)/KVBLK;
  DMA_K(0,0);DMA_V(0,0);DMA_K(1,SLOTB);
  bf16x8 qr[4];
  #pragma unroll
  for(int d0=0;d0<4;++d0)qr[d0]=*reinterpret_cast<const bf16x8*>(&Qw[(long)r32*DM+d0*16+hi*8]);
  float mhat=0.f,l_reg=0.f;f32x16 o[2];o[0]=f32x16{};o[1]=f32x16{};const f32x16 negm=f32x16{};
  const int qrel=wid*QBLK+r32; float slope2v=slope2; asm volatile("":"+v"(slope2v));
  #define CMASK(P0,P1,t) do{int jb_=(t)-(NT-4); if(jb_>=0)cmask(P0,P1,jb_,qrel,hi);}while(0)
  #define ABIAS(P0,P1,t) do{ float kb_=slope2*(float)(64*(t)+4*hi)-mhat; asm volatile("":"+v"(kb_)); _Pragma("unroll") for(int r=0;r<16;++r){ P0[r]+=kb_; P1[r]+=kb_; } _Pragma("unroll") for(int r=0;r<16;++r){ const float cr_=(float)((r&3)+8*(r>>2)); P0[r]=__builtin_fmaf(slope2v,cr_,P0[r]); P1[r]=__builtin_fmaf(slope2v,cr_+32.f,P1[r]); } }while(0)
  bool resc=false;
  #define START(P0,P1) do{ const float rm=rowmax(P0,P1); resc=false; \
    { const float dl=rm; mhat=fadd_s(mhat,dl); \
      _Pragma("unroll") for(int r=0;r<16;++r){P0[r]=fsub_s(P0[r],dl);P1[r]=fsub_s(P1[r],dl);} \
      } \
    _Pragma("unroll") for(int r=0;r<16;++r)P0[r]=__builtin_amdgcn_exp2f(P0[r]); }while(0)
  #define RESC() do{ if(resc){ asm volatile("s_waitcnt lgkmcnt(0)":::"memory"); \
      _Pragma("unroll") for(int d_=0;d_<2;++d_) _Pragma("unroll") for(int r=0;r<16;++r)o[d_][r]*=wsf[crow(r,hi)]; } }while(0)
  f32x16 pA0,pA1,pB0,pB1;
  int sl_prev=0,sl_cur=0,sl_next=SLOTB;
  #define ROT() do{sl_prev=sl_cur;sl_cur=sl_next;sl_next=(sl_next==(NSLOT-1)*SLOTB)?0:sl_next+SLOTB;}while(0)
  DMA_K(2,2*SLOTB);
  WAIT_BAR(3);
  qkt(pA0,pA1,Kbase,qr,negm,r32,hi);asm volatile("s_nop 15\n\ts_nop 7":"+v"(pA0),"+v"(pA1));ABIAS(pA0,pA1,0);CMASK(pA0,pA1,0);
  START(pA0,pA1);
  _Pragma("unroll") for(int r=0;r<16;++r)pA1[r]=__builtin_amdgcn_exp2f(pA1[r]);
  WAIT_BAR(0);
  DMA_K(3,0);DMA_V(1,SLOTB);
  ROT();
  kload8(kf,kp0+sl_cur);
  WAIT_BAR(2);
  s16x4 vlo[8],vhi[8]; u32x4 pw0,pw1,pw2,pw3;
  #define PKW(P,B) cvtpk_s(P[B],P[B+1])
  #define PAF(k) __builtin_bit_cast(bf16x8,pw##k)
  #define VFR(i) (bf16x8){vlo[i][0],vlo[i][1],vlo[i][2],vlo[i][3],vhi[i][0],vhi[i][1],vhi[i][2],vhi[i][3]}
  #define PIN(x) asm volatile("":"+v"(x))
  #define MX3(a,b,c) __builtin_fmaxf(__builtin_fmaxf((a),(b)),(c))
  #define GAPA(MF,A0,A1,A2,A3,W0,W1,PW) do{ MF; sacc+=A0; sacc+=A1; sacc+=A2; sacc+=A3; PIN(sacc); W0; W1; PIN(PW); SBAR(); }while(0)
  #define EX(v) __builtin_amdgcn_exp2f(v)
  #define GAPB(MF,X,B) do{ MF; X[B]=EX(X[B]); X[B+1]=EX(X[B+1]); X[B+2]=EX(X[B+2]); X[B+3]=EX(X[B+3]); PIN(X); SBAR(); }while(0)
  #define VRD(i) do{ vlo[i]=vtr(vp_+(((i)>>2)*4096+((i)&3)*1024)); vhi[i]=vtr(vp_+(((i)>>2)*4096+((i)&3)*1024+512)); }while(0)
  #define KRD(G,j) do{ if(G){ kload2(kf,kp0+sl_next,j); SBAR(); } }while(0)
  #define STEP(C0,C1,P0,P1,t,GK,GV,GL) do{ SBAR(); \
    const lds_cptr vp_=vp0+sl_prev; \
    VRD(0); SBAR(); float sacc=(P0[0]+P0[1]); \
    GAPA(C0=__builtin_amdgcn_mfma_f32_32x32x16_bf16(kf[0],qr[0],negm,0,0,0), P0[2],P0[3],P0[4],P0[5],     pw0[0]=PKW(P0,0), pw0[1]=PKW(P0,2), pw0); \
    VRD(4); SBAR(); GAPA(C1=__builtin_amdgcn_mfma_f32_32x32x16_bf16(kf[1],qr[0],negm,0,0,0), P0[6],P0[7],P0[8],P0[9],     pw0[2]=PKW(P0,4), pw0[3]=PKW(P0,6), pw0); \
    VRD(1); SBAR(); GAPA(C0=__builtin_amdgcn_mfma_f32_32x32x16_bf16(kf[2],qr[1],C0,0,0,0),   P0[10],P0[11],P0[12],P0[13], pw1[0]=PKW(P0,8), pw1[1]=PKW(P0,10), pw1); \
    VRD(5); SBAR(); GAPA(C1=__builtin_amdgcn_mfma_f32_32x32x16_bf16(kf[3],qr[1],C1,0,0,0),   P0[14],P0[15],P1[0],P1[1],   pw1[2]=PKW(P0,12),pw1[3]=PKW(P0,14), pw1); \
    VRD(2); SBAR(); GAPA(C0=__builtin_amdgcn_mfma_f32_32x32x16_bf16(kf[4],qr[2],C0,0,0,0),   P1[2],P1[3],P1[4],P1[5],     pw2[0]=PKW(P1,0), pw2[1]=PKW(P1,2), pw2); \
    VRD(6); SBAR(); GAPA(C1=__builtin_amdgcn_mfma_f32_32x32x16_bf16(kf[5],qr[2],C1,0,0,0),   P1[6],P1[7],P1[8],P1[9],     pw2[2]=PKW(P1,4), pw2[3]=PKW(P1,6), pw2); \
    VRD(3); SBAR(); GAPA(C0=__builtin_amdgcn_mfma_f32_32x32x16_bf16(kf[6],qr[3],C0,0,0,0),   P1[10],P1[11],P1[12],P1[13], pw3[0]=PKW(P1,8), pw3[1]=PKW(P1,10), pw3); \
    VRD(7); SBAR(); GAPA(C1=__builtin_amdgcn_mfma_f32_32x32x16_bf16(kf[7],qr[3],C1,0,0,0),   P1[14],P1[15],0.f,0.f,       pw3[2]=PKW(P1,12),pw3[3]=PKW(P1,14), pw3); \
    l_reg+=sacc; \
    if(GK){DMA_K((t)+3,sl_cur);} if(GV){DMA_V((t)+1,sl_next);} \
    ABIAS(C0,C1,t); CMASK(C0,C1,t); \
    { float a=MX3(C0[0],C0[1],C1[0]),b=MX3(C0[2],C0[3],C1[1]); a=MX3(a,C1[2],C1[3]); \
      _Pragma("unroll") for(int r=4;r<16;r+=4){a=MX3(a,C0[r],C0[r+1]);b=MX3(b,C0[r+2],C0[r+3]);a=MX3(a,C1[r],C1[r+1]);b=MX3(b,C1[r+2],C1[r+3]);} \
      float rm=__builtin_fmaxf(a,b); { auto rr=__builtin_amdgcn_permlane32_swap(__float_as_uint(rm),__float_as_uint(rm),false,false); rm=__builtin_fmaxf(__uint_as_float(rr[0]),__uint_as_float(rr[1])); } \
      resc=false; \
      if(__builtin_expect(__any(rm>(float)THRL),0)){ const float dl=__builtin_fmaxf(rm,0.f); mhat+=dl; \
        _Pragma("unroll") for(int r=0;r<16;++r){C0[r]-=dl;C1[r]-=dl;} \
        const float f=__builtin_amdgcn_exp2f(-dl); l_reg*=f; if(hi==0)wsf[r32]=f; resc=true; } } \
    SBAR(); \
    GAPB(o[0]=__builtin_amdgcn_mfma_f32_32x32x16_bf16(PAF(0),VFR(0),o[0],0,0,0), C0,0); \
    GAPB(o[1]=__builtin_amdgcn_mfma_f32_32x32x16_bf16(PAF(0),VFR(4),o[1],0,0,0), C0,4); \
    KRD(GL,0); GAPB(o[0]=__builtin_amdgcn_mfma_f32_32x32x16_bf16(PAF(1),VFR(1),o[0],0,0,0), C0,8); \
    KRD(GL,1); GAPB(o[1]=__builtin_amdgcn_mfma_f32_32x32x16_bf16(PAF(1),VFR(5),o[1],0,0,0), C0,12); \
    KRD(GL,2); GAPB(o[0]=__builtin_amdgcn_mfma_f32_32x32x16_bf16(PAF(2),VFR(2),o[0],0,0,0), C1,0); \
    KRD(GL,3); GAPB(o[1]=__builtin_amdgcn_mfma_f32_32x32x16_bf16(PAF(2),VFR(6),o[1],0,0,0), C1,4); \
    GAPB(o[0]=__builtin_amdgcn_mfma_f32_32x32x16_bf16(PAF(3),VFR(3),o[0],0,0,0), C1,8); \
    GAPB(o[1]=__builtin_amdgcn_mfma_f32_32x32x16_bf16(PAF(3),VFR(7),o[1],0,0,0), C1,12); \
    }while(0)
  int t=1;
  #undef CMASK
  #define CMASK(P0,P1,t) do{}while(0)
  for(;t+5<NT;t+=2){
    STEP(pB0,pB1,pA0,pA1,t,true,true,true);     WAIT_BAR(2); RESC(); ROT();
    STEP(pA0,pA1,pB0,pB1,t+1,true,true,true);   WAIT_BAR(2); RESC(); ROT();
  }
  #undef CMASK
  #define CMASK(P0,P1,t) do{int jb_=(t)-(NT-4); if(jb_>=0)cmask(P0,P1,jb_,qrel,hi);}while(0)
  #define ENDW(tt) do{ if((tt)+3<NT){WAIT_BAR(2);} else if((tt)+2<NT){WAIT_BAR(1);} else {WAIT_BAR(0);} }while(0)
  for(;t+1<NT;t+=2){
    STEP(pB0,pB1,pA0,pA1,t,(t+3<NT),(t+1<NT),(t+1<NT));       ENDW(t);   RESC(); ROT();
    STEP(pA0,pA1,pB0,pB1,t+1,(t+4<NT),(t+2<NT),(t+2<NT));     ENDW(t+1); RESC(); ROT();
  }
  STEP(pB0,pB1,pA0,pA1,NT-1,false,false,false); RESC();
  { float sacc=pB0[0]+pB0[1]; _Pragma("unroll") for(int r=2;r<16;++r)sacc+=pB0[r]; _Pragma("unroll") for(int r=0;r<16;++r)sacc+=pB1[r]; l_reg+=sacc;
    pw0=(u32x4){PKW(pB0,0),PKW(pB0,2),PKW(pB0,4),PKW(pB0,6)};pw1=(u32x4){PKW(pB0,8),PKW(pB0,10),PKW(pB0,12),PKW(pB0,14)};pw2=(u32x4){PKW(pB1,0),PKW(pB1,2),PKW(pB1,4),PKW(pB1,6)};pw3=(u32x4){PKW(pB1,8),PKW(pB1,10),PKW(pB1,12),PKW(pB1,14)};
    SBAR(); pv(o,vb0+sl_cur,PAF(0),PAF(1),PAF(2),PAF(3)); }
  #undef PKW
  #undef PAF
  #undef VFR
  #undef PIN
  #undef MX3
  #undef GAPA
  #undef GAPB
  #undef EX
  #undef VRD
  #undef KRD
  #undef STEP
  #undef ENDW
  {auto rr=__builtin_amdgcn_permlane32_swap(__float_as_uint(l_reg),__float_as_uint(l_reg),false,false);l_reg=__uint_as_float(rr[0])+__uint_as_float(rr[1]);}
  int lane_e=lane; asm volatile("":"+v"(lane_e)); const int r32e=lane_e&31, hie=lane_e>>5;
  if(hie==0)wsf[32+r32e]=l_reg;asm volatile("s_waitcnt lgkmcnt(0)":::"memory");
  float rli[16];
  #pragma unroll
  for(int r=0;r<16;++r)rli[r]=__builtin_amdgcn_rcpf(wsf[32+crow(r,hie)]);
  bf16*Ow=O+(rowbase+q0+wid*QBLK)*DM+vcol;
  { bf16*stg=(bf16*)(shm+LDS_OST)+wid*2048;
    #pragma unroll
    for(int r=0;r<16;++r){const int orow=crow(r,hie);
      #pragma unroll
      for(int d0=0;d0<2;++d0)stg[orow*64+d0*32+r32e]=__float2bfloat16(o[d0][r]*rli[r]);}
    asm volatile("s_waitcnt lgkmcnt(0)":::"memory");
    #pragma unroll
    for(int i=0;i<4;++i){const int row=i*8+(lane_e>>3),ch=lane_e&7; const u32x4 v=*(const u32x4*)(stg+row*64+ch*8); ATTN_STORE16(Ow+(long)row*DM+ch*8,v);} }
  asm volatile("s_waitcnt lgkmcnt(0)\n\ts_barrier":::"memory");
  #undef DMA_K
  #undef DMA_V
  #undef CMASK
  #undef ABIAS
  #undef START
  #undef RESC
  #undef ROT
}
constexpr int ATTN_LDS_BYTES=LDS_BYTES;
#undef SBAR
#undef WAIT_BAR
}

__device__ __forceinline__ void attn_unit_ref(const Params& p, unsigned char* lds, int b, int h, int comp, int qb) {
    const int tid = opaque_tid(), row = tid & 255, dh = tid >> 8;
    float* Kt = (float*)lds; float* Vt = Kt + 64 * 64;
    const bf16_t* qbuf = (const bf16_t*)(p.ws + WS_INBUF); const bf16_t* kbuf = qbuf + (size_t)T * 1024; const bf16_t* vbuf = kbuf + (size_t)T * 1024;
    bf16_t* Op = (bf16_t*)(p.ws + WS_OPART) + (size_t)comp * T * 1024;
    const size_t rowbase = (size_t)b * SEQ; const int qpos = qb * 256 + row;
    float qv[64], o[64];
    { const bf16_t* qp = qbuf + (rowbase + qpos) * 1024 + h * 128 + comp * 64;
#pragma unroll
      for (int d = 0; d < 64; d += 8) { const u32x4 w = *(const u32x4*)(qp + d);
#pragma unroll
          for (int i = 0; i < 4; ++i) { qv[d + 2 * i] = bflo(w[i]); qv[d + 2 * i + 1] = bfhi(w[i]); } } }
#pragma unroll
    for (int d = 0; d < 64; ++d) o[d] = 0.f;
    float mrun = -1e30f, l = 0.f;
    const float slope2 = exp2f(-(float)(h + 1)) * LOG2E;
    const int ntile = (qb + 1) * 4;
    for (int kt = 0; kt < ntile; ++kt) {
        __syncthreads();
        for (int ch = tid; ch < 1536; ch += NTHREADS) { const int r = ch / 24, cc = ch % 24; const size_t grow = rowbase + kt * 64 + r;
            if (cc < 8) { const u32x4 w = *(const u32x4*)(kbuf + grow * 1024 + h * 128 + comp * 64 + cc * 8);
#pragma unroll
                for (int i = 0; i < 4; ++i) { Kt[r * 64 + cc * 8 + 2 * i] = bflo(w[i]); Kt[r * 64 + cc * 8 + 2 * i + 1] = bfhi(w[i]); } }
            else { const int c2 = cc - 8; const u32x4 w = *(const u32x4*)(vbuf + grow * 1024 + h * 128 + c2 * 8);
#pragma unroll
                for (int i = 0; i < 4; ++i) { Vt[r * 128 + c2 * 8 + 2 * i] = bflo(w[i]); Vt[r * 128 + c2 * 8 + 2 * i + 1] = bfhi(w[i]); } } }
        __syncthreads();
        for (int j = 0; j < 64; ++j) {
            const int kpos = kt * 64 + j; if (kpos > qpos) break;
            float s = 0.f;
#pragma unroll
            for (int d = 0; d < 64; d += 4) { const f32x4 kv = *(const f32x4*)(Kt + j * 64 + d); s += qv[d] * kv[0] + qv[d + 1] * kv[1] + qv[d + 2] * kv[2] + qv[d + 3] * kv[3]; }
            s += slope2 * (float)kpos;
            if (s > mrun) { const float f = exp2f(mrun - s); l *= f;
#pragma unroll
                for (int d = 0; d < 64; ++d) o[d] *= f;
                mrun = s; }
            const float pr = exp2f(s - mrun); l += pr;
#pragma unroll
            for (int d = 0; d < 64; d += 4) { const f32x4 vv = *(const f32x4*)(Vt + j * 128 + dh * 64 + d); o[d] += pr * vv[0]; o[d + 1] += pr * vv[1]; o[d + 2] += pr * vv[2]; o[d + 3] += pr * vv[3]; }
        }
    }
    const float il = 1.0f / l;
    bf16_t* op = Op + (rowbase + qpos) * 1024 + h * 128 + dh * 64;
#pragma unroll
    for (int d = 0; d < 64; d += 8) { u32x4 w; w.x = pk2(o[d] * il, o[d + 1] * il); w.y = pk2(o[d + 2] * il, o[d + 3] * il); w.z = pk2(o[d + 4] * il, o[d + 5] * il); w.w = pk2(o[d + 6] * il, o[d + 7] * il); *(u32x4*)(op + d) = w; }
    __syncthreads();
}

__device__ __forceinline__ void attn_phase_tuned(const Params& p, unsigned char* lds) {
    const int G = gridDim.x, bx = blockIdx.x; const int vcu = (G % 8 == 0) ? (bx % 8) * (G / 8) + bx / 8 : bx;
    const attn_body::bf16* Q = (const attn_body::bf16*)(p.ws + WS_INBUF); const attn_body::bf16* K = Q + (size_t)T * 1024; const attn_body::bf16* V = K + (size_t)T * 1024;
    attn_body::bf16* OP = (attn_body::bf16*)(p.ws + WS_OPART);
    for (int id = vcu; id < 256; id += G) {
        const int vh = id & 1, comp = (id >> 1) & 1, h = (id >> 2) & 7, b = id >> 5;
        const float slope2 = exp2f(-(float)(h + 1)) * LOG2E;
        for (int i = 0; i < 8; ++i) attn_body::attn_unit<8>(b, h * 128 + comp * 64, h * 128 + vh * 64, 7 - i, slope2, Q, K, V, OP + (size_t)comp * T * 1024, (char*)lds);
    }
}

__device__ __forceinline__ void phase_combine(const Params& p) {
    const int tid = opaque_tid(), lane = tid & 63, wave = tid >> 6;
    const int gw = blockIdx.x * NWAVES + wave, NGW = gridDim.x * NWAVES;
    const float s1 = wave_sum(p.in[4][lane] * p.in[5][lane]), s2 = wave_sum(p.in[6][lane] * p.in[7][lane]);
    const float lam = __expf(s1) - __expf(s2) + 0.2f;
    const bf16_t* O0 = (const bf16_t*)(p.ws + WS_OPART); const bf16_t* O1 = O0 + (size_t)T * 1024; bf16_t* O = (bf16_t*)(p.ws + WS_O);
    const float* sg = p.in[8] + (lane & 7) * 16;
    for (int m = gw; m < T; m += NGW) {
        const u32x4 a0 = *(const u32x4*)(O0 + (size_t)m * 1024 + lane * 16), a1 = *(const u32x4*)(O0 + (size_t)m * 1024 + lane * 16 + 8);
        const u32x4 c0 = *(const u32x4*)(O1 + (size_t)m * 1024 + lane * 16), c1 = *(const u32x4*)(O1 + (size_t)m * 1024 + lane * 16 + 8);
        float d[16]; float ss = 0.f;
#pragma unroll
        for (int i = 0; i < 4; ++i) { d[2 * i] = bflo(a0[i]) - lam * bflo(c0[i]); d[2 * i + 1] = bfhi(a0[i]) - lam * bfhi(c0[i]); d[8 + 2 * i] = bflo(a1[i]) - lam * bflo(c1[i]); d[8 + 2 * i + 1] = bfhi(a1[i]) - lam * bfhi(c1[i]); }
#pragma unroll
        for (int i = 0; i < 16; ++i) ss += d[i] * d[i];
        ss += __shfl_xor(ss, 1); ss += __shfl_xor(ss, 2); ss += __shfl_xor(ss, 4);
        const float rs = 0.8f / sqrtf(ss * (1.0f / 128.0f) + 1e-6f);
        u32x4 w0, w1;
        w0.x = pk2(d[0] * rs * sg[0], d[1] * rs * sg[1]); w0.y = pk2(d[2] * rs * sg[2], d[3] * rs * sg[3]); w0.z = pk2(d[4] * rs * sg[4], d[5] * rs * sg[5]); w0.w = pk2(d[6] * rs * sg[6], d[7] * rs * sg[7]);
        w1.x = pk2(d[8] * rs * sg[8], d[9] * rs * sg[9]); w1.y = pk2(d[10] * rs * sg[10], d[11] * rs * sg[11]); w1.z = pk2(d[12] * rs * sg[12], d[13] * rs * sg[13]); w1.w = pk2(d[14] * rs * sg[14], d[15] * rs * sg[15]);
        *(u32x4*)(O + (size_t)m * DM + lane * 16) = w0; *(u32x4*)(O + (size_t)m * DM + lane * 16 + 8) = w1;
    }
}

__device__ __forceinline__ void phase_router(const Params& p, unsigned char* lds) {
    const int tid = opaque_tid(), lane = tid & 63, wave = tid >> 6;
    float* hs = (float*)lds;
    float* Wsm = hs + 64 * 260;
    float* lg = Wsm + 36 * 256;
    const float* h = p.out; const float* gf = p.in[24]; const float* wg = p.in[25]; const float* we = p.in[27];
    const float* ss2 = (const float*)(p.ws + WS_CTL + CTL_SS2); float* rstd2 = (float*)(p.ws + WS_RSTD2);
    unsigned* cnt = (unsigned*)(p.ws + WS_CTL + CTL_CNT); int* rt = (int*)(p.ws + WS_RT); float* gateb = (float*)(p.ws + WS_GATEB); int* tokinfo = (int*)(p.ws + WS_TOKINFO);
    for (int tb = blockIdx.x; tb < T / 64; tb += gridDim.x) {
        const int tok0 = tb * 64;
        float acc[5];
#pragma unroll
        for (int i = 0; i < 5; ++i) acc[i] = 0.f;
        for (int k0 = 0; k0 < DM; k0 += 256) {
            __syncthreads();
            for (int ch = tid; ch < 64 * 64; ch += NTHREADS) { const int r = ch >> 6, c4 = ch & 63; *(f32x4*)(hs + r * 260 + c4 * 4) = *(const f32x4*)(h + (size_t)(tok0 + r) * DM + k0 + c4 * 4); }
            for (int id = tid; id < 36 * 256; id += NTHREADS) { const int k = id / 36, cc = id % 36; const float w = cc < 4 ? wg[(size_t)(k0 + k) * 4 + cc] : we[(size_t)(k0 + k) * 32 + cc - 4]; Wsm[cc * 256 + k] = w * gf[k0 + k]; }
            __syncthreads();
            for (int k = 0; k < 256; k += 4) { const f32x4 hv = *(const f32x4*)(hs + lane * 260 + k);
#pragma unroll
                for (int i = 0; i < 5; ++i) { const int cc = wave + 8 * i; if (cc < 36) { const f32x4 wv = *(const f32x4*)(Wsm + cc * 256 + k); acc[i] += hv[0] * wv[0] + hv[1] * wv[1] + hv[2] * wv[2] + hv[3] * wv[3]; } } }
        }
#pragma unroll
        for (int i = 0; i < 5; ++i) { const int cc = wave + 8 * i; if (cc < 36) lg[lane * 40 + cc] = acc[i]; }
        __syncthreads();
        if (tid < 64) {
            const int t = tok0 + tid; const float rs = 1.0f / sqrtf(ss2[t] * (1.0f / DM) + 1e-6f); rstd2[t] = rs;
            float g4[4]; int grp = 0; float gmax = -3.0e38f;
#pragma unroll
            for (int i = 0; i < 4; ++i) { g4[i] = lg[tid * 40 + i] * rs + p.in[26][i]; if (g4[i] > gmax) { gmax = g4[i]; grp = i; } }
            float gs = 0.f;
#pragma unroll
            for (int i = 0; i < 4; ++i) gs += __expf(g4[i] - gmax);
            const float pg = 1.0f / gs;
            float e8[8]; int i0 = 0; float m0 = -3.0e38f;
#pragma unroll
            for (int i = 0; i < 8; ++i) { e8[i] = lg[tid * 40 + 4 + grp * 8 + i] * rs + p.in[28][grp * 8 + i]; if (e8[i] > m0) { m0 = e8[i]; i0 = i; } }
            int i1 = 0; float m1 = -3.0e38f;
#pragma unroll
            for (int i = 0; i < 8; ++i) if (i != i0 && e8[i] > m1) { m1 = e8[i]; i1 = i; }
            const float p1 = __expf(m1 - m0); const float g0 = pg / (1.0f + p1), g1 = pg * p1 / (1.0f + p1);
            const int e0 = grp * 8 + i0, e1 = grp * 8 + i1;
            const unsigned r0 = atomicAdd(cnt + e0, 1u), r1 = atomicAdd(cnt + e1, 1u);
            rt[(size_t)e0 * CAP + r0] = t; rt[(size_t)e1 * CAP + r1] = t; gateb[(size_t)e0 * CAP + r0] = g0; gateb[(size_t)e1 * CAP + r1] = g1;
            int4 ti; ti.x = e0 * CAP + (int)r0; ti.y = e1 * CAP + (int)r1; ti.z = 0; ti.w = 0; *(int4*)(tokinfo + (size_t)t * 4) = ti;
        }
        __syncthreads();
    }
}

__device__ __forceinline__ void phase_final(const Params& p, unsigned char* lds) {
    const int tid = opaque_tid(), lane = tid & 63, wave = tid >> 6;
    const int gw = blockIdx.x * NWAVES + wave, NGW = gridDim.x * NWAVES;
    int* pst = (int*)lds;
    const unsigned* cnt = (const unsigned*)(p.ws + WS_CTL + CTL_CNT);
    if (tid == 0) { int ts = 0; for (int e = 0; e < NEXP; ++e) { pst[e] = ts; ts += ((int)cnt[e] + 255) >> 8; } }
    __syncthreads();
    const int* tokinfo = (const int*)(p.ws + WS_TOKINFO); const bf16_t* yb = (const bf16_t*)(p.ws + WS_YB); const float* gfin = p.in[32]; float* out = p.out;
    for (int m = gw; m < T; m += NGW) {
        const int4 ti = *(const int4*)(tokinfo + (size_t)m * 4);
        const int e0 = ti.x / CAP, r0 = ti.x % CAP, e1 = ti.y / CAP, r1 = ti.y % CAP;
        const size_t s0 = (size_t)pst[e0] * 256 + r0, s1 = (size_t)pst[e1] * 256 + r1;
        f32x4* hr = (f32x4*)(out + (size_t)m * DM) + lane; const u32x2* y0 = (const u32x2*)(yb + s0 * DM) + lane; const u32x2* y1 = (const u32x2*)(yb + s1 * DM) + lane;
        f32x4 v[8]; float s = 0.f;
#pragma unroll
        for (int j = 0; j < 8; ++j) { v[j] = hr[64 * j]; const u32x2 a = y0[64 * j], b2 = y1[64 * j];
            v[j][0] += bflo(a.x) + bflo(b2.x); v[j][1] += bfhi(a.x) + bfhi(b2.x); v[j][2] += bflo(a.y) + bflo(b2.y); v[j][3] += bfhi(a.y) + bfhi(b2.y);
            s += (v[j][0] * v[j][0] + v[j][1] * v[j][1]) + (v[j][2] * v[j][2] + v[j][3] * v[j][3]); }
        s = wave_sum(s); const float rs = 1.0f / sqrtf(s * (1.0f / DM) + 1e-6f);
#pragma unroll
        for (int j = 0; j < 8; ++j) { const f32x4 gv = *((const f32x4*)gfin + lane + 64 * j); hr[64 * j] = v[j] * rs * gv; }
    }
}

#if USE_REF_GEMM
#define GEMM_PHASE gemm_phase_ref
#else
#define GEMM_PHASE gemm_phase_mfma
#endif

__global__ void __launch_bounds__(NTHREADS, 2) fwd_kernel(Params p) {
    extern __shared__ __attribute__((aligned(16))) unsigned char lds[];
    unsigned char* ws = p.ws;
    const int lo = p.ph_lo, hi = p.ph_hi;
#define IN(k) (lo <= (k) && (k) < hi)
#if N_LAUNCH_MODE == 1
    cg::grid_group grid = cg::this_grid();
#define SEAM(k) do { if (IN(k) && IN((k) + 1)) grid.sync(); } while (0)
#else
#define SEAM(k) do { } while (0)
#endif
    if (IN(PH_PRO)) { phase_prologue(p, lds); } SEAM(PH_PRO);
    if (IN(PH_INPROJ)) {
        Gemm g{(const bf16_t*)(ws + WS_XB), (const bf16_t*)(ws + WS_WIN), DM, DM, DM};
        DenseOrder S; S.init(T, NIN, gridDim.x, blockIdx.x, DM, DM);
        EpiIn E{(bf16_t*)(ws + WS_INBUF), (bf16_t*)(ws + WS_PBUF), (const float*)(ws + WS_RSTD1)};
        GEMM_PHASE<EpiIn, DenseOrder>(lds, g, S, E);
    } SEAM(PH_INPROJ);
    if (IN(PH_L2PREP)) { phase_l2prep(p); } SEAM(PH_L2PREP);
    if (IN(PH_L2GEMM)) {
        Gemm g{(const bf16_t*)(ws + WS_A2), (const bf16_t*)(ws + WS_L2T), PW, 256, 256};
        DenseOrder S; S.init(T, 3072, gridDim.x, blockIdx.x, PW, 256, 2, 256);
        EpiL2 E{(float*)(ws + WS_WL), (bf16_t*)(ws + WS_ABUF), (bf16_t*)(ws + WS_GBUF), p.in[11], p.in[14]};
        GEMM_PHASE<EpiL2, DenseOrder>(lds, g, S, E);
    } SEAM(PH_L2GEMM);
    if (IN(PH_MIX)) {
        for (int chain = blockIdx.x; chain < BATCH * NH_RW; chain += gridDim.x) rwkv_chain(p, lds, chain);
#if USE_REF_ATTN
        for (int u = blockIdx.x; u < 1024; u += gridDim.x) { const int qb = 7 - (u >> 7), r = u & 127; attn_unit_ref(p, lds, r >> 4, (r >> 1) & 7, r & 1, qb); }
#else
        __syncthreads();
        attn_phase_tuned(p, lds);
#endif
    } SEAM(PH_MIX);
    if (IN(PH_COMB)) { phase_combine(p); } SEAM(PH_COMB);
    if (IN(PH_OUT)) {
        Gemm g{(const bf16_t*)(ws + WS_O), (const bf16_t*)(ws + WS_WOUT), DM, DM, DM};
        DenseOrder S; S.init(T, DM, gridDim.x, blockIdx.x, DM, DM);
        EpiOut E{p.in[0], p.out, (bf16_t*)(ws + WS_HB), (float*)(ws + WS_CTL + CTL_SS2)};
        GEMM_PHASE<EpiOut, DenseOrder>(lds, g, S, E);
    } SEAM(PH_OUT);
    if (IN(PH_ROUTE)) { phase_router(p, lds); convert_experts(p, lds); } SEAM(PH_ROUTE);
    if (IN(PH_G1)) {
        Gemm g{(const bf16_t*)(ws + WS_HB), (const bf16_t*)(ws + WS_WGU), DM, DM, DM};
        MoeOrder<true> S{(const unsigned*)(ws + WS_CTL + CTL_CNT), (const int*)(ws + WS_RT), 4, (int)gridDim.x, (int)blockIdx.x, 0, DM, (long)1024 * 2048, DM};
        EpiGU E{(bf16_t*)(ws + WS_HID), (const float*)(ws + WS_RSTD2)};
        GEMM_PHASE<EpiGU, MoeOrder<true>>(lds, g, S, E);
    } SEAM(PH_G1);
    if (IN(PH_G2)) {
        Gemm g{(const bf16_t*)(ws + WS_HID), (const bf16_t*)(ws + WS_WD), DEXP, DEXP, DEXP};
        MoeOrder<false> S{(const unsigned*)(ws + WS_CTL + CTL_CNT), (const int*)(ws + WS_RT), 8, (int)gridDim.x, (int)blockIdx.x, 1, DEXP, (long)2048 * 512, DEXP};
        EpiDown E{(bf16_t*)(ws + WS_YB), (const float*)(ws + WS_GATEB), (const unsigned*)(ws + WS_CTL + CTL_CNT)};
        GEMM_PHASE<EpiDown, MoeOrder<false>>(lds, g, S, E);
    } SEAM(PH_G2);
    if (IN(PH_FINAL)) { phase_final(p, lds); }
}

extern "C" void kernel_launch(void* const* d_in, const int* in_sizes, int n_in, void* d_out, int out_size, void* d_ws, size_t ws_size, hipStream_t stream) {
    static int grid = 0;
    if (grid == 0) {
        if (n_in != 33 || out_size != T * DM || ws_size < WS_END) { fprintf(stderr, "kernel_launch: unexpected problem (n_in %d out %d ws %zu)\n", n_in, out_size, ws_size); grid = -1; return; }
        int dev = 0, cus = 0;
        hipGetDevice(&dev); hipDeviceGetAttribute(&cus, hipDeviceAttributeMultiprocessorCount, dev);
        if (hipFuncSetAttribute((const void*)fwd_kernel, hipFuncAttributeMaxDynamicSharedMemorySize, LDS_BYTES) != hipSuccess) { fprintf(stderr, "kernel_launch: hipFuncSetAttribute failed\n"); grid = -1; return; }
        int per_cu = 0; hipOccupancyMaxActiveBlocksPerMultiprocessor(&per_cu, (const void*)fwd_kernel, NTHREADS, LDS_BYTES); (void)hipGetLastError();
        if (per_cu < 1) fprintf(stderr, "kernel_launch: occupancy query says %d blocks per CU\n", per_cu);
        grid = cus > 0 ? cus : 256;
    }
    if (grid < 0) return;
    hipMemsetAsync((char*)d_ws + WS_CTL, 0, CTL_BYTES, stream);
    Params p{};
    for (int i = 0; i < 33; ++i) p.in[i] = (const float*)d_in[i];
    p.out = (float*)d_out; p.ws = (unsigned char*)d_ws;
#if N_LAUNCH_MODE == 1
    p.ph_lo = 0; p.ph_hi = PH_COUNT;
    void* args[] = {&p};
    hipError_t e = hipLaunchCooperativeKernel((const void*)fwd_kernel, dim3(grid), dim3(NTHREADS), args, LDS_BYTES, stream);
    if (e != hipSuccess) fprintf(stderr, "cooperative launch failed: %s (grid %d)\n", hipGetErrorString(e), grid);
#else
    for (int ph = 0; ph < PH_COUNT; ++ph) { p.ph_lo = ph; p.ph_hi = ph + 1; hipLaunchKernelGGL(fwd_kernel, dim3(grid), dim3(NTHREADS), LDS_BYTES, stream, p); }
#endif
}
```

```cpp
#include <hip/hip_runtime.h>
#include <hip/hip_cooperative_groups.h>
#include <cstdio>
#include <cstdint>
namespace cg = cooperative_groups;

#ifndef N_LAUNCH_MODE
#define N_LAUNCH_MODE 1
#endif
#ifndef PROBE_DUP
#define PROBE_DUP 0
#endif
#ifndef USE_REF_ATTN
#define USE_REF_ATTN 0
#endif
#ifndef USE_REF_GEMM
#define USE_REF_GEMM 0
#endif

constexpr int BATCH = 8, SEQ = 2048, DM = 2048, T = BATCH * SEQ;
constexpr int DAW = 1024, RWW = 1024, NH_DA = 8, NH_RW = 16;
constexpr int NIN = 6912;
constexpr int PW = 768;
constexpr int NEXP = 32, DEXP = 512, CAP = T;
constexpr int MAXTILES = 160;
constexpr float C2Q = 0.125f * 1.4426950408889634f;
constexpr float LOG2E = 1.4426950408889634f;

constexpr size_t MiB = 1u << 20;
constexpr size_t WS_CTL = 0, CTL_BYTES = 1 * MiB;
constexpr size_t CTL_SS2 = 65536;
constexpr size_t CTL_CNT = 131072;
constexpr size_t CTL_QCTR = 131072 + 256;
constexpr size_t WS_WOUT = 1 * MiB;
constexpr size_t WS_L2T = 9 * MiB;
constexpr size_t WS_RSTD1 = 11 * MiB;
constexpr size_t WS_RSTD2 = 11 * MiB + 65536;
constexpr size_t WS_TOKINFO = 11 * MiB + 131072;
constexpr size_t WS_WIN = 12 * MiB;
constexpr size_t WS_XB = 40 * MiB;
constexpr size_t WS_O = 40 * MiB;
constexpr size_t WS_INBUF = 104 * MiB;
constexpr size_t WS_PBUF = 296 * MiB;
constexpr size_t WS_A2 = 320 * MiB;
constexpr size_t WS_WL = 344 * MiB;
constexpr size_t WS_ABUF = 408 * MiB;
constexpr size_t WS_GBUF = 440 * MiB;
constexpr size_t WS_OPART = 472 * MiB;
constexpr size_t WS_HB = 104 * MiB;
constexpr size_t WS_WGU = 168 * MiB;
constexpr size_t WS_WD = 296 * MiB;
constexpr size_t WS_RT = 360 * MiB;
constexpr size_t WS_GATEB = 362 * MiB;
constexpr size_t WS_HID = 364 * MiB;
constexpr size_t WS_YB = 404 * MiB;
constexpr size_t WS_END = 564 * MiB;

constexpr int NTHREADS = 512, NWAVES = 8;
constexpr int LDS_BYTES = 147456;

typedef unsigned short bf16_t;
typedef short bf16x8 __attribute__((ext_vector_type(8)));
typedef float f32x4 __attribute__((ext_vector_type(4)));
typedef float f32x2 __attribute__((ext_vector_type(2)));
typedef unsigned u32x4 __attribute__((ext_vector_type(4)));
typedef unsigned u32x2 __attribute__((ext_vector_type(2)));

__device__ __forceinline__ unsigned f2bf(float f) { unsigned u = __builtin_bit_cast(unsigned, f); return (u + 0x7fffu + ((u >> 16) & 1u)) >> 16; }
__device__ __forceinline__ unsigned pk2(float lo, float hi) { return f2bf(lo) | (f2bf(hi) << 16); }
__device__ __forceinline__ float bf2f(unsigned h) { return __builtin_bit_cast(float, h << 16); }
__device__ __forceinline__ float bflo(unsigned w) { return __builtin_bit_cast(float, w << 16); }
__device__ __forceinline__ float bfhi(unsigned w) { return __builtin_bit_cast(float, w & 0xffff0000u); }
__device__ __forceinline__ float wave_sum(float v) {
#pragma unroll
    for (int o = 1; o < 64; o <<= 1) v += __shfl_xor(v, o);
    return v;
}
__device__ __forceinline__ int opaque_tid() { int t = threadIdx.x; asm volatile("" : "+v"(t)); return t; }
__device__ __forceinline__ float sigmoidf_(float x) { return 1.0f / (1.0f + __expf(-x)); }

struct Params {
    const float* in[33];
    float* out;
    unsigned char* ws;
    int ph_lo, ph_hi;
};

enum { PH_PRO = 0, PH_INPROJ, PH_L2PREP, PH_L2GEMM, PH_MIX, PH_COMB, PH_OUT, PH_ROUTE, PH_G1, PH_G2, PH_FINAL, PH_COUNT };

struct Unit { int pm, pn; long a_off, b_off; const int* gidx; int valid, e, tile, k; };
struct Gemm { const bf16_t* A; const bf16_t* Bt; int lda, ldb, K; };

struct DenseOrder {
    static constexpr bool GATHER = false;
    int nM, nN, nwg, G, c, lda, ldb, acol_shift, acol_w;
    __device__ void init(int M, int N, int G_, int c_, int lda_, int ldb_, int acol_shift_ = -1, int acol_w_ = 0) {
        nM = M / 256; nN = N / 256; nwg = nM * nN; G = G_; c = c_; lda = lda_; ldb = ldb_; acol_shift = acol_shift_; acol_w = acol_w_; }
    __device__ bool next(int i, Unit& u) const {
        const long L = (long)i * G + c; if (L >= nwg) return false;
        int wgid = (int)L; { const int q = nwg / 8, r = nwg % 8, xcd = wgid % 8, off = wgid / 8; wgid = (xcd < r ? xcd * (q + 1) : r * (q + 1) + (xcd - r) * q) + off; }
        const int nig = 8 * nN, gid = wgid / nig, fm = gid * 8, gsz = (nM - fm) < 8 ? (nM - fm) : 8;
        u.pm = fm + ((wgid % nig) % gsz); u.pn = (wgid % nig) / gsz;
        u.a_off = (long)u.pm * 256 * lda + (acol_shift >= 0 ? (long)(u.pn >> acol_shift) * acol_w : 0);
        u.b_off = (long)u.pn * 256 * ldb; u.gidx = nullptr; u.valid = 256; u.e = 0; u.tile = 0; u.k = 0; return true;
    }
};
template <bool GATHER_> struct MoeOrder {
    static constexpr bool GATHER = GATHER_;
    const unsigned* cnt; const int* rt; int ncol, G, c, mode; long a_ld, b_estride, b_ld;
    __device__ bool next(int i, Unit& u) const {
        const long L = (long)i * G + c; const int g = (int)(L / ncol), pn = (int)(L % ncol);
        int ts = 0, e = 0, k = -1, ce = 0;
        for (e = 0; e < NEXP; ++e) { ce = __builtin_amdgcn_readfirstlane((int)cnt[e]); const int nt = (ce + 255) >> 8; if (g < ts + nt) { k = g - ts; break; } ts += nt; }
        if (k < 0) return false;
        u.pm = g; u.pn = pn; u.e = e; u.tile = g; u.k = k; u.valid = (ce - 256 * k) < 256 ? (ce - 256 * k) : 256;
        if (mode == 0) { u.gidx = rt + (long)e * CAP + 256 * k; u.a_off = 0; }
        else { u.gidx = nullptr; u.a_off = (long)g * 256 * a_ld; }
        u.b_off = (long)e * b_estride + (long)pn * 256 * b_ld; return true;
    }
};

template <class Epi, class Sched>
__device__ __forceinline__ void gemm_phase_ref(unsigned char* lds, const Gemm g, const Sched& S, const Epi& E) {
    const int tid = threadIdx.x, wid = tid >> 6, lane = tid & 63, wr = wid >> 2, wc = wid & 3, fr = lane & 15, fq = lane >> 4;
    bf16_t* As = (bf16_t*)lds; bf16_t* Bs = As + 256 * 72;
    Unit u;
    for (int ui = 0; S.next(ui, u); ++ui) {
        f32x4 acc[2][2][4][2];
#pragma unroll
        for (int a = 0; a < 2; ++a)
#pragma unroll
            for (int b = 0; b < 2; ++b)
#pragma unroll
                for (int m = 0; m < 4; ++m)
#pragma unroll
                    for (int n = 0; n < 2; ++n) acc[a][b][m][n] = (f32x4){0.f, 0.f, 0.f, 0.f};
        long arow[4];
#pragma unroll
        for (int i = 0; i < 4; ++i) { const int row = (tid + 512 * i) >> 3; arow[i] = u.gidx ? (row < u.valid ? (long)u.gidx[row] : 0L) : (long)row; }
        for (int k0 = 0; k0 < g.K; k0 += 64) {
            __syncthreads();
#pragma unroll
            for (int i = 0; i < 4; ++i) { const int ch = tid + 512 * i, row = ch >> 3, c8 = ch & 7;
                const u32x4 va = *(const u32x4*)(g.A + u.a_off + arow[i] * g.lda + k0 + c8 * 8);
                const u32x4 vb = *(const u32x4*)(g.Bt + u.b_off + (long)row * g.ldb + k0 + c8 * 8);
                *(u32x4*)(As + row * 72 + c8 * 8) = va; *(u32x4*)(Bs + row * 72 + c8 * 8) = vb; }
            __syncthreads();
            for (int kk = 0; kk < 64; ++kk) {
                float a[2][4];
#pragma unroll
                for (int ai = 0; ai < 2; ++ai)
#pragma unroll
                    for (int m = 0; m < 4; ++m) a[ai][m] = bf2f(As[(ai * 128 + wr * 64 + m * 16 + fr) * 72 + kk]);
#pragma unroll
                for (int bj = 0; bj < 2; ++bj)
#pragma unroll
                    for (int n = 0; n < 2; ++n)
#pragma unroll
                        for (int e = 0; e < 4; ++e) {
                            const int cl = Epi::PERM ? (bj * 128 + wc * 32 + 8 * fq + 4 * n + e) : (bj * 128 + wc * 32 + 16 * n + 4 * fq + e);
                            const float b = bf2f(Bs[cl * 72 + kk]);
#pragma unroll
                            for (int ai = 0; ai < 2; ++ai)
#pragma unroll
                                for (int m = 0; m < 4; ++m) acc[ai][bj][m][n][e] += a[ai][m] * b;
                        }
            }
        }
        E(acc, u, wr, wc, fr, fq);
    }
    __syncthreads();
}


#define LAS __attribute__((address_space(3)))
namespace pg8 {
constexpr int BK = 64, HALF = 128, HTB = HALF * BK * 2, STAGE_BYTES = 8 * HTB;
__device__ __forceinline__ int lds_byte(int r, int c) { const int st = (r >> 4) * 2 + (c >> 5), rr = r & 15, cc = c & 31, ob = rr * 64 + cc * 2; return st * 1024 + (ob ^ (((ob >> 9) & 1) << 5)); }
__device__ __forceinline__ void stage_rc(int b, int& R, int& C) { const int st = b / 1024, sb = b % 1024, swz = sb ^ (((sb >> 9) & 1) << 5); R = (st >> 1) * 16 + swz / 64; C = (st & 1) * 32 + (swz % 64) / 2; }
__device__ __forceinline__ int perm32(int rho) { const int n = rho >> 4, i = rho & 15; return 8 * (i >> 2) + 4 * n + (i & 3); }
template <bool GATHER>
__device__ __forceinline__ void unit_voffA(const Unit& u, int lda, int tid, unsigned (&v0)[2], unsigned (&v1)[2]) {
#pragma unroll
    for (int i = 0; i < 2; ++i) { int R, C; stage_rc(tid * 16 + i * 8192, R, C); int r0 = R, r1 = R + HALF;
        if (GATHER) { const int a = (r0 < u.valid) ? u.gidx[r0] : 0, b = (r1 < u.valid) ? u.gidx[r1] : 0; r0 = a; r1 = b; }
        v0[i] = (unsigned)(r0 * lda + C) * 2u; v1[i] = (unsigned)(r1 * lda + C) * 2u; }
}
template <class Epi, class Sched, bool ALIGN_EPI = true>
__device__ __forceinline__ void gemm_phase(LAS unsigned char* lds, const Gemm g, const Sched& S, const Epi& E) {
    const int tid = threadIdx.x, wid = __builtin_amdgcn_readfirstlane(tid >> 6), lane = tid & 63, wr = wid >> 2, wc = wid & 3, fr = lane & 15, fq = lane >> 4;
    const int K = g.K, nt = K / BK;
    constexpr bool GATHER = Sched::GATHER;
    unsigned voffB[2];
#pragma unroll
    for (int i = 0; i < 2; ++i) { int R, C; stage_rc(tid * 16 + i * 8192, R, C); const int Rb = Epi::PERM ? ((R & ~31) + perm32(R & 31)) : R; voffB[i] = (unsigned)(Rb * g.ldb + C) * 2u; }
    const size_t hstepA = (size_t)HALF * g.lda * 2;
    const size_t kstep = (size_t)(BK * 2);
    const size_t hstepB = (size_t)HALF * g.ldb * 2;
    const unsigned ldsw = (unsigned)wid * 1024u;
    const int aoff = lds_byte(wr * 64 + fr, fq * 8), boff = lds_byte(wc * 32 + fr, fq * 8);
#define PG8_SA(b, h) (((b) * 2 + (h)) * HTB)
#define PG8_SB(b, h) ((4 + (b) * 2 + (h)) * HTB)
#define PG8_STAGE(bufoff, gbase, voff) do { _Pragma("unroll") for (int _i = 0; _i < 2; ++_i) \
        __builtin_amdgcn_global_load_lds((const unsigned*)((const char*)(gbase) + (voff)[_i]), (LAS unsigned*)(lds + (bufoff) + ldsw + _i * 8192), 16, 0, 0); } while (0)
#define PG8_LDA(dst, b, h) do { _Pragma("unroll") for (int m = 0; m < 4; ++m) _Pragma("unroll") for (int k = 0; k < 2; ++k) dst[m][k] = *(const LAS bf16x8*)(lds + PG8_SA(b, h) + aoff + m * 2048 + k * 1024); } while (0)
#define PG8_LDB(dst, b, h) do { _Pragma("unroll") for (int n = 0; n < 2; ++n) _Pragma("unroll") for (int k = 0; k < 2; ++k) dst[n][k] = *(const LAS bf16x8*)(lds + PG8_SB(b, h) + boff + n * 2048 + k * 1024); } while (0)
#define PG8_MMA(ai, bj, At, Bt) do { __builtin_amdgcn_s_setprio(1); _Pragma("unroll") for (int m = 0; m < 4; ++m) _Pragma("unroll") for (int n = 0; n < 2; ++n) _Pragma("unroll") for (int k = 0; k < 2; ++k) \
        acc[ai][bj][m][n] = __builtin_amdgcn_mfma_f32_16x16x32_bf16(Bt[n][k], At[m][k], acc[ai][bj][m][n], 0, 0, 0); __builtin_amdgcn_s_setprio(0); } while (0)
#define PG8_WAIT_V(n) asm volatile("s_waitcnt vmcnt(" #n ")" ::: "memory")
#define PG8_WAIT_L(n) asm volatile("s_waitcnt lgkmcnt(" #n ")" ::: "memory")
#define PG8_BAR __builtin_amdgcn_s_barrier()
#define PG8_SCHED __builtin_amdgcn_sched_barrier(0)
    Unit cur, nxt; int ui = 0;
    if (!S.next(0, cur)) return;
    f32x4 acc[2][2][4][2];
#pragma unroll
    for (int a = 0; a < 2; ++a)
#pragma unroll
        for (int b = 0; b < 2; ++b)
#pragma unroll
            for (int m = 0; m < 4; ++m)
#pragma unroll
                for (int n = 0; n < 2; ++n) acc[a][b][m][n] = (f32x4){0.f, 0.f, 0.f, 0.f};
    bf16x8 At[4][2], B0[2][2], B1[2][2];
    const char* cA = (const char*)(g.A + cur.a_off); const char* cB = (const char*)(g.Bt + cur.b_off);
    unsigned vA0[2], vA1[2], nA0[2], nA1[2];
    unit_voffA<GATHER>(cur, g.lda, tid, vA0, vA1);
#define PG8_STAGE_A(bufoff, gbase, h, sel) do { if constexpr (GATHER) { if (sel) { if ((h) == 0) PG8_STAGE(bufoff, gbase, nA0); else PG8_STAGE(bufoff, gbase, nA1); } else { if ((h) == 0) PG8_STAGE(bufoff, gbase, vA0); else PG8_STAGE(bufoff, gbase, vA1); } } \
        else { PG8_STAGE(bufoff, (gbase) + ((h) ? hstepA : (size_t)0), vA0); } } while (0)
    PG8_STAGE(PG8_SB(0, 0), cB, voffB); PG8_STAGE(PG8_SB(0, 1), cB + hstepB, voffB); PG8_STAGE_A(PG8_SA(0, 0), cA, 0, false); PG8_STAGE_A(PG8_SA(0, 1), cA, 1, false);
    if (wr == 1) PG8_BAR;
    PG8_WAIT_V(2); PG8_BAR;
    PG8_STAGE(PG8_SB(1, 0), cB + kstep, voffB); PG8_STAGE_A(PG8_SA(1, 0), cA + kstep, 0, false); PG8_STAGE(PG8_SB(1, 1), cB + hstepB + kstep, voffB);
    PG8_WAIT_V(6); PG8_BAR;
    for (;;) {
        const bool has_next = S.next(ui + 1, nxt);
        const char* nA = has_next ? (const char*)(g.A + nxt.a_off) : cA; const char* nB = has_next ? (const char*)(g.Bt + nxt.b_off) : cB;
        if constexpr (GATHER) { if (has_next) unit_voffA<true>(nxt, g.lda, tid, nA0, nA1); else { nA0[0] = vA0[0]; nA0[1] = vA0[1]; nA1[0] = vA1[0]; nA1[1] = vA1[1]; } }
        for (int t = 0; t < nt; t += 2) {
            const bool last = (t == nt - 2);
            const char* a1 = cA + (size_t)(t + 1) * kstep;
            const char* a2 = last ? nA : cA + (size_t)(t + 2) * kstep; const char* b2 = last ? nB : cB + (size_t)(t + 2) * kstep;
            const char* a3 = a2 + kstep; const char* b3 = b2 + kstep;
            PG8_LDB(B0, 0, 0); PG8_LDB(B1, 0, 1); PG8_SCHED; PG8_LDA(At, 0, 0); PG8_STAGE_A(PG8_SA(1, 1), a1, 1, false);
            PG8_WAIT_V(8); PG8_WAIT_L(0); PG8_BAR; PG8_MMA(0, 0, At, B0); PG8_MMA(0, 1, At, B1); PG8_BAR; PG8_SCHED;
            PG8_LDA(At, 0, 1); PG8_STAGE(PG8_SB(0, 0), b2, voffB); PG8_STAGE(PG8_SB(0, 1), b2 + hstepB, voffB); PG8_STAGE_A(PG8_SA(0, 0), a2, 0, last);
            PG8_WAIT_V(8); PG8_WAIT_L(0); PG8_BAR; PG8_MMA(1, 0, At, B0); PG8_MMA(1, 1, At, B1); PG8_BAR; PG8_SCHED;
            PG8_LDB(B0, 1, 0); PG8_LDB(B1, 1, 1); PG8_SCHED; PG8_LDA(At, 1, 0); PG8_STAGE_A(PG8_SA(0, 1), a2, 1, last);
            PG8_WAIT_V(8); PG8_WAIT_L(0); PG8_BAR; PG8_MMA(0, 0, At, B0); PG8_MMA(0, 1, At, B1); PG8_BAR; PG8_SCHED;
            PG8_LDA(At, 1, 1); PG8_STAGE(PG8_SB(1, 0), b3, voffB); PG8_STAGE(PG8_SB(1, 1), b3 + hstepB, voffB); PG8_STAGE_A(PG8_SA(1, 0), a3, 0, last);
            PG8_WAIT_V(8); PG8_WAIT_L(0); PG8_BAR; PG8_MMA(1, 0, At, B0); PG8_MMA(1, 1, At, B1); PG8_BAR; PG8_SCHED;
        }
        if constexpr (ALIGN_EPI) { if (wr == 0) PG8_BAR; }
        E(acc, cur, wr, wc, fr, fq);
        if (!has_next) break;
#pragma unroll
        for (int a = 0; a < 2; ++a)
#pragma unroll
            for (int b = 0; b < 2; ++b)
#pragma unroll
                for (int m = 0; m < 4; ++m)
#pragma unroll
                    for (int n = 0; n < 2; ++n) acc[a][b][m][n] = (f32x4){0.f, 0.f, 0.f, 0.f};
        cur = nxt; cA = nA; cB = nB; ++ui;
        if constexpr (GATHER) { vA0[0] = nA0[0]; vA0[1] = nA0[1]; vA1[0] = nA1[0]; vA1[1] = nA1[1]; }
        if constexpr (ALIGN_EPI) { if (wr == 1) PG8_BAR; }
    }
    PG8_WAIT_V(0);
    if constexpr (!ALIGN_EPI) { if (wr == 0) PG8_BAR; }
    PG8_BAR;
#undef PG8_SA
#undef PG8_SB
#undef PG8_STAGE
#undef PG8_STAGE_A
#undef PG8_LDA
#undef PG8_LDB
#undef PG8_MMA
#undef PG8_WAIT_V
#undef PG8_WAIT_L
#undef PG8_BAR
#undef PG8_SCHED
}
}
template <class Epi, class Sched>
__device__ __forceinline__ void gemm_phase_mfma(unsigned char* lds, const Gemm g, const Sched& S, const Epi& E) { pg8::gemm_phase<Epi, Sched, true>((LAS unsigned char*)lds, g, S, E); __syncthreads(); }

__device__ __forceinline__ u32x4 pack8(const f32x4 v0, const f32x4 v1) { u32x4 w; w.x = pk2(v0[0], v0[1]); w.y = pk2(v0[2], v0[3]); w.z = pk2(v1[0], v1[1]); w.w = pk2(v1[2], v1[3]); return w; }

struct EpiIn {
    static constexpr bool PERM = true;
    bf16_t* inbuf; bf16_t* pbuf; const float* rstd1;
    __device__ __forceinline__ void operator()(const f32x4 (&acc)[2][2][4][2], const Unit& u, int wr, int wc, int fr_, int fq_) const {
        int fr = fr_, fq = fq_; asm volatile("" : "+v"(fr), "+v"(fq));
        bf16_t* base; int ldc, colt; float sc0 = 1.f;
        if (u.pn < 24) { base = inbuf + (size_t)(u.pn >> 2) * T * 1024; ldc = 1024; colt = (u.pn & 3) * 256; if (u.pn < 4) sc0 = C2Q; }
        else { base = pbuf; ldc = PW; colt = (u.pn - 24) * 256; }
        const int row0 = u.pm * 256 + wr * 64 + fr, col0 = colt + wc * 32 + 8 * fq;
#pragma unroll
        for (int ai = 0; ai < 2; ++ai)
#pragma unroll
            for (int m = 0; m < 4; ++m) { const int row = row0 + ai * 128 + m * 16; const float rs = rstd1[row] * sc0; bf16_t* rowp = base + (size_t)row * ldc + col0;
#pragma unroll
                for (int bj = 0; bj < 2; ++bj) *(u32x4*)(rowp + bj * 128) = pack8(acc[ai][bj][m][0] * rs, acc[ai][bj][m][1] * rs); }
    }
};
struct EpiL2 {
    static constexpr bool PERM = true;
    float* wl; bf16_t* abuf; bf16_t* gbuf; const float* w0; const float* a0;
    __device__ __forceinline__ void operator()(const f32x4 (&acc)[2][2][4][2], const Unit& u, int wr, int wc, int fr_, int fq_) const {
        int fr = fr_, fq = fq_; asm volatile("" : "+v"(fr), "+v"(fq));
        const int grp = u.pn >> 2, colt = (u.pn & 3) * 256;
        const int row0 = u.pm * 256 + wr * 64 + fr, col0 = colt + wc * 32 + 8 * fq;
        if (grp == 0) {
#pragma unroll
            for (int bj = 0; bj < 2; ++bj) { const int c = col0 + bj * 128; const f32x4 b0 = *(const f32x4*)(w0 + c), b1 = *(const f32x4*)(w0 + c + 4);
#pragma unroll
                for (int ai = 0; ai < 2; ++ai)
#pragma unroll
                    for (int m = 0; m < 4; ++m) { const int row = row0 + ai * 128 + m * 16; f32x4 v0 = acc[ai][bj][m][0] + b0, v1 = acc[ai][bj][m][1] + b1;
#pragma unroll
                        for (int e = 0; e < 4; ++e) { v0[e] = -0.60653065971f * LOG2E * sigmoidf_(v0[e]); v1[e] = -0.60653065971f * LOG2E * sigmoidf_(v1[e]); }
                        float* p = wl + (size_t)row * 1024 + c; *(f32x4*)p = v0; *(f32x4*)(p + 4) = v1; asm volatile("" ::: "memory"); __builtin_amdgcn_sched_barrier(0); } }
        } else if (grp == 1) {
#pragma unroll
            for (int bj = 0; bj < 2; ++bj) { const int c = col0 + bj * 128; const f32x4 b0 = *(const f32x4*)(a0 + c), b1 = *(const f32x4*)(a0 + c + 4);
#pragma unroll
                for (int ai = 0; ai < 2; ++ai)
#pragma unroll
                    for (int m = 0; m < 4; ++m) { const int row = row0 + ai * 128 + m * 16; f32x4 v0 = acc[ai][bj][m][0] + b0, v1 = acc[ai][bj][m][1] + b1;
#pragma unroll
                        for (int e = 0; e < 4; ++e) { v0[e] = sigmoidf_(v0[e]); v1[e] = sigmoidf_(v1[e]); }
                        *(u32x4*)(abuf + (size_t)row * 1024 + c) = pack8(v0, v1); asm volatile("" ::: "memory"); __builtin_amdgcn_sched_barrier(0); } }
        } else {
#pragma unroll
            for (int bj = 0; bj < 2; ++bj) { const int c = col0 + bj * 128;
#pragma unroll
                for (int ai = 0; ai < 2; ++ai)
#pragma unroll
                    for (int m = 0; m < 4; ++m) { const int row = row0 + ai * 128 + m * 16; *(u32x4*)(gbuf + (size_t)row * 1024 + c) = pack8(acc[ai][bj][m][0], acc[ai][bj][m][1]); } }
        }
    }
};
struct EpiOut {
    static constexpr bool PERM = true;
    const float* x; float* h; bf16_t* hb; float* ss2;
    __device__ __forceinline__ void operator()(const f32x4 (&acc)[2][2][4][2], const Unit& u, int wr, int wc, int fr_, int fq_) const {
        int fr = fr_, fq = fq_; asm volatile("" : "+v"(fr), "+v"(fq));
        const int row0 = u.pm * 256 + wr * 64 + fr, col0 = u.pn * 256 + wc * 32 + 8 * fq;
#pragma unroll
        for (int ai = 0; ai < 2; ++ai)
#pragma unroll
            for (int m = 0; m < 4; ++m) { const int row = row0 + ai * 128 + m * 16; float ss = 0.f;
#pragma unroll
                for (int bj = 0; bj < 2; ++bj) { const size_t off = (size_t)row * DM + col0 + bj * 128;
                    const f32x4 x0 = *(const f32x4*)(x + off), x1 = *(const f32x4*)(x + off + 4);
                    const f32x4 v0 = acc[ai][bj][m][0] + x0, v1 = acc[ai][bj][m][1] + x1;
                    *(f32x4*)(h + off) = v0; *(f32x4*)(h + off + 4) = v1; *(u32x4*)(hb + off) = pack8(v0, v1);
                    ss += (v0[0] * v0[0] + v0[1] * v0[1]) + (v0[2] * v0[2] + v0[3] * v0[3]) + (v1[0] * v1[0] + v1[1] * v1[1]) + (v1[2] * v1[2] + v1[3] * v1[3]); }
                ss += __shfl_xor(ss, 16); ss += __shfl_xor(ss, 32);
                if (fq == 0) atomicAdd(ss2 + row, ss); }
    }
};
struct EpiGU {
    static constexpr bool PERM = true;
    bf16_t* hid; const float* rstd2;
    __device__ __forceinline__ void operator()(const f32x4 (&acc)[2][2][4][2], const Unit& u, int wr, int wc, int fr_, int fq_) const {
        int fr = fr_, fq = fq_; asm volatile("" : "+v"(fr), "+v"(fq));
        const int col0 = u.pn * 128 + wc * 32 + 8 * fq;
#pragma unroll
        for (int ai = 0; ai < 2; ++ai)
#pragma unroll
            for (int m = 0; m < 4; ++m) { const int rl = ai * 128 + wr * 64 + m * 16 + fr; const int tok = (rl < u.valid) ? u.gidx[rl] : 0; const float rs = rstd2[tok];
                f32x4 o0, o1;
#pragma unroll
                for (int e = 0; e < 4; ++e) { const float g0 = acc[ai][0][m][0][e] * rs, u0 = acc[ai][1][m][0][e] * rs, g1 = acc[ai][0][m][1][e] * rs, u1 = acc[ai][1][m][1][e] * rs;
                    o0[e] = g0 * sigmoidf_(g0) * u0; o1[e] = g1 * sigmoidf_(g1) * u1; }
                *(u32x4*)(hid + ((size_t)u.tile * 256 + rl) * DEXP + col0) = pack8(o0, o1); asm volatile("" ::: "memory"); __builtin_amdgcn_sched_barrier(0); }
    }
};
struct EpiDown {
    static constexpr bool PERM = true;
    bf16_t* yb; const float* gateb; const unsigned* cnt;
    __device__ __forceinline__ void operator()(const f32x4 (&acc)[2][2][4][2], const Unit& u, int wr, int wc, int fr_, int fq_) const {
        int fr = fr_, fq = fq_; asm volatile("" : "+v"(fr), "+v"(fq));
        const int col0 = u.pn * 256 + wc * 32 + 8 * fq;
        const int k = u.k;
#pragma unroll
        for (int ai = 0; ai < 2; ++ai)
#pragma unroll
            for (int m = 0; m < 4; ++m) { const int rl = ai * 128 + wr * 64 + m * 16 + fr; const float gt = (rl < u.valid) ? gateb[(size_t)u.e * CAP + 256 * k + rl] : 0.f;
#pragma unroll
                for (int bj = 0; bj < 2; ++bj) *(u32x4*)(yb + ((size_t)u.tile * 256 + rl) * DM + col0 + bj * 128) = pack8(acc[ai][bj][m][0] * gt, acc[ai][bj][m][1] * gt); }
    }
};

__device__ __forceinline__ void tr_item(const float* W, int ldw, int Kvalid, int k0, int n0, bf16_t* WT, int ldt, int trow0, float* scr, int lane,
                                        const float* gk, const float* mu, int mode) {
#pragma unroll 8
    for (int i = 0; i < 32; ++i) { const int kk = 2 * i + (lane >> 5), k = k0 + kk; float v = 0.f;
        if (k < Kvalid) { v = W[(size_t)k * ldw + n0 + (lane & 31)]; float s = gk ? gk[k] : 1.f; if (mode == 1) s *= (1.f - mu[k]); else if (mode == 2) s *= mu[k]; v *= s; }
        scr[kk * 33 + (lane & 31)] = v; }
    __builtin_amdgcn_s_waitcnt(0xC07F); asm volatile("" ::: "memory");
    const int c = lane & 7;
#pragma unroll
    for (int j = 0; j < 4; ++j) { const int n = (lane >> 3) + 8 * j; const float* s = scr + (8 * c) * 33 + n;
        u32x4 o; o.x = pk2(s[0 * 33], s[1 * 33]); o.y = pk2(s[2 * 33], s[3 * 33]); o.z = pk2(s[4 * 33], s[5 * 33]); o.w = pk2(s[6 * 33], s[7 * 33]);
        *(u32x4*)(WT + (size_t)(trow0 + n) * ldt + k0 + 8 * c) = o; }
    __builtin_amdgcn_s_waitcnt(0xC07F); asm volatile("" ::: "memory");
}

__device__ __forceinline__ void phase_prologue(const Params& p, unsigned char* lds) {
    const int tid = opaque_tid(), lane = tid & 63, wave = tid >> 6;
    const int gw = blockIdx.x * NWAVES + wave, NGW = gridDim.x * NWAVES;
    unsigned char* ws = p.ws;
    float* scr = (float*)(lds + wave * 16384);
    bf16_t* WinT = (bf16_t*)(ws + WS_WIN); bf16_t* WoutT = (bf16_t*)(ws + WS_WOUT); bf16_t* L2T = (bf16_t*)(ws + WS_L2T);
    const float* g_mix = p.in[1]; const float* mu_x = p.in[9];
    constexpr int I_WIN = 32 * 192;
    constexpr int I_L1 = 32 * 2 * 2 + 32 * 2 * 2 + 32 * 5 * 2;
    constexpr int I_WOUT = 32 * 64;
    constexpr int I_L2 = 3 * 4 * 32;
    constexpr int NITEMS = I_WIN + I_L1 + I_WOUT + I_L2;
    for (int it = gw; it < NITEMS; it += NGW) {
        int r = it;
        if (r < I_WIN) { const int kb = r / 192, nb = r % 192; tr_item(p.in[2], 6144, 2048, 64 * kb, 32 * nb, WinT, 2048, 32 * nb, scr, lane, g_mix, nullptr, 0); continue; } r -= I_WIN;
        if (r < I_L1) {
            int which, nb, mode, kb;
            if (r < 128) { which = 0; } else if (r < 256) { which = 1; r -= 128; } else { which = 2; r -= 256; }
            const int nnb = (which == 2) ? 5 : 2;
            kb = r / (nnb * 2); const int rr = r % (nnb * 2); nb = rr / 2; mode = 1 + (rr & 1);
            const float* W = which == 0 ? p.in[12] : which == 1 ? p.in[15] : p.in[17];
            const int ldw = which == 2 ? 160 : 64;
            const int rowbase = 6144 + (which == 0 ? 0 : which == 1 ? 128 : 256) + (mode == 2 ? ldw : 0);
            tr_item(W, ldw, 2048, 64 * kb, 32 * nb, WinT, 2048, rowbase + 32 * nb, scr, lane, g_mix, mu_x + which * 2048, mode); continue; } r -= I_L1;
        if (r < I_WOUT) { const int kb = r / 64, nb = r % 64; tr_item(p.in[3], 2048, 2048, 64 * kb, 32 * nb, WoutT, 2048, 32 * nb, scr, lane, nullptr, nullptr, 0); continue; } r -= I_WOUT;
        { const int which = r / 128, rr = r % 128, kb = rr / 32, nb = rr % 32;
          const float* W = which == 0 ? p.in[13] : which == 1 ? p.in[16] : p.in[18]; const int kv = which == 2 ? 160 : 64;
          tr_item(W, 1024, kv, 64 * kb, 32 * nb, L2T, 256, which * 1024 + 32 * nb, scr, lane, nullptr, nullptr, 0); }
    }
    for (int ch = blockIdx.x * NTHREADS + tid; ch < 192 * 256; ch += gridDim.x * NTHREADS) *(u32x4*)(WinT + (size_t)6720 * 2048 + (size_t)ch * 8) = (u32x4){0u, 0u, 0u, 0u};
    const float* x = p.in[0]; bf16_t* xb = (bf16_t*)(ws + WS_XB); float* rstd1 = (float*)(ws + WS_RSTD1);
    for (int m = gw; m < T; m += NGW) {
        const f32x4* xr = (const f32x4*)(x + (size_t)m * DM) + lane; f32x4 v[8]; float s = 0.f;
#pragma unroll
        for (int j = 0; j < 8; ++j) { v[j] = xr[64 * j]; s += (v[j][0] * v[j][0] + v[j][1] * v[j][1]) + (v[j][2] * v[j][2] + v[j][3] * v[j][3]); }
        s = wave_sum(s);
        u32x2* o = (u32x2*)(xb + (size_t)m * DM) + lane;
#pragma unroll
        for (int j = 0; j < 8; ++j) { u32x2 w; w.x = pk2(v[j][0], v[j][1]); w.y = pk2(v[j][2], v[j][3]); o[64 * j] = w; }
        if (lane == 0) rstd1[m] = 1.0f / sqrtf(s * (1.0f / DM) + 1e-6f);
    }
}

__device__ __forceinline__ void convert_experts(const Params& p, unsigned char* lds) {
    const int tid = opaque_tid(), lane = tid & 63, wave = tid >> 6;
    const int gw = blockIdx.x * NWAVES + wave, NGW = gridDim.x * NWAVES;
    float* scr = (float*)(lds + 65536 + wave * 8704);
    bf16_t* Wgu = (bf16_t*)(p.ws + WS_WGU); bf16_t* Wd = (bf16_t*)(p.ws + WS_WD); const float* gf = p.in[24];
    constexpr int I_G = 32 * 32 * 16;
    constexpr int I_D = 32 * 8 * 64;
    for (int it = gw; it < 2 * I_G + I_D; it += NGW) {
        int r = it;
        if (r < 2 * I_G) { const int up = r >= I_G; if (up) r -= I_G; const int e = r / 512, rr = r % 512, kb = rr / 16, nb = rr % 16; const int n0 = 32 * nb;
            tr_item((up ? p.in[30] : p.in[29]) + (size_t)e * 2048 * 512, 512, 2048, 64 * kb, n0, Wgu + (size_t)e * 1024 * 2048, 2048, 256 * (n0 >> 7) + (n0 & 127) + (up ? 128 : 0), scr, lane, gf, nullptr, 0); continue; }
        r -= 2 * I_G;
        { const int e = r / 512, rr = r % 512, kb = rr / 64, nb = rr % 64;
          tr_item(p.in[31] + (size_t)e * 512 * 2048, 2048, 512, 64 * kb, 32 * nb, Wd + (size_t)e * 2048 * 512, 512, 32 * nb, scr, lane, nullptr, nullptr, 0); }
    }
}

__device__ __forceinline__ void phase_l2prep(const Params& p) {
    const bf16_t* P = (const bf16_t*)(p.ws + WS_PBUF); bf16_t* A2 = (bf16_t*)(p.ws + WS_A2);
    const int nchunk = T * 96;
    const int tid = opaque_tid();
    for (int id = blockIdx.x * NTHREADS + tid; id < nchunk; id += gridDim.x * NTHREADS) {
        const int t = id / 96, ch = id % 96, gi = ch >> 5, jc = (ch & 31) * 8;
        const int width = gi == 2 ? 160 : 64, pa = gi == 0 ? 0 : gi == 1 ? 128 : 256, pb = pa + width;
        u32x4 o = (u32x4){0u, 0u, 0u, 0u};
        if (jc < width) {
            const u32x4 va = *(const u32x4*)(P + (size_t)t * PW + pa + jc);
            u32x4 vb = (u32x4){0u, 0u, 0u, 0u};
            if ((t & (SEQ - 1)) != 0) vb = *(const u32x4*)(P + (size_t)(t - 1) * PW + pb + jc);
            float f[8];
#pragma unroll
            for (int i = 0; i < 4; ++i) { f[2 * i] = bflo(va[i]) + bflo(vb[i]); f[2 * i + 1] = bfhi(va[i]) + bfhi(vb[i]); }
#pragma unroll
            for (int i = 0; i < 8; ++i) { if (gi == 0) f[i] = 1.0f - 2.0f / (__expf(2.0f * f[i]) + 1.0f); else if (gi == 2) f[i] = sigmoidf_(f[i]); }
            o.x = pk2(f[0], f[1]); o.y = pk2(f[2], f[3]); o.z = pk2(f[4], f[5]); o.w = pk2(f[6], f[7]);
        }
        *(u32x4*)(A2 + (size_t)t * PW + ch * 8) = o;
    }
}

constexpr int TC = 16;
constexpr int SCAN_VEC_FLOATS = 6 * TC * 64 + 2 * TC;
constexpr int SCAN_OFF_YS = 2 * SCAN_VEC_FLOATS;
constexpr int SCAN_OFF_GB = SCAN_OFF_YS + 2 * TC * 64;
constexpr int SCAN_LDS_FLOATS = SCAN_OFF_GB + 4 * TC * 64;
#define DPP_F(v, ctrl) __builtin_bit_cast(float, __builtin_amdgcn_update_dpp(0, __builtin_bit_cast(int, (v)), (ctrl), 0xF, 0xF, true))
__device__ __forceinline__ float red8(float v) {
    v += DPP_F(v, 0xB1);
    v += DPP_F(v, 0x4E);
    v += DPP_F(v, 0x141);
    return v;
}
__device__ __forceinline__ float wave_sum_fast(float v) {
    v = red8(v);
    v += DPP_F(v, 0x140);
    v += __builtin_bit_cast(float, __builtin_amdgcn_update_dpp(0, __builtin_bit_cast(int, v), 0x142, 0xa, 0xf, false));
    v += __builtin_bit_cast(float, __builtin_amdgcn_update_dpp(0, __builtin_bit_cast(int, v), 0x143, 0xc, 0xf, false));
    return __builtin_bit_cast(float, __builtin_amdgcn_readlane(__builtin_bit_cast(int, v), 63));
}
__device__ __forceinline__ f32x2 lo2(const f32x4 x) { return (f32x2){x[0], x[1]}; }
__device__ __forceinline__ f32x2 hi2(const f32x4 x) { return (f32x2){x[2], x[3]}; }
__device__ __forceinline__ void rwkv_chain(const Params& p, unsigned char* lds, int chain) {
    const int tid = opaque_tid(), lane = tid & 63, wave = __builtin_amdgcn_readfirstlane(tid >> 6);
    const int b = chain >> 4, h = chain & 15;
    float* L = (float*)lds;
    constexpr int NC = SEQ / TC;
    if (wave < 4) {
        const int r8 = lane >> 3, q = lane & 7, iA = 16 * wave + r8, iB = iA + 8;
        f32x2 SA[4], SB[4];
#pragma unroll
        for (int e = 0; e < 4; ++e) { SA[e] = (f32x2){0.f, 0.f}; SB[e] = (f32x2){0.f, 0.f}; }
        __syncthreads();
        for (int ci = 0; ci < NC; ++ci) {
            const float* V0 = L + (ci & 1) * SCAN_VEC_FLOATS;
            float* Ys = L + SCAN_OFF_YS + (ci & 1) * TC * 64;
            const float* KKs = V0 + 8 * q; const float* Ws = V0 + TC * 64 + 8 * q; const float* Bs = V0 + 2 * TC * 64 + 8 * q; const float* Ks = V0 + 3 * TC * 64 + 8 * q;
            const float* WRs = V0 + 4 * TC * 64 + 8 * q; const float* Vs = V0 + 5 * TC * 64; const float* SC = V0 + 6 * TC * 64;
            f32x4 kk0 = *(const f32x4*)(KKs), kk1 = *(const f32x4*)(KKs + 4), w0 = *(const f32x4*)(Ws), w1 = *(const f32x4*)(Ws + 4);
            f32x4 b0 = *(const f32x4*)(Bs), b1 = *(const f32x4*)(Bs + 4), k0 = *(const f32x4*)(Ks), k1 = *(const f32x4*)(Ks + 4);
            f32x4 x0 = *(const f32x4*)(WRs), x1 = *(const f32x4*)(WRs + 4); float vA = Vs[iA], vB = Vs[iB]; f32x2 sc = *(const f32x2*)(SC);
#pragma unroll 2
            for (int tl = 0; tl < TC; ++tl) {
                const int tn = (tl + 1 < TC) ? tl + 1 : tl;
                const f32x4 nkk0 = *(const f32x4*)(KKs + tn * 64), nkk1 = *(const f32x4*)(KKs + tn * 64 + 4), nw0 = *(const f32x4*)(Ws + tn * 64), nw1 = *(const f32x4*)(Ws + tn * 64 + 4);
                const f32x4 nb0 = *(const f32x4*)(Bs + tn * 64), nb1 = *(const f32x4*)(Bs + tn * 64 + 4), nk0 = *(const f32x4*)(Ks + tn * 64), nk1 = *(const f32x4*)(Ks + tn * 64 + 4);
                const f32x4 nx0 = *(const f32x4*)(WRs + tn * 64), nx1 = *(const f32x4*)(WRs + tn * 64 + 4); const float nvA = Vs[tn * 64 + iA], nvB = Vs[tn * 64 + iB]; const f32x2 nsc = *(const f32x2*)(SC + 2 * tn);
                f32x2 t0 = SA[0] * lo2(kk0) + SA[1] * hi2(kk0); t0 += SA[2] * lo2(kk1) + SA[3] * hi2(kk1);
                f32x2 t1 = SB[0] * lo2(kk0) + SB[1] * hi2(kk0); t1 += SB[2] * lo2(kk1) + SB[3] * hi2(kk1);
                f32x2 t2 = SA[0] * lo2(x0) + SA[1] * hi2(x0); t2 += SA[2] * lo2(x1) + SA[3] * hi2(x1);
                f32x2 t3 = SB[0] * lo2(x0) + SB[1] * hi2(x0); t3 += SB[2] * lo2(x1) + SB[3] * hi2(x1);
                float saA = t0[0] + t0[1], saB = t1[0] + t1[1], pA = t2[0] + t2[1], pB = t3[0] + t3[1];
                saA += DPP_F(saA, 0xB1); saB += DPP_F(saB, 0xB1); pA += DPP_F(pA, 0xB1); pB += DPP_F(pB, 0xB1);
                saA += DPP_F(saA, 0x4E); saB += DPP_F(saB, 0x4E); pA += DPP_F(pA, 0x4E); pB += DPP_F(pB, 0x4E);
                saA += DPP_F(saA, 0x141); saB += DPP_F(saB, 0x141); pA += DPP_F(pA, 0x141); pB += DPP_F(pB, 0x141);
                const float yA = pA + (saA * sc[0] + vA * sc[1]), yB = pB + (saB * sc[0] + vB * sc[1]);
                if (q == 0) { Ys[tl * 64 + iA] = yA; Ys[tl * 64 + iB] = yB; }
                const f32x2 sA2 = (f32x2){saA, saA}, sB2 = (f32x2){saB, saB}, vA2 = (f32x2){vA, vA}, vB2 = (f32x2){vB, vB};
                SA[0] = SA[0] * lo2(w0) + (sA2 * lo2(b0) + vA2 * lo2(k0)); SA[1] = SA[1] * hi2(w0) + (sA2 * hi2(b0) + vA2 * hi2(k0));
                SA[2] = SA[2] * lo2(w1) + (sA2 * lo2(b1) + vA2 * lo2(k1)); SA[3] = SA[3] * hi2(w1) + (sA2 * hi2(b1) + vA2 * hi2(k1));
                SB[0] = SB[0] * lo2(w0) + (sB2 * lo2(b0) + vB2 * lo2(k0)); SB[1] = SB[1] * hi2(w0) + (sB2 * hi2(b0) + vB2 * hi2(k0));
                SB[2] = SB[2] * lo2(w1) + (sB2 * lo2(b1) + vB2 * lo2(k1)); SB[3] = SB[3] * hi2(w1) + (sB2 * hi2(b1) + vB2 * hi2(k1));
                kk0 = nkk0; kk1 = nkk1; w0 = nw0; w1 = nw1; b0 = nb0; b1 = nb1; k0 = nk0; k1 = nk1; x0 = nx0; x1 = nx1; vA = nvA; vB = nvB; sc = nsc;
            }
            __syncthreads();
        }
    } else {
        const int aw = wave - 4, c = h * 64 + lane;
        constexpr int SPW = TC / 4;
        const bf16_t* rb = (const bf16_t*)(p.ws + WS_INBUF) + (size_t)3 * T * 1024; const bf16_t* kb = rb + (size_t)T * 1024; const bf16_t* vb = kb + (size_t)T * 1024;
        const float* wl = (const float*)(p.ws + WS_WL); const bf16_t* ab = (const bf16_t*)(p.ws + WS_ABUF); const bf16_t* gb = (const bf16_t*)(p.ws + WS_GBUF);
        bf16_t* O = (bf16_t*)(p.ws + WS_O);
        const float mu_r = p.in[10][c], mu_k = p.in[10][1024 + c], mu_v = p.in[10][2048 + c];
        const float k_k = p.in[19][c], k_a = p.in[20][c], r_k = p.in[21][c], ln_w = p.in[22][c], ln_b = p.in[23][c];
        float rc[SPW + 1], kc[SPW + 1], vc[SPW + 1], rwl[SPW], ra[SPW], rg[SPW];
#define SCAN_LOAD(ci_) do { const int tb_ = (ci_) * TC + aw * SPW; const size_t m0_ = (size_t)b * SEQ + tb_; \
        _Pragma("unroll") for (int s_ = 0; s_ < SPW + 1; ++s_) { const bool ok_ = (tb_ + s_ - 1) >= 0; const size_t off_ = (m0_ + s_ - 1) * 1024 + c; \
            rc[s_] = ok_ ? bf2f(rb[off_]) : 0.f; kc[s_] = ok_ ? bf2f(kb[off_]) : 0.f; vc[s_] = ok_ ? bf2f(vb[off_]) : 0.f; } \
        _Pragma("unroll") for (int s_ = 0; s_ < SPW; ++s_) { const size_t off_ = (m0_ + s_) * 1024 + c; rwl[s_] = wl[off_]; ra[s_] = bf2f(ab[off_]); rg[s_] = bf2f(gb[off_]); } } while (0)
#define SCAN_PREP(ci_) do { float* V0_ = L + ((ci_) & 1) * SCAN_VEC_FLOATS; float* GB_ = L + SCAN_OFF_GB + ((ci_) & 1) * 2 * TC * 64; \
        _Pragma("unroll") for (int s_ = 0; s_ < SPW; ++s_) { const int tl_ = aw * SPW + s_; \
            const float rr_ = rc[s_ + 1] + (rc[s_] - rc[s_ + 1]) * mu_r, kx_ = kc[s_ + 1] + (kc[s_] - kc[s_ + 1]) * mu_k, vv_ = vc[s_ + 1] + (vc[s_] - vc[s_ + 1]) * mu_v; \
            const float w_ = __builtin_amdgcn_exp2f(rwl[s_]), a_ = ra[s_]; \
            const float kkv_ = kx_ * k_k; const float n2_ = wave_sum_fast(kkv_ * kkv_); const float kkn_ = kkv_ * __builtin_amdgcn_rsqf(fmaxf(n2_, 1e-24f)); \
            const float kmod_ = kx_ * (1.0f + (a_ - 1.0f) * k_a); const float bb_ = kkn_ * a_; \
            const float bon_ = wave_sum_fast(rr_ * kmod_ * r_k), br_ = wave_sum_fast(bb_ * rr_), kr_ = wave_sum_fast(kmod_ * rr_); \
            V0_[tl_ * 64 + lane] = -kkn_; V0_[TC * 64 + tl_ * 64 + lane] = w_; V0_[2 * TC * 64 + tl_ * 64 + lane] = bb_; V0_[3 * TC * 64 + tl_ * 64 + lane] = kmod_; \
            V0_[4 * TC * 64 + tl_ * 64 + lane] = w_ * rr_; V0_[5 * TC * 64 + tl_ * 64 + lane] = vv_; if (lane == 0) { V0_[6 * TC * 64 + 2 * tl_] = br_; V0_[6 * TC * 64 + 2 * tl_ + 1] = kr_; } \
            GB_[tl_ * 64 + lane] = rg[s_]; GB_[TC * 64 + tl_ * 64 + lane] = bon_ * vv_ * rg[s_]; } } while (0)
#define SCAN_POST(ci_) do { const float* Ys_ = L + SCAN_OFF_YS + ((ci_) & 1) * TC * 64; const float* GB_ = L + SCAN_OFF_GB + ((ci_) & 1) * 2 * TC * 64; \
        _Pragma("unroll") for (int s_ = 0; s_ < SPW; ++s_) { const int tl_ = aw * SPW + s_; const size_t m_ = (size_t)b * SEQ + (ci_) * TC + tl_; \
            const float y_ = Ys_[tl_ * 64 + lane]; const float mean_ = wave_sum_fast(y_) * (1.0f / 64.0f); const float d_ = y_ - mean_; const float var_ = wave_sum_fast(d_ * d_) * (1.0f / 64.0f); \
            const float yn_ = d_ * __builtin_amdgcn_rsqf(var_ + 64e-5f) * ln_w + ln_b; \
            O[m_ * DM + 1024 + c] = (bf16_t)f2bf(yn_ * GB_[tl_ * 64 + lane] + GB_[TC * 64 + tl_ * 64 + lane]); } } while (0)
        SCAN_LOAD(0); SCAN_PREP(0); SCAN_LOAD(1);
        __syncthreads();
        for (int ci = 0; ci < NC; ++ci) {
            if (ci >= 1) SCAN_POST(ci - 1);
            if (ci + 1 < NC) { SCAN_PREP(ci + 1); if (ci + 2 < NC) SCAN_LOAD(ci + 2); }
            __syncthreads();
        }
        SCAN_POST(NC - 1);
#undef SCAN_LOAD
#undef SCAN_PREP
#undef SCAN_POST
    }
    __syncthreads();
}

#include <hip/hip_bf16.h>
#include <cmath>
namespace attn_body {
using bf16=__hip_bfloat16;
using bf16x8=__attribute__((ext_vector_type(8)))short;
using s16x4=__attribute__((ext_vector_type(4)))short;
using f32x16=__attribute__((ext_vector_type(16)))float;
using u32x4=__attribute__((ext_vector_type(4)))unsigned;
constexpr int SEQ=2048,D=64,DM=1024;
constexpr int NW=8,QBLK=32,QB=QBLK*NW,KVBLK=64,NQB=SEQ/QB;
__device__ __forceinline__ int crow(int r,int hi){return (r&3)+8*(r>>2)+4*hi;}
#define SBAR() __builtin_amdgcn_sched_barrier(0)
__device__ __forceinline__ void cmask(f32x16&p0,f32x16&p1,int jb,int qrel,int hi){
  const float NEG=-INFINITY; int kb=64*jb+4*hi;
  #pragma unroll
  for(int r=0;r<16;++r){int kv=kb+(r&3)+8*(r>>2); if(kv>qrel)p0[r]=NEG; if(kv+32>qrel)p1[r]=NEG;}
}

constexpr int NSLOT=3, SLOTB=8192;
constexpr int LDS_K=0, LDS_V=NSLOT*SLOTB, LDS_WS=2*NSLOT*SLOTB, LDS_OST=LDS_WS+NW*64*4, LDS_BYTES=LDS_OST+NW*4096;
constexpr float C2=0.125f*1.4426950408889634f;
__device__ __forceinline__ void glds16(const void*gsrc,unsigned lds_dst){unsigned keep;
  asm volatile("s_mov_b32 %0, m0\n\ts_mov_b32 m0, %2\n\ts_nop 0\n\tglobal_load_lds_dwordx4 %1, off\n\ts_mov_b32 m0, %0":"=&s"(keep):"v"(gsrc),"s"(lds_dst):"memory");}
__device__ __forceinline__ float max3f(float a,float b,float c){float r;asm("v_max3_f32 %0, %1, %2, %3":"=v"(r):"v"(a),"v"(b),"v"(c));return r;}
__device__ __forceinline__ float max2f(float a,float b){float r;asm("v_max_f32_e32 %0, %1, %2":"=v"(r):"v"(a),"v"(b));return r;}
__device__ __forceinline__ float fadd_s(float a,float b){float r;asm("v_add_f32_e32 %0, %1, %2":"=v"(r):"v"(a),"v"(b));return r;}
__device__ __forceinline__ float fsub_s(float a,float b){float r;asm("v_sub_f32_e32 %0, %1, %2":"=v"(r):"v"(a),"v"(b));return r;}
typedef float f32x2_t __attribute__((ext_vector_type(2))); typedef __bf16 bf16x2_t __attribute__((ext_vector_type(2)));
__device__ __forceinline__ unsigned cvtpk_s(float lo,float hi){f32x2_t v={lo,hi};bf16x2_t b=__builtin_convertvector(v,bf16x2_t);return __builtin_bit_cast(unsigned,b);}
#define WAIT_BAR(N) asm volatile("s_waitcnt vmcnt(" #N ") lgkmcnt(0)\n\ts_barrier":::"memory")

__device__ __forceinline__ void qkt(f32x16&p0,f32x16&p1,const char*Kslot,const bf16x8*qr,const f32x16&negm,int r32,int hi){
  const char*kb=Kslot+hi*1024+r32*16;
  #pragma unroll
  for(int d0=0;d0<4;++d0){
    const bf16x8 b0=*reinterpret_cast<const bf16x8*>(kb+d0*2048);
    const bf16x8 b1=*reinterpret_cast<const bf16x8*>(kb+d0*2048+512);
    if(d0==0){p0=__builtin_amdgcn_mfma_f32_32x32x16_bf16(b0,qr[0],negm,0,0,0);p1=__builtin_amdgcn_mfma_f32_32x32x16_bf16(b1,qr[0],negm,0,0,0);}
    else{p0=__builtin_amdgcn_mfma_f32_32x32x16_bf16(b0,qr[d0],p0,0,0,0);p1=__builtin_amdgcn_mfma_f32_32x32x16_bf16(b1,qr[d0],p1,0,0,0);}}
}
typedef __attribute__((address_space(3))) const char* lds_cptr;
typedef short v4i16_t __attribute__((ext_vector_type(4)));
__device__ __forceinline__ void kload8(bf16x8*kf,lds_cptr kp){
  kf[0]=*(const __attribute__((address_space(3))) bf16x8*)(kp);      kf[1]=*(const __attribute__((address_space(3))) bf16x8*)(kp+512);
  kf[2]=*(const __attribute__((address_space(3))) bf16x8*)(kp+2048); kf[3]=*(const __attribute__((address_space(3))) bf16x8*)(kp+2560);
  kf[4]=*(const __attribute__((address_space(3))) bf16x8*)(kp+4096); kf[5]=*(const __attribute__((address_space(3))) bf16x8*)(kp+4608);
  kf[6]=*(const __attribute__((address_space(3))) bf16x8*)(kp+6144); kf[7]=*(const __attribute__((address_space(3))) bf16x8*)(kp+6656);
}
__device__ __forceinline__ void kload2(bf16x8*kf,lds_cptr kp,int j){ kf[2*j]=*(const __attribute__((address_space(3))) bf16x8*)(kp+j*2048); kf[2*j+1]=*(const __attribute__((address_space(3))) bf16x8*)(kp+j*2048+512); }
__device__ __forceinline__ s16x4 vtr(lds_cptr p){ return __builtin_bit_cast(s16x4,__builtin_amdgcn_ds_read_tr16_b64_v4i16((__attribute__((address_space(3))) v4i16_t*)p)); }
__device__ __forceinline__ float rowmax(const f32x16&p0,const f32x16&p1){
  float a=max3f(p0[0],p0[1],p1[0]),b=max3f(p0[2],p0[3],p1[1]);a=max3f(a,p1[2],p1[3]);
  #pragma unroll
  for(int r=4;r<16;r+=4){a=max3f(a,p0[r],p0[r+1]);b=max3f(b,p0[r+2],p0[r+3]);a=max3f(a,p1[r],p1[r+1]);b=max3f(b,p1[r+2],p1[r+3]);}
  const float m=max2f(a,b);
  auto rr=__builtin_amdgcn_permlane32_swap(__float_as_uint(m),__float_as_uint(m),false,false);
  return max2f(__uint_as_float(rr[0]),__uint_as_float(rr[1]));
}
__device__ __forceinline__ void pv(f32x16*o,int vb,bf16x8 pa0,bf16x8 pa1,bf16x8 pa2,bf16x8 pa3){
  #pragma unroll
  for(int d0=0;d0<2;++d0){s16x4 lo[4],hi[4];
    #pragma unroll
    for(int ks=0;ks<4;++ks){
      asm volatile("ds_read_b64_tr_b16 %0,%1 offset:%c2":"=&v"(lo[ks]):"v"(vb),"i"(d0*4096+ks*1024):"memory");
      asm volatile("ds_read_b64_tr_b16 %0,%1 offset:%c2":"=&v"(hi[ks]):"v"(vb),"i"(d0*4096+ks*1024+512):"memory");}
    asm volatile("s_waitcnt lgkmcnt(0)":::"memory");SBAR();
    #define PK(k) (bf16x8){lo[k][0],lo[k][1],lo[k][2],lo[k][3],hi[k][0],hi[k][1],hi[k][2],hi[k][3]}
    o[d0]=__builtin_amdgcn_mfma_f32_32x32x16_bf16(pa0,PK(0),o[d0],0,0,0);
    o[d0]=__builtin_amdgcn_mfma_f32_32x32x16_bf16(pa1,PK(1),o[d0],0,0,0);
    o[d0]=__builtin_amdgcn_mfma_f32_32x32x16_bf16(pa2,PK(2),o[d0],0,0,0);
    o[d0]=__builtin_amdgcn_mfma_f32_32x32x16_bf16(pa3,PK(3),o[d0],0,0,0);
    #undef PK
  }
}

#ifndef ATTN_STORE16
#define ATTN_STORE16(p,v) (*(u32x4*)(p)=(v))
#endif
template<int THRL> __device__ __forceinline__ void attn_unit(int b,int qkcol,int vcol,int qb,float slope2,const bf16*Q,const bf16*__restrict__ K,const bf16*__restrict__ V,bf16*O,char*shm){
  const int tid=opaque_tid(),lane=tid&63,r32=lane&31,hi=lane>>5; const int wid=__builtin_amdgcn_readfirstlane(tid>>6);
  const long rowbase=(long)b*SEQ; const int q0=qb*QB;
  const bf16*Qw=Q+(rowbase+q0+wid*QBLK)*DM+qkcol;
  const bf16*Kh=K+rowbase*DM+qkcol,*Vh=V+rowbase*DM+vcol;
  const unsigned lds0=(unsigned)(uintptr_t)shm;
  float*wsf=(float*)(shm+LDS_WS)+wid*64;
  const bf16*ksrc=Kh+(long)lane*DM+wid*8;
  const bf16*vsrc=Vh+(long)(16*(wid&3)+(lane>>2))*DM+(wid>>2)*32+(lane&3)*8;
  const unsigned kdst=lds0+LDS_K+wid*1024, vdst=lds0+LDS_V+wid*1024;
  #define DMA_K(t,slot) glds16(ksrc+(long)(t)*KVBLK*DM,(unsigned)__builtin_amdgcn_readfirstlane(kdst+(slot)))
  #define DMA_V(t,slot) glds16(vsrc+(long)(t)*KVBLK*DM,(unsigned)__builtin_amdgcn_readfirstlane(vdst+(slot)))
  const int vb0=(int)(lds0+LDS_V)+((lane>>4)&1)*32+(lane&3)*8+(4*hi+((lane&15)>>2))*64;
  const char*Kbase=shm+LDS_K; bf16x8 kf[8];
  const lds_cptr shm3=(lds_cptr)shm; const lds_cptr kp0=shm3+LDS_K+hi*1024+r32*16; const lds_cptr vp0=shm3+LDS_V+((lane>>4)&1)*32+(lane&3)*8+(4*hi+((lane&15)>>2))*64;
  const int NT=(q0+QB)/KVBLK;
  DMA_K(0,0);DMA_V(0,0);DMA_K(1,SLOTB);
  bf16x8 qr[4];
  #pragma unroll
  for(int d0=0;d0<4;++d0)qr[d0]=*reinterpret_cast<const bf16x8*>(&Qw[(long)r32*DM+d0*16+hi*8]);
  float mhat=0.f,l_reg=0.f;f32x16 o[2];o[0]=f32x16{};o[1]=f32x16{};const f32x16 negm=f32x16{};
  const int qrel=wid*QBLK+r32; float slope2v=slope2; asm volatile("":"+v"(slope2v));
  #define CMASK(P0,P1,t) do{int jb_=(t)-(NT-4); if(jb_>=0)cmask(P0,P1,jb_,qrel,hi);}while(0)
  #define ABIAS(P0,P1,t) do{ float kb_=slope2*(float)(64*(t)+4*hi)-mhat; asm volatile("":"+v"(kb_)); _Pragma("unroll") for(int r=0;r<16;++r){ P0[r]+=kb_; P1[r]+=kb_; } _Pragma("unroll") for(int r=0;r<16;++r){ const float cr_=(float)((r&3)+8*(r>>2)); P0[r]=__builtin_fmaf(slope2v,cr_,P0[r]); P1[r]=__builtin_fmaf(slope2v,cr_+32.f,P1[r]); } }while(0)
  bool resc=false;
  #define START(P0,P1) do{ const float rm=rowmax(P0,P1); resc=false; \
    { const float dl=rm; mhat=fadd_s(mhat,dl); \
      _Pragma("unroll") for(int r=0;r<16;++r){P0[r]=fsub_s(P0[r],dl);P1[r]=fsub_s(P1[r],dl);} \
      } \
    _Pragma("unroll") for(int r=0;r<16;++r)P0[r]=__builtin_amdgcn_exp2f(P0[r]); }while(0)
  #define RESC() do{ if(resc){ asm volatile("s_waitcnt lgkmcnt(0)":::"memory"); \
      _Pragma("unroll") for(int d_=0;d_<2;++d_) _Pragma("unroll") for(int r=0;r<16;++r)o[d_][r]*=wsf[crow(r,hi)]; } }while(0)
  f32x16 pA0,pA1,pB0,pB1;
  int sl_prev=0,sl_cur=0,sl_next=SLOTB;
  #define ROT() do{sl_prev=sl_cur;sl_cur=sl_next;sl_next=(sl_next==(NSLOT-1)*SLOTB)?0:sl_next+SLOTB;}while(0)
  DMA_K(2,2*SLOTB);
  WAIT_BAR(3);
  qkt(pA0,pA1,Kbase,qr,negm,r32,hi);asm volatile("s_nop 15\n\ts_nop 7":"+v"(pA0),"+v"(pA1));ABIAS(pA0,pA1,0);CMASK(pA0,pA1,0);
  START(pA0,pA1);
  _Pragma("unroll") for(int r=0;r<16;++r)pA1[r]=__builtin_amdgcn_exp2f(pA1[r]);
  WAIT_BAR(0);
  DMA_K(3,0);DMA_V(1,SLOTB);
  ROT();
  kload8(kf,kp0+sl_cur);
  WAIT_BAR(2);
  s16x4 vlo[8],vhi[8]; u32x4 pw0,pw1,pw2,pw3;
  #define PKW(P,B) cvtpk_s(P[B],P[B+1])
  #define PAF(k) __builtin_bit_cast(bf16x8,pw##k)
  #define VFR(i) (bf16x8){vlo[i][0],vlo[i][1],vlo[i][2],vlo[i][3],vhi[i][0],vhi[i][1],vhi[i][2],vhi[i][3]}
  #define PIN(x) asm volatile("":"+v"(x))
  #define MX3(a,b,c) __builtin_fmaxf(__builtin_fmaxf((a),(b)),(c))
  #define GAPA(MF,A0,A1,A2,A3,W0,W1,PW) do{ MF; sacc+=A0; sacc+=A1; sacc+=A2; sacc+=A3; PIN(sacc); W0; W1; PIN(PW); SBAR(); }while(0)
  #define EX(v) __builtin_amdgcn_exp2f(v)
  #define GAPB(MF,X,B) do{ MF; X[B]=EX(X[B]); X[B+1]=EX(X[B+1]); X[B+2]=EX(X[B+2]); X[B+3]=EX(X[B+3]); PIN(X); SBAR(); }while(0)
  #define VRD(i) do{ vlo[i]=vtr(vp_+(((i)>>2)*4096+((i)&3)*1024)); vhi[i]=vtr(vp_+(((i)>>2)*4096+((i)&3)*1024+512)); }while(0)
  #define KRD(G,j) do{ if(G){ kload2(kf,kp0+sl_next,j); SBAR(); } }while(0)
  #define STEP(C0,C1,P0,P1,t,GK,GV,GL) do{ SBAR(); \
    const lds_cptr vp_=vp0+sl_prev; \
    VRD(0); SBAR(); float sacc=(P0[0]+P0[1]); \
    GAPA(C0=__builtin_amdgcn_mfma_f32_32x32x16_bf16(kf[0],qr[0],negm,0,0,0), P0[2],P0[3],P0[4],P0[5],     pw0[0]=PKW(P0,0), pw0[1]=PKW(P0,2), pw0); \
    VRD(4); SBAR(); GAPA(C1=__builtin_amdgcn_mfma_f32_32x32x16_bf16(kf[1],qr[0],negm,0,0,0), P0[6],P0[7],P0[8],P0[9],     pw0[2]=PKW(P0,4), pw0[3]=PKW(P0,6), pw0); \
    VRD(1); SBAR(); GAPA(C0=__builtin_amdgcn_mfma_f32_32x32x16_bf16(kf[2],qr[1],C0,0,0,0),   P0[10],P0[11],P0[12],P0[13], pw1[0]=PKW(P0,8), pw1[1]=PKW(P0,10), pw1); \
    VRD(5); SBAR(); GAPA(C1=__builtin_amdgcn_mfma_f32_32x32x16_bf16(kf[3],qr[1],C1,0,0,0),   P0[14],P0[15],P1[0],P1[1],   pw1[2]=PKW(P0,12),pw1[3]=PKW(P0,14), pw1); \
    VRD(2); SBAR(); GAPA(C0=__builtin_amdgcn_mfma_f32_32x32x16_bf16(kf[4],qr[2],C0,0,0,0),   P1[2],P1[3],P1[4],P1[5],     pw2[0]=PKW(P1,0), pw2[1]=PKW(P1,2), pw2); \
    VRD(6); SBAR(); GAPA(C1=__builtin_amdgcn_mfma_f32_32x32x16_bf16(kf[5],qr[2],C1,0,0,0),   P1[6],P1[7],P1[8],P1[9],     pw2[2]=PKW(P1,4), pw2[3]=PKW(P1,6), pw2); \
    VRD(3); SBAR(); GAPA(C0=__builtin_amdgcn_mfma_f32_32x32x16_bf16(kf[6],qr[3],C0,0,0,0),   P1[10],P1[11],P1[12],P1[13], pw3[0]=PKW(P1,8), pw3[1]=PKW(P1,10), pw3); \
    VRD(7); SBAR(); GAPA(C1=__builtin_amdgcn_mfma_f32_32x32x16_bf16(kf[7],qr[3],C1,0,0,0),   P1[14],P1[15],0.f,0.f,       pw3[2]=PKW(P1,12),pw3[3]=PKW(P1,14), pw3); \
    l_reg+=sacc; \
    if(GK){DMA_K((t)+3,sl_cur);} if(GV){DMA_V((t)+1,sl_next);} \
    ABIAS(C0,C1,t); CMASK(C0,C1,t); \
    { float a=MX3(C0[0],C0[1],C1[0]),b=MX3(C0[2],C0[3],C1[1]); a=MX3(a,C1[2],C1[3]); \
      _Pragma("unroll") for(int r=4;r<16;r+=4){a=MX3(a,C0[r],C0[r+1]);b=MX3(b,C0[r+2],C0[r+3]);a=MX3(a,C1[r],C1[r+1]);b=MX3(b,C1[r+2],C1[r+3]);} \
      float rm=__builtin_fmaxf(a,b); { auto rr=__builtin_amdgcn_permlane32_swap(__float_as_uint(rm),__float_as_uint(rm),false,false); rm=__builtin_fmaxf(__uint_as_float(rr[0]),__uint_as_float(rr[1])); } \
      resc=false; \
      if(__builtin_expect(__any(rm>(float)THRL),0)){ const float dl=__builtin_fmaxf(rm,0.f); mhat+=dl; \
        _Pragma("unroll") for(int r=0;r<16;++r){C0[r]-=dl;C1[r]-=dl;} \
        const float f=__builtin_amdgcn_exp2f(-dl); l_reg*=f; if(hi==0)wsf[r32]=f; resc=true; } } \
    SBAR(); \
    GAPB(o[0]=__builtin_amdgcn_mfma_f32_32x32x16_bf16(PAF(0),VFR(0),o[0],0,0,0), C0,0); \
    GAPB(o[1]=__builtin_amdgcn_mfma_f32_32x32x16_bf16(PAF(0),VFR(4),o[1],0,0,0), C0,4); \
    KRD(GL,0); GAPB(o[0]=__builtin_amdgcn_mfma_f32_32x32x16_bf16(PAF(1),VFR(1),o[0],0,0,0), C0,8); \
    KRD(GL,1); GAPB(o[1]=__builtin_amdgcn_mfma_f32_32x32x16_bf16(PAF(1),VFR(5),o[1],0,0,0), C0,12); \
    KRD(GL,2); GAPB(o[0]=__builtin_amdgcn_mfma_f32_32x32x16_bf16(PAF(2),VFR(2),o[0],0,0,0), C1,0); \
    KRD(GL,3); GAPB(o[1]=__builtin_amdgcn_mfma_f32_32x32x16_bf16(PAF(2),VFR(6),o[1],0,0,0), C1,4); \
    GAPB(o[0]=__builtin_amdgcn_mfma_f32_32x32x16_bf16(PAF(3),VFR(3),o[0],0,0,0), C1,8); \
    GAPB(o[1]=__builtin_amdgcn_mfma_f32_32x32x16_bf16(PAF(3),VFR(7),o[1],0,0,0), C1,12); \
    }while(0)
  int t=1;
  #undef CMASK
  #define CMASK(P0,P1,t) do{}while(0)
  for(;t+5<NT;t+=2){
    STEP(pB0,pB1,pA0,pA1,t,true,true,true);     WAIT_BAR(2); RESC(); ROT();
    STEP(pA0,pA1,pB0,pB1,t+1,true,true,true);   WAIT_BAR(2); RESC(); ROT();
  }
  #undef CMASK
  #define CMASK(P0,P1,t) do{int jb_=(t)-(NT-4); if(jb_>=0)cmask(P0,P1,jb_,qrel,hi);}while(0)
  #define ENDW(tt) do{ if((tt)+3<NT){WAIT_BAR(2);} else if((tt)+2<NT){WAIT_BAR(1);} else {WAIT_BAR(0);} }while(0)
  for(;t+1<NT;t+=2){
    STEP(pB0,pB1,pA0,pA1,t,(t+3<NT),(t+1<NT),(t+1<NT));       ENDW(t);   RESC(); ROT();
    STEP(pA0,pA1,pB0,pB1,t+1,(t+4<NT),(t+2<NT),(t+2<NT));     ENDW(t+1); RESC(); ROT();
  }
  STEP(pB0,pB1,pA0,pA1,NT-1,false,false,false); RESC();
  { float sacc=pB0[0]+pB0[1]; _Pragma("unroll") for(int r=2;r<16;++r)sacc+=pB0[r]; _Pragma("unroll") for(int r=0;r<16;++r)sacc+=pB1[r]; l_reg+=sacc;
    pw0=(u32x4){PKW(pB0,0),PKW(pB0,2),PKW(pB0,4),PKW(pB0,6)};pw1=(u32x4){PKW(pB0,8),PKW(pB0,10),PKW(pB0,12),PKW(pB0,14)};pw2=(u32x4){PKW(pB1,0),PKW(pB1,2),PKW(pB1,4),PKW(pB1,6)};pw3=(u32x4){PKW(pB1,8),PKW(pB1,10),PKW(pB1,12),PKW(pB1,14)};
    SBAR(); pv(o,vb0+sl_cur,PAF(0),PAF(1),PAF(2),PAF(3)); }
  #undef PKW
  #undef PAF
  #undef VFR
  #undef PIN
  #undef MX3
  #undef GAPA
  #undef GAPB
  #undef EX
  #undef VRD
  #undef KRD
  #undef STEP
  #undef ENDW
  {auto rr=__builtin_amdgcn_permlane32_swap(__float_as_uint(l_reg),__float_as_uint(l_reg),false,false);l_reg=__uint_as_float(rr[0])+__uint_as_float(rr[1]);}
  int lane_e=lane; asm volatile("":"+v"(lane_e)); const int r32e=lane_e&31, hie=lane_e>>5;
  if(hie==0)wsf[32+r32e]=l_reg;asm volatile("s_waitcnt lgkmcnt(0)":::"memory");
  float rli[16];
  #pragma unroll
  for(int r=0;r<16;++r)rli[r]=__builtin_amdgcn_rcpf(wsf[32+crow(r,hie)]);
  bf16*Ow=O+(rowbase+q0+wid*QBLK)*DM+vcol;
  { bf16*stg=(bf16*)(shm+LDS_OST)+wid*2048;
    #pragma unroll
    for(int r=0;r<16;++r){const int orow=crow(r,hie);
      #pragma unroll
      for(int d0=0;d0<2;++d0)stg[orow*64+d0*32+r32e]=__float2bfloat16(o[d0][r]*rli[r]);}
    asm volatile("s_waitcnt lgkmcnt(0)":::"memory");
    #pragma unroll
    for(int i=0;i<4;++i){const int row=i*8+(lane_e>>3),ch=lane_e&7; const u32x4 v=*(const u32x4*)(stg+row*64+ch*8); ATTN_STORE16(Ow+(long)row*DM+ch*8,v);} }
  asm volatile("s_waitcnt lgkmcnt(0)\n\ts_barrier":::"memory");
  #undef DMA_K
  #undef DMA_V
  #undef CMASK
  #undef ABIAS
  #undef START
  #undef RESC
  #undef ROT
}
constexpr int ATTN_LDS_BYTES=LDS_BYTES;
#undef SBAR
#undef WAIT_BAR
}

__device__ __forceinline__ void attn_unit_ref(const Params& p, unsigned char* lds, int b, int h, int comp, int qb) {
    const int tid = opaque_tid(), row = tid & 255, dh = tid >> 8;
    float* Kt = (float*)lds; float* Vt = Kt + 64 * 64;
    const bf16_t* qbuf = (const bf16_t*)(p.ws + WS_INBUF); const bf16_t* kbuf = qbuf + (size_t)T * 1024; const bf16_t* vbuf = kbuf + (size_t)T * 1024;
    bf16_t* Op = (bf16_t*)(p.ws + WS_OPART) + (size_t)comp * T * 1024;
    const size_t rowbase = (size_t)b * SEQ; const int qpos = qb * 256 + row;
    float qv[64], o[64];
    { const bf16_t* qp = qbuf + (rowbase + qpos) * 1024 + h * 128 + comp * 64;
#pragma unroll
      for (int d = 0; d < 64; d += 8) { const u32x4 w = *(const u32x4*)(qp + d);
#pragma unroll
          for (int i = 0; i < 4; ++i) { qv[d + 2 * i] = bflo(w[i]); qv[d + 2 * i + 1] = bfhi(w[i]); } } }
#pragma unroll
    for (int d = 0; d < 64; ++d) o[d] = 0.f;
    float mrun = -1e30f, l = 0.f;
    const float slope2 = exp2f(-(float)(h + 1)) * LOG2E;
    const int ntile = (qb + 1) * 4;
    for (int kt = 0; kt < ntile; ++kt) {
        __syncthreads();
        for (int ch = tid; ch < 1536; ch += NTHREADS) { const int r = ch / 24, cc = ch % 24; const size_t grow = rowbase + kt * 64 + r;
            if (cc < 8) { const u32x4 w = *(const u32x4*)(kbuf + grow * 1024 + h * 128 + comp * 64 + cc * 8);
#pragma unroll
                for (int i = 0; i < 4; ++i) { Kt[r * 64 + cc * 8 + 2 * i] = bflo(w[i]); Kt[r * 64 + cc * 8 + 2 * i + 1] = bfhi(w[i]); } }
            else { const int c2 = cc - 8; const u32x4 w = *(const u32x4*)(vbuf + grow * 1024 + h * 128 + c2 * 8);
#pragma unroll
                for (int i = 0; i < 4; ++i) { Vt[r * 128 + c2 * 8 + 2 * i] = bflo(w[i]); Vt[r * 128 + c2 * 8 + 2 * i + 1] = bfhi(w[i]); } } }
        __syncthreads();
        for (int j = 0; j < 64; ++j) {
            const int kpos = kt * 64 + j; if (kpos > qpos) break;
            float s = 0.f;
#pragma unroll
            for (int d = 0; d < 64; d += 4) { const f32x4 kv = *(const f32x4*)(Kt + j * 64 + d); s += qv[d] * kv[0] + qv[d + 1] * kv[1] + qv[d + 2] * kv[2] + qv[d + 3] * kv[3]; }
            s += slope2 * (float)kpos;
            if (s > mrun) { const float f = exp2f(mrun - s); l *= f;
#pragma unroll
                for (int d = 0; d < 64; ++d) o[d] *= f;
                mrun = s; }
            const float pr = exp2f(s - mrun); l += pr;
#pragma unroll
            for (int d = 0; d < 64; d += 4) { const f32x4 vv = *(const f32x4*)(Vt + j * 128 + dh * 64 + d); o[d] += pr * vv[0]; o[d + 1] += pr * vv[1]; o[d + 2] += pr * vv[2]; o[d + 3] += pr * vv[3]; }
        }
    }
    const float il = 1.0f / l;
    bf16_t* op = Op + (rowbase + qpos) * 1024 + h * 128 + dh * 64;
#pragma unroll
    for (int d = 0; d < 64; d += 8) { u32x4 w; w.x = pk2(o[d] * il, o[d + 1] * il); w.y = pk2(o[d + 2] * il, o[d + 3] * il); w.z = pk2(o[d + 4] * il, o[d + 5] * il); w.w = pk2(o[d + 6] * il, o[d + 7] * il); *(u32x4*)(op + d) = w; }
    __syncthreads();
}

__device__ __forceinline__ void attn_phase_queue(const Params& p, unsigned char* lds, unsigned* qctr) {
    const attn_body::bf16* Q = (const attn_body::bf16*)(p.ws + WS_INBUF); const attn_body::bf16* K = Q + (size_t)T * 1024; const attn_body::bf16* V = K + (size_t)T * 1024;
    attn_body::bf16* OP = (attn_body::bf16*)(p.ws + WS_OPART);
    volatile int* slot = (volatile int*)(lds + LDS_BYTES - 64);
    for (;;) {
        __syncthreads();
        if (threadIdx.x == 0) *slot = (int)atomicAdd(qctr, 1u);
        __syncthreads();
        const int u = __builtin_amdgcn_readfirstlane(*slot);
        if (u >= 2048) break;
        const int qb = 7 - (u >> 8), id = u & 255;
        const int vh = id & 1, comp = (id >> 1) & 1, h = (id >> 2) & 7, b = id >> 5;
        const float slope2 = exp2f(-(float)(h + 1)) * LOG2E;
        attn_body::attn_unit<8>(b, h * 128 + comp * 64, h * 128 + vh * 64, qb, slope2, Q, K, V, OP + (size_t)comp * T * 1024, (char*)lds);
    }
}

__device__ __forceinline__ void phase_combine(const Params& p) {
    const int tid = opaque_tid(), lane = tid & 63, wave = tid >> 6;
    const int gw = blockIdx.x * NWAVES + wave, NGW = gridDim.x * NWAVES;
    const float s1 = wave_sum(p.in[4][lane] * p.in[5][lane]), s2 = wave_sum(p.in[6][lane] * p.in[7][lane]);
    const float lam = __expf(s1) - __expf(s2) + 0.2f;
    const bf16_t* O0 = (const bf16_t*)(p.ws + WS_OPART); const bf16_t* O1 = O0 + (size_t)T * 1024; bf16_t* O = (bf16_t*)(p.ws + WS_O);
    const float* sg = p.in[8] + (lane & 7) * 16;
    for (int m = gw; m < T; m += NGW) {
        const u32x4 a0 = *(const u32x4*)(O0 + (size_t)m * 1024 + lane * 16), a1 = *(const u32x4*)(O0 + (size_t)m * 1024 + lane * 16 + 8);
        const u32x4 c0 = *(const u32x4*)(O1 + (size_t)m * 1024 + lane * 16), c1 = *(const u32x4*)(O1 + (size_t)m * 1024 + lane * 16 + 8);
        float d[16]; float ss = 0.f;
#pragma unroll
        for (int i = 0; i < 4; ++i) { d[2 * i] = bflo(a0[i]) - lam * bflo(c0[i]); d[2 * i + 1] = bfhi(a0[i]) - lam * bfhi(c0[i]); d[8 + 2 * i] = bflo(a1[i]) - lam * bflo(c1[i]); d[8 + 2 * i + 1] = bfhi(a1[i]) - lam * bfhi(c1[i]); }
#pragma unroll
        for (int i = 0; i < 16; ++i) ss += d[i] * d[i];
        ss += __shfl_xor(ss, 1); ss += __shfl_xor(ss, 2); ss += __shfl_xor(ss, 4);
        const float rs = 0.8f / sqrtf(ss * (1.0f / 128.0f) + 1e-6f);
        u32x4 w0, w1;
        w0.x = pk2(d[0] * rs * sg[0], d[1] * rs * sg[1]); w0.y = pk2(d[2] * rs * sg[2], d[3] * rs * sg[3]); w0.z = pk2(d[4] * rs * sg[4], d[5] * rs * sg[5]); w0.w = pk2(d[6] * rs * sg[6], d[7] * rs * sg[7]);
        w1.x = pk2(d[8] * rs * sg[8], d[9] * rs * sg[9]); w1.y = pk2(d[10] * rs * sg[10], d[11] * rs * sg[11]); w1.z = pk2(d[12] * rs * sg[12], d[13] * rs * sg[13]); w1.w = pk2(d[14] * rs * sg[14], d[15] * rs * sg[15]);
        *(u32x4*)(O + (size_t)m * DM + lane * 16) = w0; *(u32x4*)(O + (size_t)m * DM + lane * 16 + 8) = w1;
    }
}

__device__ __forceinline__ void phase_router(const Params& p, unsigned char* lds) {
    const int tid = opaque_tid(), lane = tid & 63, wave = tid >> 6;
    float* hs = (float*)lds;
    float* Wsm = hs + 64 * 260;
    float* lg = Wsm + 36 * 256;
    const float* h = p.out; const float* gf = p.in[24]; const float* wg = p.in[25]; const float* we = p.in[27];
    const float* ss2 = (const float*)(p.ws + WS_CTL + CTL_SS2); float* rstd2 = (float*)(p.ws + WS_RSTD2);
    unsigned* cnt = (unsigned*)(p.ws + WS_CTL + CTL_CNT); int* rt = (int*)(p.ws + WS_RT); float* gateb = (float*)(p.ws + WS_GATEB); int* tokinfo = (int*)(p.ws + WS_TOKINFO);
    for (int tb = blockIdx.x; tb < T / 64; tb += gridDim.x) {
        const int tok0 = tb * 64;
        float acc[5];
#pragma unroll
        for (int i = 0; i < 5; ++i) acc[i] = 0.f;
        for (int k0 = 0; k0 < DM; k0 += 256) {
            __syncthreads();
            for (int ch = tid; ch < 64 * 64; ch += NTHREADS) { const int r = ch >> 6, c4 = ch & 63; *(f32x4*)(hs + r * 260 + c4 * 4) = *(const f32x4*)(h + (size_t)(tok0 + r) * DM + k0 + c4 * 4); }
            for (int id = tid; id < 36 * 256; id += NTHREADS) { const int k = id / 36, cc = id % 36; const float w = cc < 4 ? wg[(size_t)(k0 + k) * 4 + cc] : we[(size_t)(k0 + k) * 32 + cc - 4]; Wsm[cc * 256 + k] = w * gf[k0 + k]; }
            __syncthreads();
            for (int k = 0; k < 256; k += 4) { const f32x4 hv = *(const f32x4*)(hs + lane * 260 + k);
#pragma unroll
                for (int i = 0; i < 5; ++i) { const int cc = wave + 8 * i; if (cc < 36) { const f32x4 wv = *(const f32x4*)(Wsm + cc * 256 + k); acc[i] += hv[0] * wv[0] + hv[1] * wv[1] + hv[2] * wv[2] + hv[3] * wv[3]; } } }
        }
#pragma unroll
        for (int i = 0; i < 5; ++i) { const int cc = wave + 8 * i; if (cc < 36) lg[lane * 40 + cc] = acc[i]; }
        __syncthreads();
        if (tid < 64) {
            const int t = tok0 + tid; const float rs = 1.0f / sqrtf(ss2[t] * (1.0f / DM) + 1e-6f); rstd2[t] = rs;
            float g4[4]; int grp = 0; float gmax = -3.0e38f;
#pragma unroll
            for (int i = 0; i < 4; ++i) { g4[i] = lg[tid * 40 + i] * rs + p.in[26][i]; if (g4[i] > gmax) { gmax = g4[i]; grp = i; } }
            float gs = 0.f;
#pragma unroll
            for (int i = 0; i < 4; ++i) gs += __expf(g4[i] - gmax);
            const float pg = 1.0f / gs;
            float e8[8]; int i0 = 0; float m0 = -3.0e38f;
#pragma unroll
            for (int i = 0; i < 8; ++i) { e8[i] = lg[tid * 40 + 4 + grp * 8 + i] * rs + p.in[28][grp * 8 + i]; if (e8[i] > m0) { m0 = e8[i]; i0 = i; } }
            int i1 = 0; float m1 = -3.0e38f;
#pragma unroll
            for (int i = 0; i < 8; ++i) if (i != i0 && e8[i] > m1) { m1 = e8[i]; i1 = i; }
            const float p1 = __expf(m1 - m0); const float g0 = pg / (1.0f + p1), g1 = pg * p1 / (1.0f + p1);
            const int e0 = grp * 8 + i0, e1 = grp * 8 + i1;
            const unsigned r0 = atomicAdd(cnt + e0, 1u), r1 = atomicAdd(cnt + e1, 1u);
            rt[(size_t)e0 * CAP + r0] = t; rt[(size_t)e1 * CAP + r1] = t; gateb[(size_t)e0 * CAP + r0] = g0; gateb[(size_t)e1 * CAP + r1] = g1;
            int4 ti; ti.x = e0 * CAP + (int)r0; ti.y = e1 * CAP + (int)r1; ti.z = 0; ti.w = 0; *(int4*)(tokinfo + (size_t)t * 4) = ti;
        }
        __syncthreads();
    }
}

__device__ __forceinline__ void phase_final(const Params& p, unsigned char* lds) {
    const int tid = opaque_tid(), lane = tid & 63, wave = tid >> 6;
    const int gw = blockIdx.x * NWAVES + wave, NGW = gridDim.x * NWAVES;
    int* pst = (int*)lds;
    const unsigned* cnt = (const unsigned*)(p.ws + WS_CTL + CTL_CNT);
    if (tid == 0) { int ts = 0; for (int e = 0; e < NEXP; ++e) { pst[e] = ts; ts += ((int)cnt[e] + 255) >> 8; } }
    __syncthreads();
    const int* tokinfo = (const int*)(p.ws + WS_TOKINFO); const bf16_t* yb = (const bf16_t*)(p.ws + WS_YB); const float* gfin = p.in[32]; float* out = p.out;
    for (int m = gw; m < T; m += NGW) {
        const int4 ti = *(const int4*)(tokinfo + (size_t)m * 4);
        const int e0 = ti.x / CAP, r0 = ti.x % CAP, e1 = ti.y / CAP, r1 = ti.y % CAP;
        const size_t s0 = (size_t)pst[e0] * 256 + r0, s1 = (size_t)pst[e1] * 256 + r1;
        f32x4* hr = (f32x4*)(out + (size_t)m * DM) + lane; const u32x2* y0 = (const u32x2*)(yb + s0 * DM) + lane; const u32x2* y1 = (const u32x2*)(yb + s1 * DM) + lane;
        f32x4 v[8]; float s = 0.f;
#pragma unroll
        for (int j = 0; j < 8; ++j) { v[j] = hr[64 * j]; const u32x2 a = y0[64 * j], b2 = y1[64 * j];
            v[j][0] += bflo(a.x) + bflo(b2.x); v[j][1] += bfhi(a.x) + bfhi(b2.x); v[j][2] += bflo(a.y) + bflo(b2.y); v[j][3] += bfhi(a.y) + bfhi(b2.y);
            s += (v[j][0] * v[j][0] + v[j][1] * v[j][1]) + (v[j][2] * v[j][2] + v[j][3] * v[j][3]); }
        s = wave_sum(s); const float rs = 1.0f / sqrtf(s * (1.0f / DM) + 1e-6f);
#pragma unroll
        for (int j = 0; j < 8; ++j) { const f32x4 gv = *((const f32x4*)gfin + lane + 64 * j); hr[64 * j] = v[j] * rs * gv; }
    }
}

#if USE_REF_GEMM
#define GEMM_PHASE gemm_phase_ref
#else
#define GEMM_PHASE gemm_phase_mfma
#endif

__global__ void __launch_bounds__(NTHREADS, 2) fwd_kernel(Params p) {
    extern __shared__ __attribute__((aligned(16))) unsigned char lds[];
    unsigned char* ws = p.ws;
    const int lo = p.ph_lo, hi = p.ph_hi;
#define IN(k) (lo <= (k) && (k) < hi)
#if N_LAUNCH_MODE == 1
    cg::grid_group grid = cg::this_grid();
#define SEAM(k) do { if (IN(k) && IN((k) + 1)) grid.sync(); } while (0)
#else
#define SEAM(k) do { } while (0)
#endif
    if (IN(PH_PRO)) { phase_prologue(p, lds); } SEAM(PH_PRO);
    if (IN(PH_INPROJ)) {
        Gemm g{(const bf16_t*)(ws + WS_XB), (const bf16_t*)(ws + WS_WIN), DM, DM, DM};
        DenseOrder S; S.init(T, NIN, gridDim.x, blockIdx.x, DM, DM);
        EpiIn E{(bf16_t*)(ws + WS_INBUF), (bf16_t*)(ws + WS_PBUF), (const float*)(ws + WS_RSTD1)};
        GEMM_PHASE<EpiIn, DenseOrder>(lds, g, S, E);
    } SEAM(PH_INPROJ);
    if (IN(PH_L2PREP)) { phase_l2prep(p); } SEAM(PH_L2PREP);
    if (IN(PH_L2GEMM)) {
        Gemm g{(const bf16_t*)(ws + WS_A2), (const bf16_t*)(ws + WS_L2T), PW, 256, 256};
        DenseOrder S; S.init(T, 3072, gridDim.x, blockIdx.x, PW, 256, 2, 256);
        EpiL2 E{(float*)(ws + WS_WL), (bf16_t*)(ws + WS_ABUF), (bf16_t*)(ws + WS_GBUF), p.in[11], p.in[14]};
        GEMM_PHASE<EpiL2, DenseOrder>(lds, g, S, E);
    } SEAM(PH_L2GEMM);
    if (IN(PH_MIX)) {
        for (int rep = 0; rep < ((PROBE_DUP & 1) ? 2 : 1); ++rep)
        if ((blockIdx.x & 1) == 0) for (int chain = blockIdx.x >> 1; chain < BATCH * NH_RW; chain += (gridDim.x + 1) >> 1) rwkv_chain(p, lds, chain);
        attn_phase_queue(p, lds, (unsigned*)(ws + WS_CTL + CTL_QCTR));
        if (PROBE_DUP & 2) attn_phase_queue(p, lds, (unsigned*)(ws + WS_CTL + CTL_QCTR) + 1);
    } SEAM(PH_MIX);
    if (IN(PH_COMB)) { phase_combine(p); } SEAM(PH_COMB);
    if (IN(PH_OUT)) {
        Gemm g{(const bf16_t*)(ws + WS_O), (const bf16_t*)(ws + WS_WOUT), DM, DM, DM};
        DenseOrder S; S.init(T, DM, gridDim.x, blockIdx.x, DM, DM);
        EpiOut E{p.in[0], p.out, (bf16_t*)(ws + WS_HB), (float*)(ws + WS_CTL + CTL_SS2)};
        GEMM_PHASE<EpiOut, DenseOrder>(lds, g, S, E);
    } SEAM(PH_OUT);
    if (IN(PH_ROUTE)) { phase_router(p, lds); convert_experts(p, lds); } SEAM(PH_ROUTE);
    if (IN(PH_G1)) {
        Gemm g{(const bf16_t*)(ws + WS_HB), (const bf16_t*)(ws + WS_WGU), DM, DM, DM};
        MoeOrder<true> S{(const unsigned*)(ws + WS_CTL + CTL_CNT), (const int*)(ws + WS_RT), 4, (int)gridDim.x, (int)blockIdx.x, 0, DM, (long)1024 * 2048, DM};
        EpiGU E{(bf16_t*)(ws + WS_HID), (const float*)(ws + WS_RSTD2)};
        GEMM_PHASE<EpiGU, MoeOrder<true>>(lds, g, S, E);
    } SEAM(PH_G1);
    if (IN(PH_G2)) {
        Gemm g{(const bf16_t*)(ws + WS_HID), (const bf16_t*)(ws + WS_WD), DEXP, DEXP, DEXP};
        MoeOrder<false> S{(const unsigned*)(ws + WS_CTL + CTL_CNT), (const int*)(ws + WS_RT), 8, (int)gridDim.x, (int)blockIdx.x, 1, DEXP, (long)2048 * 512, DEXP};
        EpiDown E{(bf16_t*)(ws + WS_YB), (const float*)(ws + WS_GATEB), (const unsigned*)(ws + WS_CTL + CTL_CNT)};
        GEMM_PHASE<EpiDown, MoeOrder<false>>(lds, g, S, E);
    } SEAM(PH_G2);
    if (IN(PH_FINAL)) { phase_final(p, lds); }
}

extern "C" void kernel_launch(void* const* d_in, const int* in_sizes, int n_in, void* d_out, int out_size, void* d_ws, size_t ws_size, hipStream_t stream) {
    static int grid = 0;
    if (grid == 0) {
        if (n_in != 33 || out_size != T * DM || ws_size < WS_END) { fprintf(stderr, "kernel_launch: unexpected problem (n_in %d out %d ws %zu)\n", n_in, out_size, ws_size); grid = -1; return; }
        int dev = 0, cus = 0;
        hipGetDevice(&dev); hipDeviceGetAttribute(&cus, hipDeviceAttributeMultiprocessorCount, dev);
        if (hipFuncSetAttribute((const void*)fwd_kernel, hipFuncAttributeMaxDynamicSharedMemorySize, LDS_BYTES) != hipSuccess) { fprintf(stderr, "kernel_launch: hipFuncSetAttribute failed\n"); grid = -1; return; }
        int per_cu = 0; hipOccupancyMaxActiveBlocksPerMultiprocessor(&per_cu, (const void*)fwd_kernel, NTHREADS, LDS_BYTES); (void)hipGetLastError();
        if (per_cu < 1) fprintf(stderr, "kernel_launch: occupancy query says %d blocks per CU\n", per_cu);
        grid = cus > 0 ? cus : 256;
    }
    if (grid < 0) return;
    hipMemsetAsync((char*)d_ws + WS_CTL, 0, CTL_BYTES, stream);
    Params p{};
    for (int i = 0; i < 33; ++i) p.in[i] = (const float*)d_in[i];
    p.out = (float*)d_out; p.ws = (unsigned char*)d_ws;
#if N_LAUNCH_MODE == 1
    p.ph_lo = 0; p.ph_hi = PH_COUNT;
    void* args[] = {&p};
    hipError_t e = hipLaunchCooperativeKernel((const void*)fwd_kernel, dim3(grid), dim3(NTHREADS), args, LDS_BYTES, stream);
    if (e != hipSuccess) fprintf(stderr, "cooperative launch failed: %s (grid %d)\n", hipGetErrorString(e), grid);
#else
    for (int ph = 0; ph < PH_COUNT; ++ph) { p.ph_lo = ph; p.ph_hi = ph + 1; hipLaunchKernelGGL(fwd_kernel, dim3(grid), dim3(NTHREADS), LDS_BYTES, stream, p); }
#endif
}
```

```cpp
#include <hip/hip_runtime.h>
#include <hip/hip_cooperative_groups.h>
#include <cstdio>
#include <cstdint>
namespace cg = cooperative_groups;

#ifndef N_LAUNCH_MODE
#define N_LAUNCH_MODE 1
#endif
#ifndef PROBE_DUP
#define PROBE_DUP 0
#endif
#ifndef USE_REF_ATTN
#define USE_REF_ATTN 0
#endif
#ifndef USE_REF_GEMM
#define USE_REF_GEMM 0
#endif

constexpr int BATCH = 8, SEQ = 2048, DM = 2048, T = BATCH * SEQ;
constexpr int DAW = 1024, RWW = 1024, NH_DA = 8, NH_RW = 16;
constexpr int NIN = 6912;
constexpr int PW = 768;
constexpr int NEXP = 32, DEXP = 512, CAP = T;
constexpr int MAXTILES = 160;
constexpr float C2Q = 0.125f * 1.4426950408889634f;
constexpr float LOG2E = 1.4426950408889634f;

constexpr size_t MiB = 1u << 20;
constexpr size_t WS_CTL = 0, CTL_BYTES = 1 * MiB;
constexpr size_t CTL_SS2 = 65536;
constexpr size_t CTL_CNT = 131072;
constexpr size_t CTL_QCTR = 131072 + 256;
constexpr size_t CTL_BAR = 262144;
constexpr size_t WS_WOUT = 1 * MiB;
constexpr size_t WS_L2T = 9 * MiB;
constexpr size_t WS_RSTD1 = 11 * MiB;
constexpr size_t WS_RSTD2 = 11 * MiB + 65536;
constexpr size_t WS_TOKINFO = 11 * MiB + 131072;
constexpr size_t WS_WIN = 12 * MiB;
constexpr size_t WS_XB = 40 * MiB;
constexpr size_t WS_O = 40 * MiB;
constexpr size_t WS_INBUF = 104 * MiB;
constexpr size_t WS_PBUF = 296 * MiB;
constexpr size_t WS_A2 = 320 * MiB;
constexpr size_t WS_WL = 344 * MiB;
constexpr size_t WS_ABUF = 408 * MiB;
constexpr size_t WS_GBUF = 440 * MiB;
constexpr size_t WS_OPART = 472 * MiB;
constexpr size_t WS_HB = 104 * MiB;
constexpr size_t WS_WGU = 168 * MiB;
constexpr size_t WS_WD = 296 * MiB;
constexpr size_t WS_RT = 360 * MiB;
constexpr size_t WS_GATEB = 362 * MiB;
constexpr size_t WS_HID = 364 * MiB;
constexpr size_t WS_YB = 404 * MiB;
constexpr size_t WS_END = 564 * MiB;

constexpr int NTHREADS = 512, NWAVES = 8;
constexpr int LDS_BYTES = 147456;

typedef unsigned short bf16_t;
typedef short bf16x8 __attribute__((ext_vector_type(8)));
typedef float f32x4 __attribute__((ext_vector_type(4)));
typedef float f32x2 __attribute__((ext_vector_type(2)));
typedef unsigned u32x4 __attribute__((ext_vector_type(4)));
typedef unsigned u32x2 __attribute__((ext_vector_type(2)));

__device__ __forceinline__ unsigned f2bf(float f) { unsigned u = __builtin_bit_cast(unsigned, f); return (u + 0x7fffu + ((u >> 16) & 1u)) >> 16; }
__device__ __forceinline__ unsigned pk2(float lo, float hi) { return f2bf(lo) | (f2bf(hi) << 16); }
__device__ __forceinline__ float bf2f(unsigned h) { return __builtin_bit_cast(float, h << 16); }
__device__ __forceinline__ float bflo(unsigned w) { return __builtin_bit_cast(float, w << 16); }
__device__ __forceinline__ float bfhi(unsigned w) { return __builtin_bit_cast(float, w & 0xffff0000u); }
__device__ __forceinline__ float wave_sum(float v) {
#pragma unroll
    for (int o = 1; o < 64; o <<= 1) v += __shfl_xor(v, o);
    return v;
}
__device__ __forceinline__ int opaque_tid() { int t = threadIdx.x; asm volatile("" : "+v"(t)); return t; }
__device__ __forceinline__ float sigmoidf_(float x) { return 1.0f / (1.0f + __expf(-x)); }

struct Params {
    const float* in[33];
    float* out;
    unsigned char* ws;
    int ph_lo, ph_hi;
};

enum { PH_PRO = 0, PH_INPROJ, PH_L2PREP, PH_L2GEMM, PH_MIX, PH_COMB, PH_OUT, PH_ROUTE, PH_G1, PH_G2, PH_FINAL, PH_COUNT };

struct Unit { int pm, pn; long a_off, b_off; const int* gidx; int valid, e, tile, k; };
struct Gemm { const bf16_t* A; const bf16_t* Bt; int lda, ldb, K; };

struct DenseOrder {
    static constexpr bool GATHER = false;
    int nM, nN, nwg, G, c, lda, ldb, acol_shift, acol_w;
    __device__ void init(int M, int N, int G_, int c_, int lda_, int ldb_, int acol_shift_ = -1, int acol_w_ = 0) {
        nM = M / 256; nN = N / 256; nwg = nM * nN; G = G_; c = c_; lda = lda_; ldb = ldb_; acol_shift = acol_shift_; acol_w = acol_w_; }
    __device__ bool next(int i, Unit& u) const {
        const long L = (long)i * G + c; if (L >= nwg) return false;
        int wgid = (int)L; { const int q = nwg / 8, r = nwg % 8, xcd = wgid % 8, off = wgid / 8; wgid = (xcd < r ? xcd * (q + 1) : r * (q + 1) + (xcd - r) * q) + off; }
        const int nig = 8 * nN, gid = wgid / nig, fm = gid * 8, gsz = (nM - fm) < 8 ? (nM - fm) : 8;
        u.pm = fm + ((wgid % nig) % gsz); u.pn = (wgid % nig) / gsz;
        u.a_off = (long)u.pm * 256 * lda + (acol_shift >= 0 ? (long)(u.pn >> acol_shift) * acol_w : 0);
        u.b_off = (long)u.pn * 256 * ldb; u.gidx = nullptr; u.valid = 256; u.e = 0; u.tile = 0; u.k = 0; return true;
    }
};
template <bool GATHER_> struct MoeOrder {
    static constexpr bool GATHER = GATHER_;
    const unsigned* cnt; const int* rt; int ncol, G, c, mode; long a_ld, b_estride, b_ld;
    __device__ bool next(int i, Unit& u) const {
        const long L = (long)i * G + c; const int g = (int)(L / ncol), pn = (int)(L % ncol);
        int ts = 0, e = 0, k = -1, ce = 0;
        for (e = 0; e < NEXP; ++e) { ce = __builtin_amdgcn_readfirstlane((int)cnt[e]); const int nt = (ce + 255) >> 8; if (g < ts + nt) { k = g - ts; break; } ts += nt; }
        if (k < 0) return false;
        u.pm = g; u.pn = pn; u.e = e; u.tile = g; u.k = k; u.valid = (ce - 256 * k) < 256 ? (ce - 256 * k) : 256;
        if (mode == 0) { u.gidx = rt + (long)e * CAP + 256 * k; u.a_off = 0; }
        else { u.gidx = nullptr; u.a_off = (long)g * 256 * a_ld; }
        u.b_off = (long)e * b_estride + (long)pn * 256 * b_ld; return true;
    }
};

template <class Epi, class Sched>
__device__ __forceinline__ void gemm_phase_ref(unsigned char* lds, const Gemm g, const Sched& S, const Epi& E) {
    const int tid = threadIdx.x, wid = tid >> 6, lane = tid & 63, wr = wid >> 2, wc = wid & 3, fr = lane & 15, fq = lane >> 4;
    bf16_t* As = (bf16_t*)lds; bf16_t* Bs = As + 256 * 72;
    Unit u;
    for (int ui = 0; S.next(ui, u); ++ui) {
        f32x4 acc[2][2][4][2];
#pragma unroll
        for (int a = 0; a < 2; ++a)
#pragma unroll
            for (int b = 0; b < 2; ++b)
#pragma unroll
                for (int m = 0; m < 4; ++m)
#pragma unroll
                    for (int n = 0; n < 2; ++n) acc[a][b][m][n] = (f32x4){0.f, 0.f, 0.f, 0.f};
        long arow[4];
#pragma unroll
        for (int i = 0; i < 4; ++i) { const int row = (tid + 512 * i) >> 3; arow[i] = u.gidx ? (row < u.valid ? (long)u.gidx[row] : 0L) : (long)row; }
        for (int k0 = 0; k0 < g.K; k0 += 64) {
            __syncthreads();
#pragma unroll
            for (int i = 0; i < 4; ++i) { const int ch = tid + 512 * i, row = ch >> 3, c8 = ch & 7;
                const u32x4 va = *(const u32x4*)(g.A + u.a_off + arow[i] * g.lda + k0 + c8 * 8);
                const u32x4 vb = *(const u32x4*)(g.Bt + u.b_off + (long)row * g.ldb + k0 + c8 * 8);
                *(u32x4*)(As + row * 72 + c8 * 8) = va; *(u32x4*)(Bs + row * 72 + c8 * 8) = vb; }
            __syncthreads();
            for (int kk = 0; kk < 64; ++kk) {
                float a[2][4];
#pragma unroll
                for (int ai = 0; ai < 2; ++ai)
#pragma unroll
                    for (int m = 0; m < 4; ++m) a[ai][m] = bf2f(As[(ai * 128 + wr * 64 + m * 16 + fr) * 72 + kk]);
#pragma unroll
                for (int bj = 0; bj < 2; ++bj)
#pragma unroll
                    for (int n = 0; n < 2; ++n)
#pragma unroll
                        for (int e = 0; e < 4; ++e) {
                            const int cl = Epi::PERM ? (bj * 128 + wc * 32 + 8 * fq + 4 * n + e) : (bj * 128 + wc * 32 + 16 * n + 4 * fq + e);
                            const float b = bf2f(Bs[cl * 72 + kk]);
#pragma unroll
                            for (int ai = 0; ai < 2; ++ai)
#pragma unroll
                                for (int m = 0; m < 4; ++m) acc[ai][bj][m][n][e] += a[ai][m] * b;
                        }
            }
        }
        E(acc, u, wr, wc, fr, fq);
    }
    __syncthreads();
}


#define LAS __attribute__((address_space(3)))
namespace pg8 {
constexpr int BK = 64, HALF = 128, HTB = HALF * BK * 2, STAGE_BYTES = 8 * HTB;
__device__ __forceinline__ int lds_byte(int r, int c) { const int st = (r >> 4) * 2 + (c >> 5), rr = r & 15, cc = c & 31, ob = rr * 64 + cc * 2; return st * 1024 + (ob ^ (((ob >> 9) & 1) << 5)); }
__device__ __forceinline__ void stage_rc(int b, int& R, int& C) { const int st = b / 1024, sb = b % 1024, swz = sb ^ (((sb >> 9) & 1) << 5); R = (st >> 1) * 16 + swz / 64; C = (st & 1) * 32 + (swz % 64) / 2; }
__device__ __forceinline__ int perm32(int rho) { const int n = rho >> 4, i = rho & 15; return 8 * (i >> 2) + 4 * n + (i & 3); }
template <bool GATHER>
__device__ __forceinline__ void unit_voffA(const Unit& u, int lda, int tid, unsigned (&v0)[2], unsigned (&v1)[2]) {
#pragma unroll
    for (int i = 0; i < 2; ++i) { int R, C; stage_rc(tid * 16 + i * 8192, R, C); int r0 = R, r1 = R + HALF;
        if (GATHER) { const int a = (r0 < u.valid) ? u.gidx[r0] : 0, b = (r1 < u.valid) ? u.gidx[r1] : 0; r0 = a; r1 = b; }
        v0[i] = (unsigned)(r0 * lda + C) * 2u; v1[i] = (unsigned)(r1 * lda + C) * 2u; }
}
template <class Epi, class Sched, bool ALIGN_EPI = true>
__device__ __forceinline__ void gemm_phase(LAS unsigned char* lds, const Gemm g, const Sched& S, const Epi& E) {
    const int tid = threadIdx.x, wid = __builtin_amdgcn_readfirstlane(tid >> 6), lane = tid & 63, wr = wid >> 2, wc = wid & 3, fr = lane & 15, fq = lane >> 4;
    const int K = g.K, nt = K / BK;
    constexpr bool GATHER = Sched::GATHER;
    unsigned voffB[2];
#pragma unroll
    for (int i = 0; i < 2; ++i) { int R, C; stage_rc(tid * 16 + i * 8192, R, C); const int Rb = Epi::PERM ? ((R & ~31) + perm32(R & 31)) : R; voffB[i] = (unsigned)(Rb * g.ldb + C) * 2u; }
    const size_t hstepA = (size_t)HALF * g.lda * 2;
    const size_t kstep = (size_t)(BK * 2);
    const size_t hstepB = (size_t)HALF * g.ldb * 2;
    const unsigned ldsw = (unsigned)wid * 1024u;
    const int aoff = lds_byte(wr * 64 + fr, fq * 8), boff = lds_byte(wc * 32 + fr, fq * 8);
#define PG8_SA(b, h) (((b) * 2 + (h)) * HTB)
#define PG8_SB(b, h) ((4 + (b) * 2 + (h)) * HTB)
#define PG8_STAGE(bufoff, gbase, voff) do { _Pragma("unroll") for (int _i = 0; _i < 2; ++_i) \
        __builtin_amdgcn_global_load_lds((const unsigned*)((const char*)(gbase) + (voff)[_i]), (LAS unsigned*)(lds + (bufoff) + ldsw + _i * 8192), 16, 0, 0); } while (0)
#define PG8_LDA(dst, b, h) do { _Pragma("unroll") for (int m = 0; m < 4; ++m) _Pragma("unroll") for (int k = 0; k < 2; ++k) dst[m][k] = *(const LAS bf16x8*)(lds + PG8_SA(b, h) + aoff + m * 2048 + k * 1024); } while (0)
#define PG8_LDB(dst, b, h) do { _Pragma("unroll") for (int n = 0; n < 2; ++n) _Pragma("unroll") for (int k = 0; k < 2; ++k) dst[n][k] = *(const LAS bf16x8*)(lds + PG8_SB(b, h) + boff + n * 2048 + k * 1024); } while (0)
#define PG8_MMA(ai, bj, At, Bt) do { __builtin_amdgcn_s_setprio(1); _Pragma("unroll") for (int m = 0; m < 4; ++m) _Pragma("unroll") for (int n = 0; n < 2; ++n) _Pragma("unroll") for (int k = 0; k < 2; ++k) \
        acc[ai][bj][m][n] = __builtin_amdgcn_mfma_f32_16x16x32_bf16(Bt[n][k], At[m][k], acc[ai][bj][m][n], 0, 0, 0); __builtin_amdgcn_s_setprio(0); } while (0)
#define PG8_WAIT_V(n) asm volatile("s_waitcnt vmcnt(" #n ")" ::: "memory")
#define PG8_WAIT_L(n) asm volatile("s_waitcnt lgkmcnt(" #n ")" ::: "memory")
#define PG8_BAR __builtin_amdgcn_s_barrier()
#define PG8_SCHED __builtin_amdgcn_sched_barrier(0)
    Unit cur, nxt; int ui = 0;
    if (!S.next(0, cur)) return;
    f32x4 acc[2][2][4][2];
#pragma unroll
    for (int a = 0; a < 2; ++a)
#pragma unroll
        for (int b = 0; b < 2; ++b)
#pragma unroll
            for (int m = 0; m < 4; ++m)
#pragma unroll
                for (int n = 0; n < 2; ++n) acc[a][b][m][n] = (f32x4){0.f, 0.f, 0.f, 0.f};
    bf16x8 At[4][2], B0[2][2], B1[2][2];
    const char* cA = (const char*)(g.A + cur.a_off); const char* cB = (const char*)(g.Bt + cur.b_off);
    unsigned vA0[2], vA1[2], nA0[2], nA1[2];
    unit_voffA<GATHER>(cur, g.lda, tid, vA0, vA1);
#define PG8_STAGE_A(bufoff, gbase, h, sel) do { if constexpr (GATHER) { if (sel) { if ((h) == 0) PG8_STAGE(bufoff, gbase, nA0); else PG8_STAGE(bufoff, gbase, nA1); } else { if ((h) == 0) PG8_STAGE(bufoff, gbase, vA0); else PG8_STAGE(bufoff, gbase, vA1); } } \
        else { PG8_STAGE(bufoff, (gbase) + ((h) ? hstepA : (size_t)0), vA0); } } while (0)
    PG8_STAGE(PG8_SB(0, 0), cB, voffB); PG8_STAGE(PG8_SB(0, 1), cB + hstepB, voffB); PG8_STAGE_A(PG8_SA(0, 0), cA, 0, false); PG8_STAGE_A(PG8_SA(0, 1), cA, 1, false);
    if (wr == 1) PG8_BAR;
    PG8_WAIT_V(2); PG8_BAR;
    PG8_STAGE(PG8_SB(1, 0), cB + kstep, voffB); PG8_STAGE_A(PG8_SA(1, 0), cA + kstep, 0, false); PG8_STAGE(PG8_SB(1, 1), cB + hstepB + kstep, voffB);
    PG8_WAIT_V(6); PG8_BAR;
    for (;;) {
        const bool has_next = S.next(ui + 1, nxt);
        const char* nA = has_next ? (const char*)(g.A + nxt.a_off) : cA; const char* nB = has_next ? (const char*)(g.Bt + nxt.b_off) : cB;
        if constexpr (GATHER) { if (has_next) unit_voffA<true>(nxt, g.lda, tid, nA0, nA1); else { nA0[0] = vA0[0]; nA0[1] = vA0[1]; nA1[0] = vA1[0]; nA1[1] = vA1[1]; } }
        for (int t = 0; t < nt; t += 2) {
            const bool last = (t == nt - 2);
            const char* a1 = cA + (size_t)(t + 1) * kstep;
            const char* a2 = last ? nA : cA + (size_t)(t + 2) * kstep; const char* b2 = last ? nB : cB + (size_t)(t + 2) * kstep;
            const char* a3 = a2 + kstep; const char* b3 = b2 + kstep;
            PG8_LDB(B0, 0, 0); PG8_LDB(B1, 0, 1); PG8_SCHED; PG8_LDA(At, 0, 0); PG8_STAGE_A(PG8_SA(1, 1), a1, 1, false);
            PG8_WAIT_V(8); PG8_WAIT_L(0); PG8_BAR; PG8_MMA(0, 0, At, B0); PG8_MMA(0, 1, At, B1); PG8_BAR; PG8_SCHED;
            PG8_LDA(At, 0, 1); PG8_STAGE(PG8_SB(0, 0), b2, voffB); PG8_STAGE(PG8_SB(0, 1), b2 + hstepB, voffB); PG8_STAGE_A(PG8_SA(0, 0), a2, 0, last);
            PG8_WAIT_V(8); PG8_WAIT_L(0); PG8_BAR; PG8_MMA(1, 0, At, B0); PG8_MMA(1, 1, At, B1); PG8_BAR; PG8_SCHED;
            PG8_LDB(B0, 1, 0); PG8_LDB(B1, 1, 1); PG8_SCHED; PG8_LDA(At, 1, 0); PG8_STAGE_A(PG8_SA(0, 1), a2, 1, last);
            PG8_WAIT_V(8); PG8_WAIT_L(0); PG8_BAR; PG8_MMA(0, 0, At, B0); PG8_MMA(0, 1, At, B1); PG8_BAR; PG8_SCHED;
            PG8_LDA(At, 1, 1); PG8_STAGE(PG8_SB(1, 0), b3, voffB); PG8_STAGE(PG8_SB(1, 1), b3 + hstepB, voffB); PG8_STAGE_A(PG8_SA(1, 0), a3, 0, last);
            PG8_WAIT_V(8); PG8_WAIT_L(0); PG8_BAR; PG8_MMA(1, 0, At, B0); PG8_MMA(1, 1, At, B1); PG8_BAR; PG8_SCHED;
        }
        if constexpr (ALIGN_EPI) { if (wr == 0) PG8_BAR; }
        E(acc, cur, wr, wc, fr, fq);
        if (!has_next) break;
#pragma unroll
        for (int a = 0; a < 2; ++a)
#pragma unroll
            for (int b = 0; b < 2; ++b)
#pragma unroll
                for (int m = 0; m < 4; ++m)
#pragma unroll
                    for (int n = 0; n < 2; ++n) acc[a][b][m][n] = (f32x4){0.f, 0.f, 0.f, 0.f};
        cur = nxt; cA = nA; cB = nB; ++ui;
        if constexpr (GATHER) { vA0[0] = nA0[0]; vA0[1] = nA0[1]; vA1[0] = nA1[0]; vA1[1] = nA1[1]; }
        if constexpr (ALIGN_EPI) { if (wr == 1) PG8_BAR; }
    }
    PG8_WAIT_V(0);
    if constexpr (!ALIGN_EPI) { if (wr == 0) PG8_BAR; }
    PG8_BAR;
#undef PG8_SA
#undef PG8_SB
#undef PG8_STAGE
#undef PG8_STAGE_A
#undef PG8_LDA
#undef PG8_LDB
#undef PG8_MMA
#undef PG8_WAIT_V
#undef PG8_WAIT_L
#undef PG8_BAR
#undef PG8_SCHED
}
}
template <class Epi, class Sched>
__device__ __forceinline__ void gemm_phase_mfma(unsigned char* lds, const Gemm g, const Sched& S, const Epi& E) { pg8::gemm_phase<Epi, Sched, true>((LAS unsigned char*)lds, g, S, E); __syncthreads(); }

__device__ __forceinline__ u32x4 pack8(const f32x4 v0, const f32x4 v1) { u32x4 w; w.x = pk2(v0[0], v0[1]); w.y = pk2(v0[2], v0[3]); w.z = pk2(v1[0], v1[1]); w.w = pk2(v1[2], v1[3]); return w; }

struct EpiIn {
    static constexpr bool PERM = true;
    bf16_t* inbuf; bf16_t* pbuf; const float* rstd1;
    __device__ __forceinline__ void operator()(const f32x4 (&acc)[2][2][4][2], const Unit& u, int wr, int wc, int fr_, int fq_) const {
        int fr = fr_, fq = fq_; asm volatile("" : "+v"(fr), "+v"(fq));
        bf16_t* base; int ldc, colt; float sc0 = 1.f;
        if (u.pn < 24) { base = inbuf + (size_t)(u.pn >> 2) * T * 1024; ldc = 1024; colt = (u.pn & 3) * 256; if (u.pn < 4) sc0 = C2Q; }
        else { base = pbuf; ldc = PW; colt = (u.pn - 24) * 256; }
        const int row0 = u.pm * 256 + wr * 64 + fr, col0 = colt + wc * 32 + 8 * fq;
#pragma unroll
        for (int ai = 0; ai < 2; ++ai)
#pragma unroll
            for (int m = 0; m < 4; ++m) { const int row = row0 + ai * 128 + m * 16; const float rs = rstd1[row] * sc0; bf16_t* rowp = base + (size_t)row * ldc + col0;
#pragma unroll
                for (int bj = 0; bj < 2; ++bj) *(u32x4*)(rowp + bj * 128) = pack8(acc[ai][bj][m][0] * rs, acc[ai][bj][m][1] * rs); }
    }
};
struct EpiL2 {
    static constexpr bool PERM = true;
    float* wl; bf16_t* abuf; bf16_t* gbuf; const float* w0; const float* a0;
    __device__ __forceinline__ void operator()(const f32x4 (&acc)[2][2][4][2], const Unit& u, int wr, int wc, int fr_, int fq_) const {
        int fr = fr_, fq = fq_; asm volatile("" : "+v"(fr), "+v"(fq));
        const int grp = u.pn >> 2, colt = (u.pn & 3) * 256;
        const int row0 = u.pm * 256 + wr * 64 + fr, col0 = colt + wc * 32 + 8 * fq;
        if (grp == 0) {
#pragma unroll
            for (int bj = 0; bj < 2; ++bj) { const int c = col0 + bj * 128; const f32x4 b0 = *(const f32x4*)(w0 + c), b1 = *(const f32x4*)(w0 + c + 4);
#pragma unroll
                for (int ai = 0; ai < 2; ++ai)
#pragma unroll
                    for (int m = 0; m < 4; ++m) { const int row = row0 + ai * 128 + m * 16; f32x4 v0 = acc[ai][bj][m][0] + b0, v1 = acc[ai][bj][m][1] + b1;
#pragma unroll
                        for (int e = 0; e < 4; ++e) { v0[e] = -0.60653065971f * LOG2E * sigmoidf_(v0[e]); v1[e] = -0.60653065971f * LOG2E * sigmoidf_(v1[e]); }
                        float* p = wl + (size_t)row * 1024 + c; *(f32x4*)p = v0; *(f32x4*)(p + 4) = v1; asm volatile("" ::: "memory"); __builtin_amdgcn_sched_barrier(0); } }
        } else if (grp == 1) {
#pragma unroll
            for (int bj = 0; bj < 2; ++bj) { const int c = col0 + bj * 128; const f32x4 b0 = *(const f32x4*)(a0 + c), b1 = *(const f32x4*)(a0 + c + 4);
#pragma unroll
                for (int ai = 0; ai < 2; ++ai)
#pragma unroll
                    for (int m = 0; m < 4; ++m) { const int row = row0 + ai * 128 + m * 16; f32x4 v0 = acc[ai][bj][m][0] + b0, v1 = acc[ai][bj][m][1] + b1;
#pragma unroll
                        for (int e = 0; e < 4; ++e) { v0[e] = sigmoidf_(v0[e]); v1[e] = sigmoidf_(v1[e]); }
                        *(u32x4*)(abuf + (size_t)row * 1024 + c) = pack8(v0, v1); asm volatile("" ::: "memory"); __builtin_amdgcn_sched_barrier(0); } }
        } else {
#pragma unroll
            for (int bj = 0; bj < 2; ++bj) { const int c = col0 + bj * 128;
#pragma unroll
                for (int ai = 0; ai < 2; ++ai)
#pragma unroll
                    for (int m = 0; m < 4; ++m) { const int row = row0 + ai * 128 + m * 16; *(u32x4*)(gbuf + (size_t)row * 1024 + c) = pack8(acc[ai][bj][m][0], acc[ai][bj][m][1]); } }
        }
    }
};
struct EpiOut {
    static constexpr bool PERM = true;
    const float* x; float* h; bf16_t* hb; float* ss2;
    __device__ __forceinline__ void operator()(const f32x4 (&acc)[2][2][4][2], const Unit& u, int wr, int wc, int fr_, int fq_) const {
        int fr = fr_, fq = fq_; asm volatile("" : "+v"(fr), "+v"(fq));
        const int row0 = u.pm * 256 + wr * 64 + fr, col0 = u.pn * 256 + wc * 32 + 8 * fq;
#pragma unroll
        for (int ai = 0; ai < 2; ++ai)
#pragma unroll
            for (int m = 0; m < 4; ++m) { const int row = row0 + ai * 128 + m * 16; float ss = 0.f;
#pragma unroll
                for (int bj = 0; bj < 2; ++bj) { const size_t off = (size_t)row * DM + col0 + bj * 128;
                    const f32x4 x0 = *(const f32x4*)(x + off), x1 = *(const f32x4*)(x + off + 4);
                    const f32x4 v0 = acc[ai][bj][m][0] + x0, v1 = acc[ai][bj][m][1] + x1;
                    *(f32x4*)(h + off) = v0; *(f32x4*)(h + off + 4) = v1; *(u32x4*)(hb + off) = pack8(v0, v1);
                    ss += (v0[0] * v0[0] + v0[1] * v0[1]) + (v0[2] * v0[2] + v0[3] * v0[3]) + (v1[0] * v1[0] + v1[1] * v1[1]) + (v1[2] * v1[2] + v1[3] * v1[3]); }
                ss += __shfl_xor(ss, 16); ss += __shfl_xor(ss, 32);
                if (fq == 0) atomicAdd(ss2 + row, ss); }
    }
};
struct EpiGU {
    static constexpr bool PERM = true;
    bf16_t* hid; const float* rstd2;
    __device__ __forceinline__ void operator()(const f32x4 (&acc)[2][2][4][2], const Unit& u, int wr, int wc, int fr_, int fq_) const {
        int fr = fr_, fq = fq_; asm volatile("" : "+v"(fr), "+v"(fq));
        const int col0 = u.pn * 128 + wc * 32 + 8 * fq;
#pragma unroll
        for (int ai = 0; ai < 2; ++ai)
#pragma unroll
            for (int m = 0; m < 4; ++m) { const int rl = ai * 128 + wr * 64 + m * 16 + fr; const int tok = (rl < u.valid) ? u.gidx[rl] : 0; const float rs = rstd2[tok];
                f32x4 o0, o1;
#pragma unroll
                for (int e = 0; e < 4; ++e) { const float g0 = acc[ai][0][m][0][e] * rs, u0 = acc[ai][1][m][0][e] * rs, g1 = acc[ai][0][m][1][e] * rs, u1 = acc[ai][1][m][1][e] * rs;
                    o0[e] = g0 * sigmoidf_(g0) * u0; o1[e] = g1 * sigmoidf_(g1) * u1; }
                *(u32x4*)(hid + ((size_t)u.tile * 256 + rl) * DEXP + col0) = pack8(o0, o1); asm volatile("" ::: "memory"); __builtin_amdgcn_sched_barrier(0); }
    }
};
struct EpiDown {
    static constexpr bool PERM = true;
    bf16_t* yb; const float* gateb; const unsigned* cnt;
    __device__ __forceinline__ void operator()(const f32x4 (&acc)[2][2][4][2], const Unit& u, int wr, int wc, int fr_, int fq_) const {
        int fr = fr_, fq = fq_; asm volatile("" : "+v"(fr), "+v"(fq));
        const int col0 = u.pn * 256 + wc * 32 + 8 * fq;
        const int k = u.k;
#pragma unroll
        for (int ai = 0; ai < 2; ++ai)
#pragma unroll
            for (int m = 0; m < 4; ++m) { const int rl = ai * 128 + wr * 64 + m * 16 + fr; const float gt = (rl < u.valid) ? gateb[(size_t)u.e * CAP + 256 * k + rl] : 0.f;
#pragma unroll
                for (int bj = 0; bj < 2; ++bj) *(u32x4*)(yb + ((size_t)u.tile * 256 + rl) * DM + col0 + bj * 128) = pack8(acc[ai][bj][m][0] * gt, acc[ai][bj][m][1] * gt); }
    }
};

__device__ __forceinline__ void tr_item(const float* W, int ldw, int Kvalid, int k0, int n0, bf16_t* WT, int ldt, int trow0, float* scr, int lane,
                                        const float* gk, const float* mu, int mode) {
#pragma unroll 8
    for (int i = 0; i < 32; ++i) { const int kk = 2 * i + (lane >> 5), k = k0 + kk; float v = 0.f;
        if (k < Kvalid) { v = W[(size_t)k * ldw + n0 + (lane & 31)]; float s = gk ? gk[k] : 1.f; if (mode == 1) s *= (1.f - mu[k]); else if (mode == 2) s *= mu[k]; v *= s; }
        scr[kk * 33 + (lane & 31)] = v; }
    __builtin_amdgcn_s_waitcnt(0xC07F); asm volatile("" ::: "memory");
    const int c = lane & 7;
#pragma unroll
    for (int j = 0; j < 4; ++j) { const int n = (lane >> 3) + 8 * j; const float* s = scr + (8 * c) * 33 + n;
        u32x4 o; o.x = pk2(s[0 * 33], s[1 * 33]); o.y = pk2(s[2 * 33], s[3 * 33]); o.z = pk2(s[4 * 33], s[5 * 33]); o.w = pk2(s[6 * 33], s[7 * 33]);
        *(u32x4*)(WT + (size_t)(trow0 + n) * ldt + k0 + 8 * c) = o; }
    __builtin_amdgcn_s_waitcnt(0xC07F); asm volatile("" ::: "memory");
}

__device__ __forceinline__ void phase_prologue(const Params& p, unsigned char* lds) {
    const int tid = opaque_tid(), lane = tid & 63, wave = tid >> 6;
    const int gw = blockIdx.x * NWAVES + wave, NGW = gridDim.x * NWAVES;
    unsigned char* ws = p.ws;
    float* scr = (float*)(lds + wave * 16384);
    bf16_t* WinT = (bf16_t*)(ws + WS_WIN); bf16_t* WoutT = (bf16_t*)(ws + WS_WOUT); bf16_t* L2T = (bf16_t*)(ws + WS_L2T);
    const float* g_mix = p.in[1]; const float* mu_x = p.in[9];
    constexpr int I_WIN = 32 * 192;
    constexpr int I_L1 = 32 * 2 * 2 + 32 * 2 * 2 + 32 * 5 * 2;
    constexpr int I_WOUT = 32 * 64;
    constexpr int I_L2 = 3 * 4 * 32;
    constexpr int NITEMS = I_WIN + I_L1 + I_WOUT + I_L2;
    for (int it = gw; it < NITEMS; it += NGW) {
        int r = it;
        if (r < I_WIN) { const int kb = r / 192, nb = r % 192; tr_item(p.in[2], 6144, 2048, 64 * kb, 32 * nb, WinT, 2048, 32 * nb, scr, lane, g_mix, nullptr, 0); continue; } r -= I_WIN;
        if (r < I_L1) {
            int which, nb, mode, kb;
            if (r < 128) { which = 0; } else if (r < 256) { which = 1; r -= 128; } else { which = 2; r -= 256; }
            const int nnb = (which == 2) ? 5 : 2;
            kb = r / (nnb * 2); const int rr = r % (nnb * 2); nb = rr / 2; mode = 1 + (rr & 1);
            const float* W = which == 0 ? p.in[12] : which == 1 ? p.in[15] : p.in[17];
            const int ldw = which == 2 ? 160 : 64;
            const int rowbase = 6144 + (which == 0 ? 0 : which == 1 ? 128 : 256) + (mode == 2 ? ldw : 0);
            tr_item(W, ldw, 2048, 64 * kb, 32 * nb, WinT, 2048, rowbase + 32 * nb, scr, lane, g_mix, mu_x + which * 2048, mode); continue; } r -= I_L1;
        if (r < I_WOUT) { const int kb = r / 64, nb = r % 64; tr_item(p.in[3], 2048, 2048, 64 * kb, 32 * nb, WoutT, 2048, 32 * nb, scr, lane, nullptr, nullptr, 0); continue; } r -= I_WOUT;
        { const int which = r / 128, rr = r % 128, kb = rr / 32, nb = rr % 32;
          const float* W = which == 0 ? p.in[13] : which == 1 ? p.in[16] : p.in[18]; const int kv = which == 2 ? 160 : 64;
          tr_item(W, 1024, kv, 64 * kb, 32 * nb, L2T, 256, which * 1024 + 32 * nb, scr, lane, nullptr, nullptr, 0); }
    }
    for (int ch = blockIdx.x * NTHREADS + tid; ch < 192 * 256; ch += gridDim.x * NTHREADS) *(u32x4*)(WinT + (size_t)6720 * 2048 + (size_t)ch * 8) = (u32x4){0u, 0u, 0u, 0u};
    const float* x = p.in[0]; bf16_t* xb = (bf16_t*)(ws + WS_XB); float* rstd1 = (float*)(ws + WS_RSTD1);
    for (int m = gw; m < T; m += NGW) {
        const f32x4* xr = (const f32x4*)(x + (size_t)m * DM) + lane; f32x4 v[8]; float s = 0.f;
#pragma unroll
        for (int j = 0; j < 8; ++j) { v[j] = xr[64 * j]; s += (v[j][0] * v[j][0] + v[j][1] * v[j][1]) + (v[j][2] * v[j][2] + v[j][3] * v[j][3]); }
        s = wave_sum(s);
        u32x2* o = (u32x2*)(xb + (size_t)m * DM) + lane;
#pragma unroll
        for (int j = 0; j < 8; ++j) { u32x2 w; w.x = pk2(v[j][0], v[j][1]); w.y = pk2(v[j][2], v[j][3]); o[64 * j] = w; }
        if (lane == 0) rstd1[m] = 1.0f / sqrtf(s * (1.0f / DM) + 1e-6f);
    }
}

__device__ __forceinline__ void convert_experts(const Params& p, unsigned char* lds) {
    const int tid = opaque_tid(), lane = tid & 63, wave = tid >> 6;
    const int gw = blockIdx.x * NWAVES + wave, NGW = gridDim.x * NWAVES;
    float* scr = (float*)(lds + 65536 + wave * 8704);
    bf16_t* Wgu = (bf16_t*)(p.ws + WS_WGU); bf16_t* Wd = (bf16_t*)(p.ws + WS_WD); const float* gf = p.in[24];
    constexpr int I_G = 32 * 32 * 16;
    constexpr int I_D = 32 * 8 * 64;
    for (int it = gw; it < 2 * I_G + I_D; it += NGW) {
        int r = it;
        if (r < 2 * I_G) { const int up = r >= I_G; if (up) r -= I_G; const int e = r / 512, rr = r % 512, kb = rr / 16, nb = rr % 16; const int n0 = 32 * nb;
            tr_item((up ? p.in[30] : p.in[29]) + (size_t)e * 2048 * 512, 512, 2048, 64 * kb, n0, Wgu + (size_t)e * 1024 * 2048, 2048, 256 * (n0 >> 7) + (n0 & 127) + (up ? 128 : 0), scr, lane, gf, nullptr, 0); continue; }
        r -= 2 * I_G;
        { const int e = r / 512, rr = r % 512, kb = rr / 64, nb = rr % 64;
          tr_item(p.in[31] + (size_t)e * 512 * 2048, 2048, 512, 64 * kb, 32 * nb, Wd + (size_t)e * 2048 * 512, 512, 32 * nb, scr, lane, nullptr, nullptr, 0); }
    }
}

__device__ __forceinline__ void phase_l2prep(const Params& p) {
    const bf16_t* P = (const bf16_t*)(p.ws + WS_PBUF); bf16_t* A2 = (bf16_t*)(p.ws + WS_A2);
    const int nchunk = T * 96;
    const int tid = opaque_tid();
    for (int id = blockIdx.x * NTHREADS + tid; id < nchunk; id += gridDim.x * NTHREADS) {
        const int t = id / 96, ch = id % 96, gi = ch >> 5, jc = (ch & 31) * 8;
        const int width = gi == 2 ? 160 : 64, pa = gi == 0 ? 0 : gi == 1 ? 128 : 256, pb = pa + width;
        u32x4 o = (u32x4){0u, 0u, 0u, 0u};
        if (jc < width) {
            const u32x4 va = *(const u32x4*)(P + (size_t)t * PW + pa + jc);
            u32x4 vb = (u32x4){0u, 0u, 0u, 0u};
            if ((t & (SEQ - 1)) != 0) vb = *(const u32x4*)(P + (size_t)(t - 1) * PW + pb + jc);
            float f[8];
#pragma unroll
            for (int i = 0; i < 4; ++i) { f[2 * i] = bflo(va[i]) + bflo(vb[i]); f[2 * i + 1] = bfhi(va[i]) + bfhi(vb[i]); }
#pragma unroll
            for (int i = 0; i < 8; ++i) { if (gi == 0) f[i] = 1.0f - 2.0f / (__expf(2.0f * f[i]) + 1.0f); else if (gi == 2) f[i] = sigmoidf_(f[i]); }
            o.x = pk2(f[0], f[1]); o.y = pk2(f[2], f[3]); o.z = pk2(f[4], f[5]); o.w = pk2(f[6], f[7]);
        }
        *(u32x4*)(A2 + (size_t)t * PW + ch * 8) = o;
    }
}

constexpr int TC = 16;
constexpr int SCAN_VEC_FLOATS = 6 * TC * 64 + 2 * TC;
constexpr int SCAN_OFF_YS = 2 * SCAN_VEC_FLOATS;
constexpr int SCAN_OFF_GB = SCAN_OFF_YS + 2 * TC * 64;
constexpr int SCAN_LDS_FLOATS = SCAN_OFF_GB + 4 * TC * 64;
#define DPP_F(v, ctrl) __builtin_bit_cast(float, __builtin_amdgcn_update_dpp(0, __builtin_bit_cast(int, (v)), (ctrl), 0xF, 0xF, true))
__device__ __forceinline__ float red8(float v) {
    v += DPP_F(v, 0xB1);
    v += DPP_F(v, 0x4E);
    v += DPP_F(v, 0x141);
    return v;
}
__device__ __forceinline__ float wave_sum_fast(float v) {
    v = red8(v);
    v += DPP_F(v, 0x140);
    v += __builtin_bit_cast(float, __builtin_amdgcn_update_dpp(0, __builtin_bit_cast(int, v), 0x142, 0xa, 0xf, false));
    v += __builtin_bit_cast(float, __builtin_amdgcn_update_dpp(0, __builtin_bit_cast(int, v), 0x143, 0xc, 0xf, false));
    return __builtin_bit_cast(float, __builtin_amdgcn_readlane(__builtin_bit_cast(int, v), 63));
}
__device__ __forceinline__ f32x2 lo2(const f32x4 x) { return (f32x2){x[0], x[1]}; }
__device__ __forceinline__ f32x2 hi2(const f32x4 x) { return (f32x2){x[2], x[3]}; }
__device__ __forceinline__ void rwkv_chain(const Params& p, unsigned char* lds, int chain) {
    const int tid = opaque_tid(), lane = tid & 63, wave = __builtin_amdgcn_readfirstlane(tid >> 6);
    const int b = chain >> 4, h = chain & 15;
    float* L = (float*)lds;
    constexpr int NC = SEQ / TC;
    if (wave < 4) {
        const int r8 = lane >> 3, q = lane & 7, iA = 16 * wave + r8, iB = iA + 8;
        f32x2 SA[4], SB[4];
#pragma unroll
        for (int e = 0; e < 4; ++e) { SA[e] = (f32x2){0.f, 0.f}; SB[e] = (f32x2){0.f, 0.f}; }
        __syncthreads();
        for (int ci = 0; ci < NC; ++ci) {
            const float* V0 = L + (ci & 1) * SCAN_VEC_FLOATS;
            float* Ys = L + SCAN_OFF_YS + (ci & 1) * TC * 64;
            const float* KKs = V0 + 8 * q; const float* Ws = V0 + TC * 64 + 8 * q; const float* Bs = V0 + 2 * TC * 64 + 8 * q; const float* Ks = V0 + 3 * TC * 64 + 8 * q;
            const float* WRs = V0 + 4 * TC * 64 + 8 * q; const float* Vs = V0 + 5 * TC * 64; const float* SC = V0 + 6 * TC * 64;
            f32x4 kk0 = *(const f32x4*)(KKs), kk1 = *(const f32x4*)(KKs + 4), w0 = *(const f32x4*)(Ws), w1 = *(const f32x4*)(Ws + 4);
            f32x4 b0 = *(const f32x4*)(Bs), b1 = *(const f32x4*)(Bs + 4), k0 = *(const f32x4*)(Ks), k1 = *(const f32x4*)(Ks + 4);
            f32x4 x0 = *(const f32x4*)(WRs), x1 = *(const f32x4*)(WRs + 4); float vA = Vs[iA], vB = Vs[iB]; f32x2 sc = *(const f32x2*)(SC);
#pragma unroll 2
            for (int tl = 0; tl < TC; ++tl) {
                const int tn = (tl + 1 < TC) ? tl + 1 : tl;
                const f32x4 nkk0 = *(const f32x4*)(KKs + tn * 64), nkk1 = *(const f32x4*)(KKs + tn * 64 + 4), nw0 = *(const f32x4*)(Ws + tn * 64), nw1 = *(const f32x4*)(Ws + tn * 64 + 4);
                const f32x4 nb0 = *(const f32x4*)(Bs + tn * 64), nb1 = *(const f32x4*)(Bs + tn * 64 + 4), nk0 = *(const f32x4*)(Ks + tn * 64), nk1 = *(const f32x4*)(Ks + tn * 64 + 4);
                const f32x4 nx0 = *(const f32x4*)(WRs + tn * 64), nx1 = *(const f32x4*)(WRs + tn * 64 + 4); const float nvA = Vs[tn * 64 + iA], nvB = Vs[tn * 64 + iB]; const f32x2 nsc = *(const f32x2*)(SC + 2 * tn);
                f32x2 t0 = SA[0] * lo2(kk0) + SA[1] * hi2(kk0); t0 += SA[2] * lo2(kk1) + SA[3] * hi2(kk1);
                f32x2 t1 = SB[0] * lo2(kk0) + SB[1] * hi2(kk0); t1 += SB[2] * lo2(kk1) + SB[3] * hi2(kk1);
                f32x2 t2 = SA[0] * lo2(x0) + SA[1] * hi2(x0); t2 += SA[2] * lo2(x1) + SA[3] * hi2(x1);
                f32x2 t3 = SB[0] * lo2(x0) + SB[1] * hi2(x0); t3 += SB[2] * lo2(x1) + SB[3] * hi2(x1);
                float saA = t0[0] + t0[1], saB = t1[0] + t1[1], pA = t2[0] + t2[1], pB = t3[0] + t3[1];
                saA += DPP_F(saA, 0xB1); saB += DPP_F(saB, 0xB1); pA += DPP_F(pA, 0xB1); pB += DPP_F(pB, 0xB1);
                saA += DPP_F(saA, 0x4E); saB += DPP_F(saB, 0x4E); pA += DPP_F(pA, 0x4E); pB += DPP_F(pB, 0x4E);
                saA += DPP_F(saA, 0x141); saB += DPP_F(saB, 0x141); pA += DPP_F(pA, 0x141); pB += DPP_F(pB, 0x141);
                const float yA = pA + (saA * sc[0] + vA * sc[1]), yB = pB + (saB * sc[0] + vB * sc[1]);
                if (q == 0) { Ys[tl * 64 + iA] = yA; Ys[tl * 64 + iB] = yB; }
                const f32x2 sA2 = (f32x2){saA, saA}, sB2 = (f32x2){saB, saB}, vA2 = (f32x2){vA, vA}, vB2 = (f32x2){vB, vB};
                SA[0] = SA[0] * lo2(w0) + (sA2 * lo2(b0) + vA2 * lo2(k0)); SA[1] = SA[1] * hi2(w0) + (sA2 * hi2(b0) + vA2 * hi2(k0));
                SA[2] = SA[2] * lo2(w1) + (sA2 * lo2(b1) + vA2 * lo2(k1)); SA[3] = SA[3] * hi2(w1) + (sA2 * hi2(b1) + vA2 * hi2(k1));
                SB[0] = SB[0] * lo2(w0) + (sB2 * lo2(b0) + vB2 * lo2(k0)); SB[1] = SB[1] * hi2(w0) + (sB2 * hi2(b0) + vB2 * hi2(k0));
                SB[2] = SB[2] * lo2(w1) + (sB2 * lo2(b1) + vB2 * lo2(k1)); SB[3] = SB[3] * hi2(w1) + (sB2 * hi2(b1) + vB2 * hi2(k1));
                kk0 = nkk0; kk1 = nkk1; w0 = nw0; w1 = nw1; b0 = nb0; b1 = nb1; k0 = nk0; k1 = nk1; x0 = nx0; x1 = nx1; vA = nvA; vB = nvB; sc = nsc;
            }
            __syncthreads();
        }
    } else {
        const int aw = wave - 4, c = h * 64 + lane;
        constexpr int SPW = TC / 4;
        const bf16_t* rb = (const bf16_t*)(p.ws + WS_INBUF) + (size_t)3 * T * 1024; const bf16_t* kb = rb + (size_t)T * 1024; const bf16_t* vb = kb + (size_t)T * 1024;
        const float* wl = (const float*)(p.ws + WS_WL); const bf16_t* ab = (const bf16_t*)(p.ws + WS_ABUF); const bf16_t* gb = (const bf16_t*)(p.ws + WS_GBUF);
        bf16_t* O = (bf16_t*)(p.ws + WS_O);
        const float mu_r = p.in[10][c], mu_k = p.in[10][1024 + c], mu_v = p.in[10][2048 + c];
        const float k_k = p.in[19][c], k_a = p.in[20][c], r_k = p.in[21][c], ln_w = p.in[22][c], ln_b = p.in[23][c];
        float rc[SPW + 1], kc[SPW + 1], vc[SPW + 1], rwl[SPW], ra[SPW], rg[SPW];
#define SCAN_LOAD(ci_) do { const int tb_ = (ci_) * TC + aw * SPW; const size_t m0_ = (size_t)b * SEQ + tb_; \
        _Pragma("unroll") for (int s_ = 0; s_ < SPW + 1; ++s_) { const bool ok_ = (tb_ + s_ - 1) >= 0; const size_t off_ = (m0_ + s_ - 1) * 1024 + c; \
            rc[s_] = ok_ ? bf2f(rb[off_]) : 0.f; kc[s_] = ok_ ? bf2f(kb[off_]) : 0.f; vc[s_] = ok_ ? bf2f(vb[off_]) : 0.f; } \
        _Pragma("unroll") for (int s_ = 0; s_ < SPW; ++s_) { const size_t off_ = (m0_ + s_) * 1024 + c; rwl[s_] = wl[off_]; ra[s_] = bf2f(ab[off_]); rg[s_] = bf2f(gb[off_]); } } while (0)
#define SCAN_PREP(ci_) do { float* V0_ = L + ((ci_) & 1) * SCAN_VEC_FLOATS; float* GB_ = L + SCAN_OFF_GB + ((ci_) & 1) * 2 * TC * 64; \
        _Pragma("unroll") for (int s_ = 0; s_ < SPW; ++s_) { const int tl_ = aw * SPW + s_; \
            const float rr_ = rc[s_ + 1] + (rc[s_] - rc[s_ + 1]) * mu_r, kx_ = kc[s_ + 1] + (kc[s_] - kc[s_ + 1]) * mu_k, vv_ = vc[s_ + 1] + (vc[s_] - vc[s_ + 1]) * mu_v; \
            const float w_ = __builtin_amdgcn_exp2f(rwl[s_]), a_ = ra[s_]; \
            const float kkv_ = kx_ * k_k; const float n2_ = wave_sum_fast(kkv_ * kkv_); const float kkn_ = kkv_ * __builtin_amdgcn_rsqf(fmaxf(n2_, 1e-24f)); \
            const float kmod_ = kx_ * (1.0f + (a_ - 1.0f) * k_a); const float bb_ = kkn_ * a_; \
            const float bon_ = wave_sum_fast(rr_ * kmod_ * r_k), br_ = wave_sum_fast(bb_ * rr_), kr_ = wave_sum_fast(kmod_ * rr_); \
            V0_[tl_ * 64 + lane] = -kkn_; V0_[TC * 64 + tl_ * 64 + lane] = w_; V0_[2 * TC * 64 + tl_ * 64 + lane] = bb_; V0_[3 * TC * 64 + tl_ * 64 + lane] = kmod_; \
            V0_[4 * TC * 64 + tl_ * 64 + lane] = w_ * rr_; V0_[5 * TC * 64 + tl_ * 64 + lane] = vv_; if (lane == 0) { V0_[6 * TC * 64 + 2 * tl_] = br_; V0_[6 * TC * 64 + 2 * tl_ + 1] = kr_; } \
            GB_[tl_ * 64 + lane] = rg[s_]; GB_[TC * 64 + tl_ * 64 + lane] = bon_ * vv_ * rg[s_]; } } while (0)
#define SCAN_POST(ci_) do { const float* Ys_ = L + SCAN_OFF_YS + ((ci_) & 1) * TC * 64; const float* GB_ = L + SCAN_OFF_GB + ((ci_) & 1) * 2 * TC * 64; \
        _Pragma("unroll") for (int s_ = 0; s_ < SPW; ++s_) { const int tl_ = aw * SPW + s_; const size_t m_ = (size_t)b * SEQ + (ci_) * TC + tl_; \
            const float y_ = Ys_[tl_ * 64 + lane]; const float mean_ = wave_sum_fast(y_) * (1.0f / 64.0f); const float d_ = y_ - mean_; const float var_ = wave_sum_fast(d_ * d_) * (1.0f / 64.0f); \
            const float yn_ = d_ * __builtin_amdgcn_rsqf(var_ + 64e-5f) * ln_w + ln_b; \
            O[m_ * DM + 1024 + c] = (bf16_t)f2bf(yn_ * GB_[tl_ * 64 + lane] + GB_[TC * 64 + tl_ * 64 + lane]); } } while (0)
        SCAN_LOAD(0); SCAN_PREP(0); SCAN_LOAD(1);
        __syncthreads();
        for (int ci = 0; ci < NC; ++ci) {
            if (ci >= 1) SCAN_POST(ci - 1);
            if (ci + 1 < NC) { SCAN_PREP(ci + 1); if (ci + 2 < NC) SCAN_LOAD(ci + 2); }
            __syncthreads();
        }
        SCAN_POST(NC - 1);
#undef SCAN_LOAD
#undef SCAN_PREP
#undef SCAN_POST
    }
    __syncthreads();
}

#include <hip/hip_bf16.h>
#include <cmath>
namespace attn_body {
using bf16=__hip_bfloat16;
using bf16x8=__attribute__((ext_vector_type(8)))short;
using s16x4=__attribute__((ext_vector_type(4)))short;
using f32x16=__attribute__((ext_vector_type(16)))float;
using u32x4=__attribute__((ext_vector_type(4)))unsigned;
constexpr int SEQ=2048,D=64,DM=1024;
constexpr int NW=8,QBLK=32,QB=QBLK*NW,KVBLK=64,NQB=SEQ/QB;
__device__ __forceinline__ int crow(int r,int hi){return (r&3)+8*(r>>2)+4*hi;}
#define SBAR() __builtin_amdgcn_sched_barrier(0)
__device__ __forceinline__ void cmask(f32x16&p0,f32x16&p1,int jb,int qrel,int hi){
  const float NEG=-INFINITY; int kb=64*jb+4*hi;
  #pragma unroll
  for(int r=0;r<16;++r){int kv=kb+(r&3)+8*(r>>2); if(kv>qrel)p0[r]=NEG; if(kv+32>qrel)p1[r]=NEG;}
}

constexpr int NSLOT=3, SLOTB=8192;
constexpr int LDS_K=0, LDS_V=NSLOT*SLOTB, LDS_WS=2*NSLOT*SLOTB, LDS_OST=LDS_WS+NW*64*4, LDS_BYTES=LDS_OST+NW*4096;
constexpr float C2=0.125f*1.4426950408889634f;
__device__ __forceinline__ void glds16(const void*gsrc,unsigned lds_dst){unsigned keep;
  asm volatile("s_mov_b32 %0, m0\n\ts_mov_b32 m0, %2\n\ts_nop 0\n\tglobal_load_lds_dwordx4 %1, off\n\ts_mov_b32 m0, %0":"=&s"(keep):"v"(gsrc),"s"(lds_dst):"memory");}
__device__ __forceinline__ float max3f(float a,float b,float c){float r;asm("v_max3_f32 %0, %1, %2, %3":"=v"(r):"v"(a),"v"(b),"v"(c));return r;}
__device__ __forceinline__ float max2f(float a,float b){float r;asm("v_max_f32_e32 %0, %1, %2":"=v"(r):"v"(a),"v"(b));return r;}
__device__ __forceinline__ float fadd_s(float a,float b){float r;asm("v_add_f32_e32 %0, %1, %2":"=v"(r):"v"(a),"v"(b));return r;}
__device__ __forceinline__ float fsub_s(float a,float b){float r;asm("v_sub_f32_e32 %0, %1, %2":"=v"(r):"v"(a),"v"(b));return r;}
typedef float f32x2_t __attribute__((ext_vector_type(2))); typedef __bf16 bf16x2_t __attribute__((ext_vector_type(2)));
__device__ __forceinline__ unsigned cvtpk_s(float lo,float hi){f32x2_t v={lo,hi};bf16x2_t b=__builtin_convertvector(v,bf16x2_t);return __builtin_bit_cast(unsigned,b);}
#define WAIT_BAR(N) asm volatile("s_waitcnt vmcnt(" #N ") lgkmcnt(0)\n\ts_barrier":::"memory")

__device__ __forceinline__ void qkt(f32x16&p0,f32x16&p1,const char*Kslot,const bf16x8*qr,const f32x16&negm,int r32,int hi){
  const char*kb=Kslot+hi*1024+r32*16;
  #pragma unroll
  for(int d0=0;d0<4;++d0){
    const bf16x8 b0=*reinterpret_cast<const bf16x8*>(kb+d0*2048);
    const bf16x8 b1=*reinterpret_cast<const bf16x8*>(kb+d0*2048+512);
    if(d0==0){p0=__builtin_amdgcn_mfma_f32_32x32x16_bf16(b0,qr[0],negm,0,0,0);p1=__builtin_amdgcn_mfma_f32_32x32x16_bf16(b1,qr[0],negm,0,0,0);}
    else{p0=__builtin_amdgcn_mfma_f32_32x32x16_bf16(b0,qr[d0],p0,0,0,0);p1=__builtin_amdgcn_mfma_f32_32x32x16_bf16(b1,qr[d0],p1,0,0,0);}}
}
typedef __attribute__((address_space(3))) const char* lds_cptr;
typedef short v4i16_t __attribute__((ext_vector_type(4)));
__device__ __forceinline__ void kload8(bf16x8*kf,lds_cptr kp){
  kf[0]=*(const __attribute__((address_space(3))) bf16x8*)(kp);      kf[1]=*(const __attribute__((address_space(3))) bf16x8*)(kp+512);
  kf[2]=*(const __attribute__((address_space(3))) bf16x8*)(kp+2048); kf[3]=*(const __attribute__((address_space(3))) bf16x8*)(kp+2560);
  kf[4]=*(const __attribute__((address_space(3))) bf16x8*)(kp+4096); kf[5]=*(const __attribute__((address_space(3))) bf16x8*)(kp+4608);
  kf[6]=*(const __attribute__((address_space(3))) bf16x8*)(kp+6144); kf[7]=*(const __attribute__((address_space(3))) bf16x8*)(kp+6656);
}
__device__ __forceinline__ void kload2(bf16x8*kf,lds_cptr kp,int j){ kf[2*j]=*(const __attribute__((address_space(3))) bf16x8*)(kp+j*2048); kf[2*j+1]=*(const __attribute__((address_space(3))) bf16x8*)(kp+j*2048+512); }
__device__ __forceinline__ s16x4 vtr(lds_cptr p){ return __builtin_bit_cast(s16x4,__builtin_amdgcn_ds_read_tr16_b64_v4i16((__attribute__((address_space(3))) v4i16_t*)p)); }
__device__ __forceinline__ float rowmax(const f32x16&p0,const f32x16&p1){
  float a=max3f(p0[0],p0[1],p1[0]),b=max3f(p0[2],p0[3],p1[1]);a=max3f(a,p1[2],p1[3]);
  #pragma unroll
  for(int r=4;r<16;r+=4){a=max3f(a,p0[r],p0[r+1]);b=max3f(b,p0[r+2],p0[r+3]);a=max3f(a,p1[r],p1[r+1]);b=max3f(b,p1[r+2],p1[r+3]);}
  const float m=max2f(a,b);
  auto rr=__builtin_amdgcn_permlane32_swap(__float_as_uint(m),__float_as_uint(m),false,false);
  return max2f(__uint_as_float(rr[0]),__uint_as_float(rr[1]));
}
__device__ __forceinline__ void pv(f32x16*o,int vb,bf16x8 pa0,bf16x8 pa1,bf16x8 pa2,bf16x8 pa3){
  #pragma unroll
  for(int d0=0;d0<2;++d0){s16x4 lo[4],hi[4];
    #pragma unroll
    for(int ks=0;ks<4;++ks){
      asm volatile("ds_read_b64_tr_b16 %0,%1 offset:%c2":"=&v"(lo[ks]):"v"(vb),"i"(d0*4096+ks*1024):"memory");
      asm volatile("ds_read_b64_tr_b16 %0,%1 offset:%c2":"=&v"(hi[ks]):"v"(vb),"i"(d0*4096+ks*1024+512):"memory");}
    asm volatile("s_waitcnt lgkmcnt(0)":::"memory");SBAR();
    #define PK(k) (bf16x8){lo[k][0],lo[k][1],lo[k][2],lo[k][3],hi[k][0],hi[k][1],hi[k][2],hi[k][3]}
    o[d0]=__builtin_amdgcn_mfma_f32_32x32x16_bf16(pa0,PK(0),o[d0],0,0,0);
    o[d0]=__builtin_amdgcn_mfma_f32_32x32x16_bf16(pa1,PK(1),o[d0],0,0,0);
    o[d0]=__builtin_amdgcn_mfma_f32_32x32x16_bf16(pa2,PK(2),o[d0],0,0,0);
    o[d0]=__builtin_amdgcn_mfma_f32_32x32x16_bf16(pa3,PK(3),o[d0],0,0,0);
    #undef PK
  }
}

#ifndef ATTN_STORE16
#define ATTN_STORE16(p,v) (*(u32x4*)(p)=(v))
#endif
template<int THRL> __device__ __forceinline__ void attn_unit(int b,int qkcol,int vcol,int qb,float slope2,const bf16*Q,const bf16*__restrict__ K,const bf16*__restrict__ V,bf16*O,char*shm){
  const int tid=opaque_tid(),lane=tid&63,r32=lane&31,hi=lane>>5; const int wid=__builtin_amdgcn_readfirstlane(tid>>6);
  const long rowbase=(long)b*SEQ; const int q0=qb*QB;
  const bf16*Qw=Q+(rowbase+q0+wid*QBLK)*DM+qkcol;
  const bf16*Kh=K+rowbase*DM+qkcol,*Vh=V+rowbase*DM+vcol;
  const unsigned lds0=(unsigned)(uintptr_t)shm;
  float*wsf=(float*)(shm+LDS_WS)+wid*64;
  const bf16*ksrc=Kh+(long)lane*DM+wid*8;
  const bf16*vsrc=Vh+(long)(16*(wid&3)+(lane>>2))*DM+(wid>>2)*32+(lane&3)*8;
  const unsigned kdst=lds0+LDS_K+wid*1024, vdst=lds0+LDS_V+wid*1024;
  #define DMA_K(t,slot) glds16(ksrc+(long)(t)*KVBLK*DM,(unsigned)__builtin_amdgcn_readfirstlane(kdst+(slot)))
  #define DMA_V(t,slot) glds16(vsrc+(long)(t)*KVBLK*DM,(unsigned)__builtin_amdgcn_readfirstlane(vdst+(slot)))
  const int vb0=(int)(lds0+LDS_V)+((lane>>4)&1)*32+(lane&3)*8+(4*hi+((lane&15)>>2))*64;
  const char*Kbase=shm+LDS_K; bf16x8 kf[8];
  const lds_cptr shm3=(lds_cptr)shm; const lds_cptr kp0=shm3+LDS_K+hi*1024+r32*16; const lds_cptr vp0=shm3+LDS_V+((lane>>4)&1)*32+(lane&3)*8+(4*hi+((lane&15)>>2))*64;
  const int NT=(q0+QB)/KVBLK;
  DMA_K(0,0);DMA_V(0,0);DMA_K(1,SLOTB);
  bf16x8 qr[4];
  #pragma unroll
  for(int d0=0;d0<4;++d0)qr[d0]=*reinterpret_cast<const bf16x8*>(&Qw[(long)r32*DM+d0*16+hi*8]);
  float mhat=0.f,l_reg=0.f;f32x16 o[2];o[0]=f32x16{};o[1]=f32x16{};const f32x16 negm=f32x16{};
  const int qrel=wid*QBLK+r32; float slope2v=slope2; asm volatile("":"+v"(slope2v));
  #define CMASK(P0,P1,t) do{int jb_=(t)-(NT-4); if(jb_>=0)cmask(P0,P1,jb_,qrel,hi);}while(0)
  #define ABIAS(P0,P1,t) do{ float kb_=slope2*(float)(64*(t)+4*hi)-mhat; asm volatile("":"+v"(kb_)); _Pragma("unroll") for(int r=0;r<16;++r){ P0[r]+=kb_; P1[r]+=kb_; } _Pragma("unroll") for(int r=0;r<16;++r){ const float cr_=(float)((r&3)+8*(r>>2)); P0[r]=__builtin_fmaf(slope2v,cr_,P0[r]); P1[r]=__builtin_fmaf(slope2v,cr_+32.f,P1[r]); } }while(0)
  bool resc=false;
  #define START(P0,P1) do{ const float rm=rowmax(P0,P1); resc=false; \
    { const float dl=rm; mhat=fadd_s(mhat,dl); \
      _Pragma("unroll") for(int r=0;r<16;++r){P0[r]=fsub_s(P0[r],dl);P1[r]=fsub_s(P1[r],dl);} \
      } \
    _Pragma("unroll") for(int r=0;r<16;++r)P0[r]=__builtin_amdgcn_exp2f(P0[r]); }while(0)
  #define RESC() do{ if(resc){ asm volatile("s_waitcnt lgkmcnt(0)":::"memory"); \
      _Pragma("unroll") for(int d_=0;d_<2;++d_) _Pragma("unroll") for(int r=0;r<16;++r)o[d_][r]*=wsf[crow(r,hi)]; } }while(0)
  f32x16 pA0,pA1,pB0,pB1;
  int sl_prev=0,sl_cur=0,sl_next=SLOTB;
  #define ROT() do{sl_prev=sl_cur;sl_cur=sl_next;sl_next=(sl_next==(NSLOT-1)*SLOTB)?0:sl_next+SLOTB;}while(0)
  DMA_K(2,2*SLOTB);
  WAIT_BAR(3);
  qkt(pA0,pA1,Kbase,qr,negm,r32,hi);asm volatile("s_nop 15\n\ts_nop 7":"+v"(pA0),"+v"(pA1));ABIAS(pA0,pA1,0);CMASK(pA0,pA1,0);
  START(pA0,pA1);
  _Pragma("unroll") for(int r=0;r<16;++r)pA1[r]=__builtin_amdgcn_exp2f(pA1[r]);
  WAIT_BAR(0);
  DMA_K(3,0);DMA_V(1,SLOTB);
  ROT();
  kload8(kf,kp0+sl_cur);
  WAIT_BAR(2);
  s16x4 vlo[8],vhi[8]; u32x4 pw0,pw1,pw2,pw3;
  #define PKW(P,B) cvtpk_s(P[B],P[B+1])
  #define PAF(k) __builtin_bit_cast(bf16x8,pw##k)
  #define VFR(i) (bf16x8){vlo[i][0],vlo[i][1],vlo[i][2],vlo[i][3],vhi[i][0],vhi[i][1],vhi[i][2],vhi[i][3]}
  #define PIN(x) asm volatile("":"+v"(x))
  #define MX3(a,b,c) __builtin_fmaxf(__builtin_fmaxf((a),(b)),(c))
  #define GAPA(MF,A0,A1,A2,A3,W0,W1,PW) do{ MF; sacc+=A0; sacc+=A1; sacc+=A2; sacc+=A3; PIN(sacc); W0; W1; PIN(PW); SBAR(); }while(0)
  #define EX(v) __builtin_amdgcn_exp2f(v)
  #define GAPB(MF,X,B) do{ MF; X[B]=EX(X[B]); X[B+1]=EX(X[B+1]); X[B+2]=EX(X[B+2]); X[B+3]=EX(X[B+3]); PIN(X); SBAR(); }while(0)
  #define VRD(i) do{ vlo[i]=vtr(vp_+(((i)>>2)*4096+((i)&3)*1024)); vhi[i]=vtr(vp_+(((i)>>2)*4096+((i)&3)*1024+512)); }while(0)
  #define KRD(G,j) do{ if(G){ kload2(kf,kp0+sl_next,j); SBAR(); } }while(0)
  #define STEP(C0,C1,P0,P1,t,GK,GV,GL) do{ SBAR(); \
    const lds_cptr vp_=vp0+sl_prev; \
    VRD(0); SBAR(); float sacc=(P0[0]+P0[1]); \
    GAPA(C0=__builtin_amdgcn_mfma_f32_32x32x16_bf16(kf[0],qr[0],negm,0,0,0), P0[2],P0[3],P0[4],P0[5],     pw0[0]=PKW(P0,0), pw0[1]=PKW(P0,2), pw0); \
    VRD(4); SBAR(); GAPA(C1=__builtin_amdgcn_mfma_f32_32x32x16_bf16(kf[1],qr[0],negm,0,0,0), P0[6],P0[7],P0[8],P0[9],     pw0[2]=PKW(P0,4), pw0[3]=PKW(P0,6), pw0); \
    VRD(1); SBAR(); GAPA(C0=__builtin_amdgcn_mfma_f32_32x32x16_bf16(kf[2],qr[1],C0,0,0,0),   P0[10],P0[11],P0[12],P0[13], pw1[0]=PKW(P0,8), pw1[1]=PKW(P0,10), pw1); \
    VRD(5); SBAR(); GAPA(C1=__builtin_amdgcn_mfma_f32_32x32x16_bf16(kf[3],qr[1],C1,0,0,0),   P0[14],P0[15],P1[0],P1[1],   pw1[2]=PKW(P0,12),pw1[3]=PKW(P0,14), pw1); \
    VRD(2); SBAR(); GAPA(C0=__builtin_amdgcn_mfma_f32_32x32x16_bf16(kf[4],qr[2],C0,0,0,0),   P1[2],P1[3],P1[4],P1[5],     pw2[0]=PKW(P1,0), pw2[1]=PKW(P1,2), pw2); \
    VRD(6); SBAR(); GAPA(C1=__builtin_amdgcn_mfma_f32_32x32x16_bf16(kf[5],qr[2],C1,0,0,0),   P1[6],P1[7],P1[8],P1[9],     pw2[2]=PKW(P1,4), pw2[3]=PKW(P1,6), pw2); \
    VRD(3); SBAR(); GAPA(C0=__builtin_amdgcn_mfma_f32_32x32x16_bf16(kf[6],qr[3],C0,0,0,0),   P1[10],P1[11],P1[12],P1[13], pw3[0]=PKW(P1,8), pw3[1]=PKW(P1,10), pw3); \
    VRD(7); SBAR(); GAPA(C1=__builtin_amdgcn_mfma_f32_32x32x16_bf16(kf[7],qr[3],C1,0,0,0),   P1[14],P1[15],0.f,0.f,       pw3[2]=PKW(P1,12),pw3[3]=PKW(P1,14), pw3); \
    l_reg+=sacc; \
    if(GK){DMA_K((t)+3,sl_cur);} if(GV){DMA_V((t)+1,sl_next);} \
    ABIAS(C0,C1,t); CMASK(C0,C1,t); \
    { float a=MX3(C0[0],C0[1],C1[0]),b=MX3(C0[2],C0[3],C1[1]); a=MX3(a,C1[2],C1[3]); \
      _Pragma("unroll") for(int r=4;r<16;r+=4){a=MX3(a,C0[r],C0[r+1]);b=MX3(b,C0[r+2],C0[r+3]);a=MX3(a,C1[r],C1[r+1]);b=MX3(b,C1[r+2],C1[r+3]);} \
      float rm=__builtin_fmaxf(a,b); { auto rr=__builtin_amdgcn_permlane32_swap(__float_as_uint(rm),__float_as_uint(rm),false,false); rm=__builtin_fmaxf(__uint_as_float(rr[0]),__uint_as_float(rr[1])); } \
      resc=false; \
      if(__builtin_expect(__any(rm>(float)THRL),0)){ const float dl=__builtin_fmaxf(rm,0.f); mhat+=dl; \
        _Pragma("unroll") for(int r=0;r<16;++r){C0[r]-=dl;C1[r]-=dl;} \
        const float f=__builtin_amdgcn_exp2f(-dl); l_reg*=f; if(hi==0)wsf[r32]=f; resc=true; } } \
    SBAR(); \
    GAPB(o[0]=__builtin_amdgcn_mfma_f32_32x32x16_bf16(PAF(0),VFR(0),o[0],0,0,0), C0,0); \
    GAPB(o[1]=__builtin_amdgcn_mfma_f32_32x32x16_bf16(PAF(0),VFR(4),o[1],0,0,0), C0,4); \
    KRD(GL,0); GAPB(o[0]=__builtin_amdgcn_mfma_f32_32x32x16_bf16(PAF(1),VFR(1),o[0],0,0,0), C0,8); \
    KRD(GL,1); GAPB(o[1]=__builtin_amdgcn_mfma_f32_32x32x16_bf16(PAF(1),VFR(5),o[1],0,0,0), C0,12); \
    KRD(GL,2); GAPB(o[0]=__builtin_amdgcn_mfma_f32_32x32x16_bf16(PAF(2),VFR(2),o[0],0,0,0), C1,0); \
    KRD(GL,3); GAPB(o[1]=__builtin_amdgcn_mfma_f32_32x32x16_bf16(PAF(2),VFR(6),o[1],0,0,0), C1,4); \
    GAPB(o[0]=__builtin_amdgcn_mfma_f32_32x32x16_bf16(PAF(3),VFR(3),o[0],0,0,0), C1,8); \
    GAPB(o[1]=__builtin_amdgcn_mfma_f32_32x32x16_bf16(PAF(3),VFR(7),o[1],0,0,0), C1,12); \
    }while(0)
  int t=1;
  #undef CMASK
  #define CMASK(P0,P1,t) do{}while(0)
  for(;t+5<NT;t+=2){
    STEP(pB0,pB1,pA0,pA1,t,true,true,true);     WAIT_BAR(2); RESC(); ROT();
    STEP(pA0,pA1,pB0,pB1,t+1,true,true,true);   WAIT_BAR(2); RESC(); ROT();
  }
  #undef CMASK
  #define CMASK(P0,P1,t) do{int jb_=(t)-(NT-4); if(jb_>=0)cmask(P0,P1,jb_,qrel,hi);}while(0)
  #define ENDW(tt) do{ if((tt)+3<NT){WAIT_BAR(2);} else if((tt)+2<NT){WAIT_BAR(1);} else {WAIT_BAR(0);} }while(0)
  for(;t+1<NT;t+=2){
    STEP(pB0,pB1,pA0,pA1,t,(t+3<NT),(t+1<NT),(t+1<NT));       ENDW(t);   RESC(); ROT();
    STEP(pA0,pA1,pB0,pB1,t+1,(t+4<NT),(t+2<NT),(t+2<NT));     ENDW(t+1); RESC(); ROT();
  }
  STEP(pB0,pB1,pA0,pA1,NT-1,false,false,false); RESC();
  { float sacc=pB0[0]+pB0[1]; _Pragma("unroll") for(int r=2;r<16;++r)sacc+=pB0[r]; _Pragma("unroll") for(int r=0;r<16;++r)sacc+=pB1[r]; l_reg+=sacc;
    pw0=(u32x4){PKW(pB0,0),PKW(pB0,2),PKW(pB0,4),PKW(pB0,6)};pw1=(u32x4){PKW(pB0,8),PKW(pB0,10),PKW(pB0,12),PKW(pB0,14)};pw2=(u32x4){PKW(pB1,0),PKW(pB1,2),PKW(pB1,4),PKW(pB1,6)};pw3=(u32x4){PKW(pB1,8),PKW(pB1,10),PKW(pB1,12),PKW(pB1,14)};
    SBAR(); pv(o,vb0+sl_cur,PAF(0),PAF(1),PAF(2),PAF(3)); }
  #undef PKW
  #undef PAF
  #undef VFR
  #undef PIN
  #undef MX3
  #undef GAPA
  #undef GAPB
  #undef EX
  #undef VRD
  #undef KRD
  #undef STEP
  #undef ENDW
  {auto rr=__builtin_amdgcn_permlane32_swap(__float_as_uint(l_reg),__float_as_uint(l_reg),false,false);l_reg=__uint_as_float(rr[0])+__uint_as_float(rr[1]);}
  int lane_e=lane; asm volatile("":"+v"(lane_e)); const int r32e=lane_e&31, hie=lane_e>>5;
  if(hie==0)wsf[32+r32e]=l_reg;asm volatile("s_waitcnt lgkmcnt(0)":::"memory");
  float rli[16];
  #pragma unroll
  for(int r=0;r<16;++r)rli[r]=__builtin_amdgcn_rcpf(wsf[32+crow(r,hie)]);
  bf16*Ow=O+(rowbase+q0+wid*QBLK)*DM+vcol;
  { bf16*stg=(bf16*)(shm+LDS_OST)+wid*2048;
    #pragma unroll
    for(int r=0;r<16;++r){const int orow=crow(r,hie);
      #pragma unroll
      for(int d0=0;d0<2;++d0)stg[orow*64+d0*32+r32e]=__float2bfloat16(o[d0][r]*rli[r]);}
    asm volatile("s_waitcnt lgkmcnt(0)":::"memory");
    #pragma unroll
    for(int i=0;i<4;++i){const int row=i*8+(lane_e>>3),ch=lane_e&7; const u32x4 v=*(const u32x4*)(stg+row*64+ch*8); ATTN_STORE16(Ow+(long)row*DM+ch*8,v);} }
  asm volatile("s_waitcnt lgkmcnt(0)\n\ts_barrier":::"memory");
  #undef DMA_K
  #undef DMA_V
  #undef CMASK
  #undef ABIAS
  #undef START
  #undef RESC
  #undef ROT
}
constexpr int ATTN_LDS_BYTES=LDS_BYTES;
#undef SBAR
#undef WAIT_BAR
}

__device__ __forceinline__ void attn_unit_ref(const Params& p, unsigned char* lds, int b, int h, int comp, int qb) {
    const int tid = opaque_tid(), row = tid & 255, dh = tid >> 8;
    float* Kt = (float*)lds; float* Vt = Kt + 64 * 64;
    const bf16_t* qbuf = (const bf16_t*)(p.ws + WS_INBUF); const bf16_t* kbuf = qbuf + (size_t)T * 1024; const bf16_t* vbuf = kbuf + (size_t)T * 1024;
    bf16_t* Op = (bf16_t*)(p.ws + WS_OPART) + (size_t)comp * T * 1024;
    const size_t rowbase = (size_t)b * SEQ; const int qpos = qb * 256 + row;
    float qv[64], o[64];
    { const bf16_t* qp = qbuf + (rowbase + qpos) * 1024 + h * 128 + comp * 64;
#pragma unroll
      for (int d = 0; d < 64; d += 8) { const u32x4 w = *(const u32x4*)(qp + d);
#pragma unroll
          for (int i = 0; i < 4; ++i) { qv[d + 2 * i] = bflo(w[i]); qv[d + 2 * i + 1] = bfhi(w[i]); } } }
#pragma unroll
    for (int d = 0; d < 64; ++d) o[d] = 0.f;
    float mrun = -1e30f, l = 0.f;
    const float slope2 = exp2f(-(float)(h + 1)) * LOG2E;
    const int ntile = (qb + 1) * 4;
    for (int kt = 0; kt < ntile; ++kt) {
        __syncthreads();
        for (int ch = tid; ch < 1536; ch += NTHREADS) { const int r = ch / 24, cc = ch % 24; const size_t grow = rowbase + kt * 64 + r;
            if (cc < 8) { const u32x4 w = *(const u32x4*)(kbuf + grow * 1024 + h * 128 + comp * 64 + cc * 8);
#pragma unroll
                for (int i = 0; i < 4; ++i) { Kt[r * 64 + cc * 8 + 2 * i] = bflo(w[i]); Kt[r * 64 + cc * 8 + 2 * i + 1] = bfhi(w[i]); } }
            else { const int c2 = cc - 8; const u32x4 w = *(const u32x4*)(vbuf + grow * 1024 + h * 128 + c2 * 8);
#pragma unroll
                for (int i = 0; i < 4; ++i) { Vt[r * 128 + c2 * 8 + 2 * i] = bflo(w[i]); Vt[r * 128 + c2 * 8 + 2 * i + 1] = bfhi(w[i]); } } }
        __syncthreads();
        for (int j = 0; j < 64; ++j) {
            const int kpos = kt * 64 + j; if (kpos > qpos) break;
            float s = 0.f;
#pragma unroll
            for (int d = 0; d < 64; d += 4) { const f32x4 kv = *(const f32x4*)(Kt + j * 64 + d); s += qv[d] * kv[0] + qv[d + 1] * kv[1] + qv[d + 2] * kv[2] + qv[d + 3] * kv[3]; }
            s += slope2 * (float)kpos;
            if (s > mrun) { const float f = exp2f(mrun - s); l *= f;
#pragma unroll
                for (int d = 0; d < 64; ++d) o[d] *= f;
                mrun = s; }
            const float pr = exp2f(s - mrun); l += pr;
#pragma unroll
            for (int d = 0; d < 64; d += 4) { const f32x4 vv = *(const f32x4*)(Vt + j * 128 + dh * 64 + d); o[d] += pr * vv[0]; o[d + 1] += pr * vv[1]; o[d + 2] += pr * vv[2]; o[d + 3] += pr * vv[3]; }
        }
    }
    const float il = 1.0f / l;
    bf16_t* op = Op + (rowbase + qpos) * 1024 + h * 128 + dh * 64;
#pragma unroll
    for (int d = 0; d < 64; d += 8) { u32x4 w; w.x = pk2(o[d] * il, o[d + 1] * il); w.y = pk2(o[d + 2] * il, o[d + 3] * il); w.z = pk2(o[d + 4] * il, o[d + 5] * il); w.w = pk2(o[d + 6] * il, o[d + 7] * il); *(u32x4*)(op + d) = w; }
    __syncthreads();
}

__device__ __forceinline__ void attn_phase_queue(const Params& p, unsigned char* lds, unsigned* qctr) {
    const attn_body::bf16* Q = (const attn_body::bf16*)(p.ws + WS_INBUF); const attn_body::bf16* K = Q + (size_t)T * 1024; const attn_body::bf16* V = K + (size_t)T * 1024;
    attn_body::bf16* OP = (attn_body::bf16*)(p.ws + WS_OPART);
    volatile int* slot = (volatile int*)(lds + LDS_BYTES - 64);
    for (;;) {
        __syncthreads();
        if (threadIdx.x == 0) *slot = (int)atomicAdd(qctr, 1u);
        __syncthreads();
        const int u = __builtin_amdgcn_readfirstlane(*slot);
        if (u >= 2048) break;
        const int qb = 7 - (u >> 8), id = u & 255;
        const int vh = id & 1, comp = (id >> 1) & 1, h = (id >> 2) & 7, b = id >> 5;
        const float slope2 = exp2f(-(float)(h + 1)) * LOG2E;
        attn_body::attn_unit<8>(b, h * 128 + comp * 64, h * 128 + vh * 64, qb, slope2, Q, K, V, OP + (size_t)comp * T * 1024, (char*)lds);
    }
}

__device__ __forceinline__ void phase_combine(const Params& p) {
    const int tid = opaque_tid(), lane = tid & 63, wave = tid >> 6;
    const int gw = blockIdx.x * NWAVES + wave, NGW = gridDim.x * NWAVES;
    const float s1 = wave_sum(p.in[4][lane] * p.in[5][lane]), s2 = wave_sum(p.in[6][lane] * p.in[7][lane]);
    const float lam = __expf(s1) - __expf(s2) + 0.2f;
    const bf16_t* O0 = (const bf16_t*)(p.ws + WS_OPART); const bf16_t* O1 = O0 + (size_t)T * 1024; bf16_t* O = (bf16_t*)(p.ws + WS_O);
    const float* sg = p.in[8] + (lane & 7) * 16;
    for (int m = gw; m < T; m += NGW) {
        const u32x4 a0 = *(const u32x4*)(O0 + (size_t)m * 1024 + lane * 16), a1 = *(const u32x4*)(O0 + (size_t)m * 1024 + lane * 16 + 8);
        const u32x4 c0 = *(const u32x4*)(O1 + (size_t)m * 1024 + lane * 16), c1 = *(const u32x4*)(O1 + (size_t)m * 1024 + lane * 16 + 8);
        float d[16]; float ss = 0.f;
#pragma unroll
        for (int i = 0; i < 4; ++i) { d[2 * i] = bflo(a0[i]) - lam * bflo(c0[i]); d[2 * i + 1] = bfhi(a0[i]) - lam * bfhi(c0[i]); d[8 + 2 * i] = bflo(a1[i]) - lam * bflo(c1[i]); d[8 + 2 * i + 1] = bfhi(a1[i]) - lam * bfhi(c1[i]); }
#pragma unroll
        for (int i = 0; i < 16; ++i) ss += d[i] * d[i];
        ss += __shfl_xor(ss, 1); ss += __shfl_xor(ss, 2); ss += __shfl_xor(ss, 4);
        const float rs = 0.8f / sqrtf(ss * (1.0f / 128.0f) + 1e-6f);
        u32x4 w0, w1;
        w0.x = pk2(d[0] * rs * sg[0], d[1] * rs * sg[1]); w0.y = pk2(d[2] * rs * sg[2], d[3] * rs * sg[3]); w0.z = pk2(d[4] * rs * sg[4], d[5] * rs * sg[5]); w0.w = pk2(d[6] * rs * sg[6], d[7] * rs * sg[7]);
        w1.x = pk2(d[8] * rs * sg[8], d[9] * rs * sg[9]); w1.y = pk2(d[10] * rs * sg[10], d[11] * rs * sg[11]); w1.z = pk2(d[12] * rs * sg[12], d[13] * rs * sg[13]); w1.w = pk2(d[14] * rs * sg[14], d[15] * rs * sg[15]);
        *(u32x4*)(O + (size_t)m * DM + lane * 16) = w0; *(u32x4*)(O + (size_t)m * DM + lane * 16 + 8) = w1;
    }
}

__device__ __forceinline__ void phase_router(const Params& p, unsigned char* lds) {
    const int tid = opaque_tid(), lane = tid & 63, wave = tid >> 6;
    float* hs = (float*)lds;
    float* Wsm = hs + 64 * 260;
    float* lg = Wsm + 36 * 256;
    const float* h = p.out; const float* gf = p.in[24]; const float* wg = p.in[25]; const float* we = p.in[27];
    const float* ss2 = (const float*)(p.ws + WS_CTL + CTL_SS2); float* rstd2 = (float*)(p.ws + WS_RSTD2);
    unsigned* cnt = (unsigned*)(p.ws + WS_CTL + CTL_CNT); int* rt = (int*)(p.ws + WS_RT); float* gateb = (float*)(p.ws + WS_GATEB); int* tokinfo = (int*)(p.ws + WS_TOKINFO);
    for (int tb = blockIdx.x; tb < T / 64; tb += gridDim.x) {
        const int tok0 = tb * 64;
        float acc[5];
#pragma unroll
        for (int i = 0; i < 5; ++i) acc[i] = 0.f;
        for (int k0 = 0; k0 < DM; k0 += 256) {
            __syncthreads();
            for (int ch = tid; ch < 64 * 64; ch += NTHREADS) { const int r = ch >> 6, c4 = ch & 63; *(f32x4*)(hs + r * 260 + c4 * 4) = *(const f32x4*)(h + (size_t)(tok0 + r) * DM + k0 + c4 * 4); }
            for (int id = tid; id < 36 * 256; id += NTHREADS) { const int k = id / 36, cc = id % 36; const float w = cc < 4 ? wg[(size_t)(k0 + k) * 4 + cc] : we[(size_t)(k0 + k) * 32 + cc - 4]; Wsm[cc * 256 + k] = w * gf[k0 + k]; }
            __syncthreads();
            for (int k = 0; k < 256; k += 4) { const f32x4 hv = *(const f32x4*)(hs + lane * 260 + k);
#pragma unroll
                for (int i = 0; i < 5; ++i) { const int cc = wave + 8 * i; if (cc < 36) { const f32x4 wv = *(const f32x4*)(Wsm + cc * 256 + k); acc[i] += hv[0] * wv[0] + hv[1] * wv[1] + hv[2] * wv[2] + hv[3] * wv[3]; } } }
        }
#pragma unroll
        for (int i = 0; i < 5; ++i) { const int cc = wave + 8 * i; if (cc < 36) lg[lane * 40 + cc] = acc[i]; }
        __syncthreads();
        if (tid < 64) {
            const int t = tok0 + tid; const float rs = 1.0f / sqrtf(ss2[t] * (1.0f / DM) + 1e-6f); rstd2[t] = rs;
            float g4[4]; int grp = 0; float gmax = -3.0e38f;
#pragma unroll
            for (int i = 0; i < 4; ++i) { g4[i] = lg[tid * 40 + i] * rs + p.in[26][i]; if (g4[i] > gmax) { gmax = g4[i]; grp = i; } }
            float gs = 0.f;
#pragma unroll
            for (int i = 0; i < 4; ++i) gs += __expf(g4[i] - gmax);
            const float pg = 1.0f / gs;
            float e8[8]; int i0 = 0; float m0 = -3.0e38f;
#pragma unroll
            for (int i = 0; i < 8; ++i) { e8[i] = lg[tid * 40 + 4 + grp * 8 + i] * rs + p.in[28][grp * 8 + i]; if (e8[i] > m0) { m0 = e8[i]; i0 = i; } }
            int i1 = 0; float m1 = -3.0e38f;
#pragma unroll
            for (int i = 0; i < 8; ++i) if (i != i0 && e8[i] > m1) { m1 = e8[i]; i1 = i; }
            const float p1 = __expf(m1 - m0); const float g0 = pg / (1.0f + p1), g1 = pg * p1 / (1.0f + p1);
            const int e0 = grp * 8 + i0, e1 = grp * 8 + i1;
            const unsigned r0 = atomicAdd(cnt + e0, 1u), r1 = atomicAdd(cnt + e1, 1u);
            rt[(size_t)e0 * CAP + r0] = t; rt[(size_t)e1 * CAP + r1] = t; gateb[(size_t)e0 * CAP + r0] = g0; gateb[(size_t)e1 * CAP + r1] = g1;
            int4 ti; ti.x = e0 * CAP + (int)r0; ti.y = e1 * CAP + (int)r1; ti.z = 0; ti.w = 0; *(int4*)(tokinfo + (size_t)t * 4) = ti;
        }
        __syncthreads();
    }
}

__device__ __forceinline__ void phase_final(const Params& p, unsigned char* lds) {
    const int tid = opaque_tid(), lane = tid & 63, wave = tid >> 6;
    const int gw = blockIdx.x * NWAVES + wave, NGW = gridDim.x * NWAVES;
    int* pst = (int*)lds;
    const unsigned* cnt = (const unsigned*)(p.ws + WS_CTL + CTL_CNT);
    if (tid == 0) { int ts = 0; for (int e = 0; e < NEXP; ++e) { pst[e] = ts; ts += ((int)cnt[e] + 255) >> 8; } }
    __syncthreads();
    const int* tokinfo = (const int*)(p.ws + WS_TOKINFO); const bf16_t* yb = (const bf16_t*)(p.ws + WS_YB); const float* gfin = p.in[32]; float* out = p.out;
    for (int m = gw; m < T; m += NGW) {
        const int4 ti = *(const int4*)(tokinfo + (size_t)m * 4);
        const int e0 = ti.x / CAP, r0 = ti.x % CAP, e1 = ti.y / CAP, r1 = ti.y % CAP;
        const size_t s0 = (size_t)pst[e0] * 256 + r0, s1 = (size_t)pst[e1] * 256 + r1;
        f32x4* hr = (f32x4*)(out + (size_t)m * DM) + lane; const u32x2* y0 = (const u32x2*)(yb + s0 * DM) + lane; const u32x2* y1 = (const u32x2*)(yb + s1 * DM) + lane;
        f32x4 v[8]; float s = 0.f;
#pragma unroll
        for (int j = 0; j < 8; ++j) { v[j] = hr[64 * j]; const u32x2 a = y0[64 * j], b2 = y1[64 * j];
            v[j][0] += bflo(a.x) + bflo(b2.x); v[j][1] += bfhi(a.x) + bfhi(b2.x); v[j][2] += bflo(a.y) + bflo(b2.y); v[j][3] += bfhi(a.y) + bfhi(b2.y);
            s += (v[j][0] * v[j][0] + v[j][1] * v[j][1]) + (v[j][2] * v[j][2] + v[j][3] * v[j][3]); }
        s = wave_sum(s); const float rs = 1.0f / sqrtf(s * (1.0f / DM) + 1e-6f);
#pragma unroll
        for (int j = 0; j < 8; ++j) { const f32x4 gv = *((const f32x4*)gfin + lane + 64 * j); hr[64 * j] = v[j] * rs * gv; }
    }
}

#define GAS __attribute__((address_space(1)))
typedef GAS unsigned gu32;
#define RLX_AGENT __ATOMIC_RELAXED, __HIP_MEMORY_SCOPE_AGENT
#define XB_TMO      128
#define XB_XCNT(j)  (256  + 64 * (j))
#define XB_XSUB(j)  (1280 + 64 * (j))
#define XB_XGEN(j)  (2304 + 64 * (j))
#define XB_TOP      3328
#define XB_TOPGEN   3392
#define XCD_BAR_WORDS 3456
#define XB_SPIN_CAP (1u << 18)

__device__ __forceinline__ unsigned xb_ld(unsigned* p)              { return __hip_atomic_load(p, __ATOMIC_RELAXED, __HIP_MEMORY_SCOPE_AGENT); }
__device__ __forceinline__ unsigned xb_add(unsigned* p, unsigned v) { return __hip_atomic_fetch_add(p, v, __ATOMIC_RELAXED, __HIP_MEMORY_SCOPE_AGENT); }
__device__ __forceinline__ unsigned xb_xcc_id() { return (unsigned)__builtin_amdgcn_s_getreg((3 << 11) | 20) & 0xFu; }
#define XB_SPIN(cond, bar) do { unsigned _sp = 0; while (cond) { __builtin_amdgcn_s_sleep(1); \
    if ((++_sp & 255u) == 0u) { if (xb_ld(&(bar)[XB_TMO])) break; if (_sp > XB_SPIN_CAP) { atomicAdd(&(bar)[XB_TMO], 1u); break; } } } } while (0)

struct XcdBarrier {
    unsigned* bar; unsigned x;
    volatile LAS unsigned* st;
};

__device__ __forceinline__ XcdBarrier xcd_barrier_post(unsigned* bar, volatile LAS unsigned* st) {
    XcdBarrier b; b.bar = bar; b.x = xb_xcc_id(); b.st = st;
    if (threadIdx.x == 0) (void)xb_add(&bar[XB_XCNT(b.x)], 1u);
    return b;
}
__device__ __forceinline__ void xcd_barrier_complete(unsigned* bar, unsigned x, unsigned& nloc, unsigned& nx) {
    const unsigned G = gridDim.x * gridDim.y * gridDim.z;
    unsigned sum, cnt, mine, sp = 0u;
    for (;;) {
        sum = 0u; cnt = 0u; mine = 0u;
#pragma unroll
        for (unsigned j = 0; j < 16; ++j) { const unsigned c = xb_ld(&bar[XB_XCNT(j)]); sum += c; cnt += (c > 0u) ? 1u : 0u; mine = (j == x) ? c : mine; }
        if (sum == G) break;
        __builtin_amdgcn_s_sleep(1);
        if ((++sp & 255u) == 0u) { if (xb_ld(&bar[XB_TMO])) break; if (sp > XB_SPIN_CAP) { atomicAdd(&bar[XB_TMO], 1u); break; } }
    }
    nloc = mine > 0u ? mine : 1u; nx = cnt > 0u ? cnt : 1u;
}

__device__ __forceinline__ void xcd_barrier(const XcdBarrier& b) {
    asm volatile("s_waitcnt vmcnt(0)" ::: "memory");
    __syncthreads();
    if (threadIdx.x == 0) {
        unsigned* bar = b.bar;
        __builtin_amdgcn_s_waitcnt(0);
        unsigned nloc = b.st[0], nx = b.st[1];
        if (nloc == 0u) { xcd_barrier_complete(bar, b.x, nloc, nx); b.st[0] = nloc; b.st[1] = nx; }
        const unsigned old = xb_add(&bar[XB_XSUB(b.x)], 1u);
        const unsigned gen = old / nloc;
        if (old + 1u == (gen + 1u) * nloc) {
            __builtin_amdgcn_fence(__ATOMIC_RELEASE, "agent");
            asm volatile("s_waitcnt vmcnt(0)" ::: "memory");
            const unsigned og = xb_add(&bar[XB_TOP], 1u);
            const unsigned tg = og / nx;
            if (og + 1u == (tg + 1u) * nx) xb_add(&bar[XB_TOPGEN], 1u);
            else XB_SPIN(xb_ld(&bar[XB_TOPGEN]) == tg, bar);
            __builtin_amdgcn_fence(__ATOMIC_ACQUIRE, "agent");
            xb_add(&bar[XB_XGEN(b.x)], 1u);
            asm volatile("s_waitcnt vmcnt(0)" ::: "memory");
        } else {
            XB_SPIN(xb_ld(&bar[XB_XGEN(b.x)]) == gen, bar);
            __builtin_amdgcn_fence(__ATOMIC_ACQUIRE, "agent");
            asm volatile("s_waitcnt vmcnt(0)" ::: "memory");
        }
    }
    __syncthreads();
}


#if USE_REF_GEMM
#define GEMM_PHASE gemm_phase_ref
#else
#define GEMM_PHASE gemm_phase_mfma
#endif

__global__ void __launch_bounds__(NTHREADS, 2) fwd_kernel(Params p) {
    extern __shared__ __attribute__((aligned(16))) unsigned char lds[];
    unsigned char* ws = p.ws;
    const int lo = p.ph_lo, hi = p.ph_hi;
#define IN(k) (lo <= (k) && (k) < hi)
#if N_LAUNCH_MODE == 1
    volatile LAS unsigned* bst = (volatile LAS unsigned*)((LAS unsigned char*)lds + LDS_BYTES - 32);
    if (threadIdx.x < 2) bst[threadIdx.x] = 0u;
    __syncthreads();
    const XcdBarrier bar = xcd_barrier_post((unsigned*)(ws + WS_CTL + CTL_BAR), bst);
#define SEAM(k) do { if (IN(k) && IN((k) + 1)) xcd_barrier(bar); } while (0)
#else
#define SEAM(k) do { } while (0)
#endif
    if (IN(PH_PRO)) { phase_prologue(p, lds); if (PROBE_DUP & 8) { __syncthreads(); phase_prologue(p, lds); } } SEAM(PH_PRO);
    if (IN(PH_INPROJ)) {
        Gemm g{(const bf16_t*)(ws + WS_XB), (const bf16_t*)(ws + WS_WIN), DM, DM, DM};
        DenseOrder S; S.init(T, NIN, gridDim.x, blockIdx.x, DM, DM);
        EpiIn E{(bf16_t*)(ws + WS_INBUF), (bf16_t*)(ws + WS_PBUF), (const float*)(ws + WS_RSTD1)};
        GEMM_PHASE<EpiIn, DenseOrder>(lds, g, S, E);
    } SEAM(PH_INPROJ);
    if (IN(PH_L2PREP)) { phase_l2prep(p); } SEAM(PH_L2PREP);
    if (IN(PH_L2GEMM)) {
        Gemm g{(const bf16_t*)(ws + WS_A2), (const bf16_t*)(ws + WS_L2T), PW, 256, 256};
        DenseOrder S; S.init(T, 3072, gridDim.x, blockIdx.x, PW, 256, 2, 256);
        EpiL2 E{(float*)(ws + WS_WL), (bf16_t*)(ws + WS_ABUF), (bf16_t*)(ws + WS_GBUF), p.in[11], p.in[14]};
        GEMM_PHASE<EpiL2, DenseOrder>(lds, g, S, E);
    } SEAM(PH_L2GEMM);
    if (IN(PH_MIX)) {
        for (int rep = 0; rep < ((PROBE_DUP & 1) ? 2 : 1); ++rep)
        if ((blockIdx.x & 1) == 0) for (int chain = blockIdx.x >> 1; chain < BATCH * NH_RW; chain += (gridDim.x + 1) >> 1) rwkv_chain(p, lds, chain);
        attn_phase_queue(p, lds, (unsigned*)(ws + WS_CTL + CTL_QCTR));
        if (PROBE_DUP & 2) attn_phase_queue(p, lds, (unsigned*)(ws + WS_CTL + CTL_QCTR) + 1);
    } SEAM(PH_MIX);
    if (IN(PH_COMB)) { phase_combine(p); } SEAM(PH_COMB);
    if (IN(PH_OUT)) {
        Gemm g{(const bf16_t*)(ws + WS_O), (const bf16_t*)(ws + WS_WOUT), DM, DM, DM};
        DenseOrder S; S.init(T, DM, gridDim.x, blockIdx.x, DM, DM);
        EpiOut E{p.in[0], p.out, (bf16_t*)(ws + WS_HB), (float*)(ws + WS_CTL + CTL_SS2)};
        GEMM_PHASE<EpiOut, DenseOrder>(lds, g, S, E);
    } SEAM(PH_OUT);
    if (IN(PH_ROUTE)) { phase_router(p, lds); convert_experts(p, lds); if (PROBE_DUP & 16) { __syncthreads(); convert_experts(p, lds); } } SEAM(PH_ROUTE);
    if (IN(PH_G1)) {
        Gemm g{(const bf16_t*)(ws + WS_HB), (const bf16_t*)(ws + WS_WGU), DM, DM, DM};
        MoeOrder<true> S{(const unsigned*)(ws + WS_CTL + CTL_CNT), (const int*)(ws + WS_RT), 4, (int)gridDim.x, (int)blockIdx.x, 0, DM, (long)1024 * 2048, DM};
        EpiGU E{(bf16_t*)(ws + WS_HID), (const float*)(ws + WS_RSTD2)};
        GEMM_PHASE<EpiGU, MoeOrder<true>>(lds, g, S, E);
    } SEAM(PH_G1);
    if (IN(PH_G2)) {
        Gemm g{(const bf16_t*)(ws + WS_HID), (const bf16_t*)(ws + WS_WD), DEXP, DEXP, DEXP};
        MoeOrder<false> S{(const unsigned*)(ws + WS_CTL + CTL_CNT), (const int*)(ws + WS_RT), 8, (int)gridDim.x, (int)blockIdx.x, 1, DEXP, (long)2048 * 512, DEXP};
        EpiDown E{(bf16_t*)(ws + WS_YB), (const float*)(ws + WS_GATEB), (const unsigned*)(ws + WS_CTL + CTL_CNT)};
        GEMM_PHASE<EpiDown, MoeOrder<false>>(lds, g, S, E);
    } SEAM(PH_G2);
    if (IN(PH_FINAL)) { phase_final(p, lds); }
}

extern "C" void kernel_launch(void* const* d_in, const int* in_sizes, int n_in, void* d_out, int out_size, void* d_ws, size_t ws_size, hipStream_t stream) {
    static int grid = 0;
    if (grid == 0) {
        if (n_in != 33 || out_size != T * DM || ws_size < WS_END) { fprintf(stderr, "kernel_launch: unexpected problem (n_in %d out %d ws %zu)\n", n_in, out_size, ws_size); grid = -1; return; }
        int dev = 0, cus = 0;
        hipGetDevice(&dev); hipDeviceGetAttribute(&cus, hipDeviceAttributeMultiprocessorCount, dev);
        if (hipFuncSetAttribute((const void*)fwd_kernel, hipFuncAttributeMaxDynamicSharedMemorySize, LDS_BYTES) != hipSuccess) { fprintf(stderr, "kernel_launch: hipFuncSetAttribute failed\n"); grid = -1; return; }
        int per_cu = 0; hipOccupancyMaxActiveBlocksPerMultiprocessor(&per_cu, (const void*)fwd_kernel, NTHREADS, LDS_BYTES); (void)hipGetLastError();
        if (per_cu < 1) fprintf(stderr, "kernel_launch: occupancy query says %d blocks per CU\n", per_cu);
        if (per_cu < 1) { grid = -1; return; }
        grid = cus > 0 ? cus : 256;
    }
    if (grid < 0) return;
    hipMemsetAsync((char*)d_ws + WS_CTL, 0, CTL_BYTES, stream);
    Params p{};
    for (int i = 0; i < 33; ++i) p.in[i] = (const float*)d_in[i];
    p.out = (float*)d_out; p.ws = (unsigned char*)d_ws;
#if N_LAUNCH_MODE == 1
    p.ph_lo = 0; p.ph_hi = PH_COUNT;
    void* args[] = {&p};
    hipError_t e = hipLaunchCooperativeKernel((const void*)fwd_kernel, dim3(grid), dim3(NTHREADS), args, LDS_BYTES, stream);
    if (e != hipSuccess) fprintf(stderr, "cooperative launch failed: %s (grid %d)\n", hipGetErrorString(e), grid);
#else
    for (int ph = 0; ph < PH_COUNT; ++ph) { p.ph_lo = ph; p.ph_hi = ph + 1; hipLaunchKernelGGL(fwd_kernel, dim3(grid), dim3(NTHREADS), LDS_BYTES, stream, p); }
#endif
}
```

```cpp
#include <hip/hip_runtime.h>
#include <hip/hip_cooperative_groups.h>
#include <cstdio>
#include <cstdint>
namespace cg = cooperative_groups;

#ifndef N_LAUNCH_MODE
#define N_LAUNCH_MODE 1
#endif
#ifndef PROBE_DUP
#define PROBE_DUP 0
#endif
#ifndef USE_REF_ATTN
#define USE_REF_ATTN 0
#endif
#ifndef USE_REF_GEMM
#define USE_REF_GEMM 0
#endif

constexpr int BATCH = 8, SEQ = 2048, DM = 2048, T = BATCH * SEQ;
constexpr int DAW = 1024, RWW = 1024, NH_DA = 8, NH_RW = 16;
constexpr int NIN = 6912;
constexpr int PW = 768;
constexpr int NEXP = 32, DEXP = 512, CAP = T;
constexpr int MAXTILES = 160;
constexpr float C2Q = 0.125f * 1.4426950408889634f;
constexpr float LOG2E = 1.4426950408889634f;

constexpr size_t MiB = 1u << 20;
constexpr size_t WS_CTL = 0, CTL_BYTES = 1 * MiB;
constexpr size_t CTL_SS2 = 65536;
constexpr size_t CTL_CNT = 131072;
constexpr size_t CTL_QCTR = 131072 + 256;
constexpr size_t CTL_BAR = 262144;
constexpr size_t WS_WOUT = 1 * MiB;
constexpr size_t WS_L2T = 9 * MiB;
constexpr size_t WS_RSTD1 = 11 * MiB;
constexpr size_t WS_RSTD2 = 11 * MiB + 65536;
constexpr size_t WS_TOKINFO = 11 * MiB + 131072;
constexpr size_t WS_WIN = 12 * MiB;
constexpr size_t WS_XB = 40 * MiB;
constexpr size_t WS_O = 40 * MiB;
constexpr size_t WS_INBUF = 104 * MiB;
constexpr size_t WS_PBUF = 296 * MiB;
constexpr size_t WS_A2 = 320 * MiB;
constexpr size_t WS_WL = 344 * MiB;
constexpr size_t WS_ABUF = 408 * MiB;
constexpr size_t WS_GBUF = 440 * MiB;
constexpr size_t WS_OPART = 472 * MiB;
constexpr size_t WS_HB = 104 * MiB;
constexpr size_t WS_WGU = 168 * MiB;
constexpr size_t WS_WD = 296 * MiB;
constexpr size_t WS_RT = 360 * MiB;
constexpr size_t WS_GATEB = 362 * MiB;
constexpr size_t WS_HID = 364 * MiB;
constexpr size_t WS_YB = 404 * MiB;
constexpr size_t WS_END = 564 * MiB;

constexpr int NTHREADS = 512, NWAVES = 8;
constexpr int LDS_BYTES = 147456;

typedef unsigned short bf16_t;
typedef short bf16x8 __attribute__((ext_vector_type(8)));
typedef float f32x4 __attribute__((ext_vector_type(4)));
typedef float f32x2 __attribute__((ext_vector_type(2)));
typedef unsigned u32x4 __attribute__((ext_vector_type(4)));
typedef unsigned u32x2 __attribute__((ext_vector_type(2)));

__device__ __forceinline__ unsigned f2bf(float f) { unsigned u = __builtin_bit_cast(unsigned, f); return (u + 0x7fffu + ((u >> 16) & 1u)) >> 16; }
__device__ __forceinline__ unsigned pk2(float lo, float hi) { return f2bf(lo) | (f2bf(hi) << 16); }
__device__ __forceinline__ float bf2f(unsigned h) { return __builtin_bit_cast(float, h << 16); }
__device__ __forceinline__ float bflo(unsigned w) { return __builtin_bit_cast(float, w << 16); }
__device__ __forceinline__ float bfhi(unsigned w) { return __builtin_bit_cast(float, w & 0xffff0000u); }
__device__ __forceinline__ float wave_sum(float v) {
#pragma unroll
    for (int o = 1; o < 64; o <<= 1) v += __shfl_xor(v, o);
    return v;
}
__device__ __forceinline__ int opaque_tid() { int t = threadIdx.x; asm volatile("" : "+v"(t)); return t; }
__device__ __forceinline__ float sigmoidf_(float x) { return 1.0f / (1.0f + __expf(-x)); }

struct Params {
    const float* in[33];
    float* out;
    unsigned char* ws;
    int ph_lo, ph_hi;
};

enum { PH_PRO = 0, PH_INPROJ, PH_L2PREP, PH_L2GEMM, PH_MIX, PH_COMB, PH_OUT, PH_ROUTE, PH_G1, PH_G2, PH_FINAL, PH_COUNT };

struct Unit { int pm, pn; long a_off, b_off; const int* gidx; int valid, e, tile, k; };
struct Gemm { const bf16_t* A; const bf16_t* Bt; int lda, ldb, K; };

struct DenseOrder {
    static constexpr bool GATHER = false;
    int nM, nN, nwg, G, c, lda, ldb, acol_shift, acol_w;
    __device__ void init(int M, int N, int G_, int c_, int lda_, int ldb_, int acol_shift_ = -1, int acol_w_ = 0) {
        nM = M / 256; nN = N / 256; nwg = nM * nN; G = G_; c = c_; lda = lda_; ldb = ldb_; acol_shift = acol_shift_; acol_w = acol_w_; }
    __device__ bool next(int i, Unit& u) const {
        const long L = (long)i * G + c; if (L >= nwg) return false;
        int wgid = (int)L; { const int q = nwg / 8, r = nwg % 8, xcd = wgid % 8, off = wgid / 8; wgid = (xcd < r ? xcd * (q + 1) : r * (q + 1) + (xcd - r) * q) + off; }
        const int nig = 8 * nN, gid = wgid / nig, fm = gid * 8, gsz = (nM - fm) < 8 ? (nM - fm) : 8;
        u.pm = fm + ((wgid % nig) % gsz); u.pn = (wgid % nig) / gsz;
        u.a_off = (long)u.pm * 256 * lda + (acol_shift >= 0 ? (long)(u.pn >> acol_shift) * acol_w : 0);
        u.b_off = (long)u.pn * 256 * ldb; u.gidx = nullptr; u.valid = 256; u.e = 0; u.tile = 0; u.k = 0; return true;
    }
};
template <bool GATHER_> struct MoeOrder {
    static constexpr bool GATHER = GATHER_;
    const unsigned* cnt; const int* rt; int ncol, G, c, mode; long a_ld, b_estride, b_ld;
    __device__ bool next(int i, Unit& u) const {
        const long L = (long)i * G + c; const int g = (int)(L / ncol), pn = (int)(L % ncol);
        int ts = 0, e = 0, k = -1, ce = 0;
        for (e = 0; e < NEXP; ++e) { ce = __builtin_amdgcn_readfirstlane((int)cnt[e]); const int nt = (ce + 255) >> 8; if (g < ts + nt) { k = g - ts; break; } ts += nt; }
        if (k < 0) return false;
        u.pm = g; u.pn = pn; u.e = e; u.tile = g; u.k = k; u.valid = (ce - 256 * k) < 256 ? (ce - 256 * k) : 256;
        if (mode == 0) { u.gidx = rt + (long)e * CAP + 256 * k; u.a_off = 0; }
        else { u.gidx = nullptr; u.a_off = (long)g * 256 * a_ld; }
        u.b_off = (long)e * b_estride + (long)pn * 256 * b_ld; return true;
    }
};

template <class Epi, class Sched>
__device__ __forceinline__ void gemm_phase_ref(unsigned char* lds, const Gemm g, const Sched& S, const Epi& E) {
    const int tid = threadIdx.x, wid = tid >> 6, lane = tid & 63, wr = wid >> 2, wc = wid & 3, fr = lane & 15, fq = lane >> 4;
    bf16_t* As = (bf16_t*)lds; bf16_t* Bs = As + 256 * 72;
    Unit u;
    for (int ui = 0; S.next(ui, u); ++ui) {
        f32x4 acc[2][2][4][2];
#pragma unroll
        for (int a = 0; a < 2; ++a)
#pragma unroll
            for (int b = 0; b < 2; ++b)
#pragma unroll
                for (int m = 0; m < 4; ++m)
#pragma unroll
                    for (int n = 0; n < 2; ++n) acc[a][b][m][n] = (f32x4){0.f, 0.f, 0.f, 0.f};
        long arow[4];
#pragma unroll
        for (int i = 0; i < 4; ++i) { const int row = (tid + 512 * i) >> 3; arow[i] = u.gidx ? (row < u.valid ? (long)u.gidx[row] : 0L) : (long)row; }
        for (int k0 = 0; k0 < g.K; k0 += 64) {
            __syncthreads();
#pragma unroll
            for (int i = 0; i < 4; ++i) { const int ch = tid + 512 * i, row = ch >> 3, c8 = ch & 7;
                const u32x4 va = *(const u32x4*)(g.A + u.a_off + arow[i] * g.lda + k0 + c8 * 8);
                const u32x4 vb = *(const u32x4*)(g.Bt + u.b_off + (long)row * g.ldb + k0 + c8 * 8);
                *(u32x4*)(As + row * 72 + c8 * 8) = va; *(u32x4*)(Bs + row * 72 + c8 * 8) = vb; }
            __syncthreads();
            for (int kk = 0; kk < 64; ++kk) {
                float a[2][4];
#pragma unroll
                for (int ai = 0; ai < 2; ++ai)
#pragma unroll
                    for (int m = 0; m < 4; ++m) a[ai][m] = bf2f(As[(ai * 128 + wr * 64 + m * 16 + fr) * 72 + kk]);
#pragma unroll
                for (int bj = 0; bj < 2; ++bj)
#pragma unroll
                    for (int n = 0; n < 2; ++n)
#pragma unroll
                        for (int e = 0; e < 4; ++e) {
                            const int cl = Epi::PERM ? (bj * 128 + wc * 32 + 8 * fq + 4 * n + e) : (bj * 128 + wc * 32 + 16 * n + 4 * fq + e);
                            const float b = bf2f(Bs[cl * 72 + kk]);
#pragma unroll
                            for (int ai = 0; ai < 2; ++ai)
#pragma unroll
                                for (int m = 0; m < 4; ++m) acc[ai][bj][m][n][e] += a[ai][m] * b;
                        }
            }
        }
        E(acc, u, wr, wc, fr, fq);
    }
    __syncthreads();
}


#define LAS __attribute__((address_space(3)))
namespace pg8 {
constexpr int BK = 64, HALF = 128, HTB = HALF * BK * 2, STAGE_BYTES = 8 * HTB;
__device__ __forceinline__ int lds_byte(int r, int c) { const int st = (r >> 4) * 2 + (c >> 5), rr = r & 15, cc = c & 31, ob = rr * 64 + cc * 2; return st * 1024 + (ob ^ (((ob >> 9) & 1) << 5)); }
__device__ __forceinline__ void stage_rc(int b, int& R, int& C) { const int st = b / 1024, sb = b % 1024, swz = sb ^ (((sb >> 9) & 1) << 5); R = (st >> 1) * 16 + swz / 64; C = (st & 1) * 32 + (swz % 64) / 2; }
__device__ __forceinline__ int perm32(int rho) { const int n = rho >> 4, i = rho & 15; return 8 * (i >> 2) + 4 * n + (i & 3); }
template <bool GATHER>
__device__ __forceinline__ void unit_voffA(const Unit& u, int lda, int tid, unsigned (&v0)[2], unsigned (&v1)[2]) {
#pragma unroll
    for (int i = 0; i < 2; ++i) { int R, C; stage_rc(tid * 16 + i * 8192, R, C); int r0 = R, r1 = R + HALF;
        if (GATHER) { const int a = (r0 < u.valid) ? u.gidx[r0] : 0, b = (r1 < u.valid) ? u.gidx[r1] : 0; r0 = a; r1 = b; }
        v0[i] = (unsigned)(r0 * lda + C) * 2u; v1[i] = (unsigned)(r1 * lda + C) * 2u; }
}
template <class Epi, class Sched, bool ALIGN_EPI = true>
__device__ __forceinline__ void gemm_phase(LAS unsigned char* lds, const Gemm g, const Sched& S, const Epi& E) {
    const int tid = threadIdx.x, wid = __builtin_amdgcn_readfirstlane(tid >> 6), lane = tid & 63, wr = wid >> 2, wc = wid & 3, fr = lane & 15, fq = lane >> 4;
    const int K = g.K, nt = K / BK;
    constexpr bool GATHER = Sched::GATHER;
    unsigned voffB[2];
#pragma unroll
    for (int i = 0; i < 2; ++i) { int R, C; stage_rc(tid * 16 + i * 8192, R, C); const int Rb = Epi::PERM ? ((R & ~31) + perm32(R & 31)) : R; voffB[i] = (unsigned)(Rb * g.ldb + C) * 2u; }
    const size_t hstepA = (size_t)HALF * g.lda * 2;
    const size_t kstep = (size_t)(BK * 2);
    const size_t hstepB = (size_t)HALF * g.ldb * 2;
    const unsigned ldsw = (unsigned)wid * 1024u;
    const int aoff = lds_byte(wr * 64 + fr, fq * 8), boff = lds_byte(wc * 32 + fr, fq * 8);
#define PG8_SA(b, h) (((b) * 2 + (h)) * HTB)
#define PG8_SB(b, h) ((4 + (b) * 2 + (h)) * HTB)
#define PG8_STAGE(bufoff, gbase, voff) do { _Pragma("unroll") for (int _i = 0; _i < 2; ++_i) \
        __builtin_amdgcn_global_load_lds((const unsigned*)((const char*)(gbase) + (voff)[_i]), (LAS unsigned*)(lds + (bufoff) + ldsw + _i * 8192), 16, 0, 0); } while (0)
#define PG8_LDA(dst, b, h) do { _Pragma("unroll") for (int m = 0; m < 4; ++m) _Pragma("unroll") for (int k = 0; k < 2; ++k) dst[m][k] = *(const LAS bf16x8*)(lds + PG8_SA(b, h) + aoff + m * 2048 + k * 1024); } while (0)
#define PG8_LDB(dst, b, h) do { _Pragma("unroll") for (int n = 0; n < 2; ++n) _Pragma("unroll") for (int k = 0; k < 2; ++k) dst[n][k] = *(const LAS bf16x8*)(lds + PG8_SB(b, h) + boff + n * 2048 + k * 1024); } while (0)
#define PG8_MMA(ai, bj, At, Bt) do { __builtin_amdgcn_s_setprio(1); _Pragma("unroll") for (int m = 0; m < 4; ++m) _Pragma("unroll") for (int n = 0; n < 2; ++n) _Pragma("unroll") for (int k = 0; k < 2; ++k) \
        acc[ai][bj][m][n] = __builtin_amdgcn_mfma_f32_16x16x32_bf16(Bt[n][k], At[m][k], acc[ai][bj][m][n], 0, 0, 0); __builtin_amdgcn_s_setprio(0); } while (0)
#define PG8_WAIT_V(n) asm volatile("s_waitcnt vmcnt(" #n ")" ::: "memory")
#define PG8_WAIT_L(n) asm volatile("s_waitcnt lgkmcnt(" #n ")" ::: "memory")
#define PG8_BAR __builtin_amdgcn_s_barrier()
#define PG8_SCHED __builtin_amdgcn_sched_barrier(0)
    Unit cur, nxt; int ui = 0;
    if (!S.next(0, cur)) return;
    f32x4 acc[2][2][4][2];
#pragma unroll
    for (int a = 0; a < 2; ++a)
#pragma unroll
        for (int b = 0; b < 2; ++b)
#pragma unroll
            for (int m = 0; m < 4; ++m)
#pragma unroll
                for (int n = 0; n < 2; ++n) acc[a][b][m][n] = (f32x4){0.f, 0.f, 0.f, 0.f};
    bf16x8 At[4][2], B0[2][2], B1[2][2];
    const char* cA = (const char*)(g.A + cur.a_off); const char* cB = (const char*)(g.Bt + cur.b_off);
    unsigned vA0[2], vA1[2], nA0[2], nA1[2];
    unit_voffA<GATHER>(cur, g.lda, tid, vA0, vA1);
#define PG8_STAGE_A(bufoff, gbase, h, sel) do { if constexpr (GATHER) { if (sel) { if ((h) == 0) PG8_STAGE(bufoff, gbase, nA0); else PG8_STAGE(bufoff, gbase, nA1); } else { if ((h) == 0) PG8_STAGE(bufoff, gbase, vA0); else PG8_STAGE(bufoff, gbase, vA1); } } \
        else { PG8_STAGE(bufoff, (gbase) + ((h) ? hstepA : (size_t)0), vA0); } } while (0)
    PG8_STAGE(PG8_SB(0, 0), cB, voffB); PG8_STAGE(PG8_SB(0, 1), cB + hstepB, voffB); PG8_STAGE_A(PG8_SA(0, 0), cA, 0, false); PG8_STAGE_A(PG8_SA(0, 1), cA, 1, false);
    if (wr == 1) PG8_BAR;
    PG8_WAIT_V(2); PG8_BAR;
    PG8_STAGE(PG8_SB(1, 0), cB + kstep, voffB); PG8_STAGE_A(PG8_SA(1, 0), cA + kstep, 0, false); PG8_STAGE(PG8_SB(1, 1), cB + hstepB + kstep, voffB);
    PG8_WAIT_V(6); PG8_BAR;
    for (;;) {
        const bool has_next = S.next(ui + 1, nxt);
        const char* nA = has_next ? (const char*)(g.A + nxt.a_off) : cA; const char* nB = has_next ? (const char*)(g.Bt + nxt.b_off) : cB;
        if constexpr (GATHER) { if (has_next) unit_voffA<true>(nxt, g.lda, tid, nA0, nA1); else { nA0[0] = vA0[0]; nA0[1] = vA0[1]; nA1[0] = vA1[0]; nA1[1] = vA1[1]; } }
        for (int t = 0; t < nt; t += 2) {
            const bool last = (t == nt - 2);
            const char* a1 = cA + (size_t)(t + 1) * kstep;
            const char* a2 = last ? nA : cA + (size_t)(t + 2) * kstep; const char* b2 = last ? nB : cB + (size_t)(t + 2) * kstep;
            const char* a3 = a2 + kstep; const char* b3 = b2 + kstep;
            PG8_LDB(B0, 0, 0); PG8_LDB(B1, 0, 1); PG8_SCHED; PG8_LDA(At, 0, 0); PG8_STAGE_A(PG8_SA(1, 1), a1, 1, false);
            PG8_WAIT_V(8); PG8_WAIT_L(0); PG8_BAR; PG8_MMA(0, 0, At, B0); PG8_MMA(0, 1, At, B1); PG8_BAR; PG8_SCHED;
            PG8_LDA(At, 0, 1); PG8_STAGE(PG8_SB(0, 0), b2, voffB); PG8_STAGE(PG8_SB(0, 1), b2 + hstepB, voffB); PG8_STAGE_A(PG8_SA(0, 0), a2, 0, last);
            PG8_WAIT_V(8); PG8_WAIT_L(0); PG8_BAR; PG8_MMA(1, 0, At, B0); PG8_MMA(1, 1, At, B1); PG8_BAR; PG8_SCHED;
            PG8_LDB(B0, 1, 0); PG8_LDB(B1, 1, 1); PG8_SCHED; PG8_LDA(At, 1, 0); PG8_STAGE_A(PG8_SA(0, 1), a2, 1, last);
            PG8_WAIT_V(8); PG8_WAIT_L(0); PG8_BAR; PG8_MMA(0, 0, At, B0); PG8_MMA(0, 1, At, B1); PG8_BAR; PG8_SCHED;
            PG8_LDA(At, 1, 1); PG8_STAGE(PG8_SB(1, 0), b3, voffB); PG8_STAGE(PG8_SB(1, 1), b3 + hstepB, voffB); PG8_STAGE_A(PG8_SA(1, 0), a3, 0, last);
            PG8_WAIT_V(8); PG8_WAIT_L(0); PG8_BAR; PG8_MMA(1, 0, At, B0); PG8_MMA(1, 1, At, B1); PG8_BAR; PG8_SCHED;
        }
        if constexpr (ALIGN_EPI) { if (wr == 0) PG8_BAR; }
        E(acc, cur, wr, wc, fr, fq);
        if (!has_next) break;
#pragma unroll
        for (int a = 0; a < 2; ++a)
#pragma unroll
            for (int b = 0; b < 2; ++b)
#pragma unroll
                for (int m = 0; m < 4; ++m)
#pragma unroll
                    for (int n = 0; n < 2; ++n) acc[a][b][m][n] = (f32x4){0.f, 0.f, 0.f, 0.f};
        cur = nxt; cA = nA; cB = nB; ++ui;
        if constexpr (GATHER) { vA0[0] = nA0[0]; vA0[1] = nA0[1]; vA1[0] = nA1[0]; vA1[1] = nA1[1]; }
        if constexpr (ALIGN_EPI) { if (wr == 1) PG8_BAR; }
    }
    PG8_WAIT_V(0);
    if constexpr (!ALIGN_EPI) { if (wr == 0) PG8_BAR; }
    PG8_BAR;
#undef PG8_SA
#undef PG8_SB
#undef PG8_STAGE
#undef PG8_STAGE_A
#undef PG8_LDA
#undef PG8_LDB
#undef PG8_MMA
#undef PG8_WAIT_V
#undef PG8_WAIT_L
#undef PG8_BAR
#undef PG8_SCHED
}
}
template <class Epi, class Sched>
__device__ __forceinline__ void gemm_phase_mfma(unsigned char* lds, const Gemm g, const Sched& S, const Epi& E) { pg8::gemm_phase<Epi, Sched, true>((LAS unsigned char*)lds, g, S, E); __syncthreads(); }

__device__ __forceinline__ u32x4 pack8(const f32x4 v0, const f32x4 v1) { u32x4 w; w.x = pk2(v0[0], v0[1]); w.y = pk2(v0[2], v0[3]); w.z = pk2(v1[0], v1[1]); w.w = pk2(v1[2], v1[3]); return w; }

struct EpiIn {
    static constexpr bool PERM = true;
    bf16_t* inbuf; bf16_t* pbuf; const float* rstd1;
    __device__ __forceinline__ void operator()(const f32x4 (&acc)[2][2][4][2], const Unit& u, int wr, int wc, int fr_, int fq_) const {
        int fr = fr_, fq = fq_; asm volatile("" : "+v"(fr), "+v"(fq));
        bf16_t* base; int ldc, colt; float sc0 = 1.f;
        if (u.pn < 24) { base = inbuf + (size_t)(u.pn >> 2) * T * 1024; ldc = 1024; colt = (u.pn & 3) * 256; if (u.pn < 4) sc0 = C2Q; }
        else { base = pbuf; ldc = PW; colt = (u.pn - 24) * 256; }
        const int row0 = u.pm * 256 + wr * 64 + fr, col0 = colt + wc * 32 + 8 * fq;
#pragma unroll
        for (int ai = 0; ai < 2; ++ai)
#pragma unroll
            for (int m = 0; m < 4; ++m) { const int row = row0 + ai * 128 + m * 16; const float rs = rstd1[row] * sc0; bf16_t* rowp = base + (size_t)row * ldc + col0;
#pragma unroll
                for (int bj = 0; bj < 2; ++bj) *(u32x4*)(rowp + bj * 128) = pack8(acc[ai][bj][m][0] * rs, acc[ai][bj][m][1] * rs); }
    }
};
struct EpiL2 {
    static constexpr bool PERM = true;
    float* wl; bf16_t* abuf; bf16_t* gbuf; const float* w0; const float* a0;
    __device__ __forceinline__ void operator()(const f32x4 (&acc)[2][2][4][2], const Unit& u, int wr, int wc, int fr_, int fq_) const {
        int fr = fr_, fq = fq_; asm volatile("" : "+v"(fr), "+v"(fq));
        const int grp = u.pn >> 2, colt = (u.pn & 3) * 256;
        const int row0 = u.pm * 256 + wr * 64 + fr, col0 = colt + wc * 32 + 8 * fq;
        if (grp == 0) {
#pragma unroll
            for (int bj = 0; bj < 2; ++bj) { const int c = col0 + bj * 128; const f32x4 b0 = *(const f32x4*)(w0 + c), b1 = *(const f32x4*)(w0 + c + 4);
#pragma unroll
                for (int ai = 0; ai < 2; ++ai)
#pragma unroll
                    for (int m = 0; m < 4; ++m) { const int row = row0 + ai * 128 + m * 16; f32x4 v0 = acc[ai][bj][m][0] + b0, v1 = acc[ai][bj][m][1] + b1;
#pragma unroll
                        for (int e = 0; e < 4; ++e) { v0[e] = -0.60653065971f * LOG2E * sigmoidf_(v0[e]); v1[e] = -0.60653065971f * LOG2E * sigmoidf_(v1[e]); }
                        float* p = wl + (size_t)row * 1024 + c; *(f32x4*)p = v0; *(f32x4*)(p + 4) = v1; asm volatile("" ::: "memory"); __builtin_amdgcn_sched_barrier(0); } }
        } else if (grp == 1) {
#pragma unroll
            for (int bj = 0; bj < 2; ++bj) { const int c = col0 + bj * 128; const f32x4 b0 = *(const f32x4*)(a0 + c), b1 = *(const f32x4*)(a0 + c + 4);
#pragma unroll
                for (int ai = 0; ai < 2; ++ai)
#pragma unroll
                    for (int m = 0; m < 4; ++m) { const int row = row0 + ai * 128 + m * 16; f32x4 v0 = acc[ai][bj][m][0] + b0, v1 = acc[ai][bj][m][1] + b1;
#pragma unroll
                        for (int e = 0; e < 4; ++e) { v0[e] = sigmoidf_(v0[e]); v1[e] = sigmoidf_(v1[e]); }
                        *(u32x4*)(abuf + (size_t)row * 1024 + c) = pack8(v0, v1); asm volatile("" ::: "memory"); __builtin_amdgcn_sched_barrier(0); } }
        } else {
#pragma unroll
            for (int bj = 0; bj < 2; ++bj) { const int c = col0 + bj * 128;
#pragma unroll
                for (int ai = 0; ai < 2; ++ai)
#pragma unroll
                    for (int m = 0; m < 4; ++m) { const int row = row0 + ai * 128 + m * 16; *(u32x4*)(gbuf + (size_t)row * 1024 + c) = pack8(acc[ai][bj][m][0], acc[ai][bj][m][1]); } }
        }
    }
};
struct EpiOut {
    static constexpr bool PERM = true;
    const float* x; float* h; bf16_t* hb; float* ss2;
    __device__ __forceinline__ void operator()(const f32x4 (&acc)[2][2][4][2], const Unit& u, int wr, int wc, int fr_, int fq_) const {
        int fr = fr_, fq = fq_; asm volatile("" : "+v"(fr), "+v"(fq));
        const int row0 = u.pm * 256 + wr * 64 + fr, col0 = u.pn * 256 + wc * 32 + 8 * fq;
#pragma unroll
        for (int ai = 0; ai < 2; ++ai)
#pragma unroll
            for (int m = 0; m < 4; ++m) { const int row = row0 + ai * 128 + m * 16; float ss = 0.f;
#pragma unroll
                for (int bj = 0; bj < 2; ++bj) { const size_t off = (size_t)row * DM + col0 + bj * 128;
                    const f32x4 x0 = *(const f32x4*)(x + off), x1 = *(const f32x4*)(x + off + 4);
                    const f32x4 v0 = acc[ai][bj][m][0] + x0, v1 = acc[ai][bj][m][1] + x1;
                    *(f32x4*)(h + off) = v0; *(f32x4*)(h + off + 4) = v1; *(u32x4*)(hb + off) = pack8(v0, v1);
                    ss += (v0[0] * v0[0] + v0[1] * v0[1]) + (v0[2] * v0[2] + v0[3] * v0[3]) + (v1[0] * v1[0] + v1[1] * v1[1]) + (v1[2] * v1[2] + v1[3] * v1[3]); }
                ss += __shfl_xor(ss, 16); ss += __shfl_xor(ss, 32);
                if (fq == 0) atomicAdd(ss2 + row, ss); }
    }
};
struct EpiGU {
    static constexpr bool PERM = true;
    bf16_t* hid; const float* rstd2;
    __device__ __forceinline__ void operator()(const f32x4 (&acc)[2][2][4][2], const Unit& u, int wr, int wc, int fr_, int fq_) const {
        int fr = fr_, fq = fq_; asm volatile("" : "+v"(fr), "+v"(fq));
        const int col0 = u.pn * 128 + wc * 32 + 8 * fq;
#pragma unroll
        for (int ai = 0; ai < 2; ++ai)
#pragma unroll
            for (int m = 0; m < 4; ++m) { const int rl = ai * 128 + wr * 64 + m * 16 + fr; const int tok = (rl < u.valid) ? u.gidx[rl] : 0; const float rs = rstd2[tok];
                f32x4 o0, o1;
#pragma unroll
                for (int e = 0; e < 4; ++e) { const float g0 = acc[ai][0][m][0][e] * rs, u0 = acc[ai][1][m][0][e] * rs, g1 = acc[ai][0][m][1][e] * rs, u1 = acc[ai][1][m][1][e] * rs;
                    o0[e] = g0 * sigmoidf_(g0) * u0; o1[e] = g1 * sigmoidf_(g1) * u1; }
                *(u32x4*)(hid + ((size_t)u.tile * 256 + rl) * DEXP + col0) = pack8(o0, o1); asm volatile("" ::: "memory"); __builtin_amdgcn_sched_barrier(0); }
    }
};
struct EpiDown {
    static constexpr bool PERM = true;
    bf16_t* yb; const float* gateb; const unsigned* cnt;
    __device__ __forceinline__ void operator()(const f32x4 (&acc)[2][2][4][2], const Unit& u, int wr, int wc, int fr_, int fq_) const {
        int fr = fr_, fq = fq_; asm volatile("" : "+v"(fr), "+v"(fq));
        const int col0 = u.pn * 256 + wc * 32 + 8 * fq;
        const int k = u.k;
#pragma unroll
        for (int ai = 0; ai < 2; ++ai)
#pragma unroll
            for (int m = 0; m < 4; ++m) { const int rl = ai * 128 + wr * 64 + m * 16 + fr; const float gt = (rl < u.valid) ? gateb[(size_t)u.e * CAP + 256 * k + rl] : 0.f;
#pragma unroll
                for (int bj = 0; bj < 2; ++bj) *(u32x4*)(yb + ((size_t)u.tile * 256 + rl) * DM + col0 + bj * 128) = pack8(acc[ai][bj][m][0] * gt, acc[ai][bj][m][1] * gt); }
    }
};

__device__ __forceinline__ void tr_item64(const float* W, int ldw, int Kvalid, int Nvalid, int k0, int n0, bf16_t* WT, int ldt, int trow0, float* scr, int lane,
                                          const float* gk, const float* mu, int mode) {
    const int c4 = lane & 15, rq = lane >> 4; const bool ncol_ok = (n0 + 4 * c4) < Nvalid;
    f32x4 v[16];
#pragma unroll
    for (int i = 0; i < 16; ++i) { const int k = k0 + 4 * i + rq; v[i] = (f32x4){0.f, 0.f, 0.f, 0.f};
        if (k < Kvalid && ncol_ok) v[i] = *(const f32x4*)(W + (size_t)k * ldw + n0 + 4 * c4); }
#pragma unroll
    for (int i = 0; i < 16; ++i) { const int kk = 4 * i + rq, k = k0 + kk; float sc = 1.f;
        if (k < Kvalid) { if (gk) sc = gk[k]; if (mode == 1) sc *= (1.f - mu[k]); else if (mode == 2) sc *= mu[k]; }
        float* d = scr + kk * 65 + 4 * c4; d[0] = v[i][0] * sc; d[1] = v[i][1] * sc; d[2] = v[i][2] * sc; d[3] = v[i][3] * sc; }
    __builtin_amdgcn_s_waitcnt(0xC07F); asm volatile("" ::: "memory");
    const int c = lane & 7;
#pragma unroll
    for (int j = 0; j < 8; ++j) { const int n = (lane >> 3) + 8 * j; const float* q = scr + (8 * c) * 65 + n;
        u32x4 o; o.x = pk2(q[0 * 65], q[1 * 65]); o.y = pk2(q[2 * 65], q[3 * 65]); o.z = pk2(q[4 * 65], q[5 * 65]); o.w = pk2(q[6 * 65], q[7 * 65]);
        if (n0 + n < Nvalid) *(u32x4*)(WT + (size_t)(trow0 + n) * ldt + k0 + 8 * c) = o; }
    __builtin_amdgcn_s_waitcnt(0xC07F); asm volatile("" ::: "memory");
}

__device__ __forceinline__ void phase_prologue(const Params& p, unsigned char* lds) {
    const int tid = opaque_tid(), lane = tid & 63, wave = tid >> 6;
    const int gw = blockIdx.x * NWAVES + wave, NGW = gridDim.x * NWAVES;
    unsigned char* ws = p.ws;
    float* scr = (float*)(lds + wave * 16640);
    bf16_t* WinT = (bf16_t*)(ws + WS_WIN); bf16_t* WoutT = (bf16_t*)(ws + WS_WOUT); bf16_t* L2T = (bf16_t*)(ws + WS_L2T);
    const float* g_mix = p.in[1]; const float* mu_x = p.in[9];
    constexpr int I_WIN = 32 * 96;
    constexpr int I_L1 = 32 * (1 + 1 + 3) * 2;
    constexpr int I_WOUT = 32 * 32;
    constexpr int I_L2 = 3 * 4 * 16;
    constexpr int NITEMS = I_WIN + I_L1 + I_WOUT + I_L2;
    for (int it = gw; it < NITEMS; it += NGW) {
        int r = it;
        if (r < I_WIN) { const int kb = r / 96, nb = r % 96; tr_item64(p.in[2], 6144, 2048, 6144, 64 * kb, 64 * nb, WinT, 2048, 64 * nb, scr, lane, g_mix, nullptr, 0); continue; } r -= I_WIN;
        if (r < I_L1) {
            const int kb = r / 10, rr = r % 10;
            int which, nb, mode;
            if (rr < 2) { which = 0; nb = 0; mode = 1 + rr; } else if (rr < 4) { which = 1; nb = 0; mode = 1 + (rr - 2); } else { which = 2; nb = (rr - 4) >> 1; mode = 1 + ((rr - 4) & 1); }
            const float* W = which == 0 ? p.in[12] : which == 1 ? p.in[15] : p.in[17];
            const int ldw = which == 2 ? 160 : 64;
            const int rowbase = 6144 + (which == 0 ? 0 : which == 1 ? 128 : 256) + (mode == 2 ? ldw : 0);
            tr_item64(W, ldw, 2048, ldw, 64 * kb, 64 * nb, WinT, 2048, rowbase + 64 * nb, scr, lane, g_mix, mu_x + which * 2048, mode); continue; } r -= I_L1;
        if (r < I_WOUT) { const int kb = r / 32, nb = r % 32; tr_item64(p.in[3], 2048, 2048, 2048, 64 * kb, 64 * nb, WoutT, 2048, 64 * nb, scr, lane, nullptr, nullptr, 0); continue; } r -= I_WOUT;
        { const int which = r / 64, rr = r % 64, kb = rr / 16, nb = rr % 16;
          const float* W = which == 0 ? p.in[13] : which == 1 ? p.in[16] : p.in[18]; const int kv = which == 2 ? 160 : 64;
          tr_item64(W, 1024, kv, 1024, 64 * kb, 64 * nb, L2T, 256, which * 1024 + 64 * nb, scr, lane, nullptr, nullptr, 0); }
    }
    for (int ch = blockIdx.x * NTHREADS + tid; ch < 192 * 256; ch += gridDim.x * NTHREADS) *(u32x4*)(WinT + (size_t)6720 * 2048 + (size_t)ch * 8) = (u32x4){0u, 0u, 0u, 0u};
    const float* x = p.in[0]; bf16_t* xb = (bf16_t*)(ws + WS_XB); float* rstd1 = (float*)(ws + WS_RSTD1);
    for (int m = gw; m < T; m += NGW) {
        const f32x4* xr = (const f32x4*)(x + (size_t)m * DM) + lane; f32x4 v[8]; float s = 0.f;
#pragma unroll
        for (int j = 0; j < 8; ++j) { v[j] = xr[64 * j]; s += (v[j][0] * v[j][0] + v[j][1] * v[j][1]) + (v[j][2] * v[j][2] + v[j][3] * v[j][3]); }
        s = wave_sum(s);
        u32x2* o = (u32x2*)(xb + (size_t)m * DM) + lane;
#pragma unroll
        for (int j = 0; j < 8; ++j) { u32x2 w; w.x = pk2(v[j][0], v[j][1]); w.y = pk2(v[j][2], v[j][3]); o[64 * j] = w; }
        if (lane == 0) rstd1[m] = 1.0f / sqrtf(s * (1.0f / DM) + 1e-6f);
    }
}

__device__ __forceinline__ void convert_experts(const Params& p, unsigned char* lds) {
    const int tid = opaque_tid(), lane = tid & 63, wave = tid >> 6;
    const int gw = blockIdx.x * NWAVES + wave, NGW = gridDim.x * NWAVES;
    float* scr = (float*)(lds + wave * 16640);
    bf16_t* Wgu = (bf16_t*)(p.ws + WS_WGU); bf16_t* Wd = (bf16_t*)(p.ws + WS_WD); const float* gf = p.in[24];
    constexpr int I_G = 32 * 32 * 8;
    constexpr int I_D = 32 * 8 * 32;
    for (int it = gw; it < 2 * I_G + I_D; it += NGW) {
        int r = it;
        if (r < 2 * I_G) { const int up = r >= I_G; if (up) r -= I_G; const int e = r / 256, rr = r % 256, kb = rr / 8, nb = rr % 8; const int n0 = 64 * nb;
            tr_item64((up ? p.in[30] : p.in[29]) + (size_t)e * 2048 * 512, 512, 2048, 512, 64 * kb, n0, Wgu + (size_t)e * 1024 * 2048, 2048, 256 * (n0 >> 7) + (n0 & 127) + (up ? 128 : 0), scr, lane, gf, nullptr, 0); continue; }
        r -= 2 * I_G;
        { const int e = r / 256, rr = r % 256, kb = rr / 32, nb = rr % 32;
          tr_item64(p.in[31] + (size_t)e * 512 * 2048, 2048, 512, 2048, 64 * kb, 64 * nb, Wd + (size_t)e * 2048 * 512, 512, 64 * nb, scr, lane, nullptr, nullptr, 0); }
    }
}

__device__ __forceinline__ void phase_l2prep(const Params& p) {
    const bf16_t* P = (const bf16_t*)(p.ws + WS_PBUF); bf16_t* A2 = (bf16_t*)(p.ws + WS_A2);
    const int nchunk = T * 96;
    const int tid = opaque_tid();
    for (int id = blockIdx.x * NTHREADS + tid; id < nchunk; id += gridDim.x * NTHREADS) {
        const int t = id / 96, ch = id % 96, gi = ch >> 5, jc = (ch & 31) * 8;
        const int width = gi == 2 ? 160 : 64, pa = gi == 0 ? 0 : gi == 1 ? 128 : 256, pb = pa + width;
        u32x4 o = (u32x4){0u, 0u, 0u, 0u};
        if (jc < width) {
            const u32x4 va = *(const u32x4*)(P + (size_t)t * PW + pa + jc);
            u32x4 vb = (u32x4){0u, 0u, 0u, 0u};
            if ((t & (SEQ - 1)) != 0) vb = *(const u32x4*)(P + (size_t)(t - 1) * PW + pb + jc);
            float f[8];
#pragma unroll
            for (int i = 0; i < 4; ++i) { f[2 * i] = bflo(va[i]) + bflo(vb[i]); f[2 * i + 1] = bfhi(va[i]) + bfhi(vb[i]); }
#pragma unroll
            for (int i = 0; i < 8; ++i) { if (gi == 0) f[i] = 1.0f - 2.0f / (__expf(2.0f * f[i]) + 1.0f); else if (gi == 2) f[i] = sigmoidf_(f[i]); }
            o.x = pk2(f[0], f[1]); o.y = pk2(f[2], f[3]); o.z = pk2(f[4], f[5]); o.w = pk2(f[6], f[7]);
        }
        *(u32x4*)(A2 + (size_t)t * PW + ch * 8) = o;
    }
}

constexpr int TC = 16;
constexpr int SCAN_VEC_FLOATS = 6 * TC * 64 + 2 * TC;
constexpr int SCAN_OFF_YS = 2 * SCAN_VEC_FLOATS;
constexpr int SCAN_OFF_GB = SCAN_OFF_YS + 2 * TC * 64;
constexpr int SCAN_LDS_FLOATS = SCAN_OFF_GB + 4 * TC * 64;
#define DPP_F(v, ctrl) __builtin_bit_cast(float, __builtin_amdgcn_update_dpp(0, __builtin_bit_cast(int, (v)), (ctrl), 0xF, 0xF, true))
__device__ __forceinline__ float red8(float v) {
    v += DPP_F(v, 0xB1);
    v += DPP_F(v, 0x4E);
    v += DPP_F(v, 0x141);
    return v;
}
__device__ __forceinline__ float wave_sum_fast(float v) {
    v = red8(v);
    v += DPP_F(v, 0x140);
    v += __builtin_bit_cast(float, __builtin_amdgcn_update_dpp(0, __builtin_bit_cast(int, v), 0x142, 0xa, 0xf, false));
    v += __builtin_bit_cast(float, __builtin_amdgcn_update_dpp(0, __builtin_bit_cast(int, v), 0x143, 0xc, 0xf, false));
    return __builtin_bit_cast(float, __builtin_amdgcn_readlane(__builtin_bit_cast(int, v), 63));
}
__device__ __forceinline__ f32x2 lo2(const f32x4 x) { return (f32x2){x[0], x[1]}; }
__device__ __forceinline__ f32x2 hi2(const f32x4 x) { return (f32x2){x[2], x[3]}; }
__device__ __forceinline__ void rwkv_chain(const Params& p, unsigned char* lds, int chain) {
    const int tid = opaque_tid(), lane = tid & 63, wave = __builtin_amdgcn_readfirstlane(tid >> 6);
    const int b = chain >> 4, h = chain & 15;
    float* L = (float*)lds;
    constexpr int NC = SEQ / TC;
    if (wave < 4) {
        const int r8 = lane >> 3, q = lane & 7, iA = 16 * wave + r8, iB = iA + 8;
        f32x2 SA[4], SB[4];
#pragma unroll
        for (int e = 0; e < 4; ++e) { SA[e] = (f32x2){0.f, 0.f}; SB[e] = (f32x2){0.f, 0.f}; }
        __syncthreads();
        for (int ci = 0; ci < NC; ++ci) {
            const float* V0 = L + (ci & 1) * SCAN_VEC_FLOATS;
            float* Ys = L + SCAN_OFF_YS + (ci & 1) * TC * 64;
            const float* KKs = V0 + 8 * q; const float* Ws = V0 + TC * 64 + 8 * q; const float* Bs = V0 + 2 * TC * 64 + 8 * q; const float* Ks = V0 + 3 * TC * 64 + 8 * q;
            const float* WRs = V0 + 4 * TC * 64 + 8 * q; const float* Vs = V0 + 5 * TC * 64; const float* SC = V0 + 6 * TC * 64;
            f32x4 kk0 = *(const f32x4*)(KKs), kk1 = *(const f32x4*)(KKs + 4), w0 = *(const f32x4*)(Ws), w1 = *(const f32x4*)(Ws + 4);
            f32x4 b0 = *(const f32x4*)(Bs), b1 = *(const f32x4*)(Bs + 4), k0 = *(const f32x4*)(Ks), k1 = *(const f32x4*)(Ks + 4);
            f32x4 x0 = *(const f32x4*)(WRs), x1 = *(const f32x4*)(WRs + 4); float vA = Vs[iA], vB = Vs[iB]; f32x2 sc = *(const f32x2*)(SC);
#pragma unroll 2
            for (int tl = 0; tl < TC; ++tl) {
                const int tn = (tl + 1 < TC) ? tl + 1 : tl;
                const f32x4 nkk0 = *(const f32x4*)(KKs + tn * 64), nkk1 = *(const f32x4*)(KKs + tn * 64 + 4), nw0 = *(const f32x4*)(Ws + tn * 64), nw1 = *(const f32x4*)(Ws + tn * 64 + 4);
                const f32x4 nb0 = *(const f32x4*)(Bs + tn * 64), nb1 = *(const f32x4*)(Bs + tn * 64 + 4), nk0 = *(const f32x4*)(Ks + tn * 64), nk1 = *(const f32x4*)(Ks + tn * 64 + 4);
                const f32x4 nx0 = *(const f32x4*)(WRs + tn * 64), nx1 = *(const f32x4*)(WRs + tn * 64 + 4); const float nvA = Vs[tn * 64 + iA], nvB = Vs[tn * 64 + iB]; const f32x2 nsc = *(const f32x2*)(SC + 2 * tn);
                f32x2 t0 = SA[0] * lo2(kk0) + SA[1] * hi2(kk0); t0 += SA[2] * lo2(kk1) + SA[3] * hi2(kk1);
                f32x2 t1 = SB[0] * lo2(kk0) + SB[1] * hi2(kk0); t1 += SB[2] * lo2(kk1) + SB[3] * hi2(kk1);
                f32x2 t2 = SA[0] * lo2(x0) + SA[1] * hi2(x0); t2 += SA[2] * lo2(x1) + SA[3] * hi2(x1);
                f32x2 t3 = SB[0] * lo2(x0) + SB[1] * hi2(x0); t3 += SB[2] * lo2(x1) + SB[3] * hi2(x1);
                float saA = t0[0] + t0[1], saB = t1[0] + t1[1], pA = t2[0] + t2[1], pB = t3[0] + t3[1];
                saA += DPP_F(saA, 0xB1); saB += DPP_F(saB, 0xB1); pA += DPP_F(pA, 0xB1); pB += DPP_F(pB, 0xB1);
                saA += DPP_F(saA, 0x4E); saB += DPP_F(saB, 0x4E); pA += DPP_F(pA, 0x4E); pB += DPP_F(pB, 0x4E);
                saA += DPP_F(saA, 0x141); saB += DPP_F(saB, 0x141); pA += DPP_F(pA, 0x141); pB += DPP_F(pB, 0x141);
                const float yA = pA + (saA * sc[0] + vA * sc[1]), yB = pB + (saB * sc[0] + vB * sc[1]);
                if (q == 0) { Ys[tl * 64 + iA] = yA; Ys[tl * 64 + iB] = yB; }
                const f32x2 sA2 = (f32x2){saA, saA}, sB2 = (f32x2){saB, saB}, vA2 = (f32x2){vA, vA}, vB2 = (f32x2){vB, vB};
                SA[0] = SA[0] * lo2(w0) + (sA2 * lo2(b0) + vA2 * lo2(k0)); SA[1] = SA[1] * hi2(w0) + (sA2 * hi2(b0) + vA2 * hi2(k0));
                SA[2] = SA[2] * lo2(w1) + (sA2 * lo2(b1) + vA2 * lo2(k1)); SA[3] = SA[3] * hi2(w1) + (sA2 * hi2(b1) + vA2 * hi2(k1));
                SB[0] = SB[0] * lo2(w0) + (sB2 * lo2(b0) + vB2 * lo2(k0)); SB[1] = SB[1] * hi2(w0) + (sB2 * hi2(b0) + vB2 * hi2(k0));
                SB[2] = SB[2] * lo2(w1) + (sB2 * lo2(b1) + vB2 * lo2(k1)); SB[3] = SB[3] * hi2(w1) + (sB2 * hi2(b1) + vB2 * hi2(k1));
                kk0 = nkk0; kk1 = nkk1; w0 = nw0; w1 = nw1; b0 = nb0; b1 = nb1; k0 = nk0; k1 = nk1; x0 = nx0; x1 = nx1; vA = nvA; vB = nvB; sc = nsc;
            }
            __syncthreads();
        }
    } else {
        const int aw = wave - 4, c = h * 64 + lane;
        constexpr int SPW = TC / 4;
        const bf16_t* rb = (const bf16_t*)(p.ws + WS_INBUF) + (size_t)3 * T * 1024; const bf16_t* kb = rb + (size_t)T * 1024; const bf16_t* vb = kb + (size_t)T * 1024;
        const float* wl = (const float*)(p.ws + WS_WL); const bf16_t* ab = (const bf16_t*)(p.ws + WS_ABUF); const bf16_t* gb = (const bf16_t*)(p.ws + WS_GBUF);
        bf16_t* O = (bf16_t*)(p.ws + WS_O);
        const float mu_r = p.in[10][c], mu_k = p.in[10][1024 + c], mu_v = p.in[10][2048 + c];
        const float k_k = p.in[19][c], k_a = p.in[20][c], r_k = p.in[21][c], ln_w = p.in[22][c], ln_b = p.in[23][c];
        float rc[SPW + 1], kc[SPW + 1], vc[SPW + 1], rwl[SPW], ra[SPW], rg[SPW];
#define SCAN_LOAD(ci_) do { const int tb_ = (ci_) * TC + aw * SPW; const size_t m0_ = (size_t)b * SEQ + tb_; \
        _Pragma("unroll") for (int s_ = 0; s_ < SPW + 1; ++s_) { const bool ok_ = (tb_ + s_ - 1) >= 0; const size_t off_ = (m0_ + s_ - 1) * 1024 + c; \
            rc[s_] = ok_ ? bf2f(rb[off_]) : 0.f; kc[s_] = ok_ ? bf2f(kb[off_]) : 0.f; vc[s_] = ok_ ? bf2f(vb[off_]) : 0.f; } \
        _Pragma("unroll") for (int s_ = 0; s_ < SPW; ++s_) { const size_t off_ = (m0_ + s_) * 1024 + c; rwl[s_] = wl[off_]; ra[s_] = bf2f(ab[off_]); rg[s_] = bf2f(gb[off_]); } } while (0)
#define SCAN_PREP(ci_) do { float* V0_ = L + ((ci_) & 1) * SCAN_VEC_FLOATS; float* GB_ = L + SCAN_OFF_GB + ((ci_) & 1) * 2 * TC * 64; \
        _Pragma("unroll") for (int s_ = 0; s_ < SPW; ++s_) { const int tl_ = aw * SPW + s_; \
            const float rr_ = rc[s_ + 1] + (rc[s_] - rc[s_ + 1]) * mu_r, kx_ = kc[s_ + 1] + (kc[s_] - kc[s_ + 1]) * mu_k, vv_ = vc[s_ + 1] + (vc[s_] - vc[s_ + 1]) * mu_v; \
            const float w_ = __builtin_amdgcn_exp2f(rwl[s_]), a_ = ra[s_]; \
            const float kkv_ = kx_ * k_k; const float n2_ = wave_sum_fast(kkv_ * kkv_); const float kkn_ = kkv_ * __builtin_amdgcn_rsqf(fmaxf(n2_, 1e-24f)); \
            const float kmod_ = kx_ * (1.0f + (a_ - 1.0f) * k_a); const float bb_ = kkn_ * a_; \
            const float bon_ = wave_sum_fast(rr_ * kmod_ * r_k), br_ = wave_sum_fast(bb_ * rr_), kr_ = wave_sum_fast(kmod_ * rr_); \
            V0_[tl_ * 64 + lane] = -kkn_; V0_[TC * 64 + tl_ * 64 + lane] = w_; V0_[2 * TC * 64 + tl_ * 64 + lane] = bb_; V0_[3 * TC * 64 + tl_ * 64 + lane] = kmod_; \
            V0_[4 * TC * 64 + tl_ * 64 + lane] = w_ * rr_; V0_[5 * TC * 64 + tl_ * 64 + lane] = vv_; if (lane == 0) { V0_[6 * TC * 64 + 2 * tl_] = br_; V0_[6 * TC * 64 + 2 * tl_ + 1] = kr_; } \
            GB_[tl_ * 64 + lane] = rg[s_]; GB_[TC * 64 + tl_ * 64 + lane] = bon_ * vv_ * rg[s_]; } } while (0)
#define SCAN_POST(ci_) do { const float* Ys_ = L + SCAN_OFF_YS + ((ci_) & 1) * TC * 64; const float* GB_ = L + SCAN_OFF_GB + ((ci_) & 1) * 2 * TC * 64; \
        _Pragma("unroll") for (int s_ = 0; s_ < SPW; ++s_) { const int tl_ = aw * SPW + s_; const size_t m_ = (size_t)b * SEQ + (ci_) * TC + tl_; \
            const float y_ = Ys_[tl_ * 64 + lane]; const float mean_ = wave_sum_fast(y_) * (1.0f / 64.0f); const float d_ = y_ - mean_; const float var_ = wave_sum_fast(d_ * d_) * (1.0f / 64.0f); \
            const float yn_ = d_ * __builtin_amdgcn_rsqf(var_ + 64e-5f) * ln_w + ln_b; \
            O[m_ * DM + 1024 + c] = (bf16_t)f2bf(yn_ * GB_[tl_ * 64 + lane] + GB_[TC * 64 + tl_ * 64 + lane]); } } while (0)
        SCAN_LOAD(0); SCAN_PREP(0); SCAN_LOAD(1);
        __syncthreads();
        for (int ci = 0; ci < NC; ++ci) {
            if (ci >= 1) SCAN_POST(ci - 1);
            if (ci + 1 < NC) { SCAN_PREP(ci + 1); if (ci + 2 < NC) SCAN_LOAD(ci + 2); }
            __syncthreads();
        }
        SCAN_POST(NC - 1);
#undef SCAN_LOAD
#undef SCAN_PREP
#undef SCAN_POST
    }
    __syncthreads();
}

#include <hip/hip_bf16.h>
#include <cmath>
namespace attn_body {
using bf16=__hip_bfloat16;
using bf16x8=__attribute__((ext_vector_type(8)))short;
using s16x4=__attribute__((ext_vector_type(4)))short;
using f32x16=__attribute__((ext_vector_type(16)))float;
using u32x4=__attribute__((ext_vector_type(4)))unsigned;
constexpr int SEQ=2048,D=64,DM=1024;
constexpr int NW=8,QBLK=32,QB=QBLK*NW,KVBLK=64,NQB=SEQ/QB;
__device__ __forceinline__ int crow(int r,int hi){return (r&3)+8*(r>>2)+4*hi;}
#define SBAR() __builtin_amdgcn_sched_barrier(0)
__device__ __forceinline__ void cmask(f32x16&p0,f32x16&p1,int jb,int qrel,int hi){
  const float NEG=-INFINITY; int kb=64*jb+4*hi;
  #pragma unroll
  for(int r=0;r<16;++r){int kv=kb+(r&3)+8*(r>>2); if(kv>qrel)p0[r]=NEG; if(kv+32>qrel)p1[r]=NEG;}
}

constexpr int NSLOT=3, SLOTB=8192;
constexpr int LDS_K=0, LDS_V=NSLOT*SLOTB, LDS_WS=2*NSLOT*SLOTB, LDS_OST=LDS_WS+NW*64*4, LDS_BYTES=LDS_OST+NW*4096;
constexpr float C2=0.125f*1.4426950408889634f;
__device__ __forceinline__ void glds16(const void*gsrc,unsigned lds_dst){unsigned keep;
  asm volatile("s_mov_b32 %0, m0\n\ts_mov_b32 m0, %2\n\ts_nop 0\n\tglobal_load_lds_dwordx4 %1, off\n\ts_mov_b32 m0, %0":"=&s"(keep):"v"(gsrc),"s"(lds_dst):"memory");}
__device__ __forceinline__ float max3f(float a,float b,float c){float r;asm("v_max3_f32 %0, %1, %2, %3":"=v"(r):"v"(a),"v"(b),"v"(c));return r;}
__device__ __forceinline__ float max2f(float a,float b){float r;asm("v_max_f32_e32 %0, %1, %2":"=v"(r):"v"(a),"v"(b));return r;}
__device__ __forceinline__ float fadd_s(float a,float b){float r;asm("v_add_f32_e32 %0, %1, %2":"=v"(r):"v"(a),"v"(b));return r;}
__device__ __forceinline__ float fsub_s(float a,float b){float r;asm("v_sub_f32_e32 %0, %1, %2":"=v"(r):"v"(a),"v"(b));return r;}
typedef float f32x2_t __attribute__((ext_vector_type(2))); typedef __bf16 bf16x2_t __attribute__((ext_vector_type(2)));
__device__ __forceinline__ unsigned cvtpk_s(float lo,float hi){f32x2_t v={lo,hi};bf16x2_t b=__builtin_convertvector(v,bf16x2_t);return __builtin_bit_cast(unsigned,b);}
#define WAIT_BAR(N) asm volatile("s_waitcnt vmcnt(" #N ") lgkmcnt(0)\n\ts_barrier":::"memory")

__device__ __forceinline__ void qkt(f32x16&p0,f32x16&p1,const char*Kslot,const bf16x8*qr,const f32x16&negm,int r32,int hi){
  const char*kb=Kslot+hi*1024+r32*16;
  #pragma unroll
  for(int d0=0;d0<4;++d0){
    const bf16x8 b0=*reinterpret_cast<const bf16x8*>(kb+d0*2048);
    const bf16x8 b1=*reinterpret_cast<const bf16x8*>(kb+d0*2048+512);
    if(d0==0){p0=__builtin_amdgcn_mfma_f32_32x32x16_bf16(b0,qr[0],negm,0,0,0);p1=__builtin_amdgcn_mfma_f32_32x32x16_bf16(b1,qr[0],negm,0,0,0);}
    else{p0=__builtin_amdgcn_mfma_f32_32x32x16_bf16(b0,qr[d0],p0,0,0,0);p1=__builtin_amdgcn_mfma_f32_32x32x16_bf16(b1,qr[d0],p1,0,0,0);}}
}
typedef __attribute__((address_space(3))) const char* lds_cptr;
typedef short v4i16_t __attribute__((ext_vector_type(4)));
__device__ __forceinline__ void kload8(bf16x8*kf,lds_cptr kp){
  kf[0]=*(const __attribute__((address_space(3))) bf16x8*)(kp);      kf[1]=*(const __attribute__((address_space(3))) bf16x8*)(kp+512);
  kf[2]=*(const __attribute__((address_space(3))) bf16x8*)(kp+2048); kf[3]=*(const __attribute__((address_space(3))) bf16x8*)(kp+2560);
  kf[4]=*(const __attribute__((address_space(3))) bf16x8*)(kp+4096); kf[5]=*(const __attribute__((address_space(3))) bf16x8*)(kp+4608);
  kf[6]=*(const __attribute__((address_space(3))) bf16x8*)(kp+6144); kf[7]=*(const __attribute__((address_space(3))) bf16x8*)(kp+6656);
}
__device__ __forceinline__ void kload2(bf16x8*kf,lds_cptr kp,int j){ kf[2*j]=*(const __attribute__((address_space(3))) bf16x8*)(kp+j*2048); kf[2*j+1]=*(const __attribute__((address_space(3))) bf16x8*)(kp+j*2048+512); }
__device__ __forceinline__ s16x4 vtr(lds_cptr p){ return __builtin_bit_cast(s16x4,__builtin_amdgcn_ds_read_tr16_b64_v4i16((__attribute__((address_space(3))) v4i16_t*)p)); }
__device__ __forceinline__ float rowmax(const f32x16&p0,const f32x16&p1){
  float a=max3f(p0[0],p0[1],p1[0]),b=max3f(p0[2],p0[3],p1[1]);a=max3f(a,p1[2],p1[3]);
  #pragma unroll
  for(int r=4;r<16;r+=4){a=max3f(a,p0[r],p0[r+1]);b=max3f(b,p0[r+2],p0[r+3]);a=max3f(a,p1[r],p1[r+1]);b=max3f(b,p1[r+2],p1[r+3]);}
  const float m=max2f(a,b);
  auto rr=__builtin_amdgcn_permlane32_swap(__float_as_uint(m),__float_as_uint(m),false,false);
  return max2f(__uint_as_float(rr[0]),__uint_as_float(rr[1]));
}
__device__ __forceinline__ void pv(f32x16*o,int vb,bf16x8 pa0,bf16x8 pa1,bf16x8 pa2,bf16x8 pa3){
  #pragma unroll
  for(int d0=0;d0<2;++d0){s16x4 lo[4],hi[4];
    #pragma unroll
    for(int ks=0;ks<4;++ks){
      asm volatile("ds_read_b64_tr_b16 %0,%1 offset:%c2":"=&v"(lo[ks]):"v"(vb),"i"(d0*4096+ks*1024):"memory");
      asm volatile("ds_read_b64_tr_b16 %0,%1 offset:%c2":"=&v"(hi[ks]):"v"(vb),"i"(d0*4096+ks*1024+512):"memory");}
    asm volatile("s_waitcnt lgkmcnt(0)":::"memory");SBAR();
    #define PK(k) (bf16x8){lo[k][0],lo[k][1],lo[k][2],lo[k][3],hi[k][0],hi[k][1],hi[k][2],hi[k][3]}
    o[d0]=__builtin_amdgcn_mfma_f32_32x32x16_bf16(pa0,PK(0),o[d0],0,0,0);
    o[d0]=__builtin_amdgcn_mfma_f32_32x32x16_bf16(pa1,PK(1),o[d0],0,0,0);
    o[d0]=__builtin_amdgcn_mfma_f32_32x32x16_bf16(pa2,PK(2),o[d0],0,0,0);
    o[d0]=__builtin_amdgcn_mfma_f32_32x32x16_bf16(pa3,PK(3),o[d0],0,0,0);
    #undef PK
  }
}

#ifndef ATTN_STORE16
#define ATTN_STORE16(p,v) (*(u32x4*)(p)=(v))
#endif
template<int THRL> __device__ __forceinline__ void attn_unit(int b,int qkcol,int vcol,int qb,float slope2,const bf16*Q,const bf16*__restrict__ K,const bf16*__restrict__ V,bf16*O,char*shm){
  const int tid=opaque_tid(),lane=tid&63,r32=lane&31,hi=lane>>5; const int wid=__builtin_amdgcn_readfirstlane(tid>>6);
  const long rowbase=(long)b*SEQ; const int q0=qb*QB;
  const bf16*Qw=Q+(rowbase+q0+wid*QBLK)*DM+qkcol;
  const bf16*Kh=K+rowbase*DM+qkcol,*Vh=V+rowbase*DM+vcol;
  const unsigned lds0=(unsigned)(uintptr_t)shm;
  float*wsf=(float*)(shm+LDS_WS)+wid*64;
  const bf16*ksrc=Kh+(long)lane*DM+wid*8;
  const bf16*vsrc=Vh+(long)(16*(wid&3)+(lane>>2))*DM+(wid>>2)*32+(lane&3)*8;
  const unsigned kdst=lds0+LDS_K+wid*1024, vdst=lds0+LDS_V+wid*1024;
  #define DMA_K(t,slot) glds16(ksrc+(long)(t)*KVBLK*DM,(unsigned)__builtin_amdgcn_readfirstlane(kdst+(slot)))
  #define DMA_V(t,slot) glds16(vsrc+(long)(t)*KVBLK*DM,(unsigned)__builtin_amdgcn_readfirstlane(vdst+(slot)))
  const int vb0=(int)(lds0+LDS_V)+((lane>>4)&1)*32+(lane&3)*8+(4*hi+((lane&15)>>2))*64;
  const char*Kbase=shm+LDS_K; bf16x8 kf[8];
  const lds_cptr shm3=(lds_cptr)shm; const lds_cptr kp0=shm3+LDS_K+hi*1024+r32*16; const lds_cptr vp0=shm3+LDS_V+((lane>>4)&1)*32+(lane&3)*8+(4*hi+((lane&15)>>2))*64;
  const int NT=(q0+QB)/KVBLK;
  DMA_K(0,0);DMA_V(0,0);DMA_K(1,SLOTB);
  bf16x8 qr[4];
  #pragma unroll
  for(int d0=0;d0<4;++d0)qr[d0]=*reinterpret_cast<const bf16x8*>(&Qw[(long)r32*DM+d0*16+hi*8]);
  float mhat=0.f,l_reg=0.f;f32x16 o[2];o[0]=f32x16{};o[1]=f32x16{};const f32x16 negm=f32x16{};
  const int qrel=wid*QBLK+r32; float slope2v=slope2; asm volatile("":"+v"(slope2v));
  #define CMASK(P0,P1,t) do{int jb_=(t)-(NT-4); if(jb_>=0)cmask(P0,P1,jb_,qrel,hi);}while(0)
  #define ABIAS(P0,P1,t) do{ float kb_=slope2*(float)(64*(t)+4*hi)-mhat; asm volatile("":"+v"(kb_)); _Pragma("unroll") for(int r=0;r<16;++r){ P0[r]+=kb_; P1[r]+=kb_; } _Pragma("unroll") for(int r=0;r<16;++r){ const float cr_=(float)((r&3)+8*(r>>2)); P0[r]=__builtin_fmaf(slope2v,cr_,P0[r]); P1[r]=__builtin_fmaf(slope2v,cr_+32.f,P1[r]); } }while(0)
  bool resc=false;
  #define START(P0,P1) do{ const float rm=rowmax(P0,P1); resc=false; \
    { const float dl=rm; mhat=fadd_s(mhat,dl); \
      _Pragma("unroll") for(int r=0;r<16;++r){P0[r]=fsub_s(P0[r],dl);P1[r]=fsub_s(P1[r],dl);} \
      } \
    _Pragma("unroll") for(int r=0;r<16;++r)P0[r]=__builtin_amdgcn_exp2f(P0[r]); }while(0)
  #define RESC() do{ if(resc){ asm volatile("s_waitcnt lgkmcnt(0)":::"memory"); \
      _Pragma("unroll") for(int d_=0;d_<2;++d_) _Pragma("unroll") for(int r=0;r<16;++r)o[d_][r]*=wsf[crow(r,hi)]; } }while(0)
  f32x16 pA0,pA1,pB0,pB1;
  int sl_prev=0,sl_cur=0,sl_next=SLOTB;
  #define ROT() do{sl_prev=sl_cur;sl_cur=sl_next;sl_next=(sl_next==(NSLOT-1)*SLOTB)?0:sl_next+SLOTB;}while(0)
  DMA_K(2,2*SLOTB);
  WAIT_BAR(3);
  qkt(pA0,pA1,Kbase,qr,negm,r32,hi);asm volatile("s_nop 15\n\ts_nop 7":"+v"(pA0),"+v"(pA1));ABIAS(pA0,pA1,0);CMASK(pA0,pA1,0);
  START(pA0,pA1);
  _Pragma("unroll") for(int r=0;r<16;++r)pA1[r]=__builtin_amdgcn_exp2f(pA1[r]);
  WAIT_BAR(0);
  DMA_K(3,0);DMA_V(1,SLOTB);
  ROT();
  kload8(kf,kp0+sl_cur);
  WAIT_BAR(2);
  s16x4 vlo[8],vhi[8]; u32x4 pw0,pw1,pw2,pw3;
  #define PKW(P,B) cvtpk_s(P[B],P[B+1])
  #define PAF(k) __builtin_bit_cast(bf16x8,pw##k)
  #define VFR(i) (bf16x8){vlo[i][0],vlo[i][1],vlo[i][2],vlo[i][3],vhi[i][0],vhi[i][1],vhi[i][2],vhi[i][3]}
  #define PIN(x) asm volatile("":"+v"(x))
  #define MX3(a,b,c) __builtin_fmaxf(__builtin_fmaxf((a),(b)),(c))
  #define GAPA(MF,A0,A1,A2,A3,W0,W1,PW) do{ MF; sacc+=A0; sacc+=A1; sacc+=A2; sacc+=A3; PIN(sacc); W0; W1; PIN(PW); SBAR(); }while(0)
  #define EX(v) __builtin_amdgcn_exp2f(v)
  #define GAPB(MF,X,B) do{ MF; X[B]=EX(X[B]); X[B+1]=EX(X[B+1]); X[B+2]=EX(X[B+2]); X[B+3]=EX(X[B+3]); PIN(X); SBAR(); }while(0)
  #define VRD(i) do{ vlo[i]=vtr(vp_+(((i)>>2)*4096+((i)&3)*1024)); vhi[i]=vtr(vp_+(((i)>>2)*4096+((i)&3)*1024+512)); }while(0)
  #define KRD(G,j) do{ if(G){ kload2(kf,kp0+sl_next,j); SBAR(); } }while(0)
  #define STEP(C0,C1,P0,P1,t,GK,GV,GL) do{ SBAR(); \
    const lds_cptr vp_=vp0+sl_prev; \
    VRD(0); SBAR(); float sacc=(P0[0]+P0[1]); \
    GAPA(C0=__builtin_amdgcn_mfma_f32_32x32x16_bf16(kf[0],qr[0],negm,0,0,0), P0[2],P0[3],P0[4],P0[5],     pw0[0]=PKW(P0,0), pw0[1]=PKW(P0,2), pw0); \
    VRD(4); SBAR(); GAPA(C1=__builtin_amdgcn_mfma_f32_32x32x16_bf16(kf[1],qr[0],negm,0,0,0), P0[6],P0[7],P0[8],P0[9],     pw0[2]=PKW(P0,4), pw0[3]=PKW(P0,6), pw0); \
    VRD(1); SBAR(); GAPA(C0=__builtin_amdgcn_mfma_f32_32x32x16_bf16(kf[2],qr[1],C0,0,0,0),   P0[10],P0[11],P0[12],P0[13], pw1[0]=PKW(P0,8), pw1[1]=PKW(P0,10), pw1); \
    VRD(5); SBAR(); GAPA(C1=__builtin_amdgcn_mfma_f32_32x32x16_bf16(kf[3],qr[1],C1,0,0,0),   P0[14],P0[15],P1[0],P1[1],   pw1[2]=PKW(P0,12),pw1[3]=PKW(P0,14), pw1); \
    VRD(2); SBAR(); GAPA(C0=__builtin_amdgcn_mfma_f32_32x32x16_bf16(kf[4],qr[2],C0,0,0,0),   P1[2],P1[3],P1[4],P1[5],     pw2[0]=PKW(P1,0), pw2[1]=PKW(P1,2), pw2); \
    VRD(6); SBAR(); GAPA(C1=__builtin_amdgcn_mfma_f32_32x32x16_bf16(kf[5],qr[2],C1,0,0,0),   P1[6],P1[7],P1[8],P1[9],     pw2[2]=PKW(P1,4), pw2[3]=PKW(P1,6), pw2); \
    VRD(3); SBAR(); GAPA(C0=__builtin_amdgcn_mfma_f32_32x32x16_bf16(kf[6],qr[3],C0,0,0,0),   P1[10],P1[11],P1[12],P1[13], pw3[0]=PKW(P1,8), pw3[1]=PKW(P1,10), pw3); \
    VRD(7); SBAR(); GAPA(C1=__builtin_amdgcn_mfma_f32_32x32x16_bf16(kf[7],qr[3],C1,0,0,0),   P1[14],P1[15],0.f,0.f,       pw3[2]=PKW(P1,12),pw3[3]=PKW(P1,14), pw3); \
    l_reg+=sacc; \
    if(GK){DMA_K((t)+3,sl_cur);} if(GV){DMA_V((t)+1,sl_next);} \
    ABIAS(C0,C1,t); CMASK(C0,C1,t); \
    { float a=MX3(C0[0],C0[1],C1[0]),b=MX3(C0[2],C0[3],C1[1]); a=MX3(a,C1[2],C1[3]); \
      _Pragma("unroll") for(int r=4;r<16;r+=4){a=MX3(a,C0[r],C0[r+1]);b=MX3(b,C0[r+2],C0[r+3]);a=MX3(a,C1[r],C1[r+1]);b=MX3(b,C1[r+2],C1[r+3]);} \
      float rm=__builtin_fmaxf(a,b); { auto rr=__builtin_amdgcn_permlane32_swap(__float_as_uint(rm),__float_as_uint(rm),false,false); rm=__builtin_fmaxf(__uint_as_float(rr[0]),__uint_as_float(rr[1])); } \
      resc=false; \
      if(__builtin_expect(__any(rm>(float)THRL),0)){ const float dl=__builtin_fmaxf(rm,0.f); mhat+=dl; \
        _Pragma("unroll") for(int r=0;r<16;++r){C0[r]-=dl;C1[r]-=dl;} \
        const float f=__builtin_amdgcn_exp2f(-dl); l_reg*=f; if(hi==0)wsf[r32]=f; resc=true; } } \
    SBAR(); \
    GAPB(o[0]=__builtin_amdgcn_mfma_f32_32x32x16_bf16(PAF(0),VFR(0),o[0],0,0,0), C0,0); \
    GAPB(o[1]=__builtin_amdgcn_mfma_f32_32x32x16_bf16(PAF(0),VFR(4),o[1],0,0,0), C0,4); \
    KRD(GL,0); GAPB(o[0]=__builtin_amdgcn_mfma_f32_32x32x16_bf16(PAF(1),VFR(1),o[0],0,0,0), C0,8); \
    KRD(GL,1); GAPB(o[1]=__builtin_amdgcn_mfma_f32_32x32x16_bf16(PAF(1),VFR(5),o[1],0,0,0), C0,12); \
    KRD(GL,2); GAPB(o[0]=__builtin_amdgcn_mfma_f32_32x32x16_bf16(PAF(2),VFR(2),o[0],0,0,0), C1,0); \
    KRD(GL,3); GAPB(o[1]=__builtin_amdgcn_mfma_f32_32x32x16_bf16(PAF(2),VFR(6),o[1],0,0,0), C1,4); \
    GAPB(o[0]=__builtin_amdgcn_mfma_f32_32x32x16_bf16(PAF(3),VFR(3),o[0],0,0,0), C1,8); \
    GAPB(o[1]=__builtin_amdgcn_mfma_f32_32x32x16_bf16(PAF(3),VFR(7),o[1],0,0,0), C1,12); \
    }while(0)
  int t=1;
  #undef CMASK
  #define CMASK(P0,P1,t) do{}while(0)
  for(;t+5<NT;t+=2){
    STEP(pB0,pB1,pA0,pA1,t,true,true,true);     WAIT_BAR(2); RESC(); ROT();
    STEP(pA0,pA1,pB0,pB1,t+1,true,true,true);   WAIT_BAR(2); RESC(); ROT();
  }
  #undef CMASK
  #define CMASK(P0,P1,t) do{int jb_=(t)-(NT-4); if(jb_>=0)cmask(P0,P1,jb_,qrel,hi);}while(0)
  #define ENDW(tt) do{ if((tt)+3<NT){WAIT_BAR(2);} else if((tt)+2<NT){WAIT_BAR(1);} else {WAIT_BAR(0);} }while(0)
  for(;t+1<NT;t+=2){
    STEP(pB0,pB1,pA0,pA1,t,(t+3<NT),(t+1<NT),(t+1<NT));       ENDW(t);   RESC(); ROT();
    STEP(pA0,pA1,pB0,pB1,t+1,(t+4<NT),(t+2<NT),(t+2<NT));     ENDW(t+1); RESC(); ROT();
  }
  STEP(pB0,pB1,pA0,pA1,NT-1,false,false,false); RESC();
  { float sacc=pB0[0]+pB0[1]; _Pragma("unroll") for(int r=2;r<16;++r)sacc+=pB0[r]; _Pragma("unroll") for(int r=0;r<16;++r)sacc+=pB1[r]; l_reg+=sacc;
    pw0=(u32x4){PKW(pB0,0),PKW(pB0,2),PKW(pB0,4),PKW(pB0,6)};pw1=(u32x4){PKW(pB0,8),PKW(pB0,10),PKW(pB0,12),PKW(pB0,14)};pw2=(u32x4){PKW(pB1,0),PKW(pB1,2),PKW(pB1,4),PKW(pB1,6)};pw3=(u32x4){PKW(pB1,8),PKW(pB1,10),PKW(pB1,12),PKW(pB1,14)};
    SBAR(); pv(o,vb0+sl_cur,PAF(0),PAF(1),PAF(2),PAF(3)); }
  #undef PKW
  #undef PAF
  #undef VFR
  #undef PIN
  #undef MX3
  #undef GAPA
  #undef GAPB
  #undef EX
  #undef VRD
  #undef KRD
  #undef STEP
  #undef ENDW
  {auto rr=__builtin_amdgcn_permlane32_swap(__float_as_uint(l_reg),__float_as_uint(l_reg),false,false);l_reg=__uint_as_float(rr[0])+__uint_as_float(rr[1]);}
  int lane_e=lane; asm volatile("":"+v"(lane_e)); const int r32e=lane_e&31, hie=lane_e>>5;
  if(hie==0)wsf[32+r32e]=l_reg;asm volatile("s_waitcnt lgkmcnt(0)":::"memory");
  float rli[16];
  #pragma unroll
  for(int r=0;r<16;++r)rli[r]=__builtin_amdgcn_rcpf(wsf[32+crow(r,hie)]);
  bf16*Ow=O+(rowbase+q0+wid*QBLK)*DM+vcol;
  { bf16*stg=(bf16*)(shm+LDS_OST)+wid*2048;
    #pragma unroll
    for(int r=0;r<16;++r){const int orow=crow(r,hie);
      #pragma unroll
      for(int d0=0;d0<2;++d0)stg[orow*64+d0*32+r32e]=__float2bfloat16(o[d0][r]*rli[r]);}
    asm volatile("s_waitcnt lgkmcnt(0)":::"memory");
    #pragma unroll
    for(int i=0;i<4;++i){const int row=i*8+(lane_e>>3),ch=lane_e&7; const u32x4 v=*(const u32x4*)(stg+row*64+ch*8); ATTN_STORE16(Ow+(long)row*DM+ch*8,v);} }
  asm volatile("s_waitcnt lgkmcnt(0)\n\ts_barrier":::"memory");
  #undef DMA_K
  #undef DMA_V
  #undef CMASK
  #undef ABIAS
  #undef START
  #undef RESC
  #undef ROT
}
constexpr int ATTN_LDS_BYTES=LDS_BYTES;
#undef SBAR
#undef WAIT_BAR
}

__device__ __forceinline__ void attn_unit_ref(const Params& p, unsigned char* lds, int b, int h, int comp, int qb) {
    const int tid = opaque_tid(), row = tid & 255, dh = tid >> 8;
    float* Kt = (float*)lds; float* Vt = Kt + 64 * 64;
    const bf16_t* qbuf = (const bf16_t*)(p.ws + WS_INBUF); const bf16_t* kbuf = qbuf + (size_t)T * 1024; const bf16_t* vbuf = kbuf + (size_t)T * 1024;
    bf16_t* Op = (bf16_t*)(p.ws + WS_OPART) + (size_t)comp * T * 1024;
    const size_t rowbase = (size_t)b * SEQ; const int qpos = qb * 256 + row;
    float qv[64], o[64];
    { const bf16_t* qp = qbuf + (rowbase + qpos) * 1024 + h * 128 + comp * 64;
#pragma unroll
      for (int d = 0; d < 64; d += 8) { const u32x4 w = *(const u32x4*)(qp + d);
#pragma unroll
          for (int i = 0; i < 4; ++i) { qv[d + 2 * i] = bflo(w[i]); qv[d + 2 * i + 1] = bfhi(w[i]); } } }
#pragma unroll
    for (int d = 0; d < 64; ++d) o[d] = 0.f;
    float mrun = -1e30f, l = 0.f;
    const float slope2 = exp2f(-(float)(h + 1)) * LOG2E;
    const int ntile = (qb + 1) * 4;
    for (int kt = 0; kt < ntile; ++kt) {
        __syncthreads();
        for (int ch = tid; ch < 1536; ch += NTHREADS) { const int r = ch / 24, cc = ch % 24; const size_t grow = rowbase + kt * 64 + r;
            if (cc < 8) { const u32x4 w = *(const u32x4*)(kbuf + grow * 1024 + h * 128 + comp * 64 + cc * 8);
#pragma unroll
                for (int i = 0; i < 4; ++i) { Kt[r * 64 + cc * 8 + 2 * i] = bflo(w[i]); Kt[r * 64 + cc * 8 + 2 * i + 1] = bfhi(w[i]); } }
            else { const int c2 = cc - 8; const u32x4 w = *(const u32x4*)(vbuf + grow * 1024 + h * 128 + c2 * 8);
#pragma unroll
                for (int i = 0; i < 4; ++i) { Vt[r * 128 + c2 * 8 + 2 * i] = bflo(w[i]); Vt[r * 128 + c2 * 8 + 2 * i + 1] = bfhi(w[i]); } } }
        __syncthreads();
        for (int j = 0; j < 64; ++j) {
            const int kpos = kt * 64 + j; if (kpos > qpos) break;
            float s = 0.f;
#pragma unroll
            for (int d = 0; d < 64; d += 4) { const f32x4 kv = *(const f32x4*)(Kt + j * 64 + d); s += qv[d] * kv[0] + qv[d + 1] * kv[1] + qv[d + 2] * kv[2] + qv[d + 3] * kv[3]; }
            s += slope2 * (float)kpos;
            if (s > mrun) { const float f = exp2f(mrun - s); l *= f;
#pragma unroll
                for (int d = 0; d < 64; ++d) o[d] *= f;
                mrun = s; }
            const float pr = exp2f(s - mrun); l += pr;
#pragma unroll
            for (int d = 0; d < 64; d += 4) { const f32x4 vv = *(const f32x4*)(Vt + j * 128 + dh * 64 + d); o[d] += pr * vv[0]; o[d + 1] += pr * vv[1]; o[d + 2] += pr * vv[2]; o[d + 3] += pr * vv[3]; }
        }
    }
    const float il = 1.0f / l;
    bf16_t* op = Op + (rowbase + qpos) * 1024 + h * 128 + dh * 64;
#pragma unroll
    for (int d = 0; d < 64; d += 8) { u32x4 w; w.x = pk2(o[d] * il, o[d + 1] * il); w.y = pk2(o[d + 2] * il, o[d + 3] * il); w.z = pk2(o[d + 4] * il, o[d + 5] * il); w.w = pk2(o[d + 6] * il, o[d + 7] * il); *(u32x4*)(op + d) = w; }
    __syncthreads();
}

__device__ __forceinline__ void attn_phase_queue(const Params& p, unsigned char* lds, unsigned* qctr) {
    const attn_body::bf16* Q = (const attn_body::bf16*)(p.ws + WS_INBUF); const attn_body::bf16* K = Q + (size_t)T * 1024; const attn_body::bf16* V = K + (size_t)T * 1024;
    attn_body::bf16* OP = (attn_body::bf16*)(p.ws + WS_OPART);
    volatile int* slot = (volatile int*)(lds + LDS_BYTES - 64);
    for (;;) {
        __syncthreads();
        if (threadIdx.x == 0) *slot = (int)atomicAdd(qctr, 1u);
        __syncthreads();
        const int u = __builtin_amdgcn_readfirstlane(*slot);
        if (u >= 2048) break;
        const int qb = 7 - (u >> 8), id = u & 255;
        const int vh = id & 1, comp = (id >> 1) & 1, h = (id >> 2) & 7, b = id >> 5;
        const float slope2 = exp2f(-(float)(h + 1)) * LOG2E;
        attn_body::attn_unit<8>(b, h * 128 + comp * 64, h * 128 + vh * 64, qb, slope2, Q, K, V, OP + (size_t)comp * T * 1024, (char*)lds);
    }
}

__device__ __forceinline__ void phase_combine(const Params& p) {
    const int tid = opaque_tid(), lane = tid & 63, wave = tid >> 6;
    const int gw = blockIdx.x * NWAVES + wave, NGW = gridDim.x * NWAVES;
    const float s1 = wave_sum(p.in[4][lane] * p.in[5][lane]), s2 = wave_sum(p.in[6][lane] * p.in[7][lane]);
    const float lam = __expf(s1) - __expf(s2) + 0.2f;
    const bf16_t* O0 = (const bf16_t*)(p.ws + WS_OPART); const bf16_t* O1 = O0 + (size_t)T * 1024; bf16_t* O = (bf16_t*)(p.ws + WS_O);
    const float* sg = p.in[8] + (lane & 7) * 16;
    for (int m = gw; m < T; m += NGW) {
        const u32x4 a0 = *(const u32x4*)(O0 + (size_t)m * 1024 + lane * 16), a1 = *(const u32x4*)(O0 + (size_t)m * 1024 + lane * 16 + 8);
        const u32x4 c0 = *(const u32x4*)(O1 + (size_t)m * 1024 + lane * 16), c1 = *(const u32x4*)(O1 + (size_t)m * 1024 + lane * 16 + 8);
        float d[16]; float ss = 0.f;
#pragma unroll
        for (int i = 0; i < 4; ++i) { d[2 * i] = bflo(a0[i]) - lam * bflo(c0[i]); d[2 * i + 1] = bfhi(a0[i]) - lam * bfhi(c0[i]); d[8 + 2 * i] = bflo(a1[i]) - lam * bflo(c1[i]); d[8 + 2 * i + 1] = bfhi(a1[i]) - lam * bfhi(c1[i]); }
#pragma unroll
        for (int i = 0; i < 16; ++i) ss += d[i] * d[i];
        ss += __shfl_xor(ss, 1); ss += __shfl_xor(ss, 2); ss += __shfl_xor(ss, 4);
        const float rs = 0.8f / sqrtf(ss * (1.0f / 128.0f) + 1e-6f);
        u32x4 w0, w1;
        w0.x = pk2(d[0] * rs * sg[0], d[1] * rs * sg[1]); w0.y = pk2(d[2] * rs * sg[2], d[3] * rs * sg[3]); w0.z = pk2(d[4] * rs * sg[4], d[5] * rs * sg[5]); w0.w = pk2(d[6] * rs * sg[6], d[7] * rs * sg[7]);
        w1.x = pk2(d[8] * rs * sg[8], d[9] * rs * sg[9]); w1.y = pk2(d[10] * rs * sg[10], d[11] * rs * sg[11]); w1.z = pk2(d[12] * rs * sg[12], d[13] * rs * sg[13]); w1.w = pk2(d[14] * rs * sg[14], d[15] * rs * sg[15]);
        *(u32x4*)(O + (size_t)m * DM + lane * 16) = w0; *(u32x4*)(O + (size_t)m * DM + lane * 16 + 8) = w1;
    }
}

__device__ __forceinline__ void phase_router(const Params& p, unsigned char* lds) {
    const int tid = opaque_tid(), lane = tid & 63, wave = tid >> 6;
    float* hs = (float*)lds;
    float* Wsm = hs + 64 * 260;
    float* lg = Wsm + 36 * 256;
    const float* h = p.out; const float* gf = p.in[24]; const float* wg = p.in[25]; const float* we = p.in[27];
    const float* ss2 = (const float*)(p.ws + WS_CTL + CTL_SS2); float* rstd2 = (float*)(p.ws + WS_RSTD2);
    unsigned* cnt = (unsigned*)(p.ws + WS_CTL + CTL_CNT); int* rt = (int*)(p.ws + WS_RT); float* gateb = (float*)(p.ws + WS_GATEB); int* tokinfo = (int*)(p.ws + WS_TOKINFO);
    for (int tb = blockIdx.x; tb < T / 64; tb += gridDim.x) {
        const int tok0 = tb * 64;
        float acc[5];
#pragma unroll
        for (int i = 0; i < 5; ++i) acc[i] = 0.f;
        for (int k0 = 0; k0 < DM; k0 += 256) {
            __syncthreads();
            for (int ch = tid; ch < 64 * 64; ch += NTHREADS) { const int r = ch >> 6, c4 = ch & 63; *(f32x4*)(hs + r * 260 + c4 * 4) = *(const f32x4*)(h + (size_t)(tok0 + r) * DM + k0 + c4 * 4); }
            for (int id = tid; id < 36 * 256; id += NTHREADS) { const int k = id / 36, cc = id % 36; const float w = cc < 4 ? wg[(size_t)(k0 + k) * 4 + cc] : we[(size_t)(k0 + k) * 32 + cc - 4]; Wsm[cc * 256 + k] = w * gf[k0 + k]; }
            __syncthreads();
            for (int k = 0; k < 256; k += 4) { const f32x4 hv = *(const f32x4*)(hs + lane * 260 + k);
#pragma unroll
                for (int i = 0; i < 5; ++i) { const int cc = wave + 8 * i; if (cc < 36) { const f32x4 wv = *(const f32x4*)(Wsm + cc * 256 + k); acc[i] += hv[0] * wv[0] + hv[1] * wv[1] + hv[2] * wv[2] + hv[3] * wv[3]; } } }
        }
#pragma unroll
        for (int i = 0; i < 5; ++i) { const int cc = wave + 8 * i; if (cc < 36) lg[lane * 40 + cc] = acc[i]; }
        __syncthreads();
        if (tid < 64) {
            const int t = tok0 + tid; const float rs = 1.0f / sqrtf(ss2[t] * (1.0f / DM) + 1e-6f); rstd2[t] = rs;
            float g4[4]; int grp = 0; float gmax = -3.0e38f;
#pragma unroll
            for (int i = 0; i < 4; ++i) { g4[i] = lg[tid * 40 + i] * rs + p.in[26][i]; if (g4[i] > gmax) { gmax = g4[i]; grp = i; } }
            float gs = 0.f;
#pragma unroll
            for (int i = 0; i < 4; ++i) gs += __expf(g4[i] - gmax);
            const float pg = 1.0f / gs;
            float e8[8]; int i0 = 0; float m0 = -3.0e38f;
#pragma unroll
            for (int i = 0; i < 8; ++i) { e8[i] = lg[tid * 40 + 4 + grp * 8 + i] * rs + p.in[28][grp * 8 + i]; if (e8[i] > m0) { m0 = e8[i]; i0 = i; } }
            int i1 = 0; float m1 = -3.0e38f;
#pragma unroll
            for (int i = 0; i < 8; ++i) if (i != i0 && e8[i] > m1) { m1 = e8[i]; i1 = i; }
            const float p1 = __expf(m1 - m0); const float g0 = pg / (1.0f + p1), g1 = pg * p1 / (1.0f + p1);
            const int e0 = grp * 8 + i0, e1 = grp * 8 + i1;
            const unsigned r0 = atomicAdd(cnt + e0, 1u), r1 = atomicAdd(cnt + e1, 1u);
            rt[(size_t)e0 * CAP + r0] = t; rt[(size_t)e1 * CAP + r1] = t; gateb[(size_t)e0 * CAP + r0] = g0; gateb[(size_t)e1 * CAP + r1] = g1;
            int4 ti; ti.x = e0 * CAP + (int)r0; ti.y = e1 * CAP + (int)r1; ti.z = 0; ti.w = 0; *(int4*)(tokinfo + (size_t)t * 4) = ti;
        }
        __syncthreads();
    }
}

__device__ __forceinline__ void phase_final(const Params& p, unsigned char* lds) {
    const int tid = opaque_tid(), lane = tid & 63, wave = tid >> 6;
    const int gw = blockIdx.x * NWAVES + wave, NGW = gridDim.x * NWAVES;
    int* pst = (int*)lds;
    const unsigned* cnt = (const unsigned*)(p.ws + WS_CTL + CTL_CNT);
    if (tid == 0) { int ts = 0; for (int e = 0; e < NEXP; ++e) { pst[e] = ts; ts += ((int)cnt[e] + 255) >> 8; } }
    __syncthreads();
    const int* tokinfo = (const int*)(p.ws + WS_TOKINFO); const bf16_t* yb = (const bf16_t*)(p.ws + WS_YB); const float* gfin = p.in[32]; float* out = p.out;
    for (int m = gw; m < T; m += NGW) {
        const int4 ti = *(const int4*)(tokinfo + (size_t)m * 4);
        const int e0 = ti.x / CAP, r0 = ti.x % CAP, e1 = ti.y / CAP, r1 = ti.y % CAP;
        const size_t s0 = (size_t)pst[e0] * 256 + r0, s1 = (size_t)pst[e1] * 256 + r1;
        f32x4* hr = (f32x4*)(out + (size_t)m * DM) + lane; const u32x2* y0 = (const u32x2*)(yb + s0 * DM) + lane; const u32x2* y1 = (const u32x2*)(yb + s1 * DM) + lane;
        f32x4 v[8]; float s = 0.f;
#pragma unroll
        for (int j = 0; j < 8; ++j) { v[j] = hr[64 * j]; const u32x2 a = y0[64 * j], b2 = y1[64 * j];
            v[j][0] += bflo(a.x) + bflo(b2.x); v[j][1] += bfhi(a.x) + bfhi(b2.x); v[j][2] += bflo(a.y) + bflo(b2.y); v[j][3] += bfhi(a.y) + bfhi(b2.y);
            s += (v[j][0] * v[j][0] + v[j][1] * v[j][1]) + (v[j][2] * v[j][2] + v[j][3] * v[j][3]); }
        s = wave_sum(s); const float rs = 1.0f / sqrtf(s * (1.0f / DM) + 1e-6f);
#pragma unroll
        for (int j = 0; j < 8; ++j) { const f32x4 gv = *((const f32x4*)gfin + lane + 64 * j); hr[64 * j] = v[j] * rs * gv; }
    }
}

#define GAS __attribute__((address_space(1)))
typedef GAS unsigned gu32;
#define RLX_AGENT __ATOMIC_RELAXED, __HIP_MEMORY_SCOPE_AGENT
#define XB_TMO      128
#define XB_XCNT(j)  (256  + 64 * (j))
#define XB_XSUB(j)  (1280 + 64 * (j))
#define XB_XGEN(j)  (2304 + 64 * (j))
#define XB_TOP      3328
#define XB_TOPGEN   3392
#define XCD_BAR_WORDS 3456
#define XB_SPIN_CAP (1u << 18)

__device__ __forceinline__ unsigned xb_ld(unsigned* p)              { return __hip_atomic_load(p, __ATOMIC_RELAXED, __HIP_MEMORY_SCOPE_AGENT); }
__device__ __forceinline__ unsigned xb_add(unsigned* p, unsigned v) { return __hip_atomic_fetch_add(p, v, __ATOMIC_RELAXED, __HIP_MEMORY_SCOPE_AGENT); }
__device__ __forceinline__ unsigned xb_xcc_id() { return (unsigned)__builtin_amdgcn_s_getreg((3 << 11) | 20) & 0xFu; }
#define XB_SPIN(cond, bar) do { unsigned _sp = 0; while (cond) { __builtin_amdgcn_s_sleep(1); \
    if ((++_sp & 255u) == 0u) { if (xb_ld(&(bar)[XB_TMO])) break; if (_sp > XB_SPIN_CAP) { atomicAdd(&(bar)[XB_TMO], 1u); break; } } } } while (0)

struct XcdBarrier {
    unsigned* bar; unsigned x;
    volatile LAS unsigned* st;
};

__device__ __forceinline__ XcdBarrier xcd_barrier_post(unsigned* bar, volatile LAS unsigned* st) {
    XcdBarrier b; b.bar = bar; b.x = xb_xcc_id(); b.st = st;
    if (threadIdx.x == 0) (void)xb_add(&bar[XB_XCNT(b.x)], 1u);
    return b;
}
__device__ __forceinline__ void xcd_barrier_complete(unsigned* bar, unsigned x, unsigned& nloc, unsigned& nx) {
    const unsigned G = gridDim.x * gridDim.y * gridDim.z;
    unsigned sum, cnt, mine, sp = 0u;
    for (;;) {
        sum = 0u; cnt = 0u; mine = 0u;
#pragma unroll
        for (unsigned j = 0; j < 16; ++j) { const unsigned c = xb_ld(&bar[XB_XCNT(j)]); sum += c; cnt += (c > 0u) ? 1u : 0u; mine = (j == x) ? c : mine; }
        if (sum == G) break;
        __builtin_amdgcn_s_sleep(1);
        if ((++sp & 255u) == 0u) { if (xb_ld(&bar[XB_TMO])) break; if (sp > XB_SPIN_CAP) { atomicAdd(&bar[XB_TMO], 1u); break; } }
    }
    nloc = mine > 0u ? mine : 1u; nx = cnt > 0u ? cnt : 1u;
}

__device__ __forceinline__ void xcd_barrier(const XcdBarrier& b) {
    asm volatile("s_waitcnt vmcnt(0)" ::: "memory");
    __syncthreads();
    if (threadIdx.x == 0) {
        unsigned* bar = b.bar;
        __builtin_amdgcn_s_waitcnt(0);
        unsigned nloc = b.st[0], nx = b.st[1];
        if (nloc == 0u) { xcd_barrier_complete(bar, b.x, nloc, nx); b.st[0] = nloc; b.st[1] = nx; }
        const unsigned old = xb_add(&bar[XB_XSUB(b.x)], 1u);
        const unsigned gen = old / nloc;
        if (old + 1u == (gen + 1u) * nloc) {
            __builtin_amdgcn_fence(__ATOMIC_RELEASE, "agent");
            asm volatile("s_waitcnt vmcnt(0)" ::: "memory");
            const unsigned og = xb_add(&bar[XB_TOP], 1u);
            const unsigned tg = og / nx;
            if (og + 1u == (tg + 1u) * nx) xb_add(&bar[XB_TOPGEN], 1u);
            else XB_SPIN(xb_ld(&bar[XB_TOPGEN]) == tg, bar);
            __builtin_amdgcn_fence(__ATOMIC_ACQUIRE, "agent");
            xb_add(&bar[XB_XGEN(b.x)], 1u);
            asm volatile("s_waitcnt vmcnt(0)" ::: "memory");
        } else {
            XB_SPIN(xb_ld(&bar[XB_XGEN(b.x)]) == gen, bar);
            __builtin_amdgcn_fence(__ATOMIC_ACQUIRE, "agent");
            asm volatile("s_waitcnt vmcnt(0)" ::: "memory");
        }
    }
    __syncthreads();
}


#if USE_REF_GEMM
#define GEMM_PHASE gemm_phase_ref
#else
#define GEMM_PHASE gemm_phase_mfma
#endif

__global__ void __launch_bounds__(NTHREADS, 2) fwd_kernel(Params p) {
    extern __shared__ __attribute__((aligned(16))) unsigned char lds[];
    unsigned char* ws = p.ws;
    const int lo = p.ph_lo, hi = p.ph_hi;
#define IN(k) (lo <= (k) && (k) < hi)
#if N_LAUNCH_MODE == 1
    volatile LAS unsigned* bst = (volatile LAS unsigned*)((LAS unsigned char*)lds + LDS_BYTES - 32);
    if (threadIdx.x < 2) bst[threadIdx.x] = 0u;
    __syncthreads();
    const XcdBarrier bar = xcd_barrier_post((unsigned*)(ws + WS_CTL + CTL_BAR), bst);
#define SEAM(k) do { if (IN(k) && IN((k) + 1)) xcd_barrier(bar); } while (0)
#else
#define SEAM(k) do { } while (0)
#endif
    if (IN(PH_PRO)) { phase_prologue(p, lds); if (PROBE_DUP & 8) { __syncthreads(); phase_prologue(p, lds); } } SEAM(PH_PRO);
    if (IN(PH_INPROJ)) {
        Gemm g{(const bf16_t*)(ws + WS_XB), (const bf16_t*)(ws + WS_WIN), DM, DM, DM};
        DenseOrder S; S.init(T, NIN, gridDim.x, blockIdx.x, DM, DM);
        EpiIn E{(bf16_t*)(ws + WS_INBUF), (bf16_t*)(ws + WS_PBUF), (const float*)(ws + WS_RSTD1)};
        GEMM_PHASE<EpiIn, DenseOrder>(lds, g, S, E);
    } SEAM(PH_INPROJ);
    if (IN(PH_L2PREP)) { phase_l2prep(p); } SEAM(PH_L2PREP);
    if (IN(PH_L2GEMM)) {
        Gemm g{(const bf16_t*)(ws + WS_A2), (const bf16_t*)(ws + WS_L2T), PW, 256, 256};
        DenseOrder S; S.init(T, 3072, gridDim.x, blockIdx.x, PW, 256, 2, 256);
        EpiL2 E{(float*)(ws + WS_WL), (bf16_t*)(ws + WS_ABUF), (bf16_t*)(ws + WS_GBUF), p.in[11], p.in[14]};
        GEMM_PHASE<EpiL2, DenseOrder>(lds, g, S, E);
    } SEAM(PH_L2GEMM);
    if (IN(PH_MIX)) {
        for (int rep = 0; rep < ((PROBE_DUP & 1) ? 2 : 1); ++rep)
        if ((blockIdx.x & 1) == 0) for (int chain = blockIdx.x >> 1; chain < BATCH * NH_RW; chain += (gridDim.x + 1) >> 1) rwkv_chain(p, lds, chain);
        attn_phase_queue(p, lds, (unsigned*)(ws + WS_CTL + CTL_QCTR));
        if (PROBE_DUP & 2) attn_phase_queue(p, lds, (unsigned*)(ws + WS_CTL + CTL_QCTR) + 1);
    } SEAM(PH_MIX);
    if (IN(PH_COMB)) { phase_combine(p); } SEAM(PH_COMB);
    if (IN(PH_OUT)) {
        Gemm g{(const bf16_t*)(ws + WS_O), (const bf16_t*)(ws + WS_WOUT), DM, DM, DM};
        DenseOrder S; S.init(T, DM, gridDim.x, blockIdx.x, DM, DM);
        EpiOut E{p.in[0], p.out, (bf16_t*)(ws + WS_HB), (float*)(ws + WS_CTL + CTL_SS2)};
        GEMM_PHASE<EpiOut, DenseOrder>(lds, g, S, E);
    } SEAM(PH_OUT);
    if (IN(PH_ROUTE)) { phase_router(p, lds); convert_experts(p, lds); if (PROBE_DUP & 16) { __syncthreads(); convert_experts(p, lds); } } SEAM(PH_ROUTE);
    if (IN(PH_G1)) {
        Gemm g{(const bf16_t*)(ws + WS_HB), (const bf16_t*)(ws + WS_WGU), DM, DM, DM};
        MoeOrder<true> S{(const unsigned*)(ws + WS_CTL + CTL_CNT), (const int*)(ws + WS_RT), 4, (int)gridDim.x, (int)blockIdx.x, 0, DM, (long)1024 * 2048, DM};
        EpiGU E{(bf16_t*)(ws + WS_HID), (const float*)(ws + WS_RSTD2)};
        GEMM_PHASE<EpiGU, MoeOrder<true>>(lds, g, S, E);
    } SEAM(PH_G1);
    if (IN(PH_G2)) {
        Gemm g{(const bf16_t*)(ws + WS_HID), (const bf16_t*)(ws + WS_WD), DEXP, DEXP, DEXP};
        MoeOrder<false> S{(const unsigned*)(ws + WS_CTL + CTL_CNT), (const int*)(ws + WS_RT), 8, (int)gridDim.x, (int)blockIdx.x, 1, DEXP, (long)2048 * 512, DEXP};
        EpiDown E{(bf16_t*)(ws + WS_YB), (const float*)(ws + WS_GATEB), (const unsigned*)(ws + WS_CTL + CTL_CNT)};
        GEMM_PHASE<EpiDown, MoeOrder<false>>(lds, g, S, E);
    } SEAM(PH_G2);
    if (IN(PH_FINAL)) { phase_final(p, lds); }
}

extern "C" void kernel_launch(void* const* d_in, const int* in_sizes, int n_in, void* d_out, int out_size, void* d_ws, size_t ws_size, hipStream_t stream) {
    static int grid = 0;
    if (grid == 0) {
        if (n_in != 33 || out_size != T * DM || ws_size < WS_END) { fprintf(stderr, "kernel_launch: unexpected problem (n_in %d out %d ws %zu)\n", n_in, out_size, ws_size); grid = -1; return; }
        int dev = 0, cus = 0;
        hipGetDevice(&dev); hipDeviceGetAttribute(&cus, hipDeviceAttributeMultiprocessorCount, dev);
        if (hipFuncSetAttribute((const void*)fwd_kernel, hipFuncAttributeMaxDynamicSharedMemorySize, LDS_BYTES) != hipSuccess) { fprintf(stderr, "kernel_launch: hipFuncSetAttribute failed\n"); grid = -1; return; }
        int per_cu = 0; hipOccupancyMaxActiveBlocksPerMultiprocessor(&per_cu, (const void*)fwd_kernel, NTHREADS, LDS_BYTES); (void)hipGetLastError();
        if (per_cu < 1) fprintf(stderr, "kernel_launch: occupancy query says %d blocks per CU\n", per_cu);
        if (per_cu < 1) { grid = -1; return; }
        grid = cus > 0 ? cus : 256;
    }
    if (grid < 0) return;
    hipMemsetAsync((char*)d_ws + WS_CTL, 0, CTL_BYTES, stream);
    Params p{};
    for (int i = 0; i < 33; ++i) p.in[i] = (const float*)d_in[i];
    p.out = (float*)d_out; p.ws = (unsigned char*)d_ws;
#if N_LAUNCH_MODE == 1
    p.ph_lo = 0; p.ph_hi = PH_COUNT;
    void* args[] = {&p};
    hipError_t e = hipLaunchCooperativeKernel((const void*)fwd_kernel, dim3(grid), dim3(NTHREADS), args, LDS_BYTES, stream);
    if (e != hipSuccess) fprintf(stderr, "cooperative launch failed: %s (grid %d)\n", hipGetErrorString(e), grid);
#else
    for (int ph = 0; ph < PH_COUNT; ++ph) { p.ph_lo = ph; p.ph_hi = ph + 1; hipLaunchKernelGGL(fwd_kernel, dim3(grid), dim3(NTHREADS), LDS_BYTES, stream, p); }
#endif
}
```

```cpp
#include <hip/hip_runtime.h>
#include <hip/hip_cooperative_groups.h>
#include <cstdio>
#include <cstdint>
namespace cg = cooperative_groups;

#ifndef N_LAUNCH_MODE
#define N_LAUNCH_MODE 1
#endif
#ifndef PROBE_DUP
#define PROBE_DUP 0
#endif
#ifndef USE_REF_ATTN
#define USE_REF_ATTN 0
#endif
#ifndef USE_REF_GEMM
#define USE_REF_GEMM 0
#endif

constexpr int BATCH = 8, SEQ = 2048, DM = 2048, T = BATCH * SEQ;
constexpr int DAW = 1024, RWW = 1024, NH_DA = 8, NH_RW = 16;
constexpr int NIN = 6912;
constexpr int PW = 768;
constexpr int NEXP = 32, DEXP = 512, CAP = T;
constexpr int MAXTILES = 160;
constexpr float C2Q = 0.125f * 1.4426950408889634f;
constexpr float LOG2E = 1.4426950408889634f;

constexpr size_t MiB = 1u << 20;
constexpr size_t WS_CTL = 0, CTL_BYTES = 1 * MiB;
constexpr size_t CTL_SS2 = 65536;
constexpr size_t CTL_CNT = 131072;
constexpr size_t CTL_QCTR = 131072 + 256;
constexpr size_t CTL_BAR = 262144;
constexpr size_t WS_WOUT = 1 * MiB;
constexpr size_t WS_L2T = 9 * MiB;
constexpr size_t WS_RSTD1 = 11 * MiB;
constexpr size_t WS_RSTD2 = 11 * MiB + 65536;
constexpr size_t WS_TOKINFO = 11 * MiB + 131072;
constexpr size_t WS_WRT = 11 * MiB + 524288;
constexpr size_t WS_WIN = 12 * MiB;
constexpr size_t WS_XB = 40 * MiB;
constexpr size_t WS_O = 40 * MiB;
constexpr size_t WS_INBUF = 104 * MiB;
constexpr size_t WS_PBUF = 296 * MiB;
constexpr size_t WS_A2 = 320 * MiB;
constexpr size_t WS_WL = 344 * MiB;
constexpr size_t WS_ABUF = 408 * MiB;
constexpr size_t WS_GBUF = 440 * MiB;
constexpr size_t WS_OPART = 472 * MiB;
constexpr size_t WS_HB = 104 * MiB;
constexpr size_t WS_WGU = 168 * MiB;
constexpr size_t WS_WD = 296 * MiB;
constexpr size_t WS_RT = 360 * MiB;
constexpr size_t WS_GATEB = 362 * MiB;
constexpr size_t WS_HID = 364 * MiB;
constexpr size_t WS_YB = 404 * MiB;
constexpr size_t WS_END = 564 * MiB;

constexpr int NTHREADS = 512, NWAVES = 8;
constexpr int LDS_BYTES = 147456;

typedef unsigned short bf16_t;
typedef short bf16x8 __attribute__((ext_vector_type(8)));
typedef float f32x4 __attribute__((ext_vector_type(4)));
typedef float f32x2 __attribute__((ext_vector_type(2)));
typedef unsigned u32x4 __attribute__((ext_vector_type(4)));
typedef unsigned u32x2 __attribute__((ext_vector_type(2)));

__device__ __forceinline__ unsigned f2bf(float f) { unsigned u = __builtin_bit_cast(unsigned, f); return (u + 0x7fffu + ((u >> 16) & 1u)) >> 16; }
__device__ __forceinline__ unsigned pk2(float lo, float hi) { return f2bf(lo) | (f2bf(hi) << 16); }
__device__ __forceinline__ float bf2f(unsigned h) { return __builtin_bit_cast(float, h << 16); }
__device__ __forceinline__ float bflo(unsigned w) { return __builtin_bit_cast(float, w << 16); }
__device__ __forceinline__ float bfhi(unsigned w) { return __builtin_bit_cast(float, w & 0xffff0000u); }
__device__ __forceinline__ float wave_sum(float v) {
#pragma unroll
    for (int o = 1; o < 64; o <<= 1) v += __shfl_xor(v, o);
    return v;
}
__device__ __forceinline__ int opaque_tid() { int t = threadIdx.x; asm volatile("" : "+v"(t)); return t; }
__device__ __forceinline__ float sigmoidf_(float x) { return 1.0f / (1.0f + __expf(-x)); }

struct Params {
    const float* in[33];
    float* out;
    unsigned char* ws;
    int ph_lo, ph_hi;
};

enum { PH_PRO = 0, PH_INPROJ, PH_L2PREP, PH_L2GEMM, PH_MIX, PH_COMB, PH_OUT, PH_ROUTE, PH_G1, PH_G2, PH_FINAL, PH_COUNT };

struct Unit { int pm, pn; long a_off, b_off; const int* gidx; int valid, e, tile, k; };
struct Gemm { const bf16_t* A; const bf16_t* Bt; int lda, ldb, K; };

struct DenseOrder {
    static constexpr bool GATHER = false;
    int nM, nN, nwg, G, c, lda, ldb, acol_shift, acol_w;
    __device__ void init(int M, int N, int G_, int c_, int lda_, int ldb_, int acol_shift_ = -1, int acol_w_ = 0) {
        nM = M / 256; nN = N / 256; nwg = nM * nN; G = G_; c = c_; lda = lda_; ldb = ldb_; acol_shift = acol_shift_; acol_w = acol_w_; }
    __device__ bool next(int i, Unit& u) const {
        const long L = (long)i * G + c; if (L >= nwg) return false;
        int wgid = (int)L; { const int q = nwg / 8, r = nwg % 8, xcd = wgid % 8, off = wgid / 8; wgid = (xcd < r ? xcd * (q + 1) : r * (q + 1) + (xcd - r) * q) + off; }
        const int nig = 8 * nN, gid = wgid / nig, fm = gid * 8, gsz = (nM - fm) < 8 ? (nM - fm) : 8;
        u.pm = fm + ((wgid % nig) % gsz); u.pn = (wgid % nig) / gsz;
        u.a_off = (long)u.pm * 256 * lda + (acol_shift >= 0 ? (long)(u.pn >> acol_shift) * acol_w : 0);
        u.b_off = (long)u.pn * 256 * ldb; u.gidx = nullptr; u.valid = 256; u.e = 0; u.tile = 0; u.k = 0; return true;
    }
};
template <bool GATHER_> struct MoeOrder {
    static constexpr bool GATHER = GATHER_;
    const unsigned* cnt; const int* rt; int ncol, G, c, mode; long a_ld, b_estride, b_ld;
    __device__ bool next(int i, Unit& u) const {
        const long L = (long)i * G + c; const int g = (int)(L / ncol), pn = (int)(L % ncol);
        int ts = 0, e = 0, k = -1, ce = 0;
        for (e = 0; e < NEXP; ++e) { ce = __builtin_amdgcn_readfirstlane((int)cnt[e]); const int nt = (ce + 255) >> 8; if (g < ts + nt) { k = g - ts; break; } ts += nt; }
        if (k < 0) return false;
        u.pm = g; u.pn = pn; u.e = e; u.tile = g; u.k = k; u.valid = (ce - 256 * k) < 256 ? (ce - 256 * k) : 256;
        if (mode == 0) { u.gidx = rt + (long)e * CAP + 256 * k; u.a_off = 0; }
        else { u.gidx = nullptr; u.a_off = (long)g * 256 * a_ld; }
        u.b_off = (long)e * b_estride + (long)pn * 256 * b_ld; return true;
    }
};

template <class Epi, class Sched>
__device__ __forceinline__ void gemm_phase_ref(unsigned char* lds, const Gemm g, const Sched& S, const Epi& E) {
    const int tid = threadIdx.x, wid = tid >> 6, lane = tid & 63, wr = wid >> 2, wc = wid & 3, fr = lane & 15, fq = lane >> 4;
    bf16_t* As = (bf16_t*)lds; bf16_t* Bs = As + 256 * 72;
    Unit u;
    for (int ui = 0; S.next(ui, u); ++ui) {
        f32x4 acc[2][2][4][2];
#pragma unroll
        for (int a = 0; a < 2; ++a)
#pragma unroll
            for (int b = 0; b < 2; ++b)
#pragma unroll
                for (int m = 0; m < 4; ++m)
#pragma unroll
                    for (int n = 0; n < 2; ++n) acc[a][b][m][n] = (f32x4){0.f, 0.f, 0.f, 0.f};
        long arow[4];
#pragma unroll
        for (int i = 0; i < 4; ++i) { const int row = (tid + 512 * i) >> 3; arow[i] = u.gidx ? (row < u.valid ? (long)u.gidx[row] : 0L) : (long)row; }
        for (int k0 = 0; k0 < g.K; k0 += 64) {
            __syncthreads();
#pragma unroll
            for (int i = 0; i < 4; ++i) { const int ch = tid + 512 * i, row = ch >> 3, c8 = ch & 7;
                const u32x4 va = *(const u32x4*)(g.A + u.a_off + arow[i] * g.lda + k0 + c8 * 8);
                const u32x4 vb = *(const u32x4*)(g.Bt + u.b_off + (long)row * g.ldb + k0 + c8 * 8);
                *(u32x4*)(As + row * 72 + c8 * 8) = va; *(u32x4*)(Bs + row * 72 + c8 * 8) = vb; }
            __syncthreads();
            for (int kk = 0; kk < 64; ++kk) {
                float a[2][4];
#pragma unroll
                for (int ai = 0; ai < 2; ++ai)
#pragma unroll
                    for (int m = 0; m < 4; ++m) a[ai][m] = bf2f(As[(ai * 128 + wr * 64 + m * 16 + fr) * 72 + kk]);
#pragma unroll
                for (int bj = 0; bj < 2; ++bj)
#pragma unroll
                    for (int n = 0; n < 2; ++n)
#pragma unroll
                        for (int e = 0; e < 4; ++e) {
                            const int cl = Epi::PERM ? (bj * 128 + wc * 32 + 8 * fq + 4 * n + e) : (bj * 128 + wc * 32 + 16 * n + 4 * fq + e);
                            const float b = bf2f(Bs[cl * 72 + kk]);
#pragma unroll
                            for (int ai = 0; ai < 2; ++ai)
#pragma unroll
                                for (int m = 0; m < 4; ++m) acc[ai][bj][m][n][e] += a[ai][m] * b;
                        }
            }
        }
        E(acc, u, wr, wc, fr, fq);
    }
    __syncthreads();
}


#define LAS __attribute__((address_space(3)))
namespace pg8 {
constexpr int BK = 64, HALF = 128, HTB = HALF * BK * 2, STAGE_BYTES = 8 * HTB;
__device__ __forceinline__ int lds_byte(int r, int c) { const int st = (r >> 4) * 2 + (c >> 5), rr = r & 15, cc = c & 31, ob = rr * 64 + cc * 2; return st * 1024 + (ob ^ (((ob >> 9) & 1) << 5)); }
__device__ __forceinline__ void stage_rc(int b, int& R, int& C) { const int st = b / 1024, sb = b % 1024, swz = sb ^ (((sb >> 9) & 1) << 5); R = (st >> 1) * 16 + swz / 64; C = (st & 1) * 32 + (swz % 64) / 2; }
__device__ __forceinline__ int perm32(int rho) { const int n = rho >> 4, i = rho & 15; return 8 * (i >> 2) + 4 * n + (i & 3); }
template <bool GATHER>
__device__ __forceinline__ void unit_voffA(const Unit& u, int lda, int tid, unsigned (&v0)[2], unsigned (&v1)[2]) {
#pragma unroll
    for (int i = 0; i < 2; ++i) { int R, C; stage_rc(tid * 16 + i * 8192, R, C); int r0 = R, r1 = R + HALF;
        if (GATHER) { const int a = (r0 < u.valid) ? u.gidx[r0] : 0, b = (r1 < u.valid) ? u.gidx[r1] : 0; r0 = a; r1 = b; }
        v0[i] = (unsigned)(r0 * lda + C) * 2u; v1[i] = (unsigned)(r1 * lda + C) * 2u; }
}
template <class Epi, class Sched, bool ALIGN_EPI = true>
__device__ __forceinline__ void gemm_phase(LAS unsigned char* lds, const Gemm g, const Sched& S, const Epi& E) {
    const int tid = threadIdx.x, wid = __builtin_amdgcn_readfirstlane(tid >> 6), lane = tid & 63, wr = wid >> 2, wc = wid & 3, fr = lane & 15, fq = lane >> 4;
    const int K = g.K, nt = K / BK;
    constexpr bool GATHER = Sched::GATHER;
    unsigned voffB[2];
#pragma unroll
    for (int i = 0; i < 2; ++i) { int R, C; stage_rc(tid * 16 + i * 8192, R, C); const int Rb = Epi::PERM ? ((R & ~31) + perm32(R & 31)) : R; voffB[i] = (unsigned)(Rb * g.ldb + C) * 2u; }
    const size_t hstepA = (size_t)HALF * g.lda * 2;
    const size_t kstep = (size_t)(BK * 2);
    const size_t hstepB = (size_t)HALF * g.ldb * 2;
    const unsigned ldsw = (unsigned)wid * 1024u;
    const int aoff = lds_byte(wr * 64 + fr, fq * 8), boff = lds_byte(wc * 32 + fr, fq * 8);
#define PG8_SA(b, h) (((b) * 2 + (h)) * HTB)
#define PG8_SB(b, h) ((4 + (b) * 2 + (h)) * HTB)
#define PG8_STAGE(bufoff, gbase, voff) do { _Pragma("unroll") for (int _i = 0; _i < 2; ++_i) \
        __builtin_amdgcn_global_load_lds((const unsigned*)((const char*)(gbase) + (voff)[_i]), (LAS unsigned*)(lds + (bufoff) + ldsw + _i * 8192), 16, 0, 0); } while (0)
#define PG8_LDA(dst, b, h) do { _Pragma("unroll") for (int m = 0; m < 4; ++m) _Pragma("unroll") for (int k = 0; k < 2; ++k) dst[m][k] = *(const LAS bf16x8*)(lds + PG8_SA(b, h) + aoff + m * 2048 + k * 1024); } while (0)
#define PG8_LDB(dst, b, h) do { _Pragma("unroll") for (int n = 0; n < 2; ++n) _Pragma("unroll") for (int k = 0; k < 2; ++k) dst[n][k] = *(const LAS bf16x8*)(lds + PG8_SB(b, h) + boff + n * 2048 + k * 1024); } while (0)
#define PG8_MMA(ai, bj, At, Bt) do { __builtin_amdgcn_s_setprio(1); _Pragma("unroll") for (int m = 0; m < 4; ++m) _Pragma("unroll") for (int n = 0; n < 2; ++n) _Pragma("unroll") for (int k = 0; k < 2; ++k) \
        acc[ai][bj][m][n] = __builtin_amdgcn_mfma_f32_16x16x32_bf16(Bt[n][k], At[m][k], acc[ai][bj][m][n], 0, 0, 0); __builtin_amdgcn_s_setprio(0); } while (0)
#define PG8_WAIT_V(n) asm volatile("s_waitcnt vmcnt(" #n ")" ::: "memory")
#define PG8_WAIT_L(n) asm volatile("s_waitcnt lgkmcnt(" #n ")" ::: "memory")
#define PG8_BAR __builtin_amdgcn_s_barrier()
#define PG8_SCHED __builtin_amdgcn_sched_barrier(0)
    Unit cur, nxt; int ui = 0;
    if (!S.next(0, cur)) return;
    f32x4 acc[2][2][4][2];
#pragma unroll
    for (int a = 0; a < 2; ++a)
#pragma unroll
        for (int b = 0; b < 2; ++b)
#pragma unroll
            for (int m = 0; m < 4; ++m)
#pragma unroll
                for (int n = 0; n < 2; ++n) acc[a][b][m][n] = (f32x4){0.f, 0.f, 0.f, 0.f};
    bf16x8 At[4][2], B0[2][2], B1[2][2];
    const char* cA = (const char*)(g.A + cur.a_off); const char* cB = (const char*)(g.Bt + cur.b_off);
    unsigned vA0[2], vA1[2], nA0[2], nA1[2];
    unit_voffA<GATHER>(cur, g.lda, tid, vA0, vA1);
#define PG8_STAGE_A(bufoff, gbase, h, sel) do { if constexpr (GATHER) { if (sel) { if ((h) == 0) PG8_STAGE(bufoff, gbase, nA0); else PG8_STAGE(bufoff, gbase, nA1); } else { if ((h) == 0) PG8_STAGE(bufoff, gbase, vA0); else PG8_STAGE(bufoff, gbase, vA1); } } \
        else { PG8_STAGE(bufoff, (gbase) + ((h) ? hstepA : (size_t)0), vA0); } } while (0)
    PG8_STAGE(PG8_SB(0, 0), cB, voffB); PG8_STAGE(PG8_SB(0, 1), cB + hstepB, voffB); PG8_STAGE_A(PG8_SA(0, 0), cA, 0, false); PG8_STAGE_A(PG8_SA(0, 1), cA, 1, false);
    if (wr == 1) PG8_BAR;
    PG8_WAIT_V(2); PG8_BAR;
    PG8_STAGE(PG8_SB(1, 0), cB + kstep, voffB); PG8_STAGE_A(PG8_SA(1, 0), cA + kstep, 0, false); PG8_STAGE(PG8_SB(1, 1), cB + hstepB + kstep, voffB);
    PG8_WAIT_V(6); PG8_BAR;
    for (;;) {
        const bool has_next = S.next(ui + 1, nxt);
        const char* nA = has_next ? (const char*)(g.A + nxt.a_off) : cA; const char* nB = has_next ? (const char*)(g.Bt + nxt.b_off) : cB;
        if constexpr (GATHER) { if (has_next) unit_voffA<true>(nxt, g.lda, tid, nA0, nA1); else { nA0[0] = vA0[0]; nA0[1] = vA0[1]; nA1[0] = vA1[0]; nA1[1] = vA1[1]; } }
        for (int t = 0; t < nt; t += 2) {
            const bool last = (t == nt - 2);
            const char* a1 = cA + (size_t)(t + 1) * kstep;
            const char* a2 = last ? nA : cA + (size_t)(t + 2) * kstep; const char* b2 = last ? nB : cB + (size_t)(t + 2) * kstep;
            const char* a3 = a2 + kstep; const char* b3 = b2 + kstep;
            PG8_LDB(B0, 0, 0); PG8_LDB(B1, 0, 1); PG8_SCHED; PG8_LDA(At, 0, 0); PG8_STAGE_A(PG8_SA(1, 1), a1, 1, false);
            PG8_WAIT_V(8); PG8_WAIT_L(0); PG8_BAR; PG8_MMA(0, 0, At, B0); PG8_MMA(0, 1, At, B1); PG8_BAR; PG8_SCHED;
            PG8_LDA(At, 0, 1); PG8_STAGE(PG8_SB(0, 0), b2, voffB); PG8_STAGE(PG8_SB(0, 1), b2 + hstepB, voffB); PG8_STAGE_A(PG8_SA(0, 0), a2, 0, last);
            PG8_WAIT_V(8); PG8_WAIT_L(0); PG8_BAR; PG8_MMA(1, 0, At, B0); PG8_MMA(1, 1, At, B1); PG8_BAR; PG8_SCHED;
            PG8_LDB(B0, 1, 0); PG8_LDB(B1, 1, 1); PG8_SCHED; PG8_LDA(At, 1, 0); PG8_STAGE_A(PG8_SA(0, 1), a2, 1, last);
            PG8_WAIT_V(8); PG8_WAIT_L(0); PG8_BAR; PG8_MMA(0, 0, At, B0); PG8_MMA(0, 1, At, B1); PG8_BAR; PG8_SCHED;
            PG8_LDA(At, 1, 1); PG8_STAGE(PG8_SB(1, 0), b3, voffB); PG8_STAGE(PG8_SB(1, 1), b3 + hstepB, voffB); PG8_STAGE_A(PG8_SA(1, 0), a3, 0, last);
            PG8_WAIT_V(8); PG8_WAIT_L(0); PG8_BAR; PG8_MMA(1, 0, At, B0); PG8_MMA(1, 1, At, B1); PG8_BAR; PG8_SCHED;
        }
        if constexpr (ALIGN_EPI) { if (wr == 0) PG8_BAR; }
        E(acc, cur, wr, wc, fr, fq);
        if (!has_next) break;
#pragma unroll
        for (int a = 0; a < 2; ++a)
#pragma unroll
            for (int b = 0; b < 2; ++b)
#pragma unroll
                for (int m = 0; m < 4; ++m)
#pragma unroll
                    for (int n = 0; n < 2; ++n) acc[a][b][m][n] = (f32x4){0.f, 0.f, 0.f, 0.f};
        cur = nxt; cA = nA; cB = nB; ++ui;
        if constexpr (GATHER) { vA0[0] = nA0[0]; vA0[1] = nA0[1]; vA1[0] = nA1[0]; vA1[1] = nA1[1]; }
        if constexpr (ALIGN_EPI) { if (wr == 1) PG8_BAR; }
    }
    PG8_WAIT_V(0);
    if constexpr (!ALIGN_EPI) { if (wr == 0) PG8_BAR; }
    PG8_BAR;
#undef PG8_SA
#undef PG8_SB
#undef PG8_STAGE
#undef PG8_STAGE_A
#undef PG8_LDA
#undef PG8_LDB
#undef PG8_MMA
#undef PG8_WAIT_V
#undef PG8_WAIT_L
#undef PG8_BAR
#undef PG8_SCHED
}
}
template <class Epi, class Sched>
__device__ __forceinline__ void gemm_phase_mfma(unsigned char* lds, const Gemm g, const Sched& S, const Epi& E) { pg8::gemm_phase<Epi, Sched, true>((LAS unsigned char*)lds, g, S, E); __syncthreads(); }

__device__ __forceinline__ u32x4 pack8(const f32x4 v0, const f32x4 v1) { u32x4 w; w.x = pk2(v0[0], v0[1]); w.y = pk2(v0[2], v0[3]); w.z = pk2(v1[0], v1[1]); w.w = pk2(v1[2], v1[3]); return w; }

struct EpiIn {
    static constexpr bool PERM = true;
    bf16_t* inbuf; bf16_t* pbuf; const float* rstd1;
    __device__ __forceinline__ void operator()(const f32x4 (&acc)[2][2][4][2], const Unit& u, int wr, int wc, int fr_, int fq_) const {
        int fr = fr_, fq = fq_; asm volatile("" : "+v"(fr), "+v"(fq));
        bf16_t* base; int ldc, colt; float sc0 = 1.f;
        if (u.pn < 24) { base = inbuf + (size_t)(u.pn >> 2) * T * 1024; ldc = 1024; colt = (u.pn & 3) * 256; if (u.pn < 4) sc0 = C2Q; }
        else { base = pbuf; ldc = PW; colt = (u.pn - 24) * 256; }
        const int row0 = u.pm * 256 + wr * 64 + fr, col0 = colt + wc * 32 + 8 * fq;
#pragma unroll
        for (int ai = 0; ai < 2; ++ai)
#pragma unroll
            for (int m = 0; m < 4; ++m) { const int row = row0 + ai * 128 + m * 16; const float rs = rstd1[row] * sc0; bf16_t* rowp = base + (size_t)row * ldc + col0;
#pragma unroll
                for (int bj = 0; bj < 2; ++bj) *(u32x4*)(rowp + bj * 128) = pack8(acc[ai][bj][m][0] * rs, acc[ai][bj][m][1] * rs); }
    }
};
struct EpiL2 {
    static constexpr bool PERM = true;
    float* wl; bf16_t* abuf; bf16_t* gbuf; const float* w0; const float* a0;
    __device__ __forceinline__ void operator()(const f32x4 (&acc)[2][2][4][2], const Unit& u, int wr, int wc, int fr_, int fq_) const {
        int fr = fr_, fq = fq_; asm volatile("" : "+v"(fr), "+v"(fq));
        const int grp = u.pn >> 2, colt = (u.pn & 3) * 256;
        const int row0 = u.pm * 256 + wr * 64 + fr, col0 = colt + wc * 32 + 8 * fq;
        if (grp == 0) {
#pragma unroll
            for (int bj = 0; bj < 2; ++bj) { const int c = col0 + bj * 128; const f32x4 b0 = *(const f32x4*)(w0 + c), b1 = *(const f32x4*)(w0 + c + 4);
#pragma unroll
                for (int ai = 0; ai < 2; ++ai)
#pragma unroll
                    for (int m = 0; m < 4; ++m) { const int row = row0 + ai * 128 + m * 16; f32x4 v0 = acc[ai][bj][m][0] + b0, v1 = acc[ai][bj][m][1] + b1;
#pragma unroll
                        for (int e = 0; e < 4; ++e) { v0[e] = -0.60653065971f * LOG2E * sigmoidf_(v0[e]); v1[e] = -0.60653065971f * LOG2E * sigmoidf_(v1[e]); }
                        float* p = wl + (size_t)row * 1024 + c; *(f32x4*)p = v0; *(f32x4*)(p + 4) = v1; asm volatile("" ::: "memory"); __builtin_amdgcn_sched_barrier(0); } }
        } else if (grp == 1) {
#pragma unroll
            for (int bj = 0; bj < 2; ++bj) { const int c = col0 + bj * 128; const f32x4 b0 = *(const f32x4*)(a0 + c), b1 = *(const f32x4*)(a0 + c + 4);
#pragma unroll
                for (int ai = 0; ai < 2; ++ai)
#pragma unroll
                    for (int m = 0; m < 4; ++m) { const int row = row0 + ai * 128 + m * 16; f32x4 v0 = acc[ai][bj][m][0] + b0, v1 = acc[ai][bj][m][1] + b1;
#pragma unroll
                        for (int e = 0; e < 4; ++e) { v0[e] = sigmoidf_(v0[e]); v1[e] = sigmoidf_(v1[e]); }
                        *(u32x4*)(abuf + (size_t)row * 1024 + c) = pack8(v0, v1); asm volatile("" ::: "memory"); __builtin_amdgcn_sched_barrier(0); } }
        } else {
#pragma unroll
            for (int bj = 0; bj < 2; ++bj) { const int c = col0 + bj * 128;
#pragma unroll
                for (int ai = 0; ai < 2; ++ai)
#pragma unroll
                    for (int m = 0; m < 4; ++m) { const int row = row0 + ai * 128 + m * 16; *(u32x4*)(gbuf + (size_t)row * 1024 + c) = pack8(acc[ai][bj][m][0], acc[ai][bj][m][1]); } }
        }
    }
};
struct EpiOut {
    static constexpr bool PERM = true;
    const float* x; float* h; bf16_t* hb; float* ss2;
    __device__ __forceinline__ void operator()(const f32x4 (&acc)[2][2][4][2], const Unit& u, int wr, int wc, int fr_, int fq_) const {
        int fr = fr_, fq = fq_; asm volatile("" : "+v"(fr), "+v"(fq));
        const int row0 = u.pm * 256 + wr * 64 + fr, col0 = u.pn * 256 + wc * 32 + 8 * fq;
#pragma unroll
        for (int ai = 0; ai < 2; ++ai)
#pragma unroll
            for (int m = 0; m < 4; ++m) { const int row = row0 + ai * 128 + m * 16; float ss = 0.f;
#pragma unroll
                for (int bj = 0; bj < 2; ++bj) { const size_t off = (size_t)row * DM + col0 + bj * 128;
                    const f32x4 x0 = *(const f32x4*)(x + off), x1 = *(const f32x4*)(x + off + 4);
                    const f32x4 v0 = acc[ai][bj][m][0] + x0, v1 = acc[ai][bj][m][1] + x1;
                    *(f32x4*)(h + off) = v0; *(f32x4*)(h + off + 4) = v1; *(u32x4*)(hb + off) = pack8(v0, v1);
                    ss += (v0[0] * v0[0] + v0[1] * v0[1]) + (v0[2] * v0[2] + v0[3] * v0[3]) + (v1[0] * v1[0] + v1[1] * v1[1]) + (v1[2] * v1[2] + v1[3] * v1[3]); }
                ss += __shfl_xor(ss, 16); ss += __shfl_xor(ss, 32);
                if (fq == 0) atomicAdd(ss2 + row, ss); }
    }
};
struct EpiGU {
    static constexpr bool PERM = true;
    bf16_t* hid; const float* rstd2;
    __device__ __forceinline__ void operator()(const f32x4 (&acc)[2][2][4][2], const Unit& u, int wr, int wc, int fr_, int fq_) const {
        int fr = fr_, fq = fq_; asm volatile("" : "+v"(fr), "+v"(fq));
        const int col0 = u.pn * 128 + wc * 32 + 8 * fq;
#pragma unroll
        for (int ai = 0; ai < 2; ++ai)
#pragma unroll
            for (int m = 0; m < 4; ++m) { const int rl = ai * 128 + wr * 64 + m * 16 + fr; const int tok = (rl < u.valid) ? u.gidx[rl] : 0; const float rs = rstd2[tok];
                f32x4 o0, o1;
#pragma unroll
                for (int e = 0; e < 4; ++e) { const float g0 = acc[ai][0][m][0][e] * rs, u0 = acc[ai][1][m][0][e] * rs, g1 = acc[ai][0][m][1][e] * rs, u1 = acc[ai][1][m][1][e] * rs;
                    o0[e] = g0 * sigmoidf_(g0) * u0; o1[e] = g1 * sigmoidf_(g1) * u1; }
                *(u32x4*)(hid + ((size_t)u.tile * 256 + rl) * DEXP + col0) = pack8(o0, o1); asm volatile("" ::: "memory"); __builtin_amdgcn_sched_barrier(0); }
    }
};
struct EpiDown {
    static constexpr bool PERM = true;
    bf16_t* yb; const float* gateb; const unsigned* cnt;
    __device__ __forceinline__ void operator()(const f32x4 (&acc)[2][2][4][2], const Unit& u, int wr, int wc, int fr_, int fq_) const {
        int fr = fr_, fq = fq_; asm volatile("" : "+v"(fr), "+v"(fq));
        const int col0 = u.pn * 256 + wc * 32 + 8 * fq;
        const int k = u.k;
#pragma unroll
        for (int ai = 0; ai < 2; ++ai)
#pragma unroll
            for (int m = 0; m < 4; ++m) { const int rl = ai * 128 + wr * 64 + m * 16 + fr; const float gt = (rl < u.valid) ? gateb[(size_t)u.e * CAP + 256 * k + rl] : 0.f;
#pragma unroll
                for (int bj = 0; bj < 2; ++bj) *(u32x4*)(yb + ((size_t)u.tile * 256 + rl) * DM + col0 + bj * 128) = pack8(acc[ai][bj][m][0] * gt, acc[ai][bj][m][1] * gt); }
    }
};

__device__ __forceinline__ void tr_item64(const float* W, int ldw, int Kvalid, int Nvalid, int k0, int n0, bf16_t* WT, int ldt, int trow0, float* scr, int lane,
                                          const float* gk, const float* mu, int mode) {
    const int c4 = lane & 15, rq = lane >> 4; const bool ncol_ok = (n0 + 4 * c4) < Nvalid;
    f32x4 v[16];
#pragma unroll
    for (int i = 0; i < 16; ++i) { const int k = k0 + 4 * i + rq; v[i] = (f32x4){0.f, 0.f, 0.f, 0.f};
        if (k < Kvalid && ncol_ok) v[i] = *(const f32x4*)(W + (size_t)k * ldw + n0 + 4 * c4); }
#pragma unroll
    for (int i = 0; i < 16; ++i) { const int kk = 4 * i + rq, k = k0 + kk; float sc = 1.f;
        if (k < Kvalid) { if (gk) sc = gk[k]; if (mode == 1) sc *= (1.f - mu[k]); else if (mode == 2) sc *= mu[k]; }
        float* d = scr + kk * 65 + 4 * c4; d[0] = v[i][0] * sc; d[1] = v[i][1] * sc; d[2] = v[i][2] * sc; d[3] = v[i][3] * sc; }
    __builtin_amdgcn_s_waitcnt(0xC07F); asm volatile("" ::: "memory");
    const int c = lane & 7;
#pragma unroll
    for (int j = 0; j < 8; ++j) { const int n = (lane >> 3) + 8 * j; const float* q = scr + (8 * c) * 65 + n;
        u32x4 o; o.x = pk2(q[0 * 65], q[1 * 65]); o.y = pk2(q[2 * 65], q[3 * 65]); o.z = pk2(q[4 * 65], q[5 * 65]); o.w = pk2(q[6 * 65], q[7 * 65]);
        if (n0 + n < Nvalid) *(u32x4*)(WT + (size_t)(trow0 + n) * ldt + k0 + 8 * c) = o; }
    __builtin_amdgcn_s_waitcnt(0xC07F); asm volatile("" ::: "memory");
}

__device__ __forceinline__ void phase_prologue(const Params& p, unsigned char* lds) {
    const int tid = opaque_tid(), lane = tid & 63, wave = tid >> 6;
    const int gw = blockIdx.x * NWAVES + wave, NGW = gridDim.x * NWAVES;
    unsigned char* ws = p.ws;
    float* scr = (float*)(lds + wave * 16640);
    bf16_t* WinT = (bf16_t*)(ws + WS_WIN); bf16_t* WoutT = (bf16_t*)(ws + WS_WOUT); bf16_t* L2T = (bf16_t*)(ws + WS_L2T);
    const float* g_mix = p.in[1]; const float* mu_x = p.in[9];
    constexpr int I_WIN = 32 * 96;
    constexpr int I_L1 = 32 * (1 + 1 + 3) * 2;
    constexpr int I_WOUT = 32 * 32;
    constexpr int I_L2 = 3 * 4 * 16;
    constexpr int NITEMS = I_WIN + I_L1 + I_WOUT + I_L2;
    for (int it = gw; it < NITEMS; it += NGW) {
        int r = it;
        if (r < I_WIN) { const int kb = r / 96, nb = r % 96; tr_item64(p.in[2], 6144, 2048, 6144, 64 * kb, 64 * nb, WinT, 2048, 64 * nb, scr, lane, g_mix, nullptr, 0); continue; } r -= I_WIN;
        if (r < I_L1) {
            const int kb = r / 10, rr = r % 10;
            int which, nb, mode;
            if (rr < 2) { which = 0; nb = 0; mode = 1 + rr; } else if (rr < 4) { which = 1; nb = 0; mode = 1 + (rr - 2); } else { which = 2; nb = (rr - 4) >> 1; mode = 1 + ((rr - 4) & 1); }
            const float* W = which == 0 ? p.in[12] : which == 1 ? p.in[15] : p.in[17];
            const int ldw = which == 2 ? 160 : 64;
            const int rowbase = 6144 + (which == 0 ? 0 : which == 1 ? 128 : 256) + (mode == 2 ? ldw : 0);
            tr_item64(W, ldw, 2048, ldw, 64 * kb, 64 * nb, WinT, 2048, rowbase + 64 * nb, scr, lane, g_mix, mu_x + which * 2048, mode); continue; } r -= I_L1;
        if (r < I_WOUT) { const int kb = r / 32, nb = r % 32; tr_item64(p.in[3], 2048, 2048, 2048, 64 * kb, 64 * nb, WoutT, 2048, 64 * nb, scr, lane, nullptr, nullptr, 0); continue; } r -= I_WOUT;
        { const int which = r / 64, rr = r % 64, kb = rr / 16, nb = rr % 16;
          const float* W = which == 0 ? p.in[13] : which == 1 ? p.in[16] : p.in[18]; const int kv = which == 2 ? 160 : 64;
          tr_item64(W, 1024, kv, 1024, 64 * kb, 64 * nb, L2T, 256, which * 1024 + 64 * nb, scr, lane, nullptr, nullptr, 0); }
    }
    for (int ch = blockIdx.x * NTHREADS + tid; ch < 192 * 256; ch += gridDim.x * NTHREADS) *(u32x4*)(WinT + (size_t)6720 * 2048 + (size_t)ch * 8) = (u32x4){0u, 0u, 0u, 0u};
    { bf16_t* whi = (bf16_t*)(ws + WS_WRT); bf16_t* wlo = whi + 48 * 2048; const float* gf = p.in[24]; const float* wg = p.in[25]; const float* we = p.in[27];
      for (int id = blockIdx.x * NTHREADS + tid; id < 48 * 2048; id += gridDim.x * NTHREADS) { const int cc = id >> 11, k = id & 2047; float w = 0.f;
          if (cc < 4) w = wg[(size_t)k * 4 + cc] * gf[k]; else if (cc < 36) w = we[(size_t)k * 32 + cc - 4] * gf[k];
          const unsigned hb = f2bf(w); const float hf = bf2f(hb); whi[id] = (bf16_t)hb; wlo[id] = (bf16_t)f2bf(w - hf); } }
    const float* x = p.in[0]; bf16_t* xb = (bf16_t*)(ws + WS_XB); float* rstd1 = (float*)(ws + WS_RSTD1);
    for (int m = gw; m < T; m += NGW) {
        const f32x4* xr = (const f32x4*)(x + (size_t)m * DM) + lane; f32x4 v[8]; float s = 0.f;
#pragma unroll
        for (int j = 0; j < 8; ++j) { v[j] = xr[64 * j]; s += (v[j][0] * v[j][0] + v[j][1] * v[j][1]) + (v[j][2] * v[j][2] + v[j][3] * v[j][3]); }
        s = wave_sum(s);
        u32x2* o = (u32x2*)(xb + (size_t)m * DM) + lane;
#pragma unroll
        for (int j = 0; j < 8; ++j) { u32x2 w; w.x = pk2(v[j][0], v[j][1]); w.y = pk2(v[j][2], v[j][3]); o[64 * j] = w; }
        if (lane == 0) rstd1[m] = 1.0f / sqrtf(s * (1.0f / DM) + 1e-6f);
    }
}

__device__ __forceinline__ void convert_experts(const Params& p, unsigned char* lds) {
    const int tid = opaque_tid(), lane = tid & 63, wave = tid >> 6;
    const int gw = blockIdx.x * NWAVES + wave, NGW = gridDim.x * NWAVES;
    float* scr = (float*)(lds + wave * 16640);
    bf16_t* Wgu = (bf16_t*)(p.ws + WS_WGU); bf16_t* Wd = (bf16_t*)(p.ws + WS_WD); const float* gf = p.in[24];
    constexpr int I_G = 32 * 32 * 8;
    constexpr int I_D = 32 * 8 * 32;
    for (int it = gw; it < 2 * I_G + I_D; it += NGW) {
        int r = it;
        if (r < 2 * I_G) { const int up = r >= I_G; if (up) r -= I_G; const int e = r / 256, rr = r % 256, kb = rr / 8, nb = rr % 8; const int n0 = 64 * nb;
            tr_item64((up ? p.in[30] : p.in[29]) + (size_t)e * 2048 * 512, 512, 2048, 512, 64 * kb, n0, Wgu + (size_t)e * 1024 * 2048, 2048, 256 * (n0 >> 7) + (n0 & 127) + (up ? 128 : 0), scr, lane, gf, nullptr, 0); continue; }
        r -= 2 * I_G;
        { const int e = r / 256, rr = r % 256, kb = rr / 32, nb = rr % 32;
          tr_item64(p.in[31] + (size_t)e * 512 * 2048, 2048, 512, 2048, 64 * kb, 64 * nb, Wd + (size_t)e * 2048 * 512, 512, 64 * nb, scr, lane, nullptr, nullptr, 0); }
    }
}

__device__ __forceinline__ void phase_l2prep(const Params& p) {
    const bf16_t* P = (const bf16_t*)(p.ws + WS_PBUF); bf16_t* A2 = (bf16_t*)(p.ws + WS_A2);
    const int nchunk = T * 96;
    const int tid = opaque_tid();
    for (int id = blockIdx.x * NTHREADS + tid; id < nchunk; id += gridDim.x * NTHREADS) {
        const int t = id / 96, ch = id % 96, gi = ch >> 5, jc = (ch & 31) * 8;
        const int width = gi == 2 ? 160 : 64, pa = gi == 0 ? 0 : gi == 1 ? 128 : 256, pb = pa + width;
        u32x4 o = (u32x4){0u, 0u, 0u, 0u};
        if (jc < width) {
            const u32x4 va = *(const u32x4*)(P + (size_t)t * PW + pa + jc);
            u32x4 vb = (u32x4){0u, 0u, 0u, 0u};
            if ((t & (SEQ - 1)) != 0) vb = *(const u32x4*)(P + (size_t)(t - 1) * PW + pb + jc);
            float f[8];
#pragma unroll
            for (int i = 0; i < 4; ++i) { f[2 * i] = bflo(va[i]) + bflo(vb[i]); f[2 * i + 1] = bfhi(va[i]) + bfhi(vb[i]); }
#pragma unroll
            for (int i = 0; i < 8; ++i) { if (gi == 0) f[i] = 1.0f - 2.0f / (__expf(2.0f * f[i]) + 1.0f); else if (gi == 2) f[i] = sigmoidf_(f[i]); }
            o.x = pk2(f[0], f[1]); o.y = pk2(f[2], f[3]); o.z = pk2(f[4], f[5]); o.w = pk2(f[6], f[7]);
        }
        *(u32x4*)(A2 + (size_t)t * PW + ch * 8) = o;
    }
}

constexpr int TC = 16;
constexpr int SCAN_VEC_FLOATS = 6 * TC * 64 + 2 * TC;
constexpr int SCAN_OFF_YS = 2 * SCAN_VEC_FLOATS;
constexpr int SCAN_OFF_GB = SCAN_OFF_YS + 2 * TC * 64;
constexpr int SCAN_LDS_FLOATS = SCAN_OFF_GB + 4 * TC * 64;
#define DPP_F(v, ctrl) __builtin_bit_cast(float, __builtin_amdgcn_update_dpp(0, __builtin_bit_cast(int, (v)), (ctrl), 0xF, 0xF, true))
__device__ __forceinline__ float red8(float v) {
    v += DPP_F(v, 0xB1);
    v += DPP_F(v, 0x4E);
    v += DPP_F(v, 0x141);
    return v;
}
__device__ __forceinline__ float wave_sum_fast(float v) {
    v = red8(v);
    v += DPP_F(v, 0x140);
    v += __builtin_bit_cast(float, __builtin_amdgcn_update_dpp(0, __builtin_bit_cast(int, v), 0x142, 0xa, 0xf, false));
    v += __builtin_bit_cast(float, __builtin_amdgcn_update_dpp(0, __builtin_bit_cast(int, v), 0x143, 0xc, 0xf, false));
    return __builtin_bit_cast(float, __builtin_amdgcn_readlane(__builtin_bit_cast(int, v), 63));
}
__device__ __forceinline__ f32x2 lo2(const f32x4 x) { return (f32x2){x[0], x[1]}; }
__device__ __forceinline__ f32x2 hi2(const f32x4 x) { return (f32x2){x[2], x[3]}; }
__device__ __forceinline__ void rwkv_chain(const Params& p, unsigned char* lds, int chain) {
    const int tid = opaque_tid(), lane = tid & 63, wave = __builtin_amdgcn_readfirstlane(tid >> 6);
    const int b = chain >> 4, h = chain & 15;
    float* L = (float*)lds;
    constexpr int NC = SEQ / TC;
    if (wave < 4) {
        const int r8 = lane >> 3, q = lane & 7, iA = 16 * wave + r8, iB = iA + 8;
        f32x2 SA[4], SB[4];
#pragma unroll
        for (int e = 0; e < 4; ++e) { SA[e] = (f32x2){0.f, 0.f}; SB[e] = (f32x2){0.f, 0.f}; }
        __syncthreads();
        for (int ci = 0; ci < NC; ++ci) {
            const float* V0 = L + (ci & 1) * SCAN_VEC_FLOATS;
            float* Ys = L + SCAN_OFF_YS + (ci & 1) * TC * 64;
            const float* KKs = V0 + 8 * q; const float* Ws = V0 + TC * 64 + 8 * q; const float* Bs = V0 + 2 * TC * 64 + 8 * q; const float* Ks = V0 + 3 * TC * 64 + 8 * q;
            const float* WRs = V0 + 4 * TC * 64 + 8 * q; const float* Vs = V0 + 5 * TC * 64; const float* SC = V0 + 6 * TC * 64;
            f32x4 kk0 = *(const f32x4*)(KKs), kk1 = *(const f32x4*)(KKs + 4), w0 = *(const f32x4*)(Ws), w1 = *(const f32x4*)(Ws + 4);
            f32x4 b0 = *(const f32x4*)(Bs), b1 = *(const f32x4*)(Bs + 4), k0 = *(const f32x4*)(Ks), k1 = *(const f32x4*)(Ks + 4);
            f32x4 x0 = *(const f32x4*)(WRs), x1 = *(const f32x4*)(WRs + 4); float vA = Vs[iA], vB = Vs[iB]; f32x2 sc = *(const f32x2*)(SC);
#pragma unroll 2
            for (int tl = 0; tl < TC; ++tl) {
                const int tn = (tl + 1 < TC) ? tl + 1 : tl;
                const f32x4 nkk0 = *(const f32x4*)(KKs + tn * 64), nkk1 = *(const f32x4*)(KKs + tn * 64 + 4), nw0 = *(const f32x4*)(Ws + tn * 64), nw1 = *(const f32x4*)(Ws + tn * 64 + 4);
                const f32x4 nb0 = *(const f32x4*)(Bs + tn * 64), nb1 = *(const f32x4*)(Bs + tn * 64 + 4), nk0 = *(const f32x4*)(Ks + tn * 64), nk1 = *(const f32x4*)(Ks + tn * 64 + 4);
                const f32x4 nx0 = *(const f32x4*)(WRs + tn * 64), nx1 = *(const f32x4*)(WRs + tn * 64 + 4); const float nvA = Vs[tn * 64 + iA], nvB = Vs[tn * 64 + iB]; const f32x2 nsc = *(const f32x2*)(SC + 2 * tn);
                f32x2 t0 = SA[0] * lo2(kk0) + SA[1] * hi2(kk0); t0 += SA[2] * lo2(kk1) + SA[3] * hi2(kk1);
                f32x2 t1 = SB[0] * lo2(kk0) + SB[1] * hi2(kk0); t1 += SB[2] * lo2(kk1) + SB[3] * hi2(kk1);
                f32x2 t2 = SA[0] * lo2(x0) + SA[1] * hi2(x0); t2 += SA[2] * lo2(x1) + SA[3] * hi2(x1);
                f32x2 t3 = SB[0] * lo2(x0) + SB[1] * hi2(x0); t3 += SB[2] * lo2(x1) + SB[3] * hi2(x1);
                float saA = t0[0] + t0[1], saB = t1[0] + t1[1], pA = t2[0] + t2[1], pB = t3[0] + t3[1];
                saA += DPP_F(saA, 0xB1); saB += DPP_F(saB, 0xB1); pA += DPP_F(pA, 0xB1); pB += DPP_F(pB, 0xB1);
                saA += DPP_F(saA, 0x4E); saB += DPP_F(saB, 0x4E); pA += DPP_F(pA, 0x4E); pB += DPP_F(pB, 0x4E);
                saA += DPP_F(saA, 0x141); saB += DPP_F(saB, 0x141); pA += DPP_F(pA, 0x141); pB += DPP_F(pB, 0x141);
                const float yA = pA + (saA * sc[0] + vA * sc[1]), yB = pB + (saB * sc[0] + vB * sc[1]);
                if (q == 0) { Ys[tl * 64 + iA] = yA; Ys[tl * 64 + iB] = yB; }
                const f32x2 sA2 = (f32x2){saA, saA}, sB2 = (f32x2){saB, saB}, vA2 = (f32x2){vA, vA}, vB2 = (f32x2){vB, vB};
                SA[0] = SA[0] * lo2(w0) + (sA2 * lo2(b0) + vA2 * lo2(k0)); SA[1] = SA[1] * hi2(w0) + (sA2 * hi2(b0) + vA2 * hi2(k0));
                SA[2] = SA[2] * lo2(w1) + (sA2 * lo2(b1) + vA2 * lo2(k1)); SA[3] = SA[3] * hi2(w1) + (sA2 * hi2(b1) + vA2 * hi2(k1));
                SB[0] = SB[0] * lo2(w0) + (sB2 * lo2(b0) + vB2 * lo2(k0)); SB[1] = SB[1] * hi2(w0) + (sB2 * hi2(b0) + vB2 * hi2(k0));
                SB[2] = SB[2] * lo2(w1) + (sB2 * lo2(b1) + vB2 * lo2(k1)); SB[3] = SB[3] * hi2(w1) + (sB2 * hi2(b1) + vB2 * hi2(k1));
                kk0 = nkk0; kk1 = nkk1; w0 = nw0; w1 = nw1; b0 = nb0; b1 = nb1; k0 = nk0; k1 = nk1; x0 = nx0; x1 = nx1; vA = nvA; vB = nvB; sc = nsc;
            }
            __syncthreads();
        }
    } else {
        const int aw = wave - 4, c = h * 64 + lane;
        constexpr int SPW = TC / 4;
        const bf16_t* rb = (const bf16_t*)(p.ws + WS_INBUF) + (size_t)3 * T * 1024; const bf16_t* kb = rb + (size_t)T * 1024; const bf16_t* vb = kb + (size_t)T * 1024;
        const float* wl = (const float*)(p.ws + WS_WL); const bf16_t* ab = (const bf16_t*)(p.ws + WS_ABUF); const bf16_t* gb = (const bf16_t*)(p.ws + WS_GBUF);
        bf16_t* O = (bf16_t*)(p.ws + WS_O);
        const float mu_r = p.in[10][c], mu_k = p.in[10][1024 + c], mu_v = p.in[10][2048 + c];
        const float k_k = p.in[19][c], k_a = p.in[20][c], r_k = p.in[21][c], ln_w = p.in[22][c], ln_b = p.in[23][c];
        float rc[SPW + 1], kc[SPW + 1], vc[SPW + 1], rwl[SPW], ra[SPW], rg[SPW];
#define SCAN_LOAD(ci_) do { const int tb_ = (ci_) * TC + aw * SPW; const size_t m0_ = (size_t)b * SEQ + tb_; \
        _Pragma("unroll") for (int s_ = 0; s_ < SPW + 1; ++s_) { const bool ok_ = (tb_ + s_ - 1) >= 0; const size_t off_ = (m0_ + s_ - 1) * 1024 + c; \
            rc[s_] = ok_ ? bf2f(rb[off_]) : 0.f; kc[s_] = ok_ ? bf2f(kb[off_]) : 0.f; vc[s_] = ok_ ? bf2f(vb[off_]) : 0.f; } \
        _Pragma("unroll") for (int s_ = 0; s_ < SPW; ++s_) { const size_t off_ = (m0_ + s_) * 1024 + c; rwl[s_] = wl[off_]; ra[s_] = bf2f(ab[off_]); rg[s_] = bf2f(gb[off_]); } } while (0)
#define SCAN_PREP(ci_) do { float* V0_ = L + ((ci_) & 1) * SCAN_VEC_FLOATS; float* GB_ = L + SCAN_OFF_GB + ((ci_) & 1) * 2 * TC * 64; \
        _Pragma("unroll") for (int s_ = 0; s_ < SPW; ++s_) { const int tl_ = aw * SPW + s_; \
            const float rr_ = rc[s_ + 1] + (rc[s_] - rc[s_ + 1]) * mu_r, kx_ = kc[s_ + 1] + (kc[s_] - kc[s_ + 1]) * mu_k, vv_ = vc[s_ + 1] + (vc[s_] - vc[s_ + 1]) * mu_v; \
            const float w_ = __builtin_amdgcn_exp2f(rwl[s_]), a_ = ra[s_]; \
            const float kkv_ = kx_ * k_k; const float n2_ = wave_sum_fast(kkv_ * kkv_); const float kkn_ = kkv_ * __builtin_amdgcn_rsqf(fmaxf(n2_, 1e-24f)); \
            const float kmod_ = kx_ * (1.0f + (a_ - 1.0f) * k_a); const float bb_ = kkn_ * a_; \
            const float bon_ = wave_sum_fast(rr_ * kmod_ * r_k), br_ = wave_sum_fast(bb_ * rr_), kr_ = wave_sum_fast(kmod_ * rr_); \
            V0_[tl_ * 64 + lane] = -kkn_; V0_[TC * 64 + tl_ * 64 + lane] = w_; V0_[2 * TC * 64 + tl_ * 64 + lane] = bb_; V0_[3 * TC * 64 + tl_ * 64 + lane] = kmod_; \
            V0_[4 * TC * 64 + tl_ * 64 + lane] = w_ * rr_; V0_[5 * TC * 64 + tl_ * 64 + lane] = vv_; if (lane == 0) { V0_[6 * TC * 64 + 2 * tl_] = br_; V0_[6 * TC * 64 + 2 * tl_ + 1] = kr_; } \
            GB_[tl_ * 64 + lane] = rg[s_]; GB_[TC * 64 + tl_ * 64 + lane] = bon_ * vv_ * rg[s_]; } } while (0)
#define SCAN_POST(ci_) do { const float* Ys_ = L + SCAN_OFF_YS + ((ci_) & 1) * TC * 64; const float* GB_ = L + SCAN_OFF_GB + ((ci_) & 1) * 2 * TC * 64; \
        _Pragma("unroll") for (int s_ = 0; s_ < SPW; ++s_) { const int tl_ = aw * SPW + s_; const size_t m_ = (size_t)b * SEQ + (ci_) * TC + tl_; \
            const float y_ = Ys_[tl_ * 64 + lane]; const float mean_ = wave_sum_fast(y_) * (1.0f / 64.0f); const float d_ = y_ - mean_; const float var_ = wave_sum_fast(d_ * d_) * (1.0f / 64.0f); \
            const float yn_ = d_ * __builtin_amdgcn_rsqf(var_ + 64e-5f) * ln_w + ln_b; \
            O[m_ * DM + 1024 + c] = (bf16_t)f2bf(yn_ * GB_[tl_ * 64 + lane] + GB_[TC * 64 + tl_ * 64 + lane]); } } while (0)
        SCAN_LOAD(0); SCAN_PREP(0); SCAN_LOAD(1);
        __syncthreads();
        for (int ci = 0; ci < NC; ++ci) {
            if (ci >= 1) SCAN_POST(ci - 1);
            if (ci + 1 < NC) { SCAN_PREP(ci + 1); if (ci + 2 < NC) SCAN_LOAD(ci + 2); }
            __syncthreads();
        }
        SCAN_POST(NC - 1);
#undef SCAN_LOAD
#undef SCAN_PREP
#undef SCAN_POST
    }
    __syncthreads();
}

#include <hip/hip_bf16.h>
#include <cmath>
namespace attn_body {
using bf16=__hip_bfloat16;
using bf16x8=__attribute__((ext_vector_type(8)))short;
using s16x4=__attribute__((ext_vector_type(4)))short;
using f32x16=__attribute__((ext_vector_type(16)))float;
using u32x4=__attribute__((ext_vector_type(4)))unsigned;
constexpr int SEQ=2048,D=64,DM=1024;
constexpr int NW=8,QBLK=32,QB=QBLK*NW,KVBLK=64,NQB=SEQ/QB;
__device__ __forceinline__ int crow(int r,int hi){return (r&3)+8*(r>>2)+4*hi;}
#define SBAR() __builtin_amdgcn_sched_barrier(0)
__device__ __forceinline__ void cmask(f32x16&p0,f32x16&p1,int jb,int qrel,int hi){
  const float NEG=-INFINITY; int kb=64*jb+4*hi;
  #pragma unroll
  for(int r=0;r<16;++r){int kv=kb+(r&3)+8*(r>>2); if(kv>qrel)p0[r]=NEG; if(kv+32>qrel)p1[r]=NEG;}
}

constexpr int NSLOT=3, SLOTB=8192;
constexpr int LDS_K=0, LDS_V=NSLOT*SLOTB, LDS_WS=2*NSLOT*SLOTB, LDS_OST=LDS_WS+NW*64*4, LDS_BYTES=LDS_OST+NW*4096;
constexpr float C2=0.125f*1.4426950408889634f;
__device__ __forceinline__ void glds16(const void*gsrc,unsigned lds_dst){unsigned keep;
  asm volatile("s_mov_b32 %0, m0\n\ts_mov_b32 m0, %2\n\ts_nop 0\n\tglobal_load_lds_dwordx4 %1, off\n\ts_mov_b32 m0, %0":"=&s"(keep):"v"(gsrc),"s"(lds_dst):"memory");}
__device__ __forceinline__ float max3f(float a,float b,float c){float r;asm("v_max3_f32 %0, %1, %2, %3":"=v"(r):"v"(a),"v"(b),"v"(c));return r;}
__device__ __forceinline__ float max2f(float a,float b){float r;asm("v_max_f32_e32 %0, %1, %2":"=v"(r):"v"(a),"v"(b));return r;}
__device__ __forceinline__ float fadd_s(float a,float b){float r;asm("v_add_f32_e32 %0, %1, %2":"=v"(r):"v"(a),"v"(b));return r;}
__device__ __forceinline__ float fsub_s(float a,float b){float r;asm("v_sub_f32_e32 %0, %1, %2":"=v"(r):"v"(a),"v"(b));return r;}
typedef float f32x2_t __attribute__((ext_vector_type(2))); typedef __bf16 bf16x2_t __attribute__((ext_vector_type(2)));
__device__ __forceinline__ unsigned cvtpk_s(float lo,float hi){f32x2_t v={lo,hi};bf16x2_t b=__builtin_convertvector(v,bf16x2_t);return __builtin_bit_cast(unsigned,b);}
#define WAIT_BAR(N) asm volatile("s_waitcnt vmcnt(" #N ") lgkmcnt(0)\n\ts_barrier":::"memory")

__device__ __forceinline__ void qkt(f32x16&p0,f32x16&p1,const char*Kslot,const bf16x8*qr,const f32x16&negm,int r32,int hi){
  const char*kb=Kslot+hi*1024+r32*16;
  #pragma unroll
  for(int d0=0;d0<4;++d0){
    const bf16x8 b0=*reinterpret_cast<const bf16x8*>(kb+d0*2048);
    const bf16x8 b1=*reinterpret_cast<const bf16x8*>(kb+d0*2048+512);
    if(d0==0){p0=__builtin_amdgcn_mfma_f32_32x32x16_bf16(b0,qr[0],negm,0,0,0);p1=__builtin_amdgcn_mfma_f32_32x32x16_bf16(b1,qr[0],negm,0,0,0);}
    else{p0=__builtin_amdgcn_mfma_f32_32x32x16_bf16(b0,qr[d0],p0,0,0,0);p1=__builtin_amdgcn_mfma_f32_32x32x16_bf16(b1,qr[d0],p1,0,0,0);}}
}
typedef __attribute__((address_space(3))) const char* lds_cptr;
typedef short v4i16_t __attribute__((ext_vector_type(4)));
__device__ __forceinline__ void kload8(bf16x8*kf,lds_cptr kp){
  kf[0]=*(const __attribute__((address_space(3))) bf16x8*)(kp);      kf[1]=*(const __attribute__((address_space(3))) bf16x8*)(kp+512);
  kf[2]=*(const __attribute__((address_space(3))) bf16x8*)(kp+2048); kf[3]=*(const __attribute__((address_space(3))) bf16x8*)(kp+2560);
  kf[4]=*(const __attribute__((address_space(3))) bf16x8*)(kp+4096); kf[5]=*(const __attribute__((address_space(3))) bf16x8*)(kp+4608);
  kf[6]=*(const __attribute__((address_space(3))) bf16x8*)(kp+6144); kf[7]=*(const __attribute__((address_space(3))) bf16x8*)(kp+6656);
}
__device__ __forceinline__ void kload2(bf16x8*kf,lds_cptr kp,int j){ kf[2*j]=*(const __attribute__((address_space(3))) bf16x8*)(kp+j*2048); kf[2*j+1]=*(const __attribute__((address_space(3))) bf16x8*)(kp+j*2048+512); }
__device__ __forceinline__ s16x4 vtr(lds_cptr p){ return __builtin_bit_cast(s16x4,__builtin_amdgcn_ds_read_tr16_b64_v4i16((__attribute__((address_space(3))) v4i16_t*)p)); }
__device__ __forceinline__ float rowmax(const f32x16&p0,const f32x16&p1){
  float a=max3f(p0[0],p0[1],p1[0]),b=max3f(p0[2],p0[3],p1[1]);a=max3f(a,p1[2],p1[3]);
  #pragma unroll
  for(int r=4;r<16;r+=4){a=max3f(a,p0[r],p0[r+1]);b=max3f(b,p0[r+2],p0[r+3]);a=max3f(a,p1[r],p1[r+1]);b=max3f(b,p1[r+2],p1[r+3]);}
  const float m=max2f(a,b);
  auto rr=__builtin_amdgcn_permlane32_swap(__float_as_uint(m),__float_as_uint(m),false,false);
  return max2f(__uint_as_float(rr[0]),__uint_as_float(rr[1]));
}
__device__ __forceinline__ void pv(f32x16*o,int vb,bf16x8 pa0,bf16x8 pa1,bf16x8 pa2,bf16x8 pa3){
  #pragma unroll
  for(int d0=0;d0<2;++d0){s16x4 lo[4],hi[4];
    #pragma unroll
    for(int ks=0;ks<4;++ks){
      asm volatile("ds_read_b64_tr_b16 %0,%1 offset:%c2":"=&v"(lo[ks]):"v"(vb),"i"(d0*4096+ks*1024):"memory");
      asm volatile("ds_read_b64_tr_b16 %0,%1 offset:%c2":"=&v"(hi[ks]):"v"(vb),"i"(d0*4096+ks*1024+512):"memory");}
    asm volatile("s_waitcnt lgkmcnt(0)":::"memory");SBAR();
    #define PK(k) (bf16x8){lo[k][0],lo[k][1],lo[k][2],lo[k][3],hi[k][0],hi[k][1],hi[k][2],hi[k][3]}
    o[d0]=__builtin_amdgcn_mfma_f32_32x32x16_bf16(pa0,PK(0),o[d0],0,0,0);
    o[d0]=__builtin_amdgcn_mfma_f32_32x32x16_bf16(pa1,PK(1),o[d0],0,0,0);
    o[d0]=__builtin_amdgcn_mfma_f32_32x32x16_bf16(pa2,PK(2),o[d0],0,0,0);
    o[d0]=__builtin_amdgcn_mfma_f32_32x32x16_bf16(pa3,PK(3),o[d0],0,0,0);
    #undef PK
  }
}

#ifndef ATTN_STORE16
#define ATTN_STORE16(p,v) (*(u32x4*)(p)=(v))
#endif
template<int THRL> __device__ __forceinline__ void attn_unit(int b,int qkcol,int vcol,int qb,float slope2,const bf16*Q,const bf16*__restrict__ K,const bf16*__restrict__ V,bf16*O,char*shm){
  const int tid=opaque_tid(),lane=tid&63,r32=lane&31,hi=lane>>5; const int wid=__builtin_amdgcn_readfirstlane(tid>>6);
  const long rowbase=(long)b*SEQ; const int q0=qb*QB;
  const bf16*Qw=Q+(rowbase+q0+wid*QBLK)*DM+qkcol;
  const bf16*Kh=K+rowbase*DM+qkcol,*Vh=V+rowbase*DM+vcol;
  const unsigned lds0=(unsigned)(uintptr_t)shm;
  float*wsf=(float*)(shm+LDS_WS)+wid*64;
  const bf16*ksrc=Kh+(long)lane*DM+wid*8;
  const bf16*vsrc=Vh+(long)(16*(wid&3)+(lane>>2))*DM+(wid>>2)*32+(lane&3)*8;
  const unsigned kdst=lds0+LDS_K+wid*1024, vdst=lds0+LDS_V+wid*1024;
  #define DMA_K(t,slot) glds16(ksrc+(long)(t)*KVBLK*DM,(unsigned)__builtin_amdgcn_readfirstlane(kdst+(slot)))
  #define DMA_V(t,slot) glds16(vsrc+(long)(t)*KVBLK*DM,(unsigned)__builtin_amdgcn_readfirstlane(vdst+(slot)))
  const int vb0=(int)(lds0+LDS_V)+((lane>>4)&1)*32+(lane&3)*8+(4*hi+((lane&15)>>2))*64;
  const char*Kbase=shm+LDS_K; bf16x8 kf[8];
  const lds_cptr shm3=(lds_cptr)shm; const lds_cptr kp0=shm3+LDS_K+hi*1024+r32*16; const lds_cptr vp0=shm3+LDS_V+((lane>>4)&1)*32+(lane&3)*8+(4*hi+((lane&15)>>2))*64;
  const int NT=(q0+QB)/KVBLK;
  DMA_K(0,0);DMA_V(0,0);DMA_K(1,SLOTB);
  bf16x8 qr[4];
  #pragma unroll
  for(int d0=0;d0<4;++d0)qr[d0]=*reinterpret_cast<const bf16x8*>(&Qw[(long)r32*DM+d0*16+hi*8]);
  float mhat=0.f,l_reg=0.f;f32x16 o[2];o[0]=f32x16{};o[1]=f32x16{};const f32x16 negm=f32x16{};
  const int qrel=wid*QBLK+r32; float slope2v=slope2; asm volatile("":"+v"(slope2v));
  #define CMASK(P0,P1,t) do{int jb_=(t)-(NT-4); if(jb_>=0)cmask(P0,P1,jb_,qrel,hi);}while(0)
  #define ABIAS(P0,P1,t) do{ float kb_=slope2*(float)(64*(t)+4*hi)-mhat; asm volatile("":"+v"(kb_)); _Pragma("unroll") for(int r=0;r<16;++r){ P0[r]+=kb_; P1[r]+=kb_; } _Pragma("unroll") for(int r=0;r<16;++r){ const float cr_=(float)((r&3)+8*(r>>2)); P0[r]=__builtin_fmaf(slope2v,cr_,P0[r]); P1[r]=__builtin_fmaf(slope2v,cr_+32.f,P1[r]); } }while(0)
  bool resc=false;
  #define START(P0,P1) do{ const float rm=rowmax(P0,P1); resc=false; \
    { const float dl=rm; mhat=fadd_s(mhat,dl); \
      _Pragma("unroll") for(int r=0;r<16;++r){P0[r]=fsub_s(P0[r],dl);P1[r]=fsub_s(P1[r],dl);} \
      } \
    _Pragma("unroll") for(int r=0;r<16;++r)P0[r]=__builtin_amdgcn_exp2f(P0[r]); }while(0)
  #define RESC() do{ if(resc){ asm volatile("s_waitcnt lgkmcnt(0)":::"memory"); \
      _Pragma("unroll") for(int d_=0;d_<2;++d_) _Pragma("unroll") for(int r=0;r<16;++r)o[d_][r]*=wsf[crow(r,hi)]; } }while(0)
  f32x16 pA0,pA1,pB0,pB1;
  int sl_prev=0,sl_cur=0,sl_next=SLOTB;
  #define ROT() do{sl_prev=sl_cur;sl_cur=sl_next;sl_next=(sl_next==(NSLOT-1)*SLOTB)?0:sl_next+SLOTB;}while(0)
  DMA_K(2,2*SLOTB);
  WAIT_BAR(3);
  qkt(pA0,pA1,Kbase,qr,negm,r32,hi);asm volatile("s_nop 15\n\ts_nop 7":"+v"(pA0),"+v"(pA1));ABIAS(pA0,pA1,0);CMASK(pA0,pA1,0);
  START(pA0,pA1);
  _Pragma("unroll") for(int r=0;r<16;++r)pA1[r]=__builtin_amdgcn_exp2f(pA1[r]);
  WAIT_BAR(0);
  DMA_K(3,0);DMA_V(1,SLOTB);
  ROT();
  kload8(kf,kp0+sl_cur);
  WAIT_BAR(2);
  s16x4 vlo[8],vhi[8]; u32x4 pw0,pw1,pw2,pw3;
  #define PKW(P,B) cvtpk_s(P[B],P[B+1])
  #define PAF(k) __builtin_bit_cast(bf16x8,pw##k)
  #define VFR(i) (bf16x8){vlo[i][0],vlo[i][1],vlo[i][2],vlo[i][3],vhi[i][0],vhi[i][1],vhi[i][2],vhi[i][3]}
  #define PIN(x) asm volatile("":"+v"(x))
  #define MX3(a,b,c) __builtin_fmaxf(__builtin_fmaxf((a),(b)),(c))
  #define GAPA(MF,A0,A1,A2,A3,W0,W1,PW) do{ MF; sacc+=A0; sacc+=A1; sacc+=A2; sacc+=A3; PIN(sacc); W0; W1; PIN(PW); SBAR(); }while(0)
  #define EX(v) __builtin_amdgcn_exp2f(v)
  #define GAPB(MF,X,B) do{ MF; X[B]=EX(X[B]); X[B+1]=EX(X[B+1]); X[B+2]=EX(X[B+2]); X[B+3]=EX(X[B+3]); PIN(X); SBAR(); }while(0)
  #define VRD(i) do{ vlo[i]=vtr(vp_+(((i)>>2)*4096+((i)&3)*1024)); vhi[i]=vtr(vp_+(((i)>>2)*4096+((i)&3)*1024+512)); }while(0)
  #define KRD(G,j) do{ if(G){ kload2(kf,kp0+sl_next,j); SBAR(); } }while(0)
  #define STEP(C0,C1,P0,P1,t,GK,GV,GL) do{ SBAR(); \
    const lds_cptr vp_=vp0+sl_prev; \
    VRD(0); SBAR(); float sacc=(P0[0]+P0[1]); \
    GAPA(C0=__builtin_amdgcn_mfma_f32_32x32x16_bf16(kf[0],qr[0],negm,0,0,0), P0[2],P0[3],P0[4],P0[5],     pw0[0]=PKW(P0,0), pw0[1]=PKW(P0,2), pw0); \
    VRD(4); SBAR(); GAPA(C1=__builtin_amdgcn_mfma_f32_32x32x16_bf16(kf[1],qr[0],negm,0,0,0), P0[6],P0[7],P0[8],P0[9],     pw0[2]=PKW(P0,4), pw0[3]=PKW(P0,6), pw0); \
    VRD(1); SBAR(); GAPA(C0=__builtin_amdgcn_mfma_f32_32x32x16_bf16(kf[2],qr[1],C0,0,0,0),   P0[10],P0[11],P0[12],P0[13], pw1[0]=PKW(P0,8), pw1[1]=PKW(P0,10), pw1); \
    VRD(5); SBAR(); GAPA(C1=__builtin_amdgcn_mfma_f32_32x32x16_bf16(kf[3],qr[1],C1,0,0,0),   P0[14],P0[15],P1[0],P1[1],   pw1[2]=PKW(P0,12),pw1[3]=PKW(P0,14), pw1); \
    VRD(2); SBAR(); GAPA(C0=__builtin_amdgcn_mfma_f32_32x32x16_bf16(kf[4],qr[2],C0,0,0,0),   P1[2],P1[3],P1[4],P1[5],     pw2[0]=PKW(P1,0), pw2[1]=PKW(P1,2), pw2); \
    VRD(6); SBAR(); GAPA(C1=__builtin_amdgcn_mfma_f32_32x32x16_bf16(kf[5],qr[2],C1,0,0,0),   P1[6],P1[7],P1[8],P1[9],     pw2[2]=PKW(P1,4), pw2[3]=PKW(P1,6), pw2); \
    VRD(3); SBAR(); GAPA(C0=__builtin_amdgcn_mfma_f32_32x32x16_bf16(kf[6],qr[3],C0,0,0,0),   P1[10],P1[11],P1[12],P1[13], pw3[0]=PKW(P1,8), pw3[1]=PKW(P1,10), pw3); \
    VRD(7); SBAR(); GAPA(C1=__builtin_amdgcn_mfma_f32_32x32x16_bf16(kf[7],qr[3],C1,0,0,0),   P1[14],P1[15],0.f,0.f,       pw3[2]=PKW(P1,12),pw3[3]=PKW(P1,14), pw3); \
    l_reg+=sacc; \
    if(GK){DMA_K((t)+3,sl_cur);} if(GV){DMA_V((t)+1,sl_next);} \
    ABIAS(C0,C1,t); CMASK(C0,C1,t); \
    { float a=MX3(C0[0],C0[1],C1[0]),b=MX3(C0[2],C0[3],C1[1]); a=MX3(a,C1[2],C1[3]); \
      _Pragma("unroll") for(int r=4;r<16;r+=4){a=MX3(a,C0[r],C0[r+1]);b=MX3(b,C0[r+2],C0[r+3]);a=MX3(a,C1[r],C1[r+1]);b=MX3(b,C1[r+2],C1[r+3]);} \
      float rm=__builtin_fmaxf(a,b); { auto rr=__builtin_amdgcn_permlane32_swap(__float_as_uint(rm),__float_as_uint(rm),false,false); rm=__builtin_fmaxf(__uint_as_float(rr[0]),__uint_as_float(rr[1])); } \
      resc=false; \
      if(__builtin_expect(__any(rm>(float)THRL),0)){ const float dl=__builtin_fmaxf(rm,0.f); mhat+=dl; \
        _Pragma("unroll") for(int r=0;r<16;++r){C0[r]-=dl;C1[r]-=dl;} \
        const float f=__builtin_amdgcn_exp2f(-dl); l_reg*=f; if(hi==0)wsf[r32]=f; resc=true; } } \
    SBAR(); \
    GAPB(o[0]=__builtin_amdgcn_mfma_f32_32x32x16_bf16(PAF(0),VFR(0),o[0],0,0,0), C0,0); \
    GAPB(o[1]=__builtin_amdgcn_mfma_f32_32x32x16_bf16(PAF(0),VFR(4),o[1],0,0,0), C0,4); \
    KRD(GL,0); GAPB(o[0]=__builtin_amdgcn_mfma_f32_32x32x16_bf16(PAF(1),VFR(1),o[0],0,0,0), C0,8); \
    KRD(GL,1); GAPB(o[1]=__builtin_amdgcn_mfma_f32_32x32x16_bf16(PAF(1),VFR(5),o[1],0,0,0), C0,12); \
    KRD(GL,2); GAPB(o[0]=__builtin_amdgcn_mfma_f32_32x32x16_bf16(PAF(2),VFR(2),o[0],0,0,0), C1,0); \
    KRD(GL,3); GAPB(o[1]=__builtin_amdgcn_mfma_f32_32x32x16_bf16(PAF(2),VFR(6),o[1],0,0,0), C1,4); \
    GAPB(o[0]=__builtin_amdgcn_mfma_f32_32x32x16_bf16(PAF(3),VFR(3),o[0],0,0,0), C1,8); \
    GAPB(o[1]=__builtin_amdgcn_mfma_f32_32x32x16_bf16(PAF(3),VFR(7),o[1],0,0,0), C1,12); \
    }while(0)
  int t=1;
  #undef CMASK
  #define CMASK(P0,P1,t) do{}while(0)
  for(;t+5<NT;t+=2){
    STEP(pB0,pB1,pA0,pA1,t,true,true,true);     WAIT_BAR(2); RESC(); ROT();
    STEP(pA0,pA1,pB0,pB1,t+1,true,true,true);   WAIT_BAR(2); RESC(); ROT();
  }
  #undef CMASK
  #define CMASK(P0,P1,t) do{int jb_=(t)-(NT-4); if(jb_>=0)cmask(P0,P1,jb_,qrel,hi);}while(0)
  #define ENDW(tt) do{ if((tt)+3<NT){WAIT_BAR(2);} else if((tt)+2<NT){WAIT_BAR(1);} else {WAIT_BAR(0);} }while(0)
  for(;t+1<NT;t+=2){
    STEP(pB0,pB1,pA0,pA1,t,(t+3<NT),(t+1<NT),(t+1<NT));       ENDW(t);   RESC(); ROT();
    STEP(pA0,pA1,pB0,pB1,t+1,(t+4<NT),(t+2<NT),(t+2<NT));     ENDW(t+1); RESC(); ROT();
  }
  STEP(pB0,pB1,pA0,pA1,NT-1,false,false,false); RESC();
  { float sacc=pB0[0]+pB0[1]; _Pragma("unroll") for(int r=2;r<16;++r)sacc+=pB0[r]; _Pragma("unroll") for(int r=0;r<16;++r)sacc+=pB1[r]; l_reg+=sacc;
    pw0=(u32x4){PKW(pB0,0),PKW(pB0,2),PKW(pB0,4),PKW(pB0,6)};pw1=(u32x4){PKW(pB0,8),PKW(pB0,10),PKW(pB0,12),PKW(pB0,14)};pw2=(u32x4){PKW(pB1,0),PKW(pB1,2),PKW(pB1,4),PKW(pB1,6)};pw3=(u32x4){PKW(pB1,8),PKW(pB1,10),PKW(pB1,12),PKW(pB1,14)};
    SBAR(); pv(o,vb0+sl_cur,PAF(0),PAF(1),PAF(2),PAF(3)); }
  #undef PKW
  #undef PAF
  #undef VFR
  #undef PIN
  #undef MX3
  #undef GAPA
  #undef GAPB
  #undef EX
  #undef VRD
  #undef KRD
  #undef STEP
  #undef ENDW
  {auto rr=__builtin_amdgcn_permlane32_swap(__float_as_uint(l_reg),__float_as_uint(l_reg),false,false);l_reg=__uint_as_float(rr[0])+__uint_as_float(rr[1]);}
  int lane_e=lane; asm volatile("":"+v"(lane_e)); const int r32e=lane_e&31, hie=lane_e>>5;
  if(hie==0)wsf[32+r32e]=l_reg;asm volatile("s_waitcnt lgkmcnt(0)":::"memory");
  float rli[16];
  #pragma unroll
  for(int r=0;r<16;++r)rli[r]=__builtin_amdgcn_rcpf(wsf[32+crow(r,hie)]);
  bf16*Ow=O+(rowbase+q0+wid*QBLK)*DM+vcol;
  { bf16*stg=(bf16*)(shm+LDS_OST)+wid*2048;
    #pragma unroll
    for(int r=0;r<16;++r){const int orow=crow(r,hie);
      #pragma unroll
      for(int d0=0;d0<2;++d0)stg[orow*64+d0*32+r32e]=__float2bfloat16(o[d0][r]*rli[r]);}
    asm volatile("s_waitcnt lgkmcnt(0)":::"memory");
    #pragma unroll
    for(int i=0;i<4;++i){const int row=i*8+(lane_e>>3),ch=lane_e&7; const u32x4 v=*(const u32x4*)(stg+row*64+ch*8); ATTN_STORE16(Ow+(long)row*DM+ch*8,v);} }
  asm volatile("s_waitcnt lgkmcnt(0)\n\ts_barrier":::"memory");
  #undef DMA_K
  #undef DMA_V
  #undef CMASK
  #undef ABIAS
  #undef START
  #undef RESC
  #undef ROT
}
constexpr int ATTN_LDS_BYTES=LDS_BYTES;
#undef SBAR
#undef WAIT_BAR
}

__device__ __forceinline__ void attn_unit_ref(const Params& p, unsigned char* lds, int b, int h, int comp, int qb) {
    const int tid = opaque_tid(), row = tid & 255, dh = tid >> 8;
    float* Kt = (float*)lds; float* Vt = Kt + 64 * 64;
    const bf16_t* qbuf = (const bf16_t*)(p.ws + WS_INBUF); const bf16_t* kbuf = qbuf + (size_t)T * 1024; const bf16_t* vbuf = kbuf + (size_t)T * 1024;
    bf16_t* Op = (bf16_t*)(p.ws + WS_OPART) + (size_t)comp * T * 1024;
    const size_t rowbase = (size_t)b * SEQ; const int qpos = qb * 256 + row;
    float qv[64], o[64];
    { const bf16_t* qp = qbuf + (rowbase + qpos) * 1024 + h * 128 + comp * 64;
#pragma unroll
      for (int d = 0; d < 64; d += 8) { const u32x4 w = *(const u32x4*)(qp + d);
#pragma unroll
          for (int i = 0; i < 4; ++i) { qv[d + 2 * i] = bflo(w[i]); qv[d + 2 * i + 1] = bfhi(w[i]); } } }
#pragma unroll
    for (int d = 0; d < 64; ++d) o[d] = 0.f;
    float mrun = -1e30f, l = 0.f;
    const float slope2 = exp2f(-(float)(h + 1)) * LOG2E;
    const int ntile = (qb + 1) * 4;
    for (int kt = 0; kt < ntile; ++kt) {
        __syncthreads();
        for (int ch = tid; ch < 1536; ch += NTHREADS) { const int r = ch / 24, cc = ch % 24; const size_t grow = rowbase + kt * 64 + r;
            if (cc < 8) { const u32x4 w = *(const u32x4*)(kbuf + grow * 1024 + h * 128 + comp * 64 + cc * 8);
#pragma unroll
                for (int i = 0; i < 4; ++i) { Kt[r * 64 + cc * 8 + 2 * i] = bflo(w[i]); Kt[r * 64 + cc * 8 + 2 * i + 1] = bfhi(w[i]); } }
            else { const int c2 = cc - 8; const u32x4 w = *(const u32x4*)(vbuf + grow * 1024 + h * 128 + c2 * 8);
#pragma unroll
                for (int i = 0; i < 4; ++i) { Vt[r * 128 + c2 * 8 + 2 * i] = bflo(w[i]); Vt[r * 128 + c2 * 8 + 2 * i + 1] = bfhi(w[i]); } } }
        __syncthreads();
        for (int j = 0; j < 64; ++j) {
            const int kpos = kt * 64 + j; if (kpos > qpos) break;
            float s = 0.f;
#pragma unroll
            for (int d = 0; d < 64; d += 4) { const f32x4 kv = *(const f32x4*)(Kt + j * 64 + d); s += qv[d] * kv[0] + qv[d + 1] * kv[1] + qv[d + 2] * kv[2] + qv[d + 3] * kv[3]; }
            s += slope2 * (float)kpos;
            if (s > mrun) { const float f = exp2f(mrun - s); l *= f;
#pragma unroll
                for (int d = 0; d < 64; ++d) o[d] *= f;
                mrun = s; }
            const float pr = exp2f(s - mrun); l += pr;
#pragma unroll
            for (int d = 0; d < 64; d += 4) { const f32x4 vv = *(const f32x4*)(Vt + j * 128 + dh * 64 + d); o[d] += pr * vv[0]; o[d + 1] += pr * vv[1]; o[d + 2] += pr * vv[2]; o[d + 3] += pr * vv[3]; }
        }
    }
    const float il = 1.0f / l;
    bf16_t* op = Op + (rowbase + qpos) * 1024 + h * 128 + dh * 64;
#pragma unroll
    for (int d = 0; d < 64; d += 8) { u32x4 w; w.x = pk2(o[d] * il, o[d + 1] * il); w.y = pk2(o[d + 2] * il, o[d + 3] * il); w.z = pk2(o[d + 4] * il, o[d + 5] * il); w.w = pk2(o[d + 6] * il, o[d + 7] * il); *(u32x4*)(op + d) = w; }
    __syncthreads();
}

__device__ __forceinline__ void attn_phase_queue(const Params& p, unsigned char* lds, unsigned* qctr) {
    const attn_body::bf16* Q = (const attn_body::bf16*)(p.ws + WS_INBUF); const attn_body::bf16* K = Q + (size_t)T * 1024; const attn_body::bf16* V = K + (size_t)T * 1024;
    attn_body::bf16* OP = (attn_body::bf16*)(p.ws + WS_OPART);
    volatile int* slot = (volatile int*)(lds + LDS_BYTES - 64);
    for (;;) {
        __syncthreads();
        if (threadIdx.x == 0) *slot = (int)atomicAdd(qctr, 1u);
        __syncthreads();
        const int u = __builtin_amdgcn_readfirstlane(*slot);
        if (u >= 2048) break;
        const int qb = 7 - (u >> 8), id = u & 255;
        const int vh = id & 1, comp = (id >> 1) & 1, h = (id >> 2) & 7, b = id >> 5;
        const float slope2 = exp2f(-(float)(h + 1)) * LOG2E;
        attn_body::attn_unit<8>(b, h * 128 + comp * 64, h * 128 + vh * 64, qb, slope2, Q, K, V, OP + (size_t)comp * T * 1024, (char*)lds);
    }
}

__device__ __forceinline__ void phase_combine(const Params& p) {
    const int tid = opaque_tid(), lane = tid & 63, wave = tid >> 6;
    const int gw = blockIdx.x * NWAVES + wave, NGW = gridDim.x * NWAVES;
    const float s1 = wave_sum(p.in[4][lane] * p.in[5][lane]), s2 = wave_sum(p.in[6][lane] * p.in[7][lane]);
    const float lam = __expf(s1) - __expf(s2) + 0.2f;
    const bf16_t* O0 = (const bf16_t*)(p.ws + WS_OPART); const bf16_t* O1 = O0 + (size_t)T * 1024; bf16_t* O = (bf16_t*)(p.ws + WS_O);
    const float* sg = p.in[8] + (lane & 7) * 16;
    for (int m = gw; m < T; m += NGW) {
        const u32x4 a0 = *(const u32x4*)(O0 + (size_t)m * 1024 + lane * 16), a1 = *(const u32x4*)(O0 + (size_t)m * 1024 + lane * 16 + 8);
        const u32x4 c0 = *(const u32x4*)(O1 + (size_t)m * 1024 + lane * 16), c1 = *(const u32x4*)(O1 + (size_t)m * 1024 + lane * 16 + 8);
        float d[16]; float ss = 0.f;
#pragma unroll
        for (int i = 0; i < 4; ++i) { d[2 * i] = bflo(a0[i]) - lam * bflo(c0[i]); d[2 * i + 1] = bfhi(a0[i]) - lam * bfhi(c0[i]); d[8 + 2 * i] = bflo(a1[i]) - lam * bflo(c1[i]); d[8 + 2 * i + 1] = bfhi(a1[i]) - lam * bfhi(c1[i]); }
#pragma unroll
        for (int i = 0; i < 16; ++i) ss += d[i] * d[i];
        ss += __shfl_xor(ss, 1); ss += __shfl_xor(ss, 2); ss += __shfl_xor(ss, 4);
        const float rs = 0.8f / sqrtf(ss * (1.0f / 128.0f) + 1e-6f);
        u32x4 w0, w1;
        w0.x = pk2(d[0] * rs * sg[0], d[1] * rs * sg[1]); w0.y = pk2(d[2] * rs * sg[2], d[3] * rs * sg[3]); w0.z = pk2(d[4] * rs * sg[4], d[5] * rs * sg[5]); w0.w = pk2(d[6] * rs * sg[6], d[7] * rs * sg[7]);
        w1.x = pk2(d[8] * rs * sg[8], d[9] * rs * sg[9]); w1.y = pk2(d[10] * rs * sg[10], d[11] * rs * sg[11]); w1.z = pk2(d[12] * rs * sg[12], d[13] * rs * sg[13]); w1.w = pk2(d[14] * rs * sg[14], d[15] * rs * sg[15]);
        *(u32x4*)(O + (size_t)m * DM + lane * 16) = w0; *(u32x4*)(O + (size_t)m * DM + lane * 16 + 8) = w1;
    }
}

typedef __bf16 bf16x2_n __attribute__((ext_vector_type(2)));
__device__ __forceinline__ unsigned cvt_pk_bf16_(float lo, float hi) { const f32x2 v = {lo, hi}; const bf16x2_n b = __builtin_convertvector(v, bf16x2_n); return __builtin_bit_cast(unsigned, b); }
__device__ __forceinline__ void phase_router(const Params& p, unsigned char* lds, bool dry = false) {
    const int tid = opaque_tid(), lane = tid & 63, wave = tid >> 6, fr = lane & 15, fq = lane >> 4;
    float* part = (float*)lds;
    const float* h = p.out;
    const bf16_t* whi = (const bf16_t*)(p.ws + WS_WRT); const bf16_t* wlo = whi + 48 * 2048;
    const float* ss2 = (const float*)(p.ws + WS_CTL + CTL_SS2); float* rstd2 = (float*)(p.ws + WS_RSTD2);
    unsigned* cnt = (unsigned*)(p.ws + WS_CTL + CTL_CNT); int* rt = (int*)(p.ws + WS_RT); float* gateb = (float*)(p.ws + WS_GATEB); int* tokinfo = (int*)(p.ws + WS_TOKINFO);
    const int mt = wave & 3, kh = wave >> 2;
    for (int tb = blockIdx.x; tb < T / 64; tb += gridDim.x) {
        const int tok0 = tb * 64;
        const float* hrow = h + (size_t)(tok0 + mt * 16 + fr) * DM + kh * 1024 + fq * 8;
        const bf16_t* bh = whi + (size_t)fr * DM + kh * 1024 + fq * 8; const bf16_t* bl = wlo + (size_t)fr * DM + kh * 1024 + fq * 8;
        f32x4 acc[3];
#pragma unroll
        for (int i = 0; i < 3; ++i) acc[i] = (f32x4){0.f, 0.f, 0.f, 0.f};
#pragma unroll 4
        for (int ks = 0; ks < 32; ++ks) {
            const f32x4 x0 = *(const f32x4*)(hrow + ks * 32), x1 = *(const f32x4*)(hrow + ks * 32 + 4);
            u32x4 ah, al;
            ah.x = cvt_pk_bf16_(x0[0], x0[1]); ah.y = cvt_pk_bf16_(x0[2], x0[3]); ah.z = cvt_pk_bf16_(x1[0], x1[1]); ah.w = cvt_pk_bf16_(x1[2], x1[3]);
            al.x = cvt_pk_bf16_(x0[0] - bflo(ah.x), x0[1] - bfhi(ah.x)); al.y = cvt_pk_bf16_(x0[2] - bflo(ah.y), x0[3] - bfhi(ah.y));
            al.z = cvt_pk_bf16_(x1[0] - bflo(ah.z), x1[1] - bfhi(ah.z)); al.w = cvt_pk_bf16_(x1[2] - bflo(ah.w), x1[3] - bfhi(ah.w));
            const bf16x8 ahi = __builtin_bit_cast(bf16x8, ah), alo = __builtin_bit_cast(bf16x8, al);
#pragma unroll
            for (int nt = 0; nt < 3; ++nt) {
                const bf16x8 bhi = *(const bf16x8*)(bh + (size_t)nt * 16 * DM + ks * 32), blo = *(const bf16x8*)(bl + (size_t)nt * 16 * DM + ks * 32);
                acc[nt] = __builtin_amdgcn_mfma_f32_16x16x32_bf16(ahi, bhi, acc[nt], 0, 0, 0);
                acc[nt] = __builtin_amdgcn_mfma_f32_16x16x32_bf16(alo, bhi, acc[nt], 0, 0, 0);
                acc[nt] = __builtin_amdgcn_mfma_f32_16x16x32_bf16(ahi, blo, acc[nt], 0, 0, 0);
            }
        }
#pragma unroll
        for (int nt = 0; nt < 3; ++nt)
#pragma unroll
            for (int r = 0; r < 4; ++r) part[(kh * 64 + mt * 16 + fq * 4 + r) * 48 + nt * 16 + fr] = acc[nt][r];
        __syncthreads();
        if (tid < 64 && !dry) {
            const float* l0 = part + tid * 48; const float* l1 = part + (64 + tid) * 48;
            const int t = tok0 + tid; const float rs = 1.0f / sqrtf(ss2[t] * (1.0f / DM) + 1e-6f); rstd2[t] = rs;
            float g4[4]; int grp = 0; float gmax = -3.0e38f;
#pragma unroll
            for (int i = 0; i < 4; ++i) { g4[i] = (l0[i] + l1[i]) * rs + p.in[26][i]; if (g4[i] > gmax) { gmax = g4[i]; grp = i; } }
            float gs = 0.f;
#pragma unroll
            for (int i = 0; i < 4; ++i) gs += __expf(g4[i] - gmax);
            const float pg = 1.0f / gs;
            float e8[8]; int i0 = 0; float m0 = -3.0e38f;
#pragma unroll
            for (int i = 0; i < 8; ++i) { e8[i] = (l0[4 + grp * 8 + i] + l1[4 + grp * 8 + i]) * rs + p.in[28][grp * 8 + i]; if (e8[i] > m0) { m0 = e8[i]; i0 = i; } }
            int i1 = 0; float m1 = -3.0e38f;
#pragma unroll
            for (int i = 0; i < 8; ++i) if (i != i0 && e8[i] > m1) { m1 = e8[i]; i1 = i; }
            const float p1 = __expf(m1 - m0); const float g0 = pg / (1.0f + p1), g1 = pg * p1 / (1.0f + p1);
            const int e0 = grp * 8 + i0, e1 = grp * 8 + i1;
            const unsigned r0 = atomicAdd(cnt + e0, 1u), r1 = atomicAdd(cnt + e1, 1u);
            rt[(size_t)e0 * CAP + r0] = t; rt[(size_t)e1 * CAP + r1] = t; gateb[(size_t)e0 * CAP + r0] = g0; gateb[(size_t)e1 * CAP + r1] = g1;
            int4 ti; ti.x = e0 * CAP + (int)r0; ti.y = e1 * CAP + (int)r1; ti.z = 0; ti.w = 0; *(int4*)(tokinfo + (size_t)t * 4) = ti;
        }
        __syncthreads();
    }
}

__device__ __forceinline__ void phase_final(const Params& p, unsigned char* lds) {
    const int tid = opaque_tid(), lane = tid & 63, wave = tid >> 6;
    const int gw = blockIdx.x * NWAVES + wave, NGW = gridDim.x * NWAVES;
    int* pst = (int*)lds;
    const unsigned* cnt = (const unsigned*)(p.ws + WS_CTL + CTL_CNT);
    if (tid == 0) { int ts = 0; for (int e = 0; e < NEXP; ++e) { pst[e] = ts; ts += ((int)cnt[e] + 255) >> 8; } }
    __syncthreads();
    const int* tokinfo = (const int*)(p.ws + WS_TOKINFO); const bf16_t* yb = (const bf16_t*)(p.ws + WS_YB); const float* gfin = p.in[32]; float* out = p.out;
    for (int m = gw; m < T; m += NGW) {
        const int4 ti = *(const int4*)(tokinfo + (size_t)m * 4);
        const int e0 = ti.x / CAP, r0 = ti.x % CAP, e1 = ti.y / CAP, r1 = ti.y % CAP;
        const size_t s0 = (size_t)pst[e0] * 256 + r0, s1 = (size_t)pst[e1] * 256 + r1;
        f32x4* hr = (f32x4*)(out + (size_t)m * DM) + lane; const u32x2* y0 = (const u32x2*)(yb + s0 * DM) + lane; const u32x2* y1 = (const u32x2*)(yb + s1 * DM) + lane;
        f32x4 v[8]; float s = 0.f;
#pragma unroll
        for (int j = 0; j < 8; ++j) { v[j] = hr[64 * j]; const u32x2 a = y0[64 * j], b2 = y1[64 * j];
            v[j][0] += bflo(a.x) + bflo(b2.x); v[j][1] += bfhi(a.x) + bfhi(b2.x); v[j][2] += bflo(a.y) + bflo(b2.y); v[j][3] += bfhi(a.y) + bfhi(b2.y);
            s += (v[j][0] * v[j][0] + v[j][1] * v[j][1]) + (v[j][2] * v[j][2] + v[j][3] * v[j][3]); }
        s = wave_sum(s); const float rs = 1.0f / sqrtf(s * (1.0f / DM) + 1e-6f);
#pragma unroll
        for (int j = 0; j < 8; ++j) { const f32x4 gv = *((const f32x4*)gfin + lane + 64 * j); hr[64 * j] = v[j] * rs * gv; }
    }
}

#define GAS __attribute__((address_space(1)))
typedef GAS unsigned gu32;
#define RLX_AGENT __ATOMIC_RELAXED, __HIP_MEMORY_SCOPE_AGENT
#define XB_TMO      128
#define XB_XCNT(j)  (256  + 64 * (j))
#define XB_XSUB(j)  (1280 + 64 * (j))
#define XB_XGEN(j)  (2304 + 64 * (j))
#define XB_TOP      3328
#define XB_TOPGEN   3392
#define XCD_BAR_WORDS 3456
#define XB_SPIN_CAP (1u << 18)

__device__ __forceinline__ unsigned xb_ld(unsigned* p)              { return __hip_atomic_load(p, __ATOMIC_RELAXED, __HIP_MEMORY_SCOPE_AGENT); }
__device__ __forceinline__ unsigned xb_add(unsigned* p, unsigned v) { return __hip_atomic_fetch_add(p, v, __ATOMIC_RELAXED, __HIP_MEMORY_SCOPE_AGENT); }
__device__ __forceinline__ unsigned xb_xcc_id() { return (unsigned)__builtin_amdgcn_s_getreg((3 << 11) | 20) & 0xFu; }
#define XB_SPIN(cond, bar) do { unsigned _sp = 0; while (cond) { __builtin_amdgcn_s_sleep(1); \
    if ((++_sp & 255u) == 0u) { if (xb_ld(&(bar)[XB_TMO])) break; if (_sp > XB_SPIN_CAP) { atomicAdd(&(bar)[XB_TMO], 1u); break; } } } } while (0)

struct XcdBarrier {
    unsigned* bar; unsigned x;
    volatile LAS unsigned* st;
};

__device__ __forceinline__ XcdBarrier xcd_barrier_post(unsigned* bar, volatile LAS unsigned* st) {
    XcdBarrier b; b.bar = bar; b.x = xb_xcc_id(); b.st = st;
    if (threadIdx.x == 0) (void)xb_add(&bar[XB_XCNT(b.x)], 1u);
    return b;
}
__device__ __forceinline__ void xcd_barrier_complete(unsigned* bar, unsigned x, unsigned& nloc, unsigned& nx) {
    const unsigned G = gridDim.x * gridDim.y * gridDim.z;
    unsigned sum, cnt, mine, sp = 0u;
    for (;;) {
        sum = 0u; cnt = 0u; mine = 0u;
#pragma unroll
        for (unsigned j = 0; j < 16; ++j) { const unsigned c = xb_ld(&bar[XB_XCNT(j)]); sum += c; cnt += (c > 0u) ? 1u : 0u; mine = (j == x) ? c : mine; }
        if (sum == G) break;
        __builtin_amdgcn_s_sleep(1);
        if ((++sp & 255u) == 0u) { if (xb_ld(&bar[XB_TMO])) break; if (sp > XB_SPIN_CAP) { atomicAdd(&bar[XB_TMO], 1u); break; } }
    }
    nloc = mine > 0u ? mine : 1u; nx = cnt > 0u ? cnt : 1u;
}

__device__ __forceinline__ void xcd_barrier(const XcdBarrier& b) {
    asm volatile("s_waitcnt vmcnt(0)" ::: "memory");
    __syncthreads();
    if (threadIdx.x == 0) {
        unsigned* bar = b.bar;
        __builtin_amdgcn_s_waitcnt(0);
        unsigned nloc = b.st[0], nx = b.st[1];
        if (nloc == 0u) { xcd_barrier_complete(bar, b.x, nloc, nx); b.st[0] = nloc; b.st[1] = nx; }
        const unsigned old = xb_add(&bar[XB_XSUB(b.x)], 1u);
        const unsigned gen = old / nloc;
        if (old + 1u == (gen + 1u) * nloc) {
            __builtin_amdgcn_fence(__ATOMIC_RELEASE, "agent");
            asm volatile("s_waitcnt vmcnt(0)" ::: "memory");
            const unsigned og = xb_add(&bar[XB_TOP], 1u);
            const unsigned tg = og / nx;
            if (og + 1u == (tg + 1u) * nx) xb_add(&bar[XB_TOPGEN], 1u);
            else XB_SPIN(xb_ld(&bar[XB_TOPGEN]) == tg, bar);
            __builtin_amdgcn_fence(__ATOMIC_ACQUIRE, "agent");
            xb_add(&bar[XB_XGEN(b.x)], 1u);
            asm volatile("s_waitcnt vmcnt(0)" ::: "memory");
        } else {
            XB_SPIN(xb_ld(&bar[XB_XGEN(b.x)]) == gen, bar);
            __builtin_amdgcn_fence(__ATOMIC_ACQUIRE, "agent");
            asm volatile("s_waitcnt vmcnt(0)" ::: "memory");
        }
    }
    __syncthreads();
}


#if USE_REF_GEMM
#define GEMM_PHASE gemm_phase_ref
#else
#define GEMM_PHASE gemm_phase_mfma
#endif

__global__ void __launch_bounds__(NTHREADS, 2) fwd_kernel(Params p) {
    extern __shared__ __attribute__((aligned(16))) unsigned char lds[];
    unsigned char* ws = p.ws;
    const int lo = p.ph_lo, hi = p.ph_hi;
#define IN(k) (lo <= (k) && (k) < hi)
#if N_LAUNCH_MODE == 1
    volatile LAS unsigned* bst = (volatile LAS unsigned*)((LAS unsigned char*)lds + LDS_BYTES - 32);
    if (threadIdx.x < 2) bst[threadIdx.x] = 0u;
    __syncthreads();
    const XcdBarrier bar = xcd_barrier_post((unsigned*)(ws + WS_CTL + CTL_BAR), bst);
#define SEAM(k) do { if (IN(k) && IN((k) + 1)) xcd_barrier(bar); } while (0)
#else
#define SEAM(k) do { } while (0)
#endif
    if (IN(PH_PRO)) { phase_prologue(p, lds); if (PROBE_DUP & 8) { __syncthreads(); phase_prologue(p, lds); } } SEAM(PH_PRO);
    if (IN(PH_INPROJ)) {
        Gemm g{(const bf16_t*)(ws + WS_XB), (const bf16_t*)(ws + WS_WIN), DM, DM, DM};
        DenseOrder S; S.init(T, NIN, gridDim.x, blockIdx.x, DM, DM);
        EpiIn E{(bf16_t*)(ws + WS_INBUF), (bf16_t*)(ws + WS_PBUF), (const float*)(ws + WS_RSTD1)};
        GEMM_PHASE<EpiIn, DenseOrder>(lds, g, S, E);
        if (PROBE_DUP & 64) GEMM_PHASE<EpiIn, DenseOrder>(lds, g, S, E);
    } SEAM(PH_INPROJ);
    if (IN(PH_L2PREP)) { phase_l2prep(p); if (PROBE_DUP & 4096) { phase_l2prep(p); phase_l2prep(p); phase_l2prep(p); } } SEAM(PH_L2PREP);
    if (IN(PH_L2GEMM)) {
        Gemm g{(const bf16_t*)(ws + WS_A2), (const bf16_t*)(ws + WS_L2T), PW, 256, 256};
        DenseOrder S; S.init(T, 3072, gridDim.x, blockIdx.x, PW, 256, 2, 256);
        EpiL2 E{(float*)(ws + WS_WL), (bf16_t*)(ws + WS_ABUF), (bf16_t*)(ws + WS_GBUF), p.in[11], p.in[14]};
        GEMM_PHASE<EpiL2, DenseOrder>(lds, g, S, E);
    } SEAM(PH_L2GEMM);
    if (IN(PH_MIX)) {
        for (int rep = 0; rep < ((PROBE_DUP & 1) ? 2 : 1); ++rep)
        if ((blockIdx.x & 1) == 0) for (int chain = blockIdx.x >> 1; chain < BATCH * NH_RW; chain += (gridDim.x + 1) >> 1) rwkv_chain(p, lds, chain);
        attn_phase_queue(p, lds, (unsigned*)(ws + WS_CTL + CTL_QCTR));
        if (PROBE_DUP & 2) attn_phase_queue(p, lds, (unsigned*)(ws + WS_CTL + CTL_QCTR) + 1);
    } SEAM(PH_MIX);
    if (IN(PH_COMB)) { phase_combine(p); if (PROBE_DUP & 2048) { phase_combine(p); phase_combine(p); phase_combine(p); } } SEAM(PH_COMB);
    if (IN(PH_OUT)) {
        Gemm g{(const bf16_t*)(ws + WS_O), (const bf16_t*)(ws + WS_WOUT), DM, DM, DM};
        DenseOrder S; S.init(T, DM, gridDim.x, blockIdx.x, DM, DM);
        EpiOut E{p.in[0], p.out, (bf16_t*)(ws + WS_HB), (float*)(ws + WS_CTL + CTL_SS2)};
        GEMM_PHASE<EpiOut, DenseOrder>(lds, g, S, E);
    } SEAM(PH_OUT);
    if (IN(PH_ROUTE)) { if (PROBE_DUP & 1024) { phase_router(p, lds, true); __syncthreads(); } phase_router(p, lds); convert_experts(p, lds); if (PROBE_DUP & 16) { __syncthreads(); convert_experts(p, lds); } } SEAM(PH_ROUTE);
    if (IN(PH_G1)) {
        Gemm g{(const bf16_t*)(ws + WS_HB), (const bf16_t*)(ws + WS_WGU), DM, DM, DM};
        MoeOrder<true> S{(const unsigned*)(ws + WS_CTL + CTL_CNT), (const int*)(ws + WS_RT), 4, (int)gridDim.x, (int)blockIdx.x, 0, DM, (long)1024 * 2048, DM};
        EpiGU E{(bf16_t*)(ws + WS_HID), (const float*)(ws + WS_RSTD2)};
        GEMM_PHASE<EpiGU, MoeOrder<true>>(lds, g, S, E);
        if (PROBE_DUP & 128) GEMM_PHASE<EpiGU, MoeOrder<true>>(lds, g, S, E);
    } SEAM(PH_G1);
    if (IN(PH_G2)) {
        Gemm g{(const bf16_t*)(ws + WS_HID), (const bf16_t*)(ws + WS_WD), DEXP, DEXP, DEXP};
        MoeOrder<false> S{(const unsigned*)(ws + WS_CTL + CTL_CNT), (const int*)(ws + WS_RT), 8, (int)gridDim.x, (int)blockIdx.x, 1, DEXP, (long)2048 * 512, DEXP};
        EpiDown E{(bf16_t*)(ws + WS_YB), (const float*)(ws + WS_GATEB), (const unsigned*)(ws + WS_CTL + CTL_CNT)};
        GEMM_PHASE<EpiDown, MoeOrder<false>>(lds, g, S, E);
        if (PROBE_DUP & 256) GEMM_PHASE<EpiDown, MoeOrder<false>>(lds, g, S, E);
    } SEAM(PH_G2);
    if (IN(PH_FINAL)) { phase_final(p, lds); }
}

extern "C" void kernel_launch(void* const* d_in, const int* in_sizes, int n_in, void* d_out, int out_size, void* d_ws, size_t ws_size, hipStream_t stream) {
    static int grid = 0;
    if (grid == 0) {
        if (n_in != 33 || out_size != T * DM || ws_size < WS_END) { fprintf(stderr, "kernel_launch: unexpected problem (n_in %d out %d ws %zu)\n", n_in, out_size, ws_size); grid = -1; return; }
        int dev = 0, cus = 0;
        hipGetDevice(&dev); hipDeviceGetAttribute(&cus, hipDeviceAttributeMultiprocessorCount, dev);
        if (hipFuncSetAttribute((const void*)fwd_kernel, hipFuncAttributeMaxDynamicSharedMemorySize, LDS_BYTES) != hipSuccess) { fprintf(stderr, "kernel_launch: hipFuncSetAttribute failed\n"); grid = -1; return; }
        int per_cu = 0; hipOccupancyMaxActiveBlocksPerMultiprocessor(&per_cu, (const void*)fwd_kernel, NTHREADS, LDS_BYTES); (void)hipGetLastError();
        if (per_cu < 1) fprintf(stderr, "kernel_launch: occupancy query says %d blocks per CU\n", per_cu);
        if (per_cu < 1) { grid = -1; return; }
        grid = cus > 0 ? cus : 256;
    }
    if (grid < 0) return;
    hipMemsetAsync((char*)d_ws + WS_CTL, 0, CTL_BYTES, stream);
    Params p{};
    for (int i = 0; i < 33; ++i) p.in[i] = (const float*)d_in[i];
    p.out = (float*)d_out; p.ws = (unsigned char*)d_ws;
#if N_LAUNCH_MODE == 1
    p.ph_lo = 0; p.ph_hi = PH_COUNT;
    void* args[] = {&p};
    hipError_t e = hipLaunchCooperativeKernel((const void*)fwd_kernel, dim3(grid), dim3(NTHREADS), args, LDS_BYTES, stream);
    if (e != hipSuccess) fprintf(stderr, "cooperative launch failed: %s (grid %d)\n", hipGetErrorString(e), grid);
#else
    for (int ph = 0; ph < PH_COUNT; ++ph) { p.ph_lo = ph; p.ph_hi = ph + 1; hipLaunchKernelGGL(fwd_kernel, dim3(grid), dim3(NTHREADS), LDS_BYTES, stream, p); }
#endif
}
```

```cpp
#include <hip/hip_runtime.h>
#include <hip/hip_cooperative_groups.h>
#include <cstdio>
#include <cstdint>
namespace cg = cooperative_groups;

#ifndef N_LAUNCH_MODE
#define N_LAUNCH_MODE 1
#endif
#ifndef PROBE_DUP
#define PROBE_DUP 0
#endif
#ifndef USE_REF_ATTN
#define USE_REF_ATTN 0
#endif
#ifndef USE_REF_GEMM
#define USE_REF_GEMM 0
#endif

constexpr int BATCH = 8, SEQ = 2048, DM = 2048, T = BATCH * SEQ;
constexpr int DAW = 1024, RWW = 1024, NH_DA = 8, NH_RW = 16;
constexpr int NIN = 6912;
constexpr int PW = 768;
constexpr int NEXP = 32, DEXP = 512, CAP = T;
constexpr int MAXTILES = 160;
constexpr float C2Q = 0.125f * 1.4426950408889634f;
constexpr float LOG2E = 1.4426950408889634f;

constexpr size_t MiB = 1u << 20;
constexpr size_t WS_CTL = 0, CTL_BYTES = 1 * MiB;
constexpr size_t CTL_SS2 = 65536;
constexpr size_t CTL_CNT = 131072;
constexpr size_t CTL_QCTR = 131072 + 256;
constexpr size_t CTL_BAR = 262144;
constexpr size_t WS_WOUT = 1 * MiB;
constexpr size_t WS_L2T = 9 * MiB;
constexpr size_t WS_RSTD1 = 11 * MiB;
constexpr size_t WS_RSTD2 = 11 * MiB + 65536;
constexpr size_t WS_TOKINFO = 11 * MiB + 131072;
constexpr size_t WS_WRT = 11 * MiB + 524288;
constexpr size_t WS_WIN = 12 * MiB;
constexpr size_t WS_XB = 40 * MiB;
constexpr size_t WS_O = 40 * MiB;
constexpr size_t WS_INBUF = 104 * MiB;
constexpr size_t WS_PBUF = 296 * MiB;
constexpr size_t WS_A2 = 320 * MiB;
constexpr size_t WS_WL = 344 * MiB;
constexpr size_t WS_ABUF = 408 * MiB;
constexpr size_t WS_GBUF = 440 * MiB;
constexpr size_t WS_OPART = 472 * MiB;
constexpr size_t WS_HB = 104 * MiB;
constexpr size_t WS_WGU = 168 * MiB;
constexpr size_t WS_WD = 296 * MiB;
constexpr size_t WS_RT = 360 * MiB;
constexpr size_t WS_GATEB = 362 * MiB;
constexpr size_t WS_HID = 364 * MiB;
constexpr size_t WS_YB = 404 * MiB;
constexpr size_t WS_END = 564 * MiB;

constexpr int NTHREADS = 512, NWAVES = 8;
constexpr int LDS_BYTES = 147456;

typedef unsigned short bf16_t;
typedef short bf16x8 __attribute__((ext_vector_type(8)));
typedef float f32x4 __attribute__((ext_vector_type(4)));
typedef float f32x2 __attribute__((ext_vector_type(2)));
typedef unsigned u32x4 __attribute__((ext_vector_type(4)));
typedef unsigned u32x2 __attribute__((ext_vector_type(2)));

__device__ __forceinline__ unsigned f2bf(float f) { unsigned u = __builtin_bit_cast(unsigned, f); return (u + 0x7fffu + ((u >> 16) & 1u)) >> 16; }
__device__ __forceinline__ unsigned pk2(float lo, float hi) { return f2bf(lo) | (f2bf(hi) << 16); }
__device__ __forceinline__ float bf2f(unsigned h) { return __builtin_bit_cast(float, h << 16); }
__device__ __forceinline__ float bflo(unsigned w) { return __builtin_bit_cast(float, w << 16); }
__device__ __forceinline__ float bfhi(unsigned w) { return __builtin_bit_cast(float, w & 0xffff0000u); }
__device__ __forceinline__ float wave_sum(float v) {
#pragma unroll
    for (int o = 1; o < 64; o <<= 1) v += __shfl_xor(v, o);
    return v;
}
__device__ __forceinline__ int opaque_tid() { int t = threadIdx.x; asm volatile("" : "+v"(t)); return t; }
__device__ __forceinline__ float sigmoidf_(float x) { return 1.0f / (1.0f + __expf(-x)); }

struct Params {
    const float* in[33];
    float* out;
    unsigned char* ws;
    int ph_lo, ph_hi;
};

enum { PH_PRO = 0, PH_INPROJ, PH_L2PREP, PH_L2GEMM, PH_MIX, PH_COMB, PH_OUT, PH_ROUTE, PH_G1, PH_G2, PH_FINAL, PH_COUNT };

struct Unit { int pm, pn; long a_off, b_off; const int* gidx; int valid, e, tile, k; };
struct Gemm { const bf16_t* A; const bf16_t* Bt; int lda, ldb, K; };

struct DenseOrder {
    static constexpr bool GATHER = false;
    int nM, nN, nwg, G, c, lda, ldb, acol_shift, acol_w;
    __device__ void init(int M, int N, int G_, int c_, int lda_, int ldb_, int acol_shift_ = -1, int acol_w_ = 0) {
        nM = M / 256; nN = N / 256; nwg = nM * nN; G = G_; c = c_; lda = lda_; ldb = ldb_; acol_shift = acol_shift_; acol_w = acol_w_; }
    __device__ bool next(int i, Unit& u) const {
        const long L = (long)i * G + c; if (L >= nwg) return false;
        int wgid = (int)L; { const int q = nwg / 8, r = nwg % 8, xcd = wgid % 8, off = wgid / 8; wgid = (xcd < r ? xcd * (q + 1) : r * (q + 1) + (xcd - r) * q) + off; }
        const int nig = 8 * nN, gid = wgid / nig, fm = gid * 8, gsz = (nM - fm) < 8 ? (nM - fm) : 8;
        u.pm = fm + ((wgid % nig) % gsz); u.pn = (wgid % nig) / gsz;
        u.a_off = (long)u.pm * 256 * lda + (acol_shift >= 0 ? (long)(u.pn >> acol_shift) * acol_w : 0);
        u.b_off = (long)u.pn * 256 * ldb; u.gidx = nullptr; u.valid = 256; u.e = 0; u.tile = 0; u.k = 0; return true;
    }
};
template <bool GATHER_> struct MoeOrder {
    static constexpr bool GATHER = GATHER_;
    const unsigned* cnt; const int* rt; int ncol, G, c, mode; long a_ld, b_estride, b_ld;
    __device__ bool next(int i, Unit& u) const {
        const long L = (long)i * G + c; const int g = (int)(L / ncol), pn = (int)(L % ncol);
        int ts = 0, e = 0, k = -1, ce = 0;
        for (e = 0; e < NEXP; ++e) { ce = __builtin_amdgcn_readfirstlane((int)cnt[e]); const int nt = (ce + 255) >> 8; if (g < ts + nt) { k = g - ts; break; } ts += nt; }
        if (k < 0) return false;
        u.pm = g; u.pn = pn; u.e = e; u.tile = g; u.k = k; u.valid = (ce - 256 * k) < 256 ? (ce - 256 * k) : 256;
        if (mode == 0) { u.gidx = rt + (long)e * CAP + 256 * k; u.a_off = 0; }
        else { u.gidx = nullptr; u.a_off = (long)g * 256 * a_ld; }
        u.b_off = (long)e * b_estride + (long)pn * 256 * b_ld; return true;
    }
};

template <class Epi, class Sched>
__device__ __forceinline__ void gemm_phase_ref(unsigned char* lds, const Gemm g, const Sched& S, const Epi& E) {
    const int tid = threadIdx.x, wid = tid >> 6, lane = tid & 63, wr = wid >> 2, wc = wid & 3, fr = lane & 15, fq = lane >> 4;
    bf16_t* As = (bf16_t*)lds; bf16_t* Bs = As + 256 * 72;
    Unit u;
    for (int ui = 0; S.next(ui, u); ++ui) {
        f32x4 acc[2][2][4][2];
#pragma unroll
        for (int a = 0; a < 2; ++a)
#pragma unroll
            for (int b = 0; b < 2; ++b)
#pragma unroll
                for (int m = 0; m < 4; ++m)
#pragma unroll
                    for (int n = 0; n < 2; ++n) acc[a][b][m][n] = (f32x4){0.f, 0.f, 0.f, 0.f};
        long arow[4];
#pragma unroll
        for (int i = 0; i < 4; ++i) { const int row = (tid + 512 * i) >> 3; arow[i] = u.gidx ? (row < u.valid ? (long)u.gidx[row] : 0L) : (long)row; }
        for (int k0 = 0; k0 < g.K; k0 += 64) {
            __syncthreads();
#pragma unroll
            for (int i = 0; i < 4; ++i) { const int ch = tid + 512 * i, row = ch >> 3, c8 = ch & 7;
                const u32x4 va = *(const u32x4*)(g.A + u.a_off + arow[i] * g.lda + k0 + c8 * 8);
                const u32x4 vb = *(const u32x4*)(g.Bt + u.b_off + (long)row * g.ldb + k0 + c8 * 8);
                *(u32x4*)(As + row * 72 + c8 * 8) = va; *(u32x4*)(Bs + row * 72 + c8 * 8) = vb; }
            __syncthreads();
            for (int kk = 0; kk < 64; ++kk) {
                float a[2][4];
#pragma unroll
                for (int ai = 0; ai < 2; ++ai)
#pragma unroll
                    for (int m = 0; m < 4; ++m) a[ai][m] = bf2f(As[(ai * 128 + wr * 64 + m * 16 + fr) * 72 + kk]);
#pragma unroll
                for (int bj = 0; bj < 2; ++bj)
#pragma unroll
                    for (int n = 0; n < 2; ++n)
#pragma unroll
                        for (int e = 0; e < 4; ++e) {
                            const int cl = Epi::PERM ? (bj * 128 + wc * 32 + 8 * fq + 4 * n + e) : (bj * 128 + wc * 32 + 16 * n + 4 * fq + e);
                            const float b = bf2f(Bs[cl * 72 + kk]);
#pragma unroll
                            for (int ai = 0; ai < 2; ++ai)
#pragma unroll
                                for (int m = 0; m < 4; ++m) acc[ai][bj][m][n][e] += a[ai][m] * b;
                        }
            }
        }
        E(acc, u, wr, wc, fr, fq);
    }
    __syncthreads();
}


#define LAS __attribute__((address_space(3)))
namespace pg8 {
constexpr int BK = 64, HALF = 128, HTB = HALF * BK * 2, STAGE_BYTES = 8 * HTB;
__device__ __forceinline__ int lds_byte(int r, int c) { const int st = (r >> 4) * 2 + (c >> 5), rr = r & 15, cc = c & 31, ob = rr * 64 + cc * 2; return st * 1024 + (ob ^ (((ob >> 9) & 1) << 5)); }
__device__ __forceinline__ void stage_rc(int b, int& R, int& C) { const int st = b / 1024, sb = b % 1024, swz = sb ^ (((sb >> 9) & 1) << 5); R = (st >> 1) * 16 + swz / 64; C = (st & 1) * 32 + (swz % 64) / 2; }
__device__ __forceinline__ int perm32(int rho) { const int n = rho >> 4, i = rho & 15; return 8 * (i >> 2) + 4 * n + (i & 3); }
template <bool GATHER>
__device__ __forceinline__ void unit_voffA(const Unit& u, int lda, int tid, unsigned (&v0)[2], unsigned (&v1)[2]) {
#pragma unroll
    for (int i = 0; i < 2; ++i) { int R, C; stage_rc(tid * 16 + i * 8192, R, C); int r0 = R, r1 = R + HALF;
        if (GATHER) { const int a = (r0 < u.valid) ? u.gidx[r0] : 0, b = (r1 < u.valid) ? u.gidx[r1] : 0; r0 = a; r1 = b; }
        v0[i] = (unsigned)(r0 * lda + C) * 2u; v1[i] = (unsigned)(r1 * lda + C) * 2u; }
}
template <class Epi, class Sched, bool ALIGN_EPI = true>
__device__ __forceinline__ void gemm_phase(LAS unsigned char* lds, const Gemm g, const Sched& S, const Epi& E) {
    const int tid = threadIdx.x, wid = __builtin_amdgcn_readfirstlane(tid >> 6), lane = tid & 63, wr = wid >> 2, wc = wid & 3, fr = lane & 15, fq = lane >> 4;
    const int K = g.K, nt = K / BK;
    constexpr bool GATHER = Sched::GATHER;
    unsigned voffB[2];
#pragma unroll
    for (int i = 0; i < 2; ++i) { int R, C; stage_rc(tid * 16 + i * 8192, R, C); const int Rb = Epi::PERM ? ((R & ~31) + perm32(R & 31)) : R; voffB[i] = (unsigned)(Rb * g.ldb + C) * 2u; }
    const size_t hstepA = (size_t)HALF * g.lda * 2;
    const size_t kstep = (size_t)(BK * 2);
    const size_t hstepB = (size_t)HALF * g.ldb * 2;
    const unsigned ldsw = (unsigned)wid * 1024u;
    const int aoff = lds_byte(wr * 64 + fr, fq * 8), boff = lds_byte(wc * 32 + fr, fq * 8);
#define PG8_SA(b, h) (((b) * 2 + (h)) * HTB)
#define PG8_SB(b, h) ((4 + (b) * 2 + (h)) * HTB)
#define PG8_STAGE(bufoff, gbase, voff) do { _Pragma("unroll") for (int _i = 0; _i < 2; ++_i) \
        __builtin_amdgcn_global_load_lds((const unsigned*)((const char*)(gbase) + (voff)[_i]), (LAS unsigned*)(lds + (bufoff) + ldsw + _i * 8192), 16, 0, 0); } while (0)
#define PG8_LDA(dst, b, h) do { _Pragma("unroll") for (int m = 0; m < 4; ++m) _Pragma("unroll") for (int k = 0; k < 2; ++k) dst[m][k] = *(const LAS bf16x8*)(lds + PG8_SA(b, h) + aoff + m * 2048 + k * 1024); } while (0)
#define PG8_LDB(dst, b, h) do { _Pragma("unroll") for (int n = 0; n < 2; ++n) _Pragma("unroll") for (int k = 0; k < 2; ++k) dst[n][k] = *(const LAS bf16x8*)(lds + PG8_SB(b, h) + boff + n * 2048 + k * 1024); } while (0)
#define PG8_MMA(ai, bj, At, Bt) do { __builtin_amdgcn_s_setprio(1); _Pragma("unroll") for (int m = 0; m < 4; ++m) _Pragma("unroll") for (int n = 0; n < 2; ++n) _Pragma("unroll") for (int k = 0; k < 2; ++k) \
        acc[ai][bj][m][n] = __builtin_amdgcn_mfma_f32_16x16x32_bf16(Bt[n][k], At[m][k], acc[ai][bj][m][n], 0, 0, 0); __builtin_amdgcn_s_setprio(0); } while (0)
#define PG8_WAIT_V(n) asm volatile("s_waitcnt vmcnt(" #n ")" ::: "memory")
#define PG8_WAIT_L(n) asm volatile("s_waitcnt lgkmcnt(" #n ")" ::: "memory")
#define PG8_BAR __builtin_amdgcn_s_barrier()
#define PG8_SCHED __builtin_amdgcn_sched_barrier(0)
    Unit cur, nxt; int ui = 0;
    if (!S.next(0, cur)) return;
    f32x4 acc[2][2][4][2];
#pragma unroll
    for (int a = 0; a < 2; ++a)
#pragma unroll
        for (int b = 0; b < 2; ++b)
#pragma unroll
            for (int m = 0; m < 4; ++m)
#pragma unroll
                for (int n = 0; n < 2; ++n) acc[a][b][m][n] = (f32x4){0.f, 0.f, 0.f, 0.f};
    bf16x8 At[4][2], B0[2][2], B1[2][2];
    const char* cA = (const char*)(g.A + cur.a_off); const char* cB = (const char*)(g.Bt + cur.b_off);
    unsigned vA0[2], vA1[2], nA0[2], nA1[2];
    unit_voffA<GATHER>(cur, g.lda, tid, vA0, vA1);
#define PG8_STAGE_A(bufoff, gbase, h, sel) do { if constexpr (GATHER) { if (sel) { if ((h) == 0) PG8_STAGE(bufoff, gbase, nA0); else PG8_STAGE(bufoff, gbase, nA1); } else { if ((h) == 0) PG8_STAGE(bufoff, gbase, vA0); else PG8_STAGE(bufoff, gbase, vA1); } } \
        else { PG8_STAGE(bufoff, (gbase) + ((h) ? hstepA : (size_t)0), vA0); } } while (0)
    PG8_STAGE(PG8_SB(0, 0), cB, voffB); PG8_STAGE(PG8_SB(0, 1), cB + hstepB, voffB); PG8_STAGE_A(PG8_SA(0, 0), cA, 0, false); PG8_STAGE_A(PG8_SA(0, 1), cA, 1, false);
    if (wr == 1) PG8_BAR;
    PG8_WAIT_V(2); PG8_BAR;
    PG8_STAGE(PG8_SB(1, 0), cB + kstep, voffB); PG8_STAGE_A(PG8_SA(1, 0), cA + kstep, 0, false); PG8_STAGE(PG8_SB(1, 1), cB + hstepB + kstep, voffB);
    PG8_WAIT_V(6); PG8_BAR;
    for (;;) {
        const bool has_next = S.next(ui + 1, nxt);
        const char* nA = has_next ? (const char*)(g.A + nxt.a_off) : cA; const char* nB = has_next ? (const char*)(g.Bt + nxt.b_off) : cB;
        if constexpr (GATHER) { if (has_next) unit_voffA<true>(nxt, g.lda, tid, nA0, nA1); else { nA0[0] = vA0[0]; nA0[1] = vA0[1]; nA1[0] = vA1[0]; nA1[1] = vA1[1]; } }
        for (int t = 0; t < nt; t += 2) {
            const bool last = (t == nt - 2);
            const char* a1 = cA + (size_t)(t + 1) * kstep;
            const char* a2 = last ? nA : cA + (size_t)(t + 2) * kstep; const char* b2 = last ? nB : cB + (size_t)(t + 2) * kstep;
            const char* a3 = a2 + kstep; const char* b3 = b2 + kstep;
            PG8_LDB(B0, 0, 0); PG8_LDB(B1, 0, 1); PG8_SCHED; PG8_LDA(At, 0, 0); PG8_STAGE_A(PG8_SA(1, 1), a1, 1, false);
            PG8_WAIT_V(8); PG8_WAIT_L(0); PG8_BAR; PG8_MMA(0, 0, At, B0); PG8_MMA(0, 1, At, B1); PG8_BAR; PG8_SCHED;
            PG8_LDA(At, 0, 1); PG8_STAGE(PG8_SB(0, 0), b2, voffB); PG8_STAGE(PG8_SB(0, 1), b2 + hstepB, voffB); PG8_STAGE_A(PG8_SA(0, 0), a2, 0, last);
            PG8_WAIT_V(8); PG8_WAIT_L(0); PG8_BAR; PG8_MMA(1, 0, At, B0); PG8_MMA(1, 1, At, B1); PG8_BAR; PG8_SCHED;
            PG8_LDB(B0, 1, 0); PG8_LDB(B1, 1, 1); PG8_SCHED; PG8_LDA(At, 1, 0); PG8_STAGE_A(PG8_SA(0, 1), a2, 1, last);
            PG8_WAIT_V(8); PG8_WAIT_L(0); PG8_BAR; PG8_MMA(0, 0, At, B0); PG8_MMA(0, 1, At, B1); PG8_BAR; PG8_SCHED;
            PG8_LDA(At, 1, 1); PG8_STAGE(PG8_SB(1, 0), b3, voffB); PG8_STAGE(PG8_SB(1, 1), b3 + hstepB, voffB); PG8_STAGE_A(PG8_SA(1, 0), a3, 0, last);
            PG8_WAIT_V(8); PG8_WAIT_L(0); PG8_BAR; PG8_MMA(1, 0, At, B0); PG8_MMA(1, 1, At, B1); PG8_BAR; PG8_SCHED;
        }
        if constexpr (ALIGN_EPI) { if (wr == 0) PG8_BAR; }
        E(acc, cur, wr, wc, fr, fq);
        if (!has_next) break;
#pragma unroll
        for (int a = 0; a < 2; ++a)
#pragma unroll
            for (int b = 0; b < 2; ++b)
#pragma unroll
                for (int m = 0; m < 4; ++m)
#pragma unroll
                    for (int n = 0; n < 2; ++n) acc[a][b][m][n] = (f32x4){0.f, 0.f, 0.f, 0.f};
        cur = nxt; cA = nA; cB = nB; ++ui;
        if constexpr (GATHER) { vA0[0] = nA0[0]; vA0[1] = nA0[1]; vA1[0] = nA1[0]; vA1[1] = nA1[1]; }
        if constexpr (ALIGN_EPI) { if (wr == 1) PG8_BAR; }
    }
    PG8_WAIT_V(0);
    if constexpr (!ALIGN_EPI) { if (wr == 0) PG8_BAR; }
    PG8_BAR;
#undef PG8_SA
#undef PG8_SB
#undef PG8_STAGE
#undef PG8_STAGE_A
#undef PG8_LDA
#undef PG8_LDB
#undef PG8_MMA
#undef PG8_WAIT_V
#undef PG8_WAIT_L
#undef PG8_BAR
#undef PG8_SCHED
}
}
template <class Epi, class Sched>
__device__ __forceinline__ void gemm_phase_mfma(unsigned char* lds, const Gemm g, const Sched& S, const Epi& E) { pg8::gemm_phase<Epi, Sched, true>((LAS unsigned char*)lds, g, S, E); __syncthreads(); }

__device__ __forceinline__ u32x4 pack8(const f32x4 v0, const f32x4 v1) { u32x4 w; w.x = pk2(v0[0], v0[1]); w.y = pk2(v0[2], v0[3]); w.z = pk2(v1[0], v1[1]); w.w = pk2(v1[2], v1[3]); return w; }

struct EpiIn {
    static constexpr bool PERM = true;
    bf16_t* inbuf; bf16_t* pbuf; const float* rstd1;
    __device__ __forceinline__ void operator()(const f32x4 (&acc)[2][2][4][2], const Unit& u, int wr, int wc, int fr_, int fq_) const {
        int fr = fr_, fq = fq_; asm volatile("" : "+v"(fr), "+v"(fq));
        bf16_t* base; int ldc, colt; float sc0 = 1.f;
        if (u.pn < 24) { base = inbuf + (size_t)(u.pn >> 2) * T * 1024; ldc = 1024; colt = (u.pn & 3) * 256; if (u.pn < 4) sc0 = C2Q; }
        else { base = pbuf; ldc = PW; colt = (u.pn - 24) * 256; }
        const int row0 = u.pm * 256 + wr * 64 + fr, col0 = colt + wc * 32 + 8 * fq;
#pragma unroll
        for (int ai = 0; ai < 2; ++ai)
#pragma unroll
            for (int m = 0; m < 4; ++m) { const int row = row0 + ai * 128 + m * 16; const float rs = rstd1[row] * sc0; bf16_t* rowp = base + (size_t)row * ldc + col0;
#pragma unroll
                for (int bj = 0; bj < 2; ++bj) *(u32x4*)(rowp + bj * 128) = pack8(acc[ai][bj][m][0] * rs, acc[ai][bj][m][1] * rs); }
    }
};
struct EpiL2 {
    static constexpr bool PERM = true;
    float* wl; bf16_t* abuf; bf16_t* gbuf; const float* w0; const float* a0;
    __device__ __forceinline__ void operator()(const f32x4 (&acc)[2][2][4][2], const Unit& u, int wr, int wc, int fr_, int fq_) const {
        int fr = fr_, fq = fq_; asm volatile("" : "+v"(fr), "+v"(fq));
        const int grp = u.pn >> 2, colt = (u.pn & 3) * 256;
        const int row0 = u.pm * 256 + wr * 64 + fr, col0 = colt + wc * 32 + 8 * fq;
        if (grp == 0) {
#pragma unroll
            for (int bj = 0; bj < 2; ++bj) { const int c = col0 + bj * 128; const f32x4 b0 = *(const f32x4*)(w0 + c), b1 = *(const f32x4*)(w0 + c + 4);
#pragma unroll
                for (int ai = 0; ai < 2; ++ai)
#pragma unroll
                    for (int m = 0; m < 4; ++m) { const int row = row0 + ai * 128 + m * 16; f32x4 v0 = acc[ai][bj][m][0] + b0, v1 = acc[ai][bj][m][1] + b1;
#pragma unroll
                        for (int e = 0; e < 4; ++e) { v0[e] = -0.60653065971f * LOG2E * sigmoidf_(v0[e]); v1[e] = -0.60653065971f * LOG2E * sigmoidf_(v1[e]); }
                        float* p = wl + (size_t)row * 1024 + c; *(f32x4*)p = v0; *(f32x4*)(p + 4) = v1; asm volatile("" ::: "memory"); __builtin_amdgcn_sched_barrier(0); } }
        } else if (grp == 1) {
#pragma unroll
            for (int bj = 0; bj < 2; ++bj) { const int c = col0 + bj * 128; const f32x4 b0 = *(const f32x4*)(a0 + c), b1 = *(const f32x4*)(a0 + c + 4);
#pragma unroll
                for (int ai = 0; ai < 2; ++ai)
#pragma unroll
                    for (int m = 0; m < 4; ++m) { const int row = row0 + ai * 128 + m * 16; f32x4 v0 = acc[ai][bj][m][0] + b0, v1 = acc[ai][bj][m][1] + b1;
#pragma unroll
                        for (int e = 0; e < 4; ++e) { v0[e] = sigmoidf_(v0[e]); v1[e] = sigmoidf_(v1[e]); }
                        *(u32x4*)(abuf + (size_t)row * 1024 + c) = pack8(v0, v1); asm volatile("" ::: "memory"); __builtin_amdgcn_sched_barrier(0); } }
        } else {
#pragma unroll
            for (int bj = 0; bj < 2; ++bj) { const int c = col0 + bj * 128;
#pragma unroll
                for (int ai = 0; ai < 2; ++ai)
#pragma unroll
                    for (int m = 0; m < 4; ++m) { const int row = row0 + ai * 128 + m * 16; *(u32x4*)(gbuf + (size_t)row * 1024 + c) = pack8(acc[ai][bj][m][0], acc[ai][bj][m][1]); } }
        }
    }
};
struct EpiOut {
    static constexpr bool PERM = true;
    const float* x; float* h; bf16_t* hb; float* ss2;
    __device__ __forceinline__ void operator()(const f32x4 (&acc)[2][2][4][2], const Unit& u, int wr, int wc, int fr_, int fq_) const {
        int fr = fr_, fq = fq_; asm volatile("" : "+v"(fr), "+v"(fq));
        const int row0 = u.pm * 256 + wr * 64 + fr, col0 = u.pn * 256 + wc * 32 + 8 * fq;
#pragma unroll
        for (int ai = 0; ai < 2; ++ai)
#pragma unroll
            for (int m = 0; m < 4; ++m) { const int row = row0 + ai * 128 + m * 16; float ss = 0.f;
#pragma unroll
                for (int bj = 0; bj < 2; ++bj) { const size_t off = (size_t)row * DM + col0 + bj * 128;
                    const f32x4 x0 = *(const f32x4*)(x + off), x1 = *(const f32x4*)(x + off + 4);
                    const f32x4 v0 = acc[ai][bj][m][0] + x0, v1 = acc[ai][bj][m][1] + x1;
                    *(u32x4*)(hb + off) = pack8(v0, v1);
                    ss += (v0[0] * v0[0] + v0[1] * v0[1]) + (v0[2] * v0[2] + v0[3] * v0[3]) + (v1[0] * v1[0] + v1[1] * v1[1]) + (v1[2] * v1[2] + v1[3] * v1[3]); }
                ss += __shfl_xor(ss, 16); ss += __shfl_xor(ss, 32);
                if (fq == 0) atomicAdd(ss2 + row, ss); }
    }
};
struct EpiGU {
    static constexpr bool PERM = true;
    bf16_t* hid; const float* rstd2;
    __device__ __forceinline__ void operator()(const f32x4 (&acc)[2][2][4][2], const Unit& u, int wr, int wc, int fr_, int fq_) const {
        int fr = fr_, fq = fq_; asm volatile("" : "+v"(fr), "+v"(fq));
        const int col0 = u.pn * 128 + wc * 32 + 8 * fq;
#pragma unroll
        for (int ai = 0; ai < 2; ++ai)
#pragma unroll
            for (int m = 0; m < 4; ++m) { const int rl = ai * 128 + wr * 64 + m * 16 + fr; const int tok = (rl < u.valid) ? u.gidx[rl] : 0; const float rs = rstd2[tok];
                f32x4 o0, o1;
#pragma unroll
                for (int e = 0; e < 4; ++e) { const float g0 = acc[ai][0][m][0][e] * rs, u0 = acc[ai][1][m][0][e] * rs, g1 = acc[ai][0][m][1][e] * rs, u1 = acc[ai][1][m][1][e] * rs;
                    o0[e] = g0 * sigmoidf_(g0) * u0; o1[e] = g1 * sigmoidf_(g1) * u1; }
                *(u32x4*)(hid + ((size_t)u.tile * 256 + rl) * DEXP + col0) = pack8(o0, o1); asm volatile("" ::: "memory"); __builtin_amdgcn_sched_barrier(0); }
    }
};
struct EpiDown {
    static constexpr bool PERM = true;
    bf16_t* yb; const float* gateb; const unsigned* cnt;
    __device__ __forceinline__ void operator()(const f32x4 (&acc)[2][2][4][2], const Unit& u, int wr, int wc, int fr_, int fq_) const {
        int fr = fr_, fq = fq_; asm volatile("" : "+v"(fr), "+v"(fq));
        const int col0 = u.pn * 256 + wc * 32 + 8 * fq;
        const int k = u.k;
#pragma unroll
        for (int ai = 0; ai < 2; ++ai)
#pragma unroll
            for (int m = 0; m < 4; ++m) { const int rl = ai * 128 + wr * 64 + m * 16 + fr; const float gt = (rl < u.valid) ? gateb[(size_t)u.e * CAP + 256 * k + rl] : 0.f;
#pragma unroll
                for (int bj = 0; bj < 2; ++bj) *(u32x4*)(yb + ((size_t)u.tile * 256 + rl) * DM + col0 + bj * 128) = pack8(acc[ai][bj][m][0] * gt, acc[ai][bj][m][1] * gt); }
    }
};

__device__ __forceinline__ void tr_item64(const float* W, int ldw, int Kvalid, int Nvalid, int k0, int n0, bf16_t* WT, int ldt, int trow0, float* scr, int lane,
                                          const float* gk, const float* mu, int mode) {
    const int c4 = lane & 15, rq = lane >> 4; const bool ncol_ok = (n0 + 4 * c4) < Nvalid;
    f32x4 v[16];
#pragma unroll
    for (int i = 0; i < 16; ++i) { const int k = k0 + 4 * i + rq; v[i] = (f32x4){0.f, 0.f, 0.f, 0.f};
        if (k < Kvalid && ncol_ok) v[i] = *(const f32x4*)(W + (size_t)k * ldw + n0 + 4 * c4); }
#pragma unroll
    for (int i = 0; i < 16; ++i) { const int kk = 4 * i + rq, k = k0 + kk; float sc = 1.f;
        if (k < Kvalid) { if (gk) sc = gk[k]; if (mode == 1) sc *= (1.f - mu[k]); else if (mode == 2) sc *= mu[k]; }
        float* d = scr + kk * 65 + 4 * c4; d[0] = v[i][0] * sc; d[1] = v[i][1] * sc; d[2] = v[i][2] * sc; d[3] = v[i][3] * sc; }
    __builtin_amdgcn_s_waitcnt(0xC07F); asm volatile("" ::: "memory");
    const int c = lane & 7;
#pragma unroll
    for (int j = 0; j < 8; ++j) { const int n = (lane >> 3) + 8 * j; const float* q = scr + (8 * c) * 65 + n;
        u32x4 o; o.x = pk2(q[0 * 65], q[1 * 65]); o.y = pk2(q[2 * 65], q[3 * 65]); o.z = pk2(q[4 * 65], q[5 * 65]); o.w = pk2(q[6 * 65], q[7 * 65]);
        if (n0 + n < Nvalid) *(u32x4*)(WT + (size_t)(trow0 + n) * ldt + k0 + 8 * c) = o; }
    __builtin_amdgcn_s_waitcnt(0xC07F); asm volatile("" ::: "memory");
}

__device__ __forceinline__ void phase_prologue(const Params& p, unsigned char* lds) {
    const int tid = opaque_tid(), lane = tid & 63, wave = tid >> 6;
    const int gw = blockIdx.x * NWAVES + wave, NGW = gridDim.x * NWAVES;
    unsigned char* ws = p.ws;
    float* scr = (float*)(lds + wave * 16640);
    bf16_t* WinT = (bf16_t*)(ws + WS_WIN); bf16_t* WoutT = (bf16_t*)(ws + WS_WOUT); bf16_t* L2T = (bf16_t*)(ws + WS_L2T);
    const float* g_mix = p.in[1]; const float* mu_x = p.in[9];
    constexpr int I_WIN = 32 * 96;
    constexpr int I_L1 = 32 * (1 + 1 + 3) * 2;
    constexpr int I_WOUT = 32 * 32;
    constexpr int I_L2 = 3 * 4 * 16;
    constexpr int NITEMS = I_WIN + I_L1 + I_WOUT + I_L2;
    for (int it = gw; it < NITEMS; it += NGW) {
        int r = it;
        if (r < I_WIN) { const int kb = r / 96, nb = r % 96; tr_item64(p.in[2], 6144, 2048, 6144, 64 * kb, 64 * nb, WinT, 2048, 64 * nb, scr, lane, g_mix, nullptr, 0); continue; } r -= I_WIN;
        if (r < I_L1) {
            const int kb = r / 10, rr = r % 10;
            int which, nb, mode;
            if (rr < 2) { which = 0; nb = 0; mode = 1 + rr; } else if (rr < 4) { which = 1; nb = 0; mode = 1 + (rr - 2); } else { which = 2; nb = (rr - 4) >> 1; mode = 1 + ((rr - 4) & 1); }
            const float* W = which == 0 ? p.in[12] : which == 1 ? p.in[15] : p.in[17];
            const int ldw = which == 2 ? 160 : 64;
            const int rowbase = 6144 + (which == 0 ? 0 : which == 1 ? 128 : 256) + (mode == 2 ? ldw : 0);
            tr_item64(W, ldw, 2048, ldw, 64 * kb, 64 * nb, WinT, 2048, rowbase + 64 * nb, scr, lane, g_mix, mu_x + which * 2048, mode); continue; } r -= I_L1;
        if (r < I_WOUT) { const int kb = r / 32, nb = r % 32; tr_item64(p.in[3], 2048, 2048, 2048, 64 * kb, 64 * nb, WoutT, 2048, 64 * nb, scr, lane, nullptr, nullptr, 0); continue; } r -= I_WOUT;
        { const int which = r / 64, rr = r % 64, kb = rr / 16, nb = rr % 16;
          const float* W = which == 0 ? p.in[13] : which == 1 ? p.in[16] : p.in[18]; const int kv = which == 2 ? 160 : 64;
          tr_item64(W, 1024, kv, 1024, 64 * kb, 64 * nb, L2T, 256, which * 1024 + 64 * nb, scr, lane, nullptr, nullptr, 0); }
    }
    for (int ch = blockIdx.x * NTHREADS + tid; ch < 192 * 256; ch += gridDim.x * NTHREADS) *(u32x4*)(WinT + (size_t)6720 * 2048 + (size_t)ch * 8) = (u32x4){0u, 0u, 0u, 0u};
    { bf16_t* whi = (bf16_t*)(ws + WS_WRT); bf16_t* wlo = whi + 48 * 2048; const float* gf = p.in[24]; const float* wg = p.in[25]; const float* we = p.in[27];
      for (int id = blockIdx.x * NTHREADS + tid; id < 48 * 2048; id += gridDim.x * NTHREADS) { const int cc = id >> 11, k = id & 2047; float w = 0.f;
          if (cc < 4) w = wg[(size_t)k * 4 + cc] * gf[k]; else if (cc < 36) w = we[(size_t)k * 32 + cc - 4] * gf[k];
          const unsigned hb = f2bf(w); const float hf = bf2f(hb); whi[id] = (bf16_t)hb; wlo[id] = (bf16_t)f2bf(w - hf); } }
    const float* x = p.in[0]; bf16_t* xb = (bf16_t*)(ws + WS_XB); float* rstd1 = (float*)(ws + WS_RSTD1);
    for (int m = gw; m < T; m += NGW) {
        const f32x4* xr = (const f32x4*)(x + (size_t)m * DM) + lane; f32x4 v[8]; float s = 0.f;
#pragma unroll
        for (int j = 0; j < 8; ++j) { v[j] = xr[64 * j]; s += (v[j][0] * v[j][0] + v[j][1] * v[j][1]) + (v[j][2] * v[j][2] + v[j][3] * v[j][3]); }
        s = wave_sum(s);
        u32x2* o = (u32x2*)(xb + (size_t)m * DM) + lane;
#pragma unroll
        for (int j = 0; j < 8; ++j) { u32x2 w; w.x = pk2(v[j][0], v[j][1]); w.y = pk2(v[j][2], v[j][3]); o[64 * j] = w; }
        if (lane == 0) rstd1[m] = 1.0f / sqrtf(s * (1.0f / DM) + 1e-6f);
    }
}

__device__ __forceinline__ void convert_experts(const Params& p, unsigned char* lds) {
    const int tid = opaque_tid(), lane = tid & 63, wave = tid >> 6;
    const int gw = blockIdx.x * NWAVES + wave, NGW = gridDim.x * NWAVES;
    float* scr = (float*)(lds + wave * 16640);
    bf16_t* Wgu = (bf16_t*)(p.ws + WS_WGU); bf16_t* Wd = (bf16_t*)(p.ws + WS_WD); const float* gf = p.in[24];
    constexpr int I_G = 32 * 32 * 8;
    constexpr int I_D = 32 * 8 * 32;
    for (int it = gw; it < 2 * I_G + I_D; it += NGW) {
        int r = it;
        if (r < 2 * I_G) { const int up = r >= I_G; if (up) r -= I_G; const int e = r / 256, rr = r % 256, kb = rr / 8, nb = rr % 8; const int n0 = 64 * nb;
            tr_item64((up ? p.in[30] : p.in[29]) + (size_t)e * 2048 * 512, 512, 2048, 512, 64 * kb, n0, Wgu + (size_t)e * 1024 * 2048, 2048, 256 * (n0 >> 7) + (n0 & 127) + (up ? 128 : 0), scr, lane, gf, nullptr, 0); continue; }
        r -= 2 * I_G;
        { const int e = r / 256, rr = r % 256, kb = rr / 32, nb = rr % 32;
          tr_item64(p.in[31] + (size_t)e * 512 * 2048, 2048, 512, 2048, 64 * kb, 64 * nb, Wd + (size_t)e * 2048 * 512, 512, 64 * nb, scr, lane, nullptr, nullptr, 0); }
    }
}

__device__ __forceinline__ void phase_l2prep(const Params& p) {
    const bf16_t* P = (const bf16_t*)(p.ws + WS_PBUF); bf16_t* A2 = (bf16_t*)(p.ws + WS_A2);
    const int nchunk = T * 96;
    const int tid = opaque_tid();
    for (int id = blockIdx.x * NTHREADS + tid; id < nchunk; id += gridDim.x * NTHREADS) {
        const int t = id / 96, ch = id % 96, gi = ch >> 5, jc = (ch & 31) * 8;
        const int width = gi == 2 ? 160 : 64, pa = gi == 0 ? 0 : gi == 1 ? 128 : 256, pb = pa + width;
        u32x4 o = (u32x4){0u, 0u, 0u, 0u};
        if (jc < width) {
            const u32x4 va = *(const u32x4*)(P + (size_t)t * PW + pa + jc);
            u32x4 vb = (u32x4){0u, 0u, 0u, 0u};
            if ((t & (SEQ - 1)) != 0) vb = *(const u32x4*)(P + (size_t)(t - 1) * PW + pb + jc);
            float f[8];
#pragma unroll
            for (int i = 0; i < 4; ++i) { f[2 * i] = bflo(va[i]) + bflo(vb[i]); f[2 * i + 1] = bfhi(va[i]) + bfhi(vb[i]); }
#pragma unroll
            for (int i = 0; i < 8; ++i) { if (gi == 0) f[i] = 1.0f - 2.0f / (__expf(2.0f * f[i]) + 1.0f); else if (gi == 2) f[i] = sigmoidf_(f[i]); }
            o.x = pk2(f[0], f[1]); o.y = pk2(f[2], f[3]); o.z = pk2(f[4], f[5]); o.w = pk2(f[6], f[7]);
        }
        *(u32x4*)(A2 + (size_t)t * PW + ch * 8) = o;
    }
}

constexpr int TC = 16;
constexpr int SCAN_VEC_FLOATS = 4 * TC * 64 + TC * 64 + 2 * TC;
constexpr int SCAN_OFF_YS = 2 * SCAN_VEC_FLOATS;
constexpr int SCAN_OFF_GB = SCAN_OFF_YS + 2 * TC * 64;
constexpr int SCAN_LDS_FLOATS = SCAN_OFF_GB + 4 * TC * 64;
#define DPP_F(v, ctrl) __builtin_bit_cast(float, __builtin_amdgcn_update_dpp(0, __builtin_bit_cast(int, (v)), (ctrl), 0xF, 0xF, true))
__device__ __forceinline__ float red8(float v) {
    v += DPP_F(v, 0xB1);
    v += DPP_F(v, 0x4E);
    v += DPP_F(v, 0x141);
    return v;
}
__device__ __forceinline__ float wave_sum_fast(float v) {
    v = red8(v);
    v += DPP_F(v, 0x140);
    v += __builtin_bit_cast(float, __builtin_amdgcn_update_dpp(0, __builtin_bit_cast(int, v), 0x142, 0xa, 0xf, false));
    v += __builtin_bit_cast(float, __builtin_amdgcn_update_dpp(0, __builtin_bit_cast(int, v), 0x143, 0xc, 0xf, false));
    return __builtin_bit_cast(float, __builtin_amdgcn_readlane(__builtin_bit_cast(int, v), 63));
}
typedef __bf16 bf16x2_n __attribute__((ext_vector_type(2)));
__device__ __forceinline__ unsigned cvt_pk_bf16_(float lo, float hi) { const f32x2 v = {lo, hi}; const bf16x2_n b = __builtin_convertvector(v, bf16x2_n); return __builtin_bit_cast(unsigned, b); }
__device__ __forceinline__ f32x2 lo2(const f32x4 x) { return (f32x2){x[0], x[1]}; }
__device__ __forceinline__ f32x2 hi2(const f32x4 x) { return (f32x2){x[2], x[3]}; }
__device__ __forceinline__ void rwkv_chain(const Params& p, unsigned char* lds, int chain) {
    const int tid = opaque_tid(), lane = tid & 63, wave = __builtin_amdgcn_readfirstlane(tid >> 6);
    const int b = chain >> 4, h = chain & 15;
    float* L = (float*)lds;
    constexpr int NC = SEQ / TC;
    if (wave < 4) {
        const int n = lane & 15, q = lane >> 4, irow = 16 * wave + n;
        f32x2 S[8];
#pragma unroll
        for (int e = 0; e < 8; ++e) S[e] = (f32x2){0.f, 0.f};
        __syncthreads();
        for (int ci = 0; ci < NC; ++ci) {
            const float* V0 = L + (ci & 1) * SCAN_VEC_FLOATS;
            float* Ys = L + SCAN_OFF_YS + (ci & 1) * TC * 64;
            const float* Ws = V0 + 8 * q; const float* Bs = V0 + TC * 64 + 8 * q; const float* Ks = V0 + 2 * TC * 64 + 8 * q; const float* Vs = V0 + 3 * TC * 64 + irow;
            const bf16_t* AV = (const bf16_t*)(V0 + 4 * TC * 64) + (lane & 1) * 64 + 8 * q;
            const float* SC = V0 + 5 * TC * 64;
            bf16x8 a0 = *(const bf16x8*)(AV), a1 = *(const bf16x8*)(AV + 32);
            f32x4 w0 = *(const f32x4*)(Ws), w1 = *(const f32x4*)(Ws + 4), w2 = *(const f32x4*)(Ws + 32), w3 = *(const f32x4*)(Ws + 36);
            f32x4 b0 = *(const f32x4*)(Bs), b1 = *(const f32x4*)(Bs + 4), b2 = *(const f32x4*)(Bs + 32), b3 = *(const f32x4*)(Bs + 36);
            f32x4 k0 = *(const f32x4*)(Ks), k1 = *(const f32x4*)(Ks + 4), k2 = *(const f32x4*)(Ks + 32), k3 = *(const f32x4*)(Ks + 36);
            float v = Vs[0]; f32x2 sc = *(const f32x2*)(SC);
#pragma unroll 2
            for (int tl = 0; tl < TC; ++tl) {
                const int tn = (tl + 1 < TC) ? tl + 1 : tl;
                const bf16x8 na0 = *(const bf16x8*)(AV + tn * 128), na1 = *(const bf16x8*)(AV + tn * 128 + 32);
                const f32x4 nw0 = *(const f32x4*)(Ws + tn * 64), nw1 = *(const f32x4*)(Ws + tn * 64 + 4), nw2 = *(const f32x4*)(Ws + tn * 64 + 32), nw3 = *(const f32x4*)(Ws + tn * 64 + 36);
                const f32x4 nb0 = *(const f32x4*)(Bs + tn * 64), nb1 = *(const f32x4*)(Bs + tn * 64 + 4), nb2 = *(const f32x4*)(Bs + tn * 64 + 32), nb3 = *(const f32x4*)(Bs + tn * 64 + 36);
                const f32x4 nk0 = *(const f32x4*)(Ks + tn * 64), nk1 = *(const f32x4*)(Ks + tn * 64 + 4), nk2 = *(const f32x4*)(Ks + tn * 64 + 32), nk3 = *(const f32x4*)(Ks + tn * 64 + 36);
                const float nv = Vs[tn * 64]; const f32x2 nsc = *(const f32x2*)(SC + 2 * tn);
                u32x4 s0, s1;
                s0.x = cvt_pk_bf16_(S[0][0], S[0][1]); s0.y = cvt_pk_bf16_(S[1][0], S[1][1]); s0.z = cvt_pk_bf16_(S[2][0], S[2][1]); s0.w = cvt_pk_bf16_(S[3][0], S[3][1]);
                s1.x = cvt_pk_bf16_(S[4][0], S[4][1]); s1.y = cvt_pk_bf16_(S[5][0], S[5][1]); s1.z = cvt_pk_bf16_(S[6][0], S[6][1]); s1.w = cvt_pk_bf16_(S[7][0], S[7][1]);
                f32x4 d = __builtin_amdgcn_mfma_f32_16x16x32_bf16(a0, __builtin_bit_cast(bf16x8, s0), (f32x4){0.f, 0.f, 0.f, 0.f}, 0, 0, 0);
                d = __builtin_amdgcn_mfma_f32_16x16x32_bf16(a1, __builtin_bit_cast(bf16x8, s1), d, 0, 0, 0);
                const float sa = d[0], pp = d[1];
                const float y = pp + (sa * sc[0] + v * sc[1]);
                if (q == 0) Ys[tl * 64 + irow] = y;
                const f32x2 sa2 = (f32x2){sa, sa}, v2 = (f32x2){v, v};
                S[0] = S[0] * lo2(w0) + (sa2 * lo2(b0) + v2 * lo2(k0)); S[1] = S[1] * hi2(w0) + (sa2 * hi2(b0) + v2 * hi2(k0));
                S[2] = S[2] * lo2(w1) + (sa2 * lo2(b1) + v2 * lo2(k1)); S[3] = S[3] * hi2(w1) + (sa2 * hi2(b1) + v2 * hi2(k1));
                S[4] = S[4] * lo2(w2) + (sa2 * lo2(b2) + v2 * lo2(k2)); S[5] = S[5] * hi2(w2) + (sa2 * hi2(b2) + v2 * hi2(k2));
                S[6] = S[6] * lo2(w3) + (sa2 * lo2(b3) + v2 * lo2(k3)); S[7] = S[7] * hi2(w3) + (sa2 * hi2(b3) + v2 * hi2(k3));
                a0 = na0; a1 = na1; w0 = nw0; w1 = nw1; w2 = nw2; w3 = nw3; b0 = nb0; b1 = nb1; b2 = nb2; b3 = nb3; k0 = nk0; k1 = nk1; k2 = nk2; k3 = nk3; v = nv; sc = nsc;
            }
            __syncthreads();
        }
    } else {
        const int aw = wave - 4, c = h * 64 + lane;
        constexpr int SPW = TC / 4;
        const bf16_t* rb = (const bf16_t*)(p.ws + WS_INBUF) + (size_t)3 * T * 1024; const bf16_t* kb = rb + (size_t)T * 1024; const bf16_t* vb = kb + (size_t)T * 1024;
        const float* wl = (const float*)(p.ws + WS_WL); const bf16_t* ab = (const bf16_t*)(p.ws + WS_ABUF); const bf16_t* gb = (const bf16_t*)(p.ws + WS_GBUF);
        bf16_t* O = (bf16_t*)(p.ws + WS_O);
        const float mu_r = p.in[10][c], mu_k = p.in[10][1024 + c], mu_v = p.in[10][2048 + c];
        const float k_k = p.in[19][c], k_a = p.in[20][c], r_k = p.in[21][c], ln_w = p.in[22][c], ln_b = p.in[23][c];
        float rcA[SPW + 1], kcA[SPW + 1], vcA[SPW + 1], rwlA[SPW], raA[SPW], rgA[SPW];
        float rcB[SPW + 1], kcB[SPW + 1], vcB[SPW + 1], rwlB[SPW], raB[SPW], rgB[SPW];
#define SCAN_LOAD(ci_, X) do { const int tb_ = (ci_) * TC + aw * SPW; const size_t m0_ = (size_t)b * SEQ + tb_; \
        _Pragma("unroll") for (int s_ = 0; s_ < SPW + 1; ++s_) { const bool ok_ = (tb_ + s_ - 1) >= 0; const size_t off_ = (m0_ + s_ - 1) * 1024 + c; \
            rc##X[s_] = ok_ ? bf2f(rb[off_]) : 0.f; kc##X[s_] = ok_ ? bf2f(kb[off_]) : 0.f; vc##X[s_] = ok_ ? bf2f(vb[off_]) : 0.f; } \
        _Pragma("unroll") for (int s_ = 0; s_ < SPW; ++s_) { const size_t off_ = (m0_ + s_) * 1024 + c; rwl##X[s_] = wl[off_]; ra##X[s_] = bf2f(ab[off_]); rg##X[s_] = bf2f(gb[off_]); } } while (0)
#define SCAN_PREP(ci_, X) do { float* V0_ = L + ((ci_) & 1) * SCAN_VEC_FLOATS; float* GB_ = L + SCAN_OFF_GB + ((ci_) & 1) * 2 * TC * 64; bf16_t* AV_ = (bf16_t*)(V0_ + 4 * TC * 64); \
        _Pragma("unroll") for (int s_ = 0; s_ < SPW; ++s_) { const int tl_ = aw * SPW + s_; \
            const float rr_ = rc##X[s_ + 1] + (rc##X[s_] - rc##X[s_ + 1]) * mu_r, kx_ = kc##X[s_ + 1] + (kc##X[s_] - kc##X[s_ + 1]) * mu_k, vv_ = vc##X[s_ + 1] + (vc##X[s_] - vc##X[s_ + 1]) * mu_v; \
            const float w_ = __builtin_amdgcn_exp2f(rwl##X[s_]), a_ = ra##X[s_]; \
            const float kkv_ = kx_ * k_k; const float n2_ = wave_sum_fast(kkv_ * kkv_); const float kkn_ = kkv_ * __builtin_amdgcn_rsqf(fmaxf(n2_, 1e-24f)); \
            const float kmod_ = kx_ * (1.0f + (a_ - 1.0f) * k_a); const float bb_ = kkn_ * a_; \
            const float bon_ = wave_sum_fast(rr_ * kmod_ * r_k), br_ = wave_sum_fast(bb_ * rr_), kr_ = wave_sum_fast(kmod_ * rr_); \
            V0_[tl_ * 64 + lane] = w_; V0_[TC * 64 + tl_ * 64 + lane] = bb_; V0_[2 * TC * 64 + tl_ * 64 + lane] = kmod_; V0_[3 * TC * 64 + tl_ * 64 + lane] = vv_; \
            AV_[tl_ * 128 + lane] = (bf16_t)f2bf(-kkn_); AV_[tl_ * 128 + 64 + lane] = (bf16_t)f2bf(w_ * rr_); \
            if (lane == 0) { V0_[5 * TC * 64 + 2 * tl_] = br_; V0_[5 * TC * 64 + 2 * tl_ + 1] = kr_; } \
            GB_[tl_ * 64 + lane] = rg##X[s_]; GB_[TC * 64 + tl_ * 64 + lane] = bon_ * vv_ * rg##X[s_]; } } while (0)
#define SCAN_POST(ci_) do { const float* Ys_ = L + SCAN_OFF_YS + ((ci_) & 1) * TC * 64; const float* GB_ = L + SCAN_OFF_GB + ((ci_) & 1) * 2 * TC * 64; \
        _Pragma("unroll") for (int s_ = 0; s_ < SPW; ++s_) { const int tl_ = aw * SPW + s_; const size_t m_ = (size_t)b * SEQ + (ci_) * TC + tl_; \
            const float y_ = Ys_[tl_ * 64 + lane]; const float mean_ = wave_sum_fast(y_) * (1.0f / 64.0f); const float d_ = y_ - mean_; const float var_ = wave_sum_fast(d_ * d_) * (1.0f / 64.0f); \
            const float yn_ = d_ * __builtin_amdgcn_rsqf(var_ + 64e-5f) * ln_w + ln_b; \
            O[m_ * DM + 1024 + c] = (bf16_t)f2bf(yn_ * GB_[tl_ * 64 + lane] + GB_[TC * 64 + tl_ * 64 + lane]); } } while (0)
        SCAN_LOAD(0, B); SCAN_LOAD(1, A); SCAN_PREP(0, B); SCAN_LOAD(2, B);
        __syncthreads();
        for (int ci = 0; ci < NC; ci += 2) {
            if (ci >= 1) SCAN_POST(ci - 1);
            SCAN_PREP(ci + 1, A); if (ci + 3 < NC) SCAN_LOAD(ci + 3, A);
            __syncthreads();
            SCAN_POST(ci);
            if (ci + 2 < NC) { SCAN_PREP(ci + 2, B); if (ci + 4 < NC) SCAN_LOAD(ci + 4, B); }
            __syncthreads();
        }
        SCAN_POST(NC - 1);
#undef SCAN_LOAD
#undef SCAN_PREP
#undef SCAN_POST
    }
    __syncthreads();
}

#include <hip/hip_bf16.h>
#include <cmath>
namespace attn_body {
using bf16=__hip_bfloat16;
using bf16x8=__attribute__((ext_vector_type(8)))short;
using s16x4=__attribute__((ext_vector_type(4)))short;
using f32x16=__attribute__((ext_vector_type(16)))float;
using u32x4=__attribute__((ext_vector_type(4)))unsigned;
constexpr int SEQ=2048,D=64,DM=1024;
constexpr int NW=8,QBLK=32,QB=QBLK*NW,KVBLK=64,NQB=SEQ/QB;
__device__ __forceinline__ int crow(int r,int hi){return (r&3)+8*(r>>2)+4*hi;}
#define SBAR() __builtin_amdgcn_sched_barrier(0)
__device__ __forceinline__ void cmask(f32x16&p0,f32x16&p1,int jb,int qrel,int hi){
  const float NEG=-INFINITY; int kb=64*jb+4*hi;
  #pragma unroll
  for(int r=0;r<16;++r){int kv=kb+(r&3)+8*(r>>2); if(kv>qrel)p0[r]=NEG; if(kv+32>qrel)p1[r]=NEG;}
}

constexpr int NSLOT=3, SLOTB=8192;
constexpr int LDS_K=0, LDS_V=NSLOT*SLOTB, LDS_WS=2*NSLOT*SLOTB, LDS_OST=LDS_WS+NW*64*4, LDS_BYTES=LDS_OST+NW*4096;
constexpr float C2=0.125f*1.4426950408889634f;
__device__ __forceinline__ void glds16(const void*gsrc,unsigned lds_dst){unsigned keep;
  asm volatile("s_mov_b32 %0, m0\n\ts_mov_b32 m0, %2\n\ts_nop 0\n\tglobal_load_lds_dwordx4 %1, off\n\ts_mov_b32 m0, %0":"=&s"(keep):"v"(gsrc),"s"(lds_dst):"memory");}
__device__ __forceinline__ float max3f(float a,float b,float c){float r;asm("v_max3_f32 %0, %1, %2, %3":"=v"(r):"v"(a),"v"(b),"v"(c));return r;}
__device__ __forceinline__ float max2f(float a,float b){float r;asm("v_max_f32_e32 %0, %1, %2":"=v"(r):"v"(a),"v"(b));return r;}
__device__ __forceinline__ float fadd_s(float a,float b){float r;asm("v_add_f32_e32 %0, %1, %2":"=v"(r):"v"(a),"v"(b));return r;}
__device__ __forceinline__ float fsub_s(float a,float b){float r;asm("v_sub_f32_e32 %0, %1, %2":"=v"(r):"v"(a),"v"(b));return r;}
typedef float f32x2_t __attribute__((ext_vector_type(2))); typedef __bf16 bf16x2_t __attribute__((ext_vector_type(2)));
__device__ __forceinline__ unsigned cvtpk_s(float lo,float hi){f32x2_t v={lo,hi};bf16x2_t b=__builtin_convertvector(v,bf16x2_t);return __builtin_bit_cast(unsigned,b);}
#define WAIT_BAR(N) asm volatile("s_waitcnt vmcnt(" #N ") lgkmcnt(0)\n\ts_barrier":::"memory")

__device__ __forceinline__ void qkt(f32x16&p0,f32x16&p1,const char*Kslot,const bf16x8*qr,const f32x16&negm,int r32,int hi){
  const char*kb=Kslot+hi*1024+r32*16;
  #pragma unroll
  for(int d0=0;d0<4;++d0){
    const bf16x8 b0=*reinterpret_cast<const bf16x8*>(kb+d0*2048);
    const bf16x8 b1=*reinterpret_cast<const bf16x8*>(kb+d0*2048+512);
    if(d0==0){p0=__builtin_amdgcn_mfma_f32_32x32x16_bf16(b0,qr[0],negm,0,0,0);p1=__builtin_amdgcn_mfma_f32_32x32x16_bf16(b1,qr[0],negm,0,0,0);}
    else{p0=__builtin_amdgcn_mfma_f32_32x32x16_bf16(b0,qr[d0],p0,0,0,0);p1=__builtin_amdgcn_mfma_f32_32x32x16_bf16(b1,qr[d0],p1,0,0,0);}}
}
typedef __attribute__((address_space(3))) const char* lds_cptr;
typedef short v4i16_t __attribute__((ext_vector_type(4)));
__device__ __forceinline__ void kload8(bf16x8*kf,lds_cptr kp){
  kf[0]=*(const __attribute__((address_space(3))) bf16x8*)(kp);      kf[1]=*(const __attribute__((address_space(3))) bf16x8*)(kp+512);
  kf[2]=*(const __attribute__((address_space(3))) bf16x8*)(kp+2048); kf[3]=*(const __attribute__((address_space(3))) bf16x8*)(kp+2560);
  kf[4]=*(const __attribute__((address_space(3))) bf16x8*)(kp+4096); kf[5]=*(const __attribute__((address_space(3))) bf16x8*)(kp+4608);
  kf[6]=*(const __attribute__((address_space(3))) bf16x8*)(kp+6144); kf[7]=*(const __attribute__((address_space(3))) bf16x8*)(kp+6656);
}
__device__ __forceinline__ void kload2(bf16x8*kf,lds_cptr kp,int j){ kf[2*j]=*(const __attribute__((address_space(3))) bf16x8*)(kp+j*2048); kf[2*j+1]=*(const __attribute__((address_space(3))) bf16x8*)(kp+j*2048+512); }
__device__ __forceinline__ s16x4 vtr(lds_cptr p){ return __builtin_bit_cast(s16x4,__builtin_amdgcn_ds_read_tr16_b64_v4i16((__attribute__((address_space(3))) v4i16_t*)p)); }
__device__ __forceinline__ float rowmax(const f32x16&p0,const f32x16&p1){
  float a=max3f(p0[0],p0[1],p1[0]),b=max3f(p0[2],p0[3],p1[1]);a=max3f(a,p1[2],p1[3]);
  #pragma unroll
  for(int r=4;r<16;r+=4){a=max3f(a,p0[r],p0[r+1]);b=max3f(b,p0[r+2],p0[r+3]);a=max3f(a,p1[r],p1[r+1]);b=max3f(b,p1[r+2],p1[r+3]);}
  const float m=max2f(a,b);
  auto rr=__builtin_amdgcn_permlane32_swap(__float_as_uint(m),__float_as_uint(m),false,false);
  return max2f(__uint_as_float(rr[0]),__uint_as_float(rr[1]));
}
__device__ __forceinline__ void pv(f32x16*o,int vb,bf16x8 pa0,bf16x8 pa1,bf16x8 pa2,bf16x8 pa3){
  #pragma unroll
  for(int d0=0;d0<2;++d0){s16x4 lo[4],hi[4];
    #pragma unroll
    for(int ks=0;ks<4;++ks){
      asm volatile("ds_read_b64_tr_b16 %0,%1 offset:%c2":"=&v"(lo[ks]):"v"(vb),"i"(d0*4096+ks*1024):"memory");
      asm volatile("ds_read_b64_tr_b16 %0,%1 offset:%c2":"=&v"(hi[ks]):"v"(vb),"i"(d0*4096+ks*1024+512):"memory");}
    asm volatile("s_waitcnt lgkmcnt(0)":::"memory");SBAR();
    #define PK(k) (bf16x8){lo[k][0],lo[k][1],lo[k][2],lo[k][3],hi[k][0],hi[k][1],hi[k][2],hi[k][3]}
    o[d0]=__builtin_amdgcn_mfma_f32_32x32x16_bf16(pa0,PK(0),o[d0],0,0,0);
    o[d0]=__builtin_amdgcn_mfma_f32_32x32x16_bf16(pa1,PK(1),o[d0],0,0,0);
    o[d0]=__builtin_amdgcn_mfma_f32_32x32x16_bf16(pa2,PK(2),o[d0],0,0,0);
    o[d0]=__builtin_amdgcn_mfma_f32_32x32x16_bf16(pa3,PK(3),o[d0],0,0,0);
    #undef PK
  }
}

#ifndef ATTN_STORE16
#define ATTN_STORE16(p,v) (*(u32x4*)(p)=(v))
#endif
template<int THRL> __device__ __forceinline__ void attn_unit(int b,int qkcol,int vcol,int qb,float slope2,const bf16*Q,const bf16*__restrict__ K,const bf16*__restrict__ V,bf16*O,char*shm){
  const int tid=opaque_tid(),lane=tid&63,r32=lane&31,hi=lane>>5; const int wid=__builtin_amdgcn_readfirstlane(tid>>6);
  const long rowbase=(long)b*SEQ; const int q0=qb*QB;
  const bf16*Qw=Q+(rowbase+q0+wid*QBLK)*DM+qkcol;
  const bf16*Kh=K+rowbase*DM+qkcol,*Vh=V+rowbase*DM+vcol;
  const unsigned lds0=(unsigned)(uintptr_t)shm;
  float*wsf=(float*)(shm+LDS_WS)+wid*64;
  const bf16*ksrc=Kh+(long)lane*DM+wid*8;
  const bf16*vsrc=Vh+(long)(16*(wid&3)+(lane>>2))*DM+(wid>>2)*32+(lane&3)*8;
  const unsigned kdst=lds0+LDS_K+wid*1024, vdst=lds0+LDS_V+wid*1024;
  #define DMA_K(t,slot) glds16(ksrc+(long)(t)*KVBLK*DM,(unsigned)__builtin_amdgcn_readfirstlane(kdst+(slot)))
  #define DMA_V(t,slot) glds16(vsrc+(long)(t)*KVBLK*DM,(unsigned)__builtin_amdgcn_readfirstlane(vdst+(slot)))
  const int vb0=(int)(lds0+LDS_V)+((lane>>4)&1)*32+(lane&3)*8+(4*hi+((lane&15)>>2))*64;
  const char*Kbase=shm+LDS_K; bf16x8 kf[8];
  const lds_cptr shm3=(lds_cptr)shm; const lds_cptr kp0=shm3+LDS_K+hi*1024+r32*16; const lds_cptr vp0=shm3+LDS_V+((lane>>4)&1)*32+(lane&3)*8+(4*hi+((lane&15)>>2))*64;
  const int NT=(q0+QB)/KVBLK;
  DMA_K(0,0);DMA_V(0,0);DMA_K(1,SLOTB);
  bf16x8 qr[4];
  #pragma unroll
  for(int d0=0;d0<4;++d0)qr[d0]=*reinterpret_cast<const bf16x8*>(&Qw[(long)r32*DM+d0*16+hi*8]);
  float mhat=0.f,l_reg=0.f;f32x16 o[2];o[0]=f32x16{};o[1]=f32x16{};const f32x16 negm=f32x16{};
  const int qrel=wid*QBLK+r32; float slope2v=slope2; asm volatile("":"+v"(slope2v));
  #define CMASK(P0,P1,t) do{int jb_=(t)-(NT-4); if(jb_>=0)cmask(P0,P1,jb_,qrel,hi);}while(0)
  #define ABIAS(P0,P1,t) do{ float kb_=slope2*(float)(64*(t)+4*hi)-mhat; asm volatile("":"+v"(kb_)); _Pragma("unroll") for(int r=0;r<16;++r){ P0[r]+=kb_; P1[r]+=kb_; } _Pragma("unroll") for(int r=0;r<16;++r){ const float cr_=(float)((r&3)+8*(r>>2)); P0[r]=__builtin_fmaf(slope2v,cr_,P0[r]); P1[r]=__builtin_fmaf(slope2v,cr_+32.f,P1[r]); } }while(0)
  bool resc=false;
  #define START(P0,P1) do{ const float rm=rowmax(P0,P1); resc=false; \
    { const float dl=rm; mhat=fadd_s(mhat,dl); \
      _Pragma("unroll") for(int r=0;r<16;++r){P0[r]=fsub_s(P0[r],dl);P1[r]=fsub_s(P1[r],dl);} \
      } \
    _Pragma("unroll") for(int r=0;r<16;++r)P0[r]=__builtin_amdgcn_exp2f(P0[r]); }while(0)
  #define RESC() do{ if(resc){ asm volatile("s_waitcnt lgkmcnt(0)":::"memory"); \
      _Pragma("unroll") for(int d_=0;d_<2;++d_) _Pragma("unroll") for(int r=0;r<16;++r)o[d_][r]*=wsf[crow(r,hi)]; } }while(0)
  f32x16 pA0,pA1,pB0,pB1;
  int sl_prev=0,sl_cur=0,sl_next=SLOTB;
  #define ROT() do{sl_prev=sl_cur;sl_cur=sl_next;sl_next=(sl_next==(NSLOT-1)*SLOTB)?0:sl_next+SLOTB;}while(0)
  DMA_K(2,2*SLOTB);
  WAIT_BAR(3);
  qkt(pA0,pA1,Kbase,qr,negm,r32,hi);asm volatile("s_nop 15\n\ts_nop 7":"+v"(pA0),"+v"(pA1));ABIAS(pA0,pA1,0);CMASK(pA0,pA1,0);
  START(pA0,pA1);
  _Pragma("unroll") for(int r=0;r<16;++r)pA1[r]=__builtin_amdgcn_exp2f(pA1[r]);
  WAIT_BAR(0);
  DMA_K(3,0);DMA_V(1,SLOTB);
  ROT();
  kload8(kf,kp0+sl_cur);
  WAIT_BAR(2);
  s16x4 vlo[8],vhi[8]; u32x4 pw0,pw1,pw2,pw3;
  #define PKW(P,B) cvtpk_s(P[B],P[B+1])
  #define PAF(k) __builtin_bit_cast(bf16x8,pw##k)
  #define VFR(i) (bf16x8){vlo[i][0],vlo[i][1],vlo[i][2],vlo[i][3],vhi[i][0],vhi[i][1],vhi[i][2],vhi[i][3]}
  #define PIN(x) asm volatile("":"+v"(x))
  #define MX3(a,b,c) __builtin_fmaxf(__builtin_fmaxf((a),(b)),(c))
  #define GAPA(MF,A0,A1,A2,A3,W0,W1,PW) do{ MF; sacc+=A0; sacc+=A1; sacc+=A2; sacc+=A3; PIN(sacc); W0; W1; PIN(PW); SBAR(); }while(0)
  #define EX(v) __builtin_amdgcn_exp2f(v)
  #define GAPB(MF,X,B) do{ MF; X[B]=EX(X[B]); X[B+1]=EX(X[B+1]); X[B+2]=EX(X[B+2]); X[B+3]=EX(X[B+3]); PIN(X); SBAR(); }while(0)
  #define VRD(i) do{ vlo[i]=vtr(vp_+(((i)>>2)*4096+((i)&3)*1024)); vhi[i]=vtr(vp_+(((i)>>2)*4096+((i)&3)*1024+512)); }while(0)
  #define KRD(G,j) do{ if(G){ kload2(kf,kp0+sl_next,j); SBAR(); } }while(0)
  #define STEP(C0,C1,P0,P1,t,GK,GV,GL) do{ SBAR(); \
    const lds_cptr vp_=vp0+sl_prev; \
    VRD(0); SBAR(); float sacc=(P0[0]+P0[1]); \
    GAPA(C0=__builtin_amdgcn_mfma_f32_32x32x16_bf16(kf[0],qr[0],negm,0,0,0), P0[2],P0[3],P0[4],P0[5],     pw0[0]=PKW(P0,0), pw0[1]=PKW(P0,2), pw0); \
    VRD(4); SBAR(); GAPA(C1=__builtin_amdgcn_mfma_f32_32x32x16_bf16(kf[1],qr[0],negm,0,0,0), P0[6],P0[7],P0[8],P0[9],     pw0[2]=PKW(P0,4), pw0[3]=PKW(P0,6), pw0); \
    VRD(1); SBAR(); GAPA(C0=__builtin_amdgcn_mfma_f32_32x32x16_bf16(kf[2],qr[1],C0,0,0,0),   P0[10],P0[11],P0[12],P0[13], pw1[0]=PKW(P0,8), pw1[1]=PKW(P0,10), pw1); \
    VRD(5); SBAR(); GAPA(C1=__builtin_amdgcn_mfma_f32_32x32x16_bf16(kf[3],qr[1],C1,0,0,0),   P0[14],P0[15],P1[0],P1[1],   pw1[2]=PKW(P0,12),pw1[3]=PKW(P0,14), pw1); \
    VRD(2); SBAR(); GAPA(C0=__builtin_amdgcn_mfma_f32_32x32x16_bf16(kf[4],qr[2],C0,0,0,0),   P1[2],P1[3],P1[4],P1[5],     pw2[0]=PKW(P1,0), pw2[1]=PKW(P1,2), pw2); \
    VRD(6); SBAR(); GAPA(C1=__builtin_amdgcn_mfma_f32_32x32x16_bf16(kf[5],qr[2],C1,0,0,0),   P1[6],P1[7],P1[8],P1[9],     pw2[2]=PKW(P1,4), pw2[3]=PKW(P1,6), pw2); \
    VRD(3); SBAR(); GAPA(C0=__builtin_amdgcn_mfma_f32_32x32x16_bf16(kf[6],qr[3],C0,0,0,0),   P1[10],P1[11],P1[12],P1[13], pw3[0]=PKW(P1,8), pw3[1]=PKW(P1,10), pw3); \
    VRD(7); SBAR(); GAPA(C1=__builtin_amdgcn_mfma_f32_32x32x16_bf16(kf[7],qr[3],C1,0,0,0),   P1[14],P1[15],0.f,0.f,       pw3[2]=PKW(P1,12),pw3[3]=PKW(P1,14), pw3); \
    l_reg+=sacc; \
    if(GK){DMA_K((t)+3,sl_cur);} if(GV){DMA_V((t)+1,sl_next);} \
    ABIAS(C0,C1,t); CMASK(C0,C1,t); \
    { float a=MX3(C0[0],C0[1],C1[0]),b=MX3(C0[2],C0[3],C1[1]); a=MX3(a,C1[2],C1[3]); \
      _Pragma("unroll") for(int r=4;r<16;r+=4){a=MX3(a,C0[r],C0[r+1]);b=MX3(b,C0[r+2],C0[r+3]);a=MX3(a,C1[r],C1[r+1]);b=MX3(b,C1[r+2],C1[r+3]);} \
      float rm=__builtin_fmaxf(a,b); { auto rr=__builtin_amdgcn_permlane32_swap(__float_as_uint(rm),__float_as_uint(rm),false,false); rm=__builtin_fmaxf(__uint_as_float(rr[0]),__uint_as_float(rr[1])); } \
      resc=false; \
      if(__builtin_expect(__any(rm>(float)THRL),0)){ const float dl=__builtin_fmaxf(rm,0.f); mhat+=dl; \
        _Pragma("unroll") for(int r=0;r<16;++r){C0[r]-=dl;C1[r]-=dl;} \
        const float f=__builtin_amdgcn_exp2f(-dl); l_reg*=f; if(hi==0)wsf[r32]=f; resc=true; } } \
    SBAR(); \
    GAPB(o[0]=__builtin_amdgcn_mfma_f32_32x32x16_bf16(PAF(0),VFR(0),o[0],0,0,0), C0,0); \
    GAPB(o[1]=__builtin_amdgcn_mfma_f32_32x32x16_bf16(PAF(0),VFR(4),o[1],0,0,0), C0,4); \
    KRD(GL,0); GAPB(o[0]=__builtin_amdgcn_mfma_f32_32x32x16_bf16(PAF(1),VFR(1),o[0],0,0,0), C0,8); \
    KRD(GL,1); GAPB(o[1]=__builtin_amdgcn_mfma_f32_32x32x16_bf16(PAF(1),VFR(5),o[1],0,0,0), C0,12); \
    KRD(GL,2); GAPB(o[0]=__builtin_amdgcn_mfma_f32_32x32x16_bf16(PAF(2),VFR(2),o[0],0,0,0), C1,0); \
    KRD(GL,3); GAPB(o[1]=__builtin_amdgcn_mfma_f32_32x32x16_bf16(PAF(2),VFR(6),o[1],0,0,0), C1,4); \
    GAPB(o[0]=__builtin_amdgcn_mfma_f32_32x32x16_bf16(PAF(3),VFR(3),o[0],0,0,0), C1,8); \
    GAPB(o[1]=__builtin_amdgcn_mfma_f32_32x32x16_bf16(PAF(3),VFR(7),o[1],0,0,0), C1,12); \
    }while(0)
  int t=1;
  #undef CMASK
  #define CMASK(P0,P1,t) do{}while(0)
  for(;t+5<NT;t+=2){
    STEP(pB0,pB1,pA0,pA1,t,true,true,true);     WAIT_BAR(2); RESC(); ROT();
    STEP(pA0,pA1,pB0,pB1,t+1,true,true,true);   WAIT_BAR(2); RESC(); ROT();
  }
  #undef CMASK
  #define CMASK(P0,P1,t) do{int jb_=(t)-(NT-4); if(jb_>=0)cmask(P0,P1,jb_,qrel,hi);}while(0)
  #define ENDW(tt) do{ if((tt)+3<NT){WAIT_BAR(2);} else if((tt)+2<NT){WAIT_BAR(1);} else {WAIT_BAR(0);} }while(0)
  for(;t+1<NT;t+=2){
    STEP(pB0,pB1,pA0,pA1,t,(t+3<NT),(t+1<NT),(t+1<NT));       ENDW(t);   RESC(); ROT();
    STEP(pA0,pA1,pB0,pB1,t+1,(t+4<NT),(t+2<NT),(t+2<NT));     ENDW(t+1); RESC(); ROT();
  }
  STEP(pB0,pB1,pA0,pA1,NT-1,false,false,false); RESC();
  { float sacc=pB0[0]+pB0[1]; _Pragma("unroll") for(int r=2;r<16;++r)sacc+=pB0[r]; _Pragma("unroll") for(int r=0;r<16;++r)sacc+=pB1[r]; l_reg+=sacc;
    pw0=(u32x4){PKW(pB0,0),PKW(pB0,2),PKW(pB0,4),PKW(pB0,6)};pw1=(u32x4){PKW(pB0,8),PKW(pB0,10),PKW(pB0,12),PKW(pB0,14)};pw2=(u32x4){PKW(pB1,0),PKW(pB1,2),PKW(pB1,4),PKW(pB1,6)};pw3=(u32x4){PKW(pB1,8),PKW(pB1,10),PKW(pB1,12),PKW(pB1,14)};
    SBAR(); pv(o,vb0+sl_cur,PAF(0),PAF(1),PAF(2),PAF(3)); }
  #undef PKW
  #undef PAF
  #undef VFR
  #undef PIN
  #undef MX3
  #undef GAPA
  #undef GAPB
  #undef EX
  #undef VRD
  #undef KRD
  #undef STEP
  #undef ENDW
  {auto rr=__builtin_amdgcn_permlane32_swap(__float_as_uint(l_reg),__float_as_uint(l_reg),false,false);l_reg=__uint_as_float(rr[0])+__uint_as_float(rr[1]);}
  int lane_e=lane; asm volatile("":"+v"(lane_e)); const int r32e=lane_e&31, hie=lane_e>>5;
  if(hie==0)wsf[32+r32e]=l_reg;asm volatile("s_waitcnt lgkmcnt(0)":::"memory");
  float rli[16];
  #pragma unroll
  for(int r=0;r<16;++r)rli[r]=__builtin_amdgcn_rcpf(wsf[32+crow(r,hie)]);
  bf16*Ow=O+(rowbase+q0+wid*QBLK)*DM+vcol;
  { bf16*stg=(bf16*)(shm+LDS_OST)+wid*2048;
    #pragma unroll
    for(int r=0;r<16;++r){const int orow=crow(r,hie);
      #pragma unroll
      for(int d0=0;d0<2;++d0)stg[orow*64+d0*32+r32e]=__float2bfloat16(o[d0][r]*rli[r]);}
    asm volatile("s_waitcnt lgkmcnt(0)":::"memory");
    #pragma unroll
    for(int i=0;i<4;++i){const int row=i*8+(lane_e>>3),ch=lane_e&7; const u32x4 v=*(const u32x4*)(stg+row*64+ch*8); ATTN_STORE16(Ow+(long)row*DM+ch*8,v);} }
  asm volatile("s_waitcnt lgkmcnt(0)\n\ts_barrier":::"memory");
  #undef DMA_K
  #undef DMA_V
  #undef CMASK
  #undef ABIAS
  #undef START
  #undef RESC
  #undef ROT
}
constexpr int ATTN_LDS_BYTES=LDS_BYTES;
#undef SBAR
#undef WAIT_BAR
}

__device__ __forceinline__ void attn_unit_ref(const Params& p, unsigned char* lds, int b, int h, int comp, int qb) {
    const int tid = opaque_tid(), row = tid & 255, dh = tid >> 8;
    float* Kt = (float*)lds; float* Vt = Kt + 64 * 64;
    const bf16_t* qbuf = (const bf16_t*)(p.ws + WS_INBUF); const bf16_t* kbuf = qbuf + (size_t)T * 1024; const bf16_t* vbuf = kbuf + (size_t)T * 1024;
    bf16_t* Op = (bf16_t*)(p.ws + WS_OPART) + (size_t)comp * T * 1024;
    const size_t rowbase = (size_t)b * SEQ; const int qpos = qb * 256 + row;
    float qv[64], o[64];
    { const bf16_t* qp = qbuf + (rowbase + qpos) * 1024 + h * 128 + comp * 64;
#pragma unroll
      for (int d = 0; d < 64; d += 8) { const u32x4 w = *(const u32x4*)(qp + d);
#pragma unroll
          for (int i = 0; i < 4; ++i) { qv[d + 2 * i] = bflo(w[i]); qv[d + 2 * i + 1] = bfhi(w[i]); } } }
#pragma unroll
    for (int d = 0; d < 64; ++d) o[d] = 0.f;
    float mrun = -1e30f, l = 0.f;
    const float slope2 = exp2f(-(float)(h + 1)) * LOG2E;
    const int ntile = (qb + 1) * 4;
    for (int kt = 0; kt < ntile; ++kt) {
        __syncthreads();
        for (int ch = tid; ch < 1536; ch += NTHREADS) { const int r = ch / 24, cc = ch % 24; const size_t grow = rowbase + kt * 64 + r;
            if (cc < 8) { const u32x4 w = *(const u32x4*)(kbuf + grow * 1024 + h * 128 + comp * 64 + cc * 8);
#pragma unroll
                for (int i = 0; i < 4; ++i) { Kt[r * 64 + cc * 8 + 2 * i] = bflo(w[i]); Kt[r * 64 + cc * 8 + 2 * i + 1] = bfhi(w[i]); } }
            else { const int c2 = cc - 8; const u32x4 w = *(const u32x4*)(vbuf + grow * 1024 + h * 128 + c2 * 8);
#pragma unroll
                for (int i = 0; i < 4; ++i) { Vt[r * 128 + c2 * 8 + 2 * i] = bflo(w[i]); Vt[r * 128 + c2 * 8 + 2 * i + 1] = bfhi(w[i]); } } }
        __syncthreads();
        for (int j = 0; j < 64; ++j) {
            const int kpos = kt * 64 + j; if (kpos > qpos) break;
            float s = 0.f;
#pragma unroll
            for (int d = 0; d < 64; d += 4) { const f32x4 kv = *(const f32x4*)(Kt + j * 64 + d); s += qv[d] * kv[0] + qv[d + 1] * kv[1] + qv[d + 2] * kv[2] + qv[d + 3] * kv[3]; }
            s += slope2 * (float)kpos;
            if (s > mrun) { const float f = exp2f(mrun - s); l *= f;
#pragma unroll
                for (int d = 0; d < 64; ++d) o[d] *= f;
                mrun = s; }
            const float pr = exp2f(s - mrun); l += pr;
#pragma unroll
            for (int d = 0; d < 64; d += 4) { const f32x4 vv = *(const f32x4*)(Vt + j * 128 + dh * 64 + d); o[d] += pr * vv[0]; o[d + 1] += pr * vv[1]; o[d + 2] += pr * vv[2]; o[d + 3] += pr * vv[3]; }
        }
    }
    const float il = 1.0f / l;
    bf16_t* op = Op + (rowbase + qpos) * 1024 + h * 128 + dh * 64;
#pragma unroll
    for (int d = 0; d < 64; d += 8) { u32x4 w; w.x = pk2(o[d] * il, o[d + 1] * il); w.y = pk2(o[d + 2] * il, o[d + 3] * il); w.z = pk2(o[d + 4] * il, o[d + 5] * il); w.w = pk2(o[d + 6] * il, o[d + 7] * il); *(u32x4*)(op + d) = w; }
    __syncthreads();
}

__device__ __forceinline__ void attn_phase_queue(const Params& p, unsigned char* lds, unsigned* qctr) {
    const attn_body::bf16* Q = (const attn_body::bf16*)(p.ws + WS_INBUF); const attn_body::bf16* K = Q + (size_t)T * 1024; const attn_body::bf16* V = K + (size_t)T * 1024;
    attn_body::bf16* OP = (attn_body::bf16*)(p.ws + WS_OPART);
    volatile int* slot = (volatile int*)(lds + LDS_BYTES - 64);
    for (;;) {
        __syncthreads();
        if (threadIdx.x == 0) *slot = (int)atomicAdd(qctr, 1u);
        __syncthreads();
        const int u = __builtin_amdgcn_readfirstlane(*slot);
        if (u >= 2048) break;
        const int qb = 7 - (u >> 8), id = u & 255;
        const int vh = id & 1, comp = (id >> 1) & 1, h = (id >> 2) & 7, b = id >> 5;
        const float slope2 = exp2f(-(float)(h + 1)) * LOG2E;
        attn_body::attn_unit<8>(b, h * 128 + comp * 64, h * 128 + vh * 64, qb, slope2, Q, K, V, OP + (size_t)comp * T * 1024, (char*)lds);
    }
}

__device__ __forceinline__ void phase_combine(const Params& p) {
    const int tid = opaque_tid(), lane = tid & 63, wave = tid >> 6;
    const int gw = blockIdx.x * NWAVES + wave, NGW = gridDim.x * NWAVES;
    const float s1 = wave_sum(p.in[4][lane] * p.in[5][lane]), s2 = wave_sum(p.in[6][lane] * p.in[7][lane]);
    const float lam = __expf(s1) - __expf(s2) + 0.2f;
    const bf16_t* O0 = (const bf16_t*)(p.ws + WS_OPART); const bf16_t* O1 = O0 + (size_t)T * 1024; bf16_t* O = (bf16_t*)(p.ws + WS_O);
    const float* sg = p.in[8] + (lane & 7) * 16;
    for (int m = gw; m < T; m += NGW) {
        const u32x4 a0 = *(const u32x4*)(O0 + (size_t)m * 1024 + lane * 16), a1 = *(const u32x4*)(O0 + (size_t)m * 1024 + lane * 16 + 8);
        const u32x4 c0 = *(const u32x4*)(O1 + (size_t)m * 1024 + lane * 16), c1 = *(const u32x4*)(O1 + (size_t)m * 1024 + lane * 16 + 8);
        float d[16]; float ss = 0.f;
#pragma unroll
        for (int i = 0; i < 4; ++i) { d[2 * i] = bflo(a0[i]) - lam * bflo(c0[i]); d[2 * i + 1] = bfhi(a0[i]) - lam * bfhi(c0[i]); d[8 + 2 * i] = bflo(a1[i]) - lam * bflo(c1[i]); d[8 + 2 * i + 1] = bfhi(a1[i]) - lam * bfhi(c1[i]); }
#pragma unroll
        for (int i = 0; i < 16; ++i) ss += d[i] * d[i];
        ss += __shfl_xor(ss, 1); ss += __shfl_xor(ss, 2); ss += __shfl_xor(ss, 4);
        const float rs = 0.8f / sqrtf(ss * (1.0f / 128.0f) + 1e-6f);
        u32x4 w0, w1;
        w0.x = pk2(d[0] * rs * sg[0], d[1] * rs * sg[1]); w0.y = pk2(d[2] * rs * sg[2], d[3] * rs * sg[3]); w0.z = pk2(d[4] * rs * sg[4], d[5] * rs * sg[5]); w0.w = pk2(d[6] * rs * sg[6], d[7] * rs * sg[7]);
        w1.x = pk2(d[8] * rs * sg[8], d[9] * rs * sg[9]); w1.y = pk2(d[10] * rs * sg[10], d[11] * rs * sg[11]); w1.z = pk2(d[12] * rs * sg[12], d[13] * rs * sg[13]); w1.w = pk2(d[14] * rs * sg[14], d[15] * rs * sg[15]);
        *(u32x4*)(O + (size_t)m * DM + lane * 16) = w0; *(u32x4*)(O + (size_t)m * DM + lane * 16 + 8) = w1;
    }
}

__device__ __forceinline__ void phase_router(const Params& p, unsigned char* lds, bool dry = false) {
    const int tid = opaque_tid(), lane = tid & 63, wave = tid >> 6, fr = lane & 15, fq = lane >> 4;
    float* part = (float*)lds;
    const bf16_t* hb = (const bf16_t*)(p.ws + WS_HB);
    const bf16_t* whi = (const bf16_t*)(p.ws + WS_WRT); const bf16_t* wlo = whi + 48 * 2048;
    const float* ss2 = (const float*)(p.ws + WS_CTL + CTL_SS2); float* rstd2 = (float*)(p.ws + WS_RSTD2);
    unsigned* cnt = (unsigned*)(p.ws + WS_CTL + CTL_CNT); int* rt = (int*)(p.ws + WS_RT); float* gateb = (float*)(p.ws + WS_GATEB); int* tokinfo = (int*)(p.ws + WS_TOKINFO);
    const int mt = wave & 3, kh = wave >> 2;
    for (int tb = blockIdx.x; tb < T / 64; tb += gridDim.x) {
        const int tok0 = tb * 64;
        const bf16_t* hrow = hb + (size_t)(tok0 + mt * 16 + fr) * DM + kh * 1024 + fq * 8;
        const bf16_t* bh = whi + (size_t)fr * DM + kh * 1024 + fq * 8; const bf16_t* bl = wlo + (size_t)fr * DM + kh * 1024 + fq * 8;
        f32x4 acc[3];
#pragma unroll
        for (int i = 0; i < 3; ++i) acc[i] = (f32x4){0.f, 0.f, 0.f, 0.f};
#pragma unroll 4
        for (int ks = 0; ks < 32; ++ks) {
            const bf16x8 ahi = *(const bf16x8*)(hrow + ks * 32);
#pragma unroll
            for (int nt = 0; nt < 3; ++nt) {
                const bf16x8 bhi = *(const bf16x8*)(bh + (size_t)nt * 16 * DM + ks * 32), blo = *(const bf16x8*)(bl + (size_t)nt * 16 * DM + ks * 32);
                acc[nt] = __builtin_amdgcn_mfma_f32_16x16x32_bf16(ahi, bhi, acc[nt], 0, 0, 0);
                acc[nt] = __builtin_amdgcn_mfma_f32_16x16x32_bf16(ahi, blo, acc[nt], 0, 0, 0);
            }
        }
#pragma unroll
        for (int nt = 0; nt < 3; ++nt)
#pragma unroll
            for (int r = 0; r < 4; ++r) part[(kh * 64 + mt * 16 + fq * 4 + r) * 48 + nt * 16 + fr] = acc[nt][r];
        __syncthreads();
        if (tid < 64 && !dry) {
            const float* l0 = part + tid * 48; const float* l1 = part + (64 + tid) * 48;
            const int t = tok0 + tid; const float rs = 1.0f / sqrtf(ss2[t] * (1.0f / DM) + 1e-6f); rstd2[t] = rs;
            float g4[4]; int grp = 0; float gmax = -3.0e38f;
#pragma unroll
            for (int i = 0; i < 4; ++i) { g4[i] = (l0[i] + l1[i]) * rs + p.in[26][i]; if (g4[i] > gmax) { gmax = g4[i]; grp = i; } }
            float gs = 0.f;
#pragma unroll
            for (int i = 0; i < 4; ++i) gs += __expf(g4[i] - gmax);
            const float pg = 1.0f / gs;
            float e8[8]; int i0 = 0; float m0 = -3.0e38f;
#pragma unroll
            for (int i = 0; i < 8; ++i) { e8[i] = (l0[4 + grp * 8 + i] + l1[4 + grp * 8 + i]) * rs + p.in[28][grp * 8 + i]; if (e8[i] > m0) { m0 = e8[i]; i0 = i; } }
            int i1 = 0; float m1 = -3.0e38f;
#pragma unroll
            for (int i = 0; i < 8; ++i) if (i != i0 && e8[i] > m1) { m1 = e8[i]; i1 = i; }
            const float p1 = __expf(m1 - m0); const float g0 = pg / (1.0f + p1), g1 = pg * p1 / (1.0f + p1);
            const int e0 = grp * 8 + i0, e1 = grp * 8 + i1;
            const unsigned r0 = atomicAdd(cnt + e0, 1u), r1 = atomicAdd(cnt + e1, 1u);
            rt[(size_t)e0 * CAP + r0] = t; rt[(size_t)e1 * CAP + r1] = t; gateb[(size_t)e0 * CAP + r0] = g0; gateb[(size_t)e1 * CAP + r1] = g1;
            int4 ti; ti.x = e0 * CAP + (int)r0; ti.y = e1 * CAP + (int)r1; ti.z = 0; ti.w = 0; *(int4*)(tokinfo + (size_t)t * 4) = ti;
        }
        __syncthreads();
    }
}

__device__ __forceinline__ void phase_final(const Params& p, unsigned char* lds, float* dst) {
    const int tid = opaque_tid(), lane = tid & 63, wave = tid >> 6;
    const int gw = blockIdx.x * NWAVES + wave, NGW = gridDim.x * NWAVES;
    int* pst = (int*)lds;
    const unsigned* cnt = (const unsigned*)(p.ws + WS_CTL + CTL_CNT);
    if (tid == 0) { int ts = 0; for (int e = 0; e < NEXP; ++e) { pst[e] = ts; ts += ((int)cnt[e] + 255) >> 8; } }
    __syncthreads();
    const int* tokinfo = (const int*)(p.ws + WS_TOKINFO); const bf16_t* yb = (const bf16_t*)(p.ws + WS_YB); const bf16_t* hbuf = (const bf16_t*)(p.ws + WS_HB); const float* gfin = p.in[32];
    for (int m = gw; m < T; m += NGW) {
        const int4 ti = *(const int4*)(tokinfo + (size_t)m * 4);
        const int e0 = ti.x / CAP, r0 = ti.x % CAP, e1 = ti.y / CAP, r1 = ti.y % CAP;
        const size_t s0 = (size_t)pst[e0] * 256 + r0, s1 = (size_t)pst[e1] * 256 + r1;
        const u32x2* hr = (const u32x2*)(hbuf + (size_t)m * DM) + lane; const u32x2* y0 = (const u32x2*)(yb + s0 * DM) + lane; const u32x2* y1 = (const u32x2*)(yb + s1 * DM) + lane;
        f32x4 v[8]; float s = 0.f;
#pragma unroll
        for (int j = 0; j < 8; ++j) { const u32x2 hh = hr[64 * j]; v[j] = (f32x4){bflo(hh.x), bfhi(hh.x), bflo(hh.y), bfhi(hh.y)}; const u32x2 a = y0[64 * j], b2 = y1[64 * j];
            v[j][0] += bflo(a.x) + bflo(b2.x); v[j][1] += bfhi(a.x) + bfhi(b2.x); v[j][2] += bflo(a.y) + bflo(b2.y); v[j][3] += bfhi(a.y) + bfhi(b2.y);
            s += (v[j][0] * v[j][0] + v[j][1] * v[j][1]) + (v[j][2] * v[j][2] + v[j][3] * v[j][3]); }
        s = wave_sum(s); const float rs = 1.0f / sqrtf(s * (1.0f / DM) + 1e-6f);
#pragma unroll
        for (int j = 0; j < 8; ++j) { const f32x4 gv = *((const f32x4*)gfin + lane + 64 * j); ((f32x4*)(dst + (size_t)m * DM) + lane)[64 * j] = v[j] * rs * gv; }
    }
}

#define GAS __attribute__((address_space(1)))
typedef GAS unsigned gu32;
#define RLX_AGENT __ATOMIC_RELAXED, __HIP_MEMORY_SCOPE_AGENT
#define XB_TMO      128
#define XB_XCNT(j)  (256  + 64 * (j))
#define XB_XSUB(j)  (1280 + 64 * (j))
#define XB_XGEN(j)  (2304 + 64 * (j))
#define XB_TOP      3328
#define XB_TOPGEN   3392
#define XCD_BAR_WORDS 3456
#define XB_SPIN_CAP (1u << 18)

__device__ __forceinline__ unsigned xb_ld(unsigned* p)              { return __hip_atomic_load(p, __ATOMIC_RELAXED, __HIP_MEMORY_SCOPE_AGENT); }
__device__ __forceinline__ unsigned xb_add(unsigned* p, unsigned v) { return __hip_atomic_fetch_add(p, v, __ATOMIC_RELAXED, __HIP_MEMORY_SCOPE_AGENT); }
__device__ __forceinline__ unsigned xb_xcc_id() { return (unsigned)__builtin_amdgcn_s_getreg((3 << 11) | 20) & 0xFu; }
#define XB_SPIN(cond, bar) do { unsigned _sp = 0; while (cond) { __builtin_amdgcn_s_sleep(1); \
    if ((++_sp & 255u) == 0u) { if (xb_ld(&(bar)[XB_TMO])) break; if (_sp > XB_SPIN_CAP) { atomicAdd(&(bar)[XB_TMO], 1u); break; } } } } while (0)

struct XcdBarrier {
    unsigned* bar; unsigned x;
    volatile LAS unsigned* st;
};

__device__ __forceinline__ XcdBarrier xcd_barrier_post(unsigned* bar, volatile LAS unsigned* st) {
    XcdBarrier b; b.bar = bar; b.x = xb_xcc_id(); b.st = st;
    if (threadIdx.x == 0) (void)xb_add(&bar[XB_XCNT(b.x)], 1u);
    return b;
}
__device__ __forceinline__ void xcd_barrier_complete(unsigned* bar, unsigned x, unsigned& nloc, unsigned& nx) {
    const unsigned G = gridDim.x * gridDim.y * gridDim.z;
    unsigned sum, cnt, mine, sp = 0u;
    for (;;) {
        sum = 0u; cnt = 0u; mine = 0u;
#pragma unroll
        for (unsigned j = 0; j < 16; ++j) { const unsigned c = xb_ld(&bar[XB_XCNT(j)]); sum += c; cnt += (c > 0u) ? 1u : 0u; mine = (j == x) ? c : mine; }
        if (sum == G) break;
        __builtin_amdgcn_s_sleep(1);
        if ((++sp & 255u) == 0u) { if (xb_ld(&bar[XB_TMO])) break; if (sp > XB_SPIN_CAP) { atomicAdd(&bar[XB_TMO], 1u); break; } }
    }
    nloc = mine > 0u ? mine : 1u; nx = cnt > 0u ? cnt : 1u;
}

__device__ __forceinline__ void xcd_barrier(const XcdBarrier& b) {
    asm volatile("s_waitcnt vmcnt(0)" ::: "memory");
    __syncthreads();
    if (threadIdx.x == 0) {
        unsigned* bar = b.bar;
        __builtin_amdgcn_s_waitcnt(0);
        unsigned nloc = b.st[0], nx = b.st[1];
        if (nloc == 0u) { xcd_barrier_complete(bar, b.x, nloc, nx); b.st[0] = nloc; b.st[1] = nx; }
        const unsigned old = xb_add(&bar[XB_XSUB(b.x)], 1u);
        const unsigned gen = old / nloc;
        if (old + 1u == (gen + 1u) * nloc) {
            __builtin_amdgcn_fence(__ATOMIC_RELEASE, "agent");
            asm volatile("s_waitcnt vmcnt(0)" ::: "memory");
            const unsigned og = xb_add(&bar[XB_TOP], 1u);
            const unsigned tg = og / nx;
            if (og + 1u == (tg + 1u) * nx) xb_add(&bar[XB_TOPGEN], 1u);
            else XB_SPIN(xb_ld(&bar[XB_TOPGEN]) == tg, bar);
            __builtin_amdgcn_fence(__ATOMIC_ACQUIRE, "agent");
            xb_add(&bar[XB_XGEN(b.x)], 1u);
            asm volatile("s_waitcnt vmcnt(0)" ::: "memory");
        } else {
            XB_SPIN(xb_ld(&bar[XB_XGEN(b.x)]) == gen, bar);
            __builtin_amdgcn_fence(__ATOMIC_ACQUIRE, "agent");
            asm volatile("s_waitcnt vmcnt(0)" ::: "memory");
        }
    }
    __syncthreads();
}


#if USE_REF_GEMM
#define GEMM_PHASE gemm_phase_ref
#else
#define GEMM_PHASE gemm_phase_mfma
#endif

__global__ void __launch_bounds__(NTHREADS, 2) fwd_kernel(Params p) {
    extern __shared__ __attribute__((aligned(16))) unsigned char lds[];
    unsigned char* ws = p.ws;
    const int lo = p.ph_lo, hi = p.ph_hi;
#define IN(k) (lo <= (k) && (k) < hi)
#if N_LAUNCH_MODE == 1
    volatile LAS unsigned* bst = (volatile LAS unsigned*)((LAS unsigned char*)lds + LDS_BYTES - 32);
    if (threadIdx.x < 2) bst[threadIdx.x] = 0u;
    __syncthreads();
    const XcdBarrier bar = xcd_barrier_post((unsigned*)(ws + WS_CTL + CTL_BAR), bst);
#define SEAM(k) do { if (IN(k) && IN((k) + 1)) xcd_barrier(bar); } while (0)
#else
#define SEAM(k) do { } while (0)
#endif
    if (IN(PH_PRO)) { phase_prologue(p, lds); if (PROBE_DUP & 8) { __syncthreads(); phase_prologue(p, lds); } } SEAM(PH_PRO);
    if (IN(PH_INPROJ)) {
        Gemm g{(const bf16_t*)(ws + WS_XB), (const bf16_t*)(ws + WS_WIN), DM, DM, DM};
        DenseOrder S; S.init(T, NIN, gridDim.x, blockIdx.x, DM, DM);
        EpiIn E{(bf16_t*)(ws + WS_INBUF), (bf16_t*)(ws + WS_PBUF), (const float*)(ws + WS_RSTD1)};
        GEMM_PHASE<EpiIn, DenseOrder>(lds, g, S, E);
        if (PROBE_DUP & 64) GEMM_PHASE<EpiIn, DenseOrder>(lds, g, S, E);
    } SEAM(PH_INPROJ);
    if (IN(PH_L2PREP)) { phase_l2prep(p); if (PROBE_DUP & 4096) { phase_l2prep(p); phase_l2prep(p); phase_l2prep(p); } } SEAM(PH_L2PREP);
    if (IN(PH_L2GEMM)) {
        Gemm g{(const bf16_t*)(ws + WS_A2), (const bf16_t*)(ws + WS_L2T), PW, 256, 256};
        DenseOrder S; S.init(T, 3072, gridDim.x, blockIdx.x, PW, 256, 2, 256);
        EpiL2 E{(float*)(ws + WS_WL), (bf16_t*)(ws + WS_ABUF), (bf16_t*)(ws + WS_GBUF), p.in[11], p.in[14]};
        GEMM_PHASE<EpiL2, DenseOrder>(lds, g, S, E);
        if (PROBE_DUP & 16384) GEMM_PHASE<EpiL2, DenseOrder>(lds, g, S, E);
    } SEAM(PH_L2GEMM);
    if (IN(PH_MIX)) {
        for (int rep = 0; rep < ((PROBE_DUP & 1) ? 2 : 1); ++rep)
        if ((blockIdx.x & 1) == 0) for (int chain = blockIdx.x >> 1; chain < BATCH * NH_RW; chain += (gridDim.x + 1) >> 1) rwkv_chain(p, lds, chain);
        attn_phase_queue(p, lds, (unsigned*)(ws + WS_CTL + CTL_QCTR));
        if (PROBE_DUP & 2) attn_phase_queue(p, lds, (unsigned*)(ws + WS_CTL + CTL_QCTR) + 1);
    } SEAM(PH_MIX);
    if (IN(PH_COMB)) { phase_combine(p); if (PROBE_DUP & 2048) { phase_combine(p); phase_combine(p); phase_combine(p); } } SEAM(PH_COMB);
    if (IN(PH_OUT)) {
        Gemm g{(const bf16_t*)(ws + WS_O), (const bf16_t*)(ws + WS_WOUT), DM, DM, DM};
        DenseOrder S; S.init(T, DM, gridDim.x, blockIdx.x, DM, DM);
        EpiOut E{p.in[0], p.out, (bf16_t*)(ws + WS_HB), (float*)(ws + WS_CTL + CTL_SS2)};
        GEMM_PHASE<EpiOut, DenseOrder>(lds, g, S, E);
        if (PROBE_DUP & 8192) { EpiOut E2{p.in[0], p.out, (bf16_t*)(ws + WS_HB), (float*)(ws + WS_RSTD1)}; GEMM_PHASE<EpiOut, DenseOrder>(lds, g, S, E2); }
    } SEAM(PH_OUT);
    if (IN(PH_ROUTE)) { if (PROBE_DUP & 1024) { phase_router(p, lds, true); __syncthreads(); } phase_router(p, lds); convert_experts(p, lds); if (PROBE_DUP & 16) { __syncthreads(); convert_experts(p, lds); } } SEAM(PH_ROUTE);
    if (IN(PH_G1)) {
        Gemm g{(const bf16_t*)(ws + WS_HB), (const bf16_t*)(ws + WS_WGU), DM, DM, DM};
        MoeOrder<true> S{(const unsigned*)(ws + WS_CTL + CTL_CNT), (const int*)(ws + WS_RT), 4, (int)gridDim.x, (int)blockIdx.x, 0, DM, (long)1024 * 2048, DM};
        EpiGU E{(bf16_t*)(ws + WS_HID), (const float*)(ws + WS_RSTD2)};
        GEMM_PHASE<EpiGU, MoeOrder<true>>(lds, g, S, E);
        if (PROBE_DUP & 128) GEMM_PHASE<EpiGU, MoeOrder<true>>(lds, g, S, E);
    } SEAM(PH_G1);
    if (IN(PH_G2)) {
        Gemm g{(const bf16_t*)(ws + WS_HID), (const bf16_t*)(ws + WS_WD), DEXP, DEXP, DEXP};
        MoeOrder<false> S{(const unsigned*)(ws + WS_CTL + CTL_CNT), (const int*)(ws + WS_RT), 8, (int)gridDim.x, (int)blockIdx.x, 1, DEXP, (long)2048 * 512, DEXP};
        EpiDown E{(bf16_t*)(ws + WS_YB), (const float*)(ws + WS_GATEB), (const unsigned*)(ws + WS_CTL + CTL_CNT)};
        GEMM_PHASE<EpiDown, MoeOrder<false>>(lds, g, S, E);
        if (PROBE_DUP & 256) GEMM_PHASE<EpiDown, MoeOrder<false>>(lds, g, S, E);
    } SEAM(PH_G2);
    if (IN(PH_FINAL)) { if (PROBE_DUP & 32768) { phase_final(p, lds, (float*)(ws + WS_XB)); __syncthreads(); } phase_final(p, lds, p.out); }
}

extern "C" void kernel_launch(void* const* d_in, const int* in_sizes, int n_in, void* d_out, int out_size, void* d_ws, size_t ws_size, hipStream_t stream) {
    static int grid = 0;
    if (grid == 0) {
        if (n_in != 33 || out_size != T * DM || ws_size < WS_END) { fprintf(stderr, "kernel_launch: unexpected problem (n_in %d out %d ws %zu)\n", n_in, out_size, ws_size); grid = -1; return; }
        int dev = 0, cus = 0;
        hipGetDevice(&dev); hipDeviceGetAttribute(&cus, hipDeviceAttributeMultiprocessorCount, dev);
        if (hipFuncSetAttribute((const void*)fwd_kernel, hipFuncAttributeMaxDynamicSharedMemorySize, LDS_BYTES) != hipSuccess) { fprintf(stderr, "kernel_launch: hipFuncSetAttribute failed\n"); grid = -1; return; }
        int per_cu = 0; hipOccupancyMaxActiveBlocksPerMultiprocessor(&per_cu, (const void*)fwd_kernel, NTHREADS, LDS_BYTES); (void)hipGetLastError();
        if (per_cu < 1) fprintf(stderr, "kernel_launch: occupancy query says %d blocks per CU\n", per_cu);
        if (per_cu < 1) { grid = -1; return; }
        grid = cus > 0 ? cus : 256;
    }
    if (grid < 0) return;
    hipMemsetAsync((char*)d_ws + WS_CTL, 0, CTL_BYTES, stream);
    Params p{};
    for (int i = 0; i < 33; ++i) p.in[i] = (const float*)d_in[i];
    p.out = (float*)d_out; p.ws = (unsigned char*)d_ws;
#if N_LAUNCH_MODE == 1
    p.ph_lo = 0; p.ph_hi = PH_COUNT;
    void* args[] = {&p};
    hipError_t e = hipLaunchCooperativeKernel((const void*)fwd_kernel, dim3(grid), dim3(NTHREADS), args, LDS_BYTES, stream);
    if (e != hipSuccess) fprintf(stderr, "cooperative launch failed: %s (grid %d)\n", hipGetErrorString(e), grid);
#else
    for (int ph = 0; ph < PH_COUNT; ++ph) { p.ph_lo = ph; p.ph_hi = ph + 1; hipLaunchKernelGGL(fwd_kernel, dim3(grid), dim3(NTHREADS), LDS_BYTES, stream, p); }
#endif
}
```

```cpp
#include <hip/hip_runtime.h>
#include <hip/hip_cooperative_groups.h>
#include <cstdio>
#include <cstdint>
namespace cg = cooperative_groups;

#ifndef N_LAUNCH_MODE
#define N_LAUNCH_MODE 1
#endif
#ifndef PROBE_TS_A
#define PROBE_TS_A -1
#define PROBE_TS_B -1
#endif
#ifndef PROBE_DUP
#define PROBE_DUP 0
#endif
#ifndef USE_REF_ATTN
#define USE_REF_ATTN 0
#endif
#ifndef USE_REF_GEMM
#define USE_REF_GEMM 0
#endif

constexpr int BATCH = 8, SEQ = 2048, DM = 2048, T = BATCH * SEQ;
constexpr int DAW = 1024, RWW = 1024, NH_DA = 8, NH_RW = 16;
constexpr int NIN = 6912;
constexpr int PW = 768;
constexpr int NEXP = 32, DEXP = 512, CAP = T;
constexpr int MAXTILES = 160;
constexpr float C2Q = 0.125f * 1.4426950408889634f;
constexpr float LOG2E = 1.4426950408889634f;

constexpr size_t MiB = 1u << 20;
constexpr size_t WS_CTL = 0, CTL_BYTES = 1 * MiB;
constexpr size_t CTL_SS2 = 65536;
constexpr size_t CTL_CNT = 131072;
constexpr size_t CTL_QCTR = 131072 + 256;
constexpr size_t CTL_NRM = 131072 + 1024;
constexpr size_t CTL_TS = 131072 + 512;
constexpr size_t CTL_BAR = 262144;
constexpr size_t WS_WOUT = 1 * MiB;
constexpr size_t WS_L2T = 9 * MiB;
constexpr size_t WS_RSTD1 = 11 * MiB;
constexpr size_t WS_RSTD2 = 11 * MiB + 65536;
constexpr size_t WS_TOKINFO = 11 * MiB + 131072;
constexpr size_t WS_WRT = 11 * MiB + 524288;
constexpr size_t WS_WIN = 12 * MiB;
constexpr size_t WS_XB = 40 * MiB;
constexpr size_t WS_O = 40 * MiB;
constexpr size_t WS_INBUF = 104 * MiB;
constexpr size_t WS_PBUF = 296 * MiB;
constexpr size_t WS_A2 = 320 * MiB;
constexpr size_t WS_WL = 344 * MiB;
constexpr size_t WS_ABUF = 408 * MiB;
constexpr size_t WS_GBUF = 440 * MiB;
constexpr size_t WS_OPART = 472 * MiB;
constexpr size_t WS_HB = 104 * MiB;
constexpr size_t WS_WGU = 168 * MiB;
constexpr size_t WS_WD = 168 * MiB;
__host__ __device__ constexpr size_t wd_byte_off(int e) { return 168 * MiB + (size_t)e * 2 * MiB; }
constexpr int NEXP_EARLY = 28;
__host__ __device__ constexpr size_t wgu_byte_off(int e) { return e < 6 ? (12 * MiB + (size_t)e * 4 * MiB) : e < 18 ? (296 * MiB + (size_t)(e - 6) * 4 * MiB) : e < 28 ? (536 * MiB + (size_t)(e - 18) * 4 * MiB) : (232 * MiB + (size_t)(e - 28) * 4 * MiB); }
constexpr size_t WS_RT = 360 * MiB;
constexpr size_t WS_GATEB = 362 * MiB;
constexpr size_t WS_HID = 364 * MiB;
constexpr size_t WS_YB = 404 * MiB;
constexpr size_t WS_END = 576 * MiB;

constexpr int NTHREADS = 512, NWAVES = 8;
constexpr int LDS_BYTES = 147456;

typedef unsigned short bf16_t;
typedef short bf16x8 __attribute__((ext_vector_type(8)));
typedef float f32x4 __attribute__((ext_vector_type(4)));
typedef float f32x2 __attribute__((ext_vector_type(2)));
typedef unsigned u32x4 __attribute__((ext_vector_type(4)));
typedef unsigned u32x2 __attribute__((ext_vector_type(2)));

__device__ __forceinline__ unsigned f2bf(float f) { unsigned u = __builtin_bit_cast(unsigned, f); return (u + 0x7fffu + ((u >> 16) & 1u)) >> 16; }
typedef __bf16 bf16x2_n __attribute__((ext_vector_type(2)));
__device__ __forceinline__ unsigned cvt_pk_bf16_(float lo, float hi) { const f32x2 v = {lo, hi}; const bf16x2_n b = __builtin_convertvector(v, bf16x2_n); return __builtin_bit_cast(unsigned, b); }
__device__ __forceinline__ unsigned pk2(float lo, float hi) { return cvt_pk_bf16_(lo, hi); }
__device__ __forceinline__ float bf2f(unsigned h) { return __builtin_bit_cast(float, h << 16); }
__device__ __forceinline__ float bflo(unsigned w) { return __builtin_bit_cast(float, w << 16); }
__device__ __forceinline__ float bfhi(unsigned w) { return __builtin_bit_cast(float, w & 0xffff0000u); }
__device__ __forceinline__ float wave_sum(float v) {
#pragma unroll
    for (int o = 1; o < 64; o <<= 1) v += __shfl_xor(v, o);
    return v;
}
__device__ __forceinline__ int opaque_tid() { int t = threadIdx.x; asm volatile("" : "+v"(t)); return t; }
__device__ __forceinline__ float sigmoidf_(float x) { return __builtin_amdgcn_rcpf(1.0f + __builtin_amdgcn_exp2f(-1.4426950408889634f * x)); }

struct Params {
    const float* in[33];
    float* out;
    unsigned char* ws;
    int ph_lo, ph_hi;
    unsigned long long ws_mib;
};

enum { PH_PRO = 0, PH_INPROJ, PH_L2PREP, PH_L2GEMM, PH_MIX, PH_COMB, PH_OUT, PH_ROUTE, PH_G1, PH_G2, PH_FINAL, PH_COUNT };

struct Unit { int pm, pn; long a_off, b_off; const int* gidx; int valid, e, tile, k; };
struct Gemm { const bf16_t* A; const bf16_t* Bt; int lda, ldb, K; };

struct DenseOrder {
    static constexpr bool GATHER = false;
    int nM, nN, nwg, G, c, lda, ldb, acol_shift, acol_w;
    __device__ void init(int M, int N, int G_, int c_, int lda_, int ldb_, int acol_shift_ = -1, int acol_w_ = 0) {
        nM = M / 256; nN = N / 256; nwg = nM * nN; G = G_; c = c_; lda = lda_; ldb = ldb_; acol_shift = acol_shift_; acol_w = acol_w_; }
    __device__ bool next(int i, Unit& u) const {
        const long L = (long)i * G + c; if (L >= nwg) return false;
        int wgid = (int)L; { const int q = nwg / 8, r = nwg % 8, xcd = wgid % 8, off = wgid / 8; wgid = (xcd < r ? xcd * (q + 1) : r * (q + 1) + (xcd - r) * q) + off; }
        const int nig = 8 * nN, gid = wgid / nig, fm = gid * 8, gsz = (nM - fm) < 8 ? (nM - fm) : 8;
        u.pm = fm + ((wgid % nig) % gsz); u.pn = (wgid % nig) / gsz;
        u.a_off = (long)u.pm * 256 * lda + (acol_shift >= 0 ? (long)(u.pn >> acol_shift) * acol_w : 0);
        u.b_off = (long)u.pn * 256 * ldb; u.gidx = nullptr; u.valid = 256; u.e = 0; u.tile = 0; u.k = 0; return true;
    }
};
template <bool GATHER_> struct MoeOrder {
    static constexpr bool GATHER = GATHER_;
    const int* rt; int ncol, G, c, mode; long a_ld, b_estride, b_ld;
    int my_cnt, my_ts, ntot;
    __device__ __forceinline__ void init(const unsigned* cnt) {
        const int lane = threadIdx.x & 63, e = lane & 31;
        my_cnt = (int)cnt[e]; const int nt = (my_cnt + 255) >> 8;
        int incl = nt;
#pragma unroll
        for (int o = 1; o < 32; o <<= 1) { const int v = __shfl_up(incl, o, 32); if (e >= o) incl += v; }
        my_ts = incl - nt; ntot = __builtin_amdgcn_readlane(incl, 31);
    }
    __device__ __forceinline__ bool next(int i, Unit& u) const {
        const long L = (long)i * G + c; const int g = (int)(L / ncol), pn = (int)(L % ncol);
        if (g >= ntot) return false;
        const unsigned long long m = __ballot(my_ts <= g) & 0xffffffffull;
        const int e = 63 - __builtin_clzll(m);
        const int ts = __builtin_amdgcn_readlane(my_ts, e), ce = __builtin_amdgcn_readlane(my_cnt, e), k = g - ts;
        u.pm = g; u.pn = pn; u.e = e; u.tile = g; u.k = k; u.valid = (ce - 256 * k) < 256 ? (ce - 256 * k) : 256;
        if (mode == 0) { u.gidx = rt + (long)e * CAP + 256 * k; u.a_off = 0; }
        else { u.gidx = nullptr; u.a_off = (long)g * 256 * a_ld; }
        u.b_off = (long)((mode == 1 ? wd_byte_off(e) : wgu_byte_off(e)) / 2) + (long)pn * 256 * b_ld; return true;
    }
};

template <class Epi, class Sched>
__device__ __forceinline__ void gemm_phase_ref(unsigned char* lds, const Gemm g, const Sched& S, const Epi& E) {
    const int tid = threadIdx.x, wid = tid >> 6, lane = tid & 63, wr = wid >> 2, wc = wid & 3, fr = lane & 15, fq = lane >> 4;
    bf16_t* As = (bf16_t*)lds; bf16_t* Bs = As + 256 * 72;
    Unit u;
    for (int ui = 0; S.next(ui, u); ++ui) {
        f32x4 acc[2][2][4][2];
#pragma unroll
        for (int a = 0; a < 2; ++a)
#pragma unroll
            for (int b = 0; b < 2; ++b)
#pragma unroll
                for (int m = 0; m < 4; ++m)
#pragma unroll
                    for (int n = 0; n < 2; ++n) acc[a][b][m][n] = (f32x4){0.f, 0.f, 0.f, 0.f};
        long arow[4];
#pragma unroll
        for (int i = 0; i < 4; ++i) { const int row = (tid + 512 * i) >> 3; arow[i] = u.gidx ? (row < u.valid ? (long)u.gidx[row] : 0L) : (long)row; }
        for (int k0 = 0; k0 < g.K; k0 += 64) {
            __syncthreads();
#pragma unroll
            for (int i = 0; i < 4; ++i) { const int ch = tid + 512 * i, row = ch >> 3, c8 = ch & 7;
                const u32x4 va = *(const u32x4*)(g.A + u.a_off + arow[i] * g.lda + k0 + c8 * 8);
                const u32x4 vb = *(const u32x4*)(g.Bt + u.b_off + (long)row * g.ldb + k0 + c8 * 8);
                *(u32x4*)(As + row * 72 + c8 * 8) = va; *(u32x4*)(Bs + row * 72 + c8 * 8) = vb; }
            __syncthreads();
            for (int kk = 0; kk < 64; ++kk) {
                float a[2][4];
#pragma unroll
                for (int ai = 0; ai < 2; ++ai)
#pragma unroll
                    for (int m = 0; m < 4; ++m) a[ai][m] = bf2f(As[(ai * 128 + wr * 64 + m * 16 + fr) * 72 + kk]);
#pragma unroll
                for (int bj = 0; bj < 2; ++bj)
#pragma unroll
                    for (int n = 0; n < 2; ++n)
#pragma unroll
                        for (int e = 0; e < 4; ++e) {
                            const int cl = Epi::PERM ? (bj * 128 + wc * 32 + 8 * fq + 4 * n + e) : (bj * 128 + wc * 32 + 16 * n + 4 * fq + e);
                            const float b = bf2f(Bs[cl * 72 + kk]);
#pragma unroll
                            for (int ai = 0; ai < 2; ++ai)
#pragma unroll
                                for (int m = 0; m < 4; ++m) acc[ai][bj][m][n][e] += a[ai][m] * b;
                        }
            }
        }
        E(acc, u, wr, wc, fr, fq);
    }
    __syncthreads();
}


#define LAS __attribute__((address_space(3)))
namespace pg8 {
constexpr int BK = 64, HALF = 128, HTB = HALF * BK * 2, STAGE_BYTES = 8 * HTB;
__device__ __forceinline__ int lds_byte(int r, int c) { const int st = (r >> 4) * 2 + (c >> 5), rr = r & 15, cc = c & 31, ob = rr * 64 + cc * 2; return st * 1024 + (ob ^ (((ob >> 9) & 1) << 5)); }
__device__ __forceinline__ void stage_rc(int b, int& R, int& C) { const int st = b / 1024, sb = b % 1024, swz = sb ^ (((sb >> 9) & 1) << 5); R = (st >> 1) * 16 + swz / 64; C = (st & 1) * 32 + (swz % 64) / 2; }
__device__ __forceinline__ int perm32(int rho) { const int n = rho >> 4, i = rho & 15; return 8 * (i >> 2) + 4 * n + (i & 3); }
template <bool GATHER>
__device__ __forceinline__ void unit_voffA(const Unit& u, int lda, int tid, unsigned (&v0)[2], unsigned (&v1)[2]) {
#pragma unroll
    for (int i = 0; i < 2; ++i) { int R, C; stage_rc(tid * 16 + i * 8192, R, C); int r0 = R, r1 = R + HALF;
        if (GATHER) { const int a = (r0 < u.valid) ? u.gidx[r0] : 0, b = (r1 < u.valid) ? u.gidx[r1] : 0; r0 = a; r1 = b; }
        v0[i] = (unsigned)(r0 * lda + C) * 2u; v1[i] = (unsigned)(r1 * lda + C) * 2u; }
}
template <class Epi, class Sched, bool ALIGN_EPI = true>
__device__ __forceinline__ void gemm_phase(LAS unsigned char* lds, const Gemm g, const Sched& S, const Epi& E) {
    const int tid = threadIdx.x, wid = __builtin_amdgcn_readfirstlane(tid >> 6), lane = tid & 63, wr = wid >> 2, wc = wid & 3, fr = lane & 15, fq = lane >> 4;
    const int K = g.K, nt = K / BK;
    constexpr bool GATHER = Sched::GATHER;
    unsigned voffB[2];
#pragma unroll
    for (int i = 0; i < 2; ++i) { int R, C; stage_rc(tid * 16 + i * 8192, R, C); const int Rb = Epi::PERM ? ((R & ~31) + perm32(R & 31)) : R; voffB[i] = (unsigned)(Rb * g.ldb + C) * 2u; }
    const size_t hstepA = (size_t)HALF * g.lda * 2;
    const size_t kstep = (size_t)(BK * 2);
    const size_t hstepB = (size_t)HALF * g.ldb * 2;
    const unsigned ldsw = (unsigned)wid * 1024u;
    const int aoff = lds_byte(wr * 64 + fr, fq * 8), boff = lds_byte(wc * 32 + fr, fq * 8);
#define PG8_SA(b, h) (((b) * 2 + (h)) * HTB)
#define PG8_SB(b, h) ((4 + (b) * 2 + (h)) * HTB)
#define PG8_STAGE(bufoff, gbase, voff) do { _Pragma("unroll") for (int _i = 0; _i < 2; ++_i) \
        __builtin_amdgcn_global_load_lds((const unsigned*)((const char*)(gbase) + (voff)[_i]), (LAS unsigned*)(lds + (bufoff) + ldsw + _i * 8192), 16, 0, 0); } while (0)
#define PG8_LDA(dst, b, h) do { _Pragma("unroll") for (int m = 0; m < 4; ++m) _Pragma("unroll") for (int k = 0; k < 2; ++k) dst[m][k] = *(const LAS bf16x8*)(lds + PG8_SA(b, h) + aoff + m * 2048 + k * 1024); } while (0)
#define PG8_LDB(dst, b, h) do { _Pragma("unroll") for (int n = 0; n < 2; ++n) _Pragma("unroll") for (int k = 0; k < 2; ++k) dst[n][k] = *(const LAS bf16x8*)(lds + PG8_SB(b, h) + boff + n * 2048 + k * 1024); } while (0)
#define PG8_MMA(ai, bj, At, Bt) do { __builtin_amdgcn_s_setprio(1); _Pragma("unroll") for (int m = 0; m < 4; ++m) _Pragma("unroll") for (int n = 0; n < 2; ++n) _Pragma("unroll") for (int k = 0; k < 2; ++k) \
        acc[ai][bj][m][n] = __builtin_amdgcn_mfma_f32_16x16x32_bf16(Bt[n][k], At[m][k], acc[ai][bj][m][n], 0, 0, 0); __builtin_amdgcn_s_setprio(0); } while (0)
#define PG8_WAIT_V(n) asm volatile("s_waitcnt vmcnt(" #n ")" ::: "memory")
#define PG8_WAIT_L(n) asm volatile("s_waitcnt lgkmcnt(" #n ")" ::: "memory")
#define PG8_BAR __builtin_amdgcn_s_barrier()
#define PG8_SCHED __builtin_amdgcn_sched_barrier(0)
    Unit cur, nxt; int ui = 0;
    if (!S.next(0, cur)) return;
    f32x4 acc[2][2][4][2];
#pragma unroll
    for (int a = 0; a < 2; ++a)
#pragma unroll
        for (int b = 0; b < 2; ++b)
#pragma unroll
            for (int m = 0; m < 4; ++m)
#pragma unroll
                for (int n = 0; n < 2; ++n) acc[a][b][m][n] = (f32x4){0.f, 0.f, 0.f, 0.f};
    bf16x8 At[4][2], B0[2][2], B1[2][2];
    const char* cA = (const char*)(g.A + cur.a_off); const char* cB = (const char*)(g.Bt + cur.b_off);
    unsigned vA0[2], vA1[2], nA0[2], nA1[2];
    unit_voffA<GATHER>(cur, g.lda, tid, vA0, vA1);
#define PG8_STAGE_A(bufoff, gbase, h, sel) do { if constexpr (GATHER) { if (sel) { if ((h) == 0) PG8_STAGE(bufoff, gbase, nA0); else PG8_STAGE(bufoff, gbase, nA1); } else { if ((h) == 0) PG8_STAGE(bufoff, gbase, vA0); else PG8_STAGE(bufoff, gbase, vA1); } } \
        else { PG8_STAGE(bufoff, (gbase) + ((h) ? hstepA : (size_t)0), vA0); } } while (0)
    PG8_STAGE(PG8_SB(0, 0), cB, voffB); PG8_STAGE(PG8_SB(0, 1), cB + hstepB, voffB); PG8_STAGE_A(PG8_SA(0, 0), cA, 0, false); PG8_STAGE_A(PG8_SA(0, 1), cA, 1, false);
    if (wr == 1) PG8_BAR;
    PG8_WAIT_V(2); PG8_BAR;
    PG8_STAGE(PG8_SB(1, 0), cB + kstep, voffB); PG8_STAGE_A(PG8_SA(1, 0), cA + kstep, 0, false); PG8_STAGE(PG8_SB(1, 1), cB + hstepB + kstep, voffB);
    PG8_WAIT_V(6); PG8_BAR;
    for (;;) {
        const bool has_next = S.next(ui + 1, nxt);
        const char* nA = has_next ? (const char*)(g.A + nxt.a_off) : cA; const char* nB = has_next ? (const char*)(g.Bt + nxt.b_off) : cB;
        if constexpr (GATHER) { if (has_next) unit_voffA<true>(nxt, g.lda, tid, nA0, nA1); else { nA0[0] = vA0[0]; nA0[1] = vA0[1]; nA1[0] = vA1[0]; nA1[1] = vA1[1]; } }
        for (int t = 0; t < nt; t += 2) {
            const bool last = (t == nt - 2);
            const char* a1 = cA + (size_t)(t + 1) * kstep;
            const char* a2 = last ? nA : cA + (size_t)(t + 2) * kstep; const char* b2 = last ? nB : cB + (size_t)(t + 2) * kstep;
            const char* a3 = a2 + kstep; const char* b3 = b2 + kstep;
            PG8_LDB(B0, 0, 0); PG8_LDB(B1, 0, 1); PG8_SCHED; PG8_LDA(At, 0, 0); PG8_STAGE_A(PG8_SA(1, 1), a1, 1, false);
            PG8_WAIT_V(8); PG8_WAIT_L(0); PG8_BAR; PG8_MMA(0, 0, At, B0); PG8_MMA(0, 1, At, B1); PG8_BAR; PG8_SCHED;
            PG8_LDA(At, 0, 1); PG8_STAGE(PG8_SB(0, 0), b2, voffB); PG8_STAGE(PG8_SB(0, 1), b2 + hstepB, voffB); PG8_STAGE_A(PG8_SA(0, 0), a2, 0, last);
            PG8_WAIT_V(8); PG8_WAIT_L(0); PG8_BAR; PG8_MMA(1, 0, At, B0); PG8_MMA(1, 1, At, B1); PG8_BAR; PG8_SCHED;
            PG8_LDB(B0, 1, 0); PG8_LDB(B1, 1, 1); PG8_SCHED; PG8_LDA(At, 1, 0); PG8_STAGE_A(PG8_SA(0, 1), a2, 1, last);
            PG8_WAIT_V(8); PG8_WAIT_L(0); PG8_BAR; PG8_MMA(0, 0, At, B0); PG8_MMA(0, 1, At, B1); PG8_BAR; PG8_SCHED;
            PG8_LDA(At, 1, 1); PG8_STAGE(PG8_SB(1, 0), b3, voffB); PG8_STAGE(PG8_SB(1, 1), b3 + hstepB, voffB); PG8_STAGE_A(PG8_SA(1, 0), a3, 0, last);
            PG8_WAIT_V(8); PG8_WAIT_L(0); PG8_BAR; PG8_MMA(1, 0, At, B0); PG8_MMA(1, 1, At, B1); PG8_BAR; PG8_SCHED;
        }
        if constexpr (ALIGN_EPI) { if (wr == 0) PG8_BAR; }
        E(acc, cur, wr, wc, fr, fq);
        if (!has_next) break;
#pragma unroll
        for (int a = 0; a < 2; ++a)
#pragma unroll
            for (int b = 0; b < 2; ++b)
#pragma unroll
                for (int m = 0; m < 4; ++m)
#pragma unroll
                    for (int n = 0; n < 2; ++n) acc[a][b][m][n] = (f32x4){0.f, 0.f, 0.f, 0.f};
        cur = nxt; cA = nA; cB = nB; ++ui;
        if constexpr (GATHER) { vA0[0] = nA0[0]; vA0[1] = nA0[1]; vA1[0] = nA1[0]; vA1[1] = nA1[1]; }
        if constexpr (ALIGN_EPI) { if (wr == 1) PG8_BAR; }
    }
    PG8_WAIT_V(0);
    if constexpr (!ALIGN_EPI) { if (wr == 0) PG8_BAR; }
    PG8_BAR;
#undef PG8_SA
#undef PG8_SB
#undef PG8_STAGE
#undef PG8_STAGE_A
#undef PG8_LDA
#undef PG8_LDB
#undef PG8_MMA
#undef PG8_WAIT_V
#undef PG8_WAIT_L
#undef PG8_BAR
#undef PG8_SCHED
}
}
template <class Epi, class Sched>
__device__ __forceinline__ void gemm_phase_mfma(unsigned char* lds, const Gemm g, const Sched& S, const Epi& E) { pg8::gemm_phase<Epi, Sched, true>((LAS unsigned char*)lds, g, S, E); __syncthreads(); }

__device__ __forceinline__ u32x4 pack8(const f32x4 v0, const f32x4 v1) { u32x4 w; w.x = pk2(v0[0], v0[1]); w.y = pk2(v0[2], v0[3]); w.z = pk2(v1[0], v1[1]); w.w = pk2(v1[2], v1[3]); return w; }

struct EpiIn {
    static constexpr bool PERM = true;
    bf16_t* inbuf; bf16_t* pbuf; const float* rstd1; unsigned* nrm;
    __device__ __forceinline__ void operator()(const f32x4 (&acc)[2][2][4][2], const Unit& u, int wr, int wc, int fr_, int fq_) const {
        int fr = fr_, fq = fq_; asm volatile("" : "+v"(fr), "+v"(fq));
        bf16_t* base; int ldc, colt; float sc0 = 1.f;
        if (u.pn < 24) { base = inbuf + (size_t)(u.pn >> 2) * T * 1024; ldc = 1024; colt = (u.pn & 3) * 256; if (u.pn < 4) sc0 = C2Q; }
        else { base = pbuf; ldc = PW; colt = (u.pn - 24) * 256; }
        const int row0 = u.pm * 256 + wr * 64 + fr, col0 = colt + wc * 32 + 8 * fq;
        float rs[2][4];
#pragma unroll
        for (int ai = 0; ai < 2; ++ai)
#pragma unroll
            for (int m = 0; m < 4; ++m) rs[ai][m] = rstd1[row0 + ai * 128 + m * 16];
#pragma unroll
        for (int ai = 0; ai < 2; ++ai)
#pragma unroll
            for (int m = 0; m < 4; ++m) { const int row = row0 + ai * 128 + m * 16; const float r = rs[ai][m] * sc0; bf16_t* rowp = base + (size_t)row * ldc + col0;
#pragma unroll
                for (int bj = 0; bj < 2; ++bj) *(u32x4*)(rowp + bj * 128) = pack8(acc[ai][bj][m][0] * r, acc[ai][bj][m][1] * r); }
        if (u.pn < 8) {
            float mx[2] = {0.f, 0.f};
#pragma unroll
            for (int ai = 0; ai < 2; ++ai)
#pragma unroll
                for (int m = 0; m < 4; ++m) { const float r = rs[ai][m] * sc0;
#pragma unroll
                    for (int bj = 0; bj < 2; ++bj) { const f32x4 v0 = acc[ai][bj][m][0] * r, v1 = acc[ai][bj][m][1] * r;
                        float ssq = (v0[0] * v0[0] + v0[1] * v0[1]) + (v0[2] * v0[2] + v0[3] * v0[3]) + (v1[0] * v1[0] + v1[1] * v1[1]) + (v1[2] * v1[2] + v1[3] * v1[3]);
                        ssq += __shfl_xor(ssq, 16); ssq += __shfl_xor(ssq, 32); mx[bj] = fmaxf(mx[bj], ssq); } }
#pragma unroll
            for (int bj = 0; bj < 2; ++bj) { float v = mx[bj]; v = fmaxf(v, __shfl_xor(v, 1)); v = fmaxf(v, __shfl_xor(v, 2)); v = fmaxf(v, __shfl_xor(v, 4)); v = fmaxf(v, __shfl_xor(v, 8));
                if (fr == 0 && fq == 0) { const int bb = u.pm >> 3, hh = (u.pn & 3) * 2 + bj, cc = wc >> 1; atomicMax(nrm + (u.pn >= 4 ? 512 : 0) + ((bb * 8 + hh) * 2 + cc) * 2 + (wc & 1), __float_as_uint(v)); } }
        }
    }
};
struct EpiL2 {
    static constexpr bool PERM = true;
    float* wl; bf16_t* abuf; bf16_t* gbuf; const float* w0; const float* a0;
    __device__ __forceinline__ void operator()(const f32x4 (&acc)[2][2][4][2], const Unit& u, int wr, int wc, int fr_, int fq_) const {
        int fr = fr_, fq = fq_; asm volatile("" : "+v"(fr), "+v"(fq));
        const int grp = u.pn >> 2, colt = (u.pn & 3) * 256;
        const int row0 = u.pm * 256 + wr * 64 + fr, col0 = colt + wc * 32 + 8 * fq;
        if (grp == 0) {
#pragma unroll
            for (int bj = 0; bj < 2; ++bj) { const int c = col0 + bj * 128; const f32x4 b0 = *(const f32x4*)(w0 + c), b1 = *(const f32x4*)(w0 + c + 4);
#pragma unroll
                for (int ai = 0; ai < 2; ++ai)
#pragma unroll
                    for (int m = 0; m < 4; ++m) { const int row = row0 + ai * 128 + m * 16; f32x4 v0 = acc[ai][bj][m][0] + b0, v1 = acc[ai][bj][m][1] + b1;
#pragma unroll
                        for (int e = 0; e < 4; ++e) { v0[e] = -0.60653065971f * LOG2E * sigmoidf_(v0[e]); v1[e] = -0.60653065971f * LOG2E * sigmoidf_(v1[e]); }
                        float* p = wl + (size_t)row * 1024 + c; *(f32x4*)p = v0; *(f32x4*)(p + 4) = v1; asm volatile("" ::: "memory"); __builtin_amdgcn_sched_barrier(0); } }
        } else if (grp == 1) {
#pragma unroll
            for (int bj = 0; bj < 2; ++bj) { const int c = col0 + bj * 128; const f32x4 b0 = *(const f32x4*)(a0 + c), b1 = *(const f32x4*)(a0 + c + 4);
#pragma unroll
                for (int ai = 0; ai < 2; ++ai)
#pragma unroll
                    for (int m = 0; m < 4; ++m) { const int row = row0 + ai * 128 + m * 16; f32x4 v0 = acc[ai][bj][m][0] + b0, v1 = acc[ai][bj][m][1] + b1;
#pragma unroll
                        for (int e = 0; e < 4; ++e) { v0[e] = sigmoidf_(v0[e]); v1[e] = sigmoidf_(v1[e]); }
                        *(u32x4*)(abuf + (size_t)row * 1024 + c) = pack8(v0, v1); asm volatile("" ::: "memory"); __builtin_amdgcn_sched_barrier(0); } }
        } else {
#pragma unroll
            for (int bj = 0; bj < 2; ++bj) { const int c = col0 + bj * 128;
#pragma unroll
                for (int ai = 0; ai < 2; ++ai)
#pragma unroll
                    for (int m = 0; m < 4; ++m) { const int row = row0 + ai * 128 + m * 16; *(u32x4*)(gbuf + (size_t)row * 1024 + c) = pack8(acc[ai][bj][m][0], acc[ai][bj][m][1]); } }
        }
    }
};
struct EpiOut {
    static constexpr bool PERM = true;
    const float* x; float* h; bf16_t* hb; float* ss2;
    __device__ __forceinline__ void operator()(const f32x4 (&acc)[2][2][4][2], const Unit& u, int wr, int wc, int fr_, int fq_) const {
        int fr = fr_, fq = fq_; asm volatile("" : "+v"(fr), "+v"(fq));
        const int row0 = u.pm * 256 + wr * 64 + fr, col0 = u.pn * 256 + wc * 32 + 8 * fq;
#pragma unroll
        for (int ai = 0; ai < 2; ++ai) {
            f32x4 xv[4][2][2];
#pragma unroll
            for (int m = 0; m < 4; ++m)
#pragma unroll
                for (int bj = 0; bj < 2; ++bj) { const size_t off = (size_t)(row0 + ai * 128 + m * 16) * DM + col0 + bj * 128; xv[m][bj][0] = *(const f32x4*)(x + off); xv[m][bj][1] = *(const f32x4*)(x + off + 4); }
#pragma unroll
            for (int m = 0; m < 4; ++m) { const int row = row0 + ai * 128 + m * 16; float ss = 0.f;
#pragma unroll
                for (int bj = 0; bj < 2; ++bj) { const size_t off = (size_t)row * DM + col0 + bj * 128;
                    const f32x4 v0 = acc[ai][bj][m][0] + xv[m][bj][0], v1 = acc[ai][bj][m][1] + xv[m][bj][1];
                    *(u32x4*)(hb + off) = pack8(v0, v1);
                    ss += (v0[0] * v0[0] + v0[1] * v0[1]) + (v0[2] * v0[2] + v0[3] * v0[3]) + (v1[0] * v1[0] + v1[1] * v1[1]) + (v1[2] * v1[2] + v1[3] * v1[3]); }
                ss += __shfl_xor(ss, 16); ss += __shfl_xor(ss, 32);
                if (fq == 0) atomicAdd(ss2 + row, ss); }
        }
    }
};
struct EpiGU {
    static constexpr bool PERM = true;
    bf16_t* hid; const float* rstd2;
    __device__ __forceinline__ void operator()(const f32x4 (&acc)[2][2][4][2], const Unit& u, int wr, int wc, int fr_, int fq_) const {
        int fr = fr_, fq = fq_; asm volatile("" : "+v"(fr), "+v"(fq));
        const int col0 = u.pn * 128 + wc * 32 + 8 * fq;
        int tok[2][4]; float rsv[2][4];
#pragma unroll
        for (int ai = 0; ai < 2; ++ai)
#pragma unroll
            for (int m = 0; m < 4; ++m) { const int rl = ai * 128 + wr * 64 + m * 16 + fr; tok[ai][m] = (rl < u.valid) ? u.gidx[rl] : 0; }
#pragma unroll
        for (int ai = 0; ai < 2; ++ai)
#pragma unroll
            for (int m = 0; m < 4; ++m) rsv[ai][m] = rstd2[tok[ai][m]];
#pragma unroll
        for (int ai = 0; ai < 2; ++ai)
#pragma unroll
            for (int m = 0; m < 4; ++m) { const int rl = ai * 128 + wr * 64 + m * 16 + fr; const float rs = rsv[ai][m];
                f32x4 o0, o1;
#pragma unroll
                for (int e = 0; e < 4; ++e) { const float g0 = acc[ai][0][m][0][e] * rs, u0 = acc[ai][1][m][0][e] * rs, g1 = acc[ai][0][m][1][e] * rs, u1 = acc[ai][1][m][1][e] * rs;
                    o0[e] = g0 * sigmoidf_(g0) * u0; o1[e] = g1 * sigmoidf_(g1) * u1; }
                *(u32x4*)(hid + ((size_t)u.tile * 256 + rl) * DEXP + col0) = pack8(o0, o1); asm volatile("" ::: "memory"); __builtin_amdgcn_sched_barrier(0); }
    }
};
struct EpiDown {
    static constexpr bool PERM = true;
    bf16_t* yb; const float* gateb; const unsigned* cnt;
    __device__ __forceinline__ void operator()(const f32x4 (&acc)[2][2][4][2], const Unit& u, int wr, int wc, int fr_, int fq_) const {
        int fr = fr_, fq = fq_; asm volatile("" : "+v"(fr), "+v"(fq));
        const int col0 = u.pn * 256 + wc * 32 + 8 * fq;
        const int k = u.k;
        float gtv[2][4];
#pragma unroll
        for (int ai = 0; ai < 2; ++ai)
#pragma unroll
            for (int m = 0; m < 4; ++m) { const int rl = ai * 128 + wr * 64 + m * 16 + fr; gtv[ai][m] = (rl < u.valid) ? gateb[(size_t)u.e * CAP + 256 * k + rl] : 0.f; }
#pragma unroll
        for (int ai = 0; ai < 2; ++ai)
#pragma unroll
            for (int m = 0; m < 4; ++m) { const int rl = ai * 128 + wr * 64 + m * 16 + fr; const float gt = gtv[ai][m];
#pragma unroll
                for (int bj = 0; bj < 2; ++bj) *(u32x4*)(yb + ((size_t)u.tile * 256 + rl) * DM + col0 + bj * 128) = pack8(acc[ai][bj][m][0] * gt, acc[ai][bj][m][1] * gt); }
    }
};

__device__ __forceinline__ void tr_load64(f32x4 (&v)[16], const float* W, int ldw, int Kvalid, int Nvalid, int k0, int n0, int lane) {
    const int c4 = lane & 15, rq = lane >> 4; const bool ncol_ok = (n0 + 4 * c4) < Nvalid;
#pragma unroll
    for (int i = 0; i < 16; ++i) { const int k = k0 + 4 * i + rq; v[i] = (f32x4){0.f, 0.f, 0.f, 0.f};
        if (k < Kvalid && ncol_ok) v[i] = *(const f32x4*)(W + (size_t)k * ldw + n0 + 4 * c4); }
}
__device__ __forceinline__ void tr_store64(const f32x4 (&v)[16], int Kvalid, int Nvalid, int k0, int n0, bf16_t* WT, int ldt, int trow0, float* scr, int lane,
                                           const float* gk, const float* mu, int mode) {
    const int c4 = lane & 15, rq = lane >> 4;
#pragma unroll
    for (int i = 0; i < 16; ++i) { const int kk = 4 * i + rq, k = k0 + kk; float sc = 1.f;
        if (k < Kvalid) { if (gk) sc = gk[k]; if (mode == 1) sc *= (1.f - mu[k]); else if (mode == 2) sc *= mu[k]; }
        float* d = scr + kk * 65 + 4 * c4; d[0] = v[i][0] * sc; d[1] = v[i][1] * sc; d[2] = v[i][2] * sc; d[3] = v[i][3] * sc; }
    __builtin_amdgcn_s_waitcnt(0xC07F); asm volatile("" ::: "memory");
    const int c = lane & 7;
#pragma unroll
    for (int j = 0; j < 8; ++j) { const int n = (lane >> 3) + 8 * j; const float* q = scr + (8 * c) * 65 + n;
        u32x4 o; o.x = pk2(q[0 * 65], q[1 * 65]); o.y = pk2(q[2 * 65], q[3 * 65]); o.z = pk2(q[4 * 65], q[5 * 65]); o.w = pk2(q[6 * 65], q[7 * 65]);
        if (n0 + n < Nvalid) *(u32x4*)(WT + (size_t)(trow0 + n) * ldt + k0 + 8 * c) = o; }
    __builtin_amdgcn_s_waitcnt(0xC07F); asm volatile("" ::: "memory");
}
__device__ __forceinline__ void tr_item64(const float* W, int ldw, int Kvalid, int Nvalid, int k0, int n0, bf16_t* WT, int ldt, int trow0, float* scr, int lane,
                                          const float* gk, const float* mu, int mode) {
    f32x4 v[16];
    tr_load64(v, W, ldw, Kvalid, Nvalid, k0, n0, lane);
    tr_store64(v, Kvalid, Nvalid, k0, n0, WT, ldt, trow0, scr, lane, gk, mu, mode);
}

__device__ __forceinline__ void phase_prologue(const Params& p, unsigned char* lds) {
    const int tid = opaque_tid(), lane = tid & 63, wave = tid >> 6;
    const int gw = blockIdx.x * NWAVES + wave, NGW = gridDim.x * NWAVES;
    unsigned char* ws = p.ws;
    float* scr = (float*)(lds + wave * 16640);
    bf16_t* WinT = (bf16_t*)(ws + WS_WIN); bf16_t* WoutT = (bf16_t*)(ws + WS_WOUT); bf16_t* L2T = (bf16_t*)(ws + WS_L2T);
    const float* g_mix = p.in[1]; const float* mu_x = p.in[9];
    constexpr int I_WIN = 32 * 96;
    constexpr int I_L1 = 32 * (1 + 1 + 3) * 2;
    constexpr int I_WOUT = 32 * 32;
    constexpr int I_L2 = 3 * 4 * 16;
    constexpr int NITEMS = I_WIN + I_L1 + I_WOUT + I_L2;
    for (int it = gw; it < NITEMS; it += NGW) {
        int r = it;
        if (r < I_WIN) { const int kb = r / 96, nb = r % 96; tr_item64(p.in[2], 6144, 2048, 6144, 64 * kb, 64 * nb, WinT, 2048, 64 * nb, scr, lane, g_mix, nullptr, 0); continue; } r -= I_WIN;
        if (r < I_L1) {
            const int kb = r / 10, rr = r % 10;
            int which, nb, mode;
            if (rr < 2) { which = 0; nb = 0; mode = 1 + rr; } else if (rr < 4) { which = 1; nb = 0; mode = 1 + (rr - 2); } else { which = 2; nb = (rr - 4) >> 1; mode = 1 + ((rr - 4) & 1); }
            const float* W = which == 0 ? p.in[12] : which == 1 ? p.in[15] : p.in[17];
            const int ldw = which == 2 ? 160 : 64;
            const int rowbase = 6144 + (which == 0 ? 0 : which == 1 ? 128 : 256) + (mode == 2 ? ldw : 0);
            tr_item64(W, ldw, 2048, ldw, 64 * kb, 64 * nb, WinT, 2048, rowbase + 64 * nb, scr, lane, g_mix, mu_x + which * 2048, mode); continue; } r -= I_L1;
        if (r < I_WOUT) { const int kb = r / 32, nb = r % 32; tr_item64(p.in[3], 2048, 2048, 2048, 64 * kb, 64 * nb, WoutT, 2048, 64 * nb, scr, lane, nullptr, nullptr, 0); continue; } r -= I_WOUT;
        { const int which = r / 64, rr = r % 64, kb = rr / 16, nb = rr % 16;
          const float* W = which == 0 ? p.in[13] : which == 1 ? p.in[16] : p.in[18]; const int kv = which == 2 ? 160 : 64;
          tr_item64(W, 1024, kv, 1024, 64 * kb, 64 * nb, L2T, 256, which * 1024 + 64 * nb, scr, lane, nullptr, nullptr, 0); }
    }
    for (int ch = blockIdx.x * NTHREADS + tid; ch < 192 * 256; ch += gridDim.x * NTHREADS) *(u32x4*)(WinT + (size_t)6720 * 2048 + (size_t)ch * 8) = (u32x4){0u, 0u, 0u, 0u};
    { bf16_t* whi = (bf16_t*)(ws + WS_WRT); bf16_t* wlo = whi + 48 * 2048; const float* gf = p.in[24]; const float* wg = p.in[25]; const float* we = p.in[27];
      for (int id = blockIdx.x * NTHREADS + tid; id < 48 * 2048; id += gridDim.x * NTHREADS) { const int cc = id >> 11, k = id & 2047; float w = 0.f;
          if (cc < 4) w = wg[(size_t)k * 4 + cc] * gf[k]; else if (cc < 36) w = we[(size_t)k * 32 + cc - 4] * gf[k];
          const unsigned hb = f2bf(w); const float hf = bf2f(hb); whi[id] = (bf16_t)hb; wlo[id] = (bf16_t)f2bf(w - hf); } }
    const float* x = p.in[0]; bf16_t* xb = (bf16_t*)(ws + WS_XB); float* rstd1 = (float*)(ws + WS_RSTD1);
    for (int m0 = gw; m0 < T; m0 += 2 * NGW) {
        f32x4 v[2][8];
#pragma unroll
        for (int u = 0; u < 2; ++u) { const int m = m0 + u * NGW; if (m < T) { const f32x4* xr = (const f32x4*)(x + (size_t)m * DM) + lane;
#pragma unroll
            for (int j = 0; j < 8; ++j) v[u][j] = xr[64 * j]; } }
#pragma unroll
        for (int u = 0; u < 2; ++u) { const int m = m0 + u * NGW; if (m < T) { float sq = 0.f;
#pragma unroll
            for (int j = 0; j < 8; ++j) sq += (v[u][j][0] * v[u][j][0] + v[u][j][1] * v[u][j][1]) + (v[u][j][2] * v[u][j][2] + v[u][j][3] * v[u][j][3]);
            sq = wave_sum(sq);
            u32x2* o = (u32x2*)(xb + (size_t)m * DM) + lane;
#pragma unroll
            for (int j = 0; j < 8; ++j) { u32x2 w; w.x = pk2(v[u][j][0], v[u][j][1]); w.y = pk2(v[u][j][2], v[u][j][3]); o[64 * j] = w; }
            if (lane == 0) rstd1[m] = 1.0f / sqrtf(sq * (1.0f / DM) + 1e-6f); } }
    }
}

__device__ __forceinline__ void convert_gu_queue(const Params& p, unsigned char* lds, unsigned* qctr, int e_lo, int e_hi) {
    const int tid = opaque_tid(), lane = tid & 63, wave = tid >> 6;
    float* scr = (float*)(lds + wave * 16640);
    volatile int* slot = (volatile int*)(lds + LDS_BYTES - 64);
    const float* gf = p.in[24];
    const int nitems = (e_hi - e_lo) * 512;
    for (;;) {
        __syncthreads();
        if (tid == 0) *slot = (int)atomicAdd(qctr, 8u);
        __syncthreads();
        const int r0 = __builtin_amdgcn_readfirstlane(*slot);
        if (r0 >= nitems) break;
        const int r = r0 + wave; const int e = e_lo + r / 512, rr = r % 512, up = rr >> 8, kb = (rr & 255) >> 3, n0 = 64 * (rr & 7);
        tr_item64((up ? p.in[30] : p.in[29]) + (size_t)e * 2048 * 512, 512, 2048, 512, 64 * kb, n0, (bf16_t*)(p.ws + wgu_byte_off(e)), 2048, 256 * (n0 >> 7) + (n0 & 127) + (up ? 128 : 0), scr, lane, gf, nullptr, 0);
    }
}
__device__ __forceinline__ void convert_down_queue(const Params& p, unsigned char* lds, unsigned* qctr) {
    const int tid = opaque_tid(), lane = tid & 63, wave = tid >> 6;
    float* scr = (float*)(lds + wave * 16640);
    volatile int* slot = (volatile int*)(lds + LDS_BYTES - 64);
    for (;;) {
        __syncthreads();
        if (tid == 0) *slot = (int)atomicAdd(qctr, 8u);
        __syncthreads();
        const int r = __builtin_amdgcn_readfirstlane(*slot) + wave;
        if (r - wave >= 32 * 256) break;
        const int e = r / 256, rr = r % 256, kb = rr / 32, nb = rr % 32;
        tr_item64(p.in[31] + (size_t)e * 512 * 2048, 2048, 512, 2048, 64 * kb, 64 * nb, (bf16_t*)(p.ws + wd_byte_off(e)), 512, 64 * nb, scr, lane, nullptr, nullptr, 0);
    }
}

__device__ __forceinline__ void phase_l2prep(const Params& p) {
    const bf16_t* P = (const bf16_t*)(p.ws + WS_PBUF); bf16_t* A2 = (bf16_t*)(p.ws + WS_A2);
    const int nchunk = T * 96;
    const int tid = opaque_tid();
    const int stride = gridDim.x * NTHREADS;
    for (int id0 = blockIdx.x * NTHREADS + tid; id0 < nchunk; id0 += 4 * stride) {
        u32x4 va[4], vb[4];
#pragma unroll
        for (int u = 0; u < 4; ++u) { const int id = id0 + u * stride; va[u] = (u32x4){0u, 0u, 0u, 0u}; vb[u] = va[u];
            if (id < nchunk) { const int t = id / 96, ch = id % 96, gi = ch >> 5, jc = (ch & 31) * 8; const int width = gi == 2 ? 160 : 64, pa = gi == 0 ? 0 : gi == 1 ? 128 : 256, pb = pa + width;
                if (jc < width) { va[u] = *(const u32x4*)(P + (size_t)t * PW + pa + jc); if ((t & (SEQ - 1)) != 0) vb[u] = *(const u32x4*)(P + (size_t)(t - 1) * PW + pb + jc); } } }
#pragma unroll
        for (int u = 0; u < 4; ++u) { const int id = id0 + u * stride;
            if (id < nchunk) { const int t = id / 96, ch = id % 96, gi = ch >> 5, jc = (ch & 31) * 8; const int width = gi == 2 ? 160 : 64;
                u32x4 o = (u32x4){0u, 0u, 0u, 0u};
                if (jc < width) { float f[8];
#pragma unroll
                    for (int i = 0; i < 4; ++i) { f[2 * i] = bflo(va[u][i]) + bflo(vb[u][i]); f[2 * i + 1] = bfhi(va[u][i]) + bfhi(vb[u][i]); }
#pragma unroll
                    for (int i = 0; i < 8; ++i) { if (gi == 0) f[i] = 1.0f - 2.0f * __builtin_amdgcn_rcpf(__builtin_amdgcn_exp2f(2.0f * 1.4426950408889634f * f[i]) + 1.0f); else if (gi == 2) f[i] = sigmoidf_(f[i]); }
                    o.x = pk2(f[0], f[1]); o.y = pk2(f[2], f[3]); o.z = pk2(f[4], f[5]); o.w = pk2(f[6], f[7]); }
                *(u32x4*)(A2 + (size_t)t * PW + ch * 8) = o; } }
    }
}

constexpr int TC = 16;
constexpr int CV_UT = 0, CV_ZT = 2048, CV_BT = 4096, CV_KT = 6144, CV_BKH = 8192, CV_VT = 12288, CV_GC = 14336, CV_BYTES = 14848;
constexpr int CM_TT = 0, CM_BB = 1024, CM_AB = 2048, CM_BYTES = 3072;
constexpr int CL_VEC = 0, CL_MAT = 3 * CV_BYTES, CL_YS = CL_MAT + 2 * CM_BYTES, CL_GB = CL_YS + 2 * 4096  , CL_SCR = CL_GB + 4 * 8192, CL_SCR_W = 2304, CL_END = CL_SCR + 8 * CL_SCR_W;
#define DPP_F(v, ctrl) __builtin_bit_cast(float, __builtin_amdgcn_update_dpp(0, __builtin_bit_cast(int, (v)), (ctrl), 0xF, 0xF, true))
__device__ __forceinline__ float red8(float v) {
    v += DPP_F(v, 0xB1);
    v += DPP_F(v, 0x4E);
    v += DPP_F(v, 0x141);
    return v;
}
__device__ __forceinline__ float wave_sum_fast(float v) {
    v = red8(v);
    v += DPP_F(v, 0x140);
    v += __builtin_bit_cast(float, __builtin_amdgcn_update_dpp(0, __builtin_bit_cast(int, v), 0x142, 0xa, 0xf, false));
    v += __builtin_bit_cast(float, __builtin_amdgcn_update_dpp(0, __builtin_bit_cast(int, v), 0x143, 0xc, 0xf, false));
    return __builtin_bit_cast(float, __builtin_amdgcn_readlane(__builtin_bit_cast(int, v), 63));
}
__device__ __forceinline__ bf16x8 op4(const f32x4 x) { u32x4 w; w.x = cvt_pk_bf16_(x[0], x[1]); w.y = cvt_pk_bf16_(x[2], x[3]); w.z = 0u; w.w = 0u; return __builtin_bit_cast(bf16x8, w); }
#define MFMA16(a, b, c) __builtin_amdgcn_mfma_f32_16x16x32_bf16((a), (b), (c), 0, 0, 0)
__device__ __forceinline__ void rwkv_chain(const Params& p, unsigned char* lds, int chain) {
    const int tid = opaque_tid(), lane = tid & 63, wave = __builtin_amdgcn_readfirstlane(tid >> 6);
    const int b = chain >> 4, h = chain & 15;
    constexpr int NC = SEQ / TC;
    const int n = lane & 15, q = lane >> 4;
    const f32x4 zero4 = (f32x4){0.f, 0.f, 0.f, 0.f};
    const int c = h * 64 + lane;
    constexpr int SPW = 4;
    bf16_t* O = (bf16_t*)(p.ws + WS_O);
    float* SCR = (float*)(lds + CL_SCR + wave * CL_SCR_W);
#define SCAN_POST(ci_, pw_) do { const float* Ys_ = (const float*)(lds + CL_YS + ((ci_) & 1) * 4096); const float* GB_ = (const float*)(lds + CL_GB + ((ci_) & 3) * 8192); \
        float y_[SPW]; \
        _Pragma("unroll") for (int s_ = 0; s_ < SPW; ++s_) { y_[s_] = Ys_[((pw_) * SPW + s_) * 64 + lane]; SCR[(2 * s_) * 68 + lane] = y_[s_]; SCR[(2 * s_ + 1) * 68 + lane] = y_[s_] * y_[s_]; } \
        { const float* rp_ = SCR + (lane >> 3) * 68 + (lane & 7) * 8; const f32x4 p0_ = *(const f32x4*)(rp_), p1_ = *(const f32x4*)(rp_ + 4); const f32x4 ps_ = p0_ + p1_; \
          const float t_ = red8((ps_[0] + ps_[1]) + (ps_[2] + ps_[3])); if ((lane & 7) == 0) SCR[8 * 68 + 8 + (lane >> 3)] = t_; } \
        { const f32x4 t0_ = *(const f32x4*)(SCR + 8 * 68 + 8), t1_ = *(const f32x4*)(SCR + 8 * 68 + 12); const float st_[8] = {t0_[0], t0_[1], t0_[2], t0_[3], t1_[0], t1_[1], t1_[2], t1_[3]}; \
          _Pragma("unroll") for (int s_ = 0; s_ < SPW; ++s_) { const int tl_ = (pw_) * SPW + s_; const size_t m_ = (size_t)b * SEQ + (ci_) * TC + tl_; \
            const float mean_ = st_[2 * s_] * (1.0f / 64.0f); const float var_ = fmaxf(st_[2 * s_ + 1] * (1.0f / 64.0f) - mean_ * mean_, 0.f); \
            const float yn_ = (y_[s_] - mean_) * __builtin_amdgcn_rsqf(var_ + 64e-5f) * ln_w + ln_b; \
            O[m_ * DM + 1024 + c] = (bf16_t)f2bf(yn_ * GB_[tl_ * 64 + lane] + GB_[TC * 64 + tl_ * 64 + lane]); } } } while (0)
#define OPR(arr_, ks_) (*(const bf16x8*)(V0_ + (arr_) + n * 128 + (ks_) * 64 + q * 16))
#define SCAN_MATS(ci_) do { const unsigned char* V0_ = lds + CL_VEC + ((ci_) % 3) * CV_BYTES; unsigned char* M0_ = lds + CL_MAT + ((ci_) & 1) * CM_BYTES; \
        if (wave == 0) { \
            f32x4 pa_ = MFMA16(OPR(CV_BT, 0), OPR(CV_UT, 0), zero4); pa_ = MFMA16(OPR(CV_BT, 1), OPR(CV_UT, 1), pa_);        \
            f32x4 pt_ = MFMA16(OPR(CV_UT, 0), OPR(CV_BT, 0), zero4); pt_ = MFMA16(OPR(CV_UT, 1), OPR(CV_BT, 1), pt_);        \
            _Pragma("unroll") for (int r_ = 0; r_ < 4; ++r_) { if (!(4 * q + r_ < n)) pa_[r_] = 0.f; if (!(n < 4 * q + r_)) pt_[r_] = 0.f; } \
            f32x4 rr4_ = pa_;                                                                                                 \
            _Pragma("unroll") for (int k_ = 1; k_ < 4; ++k_) { \
                const f32x4 pn_ = MFMA16(op4(pt_), op4(pa_), zero4);                                                          \
                const f32x4 ptn_ = MFMA16(op4(pa_), op4(pt_), zero4);                                                         \
                rr4_ = MFMA16(op4(ptn_), op4(rr4_), rr4_ + pn_);                                                              \
                pa_ = pn_; pt_ = ptn_; } \
            _Pragma("unroll") for (int r_ = 0; r_ < 4; ++r_) if (4 * q + r_ == n) rr4_[r_] += 1.0f; \
            *(bf16x8*)(M0_ + CM_TT + lane * 16) = op4(rr4_); \
        } else if (wave == 1) { \
            f32x4 pb_ = MFMA16(OPR(CV_KT, 0), OPR(CV_UT, 0), zero4); pb_ = MFMA16(OPR(CV_KT, 1), OPR(CV_UT, 1), pb_);        \
            _Pragma("unroll") for (int r_ = 0; r_ < 4; ++r_) if (!(4 * q + r_ < n)) pb_[r_] = 0.f; \
            *(bf16x8*)(M0_ + CM_BB + lane * 16) = op4(pb_); \
        } else if (wave == 2) { \
            f32x4 qa_ = MFMA16(OPR(CV_BT, 0), OPR(CV_ZT, 0), zero4); qa_ = MFMA16(OPR(CV_BT, 1), OPR(CV_ZT, 1), qa_);        \
            f32x4 qb_ = MFMA16(OPR(CV_KT, 0), OPR(CV_ZT, 0), zero4); qb_ = MFMA16(OPR(CV_KT, 1), OPR(CV_ZT, 1), qb_);        \
            _Pragma("unroll") for (int r_ = 0; r_ < 4; ++r_) if (!(4 * q + r_ <= n)) { qa_[r_] = 0.f; qb_[r_] = 0.f; } \
            u32x4 w_; w_.x = cvt_pk_bf16_(qa_[0], qa_[1]); w_.y = cvt_pk_bf16_(qa_[2], qa_[3]); w_.z = cvt_pk_bf16_(qb_[0], qb_[1]); w_.w = cvt_pk_bf16_(qb_[2], qb_[3]); \
            *(u32x4*)(M0_ + CM_AB + lane * 16) = w_; \
        } } while (0)
    if (wave < 4) {
        const int row = 16 * wave + n;
        const float ln_w = p.in[22][c], ln_b = p.in[23][c];
        f32x4 Sd[4];
#pragma unroll
        for (int c4 = 0; c4 < 4; ++c4) Sd[c4] = zero4;
        __syncthreads();
        SCAN_MATS(0);
        __syncthreads();
        for (int ci = 0; ci < NC; ++ci) {
            if (ci >= 1) SCAN_POST(ci - 1, wave);
            const unsigned char* V0 = lds + CL_VEC + (ci % 3) * CV_BYTES; const unsigned char* M0 = lds + CL_MAT + (ci & 1) * CM_BYTES;
            float* Ys = (float*)(lds + CL_YS + (ci & 1) * 4096);
            const int ro = n * 128 + q * 16;
            u32x4 w0, w1;
            w0.x = cvt_pk_bf16_(Sd[0][0], Sd[0][1]); w0.y = cvt_pk_bf16_(Sd[0][2], Sd[0][3]); w0.z = cvt_pk_bf16_(Sd[1][0], Sd[1][1]); w0.w = cvt_pk_bf16_(Sd[1][2], Sd[1][3]);
            w1.x = cvt_pk_bf16_(Sd[2][0], Sd[2][1]); w1.y = cvt_pk_bf16_(Sd[2][2], Sd[2][3]); w1.z = cvt_pk_bf16_(Sd[3][0], Sd[3][1]); w1.w = cvt_pk_bf16_(Sd[3][2], Sd[3][3]);
            const bf16x8 sB0 = __builtin_bit_cast(bf16x8, w0), sB1 = __builtin_bit_cast(bf16x8, w1);
            const u32x2 vraw = *(const u32x2*)(V0 + CV_VT + row * 32 + q * 8);
            u32x4 vw; vw.x = vraw.x; vw.y = vraw.y; vw.z = 0u; vw.w = 0u; const bf16x8 vB = __builtin_bit_cast(bf16x8, vw);
            f32x4 g = MFMA16(*(const bf16x8*)(V0 + CV_UT + ro), sB0, zero4);
            g = MFMA16(*(const bf16x8*)(V0 + CV_UT + ro + 64), sB1, g);
            g = MFMA16(*(const bf16x8*)(M0 + CM_BB + lane * 16), vB, g);
            f32x4 y = MFMA16(*(const bf16x8*)(V0 + CV_ZT + ro), sB0, zero4);
            y = MFMA16(*(const bf16x8*)(V0 + CV_ZT + ro + 64), sB1, y);
            const f32x4 sa = MFMA16(*(const bf16x8*)(M0 + CM_TT + lane * 16), op4(g), zero4);
            u32x4 sw; sw.x = cvt_pk_bf16_(sa[0], sa[1]); sw.y = cvt_pk_bf16_(sa[2], sa[3]); sw.z = vraw.x; sw.w = vraw.y; const bf16x8 savB = __builtin_bit_cast(bf16x8, sw);
            y = MFMA16(*(const bf16x8*)(M0 + CM_AB + lane * 16), savB, y);
#pragma unroll
            for (int r = 0; r < 4; ++r) Ys[(4 * q + r) * 64 + row] = y[r];
#pragma unroll
            for (int c4 = 0; c4 < 4; ++c4) { const f32x4 gc = *(const f32x4*)(V0 + CV_GC + (16 * c4 + 4 * q) * 4);
                Sd[c4] = MFMA16(*(const bf16x8*)(V0 + CV_BKH + (16 * c4 + n) * 64 + q * 16), savB, Sd[c4] * gc); }
            if (ci + 1 < NC) SCAN_MATS(ci + 1);
            __syncthreads();
        }
        SCAN_POST(NC - 1, wave);
    } else {
        const int aw = wave - 4;
        const bf16_t* rb = (const bf16_t*)(p.ws + WS_INBUF) + (size_t)3 * T * 1024; const bf16_t* kb = rb + (size_t)T * 1024; const bf16_t* vb = kb + (size_t)T * 1024;
        const float* wl = (const float*)(p.ws + WS_WL); const bf16_t* ab = (const bf16_t*)(p.ws + WS_ABUF); const bf16_t* gb = (const bf16_t*)(p.ws + WS_GBUF);
        const float mu_r = p.in[10][c], mu_k = p.in[10][1024 + c], mu_v = p.in[10][2048 + c];
        const float k_k = p.in[19][c], k_a = p.in[20][c], r_k = p.in[21][c];
        const int cc = lane & 31; const int pos = (lane & 32) + 8 * ((cc >> 2) & 3) + (((cc >> 4) << 2) | (cc & 3));
        unsigned short rcA[SPW + 1], kcA[SPW + 1], vcA[SPW + 1], raA[SPW], rgA[SPW]; float rwlA[SPW], wlcA[16];
        unsigned short rcB[SPW + 1], kcB[SPW + 1], vcB[SPW + 1], raB[SPW], rgB[SPW]; float rwlB[SPW], wlcB[16];
#define SCAN_LOAD(ci_, X) do { const int tb_ = (ci_) * TC + aw * SPW; const size_t m0_ = (size_t)b * SEQ + tb_; \
        _Pragma("unroll") for (int s_ = 0; s_ < SPW + 1; ++s_) { const bool ok_ = (tb_ + s_ - 1) >= 0; const size_t off_ = (m0_ + s_ - 1) * 1024 + c; \
            rc##X[s_] = ok_ ? rb[off_] : (unsigned short)0; kc##X[s_] = ok_ ? kb[off_] : (unsigned short)0; vc##X[s_] = ok_ ? vb[off_] : (unsigned short)0; } \
        _Pragma("unroll") for (int s_ = 0; s_ < SPW; ++s_) { const size_t off_ = (m0_ + s_) * 1024 + c; rwl##X[s_] = wl[off_]; ra##X[s_] = ab[off_]; rg##X[s_] = gb[off_]; } \
        _Pragma("unroll") for (int i_ = 0; i_ < 16; ++i_) wlc##X[i_] = wl[((size_t)b * SEQ + (ci_) * TC + i_) * 1024 + c]; } while (0)
#define SCAN_PREP(ci_, X) do { unsigned char* V0_ = lds + CL_VEC + ((ci_) % 3) * CV_BYTES; float* GB_ = (float*)(lds + CL_GB + ((ci_) & 3) * 8192); \
        const float p4_ = (wlc##X[0] + wlc##X[1]) + (wlc##X[2] + wlc##X[3]), p8_ = p4_ + ((wlc##X[4] + wlc##X[5]) + (wlc##X[6] + wlc##X[7])); \
        const float p12_ = p8_ + ((wlc##X[8] + wlc##X[9]) + (wlc##X[10] + wlc##X[11])), ltot_ = p12_ + ((wlc##X[12] + wlc##X[13]) + (wlc##X[14] + wlc##X[15])); \
        float lcur_ = aw == 0 ? 0.f : aw == 1 ? p4_ : aw == 2 ? p8_ : p12_;        \
        float rr_[SPW], vv_[SPW], a_[SPW], kkv_[SPW], kmod_[SPW]; \
        _Pragma("unroll") for (int s_ = 0; s_ < SPW; ++s_) { \
            rr_[s_] = bf2f(rc##X[s_ + 1]) + (bf2f(rc##X[s_]) - bf2f(rc##X[s_ + 1])) * mu_r; const float kx_ = bf2f(kc##X[s_ + 1]) + (bf2f(kc##X[s_]) - bf2f(kc##X[s_ + 1])) * mu_k; vv_[s_] = bf2f(vc##X[s_ + 1]) + (bf2f(vc##X[s_]) - bf2f(vc##X[s_ + 1])) * mu_v; \
            a_[s_] = bf2f(ra##X[s_]); kkv_[s_] = kx_ * k_k; kmod_[s_] = kx_ * (1.0f + (a_[s_] - 1.0f) * k_a); \
            SCR[(2 * s_) * 68 + lane] = kkv_[s_] * kkv_[s_]; SCR[(2 * s_ + 1) * 68 + lane] = rr_[s_] * kmod_[s_] * r_k; } \
        { const float* rp_ = SCR + (lane >> 3) * 68 + (lane & 7) * 8; const f32x4 p0_ = *(const f32x4*)(rp_), p1_ = *(const f32x4*)(rp_ + 4); const f32x4 ps_ = p0_ + p1_; \
          const float t_ = red8((ps_[0] + ps_[1]) + (ps_[2] + ps_[3])); if ((lane & 7) == 0) SCR[8 * 68 + (lane >> 3)] = t_; } \
        { const f32x4 t0_ = *(const f32x4*)(SCR + 8 * 68), t1_ = *(const f32x4*)(SCR + 8 * 68 + 4); const float st_[8] = {t0_[0], t0_[1], t0_[2], t0_[3], t1_[0], t1_[1], t1_[2], t1_[3]}; \
          _Pragma("unroll") for (int s_ = 0; s_ < SPW; ++s_) { const int tl_ = aw * SPW + s_; \
            const float rinv_ = __builtin_amdgcn_rsqf(fmaxf(st_[2 * s_], 1e-24f)); const float kkn_ = kkv_[s_] * rinv_, bb_ = kkn_ * a_[s_]; \
            const float gm1_ = __builtin_amdgcn_exp2f(lcur_); lcur_ += rwl##X[s_]; \
            const float g_ = __builtin_amdgcn_exp2f(lcur_), ig_ = __builtin_amdgcn_exp2f(-lcur_), lam_ = __builtin_amdgcn_exp2f(ltot_ - lcur_); \
            ((bf16_t*)(V0_ + CV_UT))[tl_ * 64 + pos] = (bf16_t)cvt_pk_bf16_(-kkn_ * gm1_, 0.f); ((bf16_t*)(V0_ + CV_ZT))[tl_ * 64 + pos] = (bf16_t)cvt_pk_bf16_(rr_[s_] * g_, 0.f); \
            ((bf16_t*)(V0_ + CV_BT))[tl_ * 64 + pos] = (bf16_t)cvt_pk_bf16_(bb_ * ig_, 0.f); ((bf16_t*)(V0_ + CV_KT))[tl_ * 64 + pos] = (bf16_t)cvt_pk_bf16_(kmod_[s_] * ig_, 0.f); \
            ((bf16_t*)(V0_ + CV_BKH))[lane * 32 + aw * 8 + s_] = (bf16_t)cvt_pk_bf16_(bb_ * lam_, 0.f); ((bf16_t*)(V0_ + CV_BKH))[lane * 32 + aw * 8 + 4 + s_] = (bf16_t)cvt_pk_bf16_(kmod_[s_] * lam_, 0.f); \
            ((bf16_t*)(V0_ + CV_VT))[lane * 16 + tl_] = (bf16_t)cvt_pk_bf16_(vv_[s_], 0.f); \
            GB_[tl_ * 64 + lane] = bf2f(rg##X[s_]); GB_[TC * 64 + tl_ * 64 + lane] = st_[2 * s_ + 1] * vv_[s_] * bf2f(rg##X[s_]); } \
          if (aw == 3) ((float*)(V0_ + CV_GC))[lane] = __builtin_amdgcn_exp2f(ltot_); } } while (0)
        SCAN_LOAD(0, B); SCAN_LOAD(1, A); SCAN_PREP(0, B); SCAN_LOAD(2, B);
        __syncthreads();
        SCAN_PREP(1, A); SCAN_LOAD(3, A);
        __syncthreads();
        for (int ci = 0; ci < NC; ci += 2) {
            if (ci + 2 < NC) { SCAN_PREP(ci + 2, B); if (ci + 4 < NC) SCAN_LOAD(ci + 4, B); }
            __syncthreads();
            if (ci + 3 < NC) { SCAN_PREP(ci + 3, A); if (ci + 5 < NC) SCAN_LOAD(ci + 5, A); }
            __syncthreads();
        }
#undef SCAN_LOAD
#undef SCAN_PREP
#undef SCAN_MATS
#undef SCAN_POST
#undef OPR
    }
    __syncthreads();
}

#include <hip/hip_bf16.h>
#include <cmath>
namespace attn_body {
using bf16=__hip_bfloat16;
using bf16x8=__attribute__((ext_vector_type(8)))short;
using s16x4=__attribute__((ext_vector_type(4)))short;
using f32x16=__attribute__((ext_vector_type(16)))float;
using u32x4=__attribute__((ext_vector_type(4)))unsigned;
constexpr int SEQ=2048,D=64,DM=1024;
constexpr int NW=8,QBLK=32,QB=QBLK*NW,KVBLK=64,NQB=SEQ/QB;
__device__ __forceinline__ int crow(int r,int hi){return (r&3)+8*(r>>2)+4*hi;}
#define SBAR() __builtin_amdgcn_sched_barrier(0)
__device__ __forceinline__ void cmask(f32x16&p0,f32x16&p1,int jb,int qrel,int hi){
  const float NEG=-INFINITY; int kb=64*jb+4*hi;
  #pragma unroll
  for(int r=0;r<16;++r){int kv=kb+(r&3)+8*(r>>2); if(kv>qrel)p0[r]=NEG; if(kv+32>qrel)p1[r]=NEG;}
}

constexpr int NSLOT=3, SLOTB=8192;
constexpr int LDS_K=0, LDS_V=NSLOT*SLOTB, LDS_WS=2*NSLOT*SLOTB, LDS_OST=LDS_WS+NW*64*4, LDS_BYTES=LDS_OST+NW*4096;
constexpr float C2=0.125f*1.4426950408889634f;
__device__ __forceinline__ void glds16(const void*gsrc,unsigned lds_dst){unsigned keep;
  asm volatile("s_mov_b32 %0, m0\n\ts_mov_b32 m0, %2\n\ts_nop 0\n\tglobal_load_lds_dwordx4 %1, off\n\ts_mov_b32 m0, %0":"=&s"(keep):"v"(gsrc),"s"(lds_dst):"memory");}
__device__ __forceinline__ float max3f(float a,float b,float c){float r;asm("v_max3_f32 %0, %1, %2, %3":"=v"(r):"v"(a),"v"(b),"v"(c));return r;}
__device__ __forceinline__ float max2f(float a,float b){float r;asm("v_max_f32_e32 %0, %1, %2":"=v"(r):"v"(a),"v"(b));return r;}
__device__ __forceinline__ float fadd_s(float a,float b){float r;asm("v_add_f32_e32 %0, %1, %2":"=v"(r):"v"(a),"v"(b));return r;}
__device__ __forceinline__ float fsub_s(float a,float b){float r;asm("v_sub_f32_e32 %0, %1, %2":"=v"(r):"v"(a),"v"(b));return r;}
typedef float f32x2_t __attribute__((ext_vector_type(2))); typedef __bf16 bf16x2_t __attribute__((ext_vector_type(2)));
__device__ __forceinline__ unsigned cvtpk_s(float lo,float hi){f32x2_t v={lo,hi};bf16x2_t b=__builtin_convertvector(v,bf16x2_t);return __builtin_bit_cast(unsigned,b);}
#define WAIT_BAR(N) asm volatile("s_waitcnt vmcnt(" #N ") lgkmcnt(0)\n\ts_barrier":::"memory")

__device__ __forceinline__ void qkt(f32x16&p0,f32x16&p1,const char*Kslot,const bf16x8*qr,const f32x16&negm,int r32,int hi){
  const char*kb=Kslot+hi*1024+r32*16;
  #pragma unroll
  for(int d0=0;d0<4;++d0){
    const bf16x8 b0=*reinterpret_cast<const bf16x8*>(kb+d0*2048);
    const bf16x8 b1=*reinterpret_cast<const bf16x8*>(kb+d0*2048+512);
    if(d0==0){p0=__builtin_amdgcn_mfma_f32_32x32x16_bf16(b0,qr[0],negm,0,0,0);p1=__builtin_amdgcn_mfma_f32_32x32x16_bf16(b1,qr[0],negm,0,0,0);}
    else{p0=__builtin_amdgcn_mfma_f32_32x32x16_bf16(b0,qr[d0],p0,0,0,0);p1=__builtin_amdgcn_mfma_f32_32x32x16_bf16(b1,qr[d0],p1,0,0,0);}}
}
typedef __attribute__((address_space(3))) const char* lds_cptr;
typedef short v4i16_t __attribute__((ext_vector_type(4)));
__device__ __forceinline__ void kload8(bf16x8*kf,lds_cptr kp){
  kf[0]=*(const __attribute__((address_space(3))) bf16x8*)(kp);      kf[1]=*(const __attribute__((address_space(3))) bf16x8*)(kp+512);
  kf[2]=*(const __attribute__((address_space(3))) bf16x8*)(kp+2048); kf[3]=*(const __attribute__((address_space(3))) bf16x8*)(kp+2560);
  kf[4]=*(const __attribute__((address_space(3))) bf16x8*)(kp+4096); kf[5]=*(const __attribute__((address_space(3))) bf16x8*)(kp+4608);
  kf[6]=*(const __attribute__((address_space(3))) bf16x8*)(kp+6144); kf[7]=*(const __attribute__((address_space(3))) bf16x8*)(kp+6656);
}
__device__ __forceinline__ void kload2(bf16x8*kf,lds_cptr kp,int j){ kf[2*j]=*(const __attribute__((address_space(3))) bf16x8*)(kp+j*2048); kf[2*j+1]=*(const __attribute__((address_space(3))) bf16x8*)(kp+j*2048+512); }
__device__ __forceinline__ s16x4 vtr(lds_cptr p){ return __builtin_bit_cast(s16x4,__builtin_amdgcn_ds_read_tr16_b64_v4i16((__attribute__((address_space(3))) v4i16_t*)p)); }
__device__ __forceinline__ float rowmax(const f32x16&p0,const f32x16&p1){
  float a=max3f(p0[0],p0[1],p1[0]),b=max3f(p0[2],p0[3],p1[1]);a=max3f(a,p1[2],p1[3]);
  #pragma unroll
  for(int r=4;r<16;r+=4){a=max3f(a,p0[r],p0[r+1]);b=max3f(b,p0[r+2],p0[r+3]);a=max3f(a,p1[r],p1[r+1]);b=max3f(b,p1[r+2],p1[r+3]);}
  const float m=max2f(a,b);
  auto rr=__builtin_amdgcn_permlane32_swap(__float_as_uint(m),__float_as_uint(m),false,false);
  return max2f(__uint_as_float(rr[0]),__uint_as_float(rr[1]));
}
__device__ __forceinline__ void pv(f32x16*o,int vb,bf16x8 pa0,bf16x8 pa1,bf16x8 pa2,bf16x8 pa3){
  #pragma unroll
  for(int d0=0;d0<2;++d0){s16x4 lo[4],hi[4];
    #pragma unroll
    for(int ks=0;ks<4;++ks){
      asm volatile("ds_read_b64_tr_b16 %0,%1 offset:%c2":"=&v"(lo[ks]):"v"(vb),"i"(d0*4096+ks*1024):"memory");
      asm volatile("ds_read_b64_tr_b16 %0,%1 offset:%c2":"=&v"(hi[ks]):"v"(vb),"i"(d0*4096+ks*1024+512):"memory");}
    asm volatile("s_waitcnt lgkmcnt(0)":::"memory");SBAR();
    #define PK(k) (bf16x8){lo[k][0],lo[k][1],lo[k][2],lo[k][3],hi[k][0],hi[k][1],hi[k][2],hi[k][3]}
    o[d0]=__builtin_amdgcn_mfma_f32_32x32x16_bf16(pa0,PK(0),o[d0],0,0,0);
    o[d0]=__builtin_amdgcn_mfma_f32_32x32x16_bf16(pa1,PK(1),o[d0],0,0,0);
    o[d0]=__builtin_amdgcn_mfma_f32_32x32x16_bf16(pa2,PK(2),o[d0],0,0,0);
    o[d0]=__builtin_amdgcn_mfma_f32_32x32x16_bf16(pa3,PK(3),o[d0],0,0,0);
    #undef PK
  }
}

#ifndef ATTN_STORE16
#define ATTN_STORE16(p,v) (*(u32x4*)(p)=(v))
#endif
template<int THRL> __device__ __forceinline__ void attn_unit(int b,int qkcol,int vcol,int qb,int t_lo,float slope2,const bf16*Q,const bf16*__restrict__ K,const bf16*__restrict__ V,bf16*O,char*shm){
  const int tid=opaque_tid(),lane=tid&63,r32=lane&31,hi=lane>>5; const int wid=__builtin_amdgcn_readfirstlane(tid>>6);
  const long rowbase=(long)b*SEQ; const int q0=qb*QB;
  const bf16*Qw=Q+(rowbase+q0+wid*QBLK)*DM+qkcol;
  const bf16*Kh=K+(rowbase+(long)t_lo*KVBLK)*DM+qkcol,*Vh=V+(rowbase+(long)t_lo*KVBLK)*DM+vcol;
  const unsigned lds0=(unsigned)(uintptr_t)shm;
  float*wsf=(float*)(shm+LDS_WS)+wid*64;
  const bf16*ksrc=Kh+(long)lane*DM+wid*8;
  const bf16*vsrc=Vh+(long)(16*(wid&3)+(lane>>2))*DM+(wid>>2)*32+(lane&3)*8;
  const unsigned kdst=lds0+LDS_K+wid*1024, vdst=lds0+LDS_V+wid*1024;
  #define DMA_K(t,slot) glds16(ksrc+(long)(t)*KVBLK*DM,(unsigned)__builtin_amdgcn_readfirstlane(kdst+(slot)))
  #define DMA_V(t,slot) glds16(vsrc+(long)(t)*KVBLK*DM,(unsigned)__builtin_amdgcn_readfirstlane(vdst+(slot)))
  const int vb0=(int)(lds0+LDS_V)+((lane>>4)&1)*32+(lane&3)*8+(4*hi+((lane&15)>>2))*64;
  const char*Kbase=shm+LDS_K; bf16x8 kf[8];
  const lds_cptr shm3=(lds_cptr)shm; const lds_cptr kp0=shm3+LDS_K+hi*1024+r32*16; const lds_cptr vp0=shm3+LDS_V+((lane>>4)&1)*32+(lane&3)*8+(4*hi+((lane&15)>>2))*64;
  const int NT=(q0+QB)/KVBLK-t_lo;
  DMA_K(0,0);DMA_V(0,0);DMA_K(1,SLOTB);
  bf16x8 qr[4];
  #pragma unroll
  for(int d0=0;d0<4;++d0)qr[d0]=*reinterpret_cast<const bf16x8*>(&Qw[(long)r32*DM+d0*16+hi*8]);
  float mhat=0.f,l_reg=0.f;f32x16 o[2];o[0]=f32x16{};o[1]=f32x16{};f32x16 negm;
  const int qrel=wid*QBLK+r32;
  _Pragma("unroll") for(int r=0;r<16;++r)negm[r]=slope2*(float)(4*hi+(r&3)+8*(r>>2)); asm volatile("":"+v"(negm));
  #define CMASK(P0,P1,t) do{int jb_=(t)-(NT-4); if(jb_>=0)cmask(P0,P1,jb_,qrel,hi);}while(0)
  #define ABIAS(P0,P1,t) do{ float kb_=slope2*(float)(64*((t)+t_lo))-mhat; asm volatile("":"+v"(kb_)); const float kc_=kb_+32.f*slope2; _Pragma("unroll") for(int r=0;r<16;++r){ P0[r]+=kb_; P1[r]+=kc_; } }while(0)
  bool resc=false;
  #define START(P0,P1) do{ const float rm=rowmax(P0,P1); resc=false; \
    { const float dl=rm; mhat=fadd_s(mhat,dl); \
      _Pragma("unroll") for(int r=0;r<16;++r){P0[r]=fsub_s(P0[r],dl);P1[r]=fsub_s(P1[r],dl);} \
      } \
    _Pragma("unroll") for(int r=0;r<16;++r)P0[r]=__builtin_amdgcn_exp2f(P0[r]); }while(0)
  #define RESC() do{ if(resc){ asm volatile("s_waitcnt lgkmcnt(0)":::"memory"); \
      _Pragma("unroll") for(int d_=0;d_<2;++d_) _Pragma("unroll") for(int r=0;r<16;++r)o[d_][r]*=wsf[crow(r,hi)]; } }while(0)
  f32x16 pA0,pA1,pB0,pB1;
  int sl_prev=0,sl_cur=0,sl_next=SLOTB;
  #define ROT() do{sl_prev=sl_cur;sl_cur=sl_next;sl_next=(sl_next==(NSLOT-1)*SLOTB)?0:sl_next+SLOTB;}while(0)
  DMA_K(2,2*SLOTB);
  WAIT_BAR(3);
  qkt(pA0,pA1,Kbase,qr,negm,r32,hi);asm volatile("s_nop 15\n\ts_nop 7":"+v"(pA0),"+v"(pA1));ABIAS(pA0,pA1,0);CMASK(pA0,pA1,0);
  START(pA0,pA1);
  _Pragma("unroll") for(int r=0;r<16;++r)pA1[r]=__builtin_amdgcn_exp2f(pA1[r]);
  WAIT_BAR(0);
  DMA_K(3,0);DMA_V(1,SLOTB);
  ROT();
  kload8(kf,kp0+sl_cur);
  WAIT_BAR(2);
  s16x4 vlo[8],vhi[8]; u32x4 pw0,pw1,pw2,pw3;
  #define PKW(P,B) cvtpk_s(P[B],P[B+1])
  #define PAF(k) __builtin_bit_cast(bf16x8,pw##k)
  #define VFR(i) (bf16x8){vlo[i][0],vlo[i][1],vlo[i][2],vlo[i][3],vhi[i][0],vhi[i][1],vhi[i][2],vhi[i][3]}
  #define PIN(x) asm volatile("":"+v"(x))
  #define MX3(a,b,c) __builtin_fmaxf(__builtin_fmaxf((a),(b)),(c))
  #define GAPA(MF,A0,A1,A2,A3,W0,W1,PW) do{ MF; sacc+=A0; sacc+=A1; sacc+=A2; sacc+=A3; PIN(sacc); W0; W1; PIN(PW); SBAR(); }while(0)
  #define EX(v) __builtin_amdgcn_exp2f(v)
  #define GAPB(MF,X,B) do{ MF; X[B]=EX(X[B]); X[B+1]=EX(X[B+1]); X[B+2]=EX(X[B+2]); X[B+3]=EX(X[B+3]); PIN(X); SBAR(); }while(0)
  #define VRD(i) do{ vlo[i]=vtr(vp_+(((i)>>2)*4096+((i)&3)*1024)); vhi[i]=vtr(vp_+(((i)>>2)*4096+((i)&3)*1024+512)); }while(0)
  #define KRD(G,j) do{ if(G){ kload2(kf,kp0+sl_next,j); SBAR(); } }while(0)
  #define STEP(C0,C1,P0,P1,t,GK,GV,GL) do{ SBAR(); \
    const lds_cptr vp_=vp0+sl_prev; \
    VRD(0); SBAR(); float sacc=(P0[0]+P0[1]); \
    GAPA(C0=__builtin_amdgcn_mfma_f32_32x32x16_bf16(kf[0],qr[0],negm,0,0,0), P0[2],P0[3],P0[4],P0[5],     pw0[0]=PKW(P0,0), pw0[1]=PKW(P0,2), pw0); \
    VRD(4); SBAR(); GAPA(C1=__builtin_amdgcn_mfma_f32_32x32x16_bf16(kf[1],qr[0],negm,0,0,0), P0[6],P0[7],P0[8],P0[9],     pw0[2]=PKW(P0,4), pw0[3]=PKW(P0,6), pw0); \
    VRD(1); SBAR(); GAPA(C0=__builtin_amdgcn_mfma_f32_32x32x16_bf16(kf[2],qr[1],C0,0,0,0),   P0[10],P0[11],P0[12],P0[13], pw1[0]=PKW(P0,8), pw1[1]=PKW(P0,10), pw1); \
    VRD(5); SBAR(); GAPA(C1=__builtin_amdgcn_mfma_f32_32x32x16_bf16(kf[3],qr[1],C1,0,0,0),   P0[14],P0[15],P1[0],P1[1],   pw1[2]=PKW(P0,12),pw1[3]=PKW(P0,14), pw1); \
    VRD(2); SBAR(); GAPA(C0=__builtin_amdgcn_mfma_f32_32x32x16_bf16(kf[4],qr[2],C0,0,0,0),   P1[2],P1[3],P1[4],P1[5],     pw2[0]=PKW(P1,0), pw2[1]=PKW(P1,2), pw2); \
    VRD(6); SBAR(); GAPA(C1=__builtin_amdgcn_mfma_f32_32x32x16_bf16(kf[5],qr[2],C1,0,0,0),   P1[6],P1[7],P1[8],P1[9],     pw2[2]=PKW(P1,4), pw2[3]=PKW(P1,6), pw2); \
    VRD(3); SBAR(); GAPA(C0=__builtin_amdgcn_mfma_f32_32x32x16_bf16(kf[6],qr[3],C0,0,0,0),   P1[10],P1[11],P1[12],P1[13], pw3[0]=PKW(P1,8), pw3[1]=PKW(P1,10), pw3); \
    VRD(7); SBAR(); GAPA(C1=__builtin_amdgcn_mfma_f32_32x32x16_bf16(kf[7],qr[3],C1,0,0,0),   P1[14],P1[15],0.f,0.f,       pw3[2]=PKW(P1,12),pw3[3]=PKW(P1,14), pw3); \
    l_reg+=sacc; \
    if(GK){DMA_K((t)+3,sl_cur);} if(GV){DMA_V((t)+1,sl_next);} \
    ABIAS(C0,C1,t); CMASK(C0,C1,t); \
    { float a=MX3(C0[0],C0[1],C1[0]),b=MX3(C0[2],C0[3],C1[1]); a=MX3(a,C1[2],C1[3]); \
      _Pragma("unroll") for(int r=4;r<16;r+=4){a=MX3(a,C0[r],C0[r+1]);b=MX3(b,C0[r+2],C0[r+3]);a=MX3(a,C1[r],C1[r+1]);b=MX3(b,C1[r+2],C1[r+3]);} \
      float rm=__builtin_fmaxf(a,b); { auto rr=__builtin_amdgcn_permlane32_swap(__float_as_uint(rm),__float_as_uint(rm),false,false); rm=__builtin_fmaxf(__uint_as_float(rr[0]),__uint_as_float(rr[1])); } \
      resc=false; \
      if(__builtin_expect(__any(rm>(float)THRL),0)){ const float dl=__builtin_fmaxf(rm,0.f); mhat+=dl; \
        _Pragma("unroll") for(int r=0;r<16;++r){C0[r]-=dl;C1[r]-=dl;} \
        const float f=__builtin_amdgcn_exp2f(-dl); l_reg*=f; if(hi==0)wsf[r32]=f; resc=true; } } \
    SBAR(); \
    GAPB(o[0]=__builtin_amdgcn_mfma_f32_32x32x16_bf16(PAF(0),VFR(0),o[0],0,0,0), C0,0); \
    GAPB(o[1]=__builtin_amdgcn_mfma_f32_32x32x16_bf16(PAF(0),VFR(4),o[1],0,0,0), C0,4); \
    KRD(GL,0); GAPB(o[0]=__builtin_amdgcn_mfma_f32_32x32x16_bf16(PAF(1),VFR(1),o[0],0,0,0), C0,8); \
    KRD(GL,1); GAPB(o[1]=__builtin_amdgcn_mfma_f32_32x32x16_bf16(PAF(1),VFR(5),o[1],0,0,0), C0,12); \
    KRD(GL,2); GAPB(o[0]=__builtin_amdgcn_mfma_f32_32x32x16_bf16(PAF(2),VFR(2),o[0],0,0,0), C1,0); \
    KRD(GL,3); GAPB(o[1]=__builtin_amdgcn_mfma_f32_32x32x16_bf16(PAF(2),VFR(6),o[1],0,0,0), C1,4); \
    GAPB(o[0]=__builtin_amdgcn_mfma_f32_32x32x16_bf16(PAF(3),VFR(3),o[0],0,0,0), C1,8); \
    GAPB(o[1]=__builtin_amdgcn_mfma_f32_32x32x16_bf16(PAF(3),VFR(7),o[1],0,0,0), C1,12); \
    }while(0)
  int t=1;
  #undef CMASK
  #define CMASK(P0,P1,t) do{}while(0)
  for(;t+5<NT;t+=2){
    STEP(pB0,pB1,pA0,pA1,t,true,true,true);     WAIT_BAR(2); RESC(); ROT();
    STEP(pA0,pA1,pB0,pB1,t+1,true,true,true);   WAIT_BAR(2); RESC(); ROT();
  }
  #undef CMASK
  #define CMASK(P0,P1,t) do{int jb_=(t)-(NT-4); if(jb_>=0)cmask(P0,P1,jb_,qrel,hi);}while(0)
  #define ENDW(tt) do{ if((tt)+3<NT){WAIT_BAR(2);} else if((tt)+2<NT){WAIT_BAR(1);} else {WAIT_BAR(0);} }while(0)
  for(;t+1<NT;t+=2){
    STEP(pB0,pB1,pA0,pA1,t,(t+3<NT),(t+1<NT),(t+1<NT));       ENDW(t);   RESC(); ROT();
    STEP(pA0,pA1,pB0,pB1,t+1,(t+4<NT),(t+2<NT),(t+2<NT));     ENDW(t+1); RESC(); ROT();
  }
  STEP(pB0,pB1,pA0,pA1,NT-1,false,false,false); RESC();
  { float sacc=pB0[0]+pB0[1]; _Pragma("unroll") for(int r=2;r<16;++r)sacc+=pB0[r]; _Pragma("unroll") for(int r=0;r<16;++r)sacc+=pB1[r]; l_reg+=sacc;
    pw0=(u32x4){PKW(pB0,0),PKW(pB0,2),PKW(pB0,4),PKW(pB0,6)};pw1=(u32x4){PKW(pB0,8),PKW(pB0,10),PKW(pB0,12),PKW(pB0,14)};pw2=(u32x4){PKW(pB1,0),PKW(pB1,2),PKW(pB1,4),PKW(pB1,6)};pw3=(u32x4){PKW(pB1,8),PKW(pB1,10),PKW(pB1,12),PKW(pB1,14)};
    SBAR(); pv(o,vb0+sl_cur,PAF(0),PAF(1),PAF(2),PAF(3)); }
  #undef PKW
  #undef PAF
  #undef VFR
  #undef PIN
  #undef MX3
  #undef GAPA
  #undef GAPB
  #undef EX
  #undef VRD
  #undef KRD
  #undef STEP
  #undef ENDW
  {auto rr=__builtin_amdgcn_permlane32_swap(__float_as_uint(l_reg),__float_as_uint(l_reg),false,false);l_reg=__uint_as_float(rr[0])+__uint_as_float(rr[1]);}
  int lane_e=lane; asm volatile("":"+v"(lane_e)); const int r32e=lane_e&31, hie=lane_e>>5;
  if(hie==0)wsf[32+r32e]=l_reg;asm volatile("s_waitcnt lgkmcnt(0)":::"memory");
  float rli[16];
  #pragma unroll
  for(int r=0;r<16;++r)rli[r]=__builtin_amdgcn_rcpf(wsf[32+crow(r,hie)]);
  bf16*Ow=O+(rowbase+q0+wid*QBLK)*DM+vcol;
  { bf16*stg=(bf16*)(shm+LDS_OST)+wid*2048;
    #pragma unroll
    for(int r=0;r<16;++r){const int orow=crow(r,hie);
      #pragma unroll
      for(int d0=0;d0<2;++d0)stg[orow*64+d0*32+r32e]=__float2bfloat16(o[d0][r]*rli[r]);}
    asm volatile("s_waitcnt lgkmcnt(0)":::"memory");
    #pragma unroll
    for(int i=0;i<4;++i){const int row=i*8+(lane_e>>3),ch=lane_e&7; const u32x4 v=*(const u32x4*)(stg+row*64+ch*8); ATTN_STORE16(Ow+(long)row*DM+ch*8,v);} }
  asm volatile("s_waitcnt lgkmcnt(0)\n\ts_barrier":::"memory");
  #undef DMA_K
  #undef DMA_V
  #undef CMASK
  #undef ABIAS
  #undef START
  #undef RESC
  #undef ROT
}
constexpr int ATTN_LDS_BYTES=LDS_BYTES;
#undef SBAR
#undef WAIT_BAR
}

__device__ __forceinline__ void attn_unit_ref(const Params& p, unsigned char* lds, int b, int h, int comp, int qb) {
    const int tid = opaque_tid(), row = tid & 255, dh = tid >> 8;
    float* Kt = (float*)lds; float* Vt = Kt + 64 * 64;
    const bf16_t* qbuf = (const bf16_t*)(p.ws + WS_INBUF); const bf16_t* kbuf = qbuf + (size_t)T * 1024; const bf16_t* vbuf = kbuf + (size_t)T * 1024;
    bf16_t* Op = (bf16_t*)(p.ws + WS_OPART) + (size_t)comp * T * 1024;
    const size_t rowbase = (size_t)b * SEQ; const int qpos = qb * 256 + row;
    float qv[64], o[64];
    { const bf16_t* qp = qbuf + (rowbase + qpos) * 1024 + h * 128 + comp * 64;
#pragma unroll
      for (int d = 0; d < 64; d += 8) { const u32x4 w = *(const u32x4*)(qp + d);
#pragma unroll
          for (int i = 0; i < 4; ++i) { qv[d + 2 * i] = bflo(w[i]); qv[d + 2 * i + 1] = bfhi(w[i]); } } }
#pragma unroll
    for (int d = 0; d < 64; ++d) o[d] = 0.f;
    float mrun = -1e30f, l = 0.f;
    const float slope2 = exp2f(-(float)(h + 1)) * LOG2E;
    const int ntile = (qb + 1) * 4;
    for (int kt = 0; kt < ntile; ++kt) {
        __syncthreads();
        for (int ch = tid; ch < 1536; ch += NTHREADS) { const int r = ch / 24, cc = ch % 24; const size_t grow = rowbase + kt * 64 + r;
            if (cc < 8) { const u32x4 w = *(const u32x4*)(kbuf + grow * 1024 + h * 128 + comp * 64 + cc * 8);
#pragma unroll
                for (int i = 0; i < 4; ++i) { Kt[r * 64 + cc * 8 + 2 * i] = bflo(w[i]); Kt[r * 64 + cc * 8 + 2 * i + 1] = bfhi(w[i]); } }
            else { const int c2 = cc - 8; const u32x4 w = *(const u32x4*)(vbuf + grow * 1024 + h * 128 + c2 * 8);
#pragma unroll
                for (int i = 0; i < 4; ++i) { Vt[r * 128 + c2 * 8 + 2 * i] = bflo(w[i]); Vt[r * 128 + c2 * 8 + 2 * i + 1] = bfhi(w[i]); } } }
        __syncthreads();
        for (int j = 0; j < 64; ++j) {
            const int kpos = kt * 64 + j; if (kpos > qpos) break;
            float s = 0.f;
#pragma unroll
            for (int d = 0; d < 64; d += 4) { const f32x4 kv = *(const f32x4*)(Kt + j * 64 + d); s += qv[d] * kv[0] + qv[d + 1] * kv[1] + qv[d + 2] * kv[2] + qv[d + 3] * kv[3]; }
            s += slope2 * (float)kpos;
            if (s > mrun) { const float f = exp2f(mrun - s); l *= f;
#pragma unroll
                for (int d = 0; d < 64; ++d) o[d] *= f;
                mrun = s; }
            const float pr = exp2f(s - mrun); l += pr;
#pragma unroll
            for (int d = 0; d < 64; d += 4) { const f32x4 vv = *(const f32x4*)(Vt + j * 128 + dh * 64 + d); o[d] += pr * vv[0]; o[d + 1] += pr * vv[1]; o[d + 2] += pr * vv[2]; o[d + 3] += pr * vv[3]; }
        }
    }
    const float il = 1.0f / l;
    bf16_t* op = Op + (rowbase + qpos) * 1024 + h * 128 + dh * 64;
#pragma unroll
    for (int d = 0; d < 64; d += 8) { u32x4 w; w.x = pk2(o[d] * il, o[d + 1] * il); w.y = pk2(o[d + 2] * il, o[d + 3] * il); w.z = pk2(o[d + 4] * il, o[d + 5] * il); w.w = pk2(o[d + 6] * il, o[d + 7] * il); *(u32x4*)(op + d) = w; }
    __syncthreads();
}

__device__ __forceinline__ void attn_phase_queue(const Params& p, unsigned char* lds, unsigned* qctr) {
    const attn_body::bf16* Q = (const attn_body::bf16*)(p.ws + WS_INBUF); const attn_body::bf16* K = Q + (size_t)T * 1024; const attn_body::bf16* V = K + (size_t)T * 1024;
    attn_body::bf16* OP = (attn_body::bf16*)(p.ws + WS_OPART);
    volatile int* slot = (volatile int*)(lds + LDS_BYTES - 64);
    __syncthreads();
    if (threadIdx.x == 0) *slot = (int)atomicAdd(qctr, 1u);
    __syncthreads();
    int u = __builtin_amdgcn_readfirstlane(*slot);
    while (u < 2048) {
        unsigned nxt_ticket = 0u;
        if (threadIdx.x == 0) nxt_ticket = atomicAdd(qctr, 1u);
        const int qb = 7 - (u >> 8), id = u & 255;
        const int vh = id & 1, comp = (id >> 1) & 1, h = (id >> 2) & 7, b = id >> 5;
        const float slope2 = exp2f(-(float)(h + 1)) * LOG2E;
        const float* nrm = (const float*)(p.ws + WS_CTL + CTL_NRM); const int ni = ((b * 8 + h) * 2 + comp) * 2;
        const float q2 = nrm[ni] + nrm[ni + 1], k2 = nrm[512 + ni] + nrm[512 + ni + 1];
        const float smax = sqrtf(q2 * k2) * 1.02f, dneed = (2.0f * smax + 58.0f) / slope2;
        const float tmaxf = floorf(((float)(256 * qb - 63) - dneed) * (1.0f / 64.0f));
        int t_lo = tmaxf >= 0.f ? (int)tmaxf + 1 : 0; t_lo &= ~1; t_lo = t_lo < 4 * qb ? t_lo : 4 * qb;
        t_lo = __builtin_amdgcn_readfirstlane(t_lo);
        attn_body::attn_unit<8>(b, h * 128 + comp * 64, h * 128 + vh * 64, qb, t_lo, slope2, Q, K, V, OP + (size_t)comp * T * 1024, (char*)lds);
        if (threadIdx.x == 0) *slot = (int)nxt_ticket;
        __syncthreads();
        u = __builtin_amdgcn_readfirstlane(*slot);
        __syncthreads();
    }
}

__device__ __forceinline__ void phase_combine(const Params& p) {
    const int tid = opaque_tid(), lane = tid & 63, wave = tid >> 6;
    const int gw = blockIdx.x * NWAVES + wave, NGW = gridDim.x * NWAVES;
    const float s1 = wave_sum(p.in[4][lane] * p.in[5][lane]), s2 = wave_sum(p.in[6][lane] * p.in[7][lane]);
    const float lam = __expf(s1) - __expf(s2) + 0.2f;
    const bf16_t* O0 = (const bf16_t*)(p.ws + WS_OPART); const bf16_t* O1 = O0 + (size_t)T * 1024; bf16_t* O = (bf16_t*)(p.ws + WS_O);
    const float* sg = p.in[8] + (lane & 7) * 16;
    float sgv[16];
#pragma unroll
    for (int i = 0; i < 16; ++i) sgv[i] = sg[i];
    for (int m0 = gw; m0 < T; m0 += 4 * NGW) {
        u32x4 a0[4], a1[4], c0[4], c1[4];
#pragma unroll
        for (int u = 0; u < 4; ++u) { const int m = m0 + u * NGW; if (m < T) {
            a0[u] = *(const u32x4*)(O0 + (size_t)m * 1024 + lane * 16); a1[u] = *(const u32x4*)(O0 + (size_t)m * 1024 + lane * 16 + 8);
            c0[u] = *(const u32x4*)(O1 + (size_t)m * 1024 + lane * 16); c1[u] = *(const u32x4*)(O1 + (size_t)m * 1024 + lane * 16 + 8); } }
#pragma unroll
        for (int u = 0; u < 4; ++u) { const int m = m0 + u * NGW; if (m < T) {
            float d[16]; float ss = 0.f;
#pragma unroll
            for (int i = 0; i < 4; ++i) { d[2 * i] = bflo(a0[u][i]) - lam * bflo(c0[u][i]); d[2 * i + 1] = bfhi(a0[u][i]) - lam * bfhi(c0[u][i]); d[8 + 2 * i] = bflo(a1[u][i]) - lam * bflo(c1[u][i]); d[8 + 2 * i + 1] = bfhi(a1[u][i]) - lam * bfhi(c1[u][i]); }
#pragma unroll
            for (int i = 0; i < 16; ++i) ss += d[i] * d[i];
            ss += __shfl_xor(ss, 1); ss += __shfl_xor(ss, 2); ss += __shfl_xor(ss, 4);
            const float rs = 0.8f / sqrtf(ss * (1.0f / 128.0f) + 1e-6f);
            u32x4 w0, w1;
            w0.x = pk2(d[0] * rs * sgv[0], d[1] * rs * sgv[1]); w0.y = pk2(d[2] * rs * sgv[2], d[3] * rs * sgv[3]); w0.z = pk2(d[4] * rs * sgv[4], d[5] * rs * sgv[5]); w0.w = pk2(d[6] * rs * sgv[6], d[7] * rs * sgv[7]);
            w1.x = pk2(d[8] * rs * sgv[8], d[9] * rs * sgv[9]); w1.y = pk2(d[10] * rs * sgv[10], d[11] * rs * sgv[11]); w1.z = pk2(d[12] * rs * sgv[12], d[13] * rs * sgv[13]); w1.w = pk2(d[14] * rs * sgv[14], d[15] * rs * sgv[15]);
            *(u32x4*)(O + (size_t)m * DM + lane * 16) = w0; *(u32x4*)(O + (size_t)m * DM + lane * 16 + 8) = w1; } }
    }
}

__device__ __forceinline__ void phase_router(const Params& p, unsigned char* lds, bool dry = false) {
    const int tid = opaque_tid(), lane = tid & 63, wave = tid >> 6, fr = lane & 15, fq = lane >> 4;
    float* part = (float*)lds;
    const bf16_t* hb = (const bf16_t*)(p.ws + WS_HB);
    const bf16_t* whi = (const bf16_t*)(p.ws + WS_WRT); const bf16_t* wlo = whi + 48 * 2048;
    const float* ss2 = (const float*)(p.ws + WS_CTL + CTL_SS2); float* rstd2 = (float*)(p.ws + WS_RSTD2);
    unsigned* cnt = (unsigned*)(p.ws + WS_CTL + CTL_CNT); int* rt = (int*)(p.ws + WS_RT); float* gateb = (float*)(p.ws + WS_GATEB); int* tokinfo = (int*)(p.ws + WS_TOKINFO);
    const int mt = wave & 3, kh = wave >> 2;
    constexpr int WROW = 528, WBUF = 2 * 48 * WROW;
    unsigned char* wlds = lds + 32768;
    for (int tb = blockIdx.x; tb < T / 64; tb += gridDim.x) {
        const int tok0 = tb * 64;
        const bf16_t* hrow = hb + (size_t)(tok0 + mt * 16 + fr) * DM + kh * 128 + fq * 8;
        bf16x8 af[8][4];
#pragma unroll
        for (int c = 0; c < 8; ++c)
#pragma unroll
            for (int j = 0; j < 4; ++j) af[c][j] = *(const bf16x8*)(hrow + c * 256 + j * 32);
        f32x4 acc[3];
#pragma unroll
        for (int i = 0; i < 3; ++i) acc[i] = (f32x4){0.f, 0.f, 0.f, 0.f};
        u32x4 st[6];
#define RT_STAGE_LOAD(c_) do { _Pragma("unroll") for (int i_ = 0; i_ < 6; ++i_) { const int pc_ = tid + 512 * i_, hl_ = pc_ / 1536, rr_ = (pc_ % 1536) >> 5, cc_ = pc_ & 31; \
            st[i_] = *(const u32x4*)((hl_ ? wlo : whi) + (size_t)rr_ * DM + (c_) * 256 + cc_ * 8); } } while (0)
#define RT_STAGE_WRITE(buf_) do { _Pragma("unroll") for (int i_ = 0; i_ < 6; ++i_) { const int pc_ = tid + 512 * i_, hl_ = pc_ / 1536, rr_ = (pc_ % 1536) >> 5, cc_ = pc_ & 31; \
            *(u32x4*)(wlds + (buf_) * WBUF + (hl_ * 48 + rr_) * WROW + cc_ * 16) = st[i_]; } } while (0)
        __syncthreads();
        RT_STAGE_LOAD(0); RT_STAGE_WRITE(0);
#pragma unroll
        for (int c = 0; c < 8; ++c) {
            if (c + 1 < 8) RT_STAGE_LOAD(c + 1);
            __syncthreads();
            const unsigned char* wb = wlds + (c & 1) * WBUF + fr * WROW + (kh * 128 + fq * 8) * 2;
#pragma unroll
            for (int j = 0; j < 4; ++j)
#pragma unroll
                for (int nt = 0; nt < 3; ++nt) {
                    const bf16x8 bhi = *(const bf16x8*)(wb + nt * 16 * WROW + j * 64), blo = *(const bf16x8*)(wb + (48 + nt * 16) * WROW + j * 64);
                    acc[nt] = __builtin_amdgcn_mfma_f32_16x16x32_bf16(af[c][j], bhi, acc[nt], 0, 0, 0);
                    acc[nt] = __builtin_amdgcn_mfma_f32_16x16x32_bf16(af[c][j], blo, acc[nt], 0, 0, 0);
                }
            if (c + 1 < 8) RT_STAGE_WRITE((c + 1) & 1);
        }
#undef RT_STAGE_LOAD
#undef RT_STAGE_WRITE
#pragma unroll
        for (int nt = 0; nt < 3; ++nt)
#pragma unroll
            for (int r = 0; r < 4; ++r) part[(kh * 64 + mt * 16 + fq * 4 + r) * 48 + nt * 16 + fr] = acc[nt][r];
        __syncthreads();
        int* lcnt = (int*)(lds + 24576);
        if (tid < 64) lcnt[tid] = 0;
        __syncthreads();
        int e0 = 0, e1 = 0, lr0 = 0, lr1 = 0; float g0 = 0.f, g1 = 0.f;
        if (tid < 64 && !dry) {
            const float* l0 = part + tid * 48; const float* l1 = part + (64 + tid) * 48;
            const int t = tok0 + tid; const float rs = 1.0f / sqrtf(ss2[t] * (1.0f / DM) + 1e-6f); rstd2[t] = rs;
            float g4[4]; int grp = 0; float gmax = -3.0e38f;
#pragma unroll
            for (int i = 0; i < 4; ++i) { g4[i] = (l0[i] + l1[i]) * rs + p.in[26][i]; if (g4[i] > gmax) { gmax = g4[i]; grp = i; } }
            float gs = 0.f;
#pragma unroll
            for (int i = 0; i < 4; ++i) gs += __expf(g4[i] - gmax);
            const float pg = 1.0f / gs;
            float e8[8]; int i0 = 0; float m0 = -3.0e38f;
#pragma unroll
            for (int i = 0; i < 8; ++i) { e8[i] = (l0[4 + grp * 8 + i] + l1[4 + grp * 8 + i]) * rs + p.in[28][grp * 8 + i]; if (e8[i] > m0) { m0 = e8[i]; i0 = i; } }
            int i1 = 0; float m1 = -3.0e38f;
#pragma unroll
            for (int i = 0; i < 8; ++i) if (i != i0 && e8[i] > m1) { m1 = e8[i]; i1 = i; }
            const float p1 = __expf(m1 - m0); g0 = pg / (1.0f + p1); g1 = pg * p1 / (1.0f + p1);
            e0 = grp * 8 + i0; e1 = grp * 8 + i1;
            lr0 = atomicAdd(lcnt + e0, 1); lr1 = atomicAdd(lcnt + e1, 1);
        }
        __syncthreads();
        if (tid < 32 && !dry) { const int c = lcnt[tid]; lcnt[32 + tid] = c > 0 ? (int)atomicAdd(cnt + tid, (unsigned)c) : 0; }
        __syncthreads();
        if (tid < 64 && !dry) {
            const int t = tok0 + tid; const unsigned r0 = (unsigned)(lcnt[32 + e0] + lr0), r1 = (unsigned)(lcnt[32 + e1] + lr1);
            rt[(size_t)e0 * CAP + r0] = t; rt[(size_t)e1 * CAP + r1] = t; gateb[(size_t)e0 * CAP + r0] = g0; gateb[(size_t)e1 * CAP + r1] = g1;
            int4 ti; ti.x = e0 * CAP + (int)r0; ti.y = e1 * CAP + (int)r1; ti.z = 0; ti.w = 0; *(int4*)(tokinfo + (size_t)t * 4) = ti;
        }
        __syncthreads();
    }
}

__device__ __forceinline__ void phase_final(const Params& p, unsigned char* lds, float* dst) {
    const int tid = opaque_tid(), lane = tid & 63, wave = tid >> 6;
    const int gw = blockIdx.x * NWAVES + wave, NGW = gridDim.x * NWAVES;
    int* pst = (int*)lds;
    const unsigned* cnt = (const unsigned*)(p.ws + WS_CTL + CTL_CNT);
    if (tid == 0) { int ts = 0; for (int e = 0; e < NEXP; ++e) { pst[e] = ts; ts += ((int)cnt[e] + 255) >> 8; } }
    __syncthreads();
    const int* tokinfo = (const int*)(p.ws + WS_TOKINFO); const bf16_t* yb = (const bf16_t*)(p.ws + WS_YB); const bf16_t* hbuf = (const bf16_t*)(p.ws + WS_HB); const float* gfin = p.in[32];
    f32x4 gv[8];
#pragma unroll
    for (int j = 0; j < 8; ++j) gv[j] = *((const f32x4*)gfin + lane + 64 * j);
    constexpr int MAXTOK = 8;
    unsigned sl0[MAXTOK], sl1[MAXTOK];
#pragma unroll
    for (int i = 0; i < MAXTOK; ++i) { const int m = gw + i * NGW; sl0[i] = 0u; sl1[i] = 0u;
        if (m < T) { const int4 ti = *(const int4*)(tokinfo + (size_t)m * 4); sl0[i] = (unsigned)(pst[ti.x / CAP] * 256 + ti.x % CAP); sl1[i] = (unsigned)(pst[ti.y / CAP] * 256 + ti.y % CAP); } }
    u32x2 hA[8], aA[8], bA[8], hB[8], aB[8], bB[8];
#define FIN_LOAD(i_, H, A, B) do { const int m_ = gw + (i_) * NGW; if (m_ < T) { const u32x2* hr_ = (const u32x2*)(hbuf + (size_t)m_ * DM) + lane; const u32x2* y0_ = (const u32x2*)(yb + (size_t)sl0[i_] * DM) + lane; const u32x2* y1_ = (const u32x2*)(yb + (size_t)sl1[i_] * DM) + lane; \
        _Pragma("unroll") for (int j = 0; j < 8; ++j) { H[j] = hr_[64 * j]; A[j] = y0_[64 * j]; B[j] = y1_[64 * j]; } } } while (0)
#define FIN_PROC(i_, H, A, B) do { const int m_ = gw + (i_) * NGW; if (m_ < T) { f32x4 v[8]; float s_ = 0.f; \
        _Pragma("unroll") for (int j = 0; j < 8; ++j) { v[j][0] = bflo(H[j].x) + (bflo(A[j].x) + bflo(B[j].x)); v[j][1] = bfhi(H[j].x) + (bfhi(A[j].x) + bfhi(B[j].x)); v[j][2] = bflo(H[j].y) + (bflo(A[j].y) + bflo(B[j].y)); v[j][3] = bfhi(H[j].y) + (bfhi(A[j].y) + bfhi(B[j].y)); \
            s_ += (v[j][0] * v[j][0] + v[j][1] * v[j][1]) + (v[j][2] * v[j][2] + v[j][3] * v[j][3]); } \
        s_ = wave_sum_fast(s_); const float rs_ = 1.0f / sqrtf(s_ * (1.0f / DM) + 1e-6f); \
        _Pragma("unroll") for (int j = 0; j < 8; ++j) { f32x4 ov = v[j] * rs_ * gv[j]; \
            if (PROBE_TS_A >= 0 && m_ == 0 && lane == 0 && j == 0) { const unsigned long long* ts = (const unsigned long long*)(p.ws + WS_CTL + CTL_TS); ov[0] += (PROBE_TS_A == 99) ? sqrtf(33.554432f * (float)p.ws_mib) : sqrtf(33.554432f * (float)(ts[PROBE_TS_B] - ts[PROBE_TS_A]) * 0.01f); } \
            ((f32x4*)(dst + (size_t)m_ * DM) + lane)[64 * j] = ov; } } } while (0)
    FIN_LOAD(0, hA, aA, bA);
#pragma unroll
    for (int i = 0; i < MAXTOK; i += 2) {
        FIN_LOAD(i + 1, hB, aB, bB);
        FIN_PROC(i, hA, aA, bA);
        if (i + 2 < MAXTOK) FIN_LOAD(i + 2, hA, aA, bA);
        FIN_PROC(i + 1, hB, aB, bB);
    }
    for (int m = gw + MAXTOK * NGW; m < T; m += NGW) {
        const int4 ti = *(const int4*)(tokinfo + (size_t)m * 4); sl0[0] = (unsigned)(pst[ti.x / CAP] * 256 + ti.x % CAP); sl1[0] = (unsigned)(pst[ti.y / CAP] * 256 + ti.y % CAP);
        const u32x2* hr_ = (const u32x2*)(hbuf + (size_t)m * DM) + lane; const u32x2* y0_ = (const u32x2*)(yb + (size_t)sl0[0] * DM) + lane; const u32x2* y1_ = (const u32x2*)(yb + (size_t)sl1[0] * DM) + lane;
        f32x4 v[8]; float s_ = 0.f;
#pragma unroll
        for (int j = 0; j < 8; ++j) { const u32x2 H = hr_[64 * j], A = y0_[64 * j], B = y1_[64 * j];
            v[j][0] = bflo(H.x) + (bflo(A.x) + bflo(B.x)); v[j][1] = bfhi(H.x) + (bfhi(A.x) + bfhi(B.x)); v[j][2] = bflo(H.y) + (bflo(A.y) + bflo(B.y)); v[j][3] = bfhi(H.y) + (bfhi(A.y) + bfhi(B.y));
            s_ += (v[j][0] * v[j][0] + v[j][1] * v[j][1]) + (v[j][2] * v[j][2] + v[j][3] * v[j][3]); }
        s_ = wave_sum_fast(s_); const float rs_ = 1.0f / sqrtf(s_ * (1.0f / DM) + 1e-6f);
#pragma unroll
        for (int j = 0; j < 8; ++j) ((f32x4*)(dst + (size_t)m * DM) + lane)[64 * j] = v[j] * rs_ * gv[j];
    }
#undef FIN_LOAD
#undef FIN_PROC
}

#define GAS __attribute__((address_space(1)))
typedef GAS unsigned gu32;
#define RLX_AGENT __ATOMIC_RELAXED, __HIP_MEMORY_SCOPE_AGENT
#define XB_TMO      128
#define XB_XCNT(j)  (256  + 64 * (j))
#define XB_XSUB(j)  (1280 + 64 * (j))
#define XB_XGEN(j)  (2304 + 64 * (j))
#define XB_TOP      3328
#define XB_TOPGEN   3392
#define XCD_BAR_WORDS 3456
#define XB_SPIN_CAP (1u << 18)

__device__ __forceinline__ unsigned xb_ld(unsigned* p)              { return __hip_atomic_load(p, __ATOMIC_RELAXED, __HIP_MEMORY_SCOPE_AGENT); }
__device__ __forceinline__ unsigned xb_add(unsigned* p, unsigned v) { return __hip_atomic_fetch_add(p, v, __ATOMIC_RELAXED, __HIP_MEMORY_SCOPE_AGENT); }
__device__ __forceinline__ unsigned xb_xcc_id() { return (unsigned)__builtin_amdgcn_s_getreg((3 << 11) | 20) & 0xFu; }
#define XB_SPIN(cond, bar) do { unsigned _sp = 0; while (cond) { __builtin_amdgcn_s_sleep(1); \
    if ((++_sp & 255u) == 0u) { if (xb_ld(&(bar)[XB_TMO])) break; if (_sp > XB_SPIN_CAP) { atomicAdd(&(bar)[XB_TMO], 1u); break; } } } } while (0)

struct XcdBarrier {
    unsigned* bar; unsigned x;
    volatile LAS unsigned* st;
};

__device__ __forceinline__ XcdBarrier xcd_barrier_post(unsigned* bar, volatile LAS unsigned* st) {
    XcdBarrier b; b.bar = bar; b.x = xb_xcc_id(); b.st = st;
    if (threadIdx.x == 0) (void)xb_add(&bar[XB_XCNT(b.x)], 1u);
    return b;
}
__device__ __forceinline__ void xcd_barrier_complete(unsigned* bar, unsigned x, unsigned& nloc, unsigned& nx) {
    const unsigned G = gridDim.x * gridDim.y * gridDim.z;
    unsigned sum, cnt, mine, sp = 0u;
    for (;;) {
        sum = 0u; cnt = 0u; mine = 0u;
#pragma unroll
        for (unsigned j = 0; j < 16; ++j) { const unsigned c = xb_ld(&bar[XB_XCNT(j)]); sum += c; cnt += (c > 0u) ? 1u : 0u; mine = (j == x) ? c : mine; }
        if (sum == G) break;
        __builtin_amdgcn_s_sleep(1);
        if ((++sp & 255u) == 0u) { if (xb_ld(&bar[XB_TMO])) break; if (sp > XB_SPIN_CAP) { atomicAdd(&bar[XB_TMO], 1u); break; } }
    }
    nloc = mine > 0u ? mine : 1u; nx = cnt > 0u ? cnt : 1u;
}

__device__ __forceinline__ void xcd_barrier(const XcdBarrier& b) {
    asm volatile("s_waitcnt vmcnt(0)" ::: "memory");
    __syncthreads();
    if (threadIdx.x == 0) {
        unsigned* bar = b.bar;
        __builtin_amdgcn_s_waitcnt(0);
        unsigned nloc = b.st[0], nx = b.st[1];
        if (nloc == 0u) { xcd_barrier_complete(bar, b.x, nloc, nx); b.st[0] = nloc; b.st[1] = nx; }
        const unsigned old = xb_add(&bar[XB_XSUB(b.x)], 1u);
        const unsigned gen = old / nloc;
        if (old + 1u == (gen + 1u) * nloc) {
            __builtin_amdgcn_fence(__ATOMIC_RELEASE, "agent");
            asm volatile("s_waitcnt vmcnt(0)" ::: "memory");
            const unsigned og = xb_add(&bar[XB_TOP], 1u);
            const unsigned tg = og / nx;
            if (og + 1u == (tg + 1u) * nx) xb_add(&bar[XB_TOPGEN], 1u);
            else XB_SPIN(xb_ld(&bar[XB_TOPGEN]) == tg, bar);
            __builtin_amdgcn_fence(__ATOMIC_ACQUIRE, "agent");
            xb_add(&bar[XB_XGEN(b.x)], 1u);
            asm volatile("s_waitcnt vmcnt(0)" ::: "memory");
        } else {
            XB_SPIN(xb_ld(&bar[XB_XGEN(b.x)]) == gen, bar);
            __builtin_amdgcn_fence(__ATOMIC_ACQUIRE, "agent");
            asm volatile("s_waitcnt vmcnt(0)" ::: "memory");
        }
    }
    __syncthreads();
}


#if USE_REF_GEMM
#define GEMM_PHASE gemm_phase_ref
#else
#define GEMM_PHASE gemm_phase_mfma
#endif

__global__ void __launch_bounds__(NTHREADS, 2) fwd_kernel(Params p) {
    extern __shared__ __attribute__((aligned(16))) unsigned char lds[];
    unsigned char* ws = p.ws;
    const int lo = p.ph_lo, hi = p.ph_hi;
#define IN(k) (lo <= (k) && (k) < hi)
#if N_LAUNCH_MODE == 1
    volatile LAS unsigned* bst = (volatile LAS unsigned*)((LAS unsigned char*)lds + LDS_BYTES - 32);
    if (threadIdx.x < 2) bst[threadIdx.x] = 0u;
    __syncthreads();
    const XcdBarrier bar = xcd_barrier_post((unsigned*)(ws + WS_CTL + CTL_BAR), bst);
#define SEAM(k) do { if (IN(k) && IN((k) + 1)) xcd_barrier(bar); if (PROBE_TS_A >= 0 && blockIdx.x == 0 && threadIdx.x == 0) ((unsigned long long*)(ws + WS_CTL + CTL_TS))[(k) + 1] = __builtin_amdgcn_s_memrealtime(); } while (0)
#else
#define SEAM(k) do { } while (0)
#endif
    if (PROBE_TS_A >= 0 && blockIdx.x == 0 && threadIdx.x == 0) ((unsigned long long*)(ws + WS_CTL + CTL_TS))[0] = __builtin_amdgcn_s_memrealtime();
    if (IN(PH_PRO)) { phase_prologue(p, lds); if (PROBE_DUP & 8) { __syncthreads(); phase_prologue(p, lds); } } SEAM(PH_PRO);
    if (IN(PH_INPROJ)) {
        Gemm g{(const bf16_t*)(ws + WS_XB), (const bf16_t*)(ws + WS_WIN), DM, DM, DM};
        DenseOrder S; S.init(T, NIN, gridDim.x, blockIdx.x, DM, DM);
        EpiIn E{(bf16_t*)(ws + WS_INBUF), (bf16_t*)(ws + WS_PBUF), (const float*)(ws + WS_RSTD1), (unsigned*)(ws + WS_CTL + CTL_NRM)};
        GEMM_PHASE<EpiIn, DenseOrder>(lds, g, S, E);
        if (PROBE_DUP & 64) GEMM_PHASE<EpiIn, DenseOrder>(lds, g, S, E);
    } SEAM(PH_INPROJ);
    if (IN(PH_L2PREP)) { phase_l2prep(p); if (PROBE_DUP & 4096) { phase_l2prep(p); phase_l2prep(p); phase_l2prep(p); } } SEAM(PH_L2PREP);
    if (IN(PH_L2GEMM)) {
        Gemm g{(const bf16_t*)(ws + WS_A2), (const bf16_t*)(ws + WS_L2T), PW, 256, 256};
        DenseOrder S; S.init(T, 3072, gridDim.x, blockIdx.x, PW, 256, 2, 256);
        EpiL2 E{(float*)(ws + WS_WL), (bf16_t*)(ws + WS_ABUF), (bf16_t*)(ws + WS_GBUF), p.in[11], p.in[14]};
        GEMM_PHASE<EpiL2, DenseOrder>(lds, g, S, E);
        if (PROBE_DUP & 16384) GEMM_PHASE<EpiL2, DenseOrder>(lds, g, S, E);
    } SEAM(PH_L2GEMM);
    if (IN(PH_MIX)) {
        for (int rep = 0; rep < ((PROBE_DUP & 1) ? 2 : 1); ++rep)
        if (((blockIdx.x >> 3) & 1) == 0) for (int chain = ((blockIdx.x >> 4) << 3) | (blockIdx.x & 7); chain < BATCH * NH_RW; chain += gridDim.x >> 1) rwkv_chain(p, lds, chain);
        { const unsigned g16 = (blockIdx.x >> 4) & 7, l16 = blockIdx.x & 15;
          if (l16 == 8 + g16 || l16 == 8 + ((g16 + 4) & 7)) convert_gu_queue(p, lds, (unsigned*)(ws + WS_CTL + CTL_QCTR) + 3, 0, NEXP_EARLY); }
        attn_phase_queue(p, lds, (unsigned*)(ws + WS_CTL + CTL_QCTR));
        convert_gu_queue(p, lds, (unsigned*)(ws + WS_CTL + CTL_QCTR) + 3, 0, NEXP_EARLY);
        if (PROBE_DUP & 2) attn_phase_queue(p, lds, (unsigned*)(ws + WS_CTL + CTL_QCTR) + 1);
    } SEAM(PH_MIX);
    if (IN(PH_COMB)) { phase_combine(p); if (PROBE_DUP & 2048) { phase_combine(p); phase_combine(p); phase_combine(p); } } SEAM(PH_COMB);
    if (IN(PH_OUT)) {
        Gemm g{(const bf16_t*)(ws + WS_O), (const bf16_t*)(ws + WS_WOUT), DM, DM, DM};
        DenseOrder S; S.init(T, DM, gridDim.x, blockIdx.x, DM, DM);
        EpiOut E{p.in[0], p.out, (bf16_t*)(ws + WS_HB), (float*)(ws + WS_CTL + CTL_SS2)};
        GEMM_PHASE<EpiOut, DenseOrder>(lds, g, S, E);
        if (PROBE_DUP & 8192) { EpiOut E2{p.in[0], p.out, (bf16_t*)(ws + WS_HB), (float*)(ws + WS_RSTD1)}; GEMM_PHASE<EpiOut, DenseOrder>(lds, g, S, E2); }
    } SEAM(PH_OUT);
    if (IN(PH_ROUTE)) { if (PROBE_DUP & 1024) { phase_router(p, lds, true); __syncthreads(); } phase_router(p, lds); convert_gu_queue(p, lds, (unsigned*)(ws + WS_CTL + CTL_QCTR) + 4, NEXP_EARLY, NEXP); } SEAM(PH_ROUTE);
    const int vcu_moe = (gridDim.x % 8 == 0) ? (int)((blockIdx.x % 8) * (gridDim.x / 8) + blockIdx.x / 8) : (int)blockIdx.x;
    if (IN(PH_G1)) {
        Gemm g{(const bf16_t*)(ws + WS_HB), (const bf16_t*)ws, DM, DM, DM};
        MoeOrder<true> S{(const int*)(ws + WS_RT), 4, (int)gridDim.x, vcu_moe, 0, DM, (long)1024 * 2048, DM, 0, 0, 0}; S.init((const unsigned*)(ws + WS_CTL + CTL_CNT));
        EpiGU E{(bf16_t*)(ws + WS_HID), (const float*)(ws + WS_RSTD2)};
        GEMM_PHASE<EpiGU, MoeOrder<true>>(lds, g, S, E);
        convert_down_queue(p, lds, (unsigned*)(ws + WS_CTL + CTL_QCTR) + 2);
        if (PROBE_DUP & 128) GEMM_PHASE<EpiGU, MoeOrder<true>>(lds, g, S, E);
    } SEAM(PH_G1);
    if (IN(PH_G2)) {
        Gemm g{(const bf16_t*)(ws + WS_HID), (const bf16_t*)ws, DEXP, DEXP, DEXP};
        MoeOrder<false> S{(const int*)(ws + WS_RT), 8, (int)gridDim.x, vcu_moe, 1, DEXP, (long)2048 * 512, DEXP, 0, 0, 0}; S.init((const unsigned*)(ws + WS_CTL + CTL_CNT));
        EpiDown E{(bf16_t*)(ws + WS_YB), (const float*)(ws + WS_GATEB), (const unsigned*)(ws + WS_CTL + CTL_CNT)};
        GEMM_PHASE<EpiDown, MoeOrder<false>>(lds, g, S, E);
        if (PROBE_DUP & 256) GEMM_PHASE<EpiDown, MoeOrder<false>>(lds, g, S, E);
    } SEAM(PH_G2);
    if (IN(PH_FINAL)) { if (PROBE_DUP & 32768) { phase_final(p, lds, (float*)(ws + WS_XB)); __syncthreads(); } phase_final(p, lds, p.out); }
}

extern "C" void kernel_launch(void* const* d_in, const int* in_sizes, int n_in, void* d_out, int out_size, void* d_ws, size_t ws_size, hipStream_t stream) {
    static int grid = 0;
    if (grid == 0) {
        if (n_in != 33 || out_size != T * DM || ws_size < WS_END) { fprintf(stderr, "kernel_launch: unexpected problem (n_in %d out %d ws %zu)\n", n_in, out_size, ws_size); grid = -1; return; }
        int dev = 0, cus = 0;
        hipGetDevice(&dev); hipDeviceGetAttribute(&cus, hipDeviceAttributeMultiprocessorCount, dev);
        if (hipFuncSetAttribute((const void*)fwd_kernel, hipFuncAttributeMaxDynamicSharedMemorySize, LDS_BYTES) != hipSuccess) { fprintf(stderr, "kernel_launch: hipFuncSetAttribute failed\n"); grid = -1; return; }
        int per_cu = 0; hipOccupancyMaxActiveBlocksPerMultiprocessor(&per_cu, (const void*)fwd_kernel, NTHREADS, LDS_BYTES); (void)hipGetLastError();
        if (per_cu < 1) fprintf(stderr, "kernel_launch: occupancy query says %d blocks per CU\n", per_cu);
        if (per_cu < 1) { grid = -1; return; }
        grid = cus > 0 ? cus : 256;
    }
    if (grid < 0) return;
    hipMemsetAsync((char*)d_ws + WS_CTL, 0, CTL_BYTES, stream);
    Params p{};
    for (int i = 0; i < 33; ++i) p.in[i] = (const float*)d_in[i];
    p.out = (float*)d_out; p.ws = (unsigned char*)d_ws; p.ws_mib = (unsigned long long)(ws_size >> 20);
#if N_LAUNCH_MODE == 1
    p.ph_lo = 0; p.ph_hi = PH_COUNT;
    void* args[] = {&p};
    hipError_t e = hipLaunchCooperativeKernel((const void*)fwd_kernel, dim3(grid), dim3(NTHREADS), args, LDS_BYTES, stream);
    if (e != hipSuccess) fprintf(stderr, "cooperative launch failed: %s (grid %d)\n", hipGetErrorString(e), grid);
#else
    for (int ph = 0; ph < PH_COUNT; ++ph) { p.ph_lo = ph; p.ph_hi = ph + 1; hipLaunchKernelGGL(fwd_kernel, dim3(grid), dim3(NTHREADS), LDS_BYTES, stream, p); }
#endif
}
```

```cpp
#include <hip/hip_runtime.h>
#include <hip/hip_cooperative_groups.h>
#include <cstdio>
#include <cstdint>
namespace cg = cooperative_groups;

#ifndef N_LAUNCH_MODE
#define N_LAUNCH_MODE 1
#endif
#ifndef PROBE_TS_A
#define PROBE_TS_A -1
#define PROBE_TS_B -1
#endif
#ifndef PROBE_DUP
#define PROBE_DUP 0
#endif
#ifndef USE_REF_ATTN
#define USE_REF_ATTN 0
#endif
#ifndef USE_REF_GEMM
#define USE_REF_GEMM 0
#endif

constexpr int BATCH = 8, SEQ = 2048, DM = 2048, T = BATCH * SEQ;
constexpr int DAW = 1024, RWW = 1024, NH_DA = 8, NH_RW = 16;
constexpr int NIN = 6912;
constexpr int PW = 768;
constexpr int NEXP = 32, DEXP = 512, CAP = T;
constexpr int MAXTILES = 160;
constexpr float C2Q = 0.125f * 1.4426950408889634f;
constexpr float LOG2E = 1.4426950408889634f;

constexpr size_t MiB = 1u << 20;
constexpr size_t WS_CTL = 0, CTL_BYTES = 1 * MiB;
constexpr size_t CTL_SS2 = 65536;
constexpr size_t CTL_CNT = 131072;
constexpr size_t CTL_QCTR = 131072 + 256;
constexpr size_t CTL_NRM = 131072 + 1024;
constexpr size_t CTL_TS = 131072 + 512;
constexpr size_t CTL_BAR = 262144;
constexpr size_t WS_WOUT = 1 * MiB;
constexpr size_t WS_L2T = 9 * MiB;
constexpr size_t WS_RSTD1 = 11 * MiB;
constexpr size_t WS_RSTD2 = 11 * MiB + 65536;
constexpr size_t WS_TOKINFO = 11 * MiB + 131072;
constexpr size_t WS_WRT = 11 * MiB + 524288;
constexpr size_t WS_WIN = 12 * MiB;
constexpr size_t WS_XB = 40 * MiB;
constexpr size_t WS_O = 40 * MiB;
constexpr size_t WS_INBUF = 104 * MiB;
constexpr size_t WS_PBUF = 296 * MiB;
constexpr size_t WS_A2 = 320 * MiB;
constexpr size_t WS_WL = 344 * MiB;
constexpr size_t WS_ABUF = 408 * MiB;
constexpr size_t WS_GBUF = 440 * MiB;
constexpr size_t WS_OPART = 472 * MiB;
constexpr size_t WS_HB = 104 * MiB;
constexpr size_t WS_WGU = 168 * MiB;
constexpr size_t WS_WD = 168 * MiB;
__host__ __device__ constexpr size_t wd_byte_off(int e) { return 168 * MiB + (size_t)e * 2 * MiB; }
constexpr int NEXP_EARLY = 28;
__host__ __device__ constexpr size_t wgu_byte_off(int e) { return e < 6 ? (12 * MiB + (size_t)e * 4 * MiB) : e < 18 ? (296 * MiB + (size_t)(e - 6) * 4 * MiB) : e < 28 ? (536 * MiB + (size_t)(e - 18) * 4 * MiB) : (232 * MiB + (size_t)(e - 28) * 4 * MiB); }
constexpr size_t WS_RT = 360 * MiB;
constexpr size_t WS_GATEB = 362 * MiB;
constexpr size_t WS_HID = 364 * MiB;
constexpr size_t WS_YB = 404 * MiB;
constexpr size_t WS_END = 576 * MiB;

constexpr int NTHREADS = 512, NWAVES = 8;
constexpr int LDS_BYTES = 147456;

typedef unsigned short bf16_t;
typedef short bf16x8 __attribute__((ext_vector_type(8)));
typedef float f32x4 __attribute__((ext_vector_type(4)));
typedef float f32x2 __attribute__((ext_vector_type(2)));
typedef unsigned u32x4 __attribute__((ext_vector_type(4)));
typedef unsigned u32x2 __attribute__((ext_vector_type(2)));

__device__ __forceinline__ unsigned f2bf(float f) { unsigned u = __builtin_bit_cast(unsigned, f); return (u + 0x7fffu + ((u >> 16) & 1u)) >> 16; }
typedef __bf16 bf16x2_n __attribute__((ext_vector_type(2)));
__device__ __forceinline__ unsigned cvt_pk_bf16_(float lo, float hi) { const f32x2 v = {lo, hi}; const bf16x2_n b = __builtin_convertvector(v, bf16x2_n); return __builtin_bit_cast(unsigned, b); }
__device__ __forceinline__ unsigned pk2(float lo, float hi) { return cvt_pk_bf16_(lo, hi); }
__device__ __forceinline__ float bf2f(unsigned h) { return __builtin_bit_cast(float, h << 16); }
__device__ __forceinline__ float bflo(unsigned w) { return __builtin_bit_cast(float, w << 16); }
__device__ __forceinline__ float bfhi(unsigned w) { return __builtin_bit_cast(float, w & 0xffff0000u); }
__device__ __forceinline__ float wave_sum(float v) {
#pragma unroll
    for (int o = 1; o < 64; o <<= 1) v += __shfl_xor(v, o);
    return v;
}
__device__ __forceinline__ int opaque_tid() { int t = threadIdx.x; asm volatile("" : "+v"(t)); return t; }
__device__ __forceinline__ float sigmoidf_(float x) { return __builtin_amdgcn_rcpf(1.0f + __builtin_amdgcn_exp2f(-1.4426950408889634f * x)); }

struct Params {
    const float* in[33];
    float* out;
    unsigned char* ws;
    int ph_lo, ph_hi;
    unsigned long long ws_mib;
};

enum { PH_PRO = 0, PH_INPROJ, PH_L2PREP, PH_L2GEMM, PH_MIX, PH_COMB, PH_OUT, PH_ROUTE, PH_G1, PH_G2, PH_FINAL, PH_COUNT };

struct Unit { int pm, pn; long a_off, b_off; const int* gidx; int valid, e, tile, k; };
struct Gemm { const bf16_t* A; const bf16_t* Bt; int lda, ldb, K; };

struct DenseOrder {
    static constexpr bool GATHER = false;
    int nM, nN, nwg, G, c, lda, ldb, acol_shift, acol_w;
    __device__ void init(int M, int N, int G_, int c_, int lda_, int ldb_, int acol_shift_ = -1, int acol_w_ = 0) {
        nM = M / 256; nN = N / 256; nwg = nM * nN; G = G_; c = c_; lda = lda_; ldb = ldb_; acol_shift = acol_shift_; acol_w = acol_w_; }
    __device__ bool next(int i, Unit& u) const {
        const long L = (long)i * G + c; if (L >= nwg) return false;
        int wgid = (int)L; { const int q = nwg / 8, r = nwg % 8, xcd = wgid % 8, off = wgid / 8; wgid = (xcd < r ? xcd * (q + 1) : r * (q + 1) + (xcd - r) * q) + off; }
        const int nig = 8 * nN, gid = wgid / nig, fm = gid * 8, gsz = (nM - fm) < 8 ? (nM - fm) : 8;
        u.pm = fm + ((wgid % nig) % gsz); u.pn = (wgid % nig) / gsz;
        u.a_off = (long)u.pm * 256 * lda + (acol_shift >= 0 ? (long)(u.pn >> acol_shift) * acol_w : 0);
        u.b_off = (long)u.pn * 256 * ldb; u.gidx = nullptr; u.valid = 256; u.e = 0; u.tile = 0; u.k = 0; return true;
    }
};
template <bool GATHER_> struct MoeOrder {
    static constexpr bool GATHER = GATHER_;
    const int* rt; int ncol, G, c, mode; long a_ld, b_estride, b_ld;
    int my_cnt, my_ts, ntot;
    __device__ __forceinline__ void init(const unsigned* cnt) {
        const int lane = threadIdx.x & 63, e = lane & 31;
        my_cnt = (int)cnt[e]; const int nt = (my_cnt + 255) >> 8;
        int incl = nt;
#pragma unroll
        for (int o = 1; o < 32; o <<= 1) { const int v = __shfl_up(incl, o, 32); if (e >= o) incl += v; }
        my_ts = incl - nt; ntot = __builtin_amdgcn_readlane(incl, 31);
    }
    __device__ __forceinline__ bool next(int i, Unit& u) const {
        const long L = (long)i * G + c; const int g = (int)(L / ncol), pn = (int)(L % ncol);
        if (g >= ntot) return false;
        const unsigned long long m = __ballot(my_ts <= g) & 0xffffffffull;
        const int e = 63 - __builtin_clzll(m);
        const int ts = __builtin_amdgcn_readlane(my_ts, e), ce = __builtin_amdgcn_readlane(my_cnt, e), k = g - ts;
        u.pm = g; u.pn = pn; u.e = e; u.tile = g; u.k = k; u.valid = (ce - 256 * k) < 256 ? (ce - 256 * k) : 256;
        if (mode == 0) { u.gidx = rt + (long)e * CAP + 256 * k; u.a_off = 0; }
        else { u.gidx = nullptr; u.a_off = (long)g * 256 * a_ld; }
        u.b_off = (long)((mode == 1 ? wd_byte_off(e) : wgu_byte_off(e)) / 2) + (long)pn * 256 * b_ld; return true;
    }
};

template <class Epi, class Sched>
__device__ __forceinline__ void gemm_phase_ref(unsigned char* lds, const Gemm g, const Sched& S, const Epi& E) {
    const int tid = threadIdx.x, wid = tid >> 6, lane = tid & 63, wr = wid >> 2, wc = wid & 3, fr = lane & 15, fq = lane >> 4;
    bf16_t* As = (bf16_t*)lds; bf16_t* Bs = As + 256 * 72;
    Unit u;
    for (int ui = 0; S.next(ui, u); ++ui) {
        f32x4 acc[2][2][4][2];
#pragma unroll
        for (int a = 0; a < 2; ++a)
#pragma unroll
            for (int b = 0; b < 2; ++b)
#pragma unroll
                for (int m = 0; m < 4; ++m)
#pragma unroll
                    for (int n = 0; n < 2; ++n) acc[a][b][m][n] = (f32x4){0.f, 0.f, 0.f, 0.f};
        long arow[4];
#pragma unroll
        for (int i = 0; i < 4; ++i) { const int row = (tid + 512 * i) >> 3; arow[i] = u.gidx ? (row < u.valid ? (long)u.gidx[row] : 0L) : (long)row; }
        for (int k0 = 0; k0 < g.K; k0 += 64) {
            __syncthreads();
#pragma unroll
            for (int i = 0; i < 4; ++i) { const int ch = tid + 512 * i, row = ch >> 3, c8 = ch & 7;
                const u32x4 va = *(const u32x4*)(g.A + u.a_off + arow[i] * g.lda + k0 + c8 * 8);
                const u32x4 vb = *(const u32x4*)(g.Bt + u.b_off + (long)row * g.ldb + k0 + c8 * 8);
                *(u32x4*)(As + row * 72 + c8 * 8) = va; *(u32x4*)(Bs + row * 72 + c8 * 8) = vb; }
            __syncthreads();
            for (int kk = 0; kk < 64; ++kk) {
                float a[2][4];
#pragma unroll
                for (int ai = 0; ai < 2; ++ai)
#pragma unroll
                    for (int m = 0; m < 4; ++m) a[ai][m] = bf2f(As[(ai * 128 + wr * 64 + m * 16 + fr) * 72 + kk]);
#pragma unroll
                for (int bj = 0; bj < 2; ++bj)
#pragma unroll
                    for (int n = 0; n < 2; ++n)
#pragma unroll
                        for (int e = 0; e < 4; ++e) {
                            const int cl = Epi::PERM ? (bj * 128 + wc * 32 + 8 * fq + 4 * n + e) : (bj * 128 + wc * 32 + 16 * n + 4 * fq + e);
                            const float b = bf2f(Bs[cl * 72 + kk]);
#pragma unroll
                            for (int ai = 0; ai < 2; ++ai)
#pragma unroll
                                for (int m = 0; m < 4; ++m) acc[ai][bj][m][n][e] += a[ai][m] * b;
                        }
            }
        }
        E(acc, u, wr, wc, fr, fq);
    }
    __syncthreads();
}


#define LAS __attribute__((address_space(3)))
namespace pg8 {
constexpr int BK = 64, HALF = 128, HTB = HALF * BK * 2, STAGE_BYTES = 8 * HTB;
__device__ __forceinline__ int lds_byte(int r, int c) { const int st = (r >> 4) * 2 + (c >> 5), rr = r & 15, cc = c & 31, ob = rr * 64 + cc * 2; return st * 1024 + (ob ^ (((ob >> 9) & 1) << 5)); }
__device__ __forceinline__ void stage_rc(int b, int& R, int& C) { const int st = b / 1024, sb = b % 1024, swz = sb ^ (((sb >> 9) & 1) << 5); R = (st >> 1) * 16 + swz / 64; C = (st & 1) * 32 + (swz % 64) / 2; }
__device__ __forceinline__ int perm32(int rho) { const int n = rho >> 4, i = rho & 15; return 8 * (i >> 2) + 4 * n + (i & 3); }
template <bool GATHER>
__device__ __forceinline__ void unit_voffA(const Unit& u, int lda, int tid, unsigned (&v0)[2], unsigned (&v1)[2]) {
#pragma unroll
    for (int i = 0; i < 2; ++i) { int R, C; stage_rc(tid * 16 + i * 8192, R, C); int r0 = R, r1 = R + HALF;
        if (GATHER) { const int a = (r0 < u.valid) ? u.gidx[r0] : 0, b = (r1 < u.valid) ? u.gidx[r1] : 0; r0 = a; r1 = b; }
        v0[i] = (unsigned)(r0 * lda + C) * 2u; v1[i] = (unsigned)(r1 * lda + C) * 2u; }
}
template <class Epi, class Sched, bool ALIGN_EPI = true>
__device__ __forceinline__ void gemm_phase(LAS unsigned char* lds, const Gemm g, const Sched& S, const Epi& E) {
    const int tid = threadIdx.x, wid = __builtin_amdgcn_readfirstlane(tid >> 6), lane = tid & 63, wr = wid >> 2, wc = wid & 3, fr = lane & 15, fq = lane >> 4;
    const int K = g.K, nt = K / BK;
    constexpr bool GATHER = Sched::GATHER;
    unsigned voffB[2];
#pragma unroll
    for (int i = 0; i < 2; ++i) { int R, C; stage_rc(tid * 16 + i * 8192, R, C); const int Rb = Epi::PERM ? ((R & ~31) + perm32(R & 31)) : R; voffB[i] = (unsigned)(Rb * g.ldb + C) * 2u; }
    const size_t hstepA = (size_t)HALF * g.lda * 2;
    const size_t kstep = (size_t)(BK * 2);
    const size_t hstepB = (size_t)HALF * g.ldb * 2;
    const unsigned ldsw = (unsigned)wid * 1024u;
    const int aoff = lds_byte(wr * 64 + fr, fq * 8), boff = lds_byte(wc * 32 + fr, fq * 8);
#define PG8_SA(b, h) (((b) * 2 + (h)) * HTB)
#define PG8_SB(b, h) ((4 + (b) * 2 + (h)) * HTB)
#define PG8_STAGE(bufoff, gbase, voff) do { _Pragma("unroll") for (int _i = 0; _i < 2; ++_i) \
        __builtin_amdgcn_global_load_lds((const unsigned*)((const char*)(gbase) + (voff)[_i]), (LAS unsigned*)(lds + (bufoff) + ldsw + _i * 8192), 16, 0, 0); } while (0)
#define PG8_LDA(dst, b, h) do { _Pragma("unroll") for (int m = 0; m < 4; ++m) _Pragma("unroll") for (int k = 0; k < 2; ++k) dst[m][k] = *(const LAS bf16x8*)(lds + PG8_SA(b, h) + aoff + m * 2048 + k * 1024); } while (0)
#define PG8_LDB(dst, b, h) do { _Pragma("unroll") for (int n = 0; n < 2; ++n) _Pragma("unroll") for (int k = 0; k < 2; ++k) dst[n][k] = *(const LAS bf16x8*)(lds + PG8_SB(b, h) + boff + n * 2048 + k * 1024); } while (0)
#define PG8_MMA(ai, bj, At, Bt) do { __builtin_amdgcn_s_setprio(1); _Pragma("unroll") for (int m = 0; m < 4; ++m) _Pragma("unroll") for (int n = 0; n < 2; ++n) _Pragma("unroll") for (int k = 0; k < 2; ++k) \
        acc[ai][bj][m][n] = __builtin_amdgcn_mfma_f32_16x16x32_bf16(Bt[n][k], At[m][k], acc[ai][bj][m][n], 0, 0, 0); __builtin_amdgcn_s_setprio(0); } while (0)
#define PG8_WAIT_V(n) asm volatile("s_waitcnt vmcnt(" #n ")" ::: "memory")
#define PG8_WAIT_L(n) asm volatile("s_waitcnt lgkmcnt(" #n ")" ::: "memory")
#define PG8_BAR __builtin_amdgcn_s_barrier()
#define PG8_SCHED __builtin_amdgcn_sched_barrier(0)
    Unit cur, nxt; int ui = 0;
    if (!S.next(0, cur)) return;
    f32x4 acc[2][2][4][2];
#pragma unroll
    for (int a = 0; a < 2; ++a)
#pragma unroll
        for (int b = 0; b < 2; ++b)
#pragma unroll
            for (int m = 0; m < 4; ++m)
#pragma unroll
                for (int n = 0; n < 2; ++n) acc[a][b][m][n] = (f32x4){0.f, 0.f, 0.f, 0.f};
    bf16x8 At[4][2], B0[2][2], B1[2][2];
    const char* cA = (const char*)(g.A + cur.a_off); const char* cB = (const char*)(g.Bt + cur.b_off);
    unsigned vA0[2], vA1[2], nA0[2], nA1[2];
    unit_voffA<GATHER>(cur, g.lda, tid, vA0, vA1);
#define PG8_STAGE_A(bufoff, gbase, h, sel) do { if constexpr (GATHER) { if (sel) { if ((h) == 0) PG8_STAGE(bufoff, gbase, nA0); else PG8_STAGE(bufoff, gbase, nA1); } else { if ((h) == 0) PG8_STAGE(bufoff, gbase, vA0); else PG8_STAGE(bufoff, gbase, vA1); } } \
        else { PG8_STAGE(bufoff, (gbase) + ((h) ? hstepA : (size_t)0), vA0); } } while (0)
    PG8_STAGE(PG8_SB(0, 0), cB, voffB); PG8_STAGE(PG8_SB(0, 1), cB + hstepB, voffB); PG8_STAGE_A(PG8_SA(0, 0), cA, 0, false); PG8_STAGE_A(PG8_SA(0, 1), cA, 1, false);
    if (wr == 1) PG8_BAR;
    PG8_WAIT_V(2); PG8_BAR;
    PG8_STAGE(PG8_SB(1, 0), cB + kstep, voffB); PG8_STAGE_A(PG8_SA(1, 0), cA + kstep, 0, false); PG8_STAGE(PG8_SB(1, 1), cB + hstepB + kstep, voffB);
    PG8_WAIT_V(6); PG8_BAR;
    for (;;) {
        const bool has_next = S.next(ui + 1, nxt);
        const char* nA = has_next ? (const char*)(g.A + nxt.a_off) : cA; const char* nB = has_next ? (const char*)(g.Bt + nxt.b_off) : cB;
        if constexpr (GATHER) { if (has_next) unit_voffA<true>(nxt, g.lda, tid, nA0, nA1); else { nA0[0] = vA0[0]; nA0[1] = vA0[1]; nA1[0] = vA1[0]; nA1[1] = vA1[1]; } }
        for (int t = 0; t < nt; t += 2) {
            const bool last = (t == nt - 2);
            const char* a1 = cA + (size_t)(t + 1) * kstep;
            const char* a2 = last ? nA : cA + (size_t)(t + 2) * kstep; const char* b2 = last ? nB : cB + (size_t)(t + 2) * kstep;
            const char* a3 = a2 + kstep; const char* b3 = b2 + kstep;
            PG8_LDB(B0, 0, 0); PG8_LDB(B1, 0, 1); PG8_SCHED; PG8_LDA(At, 0, 0); PG8_STAGE_A(PG8_SA(1, 1), a1, 1, false);
            PG8_WAIT_V(8); PG8_WAIT_L(0); PG8_BAR; PG8_MMA(0, 0, At, B0); PG8_MMA(0, 1, At, B1); PG8_BAR; PG8_SCHED;
            PG8_LDA(At, 0, 1); PG8_STAGE(PG8_SB(0, 0), b2, voffB); PG8_STAGE(PG8_SB(0, 1), b2 + hstepB, voffB); PG8_STAGE_A(PG8_SA(0, 0), a2, 0, last);
            PG8_WAIT_V(8); PG8_WAIT_L(0); PG8_BAR; PG8_MMA(1, 0, At, B0); PG8_MMA(1, 1, At, B1); PG8_BAR; PG8_SCHED;
            PG8_LDB(B0, 1, 0); PG8_LDB(B1, 1, 1); PG8_SCHED; PG8_LDA(At, 1, 0); PG8_STAGE_A(PG8_SA(0, 1), a2, 1, last);
            PG8_WAIT_V(8); PG8_WAIT_L(0); PG8_BAR; PG8_MMA(0, 0, At, B0); PG8_MMA(0, 1, At, B1); PG8_BAR; PG8_SCHED;
            PG8_LDA(At, 1, 1); PG8_STAGE(PG8_SB(1, 0), b3, voffB); PG8_STAGE(PG8_SB(1, 1), b3 + hstepB, voffB); PG8_STAGE_A(PG8_SA(1, 0), a3, 0, last);
            PG8_WAIT_V(8); PG8_WAIT_L(0); PG8_BAR; PG8_MMA(1, 0, At, B0); PG8_MMA(1, 1, At, B1); PG8_BAR; PG8_SCHED;
        }
        if constexpr (ALIGN_EPI) { if (wr == 0) PG8_BAR; }
        E(acc, cur, wr, wc, fr, fq);
        if (!has_next) break;
#pragma unroll
        for (int a = 0; a < 2; ++a)
#pragma unroll
            for (int b = 0; b < 2; ++b)
#pragma unroll
                for (int m = 0; m < 4; ++m)
#pragma unroll
                    for (int n = 0; n < 2; ++n) acc[a][b][m][n] = (f32x4){0.f, 0.f, 0.f, 0.f};
        cur = nxt; cA = nA; cB = nB; ++ui;
        if constexpr (GATHER) { vA0[0] = nA0[0]; vA0[1] = nA0[1]; vA1[0] = nA1[0]; vA1[1] = nA1[1]; }
        if constexpr (ALIGN_EPI) { if (wr == 1) PG8_BAR; }
    }
    PG8_WAIT_V(0);
    if constexpr (!ALIGN_EPI) { if (wr == 0) PG8_BAR; }
    PG8_BAR;
#undef PG8_SA
#undef PG8_SB
#undef PG8_STAGE
#undef PG8_STAGE_A
#undef PG8_LDA
#undef PG8_LDB
#undef PG8_MMA
#undef PG8_WAIT_V
#undef PG8_WAIT_L
#undef PG8_BAR
#undef PG8_SCHED
}
}
template <class Epi, class Sched>
__device__ __forceinline__ void gemm_phase_mfma(unsigned char* lds, const Gemm g, const Sched& S, const Epi& E) { pg8::gemm_phase<Epi, Sched, true>((LAS unsigned char*)lds, g, S, E); __syncthreads(); }

__device__ __forceinline__ u32x4 pack8(const f32x4 v0, const f32x4 v1) { u32x4 w; w.x = pk2(v0[0], v0[1]); w.y = pk2(v0[2], v0[3]); w.z = pk2(v1[0], v1[1]); w.w = pk2(v1[2], v1[3]); return w; }

struct EpiIn {
    static constexpr bool PERM = true;
    bf16_t* inbuf; bf16_t* pbuf; const float* rstd1; unsigned* nrm;
    __device__ __forceinline__ void operator()(const f32x4 (&acc)[2][2][4][2], const Unit& u, int wr, int wc, int fr_, int fq_) const {
        int fr = fr_, fq = fq_; asm volatile("" : "+v"(fr), "+v"(fq));
        bf16_t* base; int ldc, colt; float sc0 = 1.f;
        if (u.pn < 24) { base = inbuf + (size_t)(u.pn >> 2) * T * 1024; ldc = 1024; colt = (u.pn & 3) * 256; if (u.pn < 4) sc0 = C2Q; }
        else { base = pbuf; ldc = PW; colt = (u.pn - 24) * 256; }
        const int row0 = u.pm * 256 + wr * 64 + fr, col0 = colt + wc * 32 + 8 * fq;
        float rs[2][4];
#pragma unroll
        for (int ai = 0; ai < 2; ++ai)
#pragma unroll
            for (int m = 0; m < 4; ++m) rs[ai][m] = rstd1[row0 + ai * 128 + m * 16];
#pragma unroll
        for (int ai = 0; ai < 2; ++ai)
#pragma unroll
            for (int m = 0; m < 4; ++m) { const int row = row0 + ai * 128 + m * 16; const float r = rs[ai][m] * sc0; bf16_t* rowp = base + (size_t)row * ldc + col0;
#pragma unroll
                for (int bj = 0; bj < 2; ++bj) *(u32x4*)(rowp + bj * 128) = pack8(acc[ai][bj][m][0] * r, acc[ai][bj][m][1] * r); }
        if (u.pn < 8) {
            float mx[2] = {0.f, 0.f};
#pragma unroll
            for (int ai = 0; ai < 2; ++ai)
#pragma unroll
                for (int m = 0; m < 4; ++m) { const float r = rs[ai][m] * sc0;
#pragma unroll
                    for (int bj = 0; bj < 2; ++bj) { const f32x4 v0 = acc[ai][bj][m][0] * r, v1 = acc[ai][bj][m][1] * r;
                        float ssq = (v0[0] * v0[0] + v0[1] * v0[1]) + (v0[2] * v0[2] + v0[3] * v0[3]) + (v1[0] * v1[0] + v1[1] * v1[1]) + (v1[2] * v1[2] + v1[3] * v1[3]);
                        ssq += __shfl_xor(ssq, 16); ssq += __shfl_xor(ssq, 32); mx[bj] = fmaxf(mx[bj], ssq); } }
#pragma unroll
            for (int bj = 0; bj < 2; ++bj) { float v = mx[bj]; v = fmaxf(v, __shfl_xor(v, 1)); v = fmaxf(v, __shfl_xor(v, 2)); v = fmaxf(v, __shfl_xor(v, 4)); v = fmaxf(v, __shfl_xor(v, 8));
                if (fr == 0 && fq == 0) { const int bb = u.pm >> 3, hh = (u.pn & 3) * 2 + bj, cc = wc >> 1; atomicMax(nrm + (u.pn >= 4 ? 512 : 0) + ((bb * 8 + hh) * 2 + cc) * 2 + (wc & 1), __float_as_uint(v)); } }
        }
    }
};
struct EpiL2 {
    static constexpr bool PERM = true;
    float* wl; bf16_t* abuf; bf16_t* gbuf; const float* w0; const float* a0;
    __device__ __forceinline__ void operator()(const f32x4 (&acc)[2][2][4][2], const Unit& u, int wr, int wc, int fr_, int fq_) const {
        int fr = fr_, fq = fq_; asm volatile("" : "+v"(fr), "+v"(fq));
        const int grp = u.pn >> 2, colt = (u.pn & 3) * 256;
        const int row0 = u.pm * 256 + wr * 64 + fr, col0 = colt + wc * 32 + 8 * fq;
        if (grp == 0) {
#pragma unroll
            for (int bj = 0; bj < 2; ++bj) { const int c = col0 + bj * 128; const f32x4 b0 = *(const f32x4*)(w0 + c), b1 = *(const f32x4*)(w0 + c + 4);
#pragma unroll
                for (int ai = 0; ai < 2; ++ai)
#pragma unroll
                    for (int m = 0; m < 4; ++m) { const int row = row0 + ai * 128 + m * 16; f32x4 v0 = acc[ai][bj][m][0] + b0, v1 = acc[ai][bj][m][1] + b1;
#pragma unroll
                        for (int e = 0; e < 4; ++e) { v0[e] = -0.60653065971f * LOG2E * sigmoidf_(v0[e]); v1[e] = -0.60653065971f * LOG2E * sigmoidf_(v1[e]); }
                        float* p = wl + (size_t)row * 1024 + c; *(f32x4*)p = v0; *(f32x4*)(p + 4) = v1; asm volatile("" ::: "memory"); __builtin_amdgcn_sched_barrier(0); } }
        } else if (grp == 1) {
#pragma unroll
            for (int bj = 0; bj < 2; ++bj) { const int c = col0 + bj * 128; const f32x4 b0 = *(const f32x4*)(a0 + c), b1 = *(const f32x4*)(a0 + c + 4);
#pragma unroll
                for (int ai = 0; ai < 2; ++ai)
#pragma unroll
                    for (int m = 0; m < 4; ++m) { const int row = row0 + ai * 128 + m * 16; f32x4 v0 = acc[ai][bj][m][0] + b0, v1 = acc[ai][bj][m][1] + b1;
#pragma unroll
                        for (int e = 0; e < 4; ++e) { v0[e] = sigmoidf_(v0[e]); v1[e] = sigmoidf_(v1[e]); }
                        *(u32x4*)(abuf + (size_t)row * 1024 + c) = pack8(v0, v1); asm volatile("" ::: "memory"); __builtin_amdgcn_sched_barrier(0); } }
        } else {
#pragma unroll
            for (int bj = 0; bj < 2; ++bj) { const int c = col0 + bj * 128;
#pragma unroll
                for (int ai = 0; ai < 2; ++ai)
#pragma unroll
                    for (int m = 0; m < 4; ++m) { const int row = row0 + ai * 128 + m * 16; *(u32x4*)(gbuf + (size_t)row * 1024 + c) = pack8(acc[ai][bj][m][0], acc[ai][bj][m][1]); } }
        }
    }
};
struct EpiOut {
    static constexpr bool PERM = true;
    const float* x; float* h; bf16_t* hb; float* ss2;
    __device__ __forceinline__ void operator()(const f32x4 (&acc)[2][2][4][2], const Unit& u, int wr, int wc, int fr_, int fq_) const {
        int fr = fr_, fq = fq_; asm volatile("" : "+v"(fr), "+v"(fq));
        const int row0 = u.pm * 256 + wr * 64 + fr, col0 = u.pn * 256 + wc * 32 + 8 * fq;
#pragma unroll
        for (int ai = 0; ai < 2; ++ai) {
            f32x4 xv[4][2][2];
#pragma unroll
            for (int m = 0; m < 4; ++m)
#pragma unroll
                for (int bj = 0; bj < 2; ++bj) { const size_t off = (size_t)(row0 + ai * 128 + m * 16) * DM + col0 + bj * 128; xv[m][bj][0] = *(const f32x4*)(x + off); xv[m][bj][1] = *(const f32x4*)(x + off + 4); }
#pragma unroll
            for (int m = 0; m < 4; ++m) { const int row = row0 + ai * 128 + m * 16; float ss = 0.f;
#pragma unroll
                for (int bj = 0; bj < 2; ++bj) { const size_t off = (size_t)row * DM + col0 + bj * 128;
                    const f32x4 v0 = acc[ai][bj][m][0] + xv[m][bj][0], v1 = acc[ai][bj][m][1] + xv[m][bj][1];
                    *(u32x4*)(hb + off) = pack8(v0, v1);
                    ss += (v0[0] * v0[0] + v0[1] * v0[1]) + (v0[2] * v0[2] + v0[3] * v0[3]) + (v1[0] * v1[0] + v1[1] * v1[1]) + (v1[2] * v1[2] + v1[3] * v1[3]); }
                ss += __shfl_xor(ss, 16); ss += __shfl_xor(ss, 32);
                if (fq == 0) atomicAdd(ss2 + row, ss); }
        }
    }
};
struct EpiGU {
    static constexpr bool PERM = true;
    bf16_t* hid; const float* rstd2;
    __device__ __forceinline__ void operator()(const f32x4 (&acc)[2][2][4][2], const Unit& u, int wr, int wc, int fr_, int fq_) const {
        int fr = fr_, fq = fq_; asm volatile("" : "+v"(fr), "+v"(fq));
        const int col0 = u.pn * 128 + wc * 32 + 8 * fq;
        int tok[2][4]; float rsv[2][4];
#pragma unroll
        for (int ai = 0; ai < 2; ++ai)
#pragma unroll
            for (int m = 0; m < 4; ++m) { const int rl = ai * 128 + wr * 64 + m * 16 + fr; tok[ai][m] = (rl < u.valid) ? u.gidx[rl] : 0; }
#pragma unroll
        for (int ai = 0; ai < 2; ++ai)
#pragma unroll
            for (int m = 0; m < 4; ++m) rsv[ai][m] = rstd2[tok[ai][m]];
#pragma unroll
        for (int ai = 0; ai < 2; ++ai)
#pragma unroll
            for (int m = 0; m < 4; ++m) { const int rl = ai * 128 + wr * 64 + m * 16 + fr; const float rs = rsv[ai][m];
                f32x4 o0, o1;
#pragma unroll
                for (int e = 0; e < 4; ++e) { const float g0 = acc[ai][0][m][0][e] * rs, u0 = acc[ai][1][m][0][e] * rs, g1 = acc[ai][0][m][1][e] * rs, u1 = acc[ai][1][m][1][e] * rs;
                    o0[e] = g0 * sigmoidf_(g0) * u0; o1[e] = g1 * sigmoidf_(g1) * u1; }
                *(u32x4*)(hid + ((size_t)u.tile * 256 + rl) * DEXP + col0) = pack8(o0, o1); asm volatile("" ::: "memory"); __builtin_amdgcn_sched_barrier(0); }
    }
};
struct EpiDown {
    static constexpr bool PERM = true;
    bf16_t* yb; const float* gateb; const unsigned* cnt;
    __device__ __forceinline__ void operator()(const f32x4 (&acc)[2][2][4][2], const Unit& u, int wr, int wc, int fr_, int fq_) const {
        int fr = fr_, fq = fq_; asm volatile("" : "+v"(fr), "+v"(fq));
        const int col0 = u.pn * 256 + wc * 32 + 8 * fq;
        const int k = u.k;
        float gtv[2][4];
#pragma unroll
        for (int ai = 0; ai < 2; ++ai)
#pragma unroll
            for (int m = 0; m < 4; ++m) { const int rl = ai * 128 + wr * 64 + m * 16 + fr; gtv[ai][m] = (rl < u.valid) ? gateb[(size_t)u.e * CAP + 256 * k + rl] : 0.f; }
#pragma unroll
        for (int ai = 0; ai < 2; ++ai)
#pragma unroll
            for (int m = 0; m < 4; ++m) { const int rl = ai * 128 + wr * 64 + m * 16 + fr; const float gt = gtv[ai][m];
#pragma unroll
                for (int bj = 0; bj < 2; ++bj) *(u32x4*)(yb + ((size_t)u.tile * 256 + rl) * DM + col0 + bj * 128) = pack8(acc[ai][bj][m][0] * gt, acc[ai][bj][m][1] * gt); }
    }
};

__device__ __forceinline__ void tr_load64(f32x4 (&v)[16], const float* W, int ldw, int Kvalid, int Nvalid, int k0, int n0, int lane) {
    const int c4 = lane & 15, rq = lane >> 4; const bool ncol_ok = (n0 + 4 * c4) < Nvalid;
#pragma unroll
    for (int i = 0; i < 16; ++i) { const int k = k0 + 4 * i + rq; v[i] = (f32x4){0.f, 0.f, 0.f, 0.f};
        if (k < Kvalid && ncol_ok) v[i] = *(const f32x4*)(W + (size_t)k * ldw + n0 + 4 * c4); }
}
__device__ __forceinline__ void tr_store64(const f32x4 (&v)[16], int Kvalid, int Nvalid, int k0, int n0, bf16_t* WT, int ldt, int trow0, float* scr, int lane,
                                           const float* gk, const float* mu, int mode) {
    const int c4 = lane & 15, rq = lane >> 4;
#pragma unroll
    for (int i = 0; i < 16; ++i) { const int kk = 4 * i + rq, k = k0 + kk; float sc = 1.f;
        if (k < Kvalid) { if (gk) sc = gk[k]; if (mode == 1) sc *= (1.f - mu[k]); else if (mode == 2) sc *= mu[k]; }
        float* d = scr + kk * 65 + 4 * c4; d[0] = v[i][0] * sc; d[1] = v[i][1] * sc; d[2] = v[i][2] * sc; d[3] = v[i][3] * sc; }
    __builtin_amdgcn_s_waitcnt(0xC07F); asm volatile("" ::: "memory");
    const int c = lane & 7;
#pragma unroll
    for (int j = 0; j < 8; ++j) { const int n = (lane >> 3) + 8 * j; const float* q = scr + (8 * c) * 65 + n;
        u32x4 o; o.x = pk2(q[0 * 65], q[1 * 65]); o.y = pk2(q[2 * 65], q[3 * 65]); o.z = pk2(q[4 * 65], q[5 * 65]); o.w = pk2(q[6 * 65], q[7 * 65]);
        if (n0 + n < Nvalid) *(u32x4*)(WT + (size_t)(trow0 + n) * ldt + k0 + 8 * c) = o; }
    __builtin_amdgcn_s_waitcnt(0xC07F); asm volatile("" ::: "memory");
}
__device__ __forceinline__ void tr_item64(const float* W, int ldw, int Kvalid, int Nvalid, int k0, int n0, bf16_t* WT, int ldt, int trow0, float* scr, int lane,
                                          const float* gk, const float* mu, int mode) {
    f32x4 v[16];
    tr_load64(v, W, ldw, Kvalid, Nvalid, k0, n0, lane);
    tr_store64(v, Kvalid, Nvalid, k0, n0, WT, ldt, trow0, scr, lane, gk, mu, mode);
}

__device__ __forceinline__ void phase_prologue(const Params& p, unsigned char* lds) {
    const int tid = opaque_tid(), lane = tid & 63, wave = tid >> 6;
    const int gw = blockIdx.x * NWAVES + wave, NGW = gridDim.x * NWAVES;
    unsigned char* ws = p.ws;
    float* scr = (float*)(lds + wave * 16640);
    bf16_t* WinT = (bf16_t*)(ws + WS_WIN); bf16_t* WoutT = (bf16_t*)(ws + WS_WOUT); bf16_t* L2T = (bf16_t*)(ws + WS_L2T);
    const float* g_mix = p.in[1]; const float* mu_x = p.in[9];
    constexpr int I_WIN = 32 * 96;
    constexpr int I_L1 = 32 * (1 + 1 + 3) * 2;
    constexpr int I_WOUT = 32 * 32;
    constexpr int I_L2 = 3 * 4 * 16;
    constexpr int NITEMS = I_WIN + I_L1 + I_WOUT + I_L2;
    for (int it = gw; it < NITEMS; it += NGW) {
        int r = it;
        if (r < I_WIN) { const int kb = r / 96, nb = r % 96; tr_item64(p.in[2], 6144, 2048, 6144, 64 * kb, 64 * nb, WinT, 2048, 64 * nb, scr, lane, g_mix, nullptr, 0); continue; } r -= I_WIN;
        if (r < I_L1) {
            const int kb = r / 10, rr = r % 10;
            int which, nb, mode;
            if (rr < 2) { which = 0; nb = 0; mode = 1 + rr; } else if (rr < 4) { which = 1; nb = 0; mode = 1 + (rr - 2); } else { which = 2; nb = (rr - 4) >> 1; mode = 1 + ((rr - 4) & 1); }
            const float* W = which == 0 ? p.in[12] : which == 1 ? p.in[15] : p.in[17];
            const int ldw = which == 2 ? 160 : 64;
            const int rowbase = 6144 + (which == 0 ? 0 : which == 1 ? 128 : 256) + (mode == 2 ? ldw : 0);
            tr_item64(W, ldw, 2048, ldw, 64 * kb, 64 * nb, WinT, 2048, rowbase + 64 * nb, scr, lane, g_mix, mu_x + which * 2048, mode); continue; } r -= I_L1;
        if (r < I_WOUT) { const int kb = r / 32, nb = r % 32; tr_item64(p.in[3], 2048, 2048, 2048, 64 * kb, 64 * nb, WoutT, 2048, 64 * nb, scr, lane, nullptr, nullptr, 0); continue; } r -= I_WOUT;
        { const int which = r / 64, rr = r % 64, kb = rr / 16, nb = rr % 16;
          const float* W = which == 0 ? p.in[13] : which == 1 ? p.in[16] : p.in[18]; const int kv = which == 2 ? 160 : 64;
          tr_item64(W, 1024, kv, 1024, 64 * kb, 64 * nb, L2T, 256, which * 1024 + 64 * nb, scr, lane, nullptr, nullptr, 0); }
    }
    for (int ch = blockIdx.x * NTHREADS + tid; ch < 192 * 256; ch += gridDim.x * NTHREADS) *(u32x4*)(WinT + (size_t)6720 * 2048 + (size_t)ch * 8) = (u32x4){0u, 0u, 0u, 0u};
    { bf16_t* whi = (bf16_t*)(ws + WS_WRT); bf16_t* wlo = whi + 48 * 2048; const float* gf = p.in[24]; const float* wg = p.in[25]; const float* we = p.in[27];
      for (int id = blockIdx.x * NTHREADS + tid; id < 48 * 2048; id += gridDim.x * NTHREADS) { const int cc = id >> 11, k = id & 2047; float w = 0.f;
          if (cc < 4) w = wg[(size_t)k * 4 + cc] * gf[k]; else if (cc < 36) w = we[(size_t)k * 32 + cc - 4] * gf[k];
          const unsigned hb = f2bf(w); const float hf = bf2f(hb); whi[id] = (bf16_t)hb; wlo[id] = (bf16_t)f2bf(w - hf); } }
    const float* x = p.in[0]; bf16_t* xb = (bf16_t*)(ws + WS_XB); float* rstd1 = (float*)(ws + WS_RSTD1);
    for (int m0 = gw; m0 < T; m0 += 2 * NGW) {
        f32x4 v[2][8];
#pragma unroll
        for (int u = 0; u < 2; ++u) { const int m = m0 + u * NGW; if (m < T) { const f32x4* xr = (const f32x4*)(x + (size_t)m * DM) + lane;
#pragma unroll
            for (int j = 0; j < 8; ++j) v[u][j] = xr[64 * j]; } }
#pragma unroll
        for (int u = 0; u < 2; ++u) { const int m = m0 + u * NGW; if (m < T) { float sq = 0.f;
#pragma unroll
            for (int j = 0; j < 8; ++j) sq += (v[u][j][0] * v[u][j][0] + v[u][j][1] * v[u][j][1]) + (v[u][j][2] * v[u][j][2] + v[u][j][3] * v[u][j][3]);
            sq = wave_sum(sq);
            u32x2* o = (u32x2*)(xb + (size_t)m * DM) + lane;
#pragma unroll
            for (int j = 0; j < 8; ++j) { u32x2 w; w.x = pk2(v[u][j][0], v[u][j][1]); w.y = pk2(v[u][j][2], v[u][j][3]); o[64 * j] = w; }
            if (lane == 0) rstd1[m] = 1.0f / sqrtf(sq * (1.0f / DM) + 1e-6f); } }
    }
}

__device__ __forceinline__ void convert_gu_queue(const Params& p, unsigned char* lds, unsigned* qctr, int e_lo, int e_hi) {
    const int tid = opaque_tid(), lane = tid & 63, wave = tid >> 6;
    float* scr = (float*)(lds + wave * 16640);
    volatile int* slot = (volatile int*)(lds + LDS_BYTES - 64);
    const float* gf = p.in[24];
    const int nitems = (e_hi - e_lo) * 512;
    for (;;) {
        __syncthreads();
        if (tid == 0) *slot = (int)atomicAdd(qctr, 8u);
        __syncthreads();
        const int r0 = __builtin_amdgcn_readfirstlane(*slot);
        if (r0 >= nitems) break;
        const int r = r0 + wave; const int e = e_lo + r / 512, rr = r % 512, up = rr >> 8, kb = (rr & 255) >> 3, n0 = 64 * (rr & 7);
        tr_item64((up ? p.in[30] : p.in[29]) + (size_t)e * 2048 * 512, 512, 2048, 512, 64 * kb, n0, (bf16_t*)(p.ws + wgu_byte_off(e)), 2048, 256 * (n0 >> 7) + (n0 & 127) + (up ? 128 : 0), scr, lane, gf, nullptr, 0);
    }
}
__device__ __forceinline__ void convert_down_queue(const Params& p, unsigned char* lds, unsigned* qctr) {
    const int tid = opaque_tid(), lane = tid & 63, wave = tid >> 6;
    float* scr = (float*)(lds + wave * 16640);
    volatile int* slot = (volatile int*)(lds + LDS_BYTES - 64);
    for (;;) {
        __syncthreads();
        if (tid == 0) *slot = (int)atomicAdd(qctr, 8u);
        __syncthreads();
        const int r = __builtin_amdgcn_readfirstlane(*slot) + wave;
        if (r - wave >= 32 * 256) break;
        const int e = r / 256, rr = r % 256, kb = rr / 32, nb = rr % 32;
        tr_item64(p.in[31] + (size_t)e * 512 * 2048, 2048, 512, 2048, 64 * kb, 64 * nb, (bf16_t*)(p.ws + wd_byte_off(e)), 512, 64 * nb, scr, lane, nullptr, nullptr, 0);
    }
}

__device__ __forceinline__ void phase_l2prep(const Params& p) {
    const bf16_t* P = (const bf16_t*)(p.ws + WS_PBUF); bf16_t* A2 = (bf16_t*)(p.ws + WS_A2);
    const int nchunk = T * 96;
    const int tid = opaque_tid();
    const int stride = gridDim.x * NTHREADS;
    for (int id0 = blockIdx.x * NTHREADS + tid; id0 < nchunk; id0 += 4 * stride) {
        u32x4 va[4], vb[4];
#pragma unroll
        for (int u = 0; u < 4; ++u) { const int id = id0 + u * stride; va[u] = (u32x4){0u, 0u, 0u, 0u}; vb[u] = va[u];
            if (id < nchunk) { const int t = id / 96, ch = id % 96, gi = ch >> 5, jc = (ch & 31) * 8; const int width = gi == 2 ? 160 : 64, pa = gi == 0 ? 0 : gi == 1 ? 128 : 256, pb = pa + width;
                if (jc < width) { va[u] = *(const u32x4*)(P + (size_t)t * PW + pa + jc); if ((t & (SEQ - 1)) != 0) vb[u] = *(const u32x4*)(P + (size_t)(t - 1) * PW + pb + jc); } } }
#pragma unroll
        for (int u = 0; u < 4; ++u) { const int id = id0 + u * stride;
            if (id < nchunk) { const int t = id / 96, ch = id % 96, gi = ch >> 5, jc = (ch & 31) * 8; const int width = gi == 2 ? 160 : 64;
                u32x4 o = (u32x4){0u, 0u, 0u, 0u};
                if (jc < width) { float f[8];
#pragma unroll
                    for (int i = 0; i < 4; ++i) { f[2 * i] = bflo(va[u][i]) + bflo(vb[u][i]); f[2 * i + 1] = bfhi(va[u][i]) + bfhi(vb[u][i]); }
#pragma unroll
                    for (int i = 0; i < 8; ++i) { if (gi == 0) f[i] = 1.0f - 2.0f * __builtin_amdgcn_rcpf(__builtin_amdgcn_exp2f(2.0f * 1.4426950408889634f * f[i]) + 1.0f); else if (gi == 2) f[i] = sigmoidf_(f[i]); }
                    o.x = pk2(f[0], f[1]); o.y = pk2(f[2], f[3]); o.z = pk2(f[4], f[5]); o.w = pk2(f[6], f[7]); }
                *(u32x4*)(A2 + (size_t)t * PW + ch * 8) = o; } }
    }
}

constexpr int TC = 16;
constexpr int CV_UT = 0, CV_ZT = 2048, CV_BT = 4096, CV_KT = 6144, CV_BKH = 8192, CV_VT = 12288, CV_GC = 14336, CV_BYTES = 14848;
constexpr int CM_TT = 0, CM_BB = 1024, CM_AB = 2048, CM_BYTES = 3072;
constexpr int CL_VEC = 0, CL_MAT = 3 * CV_BYTES, CL_YS = CL_MAT + 2 * CM_BYTES, CL_GB = CL_YS + 2 * 4096  , CL_SCR = CL_GB + 4 * 8192, CL_SCR_W = 2304, CL_END = CL_SCR + 8 * CL_SCR_W;
#define DPP_F(v, ctrl) __builtin_bit_cast(float, __builtin_amdgcn_update_dpp(0, __builtin_bit_cast(int, (v)), (ctrl), 0xF, 0xF, true))
__device__ __forceinline__ float red8(float v) {
    v += DPP_F(v, 0xB1);
    v += DPP_F(v, 0x4E);
    v += DPP_F(v, 0x141);
    return v;
}
__device__ __forceinline__ float wave_sum_fast(float v) {
    v = red8(v);
    v += DPP_F(v, 0x140);
    v += __builtin_bit_cast(float, __builtin_amdgcn_update_dpp(0, __builtin_bit_cast(int, v), 0x142, 0xa, 0xf, false));
    v += __builtin_bit_cast(float, __builtin_amdgcn_update_dpp(0, __builtin_bit_cast(int, v), 0x143, 0xc, 0xf, false));
    return __builtin_bit_cast(float, __builtin_amdgcn_readlane(__builtin_bit_cast(int, v), 63));
}
__device__ __forceinline__ bf16x8 op4(const f32x4 x) { u32x4 w; w.x = cvt_pk_bf16_(x[0], x[1]); w.y = cvt_pk_bf16_(x[2], x[3]); w.z = 0u; w.w = 0u; return __builtin_bit_cast(bf16x8, w); }
#define MFMA16(a, b, c) __builtin_amdgcn_mfma_f32_16x16x32_bf16((a), (b), (c), 0, 0, 0)
__device__ __forceinline__ void rwkv_chain(const Params& p, unsigned char* lds, int chain) {
    const int tid = opaque_tid(), lane = tid & 63, wave = __builtin_amdgcn_readfirstlane(tid >> 6);
    const int b = chain >> 4, h = chain & 15;
    constexpr int NC = SEQ / TC;
    const int n = lane & 15, q = lane >> 4;
    const f32x4 zero4 = (f32x4){0.f, 0.f, 0.f, 0.f};
    const int c = h * 64 + lane;
    constexpr int SPW = 4;
    bf16_t* O = (bf16_t*)(p.ws + WS_O);
    float* SCR = (float*)(lds + CL_SCR + wave * CL_SCR_W);
#define SCAN_POST(ci_, pw_) do { const float* Ys_ = (const float*)(lds + CL_YS + ((ci_) & 1) * 4096); const float* GB_ = (const float*)(lds + CL_GB + ((ci_) & 3) * 8192); \
        float y_[SPW]; \
        _Pragma("unroll") for (int s_ = 0; s_ < SPW; ++s_) { y_[s_] = Ys_[((pw_) * SPW + s_) * 64 + lane]; SCR[(2 * s_) * 68 + lane] = y_[s_]; SCR[(2 * s_ + 1) * 68 + lane] = y_[s_] * y_[s_]; } \
        { const float* rp_ = SCR + (lane >> 3) * 68 + (lane & 7) * 8; const f32x4 p0_ = *(const f32x4*)(rp_), p1_ = *(const f32x4*)(rp_ + 4); const f32x4 ps_ = p0_ + p1_; \
          const float t_ = red8((ps_[0] + ps_[1]) + (ps_[2] + ps_[3])); if ((lane & 7) == 0) SCR[8 * 68 + 8 + (lane >> 3)] = t_; } \
        { const f32x4 t0_ = *(const f32x4*)(SCR + 8 * 68 + 8), t1_ = *(const f32x4*)(SCR + 8 * 68 + 12); const float st_[8] = {t0_[0], t0_[1], t0_[2], t0_[3], t1_[0], t1_[1], t1_[2], t1_[3]}; \
          _Pragma("unroll") for (int s_ = 0; s_ < SPW; ++s_) { const int tl_ = (pw_) * SPW + s_; const size_t m_ = (size_t)b * SEQ + (ci_) * TC + tl_; \
            const float mean_ = st_[2 * s_] * (1.0f / 64.0f); const float var_ = fmaxf(st_[2 * s_ + 1] * (1.0f / 64.0f) - mean_ * mean_, 0.f); \
            const float yn_ = (y_[s_] - mean_) * __builtin_amdgcn_rsqf(var_ + 64e-5f) * ln_w + ln_b; \
            O[m_ * DM + 1024 + c] = (bf16_t)f2bf(yn_ * GB_[tl_ * 64 + lane] + GB_[TC * 64 + tl_ * 64 + lane]); } } } while (0)
#define OPR(arr_, ks_) (*(const bf16x8*)(V0_ + (arr_) + n * 128 + (ks_) * 64 + q * 16))
#define SCAN_MATS(ci_) do { const unsigned char* V0_ = lds + CL_VEC + ((ci_) % 3) * CV_BYTES; unsigned char* M0_ = lds + CL_MAT + ((ci_) & 1) * CM_BYTES; \
        if (wave == 0) { \
            f32x4 pa_ = MFMA16(OPR(CV_BT, 0), OPR(CV_UT, 0), zero4); pa_ = MFMA16(OPR(CV_BT, 1), OPR(CV_UT, 1), pa_);        \
            f32x4 pt_ = MFMA16(OPR(CV_UT, 0), OPR(CV_BT, 0), zero4); pt_ = MFMA16(OPR(CV_UT, 1), OPR(CV_BT, 1), pt_);        \
            _Pragma("unroll") for (int r_ = 0; r_ < 4; ++r_) { if (!(4 * q + r_ < n)) pa_[r_] = 0.f; if (!(n < 4 * q + r_)) pt_[r_] = 0.f; } \
            f32x4 rr4_ = pa_;                                                                                                 \
            _Pragma("unroll") for (int k_ = 1; k_ < 4; ++k_) { \
                const f32x4 pn_ = MFMA16(op4(pt_), op4(pa_), zero4);                                                          \
                const f32x4 ptn_ = MFMA16(op4(pa_), op4(pt_), zero4);                                                         \
                rr4_ = MFMA16(op4(ptn_), op4(rr4_), rr4_ + pn_);                                                              \
                pa_ = pn_; pt_ = ptn_; } \
            _Pragma("unroll") for (int r_ = 0; r_ < 4; ++r_) if (4 * q + r_ == n) rr4_[r_] += 1.0f; \
            *(bf16x8*)(M0_ + CM_TT + lane * 16) = op4(rr4_); \
        } else if (wave == 1) { \
            f32x4 pb_ = MFMA16(OPR(CV_KT, 0), OPR(CV_UT, 0), zero4); pb_ = MFMA16(OPR(CV_KT, 1), OPR(CV_UT, 1), pb_);        \
            _Pragma("unroll") for (int r_ = 0; r_ < 4; ++r_) if (!(4 * q + r_ < n)) pb_[r_] = 0.f; \
            *(bf16x8*)(M0_ + CM_BB + lane * 16) = op4(pb_); \
        } else if (wave == 2) { \
            f32x4 qa_ = MFMA16(OPR(CV_BT, 0), OPR(CV_ZT, 0), zero4); qa_ = MFMA16(OPR(CV_BT, 1), OPR(CV_ZT, 1), qa_);        \
            f32x4 qb_ = MFMA16(OPR(CV_KT, 0), OPR(CV_ZT, 0), zero4); qb_ = MFMA16(OPR(CV_KT, 1), OPR(CV_ZT, 1), qb_);        \
            _Pragma("unroll") for (int r_ = 0; r_ < 4; ++r_) if (!(4 * q + r_ <= n)) { qa_[r_] = 0.f; qb_[r_] = 0.f; } \
            u32x4 w_; w_.x = cvt_pk_bf16_(qa_[0], qa_[1]); w_.y = cvt_pk_bf16_(qa_[2], qa_[3]); w_.z = cvt_pk_bf16_(qb_[0], qb_[1]); w_.w = cvt_pk_bf16_(qb_[2], qb_[3]); \
            *(u32x4*)(M0_ + CM_AB + lane * 16) = w_; \
        } } while (0)
    if (wave < 4) {
        const int row = 16 * wave + n;
        const float ln_w = p.in[22][c], ln_b = p.in[23][c];
        f32x4 Sd[4];
#pragma unroll
        for (int c4 = 0; c4 < 4; ++c4) Sd[c4] = zero4;
        __syncthreads();
        SCAN_MATS(0);
        __syncthreads();
        for (int ci = 0; ci < NC; ++ci) {
            if (ci >= 1) SCAN_POST(ci - 1, wave);
            const unsigned char* V0 = lds + CL_VEC + (ci % 3) * CV_BYTES; const unsigned char* M0 = lds + CL_MAT + (ci & 1) * CM_BYTES;
            float* Ys = (float*)(lds + CL_YS + (ci & 1) * 4096);
            const int ro = n * 128 + q * 16;
            u32x4 w0, w1;
            w0.x = cvt_pk_bf16_(Sd[0][0], Sd[0][1]); w0.y = cvt_pk_bf16_(Sd[0][2], Sd[0][3]); w0.z = cvt_pk_bf16_(Sd[1][0], Sd[1][1]); w0.w = cvt_pk_bf16_(Sd[1][2], Sd[1][3]);
            w1.x = cvt_pk_bf16_(Sd[2][0], Sd[2][1]); w1.y = cvt_pk_bf16_(Sd[2][2], Sd[2][3]); w1.z = cvt_pk_bf16_(Sd[3][0], Sd[3][1]); w1.w = cvt_pk_bf16_(Sd[3][2], Sd[3][3]);
            const bf16x8 sB0 = __builtin_bit_cast(bf16x8, w0), sB1 = __builtin_bit_cast(bf16x8, w1);
            const u32x2 vraw = *(const u32x2*)(V0 + CV_VT + row * 32 + q * 8);
            u32x4 vw; vw.x = vraw.x; vw.y = vraw.y; vw.z = 0u; vw.w = 0u; const bf16x8 vB = __builtin_bit_cast(bf16x8, vw);
            f32x4 g = MFMA16(*(const bf16x8*)(V0 + CV_UT + ro), sB0, zero4);
            g = MFMA16(*(const bf16x8*)(V0 + CV_UT + ro + 64), sB1, g);
            g = MFMA16(*(const bf16x8*)(M0 + CM_BB + lane * 16), vB, g);
            f32x4 y = MFMA16(*(const bf16x8*)(V0 + CV_ZT + ro), sB0, zero4);
            y = MFMA16(*(const bf16x8*)(V0 + CV_ZT + ro + 64), sB1, y);
            const f32x4 sa = MFMA16(*(const bf16x8*)(M0 + CM_TT + lane * 16), op4(g), zero4);
            u32x4 sw; sw.x = cvt_pk_bf16_(sa[0], sa[1]); sw.y = cvt_pk_bf16_(sa[2], sa[3]); sw.z = vraw.x; sw.w = vraw.y; const bf16x8 savB = __builtin_bit_cast(bf16x8, sw);
            y = MFMA16(*(const bf16x8*)(M0 + CM_AB + lane * 16), savB, y);
#pragma unroll
            for (int r = 0; r < 4; ++r) Ys[(4 * q + r) * 64 + row] = y[r];
#pragma unroll
            for (int c4 = 0; c4 < 4; ++c4) { const f32x4 gc = *(const f32x4*)(V0 + CV_GC + (16 * c4 + 4 * q) * 4);
                Sd[c4] = MFMA16(*(const bf16x8*)(V0 + CV_BKH + (16 * c4 + n) * 64 + q * 16), savB, Sd[c4] * gc); }
            if (ci + 1 < NC) SCAN_MATS(ci + 1);
            __syncthreads();
        }
        SCAN_POST(NC - 1, wave);
    } else {
        const int aw = wave - 4;
        const bf16_t* rb = (const bf16_t*)(p.ws + WS_INBUF) + (size_t)3 * T * 1024; const bf16_t* kb = rb + (size_t)T * 1024; const bf16_t* vb = kb + (size_t)T * 1024;
        const float* wl = (const float*)(p.ws + WS_WL); const bf16_t* ab = (const bf16_t*)(p.ws + WS_ABUF); const bf16_t* gb = (const bf16_t*)(p.ws + WS_GBUF);
        const float mu_r = p.in[10][c], mu_k = p.in[10][1024 + c], mu_v = p.in[10][2048 + c];
        const float k_k = p.in[19][c], k_a = p.in[20][c], r_k = p.in[21][c];
        const int cc = lane & 31; const int pos = (lane & 32) + 8 * ((cc >> 2) & 3) + (((cc >> 4) << 2) | (cc & 3));
        unsigned short rcA[SPW + 1], kcA[SPW + 1], vcA[SPW + 1], raA[SPW], rgA[SPW]; float rwlA[SPW], wlcA[16];
        unsigned short rcB[SPW + 1], kcB[SPW + 1], vcB[SPW + 1], raB[SPW], rgB[SPW]; float rwlB[SPW], wlcB[16];
#define SCAN_LOAD(ci_, X) do { const int tb_ = (ci_) * TC + aw * SPW; const size_t m0_ = (size_t)b * SEQ + tb_; \
        _Pragma("unroll") for (int s_ = 0; s_ < SPW + 1; ++s_) { const bool ok_ = (tb_ + s_ - 1) >= 0; const size_t off_ = (m0_ + s_ - 1) * 1024 + c; \
            rc##X[s_] = ok_ ? rb[off_] : (unsigned short)0; kc##X[s_] = ok_ ? kb[off_] : (unsigned short)0; vc##X[s_] = ok_ ? vb[off_] : (unsigned short)0; } \
        _Pragma("unroll") for (int s_ = 0; s_ < SPW; ++s_) { const size_t off_ = (m0_ + s_) * 1024 + c; rwl##X[s_] = wl[off_]; ra##X[s_] = ab[off_]; rg##X[s_] = gb[off_]; } \
        _Pragma("unroll") for (int i_ = 0; i_ < 16; ++i_) wlc##X[i_] = wl[((size_t)b * SEQ + (ci_) * TC + i_) * 1024 + c]; } while (0)
#define SCAN_PREP(ci_, X) do { unsigned char* V0_ = lds + CL_VEC + ((ci_) % 3) * CV_BYTES; float* GB_ = (float*)(lds + CL_GB + ((ci_) & 3) * 8192); \
        const float p4_ = (wlc##X[0] + wlc##X[1]) + (wlc##X[2] + wlc##X[3]), p8_ = p4_ + ((wlc##X[4] + wlc##X[5]) + (wlc##X[6] + wlc##X[7])); \
        const float p12_ = p8_ + ((wlc##X[8] + wlc##X[9]) + (wlc##X[10] + wlc##X[11])), ltot_ = p12_ + ((wlc##X[12] + wlc##X[13]) + (wlc##X[14] + wlc##X[15])); \
        float lcur_ = aw == 0 ? 0.f : aw == 1 ? p4_ : aw == 2 ? p8_ : p12_;        \
        float rr_[SPW], vv_[SPW], a_[SPW], kkv_[SPW], kmod_[SPW]; \
        _Pragma("unroll") for (int s_ = 0; s_ < SPW; ++s_) { \
            rr_[s_] = bf2f(rc##X[s_ + 1]) + (bf2f(rc##X[s_]) - bf2f(rc##X[s_ + 1])) * mu_r; const float kx_ = bf2f(kc##X[s_ + 1]) + (bf2f(kc##X[s_]) - bf2f(kc##X[s_ + 1])) * mu_k; vv_[s_] = bf2f(vc##X[s_ + 1]) + (bf2f(vc##X[s_]) - bf2f(vc##X[s_ + 1])) * mu_v; \
            a_[s_] = bf2f(ra##X[s_]); kkv_[s_] = kx_ * k_k; kmod_[s_] = kx_ * (1.0f + (a_[s_] - 1.0f) * k_a); \
            SCR[(2 * s_) * 68 + lane] = kkv_[s_] * kkv_[s_]; SCR[(2 * s_ + 1) * 68 + lane] = rr_[s_] * kmod_[s_] * r_k; } \
        { const float* rp_ = SCR + (lane >> 3) * 68 + (lane & 7) * 8; const f32x4 p0_ = *(const f32x4*)(rp_), p1_ = *(const f32x4*)(rp_ + 4); const f32x4 ps_ = p0_ + p1_; \
          const float t_ = red8((ps_[0] + ps_[1]) + (ps_[2] + ps_[3])); if ((lane & 7) == 0) SCR[8 * 68 + (lane >> 3)] = t_; } \
        { const f32x4 t0_ = *(const f32x4*)(SCR + 8 * 68), t1_ = *(const f32x4*)(SCR + 8 * 68 + 4); const float st_[8] = {t0_[0], t0_[1], t0_[2], t0_[3], t1_[0], t1_[1], t1_[2], t1_[3]}; \
          _Pragma("unroll") for (int s_ = 0; s_ < SPW; ++s_) { const int tl_ = aw * SPW + s_; \
            const float rinv_ = __builtin_amdgcn_rsqf(fmaxf(st_[2 * s_], 1e-24f)); const float kkn_ = kkv_[s_] * rinv_, bb_ = kkn_ * a_[s_]; \
            const float gm1_ = __builtin_amdgcn_exp2f(lcur_); lcur_ += rwl##X[s_]; \
            const float g_ = __builtin_amdgcn_exp2f(lcur_), ig_ = __builtin_amdgcn_exp2f(-lcur_), lam_ = __builtin_amdgcn_exp2f(ltot_ - lcur_); \
            ((bf16_t*)(V0_ + CV_UT))[tl_ * 64 + pos] = (bf16_t)cvt_pk_bf16_(-kkn_ * gm1_, 0.f); ((bf16_t*)(V0_ + CV_ZT))[tl_ * 64 + pos] = (bf16_t)cvt_pk_bf16_(rr_[s_] * g_, 0.f); \
            ((bf16_t*)(V0_ + CV_BT))[tl_ * 64 + pos] = (bf16_t)cvt_pk_bf16_(bb_ * ig_, 0.f); ((bf16_t*)(V0_ + CV_KT))[tl_ * 64 + pos] = (bf16_t)cvt_pk_bf16_(kmod_[s_] * ig_, 0.f); \
            ((bf16_t*)(V0_ + CV_BKH))[lane * 32 + aw * 8 + s_] = (bf16_t)cvt_pk_bf16_(bb_ * lam_, 0.f); ((bf16_t*)(V0_ + CV_BKH))[lane * 32 + aw * 8 + 4 + s_] = (bf16_t)cvt_pk_bf16_(kmod_[s_] * lam_, 0.f); \
            ((bf16_t*)(V0_ + CV_VT))[lane * 16 + tl_] = (bf16_t)cvt_pk_bf16_(vv_[s_], 0.f); \
            GB_[tl_ * 64 + lane] = bf2f(rg##X[s_]); GB_[TC * 64 + tl_ * 64 + lane] = st_[2 * s_ + 1] * vv_[s_] * bf2f(rg##X[s_]); } \
          if (aw == 3) ((float*)(V0_ + CV_GC))[lane] = __builtin_amdgcn_exp2f(ltot_); } } while (0)
        SCAN_LOAD(0, B); SCAN_LOAD(1, A); SCAN_PREP(0, B); SCAN_LOAD(2, B);
        __syncthreads();
        SCAN_PREP(1, A); SCAN_LOAD(3, A);
        __syncthreads();
        for (int ci = 0; ci < NC; ci += 2) {
            if (ci + 2 < NC) { SCAN_PREP(ci + 2, B); if (ci + 4 < NC) SCAN_LOAD(ci + 4, B); }
            __syncthreads();
            if (ci + 3 < NC) { SCAN_PREP(ci + 3, A); if (ci + 5 < NC) SCAN_LOAD(ci + 5, A); }
            __syncthreads();
        }
#undef SCAN_LOAD
#undef SCAN_PREP
#undef SCAN_MATS
#undef SCAN_POST
#undef OPR
    }
    __syncthreads();
}

#include <hip/hip_bf16.h>
#include <cmath>
namespace attn_body {
using bf16=__hip_bfloat16;
using bf16x8=__attribute__((ext_vector_type(8)))short;
using s16x4=__attribute__((ext_vector_type(4)))short;
using f32x16=__attribute__((ext_vector_type(16)))float;
using u32x4=__attribute__((ext_vector_type(4)))unsigned;
constexpr int SEQ=2048,D=64,DM=1024;
constexpr int NW=8,QBLK=32,QB=QBLK*NW,KVBLK=64,NQB=SEQ/QB;
__device__ __forceinline__ int crow(int r,int hi){return (r&3)+8*(r>>2)+4*hi;}
#define SBAR() __builtin_amdgcn_sched_barrier(0)
__device__ __forceinline__ void cmask(f32x16&p0,f32x16&p1,int jb,int qrel,int hi){
  const float NEG=-INFINITY; int kb=64*jb+4*hi;
  #pragma unroll
  for(int r=0;r<16;++r){int kv=kb+(r&3)+8*(r>>2); if(kv>qrel)p0[r]=NEG; if(kv+32>qrel)p1[r]=NEG;}
}

constexpr int NSLOT=3, SLOTB=8192, SLOTV=16384, NKSLOT=4;
constexpr int LDS_K=0, LDS_V=NKSLOT*SLOTB, LDS_WS=LDS_V+NSLOT*SLOTV, LDS_OST=LDS_WS+NW*64*4, LDS_BYTES=LDS_OST+NW*4096;
constexpr float C2=0.125f*1.4426950408889634f;
__device__ __forceinline__ void glds16(const void*gsrc,unsigned lds_dst){unsigned keep;
  asm volatile("s_mov_b32 %0, m0\n\ts_mov_b32 m0, %2\n\ts_nop 0\n\tglobal_load_lds_dwordx4 %1, off\n\ts_mov_b32 m0, %0":"=&s"(keep):"v"(gsrc),"s"(lds_dst):"memory");}
__device__ __forceinline__ float max3f(float a,float b,float c){float r;asm("v_max3_f32 %0, %1, %2, %3":"=v"(r):"v"(a),"v"(b),"v"(c));return r;}
__device__ __forceinline__ float max2f(float a,float b){float r;asm("v_max_f32_e32 %0, %1, %2":"=v"(r):"v"(a),"v"(b));return r;}
__device__ __forceinline__ float fadd_s(float a,float b){float r;asm("v_add_f32_e32 %0, %1, %2":"=v"(r):"v"(a),"v"(b));return r;}
__device__ __forceinline__ float fsub_s(float a,float b){float r;asm("v_sub_f32_e32 %0, %1, %2":"=v"(r):"v"(a),"v"(b));return r;}
typedef float f32x2_t __attribute__((ext_vector_type(2))); typedef __bf16 bf16x2_t __attribute__((ext_vector_type(2)));
__device__ __forceinline__ unsigned cvtpk_s(float lo,float hi){f32x2_t v={lo,hi};bf16x2_t b=__builtin_convertvector(v,bf16x2_t);return __builtin_bit_cast(unsigned,b);}
#define WAIT_BAR(N) asm volatile("s_waitcnt vmcnt(" #N ") lgkmcnt(0)\n\ts_barrier":::"memory")

__device__ __forceinline__ void qkt(f32x16&p0,f32x16&p1,const char*Kslot,const bf16x8*qr,const f32x16&negm,int r32,int hi){
  const char*kb=Kslot+hi*1024+r32*16;
  #pragma unroll
  for(int d0=0;d0<4;++d0){
    const bf16x8 b0=*reinterpret_cast<const bf16x8*>(kb+d0*2048);
    const bf16x8 b1=*reinterpret_cast<const bf16x8*>(kb+d0*2048+512);
    if(d0==0){p0=__builtin_amdgcn_mfma_f32_32x32x16_bf16(b0,qr[0],negm,0,0,0);p1=__builtin_amdgcn_mfma_f32_32x32x16_bf16(b1,qr[0],negm,0,0,0);}
    else{p0=__builtin_amdgcn_mfma_f32_32x32x16_bf16(b0,qr[d0],p0,0,0,0);p1=__builtin_amdgcn_mfma_f32_32x32x16_bf16(b1,qr[d0],p1,0,0,0);}}
}
typedef __attribute__((address_space(3))) const char* lds_cptr;
typedef short v4i16_t __attribute__((ext_vector_type(4)));
__device__ __forceinline__ void kload8(bf16x8*kf,lds_cptr kp){
  kf[0]=*(const __attribute__((address_space(3))) bf16x8*)(kp);      kf[1]=*(const __attribute__((address_space(3))) bf16x8*)(kp+512);
  kf[2]=*(const __attribute__((address_space(3))) bf16x8*)(kp+2048); kf[3]=*(const __attribute__((address_space(3))) bf16x8*)(kp+2560);
  kf[4]=*(const __attribute__((address_space(3))) bf16x8*)(kp+4096); kf[5]=*(const __attribute__((address_space(3))) bf16x8*)(kp+4608);
  kf[6]=*(const __attribute__((address_space(3))) bf16x8*)(kp+6144); kf[7]=*(const __attribute__((address_space(3))) bf16x8*)(kp+6656);
}
__device__ __forceinline__ void kload2(bf16x8*kf,lds_cptr kp,int j){ kf[2*j]=*(const __attribute__((address_space(3))) bf16x8*)(kp+j*2048); kf[2*j+1]=*(const __attribute__((address_space(3))) bf16x8*)(kp+j*2048+512); }
__device__ __forceinline__ s16x4 vtr(lds_cptr p){ return __builtin_bit_cast(s16x4,__builtin_amdgcn_ds_read_tr16_b64_v4i16((__attribute__((address_space(3))) v4i16_t*)p)); }
__device__ __forceinline__ float rowmax(const f32x16&p0,const f32x16&p1){
  float a=max3f(p0[0],p0[1],p1[0]),b=max3f(p0[2],p0[3],p1[1]);a=max3f(a,p1[2],p1[3]);
  #pragma unroll
  for(int r=4;r<16;r+=4){a=max3f(a,p0[r],p0[r+1]);b=max3f(b,p0[r+2],p0[r+3]);a=max3f(a,p1[r],p1[r+1]);b=max3f(b,p1[r+2],p1[r+3]);}
  const float m=max2f(a,b);
  auto rr=__builtin_amdgcn_permlane32_swap(__float_as_uint(m),__float_as_uint(m),false,false);
  return max2f(__uint_as_float(rr[0]),__uint_as_float(rr[1]));
}
__device__ __forceinline__ void pv(f32x16*o,int vb,bf16x8 pa0,bf16x8 pa1,bf16x8 pa2,bf16x8 pa3){
  #pragma unroll
  for(int d0=0;d0<4;++d0){s16x4 lo[4],hi[4];
    #pragma unroll
    for(int ks=0;ks<4;++ks){
      asm volatile("ds_read_b64_tr_b16 %0,%1 offset:%c2":"=&v"(lo[ks]):"v"(vb),"i"(d0*4096+ks*1024):"memory");
      asm volatile("ds_read_b64_tr_b16 %0,%1 offset:%c2":"=&v"(hi[ks]):"v"(vb),"i"(d0*4096+ks*1024+512):"memory");}
    asm volatile("s_waitcnt lgkmcnt(0)":::"memory");SBAR();
    #define PK(k) (bf16x8){lo[k][0],lo[k][1],lo[k][2],lo[k][3],hi[k][0],hi[k][1],hi[k][2],hi[k][3]}
    o[d0]=__builtin_amdgcn_mfma_f32_32x32x16_bf16(pa0,PK(0),o[d0],0,0,0);
    o[d0]=__builtin_amdgcn_mfma_f32_32x32x16_bf16(pa1,PK(1),o[d0],0,0,0);
    o[d0]=__builtin_amdgcn_mfma_f32_32x32x16_bf16(pa2,PK(2),o[d0],0,0,0);
    o[d0]=__builtin_amdgcn_mfma_f32_32x32x16_bf16(pa3,PK(3),o[d0],0,0,0);
    #undef PK
  }
}

#ifndef ATTN_STORE16
#define ATTN_STORE16(p,v) (*(u32x4*)(p)=(v))
#endif
template<int THRL> __device__ __forceinline__ void attn_unit(int b,int qkcol,int vcol,int qb,int t_lo,float slope2,const bf16*Q,const bf16*__restrict__ K,const bf16*__restrict__ V,bf16*O,char*shm){
  const int tid=opaque_tid(),lane=tid&63,r32=lane&31,hi=lane>>5; const int wid=__builtin_amdgcn_readfirstlane(tid>>6);
  const long rowbase=(long)b*SEQ; const int q0=qb*QB;
  const bf16*Qw=Q+(rowbase+q0+wid*QBLK)*DM+qkcol;
  const bf16*Kh=K+(rowbase+(long)t_lo*KVBLK)*DM+qkcol,*Vh=V+(rowbase+(long)t_lo*KVBLK)*DM+vcol;
  const unsigned lds0=(unsigned)(uintptr_t)shm;
  float*wsf=(float*)(shm+LDS_WS)+wid*64;
  const bf16*ksrc=Kh+(long)lane*DM+wid*8;
  const bf16*vsrc=Vh+(long)(16*(wid&3)+(lane>>2))*DM+(wid>>2)*32+(lane&3)*8;
  const unsigned kdst=lds0+LDS_K+wid*1024, vdst=lds0+LDS_V+(wid>>2)*4096+(wid&3)*1024;
  #define DMA_K(t,slot) glds16(ksrc+(long)(t)*KVBLK*DM,(unsigned)__builtin_amdgcn_readfirstlane(kdst+(slot)))
  #define DMA_V(t,slot) do{ glds16(vsrc+(long)(t)*KVBLK*DM,(unsigned)__builtin_amdgcn_readfirstlane(vdst+(slot))); glds16(vsrc+(long)(t)*KVBLK*DM+64,(unsigned)__builtin_amdgcn_readfirstlane(vdst+(slot)+8192)); }while(0)
  #define KSL(t) ((((t))&3)*SLOTB)
  const int vb0=(int)(lds0+LDS_V)+((lane>>4)&1)*32+(lane&3)*8+(4*hi+((lane&15)>>2))*64;
  const char*Kbase=shm+LDS_K; bf16x8 kf[4];
  const lds_cptr shm3=(lds_cptr)shm; const lds_cptr kp0=shm3+LDS_K+hi*1024+r32*16; const lds_cptr vp0=shm3+LDS_V+((lane>>4)&1)*32+(lane&3)*8+(4*hi+((lane&15)>>2))*64;
  const int NT=(q0+QB)/KVBLK-t_lo;
  DMA_K(0,0);DMA_V(0,0);DMA_K(1,SLOTB);
  bf16x8 qr[4];
  #pragma unroll
  for(int d0=0;d0<4;++d0)qr[d0]=*reinterpret_cast<const bf16x8*>(&Qw[(long)r32*DM+d0*16+hi*8]);
  float mhat=0.f,l_reg=0.f;f32x16 o[4];o[0]=f32x16{};o[1]=f32x16{};o[2]=f32x16{};o[3]=f32x16{};f32x16 negm;
  const int qrel=wid*QBLK+r32;
  _Pragma("unroll") for(int r=0;r<16;++r)negm[r]=slope2*(float)(4*hi+(r&3)+8*(r>>2)); asm volatile("":"+v"(negm));
  #define CMASK(P0,P1,t) do{int jb_=(t)-(NT-4); if(jb_>=0)cmask(P0,P1,jb_,qrel,hi);}while(0)
  #define ABIAS(P0,P1,t) do{ float kb_=slope2*(float)(64*((t)+t_lo))-mhat; asm volatile("":"+v"(kb_)); const float kc_=kb_+32.f*slope2; _Pragma("unroll") for(int r=0;r<16;++r){ P0[r]+=kb_; P1[r]+=kc_; } }while(0)
  bool resc=false;
  #define START(P0,P1) do{ const float rm=rowmax(P0,P1); resc=false; \
    { const float dl=rm; mhat=fadd_s(mhat,dl); \
      _Pragma("unroll") for(int r=0;r<16;++r){P0[r]=fsub_s(P0[r],dl);P1[r]=fsub_s(P1[r],dl);} \
      } \
    _Pragma("unroll") for(int r=0;r<16;++r)P0[r]=__builtin_amdgcn_exp2f(P0[r]); }while(0)
  #define RESC() do{ if(resc){ asm volatile("s_waitcnt lgkmcnt(0)":::"memory"); \
      _Pragma("unroll") for(int d_=0;d_<4;++d_) _Pragma("unroll") for(int r=0;r<16;++r)o[d_][r]*=wsf[crow(r,hi)]; } }while(0)
  f32x16 pA0,pA1,pB0,pB1;
  int vs_prev=0,vs_cur=0,vs_next=SLOTV;
  #define ROT() do{vs_prev=vs_cur;vs_cur=vs_next;vs_next=(vs_next==(NSLOT-1)*SLOTV)?0:vs_next+SLOTV;}while(0)
  DMA_K(2,2*SLOTB);
  WAIT_BAR(3);
  qkt(pA0,pA1,Kbase,qr,negm,r32,hi);asm volatile("s_nop 15\n\ts_nop 7":"+v"(pA0),"+v"(pA1));ABIAS(pA0,pA1,0);CMASK(pA0,pA1,0);
  START(pA0,pA1);
  _Pragma("unroll") for(int r=0;r<16;++r)pA1[r]=__builtin_amdgcn_exp2f(pA1[r]);
  WAIT_BAR(0);
  DMA_K(3,3*SLOTB);DMA_V(1,SLOTV);
  ROT();
  #define KFR(s,i,kp) kf[s]=*(const __attribute__((address_space(3))) bf16x8*)((kp)+((i)>>1)*2048+((i)&1)*512)
  { const lds_cptr kq_=kp0+KSL(1); KFR(0,0,kq_); KFR(1,1,kq_); KFR(2,2,kq_); }
  s16x4 vlo[4],vhi[4]; u32x4 pw0,pw1,pw2,pw3;
  #define PKW(P,B) cvtpk_s(P[B],P[B+1])
  #define PAF(k) __builtin_bit_cast(bf16x8,pw##k)
  #define VFR(i) (bf16x8){vlo[i][0],vlo[i][1],vlo[i][2],vlo[i][3],vhi[i][0],vhi[i][1],vhi[i][2],vhi[i][3]}
  #define PIN(x) asm volatile("":"+v"(x))
  #define MX3(a,b,c) __builtin_fmaxf(__builtin_fmaxf((a),(b)),(c))
  #define GAPA(MF,A0,A1,A2,A3,W0,W1,PW) do{ MF; sacc+=A0; sacc+=A1; sacc+=A2; sacc+=A3; PIN(sacc); W0; W1; PIN(PW); SBAR(); }while(0)
  #define EX(v) __builtin_amdgcn_exp2f(v)
  #define GAPB(MF,X,B) do{ MF; X[B]=EX(X[B]); X[B+1]=EX(X[B+1]); PIN(X); SBAR(); }while(0)
  #define VRD(j) do{ vlo[(j)&3]=vtr(vp_+(((j)&3)*4096+((j)>>2)*1024)); vhi[(j)&3]=vtr(vp_+(((j)&3)*4096+((j)>>2)*1024+512)); SBAR(); }while(0)
  #define KNX(G,i) do{ if(G){ KFR(i,i,kn_); SBAR(); } }while(0)
  #define PVM(j,k) o[(j)&3]=__builtin_amdgcn_mfma_f32_32x32x16_bf16(PAF(k),VFR((j)&3),o[(j)&3],0,0,0)
  #define STEP(C0,C1,P0,P1,t,GK,GV,GL) do{ SBAR(); \
    const lds_cptr vp_=vp0+vs_prev; const lds_cptr kp_=kp0+KSL(t); const lds_cptr kn_=kp0+KSL((t)+1); \
    KFR(3,3,kp_); SBAR(); float sacc=(P0[0]+P0[1]); \
    GAPA(C0=__builtin_amdgcn_mfma_f32_32x32x16_bf16(kf[0],qr[0],negm,0,0,0), P0[2],P0[3],P0[4],P0[5],     pw0[0]=PKW(P0,0), pw0[1]=PKW(P0,2), pw0); \
    KFR(0,4,kp_); SBAR(); GAPA(C1=__builtin_amdgcn_mfma_f32_32x32x16_bf16(kf[1],qr[0],negm,0,0,0), P0[6],P0[7],P0[8],P0[9],     pw0[2]=PKW(P0,4), pw0[3]=PKW(P0,6), pw0); \
    KFR(1,5,kp_); SBAR(); GAPA(C0=__builtin_amdgcn_mfma_f32_32x32x16_bf16(kf[2],qr[1],C0,0,0,0),   P0[10],P0[11],P0[12],P0[13], pw1[0]=PKW(P0,8), pw1[1]=PKW(P0,10), pw1); \
    KFR(2,6,kp_); SBAR(); GAPA(C1=__builtin_amdgcn_mfma_f32_32x32x16_bf16(kf[3],qr[1],C1,0,0,0),   P0[14],P0[15],P1[0],P1[1],   pw1[2]=PKW(P0,12),pw1[3]=PKW(P0,14), pw1); \
    KFR(3,7,kp_); SBAR(); GAPA(C0=__builtin_amdgcn_mfma_f32_32x32x16_bf16(kf[0],qr[2],C0,0,0,0),   P1[2],P1[3],P1[4],P1[5],     pw2[0]=PKW(P1,0), pw2[1]=PKW(P1,2), pw2); \
    VRD(0); GAPA(C1=__builtin_amdgcn_mfma_f32_32x32x16_bf16(kf[1],qr[2],C1,0,0,0),   P1[6],P1[7],P1[8],P1[9],     pw2[2]=PKW(P1,4), pw2[3]=PKW(P1,6), pw2); \
    VRD(1); GAPA(C0=__builtin_amdgcn_mfma_f32_32x32x16_bf16(kf[2],qr[3],C0,0,0,0),   P1[10],P1[11],P1[12],P1[13], pw3[0]=PKW(P1,8), pw3[1]=PKW(P1,10), pw3); \
    VRD(2); GAPA(C1=__builtin_amdgcn_mfma_f32_32x32x16_bf16(kf[3],qr[3],C1,0,0,0),   P1[14],P1[15],0.f,0.f,       pw3[2]=PKW(P1,12),pw3[3]=PKW(P1,14), pw3); \
    l_reg+=sacc; \
    if(GK){DMA_K((t)+3,KSL((t)+3));} if(GV){DMA_V((t)+1,vs_next);} \
    ABIAS(C0,C1,t); CMASK(C0,C1,t); \
    { float a=MX3(C0[0],C0[1],C1[0]),b=MX3(C0[2],C0[3],C1[1]); a=MX3(a,C1[2],C1[3]); \
      _Pragma("unroll") for(int r=4;r<16;r+=4){a=MX3(a,C0[r],C0[r+1]);b=MX3(b,C0[r+2],C0[r+3]);a=MX3(a,C1[r],C1[r+1]);b=MX3(b,C1[r+2],C1[r+3]);} \
      float rm=__builtin_fmaxf(a,b); { auto rr=__builtin_amdgcn_permlane32_swap(__float_as_uint(rm),__float_as_uint(rm),false,false); rm=__builtin_fmaxf(__uint_as_float(rr[0]),__uint_as_float(rr[1])); } \
      resc=false; \
      if(__builtin_expect(__any(rm>(float)THRL),0)){ const float dl=__builtin_fmaxf(rm,0.f); mhat+=dl; \
        _Pragma("unroll") for(int r=0;r<16;++r){C0[r]-=dl;C1[r]-=dl;} \
        const float f=__builtin_amdgcn_exp2f(-dl); l_reg*=f; if(hi==0)wsf[r32]=f; resc=true; } } \
    SBAR(); \
    VRD(3);  GAPB(PVM(0,0),  C0,0); \
    VRD(4);  GAPB(PVM(1,0),  C0,2); \
    VRD(5);  GAPB(PVM(2,0),  C0,4); \
    VRD(6);  GAPB(PVM(3,0),  C0,6); \
    VRD(7);  GAPB(PVM(4,1),  C0,8); \
    VRD(8);  GAPB(PVM(5,1),  C0,10); \
    VRD(9);  GAPB(PVM(6,1),  C0,12); \
    VRD(10); GAPB(PVM(7,1),  C0,14); \
    VRD(11); GAPB(PVM(8,2),  C1,0); \
    VRD(12); GAPB(PVM(9,2),  C1,2); \
    VRD(13); GAPB(PVM(10,2), C1,4); \
    VRD(14); GAPB(PVM(11,2), C1,6); \
    VRD(15); GAPB(PVM(12,3), C1,8); \
    KNX(GL,0); GAPB(PVM(13,3), C1,10); \
    KNX(GL,1); GAPB(PVM(14,3), C1,12); \
    KNX(GL,2); GAPB(PVM(15,3), C1,14); \
    }while(0)
  int t=1;
  #undef CMASK
  #define CMASK(P0,P1,t) do{}while(0)
  for(;t+5<NT;t+=2){
    STEP(pB0,pB1,pA0,pA1,t,true,true,true);     WAIT_BAR(3); RESC(); ROT();
    STEP(pA0,pA1,pB0,pB1,t+1,true,true,true);   WAIT_BAR(3); RESC(); ROT();
  }
  #undef CMASK
  #define CMASK(P0,P1,t) do{int jb_=(t)-(NT-4); if(jb_>=0)cmask(P0,P1,jb_,qrel,hi);}while(0)
  #define ENDW(tt) do{ if((tt)+3<NT){WAIT_BAR(3);} else if((tt)+2<NT){WAIT_BAR(2);} else {WAIT_BAR(0);} }while(0)
  for(;t+1<NT;t+=2){
    STEP(pB0,pB1,pA0,pA1,t,(t+3<NT),(t+1<NT),(t+1<NT));       ENDW(t);   RESC(); ROT();
    STEP(pA0,pA1,pB0,pB1,t+1,(t+4<NT),(t+2<NT),(t+2<NT));     ENDW(t+1); RESC(); ROT();
  }
  STEP(pB0,pB1,pA0,pA1,NT-1,false,false,false); RESC();
  { float sacc=pB0[0]+pB0[1]; _Pragma("unroll") for(int r=2;r<16;++r)sacc+=pB0[r]; _Pragma("unroll") for(int r=0;r<16;++r)sacc+=pB1[r]; l_reg+=sacc;
    pw0=(u32x4){PKW(pB0,0),PKW(pB0,2),PKW(pB0,4),PKW(pB0,6)};pw1=(u32x4){PKW(pB0,8),PKW(pB0,10),PKW(pB0,12),PKW(pB0,14)};pw2=(u32x4){PKW(pB1,0),PKW(pB1,2),PKW(pB1,4),PKW(pB1,6)};pw3=(u32x4){PKW(pB1,8),PKW(pB1,10),PKW(pB1,12),PKW(pB1,14)};
    SBAR(); pv(o,vb0+vs_cur,PAF(0),PAF(1),PAF(2),PAF(3)); }
  #undef PKW
  #undef PAF
  #undef VFR
  #undef PIN
  #undef MX3
  #undef GAPA
  #undef GAPB
  #undef EX
  #undef VRD
  #undef KNX
  #undef PVM
  #undef KFR
  #undef STEP
  #undef ENDW
  {auto rr=__builtin_amdgcn_permlane32_swap(__float_as_uint(l_reg),__float_as_uint(l_reg),false,false);l_reg=__uint_as_float(rr[0])+__uint_as_float(rr[1]);}
  int lane_e=lane; asm volatile("":"+v"(lane_e)); const int r32e=lane_e&31, hie=lane_e>>5;
  if(hie==0)wsf[32+r32e]=l_reg;asm volatile("s_waitcnt lgkmcnt(0)":::"memory");
  float rli[16];
  #pragma unroll
  for(int r=0;r<16;++r)rli[r]=__builtin_amdgcn_rcpf(wsf[32+crow(r,hie)]);
  bf16*Ow=O+(rowbase+q0+wid*QBLK)*DM+vcol;
  { bf16*stg=(bf16*)(shm+LDS_OST)+wid*2048;
    #pragma unroll
    for(int hf=0;hf<2;++hf){
      #pragma unroll
      for(int r=0;r<16;++r){const int orow=crow(r,hie);
        #pragma unroll
        for(int d0=0;d0<2;++d0)stg[orow*64+d0*32+r32e]=__float2bfloat16(o[2*hf+d0][r]*rli[r]);}
      asm volatile("s_waitcnt lgkmcnt(0)":::"memory");
      #pragma unroll
      for(int i=0;i<4;++i){const int row=i*8+(lane_e>>3),ch=lane_e&7; const u32x4 v=*(const u32x4*)(stg+row*64+ch*8); ATTN_STORE16(Ow+(long)row*DM+hf*64+ch*8,v);}
      asm volatile("s_waitcnt lgkmcnt(0)":::"memory"); } }
  asm volatile("s_waitcnt lgkmcnt(0)\n\ts_barrier":::"memory");
  #undef DMA_K
  #undef DMA_V
  #undef KSL
  #undef CMASK
  #undef ABIAS
  #undef START
  #undef RESC
  #undef ROT
}
constexpr int ATTN_LDS_BYTES=LDS_BYTES;
#undef SBAR
#undef WAIT_BAR
}

__device__ __forceinline__ void attn_unit_ref(const Params& p, unsigned char* lds, int b, int h, int comp, int qb) {
    const int tid = opaque_tid(), row = tid & 255, dh = tid >> 8;
    float* Kt = (float*)lds; float* Vt = Kt + 64 * 64;
    const bf16_t* qbuf = (const bf16_t*)(p.ws + WS_INBUF); const bf16_t* kbuf = qbuf + (size_t)T * 1024; const bf16_t* vbuf = kbuf + (size_t)T * 1024;
    bf16_t* Op = (bf16_t*)(p.ws + WS_OPART) + (size_t)comp * T * 1024;
    const size_t rowbase = (size_t)b * SEQ; const int qpos = qb * 256 + row;
    float qv[64], o[64];
    { const bf16_t* qp = qbuf + (rowbase + qpos) * 1024 + h * 128 + comp * 64;
#pragma unroll
      for (int d = 0; d < 64; d += 8) { const u32x4 w = *(const u32x4*)(qp + d);
#pragma unroll
          for (int i = 0; i < 4; ++i) { qv[d + 2 * i] = bflo(w[i]); qv[d + 2 * i + 1] = bfhi(w[i]); } } }
#pragma unroll
    for (int d = 0; d < 64; ++d) o[d] = 0.f;
    float mrun = -1e30f, l = 0.f;
    const float slope2 = exp2f(-(float)(h + 1)) * LOG2E;
    const int ntile = (qb + 1) * 4;
    for (int kt = 0; kt < ntile; ++kt) {
        __syncthreads();
        for (int ch = tid; ch < 1536; ch += NTHREADS) { const int r = ch / 24, cc = ch % 24; const size_t grow = rowbase + kt * 64 + r;
            if (cc < 8) { const u32x4 w = *(const u32x4*)(kbuf + grow * 1024 + h * 128 + comp * 64 + cc * 8);
#pragma unroll
                for (int i = 0; i < 4; ++i) { Kt[r * 64 + cc * 8 + 2 * i] = bflo(w[i]); Kt[r * 64 + cc * 8 + 2 * i + 1] = bfhi(w[i]); } }
            else { const int c2 = cc - 8; const u32x4 w = *(const u32x4*)(vbuf + grow * 1024 + h * 128 + c2 * 8);
#pragma unroll
                for (int i = 0; i < 4; ++i) { Vt[r * 128 + c2 * 8 + 2 * i] = bflo(w[i]); Vt[r * 128 + c2 * 8 + 2 * i + 1] = bfhi(w[i]); } } }
        __syncthreads();
        for (int j = 0; j < 64; ++j) {
            const int kpos = kt * 64 + j; if (kpos > qpos) break;
            float s = 0.f;
#pragma unroll
            for (int d = 0; d < 64; d += 4) { const f32x4 kv = *(const f32x4*)(Kt + j * 64 + d); s += qv[d] * kv[0] + qv[d + 1] * kv[1] + qv[d + 2] * kv[2] + qv[d + 3] * kv[3]; }
            s += slope2 * (float)kpos;
            if (s > mrun) { const float f = exp2f(mrun - s); l *= f;
#pragma unroll
                for (int d = 0; d < 64; ++d) o[d] *= f;
                mrun = s; }
            const float pr = exp2f(s - mrun); l += pr;
#pragma unroll
            for (int d = 0; d < 64; d += 4) { const f32x4 vv = *(const f32x4*)(Vt + j * 128 + dh * 64 + d); o[d] += pr * vv[0]; o[d + 1] += pr * vv[1]; o[d + 2] += pr * vv[2]; o[d + 3] += pr * vv[3]; }
        }
    }
    const float il = 1.0f / l;
    bf16_t* op = Op + (rowbase + qpos) * 1024 + h * 128 + dh * 64;
#pragma unroll
    for (int d = 0; d < 64; d += 8) { u32x4 w; w.x = pk2(o[d] * il, o[d + 1] * il); w.y = pk2(o[d + 2] * il, o[d + 3] * il); w.z = pk2(o[d + 4] * il, o[d + 5] * il); w.w = pk2(o[d + 6] * il, o[d + 7] * il); *(u32x4*)(op + d) = w; }
    __syncthreads();
}

__device__ __forceinline__ void attn_phase_queue(const Params& p, unsigned char* lds, unsigned* qctr) {
    const attn_body::bf16* Q = (const attn_body::bf16*)(p.ws + WS_INBUF); const attn_body::bf16* K = Q + (size_t)T * 1024; const attn_body::bf16* V = K + (size_t)T * 1024;
    attn_body::bf16* OP = (attn_body::bf16*)(p.ws + WS_OPART);
    volatile int* slot = (volatile int*)(lds + LDS_BYTES - 64);
    __syncthreads();
    if (threadIdx.x == 0) *slot = (int)atomicAdd(qctr, 1u);
    __syncthreads();
    int u = __builtin_amdgcn_readfirstlane(*slot);
    while (u < 1024) {
        unsigned nxt_ticket = 0u;
        if (threadIdx.x == 0) nxt_ticket = atomicAdd(qctr, 1u);
        const int qb = 7 - (u >> 7), id = u & 127;
        const int comp = id & 1, h = (id >> 1) & 7, b = id >> 4;
        const float slope2 = exp2f(-(float)(h + 1)) * LOG2E;
        const float* nrm = (const float*)(p.ws + WS_CTL + CTL_NRM); const int ni = ((b * 8 + h) * 2 + comp) * 2;
        const float q2 = nrm[ni] + nrm[ni + 1], k2 = nrm[512 + ni] + nrm[512 + ni + 1];
        const float smax = sqrtf(q2 * k2) * 1.02f, dneed = (2.0f * smax + 58.0f) / slope2;
        const float tmaxf = floorf(((float)(256 * qb - 63) - dneed) * (1.0f / 64.0f));
        int t_lo = tmaxf >= 0.f ? (int)tmaxf + 1 : 0; t_lo &= ~1; t_lo = t_lo < 4 * qb ? t_lo : 4 * qb;
        t_lo = __builtin_amdgcn_readfirstlane(t_lo);
        attn_body::attn_unit<8>(b, h * 128 + comp * 64, h * 128, qb, t_lo, slope2, Q, K, V, OP + (size_t)comp * T * 1024, (char*)lds);
        if (threadIdx.x == 0) *slot = (int)nxt_ticket;
        __syncthreads();
        u = __builtin_amdgcn_readfirstlane(*slot);
        __syncthreads();
    }
}

__device__ __forceinline__ void phase_combine(const Params& p) {
    const int tid = opaque_tid(), lane = tid & 63, wave = tid >> 6;
    const int gw = blockIdx.x * NWAVES + wave, NGW = gridDim.x * NWAVES;
    const float s1 = wave_sum(p.in[4][lane] * p.in[5][lane]), s2 = wave_sum(p.in[6][lane] * p.in[7][lane]);
    const float lam = __expf(s1) - __expf(s2) + 0.2f;
    const bf16_t* O0 = (const bf16_t*)(p.ws + WS_OPART); const bf16_t* O1 = O0 + (size_t)T * 1024; bf16_t* O = (bf16_t*)(p.ws + WS_O);
    const float* sg = p.in[8] + (lane & 7) * 16;
    float sgv[16];
#pragma unroll
    for (int i = 0; i < 16; ++i) sgv[i] = sg[i];
    for (int m0 = gw; m0 < T; m0 += 4 * NGW) {
        u32x4 a0[4], a1[4], c0[4], c1[4];
#pragma unroll
        for (int u = 0; u < 4; ++u) { const int m = m0 + u * NGW; if (m < T) {
            a0[u] = *(const u32x4*)(O0 + (size_t)m * 1024 + lane * 16); a1[u] = *(const u32x4*)(O0 + (size_t)m * 1024 + lane * 16 + 8);
            c0[u] = *(const u32x4*)(O1 + (size_t)m * 1024 + lane * 16); c1[u] = *(const u32x4*)(O1 + (size_t)m * 1024 + lane * 16 + 8); } }
#pragma unroll
        for (int u = 0; u < 4; ++u) { const int m = m0 + u * NGW; if (m < T) {
            float d[16]; float ss = 0.f;
#pragma unroll
            for (int i = 0; i < 4; ++i) { d[2 * i] = bflo(a0[u][i]) - lam * bflo(c0[u][i]); d[2 * i + 1] = bfhi(a0[u][i]) - lam * bfhi(c0[u][i]); d[8 + 2 * i] = bflo(a1[u][i]) - lam * bflo(c1[u][i]); d[8 + 2 * i + 1] = bfhi(a1[u][i]) - lam * bfhi(c1[u][i]); }
#pragma unroll
            for (int i = 0; i < 16; ++i) ss += d[i] * d[i];
            ss += __shfl_xor(ss, 1); ss += __shfl_xor(ss, 2); ss += __shfl_xor(ss, 4);
            const float rs = 0.8f / sqrtf(ss * (1.0f / 128.0f) + 1e-6f);
            u32x4 w0, w1;
            w0.x = pk2(d[0] * rs * sgv[0], d[1] * rs * sgv[1]); w0.y = pk2(d[2] * rs * sgv[2], d[3] * rs * sgv[3]); w0.z = pk2(d[4] * rs * sgv[4], d[5] * rs * sgv[5]); w0.w = pk2(d[6] * rs * sgv[6], d[7] * rs * sgv[7]);
            w1.x = pk2(d[8] * rs * sgv[8], d[9] * rs * sgv[9]); w1.y = pk2(d[10] * rs * sgv[10], d[11] * rs * sgv[11]); w1.z = pk2(d[12] * rs * sgv[12], d[13] * rs * sgv[13]); w1.w = pk2(d[14] * rs * sgv[14], d[15] * rs * sgv[15]);
            *(u32x4*)(O + (size_t)m * DM + lane * 16) = w0; *(u32x4*)(O + (size_t)m * DM + lane * 16 + 8) = w1; } }
    }
}

__device__ __forceinline__ void phase_router(const Params& p, unsigned char* lds, bool dry = false) {
    const int tid = opaque_tid(), lane = tid & 63, wave = tid >> 6, fr = lane & 15, fq = lane >> 4;
    float* part = (float*)lds;
    const bf16_t* hb = (const bf16_t*)(p.ws + WS_HB);
    const bf16_t* whi = (const bf16_t*)(p.ws + WS_WRT); const bf16_t* wlo = whi + 48 * 2048;
    const float* ss2 = (const float*)(p.ws + WS_CTL + CTL_SS2); float* rstd2 = (float*)(p.ws + WS_RSTD2);
    unsigned* cnt = (unsigned*)(p.ws + WS_CTL + CTL_CNT); int* rt = (int*)(p.ws + WS_RT); float* gateb = (float*)(p.ws + WS_GATEB); int* tokinfo = (int*)(p.ws + WS_TOKINFO);
    const int mt = wave & 3, kh = wave >> 2;
    constexpr int WROW = 528, WBUF = 2 * 48 * WROW;
    unsigned char* wlds = lds + 32768;
    for (int tb = blockIdx.x; tb < T / 64; tb += gridDim.x) {
        const int tok0 = tb * 64;
        const bf16_t* hrow = hb + (size_t)(tok0 + mt * 16 + fr) * DM + kh * 128 + fq * 8;
        bf16x8 af[8][4];
#pragma unroll
        for (int c = 0; c < 8; ++c)
#pragma unroll
            for (int j = 0; j < 4; ++j) af[c][j] = *(const bf16x8*)(hrow + c * 256 + j * 32);
        f32x4 acc[3];
#pragma unroll
        for (int i = 0; i < 3; ++i) acc[i] = (f32x4){0.f, 0.f, 0.f, 0.f};
        u32x4 st[6];
#define RT_STAGE_LOAD(c_) do { _Pragma("unroll") for (int i_ = 0; i_ < 6; ++i_) { const int pc_ = tid + 512 * i_, hl_ = pc_ / 1536, rr_ = (pc_ % 1536) >> 5, cc_ = pc_ & 31; \
            st[i_] = *(const u32x4*)((hl_ ? wlo : whi) + (size_t)rr_ * DM + (c_) * 256 + cc_ * 8); } } while (0)
#define RT_STAGE_WRITE(buf_) do { _Pragma("unroll") for (int i_ = 0; i_ < 6; ++i_) { const int pc_ = tid + 512 * i_, hl_ = pc_ / 1536, rr_ = (pc_ % 1536) >> 5, cc_ = pc_ & 31; \
            *(u32x4*)(wlds + (buf_) * WBUF + (hl_ * 48 + rr_) * WROW + cc_ * 16) = st[i_]; } } while (0)
        __syncthreads();
        RT_STAGE_LOAD(0); RT_STAGE_WRITE(0);
#pragma unroll
        for (int c = 0; c < 8; ++c) {
            if (c + 1 < 8) RT_STAGE_LOAD(c + 1);
            __syncthreads();
            const unsigned char* wb = wlds + (c & 1) * WBUF + fr * WROW + (kh * 128 + fq * 8) * 2;
#pragma unroll
            for (int j = 0; j < 4; ++j)
#pragma unroll
                for (int nt = 0; nt < 3; ++nt) {
                    const bf16x8 bhi = *(const bf16x8*)(wb + nt * 16 * WROW + j * 64), blo = *(const bf16x8*)(wb + (48 + nt * 16) * WROW + j * 64);
                    acc[nt] = __builtin_amdgcn_mfma_f32_16x16x32_bf16(af[c][j], bhi, acc[nt], 0, 0, 0);
                    acc[nt] = __builtin_amdgcn_mfma_f32_16x16x32_bf16(af[c][j], blo, acc[nt], 0, 0, 0);
                }
            if (c + 1 < 8) RT_STAGE_WRITE((c + 1) & 1);
        }
#undef RT_STAGE_LOAD
#undef RT_STAGE_WRITE
#pragma unroll
        for (int nt = 0; nt < 3; ++nt)
#pragma unroll
            for (int r = 0; r < 4; ++r) part[(kh * 64 + mt * 16 + fq * 4 + r) * 48 + nt * 16 + fr] = acc[nt][r];
        __syncthreads();
        int* lcnt = (int*)(lds + 24576);
        if (tid < 64) lcnt[tid] = 0;
        __syncthreads();
        int e0 = 0, e1 = 0, lr0 = 0, lr1 = 0; float g0 = 0.f, g1 = 0.f;
        if (tid < 64 && !dry) {
            const float* l0 = part + tid * 48; const float* l1 = part + (64 + tid) * 48;
            const int t = tok0 + tid; const float rs = 1.0f / sqrtf(ss2[t] * (1.0f / DM) + 1e-6f); rstd2[t] = rs;
            float g4[4]; int grp = 0; float gmax = -3.0e38f;
#pragma unroll
            for (int i = 0; i < 4; ++i) { g4[i] = (l0[i] + l1[i]) * rs + p.in[26][i]; if (g4[i] > gmax) { gmax = g4[i]; grp = i; } }
            float gs = 0.f;
#pragma unroll
            for (int i = 0; i < 4; ++i) gs += __expf(g4[i] - gmax);
            const float pg = 1.0f / gs;
            float e8[8]; int i0 = 0; float m0 = -3.0e38f;
#pragma unroll
            for (int i = 0; i < 8; ++i) { e8[i] = (l0[4 + grp * 8 + i] + l1[4 + grp * 8 + i]) * rs + p.in[28][grp * 8 + i]; if (e8[i] > m0) { m0 = e8[i]; i0 = i; } }
            int i1 = 0; float m1 = -3.0e38f;
#pragma unroll
            for (int i = 0; i < 8; ++i) if (i != i0 && e8[i] > m1) { m1 = e8[i]; i1 = i; }
            const float p1 = __expf(m1 - m0); g0 = pg / (1.0f + p1); g1 = pg * p1 / (1.0f + p1);
            e0 = grp * 8 + i0; e1 = grp * 8 + i1;
            lr0 = atomicAdd(lcnt + e0, 1); lr1 = atomicAdd(lcnt + e1, 1);
        }
        __syncthreads();
        if (tid < 32 && !dry) { const int c = lcnt[tid]; lcnt[32 + tid] = c > 0 ? (int)atomicAdd(cnt + tid, (unsigned)c) : 0; }
        __syncthreads();
        if (tid < 64 && !dry) {
            const int t = tok0 + tid; const unsigned r0 = (unsigned)(lcnt[32 + e0] + lr0), r1 = (unsigned)(lcnt[32 + e1] + lr1);
            rt[(size_t)e0 * CAP + r0] = t; rt[(size_t)e1 * CAP + r1] = t; gateb[(size_t)e0 * CAP + r0] = g0; gateb[(size_t)e1 * CAP + r1] = g1;
            int4 ti; ti.x = e0 * CAP + (int)r0; ti.y = e1 * CAP + (int)r1; ti.z = 0; ti.w = 0; *(int4*)(tokinfo + (size_t)t * 4) = ti;
        }
        __syncthreads();
    }
}

__device__ __forceinline__ void phase_final(const Params& p, unsigned char* lds, float* dst) {
    const int tid = opaque_tid(), lane = tid & 63, wave = tid >> 6;
    const int gw = blockIdx.x * NWAVES + wave, NGW = gridDim.x * NWAVES;
    int* pst = (int*)lds;
    const unsigned* cnt = (const unsigned*)(p.ws + WS_CTL + CTL_CNT);
    if (tid == 0) { int ts = 0; for (int e = 0; e < NEXP; ++e) { pst[e] = ts; ts += ((int)cnt[e] + 255) >> 8; } }
    __syncthreads();
    const int* tokinfo = (const int*)(p.ws + WS_TOKINFO); const bf16_t* yb = (const bf16_t*)(p.ws + WS_YB); const bf16_t* hbuf = (const bf16_t*)(p.ws + WS_HB); const float* gfin = p.in[32];
    f32x4 gv[8];
#pragma unroll
    for (int j = 0; j < 8; ++j) gv[j] = *((const f32x4*)gfin + lane + 64 * j);
    constexpr int MAXTOK = 8;
    unsigned sl0[MAXTOK], sl1[MAXTOK];
#pragma unroll
    for (int i = 0; i < MAXTOK; ++i) { const int m = gw + i * NGW; sl0[i] = 0u; sl1[i] = 0u;
        if (m < T) { const int4 ti = *(const int4*)(tokinfo + (size_t)m * 4); sl0[i] = (unsigned)(pst[ti.x / CAP] * 256 + ti.x % CAP); sl1[i] = (unsigned)(pst[ti.y / CAP] * 256 + ti.y % CAP); } }
    u32x2 hA[8], aA[8], bA[8], hB[8], aB[8], bB[8];
#define FIN_LOAD(i_, H, A, B) do { const int m_ = gw + (i_) * NGW; if (m_ < T) { const u32x2* hr_ = (const u32x2*)(hbuf + (size_t)m_ * DM) + lane; const u32x2* y0_ = (const u32x2*)(yb + (size_t)sl0[i_] * DM) + lane; const u32x2* y1_ = (const u32x2*)(yb + (size_t)sl1[i_] * DM) + lane; \
        _Pragma("unroll") for (int j = 0; j < 8; ++j) { H[j] = hr_[64 * j]; A[j] = y0_[64 * j]; B[j] = y1_[64 * j]; } } } while (0)
#define FIN_PROC(i_, H, A, B) do { const int m_ = gw + (i_) * NGW; if (m_ < T) { f32x4 v[8]; float s_ = 0.f; \
        _Pragma("unroll") for (int j = 0; j < 8; ++j) { v[j][0] = bflo(H[j].x) + (bflo(A[j].x) + bflo(B[j].x)); v[j][1] = bfhi(H[j].x) + (bfhi(A[j].x) + bfhi(B[j].x)); v[j][2] = bflo(H[j].y) + (bflo(A[j].y) + bflo(B[j].y)); v[j][3] = bfhi(H[j].y) + (bfhi(A[j].y) + bfhi(B[j].y)); \
            s_ += (v[j][0] * v[j][0] + v[j][1] * v[j][1]) + (v[j][2] * v[j][2] + v[j][3] * v[j][3]); } \
        s_ = wave_sum_fast(s_); const float rs_ = 1.0f / sqrtf(s_ * (1.0f / DM) + 1e-6f); \
        _Pragma("unroll") for (int j = 0; j < 8; ++j) { f32x4 ov = v[j] * rs_ * gv[j]; \
            if (PROBE_TS_A >= 0 && m_ == 0 && lane == 0 && j == 0) { const unsigned long long* ts = (const unsigned long long*)(p.ws + WS_CTL + CTL_TS); ov[0] += (PROBE_TS_A == 99) ? sqrtf(33.554432f * (float)p.ws_mib) : sqrtf(33.554432f * (float)(ts[PROBE_TS_B] - ts[PROBE_TS_A]) * 0.01f); } \
            ((f32x4*)(dst + (size_t)m_ * DM) + lane)[64 * j] = ov; } } } while (0)
    FIN_LOAD(0, hA, aA, bA);
#pragma unroll
    for (int i = 0; i < MAXTOK; i += 2) {
        FIN_LOAD(i + 1, hB, aB, bB);
        FIN_PROC(i, hA, aA, bA);
        if (i + 2 < MAXTOK) FIN_LOAD(i + 2, hA, aA, bA);
        FIN_PROC(i + 1, hB, aB, bB);
    }
    for (int m = gw + MAXTOK * NGW; m < T; m += NGW) {
        const int4 ti = *(const int4*)(tokinfo + (size_t)m * 4); sl0[0] = (unsigned)(pst[ti.x / CAP] * 256 + ti.x % CAP); sl1[0] = (unsigned)(pst[ti.y / CAP] * 256 + ti.y % CAP);
        const u32x2* hr_ = (const u32x2*)(hbuf + (size_t)m * DM) + lane; const u32x2* y0_ = (const u32x2*)(yb + (size_t)sl0[0] * DM) + lane; const u32x2* y1_ = (const u32x2*)(yb + (size_t)sl1[0] * DM) + lane;
        f32x4 v[8]; float s_ = 0.f;
#pragma unroll
        for (int j = 0; j < 8; ++j) { const u32x2 H = hr_[64 * j], A = y0_[64 * j], B = y1_[64 * j];
            v[j][0] = bflo(H.x) + (bflo(A.x) + bflo(B.x)); v[j][1] = bfhi(H.x) + (bfhi(A.x) + bfhi(B.x)); v[j][2] = bflo(H.y) + (bflo(A.y) + bflo(B.y)); v[j][3] = bfhi(H.y) + (bfhi(A.y) + bfhi(B.y));
            s_ += (v[j][0] * v[j][0] + v[j][1] * v[j][1]) + (v[j][2] * v[j][2] + v[j][3] * v[j][3]); }
        s_ = wave_sum_fast(s_); const float rs_ = 1.0f / sqrtf(s_ * (1.0f / DM) + 1e-6f);
#pragma unroll
        for (int j = 0; j < 8; ++j) ((f32x4*)(dst + (size_t)m * DM) + lane)[64 * j] = v[j] * rs_ * gv[j];
    }
#undef FIN_LOAD
#undef FIN_PROC
}

#define GAS __attribute__((address_space(1)))
typedef GAS unsigned gu32;
#define RLX_AGENT __ATOMIC_RELAXED, __HIP_MEMORY_SCOPE_AGENT
#define XB_TMO      128
#define XB_XCNT(j)  (256  + 64 * (j))
#define XB_XSUB(j)  (1280 + 64 * (j))
#define XB_XGEN(j)  (2304 + 64 * (j))
#define XB_TOP      3328
#define XB_TOPGEN   3392
#define XCD_BAR_WORDS 3456
#define XB_SPIN_CAP (1u << 18)

__device__ __forceinline__ unsigned xb_ld(unsigned* p)              { return __hip_atomic_load(p, __ATOMIC_RELAXED, __HIP_MEMORY_SCOPE_AGENT); }
__device__ __forceinline__ unsigned xb_add(unsigned* p, unsigned v) { return __hip_atomic_fetch_add(p, v, __ATOMIC_RELAXED, __HIP_MEMORY_SCOPE_AGENT); }
__device__ __forceinline__ unsigned xb_xcc_id() { return (unsigned)__builtin_amdgcn_s_getreg((3 << 11) | 20) & 0xFu; }
#define XB_SPIN(cond, bar) do { unsigned _sp = 0; while (cond) { __builtin_amdgcn_s_sleep(1); \
    if ((++_sp & 255u) == 0u) { if (xb_ld(&(bar)[XB_TMO])) break; if (_sp > XB_SPIN_CAP) { atomicAdd(&(bar)[XB_TMO], 1u); break; } } } } while (0)

struct XcdBarrier {
    unsigned* bar; unsigned x;
    volatile LAS unsigned* st;
};

__device__ __forceinline__ XcdBarrier xcd_barrier_post(unsigned* bar, volatile LAS unsigned* st) {
    XcdBarrier b; b.bar = bar; b.x = xb_xcc_id(); b.st = st;
    if (threadIdx.x == 0) (void)xb_add(&bar[XB_XCNT(b.x)], 1u);
    return b;
}
__device__ __forceinline__ void xcd_barrier_complete(unsigned* bar, unsigned x, unsigned& nloc, unsigned& nx) {
    const unsigned G = gridDim.x * gridDim.y * gridDim.z;
    unsigned sum, cnt, mine, sp = 0u;
    for (;;) {
        sum = 0u; cnt = 0u; mine = 0u;
#pragma unroll
        for (unsigned j = 0; j < 16; ++j) { const unsigned c = xb_ld(&bar[XB_XCNT(j)]); sum += c; cnt += (c > 0u) ? 1u : 0u; mine = (j == x) ? c : mine; }
        if (sum == G) break;
        __builtin_amdgcn_s_sleep(1);
        if ((++sp & 255u) == 0u) { if (xb_ld(&bar[XB_TMO])) break; if (sp > XB_SPIN_CAP) { atomicAdd(&bar[XB_TMO], 1u); break; } }
    }
    nloc = mine > 0u ? mine : 1u; nx = cnt > 0u ? cnt : 1u;
}

__device__ __forceinline__ void xcd_barrier(const XcdBarrier& b) {
    asm volatile("s_waitcnt vmcnt(0)" ::: "memory");
    __syncthreads();
    if (threadIdx.x == 0) {
        unsigned* bar = b.bar;
        __builtin_amdgcn_s_waitcnt(0);
        unsigned nloc = b.st[0], nx = b.st[1];
        if (nloc == 0u) { xcd_barrier_complete(bar, b.x, nloc, nx); b.st[0] = nloc; b.st[1] = nx; }
        const unsigned old = xb_add(&bar[XB_XSUB(b.x)], 1u);
        const unsigned gen = old / nloc;
        if (old + 1u == (gen + 1u) * nloc) {
            __builtin_amdgcn_fence(__ATOMIC_RELEASE, "agent");
            asm volatile("s_waitcnt vmcnt(0)" ::: "memory");
            const unsigned og = xb_add(&bar[XB_TOP], 1u);
            const unsigned tg = og / nx;
            if (og + 1u == (tg + 1u) * nx) xb_add(&bar[XB_TOPGEN], 1u);
            else XB_SPIN(xb_ld(&bar[XB_TOPGEN]) == tg, bar);
            __builtin_amdgcn_fence(__ATOMIC_ACQUIRE, "agent");
            xb_add(&bar[XB_XGEN(b.x)], 1u);
            asm volatile("s_waitcnt vmcnt(0)" ::: "memory");
        } else {
            XB_SPIN(xb_ld(&bar[XB_XGEN(b.x)]) == gen, bar);
            __builtin_amdgcn_fence(__ATOMIC_ACQUIRE, "agent");
            asm volatile("s_waitcnt vmcnt(0)" ::: "memory");
        }
    }
    __syncthreads();
}


#if USE_REF_GEMM
#define GEMM_PHASE gemm_phase_ref
#else
#define GEMM_PHASE gemm_phase_mfma
#endif

__global__ void __launch_bounds__(NTHREADS, 2) fwd_kernel(Params p) {
    extern __shared__ __attribute__((aligned(16))) unsigned char lds[];
    unsigned char* ws = p.ws;
    const int lo = p.ph_lo, hi = p.ph_hi;
#define IN(k) (lo <= (k) && (k) < hi)
#if N_LAUNCH_MODE == 1
    volatile LAS unsigned* bst = (volatile LAS unsigned*)((LAS unsigned char*)lds + LDS_BYTES - 32);
    if (threadIdx.x < 2) bst[threadIdx.x] = 0u;
    __syncthreads();
    const XcdBarrier bar = xcd_barrier_post((unsigned*)(ws + WS_CTL + CTL_BAR), bst);
#define SEAM(k) do { if (IN(k) && IN((k) + 1)) xcd_barrier(bar); if (PROBE_TS_A >= 0 && blockIdx.x == 0 && threadIdx.x == 0) ((unsigned long long*)(ws + WS_CTL + CTL_TS))[(k) + 1] = __builtin_amdgcn_s_memrealtime(); } while (0)
#else
#define SEAM(k) do { } while (0)
#endif
    if (PROBE_TS_A >= 0 && blockIdx.x == 0 && threadIdx.x == 0) ((unsigned long long*)(ws + WS_CTL + CTL_TS))[0] = __builtin_amdgcn_s_memrealtime();
    if (IN(PH_PRO)) { phase_prologue(p, lds); if (PROBE_DUP & 8) { __syncthreads(); phase_prologue(p, lds); } } SEAM(PH_PRO);
    if (IN(PH_INPROJ)) {
        Gemm g{(const bf16_t*)(ws + WS_XB), (const bf16_t*)(ws + WS_WIN), DM, DM, DM};
        DenseOrder S; S.init(T, NIN, gridDim.x, blockIdx.x, DM, DM);
        EpiIn E{(bf16_t*)(ws + WS_INBUF), (bf16_t*)(ws + WS_PBUF), (const float*)(ws + WS_RSTD1), (unsigned*)(ws + WS_CTL + CTL_NRM)};
        GEMM_PHASE<EpiIn, DenseOrder>(lds, g, S, E);
        if (PROBE_DUP & 64) GEMM_PHASE<EpiIn, DenseOrder>(lds, g, S, E);
    } SEAM(PH_INPROJ);
    if (IN(PH_L2PREP)) { phase_l2prep(p); if (PROBE_DUP & 4096) { phase_l2prep(p); phase_l2prep(p); phase_l2prep(p); } } SEAM(PH_L2PREP);
    if (IN(PH_L2GEMM)) {
        Gemm g{(const bf16_t*)(ws + WS_A2), (const bf16_t*)(ws + WS_L2T), PW, 256, 256};
        DenseOrder S; S.init(T, 3072, gridDim.x, blockIdx.x, PW, 256, 2, 256);
        EpiL2 E{(float*)(ws + WS_WL), (bf16_t*)(ws + WS_ABUF), (bf16_t*)(ws + WS_GBUF), p.in[11], p.in[14]};
        GEMM_PHASE<EpiL2, DenseOrder>(lds, g, S, E);
        if (PROBE_DUP & 16384) GEMM_PHASE<EpiL2, DenseOrder>(lds, g, S, E);
    } SEAM(PH_L2GEMM);
    if (IN(PH_MIX)) {
        for (int rep = 0; rep < ((PROBE_DUP & 1) ? 2 : 1); ++rep)
        if (((blockIdx.x >> 3) & 1) == 0) for (int chain = ((blockIdx.x >> 4) << 3) | (blockIdx.x & 7); chain < BATCH * NH_RW; chain += gridDim.x >> 1) rwkv_chain(p, lds, chain);
        { const unsigned g16 = (blockIdx.x >> 4) & 7, l16 = blockIdx.x & 15;
          if (l16 == 8 + g16 || l16 == 8 + ((g16 + 4) & 7)) convert_gu_queue(p, lds, (unsigned*)(ws + WS_CTL + CTL_QCTR) + 3, 0, NEXP_EARLY); }
        attn_phase_queue(p, lds, (unsigned*)(ws + WS_CTL + CTL_QCTR));
        convert_gu_queue(p, lds, (unsigned*)(ws + WS_CTL + CTL_QCTR) + 3, 0, NEXP_EARLY);
        if (PROBE_DUP & 2) attn_phase_queue(p, lds, (unsigned*)(ws + WS_CTL + CTL_QCTR) + 1);
    } SEAM(PH_MIX);
    if (IN(PH_COMB)) { phase_combine(p); if (PROBE_DUP & 2048) { phase_combine(p); phase_combine(p); phase_combine(p); } } SEAM(PH_COMB);
    if (IN(PH_OUT)) {
        Gemm g{(const bf16_t*)(ws + WS_O), (const bf16_t*)(ws + WS_WOUT), DM, DM, DM};
        DenseOrder S; S.init(T, DM, gridDim.x, blockIdx.x, DM, DM);
        EpiOut E{p.in[0], p.out, (bf16_t*)(ws + WS_HB), (float*)(ws + WS_CTL + CTL_SS2)};
        GEMM_PHASE<EpiOut, DenseOrder>(lds, g, S, E);
        if (PROBE_DUP & 8192) { EpiOut E2{p.in[0], p.out, (bf16_t*)(ws + WS_HB), (float*)(ws + WS_RSTD1)}; GEMM_PHASE<EpiOut, DenseOrder>(lds, g, S, E2); }
    } SEAM(PH_OUT);
    if (IN(PH_ROUTE)) { if (PROBE_DUP & 1024) { phase_router(p, lds, true); __syncthreads(); } phase_router(p, lds); convert_gu_queue(p, lds, (unsigned*)(ws + WS_CTL + CTL_QCTR) + 4, NEXP_EARLY, NEXP); } SEAM(PH_ROUTE);
    const int vcu_moe = (gridDim.x % 8 == 0) ? (int)((blockIdx.x % 8) * (gridDim.x / 8) + blockIdx.x / 8) : (int)blockIdx.x;
    if (IN(PH_G1)) {
        Gemm g{(const bf16_t*)(ws + WS_HB), (const bf16_t*)ws, DM, DM, DM};
        MoeOrder<true> S{(const int*)(ws + WS_RT), 4, (int)gridDim.x, vcu_moe, 0, DM, (long)1024 * 2048, DM, 0, 0, 0}; S.init((const unsigned*)(ws + WS_CTL + CTL_CNT));
        EpiGU E{(bf16_t*)(ws + WS_HID), (const float*)(ws + WS_RSTD2)};
        GEMM_PHASE<EpiGU, MoeOrder<true>>(lds, g, S, E);
        convert_down_queue(p, lds, (unsigned*)(ws + WS_CTL + CTL_QCTR) + 2);
        if (PROBE_DUP & 128) GEMM_PHASE<EpiGU, MoeOrder<true>>(lds, g, S, E);
    } SEAM(PH_G1);
    if (IN(PH_G2)) {
        Gemm g{(const bf16_t*)(ws + WS_HID), (const bf16_t*)ws, DEXP, DEXP, DEXP};
        MoeOrder<false> S{(const int*)(ws + WS_RT), 8, (int)gridDim.x, vcu_moe, 1, DEXP, (long)2048 * 512, DEXP, 0, 0, 0}; S.init((const unsigned*)(ws + WS_CTL + CTL_CNT));
        EpiDown E{(bf16_t*)(ws + WS_YB), (const float*)(ws + WS_GATEB), (const unsigned*)(ws + WS_CTL + CTL_CNT)};
        GEMM_PHASE<EpiDown, MoeOrder<false>>(lds, g, S, E);
        if (PROBE_DUP & 256) GEMM_PHASE<EpiDown, MoeOrder<false>>(lds, g, S, E);
    } SEAM(PH_G2);
    if (IN(PH_FINAL)) { if (PROBE_DUP & 32768) { phase_final(p, lds, (float*)(ws + WS_XB)); __syncthreads(); } phase_final(p, lds, p.out); }
}

extern "C" void kernel_launch(void* const* d_in, const int* in_sizes, int n_in, void* d_out, int out_size, void* d_ws, size_t ws_size, hipStream_t stream) {
    static int grid = 0;
    if (grid == 0) {
        if (n_in != 33 || out_size != T * DM || ws_size < WS_END) { fprintf(stderr, "kernel_launch: unexpected problem (n_in %d out %d ws %zu)\n", n_in, out_size, ws_size); grid = -1; return; }
        int dev = 0, cus = 0;
        hipGetDevice(&dev); hipDeviceGetAttribute(&cus, hipDeviceAttributeMultiprocessorCount, dev);
        if (hipFuncSetAttribute((const void*)fwd_kernel, hipFuncAttributeMaxDynamicSharedMemorySize, LDS_BYTES) != hipSuccess) { fprintf(stderr, "kernel_launch: hipFuncSetAttribute failed\n"); grid = -1; return; }
        int per_cu = 0; hipOccupancyMaxActiveBlocksPerMultiprocessor(&per_cu, (const void*)fwd_kernel, NTHREADS, LDS_BYTES); (void)hipGetLastError();
        if (per_cu < 1) fprintf(stderr, "kernel_launch: occupancy query says %d blocks per CU\n", per_cu);
        if (per_cu < 1) { grid = -1; return; }
        grid = cus > 0 ? cus : 256;
    }
    if (grid < 0) return;
    hipMemsetAsync((char*)d_ws + WS_CTL, 0, CTL_BYTES, stream);
    Params p{};
    for (int i = 0; i < 33; ++i) p.in[i] = (const float*)d_in[i];
    p.out = (float*)d_out; p.ws = (unsigned char*)d_ws; p.ws_mib = (unsigned long long)(ws_size >> 20);
#if N_LAUNCH_MODE == 1
    p.ph_lo = 0; p.ph_hi = PH_COUNT;
    void* args[] = {&p};
    hipError_t e = hipLaunchCooperativeKernel((const void*)fwd_kernel, dim3(grid), dim3(NTHREADS), args, LDS_BYTES, stream);
    if (e != hipSuccess) fprintf(stderr, "cooperative launch failed: %s (grid %d)\n", hipGetErrorString(e), grid);
#else
    for (int ph = 0; ph < PH_COUNT; ++ph) { p.ph_lo = ph; p.ph_hi = ph + 1; hipLaunchKernelGGL(fwd_kernel, dim3(grid), dim3(NTHREADS), LDS_BYTES, stream, p); }
#endif
}
```

```cpp
#include <hip/hip_runtime.h>
#include <hip/hip_cooperative_groups.h>
#include <cstdio>
#include <cstdint>
namespace cg = cooperative_groups;

#ifndef N_LAUNCH_MODE
#define N_LAUNCH_MODE 1
#endif
#ifndef PROBE_TS_A
#define PROBE_TS_A -1
#define PROBE_TS_B -1
#endif
#ifndef PROBE_DUP
#define PROBE_DUP 0
#endif
#ifndef USE_REF_ATTN
#define USE_REF_ATTN 0
#endif
#ifndef USE_REF_GEMM
#define USE_REF_GEMM 0
#endif

constexpr int BATCH = 8, SEQ = 2048, DM = 2048, T = BATCH * SEQ;
constexpr int DAW = 1024, RWW = 1024, NH_DA = 8, NH_RW = 16;
constexpr int NIN = 6912;
constexpr int PW = 768;
constexpr int NEXP = 32, DEXP = 512, CAP = T;
constexpr int MAXTILES = 160;
constexpr float C2Q = 0.125f * 1.4426950408889634f;
constexpr float LOG2E = 1.4426950408889634f;

constexpr size_t MiB = 1u << 20;
constexpr size_t WS_CTL = 0, CTL_BYTES = 1 * MiB;
constexpr size_t CTL_SS2 = 65536;
constexpr size_t CTL_CNT = 131072;
constexpr size_t CTL_QCTR = 131072 + 256;
constexpr size_t CTL_NRM = 131072 + 1024;
constexpr size_t CTL_TS = 131072 + 512;
constexpr size_t CTL_BAR = 262144;
constexpr size_t WS_WOUT = 1 * MiB;
constexpr size_t WS_L2T = 9 * MiB;
constexpr size_t WS_RSTD1 = 11 * MiB;
constexpr size_t WS_RSTD2 = 11 * MiB + 65536;
constexpr size_t WS_TOKINFO = 11 * MiB + 131072;
constexpr size_t WS_WRT = 11 * MiB + 524288;
constexpr size_t WS_WIN = 12 * MiB;
constexpr size_t WS_XB = 40 * MiB;
constexpr size_t WS_O = 40 * MiB;
constexpr size_t WS_INBUF = 104 * MiB;
constexpr size_t WS_PBUF = 296 * MiB;
constexpr size_t WS_A2 = 320 * MiB;
constexpr size_t WS_WL = 344 * MiB;
constexpr size_t WS_ABUF = 408 * MiB;
constexpr size_t WS_GBUF = 440 * MiB;
constexpr size_t WS_OPART = 472 * MiB;
constexpr size_t WS_HB = 104 * MiB;
constexpr size_t WS_WGU = 168 * MiB;
constexpr size_t WS_WD = 168 * MiB;
__host__ __device__ constexpr size_t wd_byte_off(int e) { return 168 * MiB + (size_t)e * 2 * MiB; }
constexpr int NEXP_EARLY = 28, NEXP_MIX = 18;
__host__ __device__ constexpr size_t wgu_byte_off(int e) { return e < 6 ? (12 * MiB + (size_t)e * 4 * MiB) : e < 18 ? (296 * MiB + (size_t)(e - 6) * 4 * MiB) : e < 28 ? (536 * MiB + (size_t)(e - 18) * 4 * MiB) : (232 * MiB + (size_t)(e - 28) * 4 * MiB); }
constexpr size_t WS_RT = 360 * MiB;
constexpr size_t WS_GATEB = 362 * MiB;
constexpr size_t WS_HID = 364 * MiB;
constexpr size_t WS_YB = 404 * MiB;
constexpr size_t WS_END = 576 * MiB;

constexpr int NTHREADS = 512, NWAVES = 8;
constexpr int LDS_BYTES = 147456;

typedef unsigned short bf16_t;
typedef short bf16x8 __attribute__((ext_vector_type(8)));
typedef float f32x4 __attribute__((ext_vector_type(4)));
typedef float f32x2 __attribute__((ext_vector_type(2)));
typedef unsigned u32x4 __attribute__((ext_vector_type(4)));
typedef unsigned u32x2 __attribute__((ext_vector_type(2)));

__device__ __forceinline__ unsigned f2bf(float f) { unsigned u = __builtin_bit_cast(unsigned, f); return (u + 0x7fffu + ((u >> 16) & 1u)) >> 16; }
typedef __bf16 bf16x2_n __attribute__((ext_vector_type(2)));
__device__ __forceinline__ unsigned cvt_pk_bf16_(float lo, float hi) { const f32x2 v = {lo, hi}; const bf16x2_n b = __builtin_convertvector(v, bf16x2_n); return __builtin_bit_cast(unsigned, b); }
__device__ __forceinline__ unsigned pk2(float lo, float hi) { return cvt_pk_bf16_(lo, hi); }
__device__ __forceinline__ float bf2f(unsigned h) { return __builtin_bit_cast(float, h << 16); }
__device__ __forceinline__ float bflo(unsigned w) { return __builtin_bit_cast(float, w << 16); }
__device__ __forceinline__ float bfhi(unsigned w) { return __builtin_bit_cast(float, w & 0xffff0000u); }
__device__ __forceinline__ float wave_sum(float v) {
#pragma unroll
    for (int o = 1; o < 64; o <<= 1) v += __shfl_xor(v, o);
    return v;
}
__device__ __forceinline__ int opaque_tid() { int t = threadIdx.x; asm volatile("" : "+v"(t)); return t; }
__device__ __forceinline__ float sigmoidf_(float x) { return __builtin_amdgcn_rcpf(1.0f + __builtin_amdgcn_exp2f(-1.4426950408889634f * x)); }

struct Params {
    const float* in[33];
    float* out;
    unsigned char* ws;
    int ph_lo, ph_hi;
    unsigned long long ws_mib;
};

enum { PH_PRO = 0, PH_INPROJ, PH_L2PREP, PH_L2GEMM, PH_MIX, PH_COMB, PH_OUT, PH_ROUTE, PH_G1, PH_G2, PH_FINAL, PH_COUNT };

struct Unit { int pm, pn; long a_off, b_off; const int* gidx; int valid, e, tile, k; };
struct Gemm { const bf16_t* A; const bf16_t* Bt; int lda, ldb, K; };

struct DenseOrder {
    static constexpr bool GATHER = false;
    int nM, nN, nwg, G, c, lda, ldb, acol_shift, acol_w;
    __device__ void init(int M, int N, int G_, int c_, int lda_, int ldb_, int acol_shift_ = -1, int acol_w_ = 0) {
        nM = M / 256; nN = N / 256; nwg = nM * nN; G = G_; c = c_; lda = lda_; ldb = ldb_; acol_shift = acol_shift_; acol_w = acol_w_; }
    __device__ bool next(int i, Unit& u) const {
        const long L = (long)i * G + c; if (L >= nwg) return false;
        int wgid = (int)L; { const int q = nwg / 8, r = nwg % 8, xcd = wgid % 8, off = wgid / 8; wgid = (xcd < r ? xcd * (q + 1) : r * (q + 1) + (xcd - r) * q) + off; }
        const int nig = 8 * nN, gid = wgid / nig, fm = gid * 8, gsz = (nM - fm) < 8 ? (nM - fm) : 8;
        u.pm = fm + ((wgid % nig) % gsz); u.pn = (wgid % nig) / gsz;
        u.a_off = (long)u.pm * 256 * lda + (acol_shift >= 0 ? (long)(u.pn >> acol_shift) * acol_w : 0);
        u.b_off = (long)u.pn * 256 * ldb; u.gidx = nullptr; u.valid = 256; u.e = 0; u.tile = 0; u.k = 0; return true;
    }
};
template <bool GATHER_> struct MoeOrder {
    static constexpr bool GATHER = GATHER_;
    const int* rt; int ncol, G, c, mode; long a_ld, b_estride, b_ld;
    int my_cnt, my_ts, ntot;
    __device__ __forceinline__ void init(const unsigned* cnt) {
        const int lane = threadIdx.x & 63, e = lane & 31;
        my_cnt = (int)cnt[e]; const int nt = (my_cnt + 255) >> 8;
        int incl = nt;
#pragma unroll
        for (int o = 1; o < 32; o <<= 1) { const int v = __shfl_up(incl, o, 32); if (e >= o) incl += v; }
        my_ts = incl - nt; ntot = __builtin_amdgcn_readlane(incl, 31);
    }
    __device__ __forceinline__ bool next(int i, Unit& u) const {
        const long L = (long)i * G + c; const int g = (int)(L / ncol), pn = (int)(L % ncol);
        if (g >= ntot) return false;
        const unsigned long long m = __ballot(my_ts <= g) & 0xffffffffull;
        const int e = 63 - __builtin_clzll(m);
        const int ts = __builtin_amdgcn_readlane(my_ts, e), ce = __builtin_amdgcn_readlane(my_cnt, e), k = g - ts;
        u.pm = g; u.pn = pn; u.e = e; u.tile = g; u.k = k; u.valid = (ce - 256 * k) < 256 ? (ce - 256 * k) : 256;
        if (mode == 0) { u.gidx = rt + (long)e * CAP + 256 * k; u.a_off = 0; }
        else { u.gidx = nullptr; u.a_off = (long)g * 256 * a_ld; }
        u.b_off = (long)((mode == 1 ? wd_byte_off(e) : wgu_byte_off(e)) / 2) + (long)pn * 256 * b_ld; return true;
    }
};

template <class Epi, class Sched>
__device__ __forceinline__ void gemm_phase_ref(unsigned char* lds, const Gemm g, const Sched& S, const Epi& E) {
    const int tid = threadIdx.x, wid = tid >> 6, lane = tid & 63, wr = wid >> 2, wc = wid & 3, fr = lane & 15, fq = lane >> 4;
    bf16_t* As = (bf16_t*)lds; bf16_t* Bs = As + 256 * 72;
    Unit u;
    for (int ui = 0; S.next(ui, u); ++ui) {
        f32x4 acc[2][2][4][2];
#pragma unroll
        for (int a = 0; a < 2; ++a)
#pragma unroll
            for (int b = 0; b < 2; ++b)
#pragma unroll
                for (int m = 0; m < 4; ++m)
#pragma unroll
                    for (int n = 0; n < 2; ++n) acc[a][b][m][n] = (f32x4){0.f, 0.f, 0.f, 0.f};
        long arow[4];
#pragma unroll
        for (int i = 0; i < 4; ++i) { const int row = (tid + 512 * i) >> 3; arow[i] = u.gidx ? (row < u.valid ? (long)u.gidx[row] : 0L) : (long)row; }
        for (int k0 = 0; k0 < g.K; k0 += 64) {
            __syncthreads();
#pragma unroll
            for (int i = 0; i < 4; ++i) { const int ch = tid + 512 * i, row = ch >> 3, c8 = ch & 7;
                const u32x4 va = *(const u32x4*)(g.A + u.a_off + arow[i] * g.lda + k0 + c8 * 8);
                const u32x4 vb = *(const u32x4*)(g.Bt + u.b_off + (long)row * g.ldb + k0 + c8 * 8);
                *(u32x4*)(As + row * 72 + c8 * 8) = va; *(u32x4*)(Bs + row * 72 + c8 * 8) = vb; }
            __syncthreads();
            for (int kk = 0; kk < 64; ++kk) {
                float a[2][4];
#pragma unroll
                for (int ai = 0; ai < 2; ++ai)
#pragma unroll
                    for (int m = 0; m < 4; ++m) a[ai][m] = bf2f(As[(ai * 128 + wr * 64 + m * 16 + fr) * 72 + kk]);
#pragma unroll
                for (int bj = 0; bj < 2; ++bj)
#pragma unroll
                    for (int n = 0; n < 2; ++n)
#pragma unroll
                        for (int e = 0; e < 4; ++e) {
                            const int cl = Epi::PERM ? (bj * 128 + wc * 32 + 8 * fq + 4 * n + e) : (bj * 128 + wc * 32 + 16 * n + 4 * fq + e);
                            const float b = bf2f(Bs[cl * 72 + kk]);
#pragma unroll
                            for (int ai = 0; ai < 2; ++ai)
#pragma unroll
                                for (int m = 0; m < 4; ++m) acc[ai][bj][m][n][e] += a[ai][m] * b;
                        }
            }
        }
        E(acc, u, wr, wc, fr, fq);
    }
    __syncthreads();
}


#define LAS __attribute__((address_space(3)))
namespace pg8 {
constexpr int BK = 64, HALF = 128, HTB = HALF * BK * 2, STAGE_BYTES = 8 * HTB;
__device__ __forceinline__ int lds_byte(int r, int c) { const int st = (r >> 4) * 2 + (c >> 5), rr = r & 15, cc = c & 31, ob = rr * 64 + cc * 2; return st * 1024 + (ob ^ (((ob >> 9) & 1) << 5)); }
__device__ __forceinline__ void stage_rc(int b, int& R, int& C) { const int st = b / 1024, sb = b % 1024, swz = sb ^ (((sb >> 9) & 1) << 5); R = (st >> 1) * 16 + swz / 64; C = (st & 1) * 32 + (swz % 64) / 2; }
__device__ __forceinline__ int perm32(int rho) { const int n = rho >> 4, i = rho & 15; return 8 * (i >> 2) + 4 * n + (i & 3); }
template <bool GATHER>
__device__ __forceinline__ void unit_voffA(const Unit& u, int lda, int tid, unsigned (&v0)[2], unsigned (&v1)[2]) {
#pragma unroll
    for (int i = 0; i < 2; ++i) { int R, C; stage_rc(tid * 16 + i * 8192, R, C); int r0 = R, r1 = R + HALF;
        if (GATHER) { const int a = (r0 < u.valid) ? u.gidx[r0] : 0, b = (r1 < u.valid) ? u.gidx[r1] : 0; r0 = a; r1 = b; }
        v0[i] = (unsigned)(r0 * lda + C) * 2u; v1[i] = (unsigned)(r1 * lda + C) * 2u; }
}
template <class Epi, class Sched, bool ALIGN_EPI = true>
__device__ __forceinline__ void gemm_phase(LAS unsigned char* lds, const Gemm g, const Sched& S, const Epi& E) {
    const int tid = threadIdx.x, wid = __builtin_amdgcn_readfirstlane(tid >> 6), lane = tid & 63, wr = wid >> 2, wc = wid & 3, fr = lane & 15, fq = lane >> 4;
    const int K = g.K, nt = K / BK;
    constexpr bool GATHER = Sched::GATHER;
    unsigned voffB[2];
#pragma unroll
    for (int i = 0; i < 2; ++i) { int R, C; stage_rc(tid * 16 + i * 8192, R, C); const int Rb = Epi::PERM ? ((R & ~31) + perm32(R & 31)) : R; voffB[i] = (unsigned)(Rb * g.ldb + C) * 2u; }
    const size_t hstepA = (size_t)HALF * g.lda * 2;
    const size_t kstep = (size_t)(BK * 2);
    const size_t hstepB = (size_t)HALF * g.ldb * 2;
    const unsigned ldsw = (unsigned)wid * 1024u;
    const int aoff = lds_byte(wr * 64 + fr, fq * 8), boff = lds_byte(wc * 32 + fr, fq * 8);
#define PG8_SA(b, h) (((b) * 2 + (h)) * HTB)
#define PG8_SB(b, h) ((4 + (b) * 2 + (h)) * HTB)
#define PG8_STAGE(bufoff, gbase, voff) do { _Pragma("unroll") for (int _i = 0; _i < 2; ++_i) \
        __builtin_amdgcn_global_load_lds((const unsigned*)((const char*)(gbase) + (voff)[_i]), (LAS unsigned*)(lds + (bufoff) + ldsw + _i * 8192), 16, 0, 0); } while (0)
#define PG8_LDA(dst, b, h) do { _Pragma("unroll") for (int m = 0; m < 4; ++m) _Pragma("unroll") for (int k = 0; k < 2; ++k) dst[m][k] = *(const LAS bf16x8*)(lds + PG8_SA(b, h) + aoff + m * 2048 + k * 1024); } while (0)
#define PG8_LDB(dst, b, h) do { _Pragma("unroll") for (int n = 0; n < 2; ++n) _Pragma("unroll") for (int k = 0; k < 2; ++k) dst[n][k] = *(const LAS bf16x8*)(lds + PG8_SB(b, h) + boff + n * 2048 + k * 1024); } while (0)
#define PG8_MMA(ai, bj, At, Bt) do { __builtin_amdgcn_s_setprio(1); _Pragma("unroll") for (int m = 0; m < 4; ++m) _Pragma("unroll") for (int n = 0; n < 2; ++n) _Pragma("unroll") for (int k = 0; k < 2; ++k) \
        acc[ai][bj][m][n] = __builtin_amdgcn_mfma_f32_16x16x32_bf16(Bt[n][k], At[m][k], acc[ai][bj][m][n], 0, 0, 0); __builtin_amdgcn_s_setprio(0); } while (0)
#define PG8_WAIT_V(n) asm volatile("s_waitcnt vmcnt(" #n ")" ::: "memory")
#define PG8_WAIT_L(n) asm volatile("s_waitcnt lgkmcnt(" #n ")" ::: "memory")
#define PG8_BAR __builtin_amdgcn_s_barrier()
#define PG8_SCHED __builtin_amdgcn_sched_barrier(0)
    Unit cur, nxt; int ui = 0;
    if (!S.next(0, cur)) return;
    f32x4 acc[2][2][4][2];
#pragma unroll
    for (int a = 0; a < 2; ++a)
#pragma unroll
        for (int b = 0; b < 2; ++b)
#pragma unroll
            for (int m = 0; m < 4; ++m)
#pragma unroll
                for (int n = 0; n < 2; ++n) acc[a][b][m][n] = (f32x4){0.f, 0.f, 0.f, 0.f};
    bf16x8 At[4][2], B0[2][2], B1[2][2];
    const char* cA = (const char*)(g.A + cur.a_off); const char* cB = (const char*)(g.Bt + cur.b_off);
    unsigned vA0[2], vA1[2], nA0[2], nA1[2];
    unit_voffA<GATHER>(cur, g.lda, tid, vA0, vA1);
#define PG8_STAGE_A(bufoff, gbase, h, sel) do { if constexpr (GATHER) { if (sel) { if ((h) == 0) PG8_STAGE(bufoff, gbase, nA0); else PG8_STAGE(bufoff, gbase, nA1); } else { if ((h) == 0) PG8_STAGE(bufoff, gbase, vA0); else PG8_STAGE(bufoff, gbase, vA1); } } \
        else { PG8_STAGE(bufoff, (gbase) + ((h) ? hstepA : (size_t)0), vA0); } } while (0)
    PG8_STAGE(PG8_SB(0, 0), cB, voffB); PG8_STAGE(PG8_SB(0, 1), cB + hstepB, voffB); PG8_STAGE_A(PG8_SA(0, 0), cA, 0, false); PG8_STAGE_A(PG8_SA(0, 1), cA, 1, false);
    if (wr == 1) PG8_BAR;
    PG8_WAIT_V(2); PG8_BAR;
    PG8_STAGE(PG8_SB(1, 0), cB + kstep, voffB); PG8_STAGE_A(PG8_SA(1, 0), cA + kstep, 0, false); PG8_STAGE(PG8_SB(1, 1), cB + hstepB + kstep, voffB);
    PG8_WAIT_V(6); PG8_BAR;
    for (;;) {
        const bool has_next = S.next(ui + 1, nxt);
        const char* nA = has_next ? (const char*)(g.A + nxt.a_off) : cA; const char* nB = has_next ? (const char*)(g.Bt + nxt.b_off) : cB;
        if constexpr (GATHER) { if (has_next) unit_voffA<true>(nxt, g.lda, tid, nA0, nA1); else { nA0[0] = vA0[0]; nA0[1] = vA0[1]; nA1[0] = vA1[0]; nA1[1] = vA1[1]; } }
        for (int t = 0; t < nt; t += 2) {
            const bool last = (t == nt - 2);
            const char* a1 = cA + (size_t)(t + 1) * kstep;
            const char* a2 = last ? nA : cA + (size_t)(t + 2) * kstep; const char* b2 = last ? nB : cB + (size_t)(t + 2) * kstep;
            const char* a3 = a2 + kstep; const char* b3 = b2 + kstep;
            PG8_LDB(B0, 0, 0); PG8_LDB(B1, 0, 1); PG8_SCHED; PG8_LDA(At, 0, 0); PG8_STAGE_A(PG8_SA(1, 1), a1, 1, false);
            PG8_WAIT_V(8); PG8_WAIT_L(0); PG8_BAR; PG8_MMA(0, 0, At, B0); PG8_MMA(0, 1, At, B1); PG8_BAR; PG8_SCHED;
            PG8_LDA(At, 0, 1); PG8_STAGE(PG8_SB(0, 0), b2, voffB); PG8_STAGE(PG8_SB(0, 1), b2 + hstepB, voffB); PG8_STAGE_A(PG8_SA(0, 0), a2, 0, last);
            PG8_WAIT_V(8); PG8_WAIT_L(0); PG8_BAR; PG8_MMA(1, 0, At, B0); PG8_MMA(1, 1, At, B1); PG8_BAR; PG8_SCHED;
            PG8_LDB(B0, 1, 0); PG8_LDB(B1, 1, 1); PG8_SCHED; PG8_LDA(At, 1, 0); PG8_STAGE_A(PG8_SA(0, 1), a2, 1, last);
            PG8_WAIT_V(8); PG8_WAIT_L(0); PG8_BAR; PG8_MMA(0, 0, At, B0); PG8_MMA(0, 1, At, B1); PG8_BAR; PG8_SCHED;
            PG8_LDA(At, 1, 1); PG8_STAGE(PG8_SB(1, 0), b3, voffB); PG8_STAGE(PG8_SB(1, 1), b3 + hstepB, voffB); PG8_STAGE_A(PG8_SA(1, 0), a3, 0, last);
            PG8_WAIT_V(8); PG8_WAIT_L(0); PG8_BAR; PG8_MMA(1, 0, At, B0); PG8_MMA(1, 1, At, B1); PG8_BAR; PG8_SCHED;
        }
        if constexpr (ALIGN_EPI) { if (wr == 0) PG8_BAR; }
        E(acc, cur, wr, wc, fr, fq);
        if (!has_next) break;
#pragma unroll
        for (int a = 0; a < 2; ++a)
#pragma unroll
            for (int b = 0; b < 2; ++b)
#pragma unroll
                for (int m = 0; m < 4; ++m)
#pragma unroll
                    for (int n = 0; n < 2; ++n) acc[a][b][m][n] = (f32x4){0.f, 0.f, 0.f, 0.f};
        cur = nxt; cA = nA; cB = nB; ++ui;
        if constexpr (GATHER) { vA0[0] = nA0[0]; vA0[1] = nA0[1]; vA1[0] = nA1[0]; vA1[1] = nA1[1]; }
        if constexpr (ALIGN_EPI) { if (wr == 1) PG8_BAR; }
    }
    PG8_WAIT_V(0);
    if constexpr (!ALIGN_EPI) { if (wr == 0) PG8_BAR; }
    PG8_BAR;
#undef PG8_SA
#undef PG8_SB
#undef PG8_STAGE
#undef PG8_STAGE_A
#undef PG8_LDA
#undef PG8_LDB
#undef PG8_MMA
#undef PG8_WAIT_V
#undef PG8_WAIT_L
#undef PG8_BAR
#undef PG8_SCHED
}
}
template <class Epi, class Sched>
__device__ __forceinline__ void gemm_phase_mfma(unsigned char* lds, const Gemm g, const Sched& S, const Epi& E) { pg8::gemm_phase<Epi, Sched, true>((LAS unsigned char*)lds, g, S, E); __syncthreads(); }

__device__ __forceinline__ u32x4 pack8(const f32x4 v0, const f32x4 v1) { u32x4 w; w.x = pk2(v0[0], v0[1]); w.y = pk2(v0[2], v0[3]); w.z = pk2(v1[0], v1[1]); w.w = pk2(v1[2], v1[3]); return w; }

struct EpiIn {
    static constexpr bool PERM = true;
    bf16_t* inbuf; bf16_t* pbuf; const float* rstd1; unsigned* nrm;
    __device__ __forceinline__ void operator()(const f32x4 (&acc)[2][2][4][2], const Unit& u, int wr, int wc, int fr_, int fq_) const {
        int fr = fr_, fq = fq_; asm volatile("" : "+v"(fr), "+v"(fq));
        bf16_t* base; int ldc, colt; float sc0 = 1.f;
        if (u.pn < 24) { base = inbuf + (size_t)(u.pn >> 2) * T * 1024; ldc = 1024; colt = (u.pn & 3) * 256; if (u.pn < 4) sc0 = C2Q; }
        else { base = pbuf; ldc = PW; colt = (u.pn - 24) * 256; }
        const int row0 = u.pm * 256 + wr * 64 + fr, col0 = colt + wc * 32 + 8 * fq;
        float rs[2][4];
#pragma unroll
        for (int ai = 0; ai < 2; ++ai)
#pragma unroll
            for (int m = 0; m < 4; ++m) rs[ai][m] = rstd1[row0 + ai * 128 + m * 16];
#pragma unroll
        for (int ai = 0; ai < 2; ++ai)
#pragma unroll
            for (int m = 0; m < 4; ++m) { const int row = row0 + ai * 128 + m * 16; const float r = rs[ai][m] * sc0; bf16_t* rowp = base + (size_t)row * ldc + col0;
#pragma unroll
                for (int bj = 0; bj < 2; ++bj) *(u32x4*)(rowp + bj * 128) = pack8(acc[ai][bj][m][0] * r, acc[ai][bj][m][1] * r); }
        if (u.pn < 8) {
            float mx[2] = {0.f, 0.f};
#pragma unroll
            for (int ai = 0; ai < 2; ++ai)
#pragma unroll
                for (int m = 0; m < 4; ++m) { const float r = rs[ai][m] * sc0;
#pragma unroll
                    for (int bj = 0; bj < 2; ++bj) { const f32x4 v0 = acc[ai][bj][m][0] * r, v1 = acc[ai][bj][m][1] * r;
                        float ssq = (v0[0] * v0[0] + v0[1] * v0[1]) + (v0[2] * v0[2] + v0[3] * v0[3]) + (v1[0] * v1[0] + v1[1] * v1[1]) + (v1[2] * v1[2] + v1[3] * v1[3]);
                        ssq += __shfl_xor(ssq, 16); ssq += __shfl_xor(ssq, 32); mx[bj] = fmaxf(mx[bj], ssq); } }
#pragma unroll
            for (int bj = 0; bj < 2; ++bj) { float v = mx[bj]; v = fmaxf(v, __shfl_xor(v, 1)); v = fmaxf(v, __shfl_xor(v, 2)); v = fmaxf(v, __shfl_xor(v, 4)); v = fmaxf(v, __shfl_xor(v, 8));
                if (fr == 0 && fq == 0) { const int bb = u.pm >> 3, hh = (u.pn & 3) * 2 + bj, cc = wc >> 1; atomicMax(nrm + (u.pn >= 4 ? 512 : 0) + ((bb * 8 + hh) * 2 + cc) * 2 + (wc & 1), __float_as_uint(v)); } }
        }
    }
};
struct EpiL2 {
    static constexpr bool PERM = true;
    float* wl; bf16_t* abuf; bf16_t* gbuf; const float* w0; const float* a0;
    __device__ __forceinline__ void operator()(const f32x4 (&acc)[2][2][4][2], const Unit& u, int wr, int wc, int fr_, int fq_) const {
        int fr = fr_, fq = fq_; asm volatile("" : "+v"(fr), "+v"(fq));
        const int grp = u.pn >> 2, colt = (u.pn & 3) * 256;
        const int row0 = u.pm * 256 + wr * 64 + fr, col0 = colt + wc * 32 + 8 * fq;
        if (grp == 0) {
#pragma unroll
            for (int bj = 0; bj < 2; ++bj) { const int c = col0 + bj * 128; const f32x4 b0 = *(const f32x4*)(w0 + c), b1 = *(const f32x4*)(w0 + c + 4);
#pragma unroll
                for (int ai = 0; ai < 2; ++ai)
#pragma unroll
                    for (int m = 0; m < 4; ++m) { const int row = row0 + ai * 128 + m * 16; f32x4 v0 = acc[ai][bj][m][0] + b0, v1 = acc[ai][bj][m][1] + b1;
#pragma unroll
                        for (int e = 0; e < 4; ++e) { v0[e] = -0.60653065971f * LOG2E * sigmoidf_(v0[e]); v1[e] = -0.60653065971f * LOG2E * sigmoidf_(v1[e]); }
                        float* p = wl + (size_t)row * 1024 + c; *(f32x4*)p = v0; *(f32x4*)(p + 4) = v1; asm volatile("" ::: "memory"); __builtin_amdgcn_sched_barrier(0); } }
        } else if (grp == 1) {
#pragma unroll
            for (int bj = 0; bj < 2; ++bj) { const int c = col0 + bj * 128; const f32x4 b0 = *(const f32x4*)(a0 + c), b1 = *(const f32x4*)(a0 + c + 4);
#pragma unroll
                for (int ai = 0; ai < 2; ++ai)
#pragma unroll
                    for (int m = 0; m < 4; ++m) { const int row = row0 + ai * 128 + m * 16; f32x4 v0 = acc[ai][bj][m][0] + b0, v1 = acc[ai][bj][m][1] + b1;
#pragma unroll
                        for (int e = 0; e < 4; ++e) { v0[e] = sigmoidf_(v0[e]); v1[e] = sigmoidf_(v1[e]); }
                        *(u32x4*)(abuf + (size_t)row * 1024 + c) = pack8(v0, v1); asm volatile("" ::: "memory"); __builtin_amdgcn_sched_barrier(0); } }
        } else {
#pragma unroll
            for (int bj = 0; bj < 2; ++bj) { const int c = col0 + bj * 128;
#pragma unroll
                for (int ai = 0; ai < 2; ++ai)
#pragma unroll
                    for (int m = 0; m < 4; ++m) { const int row = row0 + ai * 128 + m * 16; *(u32x4*)(gbuf + (size_t)row * 1024 + c) = pack8(acc[ai][bj][m][0], acc[ai][bj][m][1]); } }
        }
    }
};
struct EpiOut {
    static constexpr bool PERM = true;
    const float* x; float* h; bf16_t* hb; float* ss2;
    __device__ __forceinline__ void operator()(const f32x4 (&acc)[2][2][4][2], const Unit& u, int wr, int wc, int fr_, int fq_) const {
        int fr = fr_, fq = fq_; asm volatile("" : "+v"(fr), "+v"(fq));
        const int row0 = u.pm * 256 + wr * 64 + fr, col0 = u.pn * 256 + wc * 32 + 8 * fq;
#pragma unroll
        for (int ai = 0; ai < 2; ++ai) {
            f32x4 xv[4][2][2];
#pragma unroll
            for (int m = 0; m < 4; ++m)
#pragma unroll
                for (int bj = 0; bj < 2; ++bj) { const size_t off = (size_t)(row0 + ai * 128 + m * 16) * DM + col0 + bj * 128; xv[m][bj][0] = *(const f32x4*)(x + off); xv[m][bj][1] = *(const f32x4*)(x + off + 4); }
#pragma unroll
            for (int m = 0; m < 4; ++m) { const int row = row0 + ai * 128 + m * 16; float ss = 0.f;
#pragma unroll
                for (int bj = 0; bj < 2; ++bj) { const size_t off = (size_t)row * DM + col0 + bj * 128;
                    const f32x4 v0 = acc[ai][bj][m][0] + xv[m][bj][0], v1 = acc[ai][bj][m][1] + xv[m][bj][1];
                    *(u32x4*)(hb + off) = pack8(v0, v1);
                    ss += (v0[0] * v0[0] + v0[1] * v0[1]) + (v0[2] * v0[2] + v0[3] * v0[3]) + (v1[0] * v1[0] + v1[1] * v1[1]) + (v1[2] * v1[2] + v1[3] * v1[3]); }
                ss += __shfl_xor(ss, 16); ss += __shfl_xor(ss, 32);
                if (fq == 0) atomicAdd(ss2 + row, ss); }
        }
    }
};
struct EpiGU {
    static constexpr bool PERM = true;
    bf16_t* hid; const float* rstd2;
    __device__ __forceinline__ void operator()(const f32x4 (&acc)[2][2][4][2], const Unit& u, int wr, int wc, int fr_, int fq_) const {
        int fr = fr_, fq = fq_; asm volatile("" : "+v"(fr), "+v"(fq));
        const int col0 = u.pn * 128 + wc * 32 + 8 * fq;
        int tok[2][4]; float rsv[2][4];
#pragma unroll
        for (int ai = 0; ai < 2; ++ai)
#pragma unroll
            for (int m = 0; m < 4; ++m) { const int rl = ai * 128 + wr * 64 + m * 16 + fr; tok[ai][m] = (rl < u.valid) ? u.gidx[rl] : 0; }
#pragma unroll
        for (int ai = 0; ai < 2; ++ai)
#pragma unroll
            for (int m = 0; m < 4; ++m) rsv[ai][m] = rstd2[tok[ai][m]];
#pragma unroll
        for (int ai = 0; ai < 2; ++ai)
#pragma unroll
            for (int m = 0; m < 4; ++m) { const int rl = ai * 128 + wr * 64 + m * 16 + fr; const float rs = rsv[ai][m];
                f32x4 o0, o1;
#pragma unroll
                for (int e = 0; e < 4; ++e) { const float g0 = acc[ai][0][m][0][e] * rs, u0 = acc[ai][1][m][0][e] * rs, g1 = acc[ai][0][m][1][e] * rs, u1 = acc[ai][1][m][1][e] * rs;
                    o0[e] = g0 * sigmoidf_(g0) * u0; o1[e] = g1 * sigmoidf_(g1) * u1; }
                *(u32x4*)(hid + ((size_t)u.tile * 256 + rl) * DEXP + col0) = pack8(o0, o1); asm volatile("" ::: "memory"); __builtin_amdgcn_sched_barrier(0); }
    }
};
struct EpiDown {
    static constexpr bool PERM = true;
    bf16_t* yb; const float* gateb; const unsigned* cnt;
    __device__ __forceinline__ void operator()(const f32x4 (&acc)[2][2][4][2], const Unit& u, int wr, int wc, int fr_, int fq_) const {
        int fr = fr_, fq = fq_; asm volatile("" : "+v"(fr), "+v"(fq));
        const int col0 = u.pn * 256 + wc * 32 + 8 * fq;
        const int k = u.k;
        float gtv[2][4];
#pragma unroll
        for (int ai = 0; ai < 2; ++ai)
#pragma unroll
            for (int m = 0; m < 4; ++m) { const int rl = ai * 128 + wr * 64 + m * 16 + fr; gtv[ai][m] = (rl < u.valid) ? gateb[(size_t)u.e * CAP + 256 * k + rl] : 0.f; }
#pragma unroll
        for (int ai = 0; ai < 2; ++ai)
#pragma unroll
            for (int m = 0; m < 4; ++m) { const int rl = ai * 128 + wr * 64 + m * 16 + fr; const float gt = gtv[ai][m];
#pragma unroll
                for (int bj = 0; bj < 2; ++bj) *(u32x4*)(yb + ((size_t)u.tile * 256 + rl) * DM + col0 + bj * 128) = pack8(acc[ai][bj][m][0] * gt, acc[ai][bj][m][1] * gt); }
    }
};

__device__ __forceinline__ void tr_load64(f32x4 (&v)[16], const float* W, int ldw, int Kvalid, int Nvalid, int k0, int n0, int lane) {
    const int c4 = lane & 15, rq = lane >> 4; const bool ncol_ok = (n0 + 4 * c4) < Nvalid;
#pragma unroll
    for (int i = 0; i < 16; ++i) { const int k = k0 + 4 * i + rq; v[i] = (f32x4){0.f, 0.f, 0.f, 0.f};
        if (k < Kvalid && ncol_ok) v[i] = *(const f32x4*)(W + (size_t)k * ldw + n0 + 4 * c4); }
}
__device__ __forceinline__ void tr_store64(const f32x4 (&v)[16], int Kvalid, int Nvalid, int k0, int n0, bf16_t* WT, int ldt, int trow0, float* scr, int lane,
                                           const float* gk, const float* mu, int mode) {
    const int c4 = lane & 15, rq = lane >> 4;
#pragma unroll
    for (int i = 0; i < 16; ++i) { const int kk = 4 * i + rq, k = k0 + kk; float sc = 1.f;
        if (k < Kvalid) { if (gk) sc = gk[k]; if (mode == 1) sc *= (1.f - mu[k]); else if (mode == 2) sc *= mu[k]; }
        float* d = scr + kk * 65 + 4 * c4; d[0] = v[i][0] * sc; d[1] = v[i][1] * sc; d[2] = v[i][2] * sc; d[3] = v[i][3] * sc; }
    __builtin_amdgcn_s_waitcnt(0xC07F); asm volatile("" ::: "memory");
    const int c = lane & 7;
#pragma unroll
    for (int j = 0; j < 8; ++j) { const int n = (lane >> 3) + 8 * j; const float* q = scr + (8 * c) * 65 + n;
        u32x4 o; o.x = pk2(q[0 * 65], q[1 * 65]); o.y = pk2(q[2 * 65], q[3 * 65]); o.z = pk2(q[4 * 65], q[5 * 65]); o.w = pk2(q[6 * 65], q[7 * 65]);
        if (n0 + n < Nvalid) *(u32x4*)(WT + (size_t)(trow0 + n) * ldt + k0 + 8 * c) = o; }
    __builtin_amdgcn_s_waitcnt(0xC07F); asm volatile("" ::: "memory");
}
__device__ __forceinline__ void tr_item64(const float* W, int ldw, int Kvalid, int Nvalid, int k0, int n0, bf16_t* WT, int ldt, int trow0, float* scr, int lane,
                                          const float* gk, const float* mu, int mode) {
    f32x4 v[16];
    tr_load64(v, W, ldw, Kvalid, Nvalid, k0, n0, lane);
    tr_store64(v, Kvalid, Nvalid, k0, n0, WT, ldt, trow0, scr, lane, gk, mu, mode);
}

__device__ __forceinline__ void phase_prologue(const Params& p, unsigned char* lds) {
    const int tid = opaque_tid(), lane = tid & 63, wave = tid >> 6;
    const int gw = blockIdx.x * NWAVES + wave, NGW = gridDim.x * NWAVES;
    unsigned char* ws = p.ws;
    float* scr = (float*)(lds + wave * 16640);
    bf16_t* WinT = (bf16_t*)(ws + WS_WIN); bf16_t* WoutT = (bf16_t*)(ws + WS_WOUT); bf16_t* L2T = (bf16_t*)(ws + WS_L2T);
    const float* g_mix = p.in[1]; const float* mu_x = p.in[9];
    constexpr int I_WIN = 32 * 96;
    constexpr int I_L1 = 32 * (1 + 1 + 3) * 2;
    constexpr int I_WOUT = 32 * 32;
    constexpr int I_L2 = 3 * 4 * 16;
    constexpr int NITEMS = I_WIN + I_L1 + I_WOUT + I_L2;
    for (int it = gw; it < NITEMS; it += NGW) {
        int r = it;
        if (r < I_WIN) { const int kb = r / 96, nb = r % 96; tr_item64(p.in[2], 6144, 2048, 6144, 64 * kb, 64 * nb, WinT, 2048, 64 * nb, scr, lane, g_mix, nullptr, 0); continue; } r -= I_WIN;
        if (r < I_L1) {
            const int kb = r / 10, rr = r % 10;
            int which, nb, mode;
            if (rr < 2) { which = 0; nb = 0; mode = 1 + rr; } else if (rr < 4) { which = 1; nb = 0; mode = 1 + (rr - 2); } else { which = 2; nb = (rr - 4) >> 1; mode = 1 + ((rr - 4) & 1); }
            const float* W = which == 0 ? p.in[12] : which == 1 ? p.in[15] : p.in[17];
            const int ldw = which == 2 ? 160 : 64;
            const int rowbase = 6144 + (which == 0 ? 0 : which == 1 ? 128 : 256) + (mode == 2 ? ldw : 0);
            tr_item64(W, ldw, 2048, ldw, 64 * kb, 64 * nb, WinT, 2048, rowbase + 64 * nb, scr, lane, g_mix, mu_x + which * 2048, mode); continue; } r -= I_L1;
        if (r < I_WOUT) { const int kb = r / 32, nb = r % 32; tr_item64(p.in[3], 2048, 2048, 2048, 64 * kb, 64 * nb, WoutT, 2048, 64 * nb, scr, lane, nullptr, nullptr, 0); continue; } r -= I_WOUT;
        { const int which = r / 64, rr = r % 64, kb = rr / 16, nb = rr % 16;
          const float* W = which == 0 ? p.in[13] : which == 1 ? p.in[16] : p.in[18]; const int kv = which == 2 ? 160 : 64;
          tr_item64(W, 1024, kv, 1024, 64 * kb, 64 * nb, L2T, 256, which * 1024 + 64 * nb, scr, lane, nullptr, nullptr, 0); }
    }
    for (int ch = blockIdx.x * NTHREADS + tid; ch < 192 * 256; ch += gridDim.x * NTHREADS) *(u32x4*)(WinT + (size_t)6720 * 2048 + (size_t)ch * 8) = (u32x4){0u, 0u, 0u, 0u};
    { bf16_t* whi = (bf16_t*)(ws + WS_WRT); bf16_t* wlo = whi + 48 * 2048; const float* gf = p.in[24]; const float* wg = p.in[25]; const float* we = p.in[27];
      for (int id = blockIdx.x * NTHREADS + tid; id < 48 * 2048; id += gridDim.x * NTHREADS) { const int cc = id >> 11, k = id & 2047; float w = 0.f;
          if (cc < 4) w = wg[(size_t)k * 4 + cc] * gf[k]; else if (cc < 36) w = we[(size_t)k * 32 + cc - 4] * gf[k];
          const unsigned hb = f2bf(w); const float hf = bf2f(hb); whi[id] = (bf16_t)hb; wlo[id] = (bf16_t)f2bf(w - hf); } }
    const float* x = p.in[0]; bf16_t* xb = (bf16_t*)(ws + WS_XB); float* rstd1 = (float*)(ws + WS_RSTD1);
    for (int m0 = gw; m0 < T; m0 += 2 * NGW) {
        f32x4 v[2][8];
#pragma unroll
        for (int u = 0; u < 2; ++u) { const int m = m0 + u * NGW; if (m < T) { const f32x4* xr = (const f32x4*)(x + (size_t)m * DM) + lane;
#pragma unroll
            for (int j = 0; j < 8; ++j) v[u][j] = xr[64 * j]; } }
#pragma unroll
        for (int u = 0; u < 2; ++u) { const int m = m0 + u * NGW; if (m < T) { float sq = 0.f;
#pragma unroll
            for (int j = 0; j < 8; ++j) sq += (v[u][j][0] * v[u][j][0] + v[u][j][1] * v[u][j][1]) + (v[u][j][2] * v[u][j][2] + v[u][j][3] * v[u][j][3]);
            sq = wave_sum(sq);
            u32x2* o = (u32x2*)(xb + (size_t)m * DM) + lane;
#pragma unroll
            for (int j = 0; j < 8; ++j) { u32x2 w; w.x = pk2(v[u][j][0], v[u][j][1]); w.y = pk2(v[u][j][2], v[u][j][3]); o[64 * j] = w; }
            if (lane == 0) rstd1[m] = 1.0f / sqrtf(sq * (1.0f / DM) + 1e-6f); } }
    }
}

__device__ __forceinline__ void convert_gu_queue(const Params& p, unsigned char* lds, unsigned* qctr, int e_lo, int e_hi) {
    const int tid = opaque_tid(), lane = tid & 63, wave = tid >> 6;
    float* scr = (float*)(lds + wave * 16640);
    volatile int* slot = (volatile int*)(lds + LDS_BYTES - 64);
    const float* gf = p.in[24];
    const int nitems = (e_hi - e_lo) * 512;
    for (;;) {
        __syncthreads();
        if (tid == 0) *slot = (int)atomicAdd(qctr, 8u);
        __syncthreads();
        const int r0 = __builtin_amdgcn_readfirstlane(*slot);
        if (r0 >= nitems) break;
        const int r = r0 + wave; const int e = e_lo + r / 512, rr = r % 512, up = rr >> 8, kb = (rr & 255) >> 3, n0 = 64 * (rr & 7);
        tr_item64((up ? p.in[30] : p.in[29]) + (size_t)e * 2048 * 512, 512, 2048, 512, 64 * kb, n0, (bf16_t*)(p.ws + wgu_byte_off(e)), 2048, 256 * (n0 >> 7) + (n0 & 127) + (up ? 128 : 0), scr, lane, gf, nullptr, 0);
    }
}
__device__ __forceinline__ void convert_down_queue(const Params& p, unsigned char* lds, unsigned* qctr) {
    const int tid = opaque_tid(), lane = tid & 63, wave = tid >> 6;
    float* scr = (float*)(lds + wave * 16640);
    volatile int* slot = (volatile int*)(lds + LDS_BYTES - 64);
    for (;;) {
        __syncthreads();
        if (tid == 0) *slot = (int)atomicAdd(qctr, 8u);
        __syncthreads();
        const int r = __builtin_amdgcn_readfirstlane(*slot) + wave;
        if (r - wave >= 32 * 256) break;
        const int e = r / 256, rr = r % 256, kb = rr / 32, nb = rr % 32;
        tr_item64(p.in[31] + (size_t)e * 512 * 2048, 2048, 512, 2048, 64 * kb, 64 * nb, (bf16_t*)(p.ws + wd_byte_off(e)), 512, 64 * nb, scr, lane, nullptr, nullptr, 0);
    }
}

__device__ __forceinline__ void phase_l2prep(const Params& p) {
    const bf16_t* P = (const bf16_t*)(p.ws + WS_PBUF); bf16_t* A2 = (bf16_t*)(p.ws + WS_A2);
    const int nchunk = T * 96;
    const int tid = opaque_tid();
    const int stride = gridDim.x * NTHREADS;
    for (int id0 = blockIdx.x * NTHREADS + tid; id0 < nchunk; id0 += 4 * stride) {
        u32x4 va[4], vb[4];
#pragma unroll
        for (int u = 0; u < 4; ++u) { const int id = id0 + u * stride; va[u] = (u32x4){0u, 0u, 0u, 0u}; vb[u] = va[u];
            if (id < nchunk) { const int t = id / 96, ch = id % 96, gi = ch >> 5, jc = (ch & 31) * 8; const int width = gi == 2 ? 160 : 64, pa = gi == 0 ? 0 : gi == 1 ? 128 : 256, pb = pa + width;
                if (jc < width) { va[u] = *(const u32x4*)(P + (size_t)t * PW + pa + jc); if ((t & (SEQ - 1)) != 0) vb[u] = *(const u32x4*)(P + (size_t)(t - 1) * PW + pb + jc); } } }
#pragma unroll
        for (int u = 0; u < 4; ++u) { const int id = id0 + u * stride;
            if (id < nchunk) { const int t = id / 96, ch = id % 96, gi = ch >> 5, jc = (ch & 31) * 8; const int width = gi == 2 ? 160 : 64;
                u32x4 o = (u32x4){0u, 0u, 0u, 0u};
                if (jc < width) { float f[8];
#pragma unroll
                    for (int i = 0; i < 4; ++i) { f[2 * i] = bflo(va[u][i]) + bflo(vb[u][i]); f[2 * i + 1] = bfhi(va[u][i]) + bfhi(vb[u][i]); }
#pragma unroll
                    for (int i = 0; i < 8; ++i) { if (gi == 0) f[i] = 1.0f - 2.0f * __builtin_amdgcn_rcpf(__builtin_amdgcn_exp2f(2.0f * 1.4426950408889634f * f[i]) + 1.0f); else if (gi == 2) f[i] = sigmoidf_(f[i]); }
                    o.x = pk2(f[0], f[1]); o.y = pk2(f[2], f[3]); o.z = pk2(f[4], f[5]); o.w = pk2(f[6], f[7]); }
                *(u32x4*)(A2 + (size_t)t * PW + ch * 8) = o; } }
    }
}

constexpr int TC = 16;
constexpr int CV_UT = 0, CV_ZT = 2048, CV_BT = 4096, CV_KT = 6144, CV_BKH = 8192, CV_VT = 12288, CV_GC = 14336, CV_BYTES = 14848;
constexpr int CM_TT = 0, CM_BB = 1024, CM_AB = 2048, CM_BYTES = 3072;
constexpr int CL_VEC = 0, CL_MAT = 3 * CV_BYTES, CL_YS = CL_MAT + 2 * CM_BYTES, CL_GB = CL_YS + 2 * 4096  , CL_SCR = CL_GB + 4 * 8192, CL_SCR_W = 2304, CL_END = CL_SCR + 8 * CL_SCR_W;
#define DPP_F(v, ctrl) __builtin_bit_cast(float, __builtin_amdgcn_update_dpp(0, __builtin_bit_cast(int, (v)), (ctrl), 0xF, 0xF, true))
__device__ __forceinline__ float red8(float v) {
    v += DPP_F(v, 0xB1);
    v += DPP_F(v, 0x4E);
    v += DPP_F(v, 0x141);
    return v;
}
__device__ __forceinline__ float wave_sum_fast(float v) {
    v = red8(v);
    v += DPP_F(v, 0x140);
    v += __builtin_bit_cast(float, __builtin_amdgcn_update_dpp(0, __builtin_bit_cast(int, v), 0x142, 0xa, 0xf, false));
    v += __builtin_bit_cast(float, __builtin_amdgcn_update_dpp(0, __builtin_bit_cast(int, v), 0x143, 0xc, 0xf, false));
    return __builtin_bit_cast(float, __builtin_amdgcn_readlane(__builtin_bit_cast(int, v), 63));
}
__device__ __forceinline__ bf16x8 op4(const f32x4 x) { u32x4 w; w.x = cvt_pk_bf16_(x[0], x[1]); w.y = cvt_pk_bf16_(x[2], x[3]); w.z = 0u; w.w = 0u; return __builtin_bit_cast(bf16x8, w); }
#define MFMA16(a, b, c) __builtin_amdgcn_mfma_f32_16x16x32_bf16((a), (b), (c), 0, 0, 0)
__device__ __forceinline__ void rwkv_chain(const Params& p, unsigned char* lds, int chain) {
    const int tid = opaque_tid(), lane = tid & 63, wave = __builtin_amdgcn_readfirstlane(tid >> 6);
    const int b = chain >> 4, h = chain & 15;
    constexpr int NC = SEQ / TC;
    const int n = lane & 15, q = lane >> 4;
    const f32x4 zero4 = (f32x4){0.f, 0.f, 0.f, 0.f};
    const int c = h * 64 + lane;
    constexpr int SPW = 4;
    bf16_t* O = (bf16_t*)(p.ws + WS_O);
    float* SCR = (float*)(lds + CL_SCR + wave * CL_SCR_W);
#define SCAN_POST(ci_, pw_) do { const float* Ys_ = (const float*)(lds + CL_YS + ((ci_) & 1) * 4096); const float* GB_ = (const float*)(lds + CL_GB + ((ci_) & 3) * 8192); \
        float y_[SPW]; \
        _Pragma("unroll") for (int s_ = 0; s_ < SPW; ++s_) { y_[s_] = Ys_[((pw_) * SPW + s_) * 64 + lane]; SCR[(2 * s_) * 68 + lane] = y_[s_]; SCR[(2 * s_ + 1) * 68 + lane] = y_[s_] * y_[s_]; } \
        { const float* rp_ = SCR + (lane >> 3) * 68 + (lane & 7) * 8; const f32x4 p0_ = *(const f32x4*)(rp_), p1_ = *(const f32x4*)(rp_ + 4); const f32x4 ps_ = p0_ + p1_; \
          const float t_ = red8((ps_[0] + ps_[1]) + (ps_[2] + ps_[3])); if ((lane & 7) == 0) SCR[8 * 68 + 8 + (lane >> 3)] = t_; } \
        { const f32x4 t0_ = *(const f32x4*)(SCR + 8 * 68 + 8), t1_ = *(const f32x4*)(SCR + 8 * 68 + 12); const float st_[8] = {t0_[0], t0_[1], t0_[2], t0_[3], t1_[0], t1_[1], t1_[2], t1_[3]}; \
          _Pragma("unroll") for (int s_ = 0; s_ < SPW; ++s_) { const int tl_ = (pw_) * SPW + s_; const size_t m_ = (size_t)b * SEQ + (ci_) * TC + tl_; \
            const float mean_ = st_[2 * s_] * (1.0f / 64.0f); const float var_ = fmaxf(st_[2 * s_ + 1] * (1.0f / 64.0f) - mean_ * mean_, 0.f); \
            const float yn_ = (y_[s_] - mean_) * __builtin_amdgcn_rsqf(var_ + 64e-5f) * ln_w + ln_b; \
            O[m_ * DM + 1024 + c] = (bf16_t)f2bf(yn_ * GB_[tl_ * 64 + lane] + GB_[TC * 64 + tl_ * 64 + lane]); } } } while (0)
#define OPR(arr_, ks_) (*(const bf16x8*)(V0_ + (arr_) + n * 128 + (ks_) * 64 + q * 16))
#define SCAN_MATS(ci_) do { const unsigned char* V0_ = lds + CL_VEC + ((ci_) % 3) * CV_BYTES; unsigned char* M0_ = lds + CL_MAT + ((ci_) & 1) * CM_BYTES; \
        if (wave == 0) { \
            f32x4 pa_ = MFMA16(OPR(CV_BT, 0), OPR(CV_UT, 0), zero4); pa_ = MFMA16(OPR(CV_BT, 1), OPR(CV_UT, 1), pa_);        \
            f32x4 pt_ = MFMA16(OPR(CV_UT, 0), OPR(CV_BT, 0), zero4); pt_ = MFMA16(OPR(CV_UT, 1), OPR(CV_BT, 1), pt_);        \
            _Pragma("unroll") for (int r_ = 0; r_ < 4; ++r_) { if (!(4 * q + r_ < n)) pa_[r_] = 0.f; if (!(n < 4 * q + r_)) pt_[r_] = 0.f; } \
            f32x4 rr4_ = pa_;                                                                                                 \
            _Pragma("unroll") for (int k_ = 1; k_ < 4; ++k_) { \
                const f32x4 pn_ = MFMA16(op4(pt_), op4(pa_), zero4);                                                          \
                const f32x4 ptn_ = MFMA16(op4(pa_), op4(pt_), zero4);                                                         \
                rr4_ = MFMA16(op4(ptn_), op4(rr4_), rr4_ + pn_);                                                              \
                pa_ = pn_; pt_ = ptn_; } \
            _Pragma("unroll") for (int r_ = 0; r_ < 4; ++r_) if (4 * q + r_ == n) rr4_[r_] += 1.0f; \
            *(bf16x8*)(M0_ + CM_TT + lane * 16) = op4(rr4_); \
        } else if (wave == 1) { \
            f32x4 pb_ = MFMA16(OPR(CV_KT, 0), OPR(CV_UT, 0), zero4); pb_ = MFMA16(OPR(CV_KT, 1), OPR(CV_UT, 1), pb_);        \
            _Pragma("unroll") for (int r_ = 0; r_ < 4; ++r_) if (!(4 * q + r_ < n)) pb_[r_] = 0.f; \
            *(bf16x8*)(M0_ + CM_BB + lane * 16) = op4(pb_); \
        } else if (wave == 2) { \
            f32x4 qa_ = MFMA16(OPR(CV_BT, 0), OPR(CV_ZT, 0), zero4); qa_ = MFMA16(OPR(CV_BT, 1), OPR(CV_ZT, 1), qa_);        \
            f32x4 qb_ = MFMA16(OPR(CV_KT, 0), OPR(CV_ZT, 0), zero4); qb_ = MFMA16(OPR(CV_KT, 1), OPR(CV_ZT, 1), qb_);        \
            _Pragma("unroll") for (int r_ = 0; r_ < 4; ++r_) if (!(4 * q + r_ <= n)) { qa_[r_] = 0.f; qb_[r_] = 0.f; } \
            u32x4 w_; w_.x = cvt_pk_bf16_(qa_[0], qa_[1]); w_.y = cvt_pk_bf16_(qa_[2], qa_[3]); w_.z = cvt_pk_bf16_(qb_[0], qb_[1]); w_.w = cvt_pk_bf16_(qb_[2], qb_[3]); \
            *(u32x4*)(M0_ + CM_AB + lane * 16) = w_; \
        } } while (0)
    if (wave < 4) {
        const int row = 16 * wave + n;
        const float ln_w = p.in[22][c], ln_b = p.in[23][c];
        f32x4 Sd[4];
#pragma unroll
        for (int c4 = 0; c4 < 4; ++c4) Sd[c4] = zero4;
        __syncthreads();
        SCAN_MATS(0);
        __syncthreads();
        for (int ci = 0; ci < NC; ++ci) {
            if (ci >= 1) SCAN_POST(ci - 1, wave);
            const unsigned char* V0 = lds + CL_VEC + (ci % 3) * CV_BYTES; const unsigned char* M0 = lds + CL_MAT + (ci & 1) * CM_BYTES;
            float* Ys = (float*)(lds + CL_YS + (ci & 1) * 4096);
            const int ro = n * 128 + q * 16;
            u32x4 w0, w1;
            w0.x = cvt_pk_bf16_(Sd[0][0], Sd[0][1]); w0.y = cvt_pk_bf16_(Sd[0][2], Sd[0][3]); w0.z = cvt_pk_bf16_(Sd[1][0], Sd[1][1]); w0.w = cvt_pk_bf16_(Sd[1][2], Sd[1][3]);
            w1.x = cvt_pk_bf16_(Sd[2][0], Sd[2][1]); w1.y = cvt_pk_bf16_(Sd[2][2], Sd[2][3]); w1.z = cvt_pk_bf16_(Sd[3][0], Sd[3][1]); w1.w = cvt_pk_bf16_(Sd[3][2], Sd[3][3]);
            const bf16x8 sB0 = __builtin_bit_cast(bf16x8, w0), sB1 = __builtin_bit_cast(bf16x8, w1);
            const u32x2 vraw = *(const u32x2*)(V0 + CV_VT + row * 32 + q * 8);
            u32x4 vw; vw.x = vraw.x; vw.y = vraw.y; vw.z = 0u; vw.w = 0u; const bf16x8 vB = __builtin_bit_cast(bf16x8, vw);
            f32x4 g = MFMA16(*(const bf16x8*)(V0 + CV_UT + ro), sB0, zero4);
            g = MFMA16(*(const bf16x8*)(V0 + CV_UT + ro + 64), sB1, g);
            g = MFMA16(*(const bf16x8*)(M0 + CM_BB + lane * 16), vB, g);
            f32x4 y = MFMA16(*(const bf16x8*)(V0 + CV_ZT + ro), sB0, zero4);
            y = MFMA16(*(const bf16x8*)(V0 + CV_ZT + ro + 64), sB1, y);
            const f32x4 sa = MFMA16(*(const bf16x8*)(M0 + CM_TT + lane * 16), op4(g), zero4);
            u32x4 sw; sw.x = cvt_pk_bf16_(sa[0], sa[1]); sw.y = cvt_pk_bf16_(sa[2], sa[3]); sw.z = vraw.x; sw.w = vraw.y; const bf16x8 savB = __builtin_bit_cast(bf16x8, sw);
            y = MFMA16(*(const bf16x8*)(M0 + CM_AB + lane * 16), savB, y);
#pragma unroll
            for (int r = 0; r < 4; ++r) Ys[(4 * q + r) * 64 + row] = y[r];
#pragma unroll
            for (int c4 = 0; c4 < 4; ++c4) { const f32x4 gc = *(const f32x4*)(V0 + CV_GC + (16 * c4 + 4 * q) * 4);
                Sd[c4] = MFMA16(*(const bf16x8*)(V0 + CV_BKH + (16 * c4 + n) * 64 + q * 16), savB, Sd[c4] * gc); }
            if (ci + 1 < NC) SCAN_MATS(ci + 1);
            __syncthreads();
        }
        SCAN_POST(NC - 1, wave);
    } else {
        const int aw = wave - 4;
        const bf16_t* rb = (const bf16_t*)(p.ws + WS_INBUF) + (size_t)3 * T * 1024; const bf16_t* kb = rb + (size_t)T * 1024; const bf16_t* vb = kb + (size_t)T * 1024;
        const float* wl = (const float*)(p.ws + WS_WL); const bf16_t* ab = (const bf16_t*)(p.ws + WS_ABUF); const bf16_t* gb = (const bf16_t*)(p.ws + WS_GBUF);
        const float mu_r = p.in[10][c], mu_k = p.in[10][1024 + c], mu_v = p.in[10][2048 + c];
        const float k_k = p.in[19][c], k_a = p.in[20][c], r_k = p.in[21][c];
        const int cc = lane & 31; const int pos = (lane & 32) + 8 * ((cc >> 2) & 3) + (((cc >> 4) << 2) | (cc & 3));
        unsigned short rcA[SPW + 1], kcA[SPW + 1], vcA[SPW + 1], raA[SPW], rgA[SPW]; float rwlA[SPW], wlcA[16];
        unsigned short rcB[SPW + 1], kcB[SPW + 1], vcB[SPW + 1], raB[SPW], rgB[SPW]; float rwlB[SPW], wlcB[16];
#define SCAN_LOAD(ci_, X) do { const int tb_ = (ci_) * TC + aw * SPW; const size_t m0_ = (size_t)b * SEQ + tb_; \
        _Pragma("unroll") for (int s_ = 0; s_ < SPW + 1; ++s_) { const bool ok_ = (tb_ + s_ - 1) >= 0; const size_t off_ = (m0_ + s_ - 1) * 1024 + c; \
            rc##X[s_] = ok_ ? rb[off_] : (unsigned short)0; kc##X[s_] = ok_ ? kb[off_] : (unsigned short)0; vc##X[s_] = ok_ ? vb[off_] : (unsigned short)0; } \
        _Pragma("unroll") for (int s_ = 0; s_ < SPW; ++s_) { const size_t off_ = (m0_ + s_) * 1024 + c; rwl##X[s_] = wl[off_]; ra##X[s_] = ab[off_]; rg##X[s_] = gb[off_]; } \
        _Pragma("unroll") for (int i_ = 0; i_ < 16; ++i_) wlc##X[i_] = wl[((size_t)b * SEQ + (ci_) * TC + i_) * 1024 + c]; } while (0)
#define SCAN_PREP(ci_, X) do { unsigned char* V0_ = lds + CL_VEC + ((ci_) % 3) * CV_BYTES; float* GB_ = (float*)(lds + CL_GB + ((ci_) & 3) * 8192); \
        const float p4_ = (wlc##X[0] + wlc##X[1]) + (wlc##X[2] + wlc##X[3]), p8_ = p4_ + ((wlc##X[4] + wlc##X[5]) + (wlc##X[6] + wlc##X[7])); \
        const float p12_ = p8_ + ((wlc##X[8] + wlc##X[9]) + (wlc##X[10] + wlc##X[11])), ltot_ = p12_ + ((wlc##X[12] + wlc##X[13]) + (wlc##X[14] + wlc##X[15])); \
        float lcur_ = aw == 0 ? 0.f : aw == 1 ? p4_ : aw == 2 ? p8_ : p12_;        \
        float rr_[SPW], vv_[SPW], a_[SPW], kkv_[SPW], kmod_[SPW]; \
        _Pragma("unroll") for (int s_ = 0; s_ < SPW; ++s_) { \
            rr_[s_] = bf2f(rc##X[s_ + 1]) + (bf2f(rc##X[s_]) - bf2f(rc##X[s_ + 1])) * mu_r; const float kx_ = bf2f(kc##X[s_ + 1]) + (bf2f(kc##X[s_]) - bf2f(kc##X[s_ + 1])) * mu_k; vv_[s_] = bf2f(vc##X[s_ + 1]) + (bf2f(vc##X[s_]) - bf2f(vc##X[s_ + 1])) * mu_v; \
            a_[s_] = bf2f(ra##X[s_]); kkv_[s_] = kx_ * k_k; kmod_[s_] = kx_ * (1.0f + (a_[s_] - 1.0f) * k_a); \
            SCR[(2 * s_) * 68 + lane] = kkv_[s_] * kkv_[s_]; SCR[(2 * s_ + 1) * 68 + lane] = rr_[s_] * kmod_[s_] * r_k; } \
        { const float* rp_ = SCR + (lane >> 3) * 68 + (lane & 7) * 8; const f32x4 p0_ = *(const f32x4*)(rp_), p1_ = *(const f32x4*)(rp_ + 4); const f32x4 ps_ = p0_ + p1_; \
          const float t_ = red8((ps_[0] + ps_[1]) + (ps_[2] + ps_[3])); if ((lane & 7) == 0) SCR[8 * 68 + (lane >> 3)] = t_; } \
        { const f32x4 t0_ = *(const f32x4*)(SCR + 8 * 68), t1_ = *(const f32x4*)(SCR + 8 * 68 + 4); const float st_[8] = {t0_[0], t0_[1], t0_[2], t0_[3], t1_[0], t1_[1], t1_[2], t1_[3]}; \
          _Pragma("unroll") for (int s_ = 0; s_ < SPW; ++s_) { const int tl_ = aw * SPW + s_; \
            const float rinv_ = __builtin_amdgcn_rsqf(fmaxf(st_[2 * s_], 1e-24f)); const float kkn_ = kkv_[s_] * rinv_, bb_ = kkn_ * a_[s_]; \
            const float gm1_ = __builtin_amdgcn_exp2f(lcur_); lcur_ += rwl##X[s_]; \
            const float g_ = __builtin_amdgcn_exp2f(lcur_), ig_ = __builtin_amdgcn_exp2f(-lcur_), lam_ = __builtin_amdgcn_exp2f(ltot_ - lcur_); \
            ((bf16_t*)(V0_ + CV_UT))[tl_ * 64 + pos] = (bf16_t)cvt_pk_bf16_(-kkn_ * gm1_, 0.f); ((bf16_t*)(V0_ + CV_ZT))[tl_ * 64 + pos] = (bf16_t)cvt_pk_bf16_(rr_[s_] * g_, 0.f); \
            ((bf16_t*)(V0_ + CV_BT))[tl_ * 64 + pos] = (bf16_t)cvt_pk_bf16_(bb_ * ig_, 0.f); ((bf16_t*)(V0_ + CV_KT))[tl_ * 64 + pos] = (bf16_t)cvt_pk_bf16_(kmod_[s_] * ig_, 0.f); \
            ((bf16_t*)(V0_ + CV_BKH))[lane * 32 + aw * 8 + s_] = (bf16_t)cvt_pk_bf16_(bb_ * lam_, 0.f); ((bf16_t*)(V0_ + CV_BKH))[lane * 32 + aw * 8 + 4 + s_] = (bf16_t)cvt_pk_bf16_(kmod_[s_] * lam_, 0.f); \
            ((bf16_t*)(V0_ + CV_VT))[lane * 16 + tl_] = (bf16_t)cvt_pk_bf16_(vv_[s_], 0.f); \
            GB_[tl_ * 64 + lane] = bf2f(rg##X[s_]); GB_[TC * 64 + tl_ * 64 + lane] = st_[2 * s_ + 1] * vv_[s_] * bf2f(rg##X[s_]); } \
          if (aw == 3) ((float*)(V0_ + CV_GC))[lane] = __builtin_amdgcn_exp2f(ltot_); } } while (0)
        SCAN_LOAD(0, B); SCAN_LOAD(1, A); SCAN_PREP(0, B); SCAN_LOAD(2, B);
        __syncthreads();
        SCAN_PREP(1, A); SCAN_LOAD(3, A);
        __syncthreads();
        for (int ci = 0; ci < NC; ci += 2) {
            if (ci + 2 < NC) { SCAN_PREP(ci + 2, B); if (ci + 4 < NC) SCAN_LOAD(ci + 4, B); }
            __syncthreads();
            if (ci + 3 < NC) { SCAN_PREP(ci + 3, A); if (ci + 5 < NC) SCAN_LOAD(ci + 5, A); }
            __syncthreads();
        }
#undef SCAN_LOAD
#undef SCAN_PREP
#undef SCAN_MATS
#undef SCAN_POST
#undef OPR
    }
    __syncthreads();
}

#include <hip/hip_bf16.h>
#include <cmath>
namespace attn_body {
using bf16=__hip_bfloat16;
using bf16x8=__attribute__((ext_vector_type(8)))short;
using s16x4=__attribute__((ext_vector_type(4)))short;
using f32x16=__attribute__((ext_vector_type(16)))float;
using u32x4=__attribute__((ext_vector_type(4)))unsigned;
constexpr int SEQ=2048,D=64,DM=1024;
constexpr int NW=8,QBLK=32,QB=QBLK*NW,KVBLK=64,NQB=SEQ/QB;
__device__ __forceinline__ int crow(int r,int hi){return (r&3)+8*(r>>2)+4*hi;}
#define SBAR() __builtin_amdgcn_sched_barrier(0)
__device__ __forceinline__ void cmask(f32x16&p0,f32x16&p1,int jb,int qrel,int hi){
  const float NEG=-INFINITY; int kb=64*jb+4*hi;
  #pragma unroll
  for(int r=0;r<16;++r){int kv=kb+(r&3)+8*(r>>2); if(kv>qrel)p0[r]=NEG; if(kv+32>qrel)p1[r]=NEG;}
}

constexpr int NSLOT=3, SLOTB=8192, SLOTV=16384, NKSLOT=4;
constexpr int LDS_K=0, LDS_V=NKSLOT*SLOTB, LDS_WS=LDS_V+NSLOT*SLOTV, LDS_OST=LDS_WS+NW*64*4, LDS_BYTES=LDS_OST+NW*4096;
constexpr float C2=0.125f*1.4426950408889634f;
__device__ __forceinline__ void glds16(const void*gsrc,unsigned lds_dst){unsigned keep;
  asm volatile("s_mov_b32 %0, m0\n\ts_mov_b32 m0, %2\n\ts_nop 0\n\tglobal_load_lds_dwordx4 %1, off\n\ts_mov_b32 m0, %0":"=&s"(keep):"v"(gsrc),"s"(lds_dst):"memory");}
__device__ __forceinline__ float max3f(float a,float b,float c){float r;asm("v_max3_f32 %0, %1, %2, %3":"=v"(r):"v"(a),"v"(b),"v"(c));return r;}
__device__ __forceinline__ float max2f(float a,float b){float r;asm("v_max_f32_e32 %0, %1, %2":"=v"(r):"v"(a),"v"(b));return r;}
__device__ __forceinline__ float fadd_s(float a,float b){float r;asm("v_add_f32_e32 %0, %1, %2":"=v"(r):"v"(a),"v"(b));return r;}
__device__ __forceinline__ float fsub_s(float a,float b){float r;asm("v_sub_f32_e32 %0, %1, %2":"=v"(r):"v"(a),"v"(b));return r;}
typedef float f32x2_t __attribute__((ext_vector_type(2))); typedef __bf16 bf16x2_t __attribute__((ext_vector_type(2)));
__device__ __forceinline__ unsigned cvtpk_s(float lo,float hi){f32x2_t v={lo,hi};bf16x2_t b=__builtin_convertvector(v,bf16x2_t);return __builtin_bit_cast(unsigned,b);}
#define WAIT_BAR(N) asm volatile("s_waitcnt vmcnt(" #N ") lgkmcnt(0)\n\ts_barrier":::"memory")

__device__ __forceinline__ void qkt(f32x16&p0,f32x16&p1,const char*Kslot,const bf16x8*qr,const f32x16&negm,int r32,int hi){
  const char*kb=Kslot+hi*1024+r32*16;
  #pragma unroll
  for(int d0=0;d0<4;++d0){
    const bf16x8 b0=*reinterpret_cast<const bf16x8*>(kb+d0*2048);
    const bf16x8 b1=*reinterpret_cast<const bf16x8*>(kb+d0*2048+512);
    if(d0==0){p0=__builtin_amdgcn_mfma_f32_32x32x16_bf16(b0,qr[0],negm,0,0,0);p1=__builtin_amdgcn_mfma_f32_32x32x16_bf16(b1,qr[0],negm,0,0,0);}
    else{p0=__builtin_amdgcn_mfma_f32_32x32x16_bf16(b0,qr[d0],p0,0,0,0);p1=__builtin_amdgcn_mfma_f32_32x32x16_bf16(b1,qr[d0],p1,0,0,0);}}
}
typedef __attribute__((address_space(3))) const char* lds_cptr;
typedef short v4i16_t __attribute__((ext_vector_type(4)));
__device__ __forceinline__ void kload8(bf16x8*kf,lds_cptr kp){
  kf[0]=*(const __attribute__((address_space(3))) bf16x8*)(kp);      kf[1]=*(const __attribute__((address_space(3))) bf16x8*)(kp+512);
  kf[2]=*(const __attribute__((address_space(3))) bf16x8*)(kp+2048); kf[3]=*(const __attribute__((address_space(3))) bf16x8*)(kp+2560);
  kf[4]=*(const __attribute__((address_space(3))) bf16x8*)(kp+4096); kf[5]=*(const __attribute__((address_space(3))) bf16x8*)(kp+4608);
  kf[6]=*(const __attribute__((address_space(3))) bf16x8*)(kp+6144); kf[7]=*(const __attribute__((address_space(3))) bf16x8*)(kp+6656);
}
__device__ __forceinline__ void kload2(bf16x8*kf,lds_cptr kp,int j){ kf[2*j]=*(const __attribute__((address_space(3))) bf16x8*)(kp+j*2048); kf[2*j+1]=*(const __attribute__((address_space(3))) bf16x8*)(kp+j*2048+512); }
__device__ __forceinline__ s16x4 vtr(lds_cptr p){ return __builtin_bit_cast(s16x4,__builtin_amdgcn_ds_read_tr16_b64_v4i16((__attribute__((address_space(3))) v4i16_t*)p)); }
__device__ __forceinline__ float rowmax(const f32x16&p0,const f32x16&p1){
  float a=max3f(p0[0],p0[1],p1[0]),b=max3f(p0[2],p0[3],p1[1]);a=max3f(a,p1[2],p1[3]);
  #pragma unroll
  for(int r=4;r<16;r+=4){a=max3f(a,p0[r],p0[r+1]);b=max3f(b,p0[r+2],p0[r+3]);a=max3f(a,p1[r],p1[r+1]);b=max3f(b,p1[r+2],p1[r+3]);}
  const float m=max2f(a,b);
  auto rr=__builtin_amdgcn_permlane32_swap(__float_as_uint(m),__float_as_uint(m),false,false);
  return max2f(__uint_as_float(rr[0]),__uint_as_float(rr[1]));
}
__device__ __forceinline__ void pv(f32x16*o,int vb,bf16x8 pa0,bf16x8 pa1,bf16x8 pa2,bf16x8 pa3){
  #pragma unroll
  for(int d0=0;d0<4;++d0){s16x4 lo[4],hi[4];
    #pragma unroll
    for(int ks=0;ks<4;++ks){
      asm volatile("ds_read_b64_tr_b16 %0,%1 offset:%c2":"=&v"(lo[ks]):"v"(vb),"i"(d0*4096+ks*1024):"memory");
      asm volatile("ds_read_b64_tr_b16 %0,%1 offset:%c2":"=&v"(hi[ks]):"v"(vb),"i"(d0*4096+ks*1024+512):"memory");}
    asm volatile("s_waitcnt lgkmcnt(0)":::"memory");SBAR();
    #define PK(k) (bf16x8){lo[k][0],lo[k][1],lo[k][2],lo[k][3],hi[k][0],hi[k][1],hi[k][2],hi[k][3]}
    o[d0]=__builtin_amdgcn_mfma_f32_32x32x16_bf16(pa0,PK(0),o[d0],0,0,0);
    o[d0]=__builtin_amdgcn_mfma_f32_32x32x16_bf16(pa1,PK(1),o[d0],0,0,0);
    o[d0]=__builtin_amdgcn_mfma_f32_32x32x16_bf16(pa2,PK(2),o[d0],0,0,0);
    o[d0]=__builtin_amdgcn_mfma_f32_32x32x16_bf16(pa3,PK(3),o[d0],0,0,0);
    #undef PK
  }
}

#ifndef ATTN_STORE16
#define ATTN_STORE16(p,v) (*(u32x4*)(p)=(v))
#endif
template<int THRL> __device__ __forceinline__ void attn_unit(int b,int qkcol,int vcol,int qb,int t_lo,float slope2,const bf16*Q,const bf16*__restrict__ K,const bf16*__restrict__ V,bf16*O,char*shm){
  const int tid=opaque_tid(),lane=tid&63,r32=lane&31,hi=lane>>5; const int wid=__builtin_amdgcn_readfirstlane(tid>>6);
  const long rowbase=(long)b*SEQ; const int q0=qb*QB;
  const bf16*Qw=Q+(rowbase+q0+wid*QBLK)*DM+qkcol;
  const bf16*Kh=K+(rowbase+(long)t_lo*KVBLK)*DM+qkcol,*Vh=V+(rowbase+(long)t_lo*KVBLK)*DM+vcol;
  const unsigned lds0=(unsigned)(uintptr_t)shm;
  float*wsf=(float*)(shm+LDS_WS)+wid*64;
  const bf16*ksrc=Kh+(long)lane*DM+wid*8;
  const bf16*vsrc=Vh+(long)(16*(wid&3)+(lane>>2))*DM+(wid>>2)*32+(lane&3)*8;
  const unsigned kdst=lds0+LDS_K+wid*1024, vdst=lds0+LDS_V+(wid>>2)*4096+(wid&3)*1024;
  #define DMA_K(t,slot) glds16(ksrc+(long)(t)*KVBLK*DM,(unsigned)__builtin_amdgcn_readfirstlane(kdst+(slot)))
  #define DMA_V(t,slot) do{ glds16(vsrc+(long)(t)*KVBLK*DM,(unsigned)__builtin_amdgcn_readfirstlane(vdst+(slot))); glds16(vsrc+(long)(t)*KVBLK*DM+64,(unsigned)__builtin_amdgcn_readfirstlane(vdst+(slot)+8192)); }while(0)
  #define KSL(t) ((((t))&3)*SLOTB)
  const int vb0=(int)(lds0+LDS_V)+((lane>>4)&1)*32+(lane&3)*8+(4*hi+((lane&15)>>2))*64;
  const char*Kbase=shm+LDS_K; bf16x8 kf[4];
  const lds_cptr shm3=(lds_cptr)shm; const lds_cptr kp0=shm3+LDS_K+hi*1024+r32*16; const lds_cptr vp0=shm3+LDS_V+((lane>>4)&1)*32+(lane&3)*8+(4*hi+((lane&15)>>2))*64;
  const int NT=(q0+QB)/KVBLK-t_lo;
  DMA_K(0,0);DMA_V(0,0);DMA_K(1,SLOTB);
  bf16x8 qr[4];
  #pragma unroll
  for(int d0=0;d0<4;++d0)qr[d0]=*reinterpret_cast<const bf16x8*>(&Qw[(long)r32*DM+d0*16+hi*8]);
  float mhat=0.f,l_reg=0.f;f32x16 o[4];o[0]=f32x16{};o[1]=f32x16{};o[2]=f32x16{};o[3]=f32x16{};f32x16 negm;
  const int qrel=wid*QBLK+r32;
  _Pragma("unroll") for(int r=0;r<16;++r)negm[r]=slope2*(float)(4*hi+(r&3)+8*(r>>2)); asm volatile("":"+v"(negm));
  #define CMASK(P0,P1,t) do{int jb_=(t)-(NT-4); if(jb_>=0)cmask(P0,P1,jb_,qrel,hi);}while(0)
  #define ABIAS(P0,P1,t) do{ float kb_=slope2*(float)(64*((t)+t_lo))-mhat; asm volatile("":"+v"(kb_)); const float kc_=kb_+32.f*slope2; _Pragma("unroll") for(int r=0;r<16;++r){ P0[r]+=kb_; P1[r]+=kc_; } }while(0)
  bool resc=false;
  #define START(P0,P1) do{ const float rm=rowmax(P0,P1); resc=false; \
    { const float dl=rm; mhat=fadd_s(mhat,dl); \
      _Pragma("unroll") for(int r=0;r<16;++r){P0[r]=fsub_s(P0[r],dl);P1[r]=fsub_s(P1[r],dl);} \
      } \
    _Pragma("unroll") for(int r=0;r<16;++r)P0[r]=__builtin_amdgcn_exp2f(P0[r]); }while(0)
  #define RESC() do{ if(resc){ asm volatile("s_waitcnt lgkmcnt(0)":::"memory"); \
      _Pragma("unroll") for(int d_=0;d_<4;++d_) _Pragma("unroll") for(int r=0;r<16;++r)o[d_][r]*=wsf[crow(r,hi)]; } }while(0)
  f32x16 pA0,pA1,pB0,pB1;
  int vs_prev=0,vs_cur=0,vs_next=SLOTV;
  #define ROT() do{vs_prev=vs_cur;vs_cur=vs_next;vs_next=(vs_next==(NSLOT-1)*SLOTV)?0:vs_next+SLOTV;}while(0)
  DMA_K(2,2*SLOTB);
  WAIT_BAR(3);
  qkt(pA0,pA1,Kbase,qr,negm,r32,hi);asm volatile("s_nop 15\n\ts_nop 7":"+v"(pA0),"+v"(pA1));ABIAS(pA0,pA1,0);CMASK(pA0,pA1,0);
  START(pA0,pA1);
  _Pragma("unroll") for(int r=0;r<16;++r)pA1[r]=__builtin_amdgcn_exp2f(pA1[r]);
  WAIT_BAR(0);
  DMA_K(3,3*SLOTB);DMA_V(1,SLOTV);
  ROT();
  #define KFR(s,i,kp) kf[s]=*(const __attribute__((address_space(3))) bf16x8*)((kp)+((i)>>1)*2048+((i)&1)*512)
  { const lds_cptr kq_=kp0+KSL(1); KFR(0,0,kq_); KFR(1,1,kq_); KFR(2,2,kq_); KFR(3,3,kq_); }
  s16x4 vlo[6],vhi[6]; u32x4 pw0,pw1,pw2,pw3;
  #define PKW(P,B) cvtpk_s(P[B],P[B+1])
  #define PAF(k) __builtin_bit_cast(bf16x8,pw##k)
  #define VFR(i) (bf16x8){vlo[i][0],vlo[i][1],vlo[i][2],vlo[i][3],vhi[i][0],vhi[i][1],vhi[i][2],vhi[i][3]}
  #define PIN(x) asm volatile("":"+v"(x))
  #define MX3(a,b,c) __builtin_fmaxf(__builtin_fmaxf((a),(b)),(c))
  #define GAPA(MF,RD,A0,A1,A2,A3,W0,W1,PW) do{ MF; RD; sacc+=A0; sacc+=A1; sacc+=A2; sacc+=A3; PIN(sacc); W0; W1; PIN(PW); SBAR(); }while(0)
  #define EX(v) __builtin_amdgcn_exp2f(v)
  #define GAPB(MF,RD,X,B) do{ MF; RD; X[B]=EX(X[B]); X[B+1]=EX(X[B+1]); PIN(X); SBAR(); }while(0)
  #define VRD(j) do{ vlo[(j)%6]=vtr(vp_+(((j)&3)*4096+((j)>>2)*1024)); vhi[(j)%6]=vtr(vp_+(((j)&3)*4096+((j)>>2)*1024+512)); }while(0)
  #define NORD do{}while(0)
  #define KNX(G,i) do{ if(G){ KFR(i,i,kn_); } }while(0)
  #define PVM(j,k) o[(j)&3]=__builtin_amdgcn_mfma_f32_32x32x16_bf16(PAF(k),VFR((j)%6),o[(j)&3],0,0,0)
  #define STEP(C0,C1,P0,P1,t,GK,GV,GL) do{ SBAR(); \
    const lds_cptr vp_=vp0+vs_prev; const lds_cptr kp_=kp0+KSL(t); const lds_cptr kn_=kp0+KSL((t)+1); \
    float sacc=(P0[0]+P0[1]); \
    GAPA(C0=__builtin_amdgcn_mfma_f32_32x32x16_bf16(kf[0],qr[0],negm,0,0,0), KFR(0,4,kp_),          P0[2],P0[3],P0[4],P0[5],     pw0[0]=PKW(P0,0), pw0[1]=PKW(P0,2), pw0); \
    GAPA(C1=__builtin_amdgcn_mfma_f32_32x32x16_bf16(kf[1],qr[0],negm,0,0,0), KFR(1,5,kp_),          P0[6],P0[7],P0[8],P0[9],     pw0[2]=PKW(P0,4), pw0[3]=PKW(P0,6), pw0); \
    GAPA(C0=__builtin_amdgcn_mfma_f32_32x32x16_bf16(kf[2],qr[1],C0,0,0,0),   KFR(2,6,kp_); VRD(0),  P0[10],P0[11],P0[12],P0[13], pw1[0]=PKW(P0,8), pw1[1]=PKW(P0,10), pw1); \
    GAPA(C1=__builtin_amdgcn_mfma_f32_32x32x16_bf16(kf[3],qr[1],C1,0,0,0),   KFR(3,7,kp_); VRD(1),  P0[14],P0[15],P1[0],P1[1],   pw1[2]=PKW(P0,12),pw1[3]=PKW(P0,14), pw1); \
    GAPA(C0=__builtin_amdgcn_mfma_f32_32x32x16_bf16(kf[0],qr[2],C0,0,0,0),   VRD(2),                P1[2],P1[3],P1[4],P1[5],     pw2[0]=PKW(P1,0), pw2[1]=PKW(P1,2), pw2); \
    GAPA(C1=__builtin_amdgcn_mfma_f32_32x32x16_bf16(kf[1],qr[2],C1,0,0,0),   VRD(3),                P1[6],P1[7],P1[8],P1[9],     pw2[2]=PKW(P1,4), pw2[3]=PKW(P1,6), pw2); \
    GAPA(C0=__builtin_amdgcn_mfma_f32_32x32x16_bf16(kf[2],qr[3],C0,0,0,0),   VRD(4),                P1[10],P1[11],P1[12],P1[13], pw3[0]=PKW(P1,8), pw3[1]=PKW(P1,10), pw3); \
    GAPA(C1=__builtin_amdgcn_mfma_f32_32x32x16_bf16(kf[3],qr[3],C1,0,0,0),   VRD(5),                P1[14],P1[15],0.f,0.f,       pw3[2]=PKW(P1,12),pw3[3]=PKW(P1,14), pw3); \
    l_reg+=sacc; \
    if(GK){DMA_K((t)+3,KSL((t)+3));} if(GV){DMA_V((t)+1,vs_next);} \
    ABIAS(C0,C1,t); CMASK(C0,C1,t); \
    { float a=MX3(C0[0],C0[1],C1[0]),b=MX3(C0[2],C0[3],C1[1]); a=MX3(a,C1[2],C1[3]); \
      _Pragma("unroll") for(int r=4;r<16;r+=4){a=MX3(a,C0[r],C0[r+1]);b=MX3(b,C0[r+2],C0[r+3]);a=MX3(a,C1[r],C1[r+1]);b=MX3(b,C1[r+2],C1[r+3]);} \
      float rm=__builtin_fmaxf(a,b); { auto rr=__builtin_amdgcn_permlane32_swap(__float_as_uint(rm),__float_as_uint(rm),false,false); rm=__builtin_fmaxf(__uint_as_float(rr[0]),__uint_as_float(rr[1])); } \
      resc=false; \
      if(__builtin_expect(__any(rm>(float)THRL),0)){ const float dl=__builtin_fmaxf(rm,0.f); mhat+=dl; \
        _Pragma("unroll") for(int r=0;r<16;++r){C0[r]-=dl;C1[r]-=dl;} \
        const float f=__builtin_amdgcn_exp2f(-dl); l_reg*=f; if(hi==0)wsf[r32]=f; resc=true; } } \
    SBAR(); \
    GAPB(PVM(0,0),  VRD(6),  C0,0); \
    GAPB(PVM(1,0),  VRD(7),  C0,2); \
    GAPB(PVM(2,0),  VRD(8),  C0,4); \
    GAPB(PVM(3,0),  VRD(9),  C0,6); \
    GAPB(PVM(4,1),  VRD(10), C0,8); \
    GAPB(PVM(5,1),  VRD(11), C0,10); \
    GAPB(PVM(6,1),  VRD(12), C0,12); \
    GAPB(PVM(7,1),  VRD(13), C0,14); \
    GAPB(PVM(8,2),  VRD(14), C1,0); \
    GAPB(PVM(9,2),  VRD(15), C1,2); \
    GAPB(PVM(10,2), NORD,    C1,4); \
    GAPB(PVM(11,2), NORD,    C1,6); \
    GAPB(PVM(12,3), KNX(GL,0), C1,8); \
    GAPB(PVM(13,3), KNX(GL,1), C1,10); \
    GAPB(PVM(14,3), KNX(GL,2), C1,12); \
    GAPB(PVM(15,3), KNX(GL,3), C1,14); \
    }while(0)
  int t=1;
  #undef CMASK
  #define CMASK(P0,P1,t) do{}while(0)
  for(;t+5<NT;t+=2){
    STEP(pB0,pB1,pA0,pA1,t,true,true,true);     WAIT_BAR(3); RESC(); ROT();
    STEP(pA0,pA1,pB0,pB1,t+1,true,true,true);   WAIT_BAR(3); RESC(); ROT();
  }
  #undef CMASK
  #define CMASK(P0,P1,t) do{int jb_=(t)-(NT-4); if(jb_>=0)cmask(P0,P1,jb_,qrel,hi);}while(0)
  #define ENDW(tt) do{ if((tt)+3<NT){WAIT_BAR(3);} else if((tt)+2<NT){WAIT_BAR(2);} else {WAIT_BAR(0);} }while(0)
  for(;t+1<NT;t+=2){
    STEP(pB0,pB1,pA0,pA1,t,(t+3<NT),(t+1<NT),(t+1<NT));       ENDW(t);   RESC(); ROT();
    STEP(pA0,pA1,pB0,pB1,t+1,(t+4<NT),(t+2<NT),(t+2<NT));     ENDW(t+1); RESC(); ROT();
  }
  STEP(pB0,pB1,pA0,pA1,NT-1,false,false,false); RESC();
  { float sacc=pB0[0]+pB0[1]; _Pragma("unroll") for(int r=2;r<16;++r)sacc+=pB0[r]; _Pragma("unroll") for(int r=0;r<16;++r)sacc+=pB1[r]; l_reg+=sacc;
    pw0=(u32x4){PKW(pB0,0),PKW(pB0,2),PKW(pB0,4),PKW(pB0,6)};pw1=(u32x4){PKW(pB0,8),PKW(pB0,10),PKW(pB0,12),PKW(pB0,14)};pw2=(u32x4){PKW(pB1,0),PKW(pB1,2),PKW(pB1,4),PKW(pB1,6)};pw3=(u32x4){PKW(pB1,8),PKW(pB1,10),PKW(pB1,12),PKW(pB1,14)};
    SBAR(); pv(o,vb0+vs_cur,PAF(0),PAF(1),PAF(2),PAF(3)); }
  #undef PKW
  #undef PAF
  #undef VFR
  #undef PIN
  #undef MX3
  #undef GAPA
  #undef GAPB
  #undef EX
  #undef VRD
  #undef NORD
  #undef KNX
  #undef PVM
  #undef KFR
  #undef STEP
  #undef ENDW
  {auto rr=__builtin_amdgcn_permlane32_swap(__float_as_uint(l_reg),__float_as_uint(l_reg),false,false);l_reg=__uint_as_float(rr[0])+__uint_as_float(rr[1]);}
  int lane_e=lane; asm volatile("":"+v"(lane_e)); const int r32e=lane_e&31, hie=lane_e>>5;
  if(hie==0)wsf[32+r32e]=l_reg;asm volatile("s_waitcnt lgkmcnt(0)":::"memory");
  float rli[16];
  #pragma unroll
  for(int r=0;r<16;++r)rli[r]=__builtin_amdgcn_rcpf(wsf[32+crow(r,hie)]);
  bf16*Ow=O+(rowbase+q0+wid*QBLK)*DM+vcol;
  { bf16*stg=(bf16*)(shm+LDS_OST)+wid*2048;
    #pragma unroll
    for(int hf=0;hf<2;++hf){
      #pragma unroll
      for(int r=0;r<16;++r){const int orow=crow(r,hie);
        #pragma unroll
        for(int d0=0;d0<2;++d0)stg[orow*64+d0*32+r32e]=__float2bfloat16(o[2*hf+d0][r]*rli[r]);}
      asm volatile("s_waitcnt lgkmcnt(0)":::"memory");
      #pragma unroll
      for(int i=0;i<4;++i){const int row=i*8+(lane_e>>3),ch=lane_e&7; const u32x4 v=*(const u32x4*)(stg+row*64+ch*8); ATTN_STORE16(Ow+(long)row*DM+hf*64+ch*8,v);}
      asm volatile("s_waitcnt lgkmcnt(0)":::"memory"); } }
  asm volatile("s_waitcnt lgkmcnt(0)\n\ts_barrier":::"memory");
  #undef DMA_K
  #undef DMA_V
  #undef KSL
  #undef CMASK
  #undef ABIAS
  #undef START
  #undef RESC
  #undef ROT
}
constexpr int ATTN_LDS_BYTES=LDS_BYTES;
#undef SBAR
#undef WAIT_BAR
}

__device__ __forceinline__ void attn_unit_ref(const Params& p, unsigned char* lds, int b, int h, int comp, int qb) {
    const int tid = opaque_tid(), row = tid & 255, dh = tid >> 8;
    float* Kt = (float*)lds; float* Vt = Kt + 64 * 64;
    const bf16_t* qbuf = (const bf16_t*)(p.ws + WS_INBUF); const bf16_t* kbuf = qbuf + (size_t)T * 1024; const bf16_t* vbuf = kbuf + (size_t)T * 1024;
    bf16_t* Op = (bf16_t*)(p.ws + WS_OPART) + (size_t)comp * T * 1024;
    const size_t rowbase = (size_t)b * SEQ; const int qpos = qb * 256 + row;
    float qv[64], o[64];
    { const bf16_t* qp = qbuf + (rowbase + qpos) * 1024 + h * 128 + comp * 64;
#pragma unroll
      for (int d = 0; d < 64; d += 8) { const u32x4 w = *(const u32x4*)(qp + d);
#pragma unroll
          for (int i = 0; i < 4; ++i) { qv[d + 2 * i] = bflo(w[i]); qv[d + 2 * i + 1] = bfhi(w[i]); } } }
#pragma unroll
    for (int d = 0; d < 64; ++d) o[d] = 0.f;
    float mrun = -1e30f, l = 0.f;
    const float slope2 = exp2f(-(float)(h + 1)) * LOG2E;
    const int ntile = (qb + 1) * 4;
    for (int kt = 0; kt < ntile; ++kt) {
        __syncthreads();
        for (int ch = tid; ch < 1536; ch += NTHREADS) { const int r = ch / 24, cc = ch % 24; const size_t grow = rowbase + kt * 64 + r;
            if (cc < 8) { const u32x4 w = *(const u32x4*)(kbuf + grow * 1024 + h * 128 + comp * 64 + cc * 8);
#pragma unroll
                for (int i = 0; i < 4; ++i) { Kt[r * 64 + cc * 8 + 2 * i] = bflo(w[i]); Kt[r * 64 + cc * 8 + 2 * i + 1] = bfhi(w[i]); } }
            else { const int c2 = cc - 8; const u32x4 w = *(const u32x4*)(vbuf + grow * 1024 + h * 128 + c2 * 8);
#pragma unroll
                for (int i = 0; i < 4; ++i) { Vt[r * 128 + c2 * 8 + 2 * i] = bflo(w[i]); Vt[r * 128 + c2 * 8 + 2 * i + 1] = bfhi(w[i]); } } }
        __syncthreads();
        for (int j = 0; j < 64; ++j) {
            const int kpos = kt * 64 + j; if (kpos > qpos) break;
            float s = 0.f;
#pragma unroll
            for (int d = 0; d < 64; d += 4) { const f32x4 kv = *(const f32x4*)(Kt + j * 64 + d); s += qv[d] * kv[0] + qv[d + 1] * kv[1] + qv[d + 2] * kv[2] + qv[d + 3] * kv[3]; }
            s += slope2 * (float)kpos;
            if (s > mrun) { const float f = exp2f(mrun - s); l *= f;
#pragma unroll
                for (int d = 0; d < 64; ++d) o[d] *= f;
                mrun = s; }
            const float pr = exp2f(s - mrun); l += pr;
#pragma unroll
            for (int d = 0; d < 64; d += 4) { const f32x4 vv = *(const f32x4*)(Vt + j * 128 + dh * 64 + d); o[d] += pr * vv[0]; o[d + 1] += pr * vv[1]; o[d + 2] += pr * vv[2]; o[d + 3] += pr * vv[3]; }
        }
    }
    const float il = 1.0f / l;
    bf16_t* op = Op + (rowbase + qpos) * 1024 + h * 128 + dh * 64;
#pragma unroll
    for (int d = 0; d < 64; d += 8) { u32x4 w; w.x = pk2(o[d] * il, o[d + 1] * il); w.y = pk2(o[d + 2] * il, o[d + 3] * il); w.z = pk2(o[d + 4] * il, o[d + 5] * il); w.w = pk2(o[d + 6] * il, o[d + 7] * il); *(u32x4*)(op + d) = w; }
    __syncthreads();
}

__device__ __forceinline__ void attn_phase_queue(const Params& p, unsigned char* lds, unsigned* qctr) {
    const attn_body::bf16* Q = (const attn_body::bf16*)(p.ws + WS_INBUF); const attn_body::bf16* K = Q + (size_t)T * 1024; const attn_body::bf16* V = K + (size_t)T * 1024;
    attn_body::bf16* OP = (attn_body::bf16*)(p.ws + WS_OPART);
    volatile int* slot = (volatile int*)(lds + LDS_BYTES - 64);
    __syncthreads();
    if (threadIdx.x == 0) *slot = (int)atomicAdd(qctr, 1u);
    __syncthreads();
    int u = __builtin_amdgcn_readfirstlane(*slot);
    while (u < 1024) {
        unsigned nxt_ticket = 0u;
        if (threadIdx.x == 0) nxt_ticket = atomicAdd(qctr, 1u);
        const int qb = 7 - (u >> 7), id = u & 127;
        const int comp = id & 1, h = (id >> 1) & 7, b = id >> 4;
        const float slope2 = exp2f(-(float)(h + 1)) * LOG2E;
        const float* nrm = (const float*)(p.ws + WS_CTL + CTL_NRM); const int ni = ((b * 8 + h) * 2 + comp) * 2;
        const float q2 = nrm[ni] + nrm[ni + 1], k2 = nrm[512 + ni] + nrm[512 + ni + 1];
        const float smax = sqrtf(q2 * k2) * 1.02f, dneed = (2.0f * smax + 58.0f) / slope2;
        const float tmaxf = floorf(((float)(256 * qb - 63) - dneed) * (1.0f / 64.0f));
        int t_lo = tmaxf >= 0.f ? (int)tmaxf + 1 : 0; t_lo &= ~1; t_lo = t_lo < 4 * qb ? t_lo : 4 * qb;
        t_lo = __builtin_amdgcn_readfirstlane(t_lo);
        attn_body::attn_unit<8>(b, h * 128 + comp * 64, h * 128, qb, t_lo, slope2, Q, K, V, OP + (size_t)comp * T * 1024, (char*)lds);
        if (threadIdx.x == 0) *slot = (int)nxt_ticket;
        __syncthreads();
        u = __builtin_amdgcn_readfirstlane(*slot);
        __syncthreads();
    }
}

__device__ __forceinline__ void phase_combine(const Params& p) {
    const int tid = opaque_tid(), lane = tid & 63, wave = tid >> 6;
    const int gw = blockIdx.x * NWAVES + wave, NGW = gridDim.x * NWAVES;
    const float s1 = wave_sum(p.in[4][lane] * p.in[5][lane]), s2 = wave_sum(p.in[6][lane] * p.in[7][lane]);
    const float lam = __expf(s1) - __expf(s2) + 0.2f;
    const bf16_t* O0 = (const bf16_t*)(p.ws + WS_OPART); const bf16_t* O1 = O0 + (size_t)T * 1024; bf16_t* O = (bf16_t*)(p.ws + WS_O);
    const float* sg = p.in[8] + (lane & 7) * 16;
    float sgv[16];
#pragma unroll
    for (int i = 0; i < 16; ++i) sgv[i] = sg[i];
    for (int m0 = gw; m0 < T; m0 += 4 * NGW) {
        u32x4 a0[4], a1[4], c0[4], c1[4];
#pragma unroll
        for (int u = 0; u < 4; ++u) { const int m = m0 + u * NGW; if (m < T) {
            a0[u] = *(const u32x4*)(O0 + (size_t)m * 1024 + lane * 16); a1[u] = *(const u32x4*)(O0 + (size_t)m * 1024 + lane * 16 + 8);
            c0[u] = *(const u32x4*)(O1 + (size_t)m * 1024 + lane * 16); c1[u] = *(const u32x4*)(O1 + (size_t)m * 1024 + lane * 16 + 8); } }
#pragma unroll
        for (int u = 0; u < 4; ++u) { const int m = m0 + u * NGW; if (m < T) {
            float d[16]; float ss = 0.f;
#pragma unroll
            for (int i = 0; i < 4; ++i) { d[2 * i] = bflo(a0[u][i]) - lam * bflo(c0[u][i]); d[2 * i + 1] = bfhi(a0[u][i]) - lam * bfhi(c0[u][i]); d[8 + 2 * i] = bflo(a1[u][i]) - lam * bflo(c1[u][i]); d[8 + 2 * i + 1] = bfhi(a1[u][i]) - lam * bfhi(c1[u][i]); }
#pragma unroll
            for (int i = 0; i < 16; ++i) ss += d[i] * d[i];
            ss += __shfl_xor(ss, 1); ss += __shfl_xor(ss, 2); ss += __shfl_xor(ss, 4);
            const float rs = 0.8f / sqrtf(ss * (1.0f / 128.0f) + 1e-6f);
            u32x4 w0, w1;
            w0.x = pk2(d[0] * rs * sgv[0], d[1] * rs * sgv[1]); w0.y = pk2(d[2] * rs * sgv[2], d[3] * rs * sgv[3]); w0.z = pk2(d[4] * rs * sgv[4], d[5] * rs * sgv[5]); w0.w = pk2(d[6] * rs * sgv[6], d[7] * rs * sgv[7]);
            w1.x = pk2(d[8] * rs * sgv[8], d[9] * rs * sgv[9]); w1.y = pk2(d[10] * rs * sgv[10], d[11] * rs * sgv[11]); w1.z = pk2(d[12] * rs * sgv[12], d[13] * rs * sgv[13]); w1.w = pk2(d[14] * rs * sgv[14], d[15] * rs * sgv[15]);
            *(u32x4*)(O + (size_t)m * DM + lane * 16) = w0; *(u32x4*)(O + (size_t)m * DM + lane * 16 + 8) = w1; } }
    }
}

__device__ __forceinline__ void phase_router(const Params& p, unsigned char* lds, bool dry = false) {
    const int tid = opaque_tid(), lane = tid & 63, wave = tid >> 6, fr = lane & 15, fq = lane >> 4;
    float* part = (float*)lds;
    const bf16_t* hb = (const bf16_t*)(p.ws + WS_HB);
    const bf16_t* whi = (const bf16_t*)(p.ws + WS_WRT); const bf16_t* wlo = whi + 48 * 2048;
    const float* ss2 = (const float*)(p.ws + WS_CTL + CTL_SS2); float* rstd2 = (float*)(p.ws + WS_RSTD2);
    unsigned* cnt = (unsigned*)(p.ws + WS_CTL + CTL_CNT); int* rt = (int*)(p.ws + WS_RT); float* gateb = (float*)(p.ws + WS_GATEB); int* tokinfo = (int*)(p.ws + WS_TOKINFO);
    const int mt = wave & 3, kh = wave >> 2;
    constexpr int WROW = 528, WBUF = 2 * 48 * WROW;
    unsigned char* wlds = lds + 32768;
    for (int tb = blockIdx.x; tb < T / 64; tb += gridDim.x) {
        const int tok0 = tb * 64;
        const bf16_t* hrow = hb + (size_t)(tok0 + mt * 16 + fr) * DM + kh * 128 + fq * 8;
        bf16x8 af[8][4];
#pragma unroll
        for (int c = 0; c < 8; ++c)
#pragma unroll
            for (int j = 0; j < 4; ++j) af[c][j] = *(const bf16x8*)(hrow + c * 256 + j * 32);
        f32x4 acc[3];
#pragma unroll
        for (int i = 0; i < 3; ++i) acc[i] = (f32x4){0.f, 0.f, 0.f, 0.f};
        u32x4 st[6];
#define RT_STAGE_LOAD(c_) do { _Pragma("unroll") for (int i_ = 0; i_ < 6; ++i_) { const int pc_ = tid + 512 * i_, hl_ = pc_ / 1536, rr_ = (pc_ % 1536) >> 5, cc_ = pc_ & 31; \
            st[i_] = *(const u32x4*)((hl_ ? wlo : whi) + (size_t)rr_ * DM + (c_) * 256 + cc_ * 8); } } while (0)
#define RT_STAGE_WRITE(buf_) do { _Pragma("unroll") for (int i_ = 0; i_ < 6; ++i_) { const int pc_ = tid + 512 * i_, hl_ = pc_ / 1536, rr_ = (pc_ % 1536) >> 5, cc_ = pc_ & 31; \
            *(u32x4*)(wlds + (buf_) * WBUF + (hl_ * 48 + rr_) * WROW + cc_ * 16) = st[i_]; } } while (0)
        __syncthreads();
        RT_STAGE_LOAD(0); RT_STAGE_WRITE(0);
#pragma unroll
        for (int c = 0; c < 8; ++c) {
            if (c + 1 < 8) RT_STAGE_LOAD(c + 1);
            __syncthreads();
            const unsigned char* wb = wlds + (c & 1) * WBUF + fr * WROW + (kh * 128 + fq * 8) * 2;
#pragma unroll
            for (int j = 0; j < 4; ++j)
#pragma unroll
                for (int nt = 0; nt < 3; ++nt) {
                    const bf16x8 bhi = *(const bf16x8*)(wb + nt * 16 * WROW + j * 64), blo = *(const bf16x8*)(wb + (48 + nt * 16) * WROW + j * 64);
                    acc[nt] = __builtin_amdgcn_mfma_f32_16x16x32_bf16(af[c][j], bhi, acc[nt], 0, 0, 0);
                    acc[nt] = __builtin_amdgcn_mfma_f32_16x16x32_bf16(af[c][j], blo, acc[nt], 0, 0, 0);
                }
            if (c + 1 < 8) RT_STAGE_WRITE((c + 1) & 1);
        }
#undef RT_STAGE_LOAD
#undef RT_STAGE_WRITE
#pragma unroll
        for (int nt = 0; nt < 3; ++nt)
#pragma unroll
            for (int r = 0; r < 4; ++r) part[(kh * 64 + mt * 16 + fq * 4 + r) * 48 + nt * 16 + fr] = acc[nt][r];
        __syncthreads();
        int* lcnt = (int*)(lds + 24576);
        if (tid < 64) lcnt[tid] = 0;
        __syncthreads();
        int e0 = 0, e1 = 0, lr0 = 0, lr1 = 0; float g0 = 0.f, g1 = 0.f;
        if (tid < 64 && !dry) {
            const float* l0 = part + tid * 48; const float* l1 = part + (64 + tid) * 48;
            const int t = tok0 + tid; const float rs = 1.0f / sqrtf(ss2[t] * (1.0f / DM) + 1e-6f); rstd2[t] = rs;
            float g4[4]; int grp = 0; float gmax = -3.0e38f;
#pragma unroll
            for (int i = 0; i < 4; ++i) { g4[i] = (l0[i] + l1[i]) * rs + p.in[26][i]; if (g4[i] > gmax) { gmax = g4[i]; grp = i; } }
            float gs = 0.f;
#pragma unroll
            for (int i = 0; i < 4; ++i) gs += __expf(g4[i] - gmax);
            const float pg = 1.0f / gs;
            float e8[8]; int i0 = 0; float m0 = -3.0e38f;
#pragma unroll
            for (int i = 0; i < 8; ++i) { e8[i] = (l0[4 + grp * 8 + i] + l1[4 + grp * 8 + i]) * rs + p.in[28][grp * 8 + i]; if (e8[i] > m0) { m0 = e8[i]; i0 = i; } }
            int i1 = 0; float m1 = -3.0e38f;
#pragma unroll
            for (int i = 0; i < 8; ++i) if (i != i0 && e8[i] > m1) { m1 = e8[i]; i1 = i; }
            const float p1 = __expf(m1 - m0); g0 = pg / (1.0f + p1); g1 = pg * p1 / (1.0f + p1);
            e0 = grp * 8 + i0; e1 = grp * 8 + i1;
            lr0 = atomicAdd(lcnt + e0, 1); lr1 = atomicAdd(lcnt + e1, 1);
        }
        __syncthreads();
        if (tid < 32 && !dry) { const int c = lcnt[tid]; lcnt[32 + tid] = c > 0 ? (int)atomicAdd(cnt + tid, (unsigned)c) : 0; }
        __syncthreads();
        if (tid < 64 && !dry) {
            const int t = tok0 + tid; const unsigned r0 = (unsigned)(lcnt[32 + e0] + lr0), r1 = (unsigned)(lcnt[32 + e1] + lr1);
            rt[(size_t)e0 * CAP + r0] = t; rt[(size_t)e1 * CAP + r1] = t; gateb[(size_t)e0 * CAP + r0] = g0; gateb[(size_t)e1 * CAP + r1] = g1;
            int4 ti; ti.x = e0 * CAP + (int)r0; ti.y = e1 * CAP + (int)r1; ti.z = 0; ti.w = 0; *(int4*)(tokinfo + (size_t)t * 4) = ti;
        }
        __syncthreads();
    }
}

__device__ __forceinline__ void phase_final(const Params& p, unsigned char* lds, float* dst) {
    const int tid = opaque_tid(), lane = tid & 63, wave = tid >> 6;
    const int gw = blockIdx.x * NWAVES + wave, NGW = gridDim.x * NWAVES;
    int* pst = (int*)lds;
    const unsigned* cnt = (const unsigned*)(p.ws + WS_CTL + CTL_CNT);
    if (tid == 0) { int ts = 0; for (int e = 0; e < NEXP; ++e) { pst[e] = ts; ts += ((int)cnt[e] + 255) >> 8; } }
    __syncthreads();
    const int* tokinfo = (const int*)(p.ws + WS_TOKINFO); const bf16_t* yb = (const bf16_t*)(p.ws + WS_YB); const bf16_t* hbuf = (const bf16_t*)(p.ws + WS_HB); const float* gfin = p.in[32];
    f32x4 gv[8];
#pragma unroll
    for (int j = 0; j < 8; ++j) gv[j] = *((const f32x4*)gfin + lane + 64 * j);
    constexpr int MAXTOK = 8;
    unsigned sl0[MAXTOK], sl1[MAXTOK];
#pragma unroll
    for (int i = 0; i < MAXTOK; ++i) { const int m = gw + i * NGW; sl0[i] = 0u; sl1[i] = 0u;
        if (m < T) { const int4 ti = *(const int4*)(tokinfo + (size_t)m * 4); sl0[i] = (unsigned)(pst[ti.x / CAP] * 256 + ti.x % CAP); sl1[i] = (unsigned)(pst[ti.y / CAP] * 256 + ti.y % CAP); } }
    u32x2 hA[8], aA[8], bA[8], hB[8], aB[8], bB[8];
#define FIN_LOAD(i_, H, A, B) do { const int m_ = gw + (i_) * NGW; if (m_ < T) { const u32x2* hr_ = (const u32x2*)(hbuf + (size_t)m_ * DM) + lane; const u32x2* y0_ = (const u32x2*)(yb + (size_t)sl0[i_] * DM) + lane; const u32x2* y1_ = (const u32x2*)(yb + (size_t)sl1[i_] * DM) + lane; \
        _Pragma("unroll") for (int j = 0; j < 8; ++j) { H[j] = hr_[64 * j]; A[j] = y0_[64 * j]; B[j] = y1_[64 * j]; } } } while (0)
#define FIN_PROC(i_, H, A, B) do { const int m_ = gw + (i_) * NGW; if (m_ < T) { f32x4 v[8]; float s_ = 0.f; \
        _Pragma("unroll") for (int j = 0; j < 8; ++j) { v[j][0] = bflo(H[j].x) + (bflo(A[j].x) + bflo(B[j].x)); v[j][1] = bfhi(H[j].x) + (bfhi(A[j].x) + bfhi(B[j].x)); v[j][2] = bflo(H[j].y) + (bflo(A[j].y) + bflo(B[j].y)); v[j][3] = bfhi(H[j].y) + (bfhi(A[j].y) + bfhi(B[j].y)); \
            s_ += (v[j][0] * v[j][0] + v[j][1] * v[j][1]) + (v[j][2] * v[j][2] + v[j][3] * v[j][3]); } \
        s_ = wave_sum_fast(s_); const float rs_ = 1.0f / sqrtf(s_ * (1.0f / DM) + 1e-6f); \
        _Pragma("unroll") for (int j = 0; j < 8; ++j) { f32x4 ov = v[j] * rs_ * gv[j]; \
            if (PROBE_TS_A >= 0 && m_ == 0 && lane == 0 && j == 0) { const unsigned long long* ts = (const unsigned long long*)(p.ws + WS_CTL + CTL_TS); ov[0] += (PROBE_TS_A == 99) ? sqrtf(33.554432f * (float)p.ws_mib) : sqrtf(33.554432f * (float)(ts[PROBE_TS_B] - ts[PROBE_TS_A]) * 0.01f); } \
            ((f32x4*)(dst + (size_t)m_ * DM) + lane)[64 * j] = ov; } } } while (0)
    FIN_LOAD(0, hA, aA, bA);
#pragma unroll
    for (int i = 0; i < MAXTOK; i += 2) {
        FIN_LOAD(i + 1, hB, aB, bB);
        FIN_PROC(i, hA, aA, bA);
        if (i + 2 < MAXTOK) FIN_LOAD(i + 2, hA, aA, bA);
        FIN_PROC(i + 1, hB, aB, bB);
    }
    for (int m = gw + MAXTOK * NGW; m < T; m += NGW) {
        const int4 ti = *(const int4*)(tokinfo + (size_t)m * 4); sl0[0] = (unsigned)(pst[ti.x / CAP] * 256 + ti.x % CAP); sl1[0] = (unsigned)(pst[ti.y / CAP] * 256 + ti.y % CAP);
        const u32x2* hr_ = (const u32x2*)(hbuf + (size_t)m * DM) + lane; const u32x2* y0_ = (const u32x2*)(yb + (size_t)sl0[0] * DM) + lane; const u32x2* y1_ = (const u32x2*)(yb + (size_t)sl1[0] * DM) + lane;
        f32x4 v[8]; float s_ = 0.f;
#pragma unroll
        for (int j = 0; j < 8; ++j) { const u32x2 H = hr_[64 * j], A = y0_[64 * j], B = y1_[64 * j];
            v[j][0] = bflo(H.x) + (bflo(A.x) + bflo(B.x)); v[j][1] = bfhi(H.x) + (bfhi(A.x) + bfhi(B.x)); v[j][2] = bflo(H.y) + (bflo(A.y) + bflo(B.y)); v[j][3] = bfhi(H.y) + (bfhi(A.y) + bfhi(B.y));
            s_ += (v[j][0] * v[j][0] + v[j][1] * v[j][1]) + (v[j][2] * v[j][2] + v[j][3] * v[j][3]); }
        s_ = wave_sum_fast(s_); const float rs_ = 1.0f / sqrtf(s_ * (1.0f / DM) + 1e-6f);
#pragma unroll
        for (int j = 0; j < 8; ++j) ((f32x4*)(dst + (size_t)m * DM) + lane)[64 * j] = v[j] * rs_ * gv[j];
    }
#undef FIN_LOAD
#undef FIN_PROC
}

#define GAS __attribute__((address_space(1)))
typedef GAS unsigned gu32;
#define RLX_AGENT __ATOMIC_RELAXED, __HIP_MEMORY_SCOPE_AGENT
#define XB_TMO      128
#define XB_XCNT(j)  (256  + 64 * (j))
#define XB_XSUB(j)  (1280 + 64 * (j))
#define XB_XGEN(j)  (2304 + 64 * (j))
#define XB_TOP      3328
#define XB_TOPGEN   3392
#define XCD_BAR_WORDS 3456
#define XB_SPIN_CAP (1u << 18)

__device__ __forceinline__ unsigned xb_ld(unsigned* p)              { return __hip_atomic_load(p, __ATOMIC_RELAXED, __HIP_MEMORY_SCOPE_AGENT); }
__device__ __forceinline__ unsigned xb_add(unsigned* p, unsigned v) { return __hip_atomic_fetch_add(p, v, __ATOMIC_RELAXED, __HIP_MEMORY_SCOPE_AGENT); }
__device__ __forceinline__ unsigned xb_xcc_id() { return (unsigned)__builtin_amdgcn_s_getreg((3 << 11) | 20) & 0xFu; }
#define XB_SPIN(cond, bar) do { unsigned _sp = 0; while (cond) { __builtin_amdgcn_s_sleep(1); \
    if ((++_sp & 255u) == 0u) { if (xb_ld(&(bar)[XB_TMO])) break; if (_sp > XB_SPIN_CAP) { atomicAdd(&(bar)[XB_TMO], 1u); break; } } } } while (0)

struct XcdBarrier {
    unsigned* bar; unsigned x;
    volatile LAS unsigned* st;
};

__device__ __forceinline__ XcdBarrier xcd_barrier_post(unsigned* bar, volatile LAS unsigned* st) {
    XcdBarrier b; b.bar = bar; b.x = xb_xcc_id(); b.st = st;
    if (threadIdx.x == 0) (void)xb_add(&bar[XB_XCNT(b.x)], 1u);
    return b;
}
__device__ __forceinline__ void xcd_barrier_complete(unsigned* bar, unsigned x, unsigned& nloc, unsigned& nx) {
    const unsigned G = gridDim.x * gridDim.y * gridDim.z;
    unsigned sum, cnt, mine, sp = 0u;
    for (;;) {
        sum = 0u; cnt = 0u; mine = 0u;
#pragma unroll
        for (unsigned j = 0; j < 16; ++j) { const unsigned c = xb_ld(&bar[XB_XCNT(j)]); sum += c; cnt += (c > 0u) ? 1u : 0u; mine = (j == x) ? c : mine; }
        if (sum == G) break;
        __builtin_amdgcn_s_sleep(1);
        if ((++sp & 255u) == 0u) { if (xb_ld(&bar[XB_TMO])) break; if (sp > XB_SPIN_CAP) { atomicAdd(&bar[XB_TMO], 1u); break; } }
    }
    nloc = mine > 0u ? mine : 1u; nx = cnt > 0u ? cnt : 1u;
}

__device__ __forceinline__ void xcd_barrier(const XcdBarrier& b) {
    asm volatile("s_waitcnt vmcnt(0)" ::: "memory");
    __syncthreads();
    if (threadIdx.x == 0) {
        unsigned* bar = b.bar;
        __builtin_amdgcn_s_waitcnt(0);
        unsigned nloc = b.st[0], nx = b.st[1];
        if (nloc == 0u) { xcd_barrier_complete(bar, b.x, nloc, nx); b.st[0] = nloc; b.st[1] = nx; }
        const unsigned old = xb_add(&bar[XB_XSUB(b.x)], 1u);
        const unsigned gen = old / nloc;
        if (old + 1u == (gen + 1u) * nloc) {
            __builtin_amdgcn_fence(__ATOMIC_RELEASE, "agent");
            asm volatile("s_waitcnt vmcnt(0)" ::: "memory");
            const unsigned og = xb_add(&bar[XB_TOP], 1u);
            const unsigned tg = og / nx;
            if (og + 1u == (tg + 1u) * nx) xb_add(&bar[XB_TOPGEN], 1u);
            else XB_SPIN(xb_ld(&bar[XB_TOPGEN]) == tg, bar);
            __builtin_amdgcn_fence(__ATOMIC_ACQUIRE, "agent");
            xb_add(&bar[XB_XGEN(b.x)], 1u);
            asm volatile("s_waitcnt vmcnt(0)" ::: "memory");
        } else {
            XB_SPIN(xb_ld(&bar[XB_XGEN(b.x)]) == gen, bar);
            __builtin_amdgcn_fence(__ATOMIC_ACQUIRE, "agent");
            asm volatile("s_waitcnt vmcnt(0)" ::: "memory");
        }
    }
    __syncthreads();
}


#if USE_REF_GEMM
#define GEMM_PHASE gemm_phase_ref
#else
#define GEMM_PHASE gemm_phase_mfma
#endif

__global__ void __launch_bounds__(NTHREADS, 2) fwd_kernel(Params p) {
    extern __shared__ __attribute__((aligned(16))) unsigned char lds[];
    unsigned char* ws = p.ws;
    const int lo = p.ph_lo, hi = p.ph_hi;
#define IN(k) (lo <= (k) && (k) < hi)
#if N_LAUNCH_MODE == 1
    volatile LAS unsigned* bst = (volatile LAS unsigned*)((LAS unsigned char*)lds + LDS_BYTES - 32);
    if (threadIdx.x < 2) bst[threadIdx.x] = 0u;
    __syncthreads();
    const XcdBarrier bar = xcd_barrier_post((unsigned*)(ws + WS_CTL + CTL_BAR), bst);
#define SEAM(k) do { if (IN(k) && IN((k) + 1)) xcd_barrier(bar); if (PROBE_TS_A >= 0 && blockIdx.x == 0 && threadIdx.x == 0) ((unsigned long long*)(ws + WS_CTL + CTL_TS))[(k) + 1] = __builtin_amdgcn_s_memrealtime(); } while (0)
#else
#define SEAM(k) do { } while (0)
#endif
    if (PROBE_TS_A >= 0 && blockIdx.x == 0 && threadIdx.x == 0) ((unsigned long long*)(ws + WS_CTL + CTL_TS))[0] = __builtin_amdgcn_s_memrealtime();
    if (IN(PH_PRO)) { phase_prologue(p, lds); if (PROBE_DUP & 8) { __syncthreads(); phase_prologue(p, lds); } } SEAM(PH_PRO);
    if (IN(PH_INPROJ)) {
        Gemm g{(const bf16_t*)(ws + WS_XB), (const bf16_t*)(ws + WS_WIN), DM, DM, DM};
        DenseOrder S; S.init(T, NIN, gridDim.x, blockIdx.x, DM, DM);
        EpiIn E{(bf16_t*)(ws + WS_INBUF), (bf16_t*)(ws + WS_PBUF), (const float*)(ws + WS_RSTD1), (unsigned*)(ws + WS_CTL + CTL_NRM)};
        GEMM_PHASE<EpiIn, DenseOrder>(lds, g, S, E);
        if (PROBE_DUP & 64) GEMM_PHASE<EpiIn, DenseOrder>(lds, g, S, E);
        convert_gu_queue(p, lds, (unsigned*)(ws + WS_CTL + CTL_QCTR) + 5, NEXP_MIX, NEXP_EARLY);
    } SEAM(PH_INPROJ);
    if (IN(PH_L2PREP)) { phase_l2prep(p); if (PROBE_DUP & 4096) { phase_l2prep(p); phase_l2prep(p); phase_l2prep(p); } } SEAM(PH_L2PREP);
    if (IN(PH_L2GEMM)) {
        Gemm g{(const bf16_t*)(ws + WS_A2), (const bf16_t*)(ws + WS_L2T), PW, 256, 256};
        DenseOrder S; S.init(T, 3072, gridDim.x, blockIdx.x, PW, 256, 2, 256);
        EpiL2 E{(float*)(ws + WS_WL), (bf16_t*)(ws + WS_ABUF), (bf16_t*)(ws + WS_GBUF), p.in[11], p.in[14]};
        GEMM_PHASE<EpiL2, DenseOrder>(lds, g, S, E);
        if (PROBE_DUP & 16384) GEMM_PHASE<EpiL2, DenseOrder>(lds, g, S, E);
    } SEAM(PH_L2GEMM);
    if (IN(PH_MIX)) {
        for (int rep = 0; rep < ((PROBE_DUP & 1) ? 2 : 1); ++rep)
        if (((blockIdx.x >> 3) & 1) == 0) for (int chain = ((blockIdx.x >> 4) << 3) | (blockIdx.x & 7); chain < BATCH * NH_RW; chain += gridDim.x >> 1) rwkv_chain(p, lds, chain);
        { const unsigned g16 = (blockIdx.x >> 4) & 7, l16 = blockIdx.x & 15;
          if (l16 == 8 + g16 || l16 == 8 + ((g16 + 4) & 7)) convert_gu_queue(p, lds, (unsigned*)(ws + WS_CTL + CTL_QCTR) + 3, 0, NEXP_MIX); }
        attn_phase_queue(p, lds, (unsigned*)(ws + WS_CTL + CTL_QCTR));
        convert_gu_queue(p, lds, (unsigned*)(ws + WS_CTL + CTL_QCTR) + 3, 0, NEXP_MIX);
        if (PROBE_DUP & 2) attn_phase_queue(p, lds, (unsigned*)(ws + WS_CTL + CTL_QCTR) + 1);
    } SEAM(PH_MIX);
    if (IN(PH_COMB)) { phase_combine(p); if (PROBE_DUP & 2048) { phase_combine(p); phase_combine(p); phase_combine(p); } } SEAM(PH_COMB);
    if (IN(PH_OUT)) {
        Gemm g{(const bf16_t*)(ws + WS_O), (const bf16_t*)(ws + WS_WOUT), DM, DM, DM};
        DenseOrder S; S.init(T, DM, gridDim.x, blockIdx.x, DM, DM);
        EpiOut E{p.in[0], p.out, (bf16_t*)(ws + WS_HB), (float*)(ws + WS_CTL + CTL_SS2)};
        GEMM_PHASE<EpiOut, DenseOrder>(lds, g, S, E);
        if (PROBE_DUP & 8192) { EpiOut E2{p.in[0], p.out, (bf16_t*)(ws + WS_HB), (float*)(ws + WS_RSTD1)}; GEMM_PHASE<EpiOut, DenseOrder>(lds, g, S, E2); }
    } SEAM(PH_OUT);
    if (IN(PH_ROUTE)) { if (PROBE_DUP & 1024) { phase_router(p, lds, true); __syncthreads(); } phase_router(p, lds); convert_gu_queue(p, lds, (unsigned*)(ws + WS_CTL + CTL_QCTR) + 4, NEXP_EARLY, NEXP); } SEAM(PH_ROUTE);
    const int vcu_moe = (gridDim.x % 8 == 0) ? (int)((blockIdx.x % 8) * (gridDim.x / 8) + blockIdx.x / 8) : (int)blockIdx.x;
    if (IN(PH_G1)) {
        Gemm g{(const bf16_t*)(ws + WS_HB), (const bf16_t*)ws, DM, DM, DM};
        MoeOrder<true> S{(const int*)(ws + WS_RT), 4, (int)gridDim.x, vcu_moe, 0, DM, (long)1024 * 2048, DM, 0, 0, 0}; S.init((const unsigned*)(ws + WS_CTL + CTL_CNT));
        EpiGU E{(bf16_t*)(ws + WS_HID), (const float*)(ws + WS_RSTD2)};
        GEMM_PHASE<EpiGU, MoeOrder<true>>(lds, g, S, E);
        convert_down_queue(p, lds, (unsigned*)(ws + WS_CTL + CTL_QCTR) + 2);
        if (PROBE_DUP & 128) GEMM_PHASE<EpiGU, MoeOrder<true>>(lds, g, S, E);
    } SEAM(PH_G1);
    if (IN(PH_G2)) {
        Gemm g{(const bf16_t*)(ws + WS_HID), (const bf16_t*)ws, DEXP, DEXP, DEXP};
        MoeOrder<false> S{(const int*)(ws + WS_RT), 8, (int)gridDim.x, vcu_moe, 1, DEXP, (long)2048 * 512, DEXP, 0, 0, 0}; S.init((const unsigned*)(ws + WS_CTL + CTL_CNT));
        EpiDown E{(bf16_t*)(ws + WS_YB), (const float*)(ws + WS_GATEB), (const unsigned*)(ws + WS_CTL + CTL_CNT)};
        GEMM_PHASE<EpiDown, MoeOrder<false>>(lds, g, S, E);
        if (PROBE_DUP & 256) GEMM_PHASE<EpiDown, MoeOrder<false>>(lds, g, S, E);
    } SEAM(PH_G2);
    if (IN(PH_FINAL)) { if (PROBE_DUP & 32768) { phase_final(p, lds, (float*)(ws + WS_XB)); __syncthreads(); } phase_final(p, lds, p.out); }
}

extern "C" void kernel_launch(void* const* d_in, const int* in_sizes, int n_in, void* d_out, int out_size, void* d_ws, size_t ws_size, hipStream_t stream) {
    static int grid = 0;
    if (grid == 0) {
        if (n_in != 33 || out_size != T * DM || ws_size < WS_END) { fprintf(stderr, "kernel_launch: unexpected problem (n_in %d out %d ws %zu)\n", n_in, out_size, ws_size); grid = -1; return; }
        int dev = 0, cus = 0;
        hipGetDevice(&dev); hipDeviceGetAttribute(&cus, hipDeviceAttributeMultiprocessorCount, dev);
        if (hipFuncSetAttribute((const void*)fwd_kernel, hipFuncAttributeMaxDynamicSharedMemorySize, LDS_BYTES) != hipSuccess) { fprintf(stderr, "kernel_launch: hipFuncSetAttribute failed\n"); grid = -1; return; }
        int per_cu = 0; hipOccupancyMaxActiveBlocksPerMultiprocessor(&per_cu, (const void*)fwd_kernel, NTHREADS, LDS_BYTES); (void)hipGetLastError();
        if (per_cu < 1) fprintf(stderr, "kernel_launch: occupancy query says %d blocks per CU\n", per_cu);
        if (per_cu < 1) { grid = -1; return; }
        grid = cus > 0 ? cus : 256;
    }
    if (grid < 0) return;
    hipMemsetAsync((char*)d_ws + WS_CTL, 0, CTL_BYTES, stream);
    Params p{};
    for (int i = 0; i < 33; ++i) p.in[i] = (const float*)d_in[i];
    p.out = (float*)d_out; p.ws = (unsigned char*)d_ws; p.ws_mib = (unsigned long long)(ws_size >> 20);
#if N_LAUNCH_MODE == 1
    p.ph_lo = 0; p.ph_hi = PH_COUNT;
    void* args[] = {&p};
    hipError_t e = hipLaunchCooperativeKernel((const void*)fwd_kernel, dim3(grid), dim3(NTHREADS), args, LDS_BYTES, stream);
    if (e != hipSuccess) fprintf(stderr, "cooperative launch failed: %s (grid %d)\n", hipGetErrorString(e), grid);
#else
    for (int ph = 0; ph < PH_COUNT; ++ph) { p.ph_lo = ph; p.ph_hi = ph + 1; hipLaunchKernelGGL(fwd_kernel, dim3(grid), dim3(NTHREADS), LDS_BYTES, stream, p); }
#endif
}
```
